# Optimizing an MI355X kernel written in HIP

```python
import jax
import jax.numpy as jnp
from jax import lax
import numpy as np

D_MODEL = 2048
BATCH = 32
SEQ = 256
DEPTH = 4
DEC_BATCH = 2
DEC_SEQ = 2048
PAST_LEN = 256

GRID_W = 64
N_MIXERS = 3
N_MLA = (DEPTH + 2) // 3
N_HGRN = (DEPTH + 1) // 3
N_NAT = DEPTH // 3
N_MOD = 6
D_FF = 4 * D_MODEL
NORM_EPS = 1e-6
Q_BLOCK = 128
ROPE_THETA = 10000.0

MLA_HEADS = 16
MLA_NOPE = 128
MLA_ROPE = 64
MLA_QK = MLA_NOPE + MLA_ROPE
MLA_V = 128
MLA_Q_LORA = 768
MLA_KV_LORA = 512

HG_HEADS = 16
HG_K = 128
HG_V = D_MODEL // HG_HEADS
HG_CHUNK = 32

NAT_HEADS = 16
NAT_HD = D_MODEL // NAT_HEADS
NAT_WIN_ROWS = 8
NAT_WIN_COLS = 16

kernel_name = 'hybrid_mla_hgrn2_natten_diffusion_step'


def rms_norm(x, g):
    xf = x.astype(jnp.float32)
    y = xf * lax.rsqrt(jnp.mean(xf * xf, axis=-1, keepdims=True) + NORM_EPS)
    return (y * g.astype(jnp.float32)).astype(x.dtype)


def adaln(cvec, w, b):
    m = jax.nn.silu(cvec) @ w + b
    return [t[:, None, :] for t in jnp.split(m, N_MOD, axis=-1)]


def modulate(h, shift, scale):
    return h * (1 + scale) + shift


def sqrelu_mlp(h, w1, w2):
    return jnp.square(jax.nn.relu(h @ w1)) @ w2


def merge_heads(o):
    return o.reshape(o.shape[0], o.shape[1], -1)


def axial_rope(n_tok):
    n_freq = MLA_ROPE // 4
    inv = 1.0 / (ROPE_THETA ** (jnp.arange(n_freq, dtype=jnp.float32) / n_freq))
    t = jnp.arange(n_tok)
    row = (t // GRID_W).astype(jnp.float32)
    col = (t % GRID_W).astype(jnp.float32)
    ang = jnp.concatenate([row[:, None] * inv, col[:, None] * inv], axis=-1)
    return jnp.cos(ang)[None, :, None, :], jnp.sin(ang)[None, :, None, :]


def apply_rope(x, rope):
    cos, sin = rope
    x1, x2 = jnp.split(x.astype(jnp.float32), 2, axis=-1)
    return jnp.concatenate([x1 * cos - x2 * sin, x1 * sin + x2 * cos], axis=-1).astype(x.dtype)


def rope_tail(x, n_plain, rope):
    if rope is None:
        return x
    return jnp.concatenate([x[..., :n_plain], apply_rope(x[..., n_plain:], rope)], axis=-1)


def block_attention(q, k, v):
    b, nq, h, dq = q.shape
    nb = nq // Q_BLOCK
    scale = dq ** -0.5
    qb = jnp.moveaxis(q.reshape(b, nb, Q_BLOCK, h, dq), 1, 0)

    def attend(qi):
        s = jnp.einsum('bqhd,bkhd->bhqk', qi, k).astype(jnp.float32) * scale
        p = jax.nn.softmax(s, axis=-1).astype(v.dtype)
        return jnp.einsum('bhqk,bkhd->bqhd', p, v)

    o = lax.map(attend, qb)
    return jnp.moveaxis(o, 0, 1).reshape(b, nq, h, v.shape[-1])


def mla_queries(h, w_qa, g_qa, w_qb, g_qn, rope):
    b, n, _ = h.shape
    q = (rms_norm(h @ w_qa, g_qa) @ w_qb).reshape(b, n, MLA_HEADS, MLA_QK)
    return rope_tail(rms_norm(q, g_qn), MLA_NOPE, rope)


def mla_compress(h, w_kva, g_kva):
    kv = h @ w_kva
    return rms_norm(kv[..., :MLA_KV_LORA], g_kva), kv[..., MLA_KV_LORA:]


def mla_expand(ckv, kpe, w_kvb, g_kn, rope):
    b, n, _ = ckv.shape
    kv = (ckv @ w_kvb).reshape(b, n, MLA_HEADS, MLA_NOPE + MLA_V)
    k_pe = jnp.broadcast_to(kpe[:, :, None, :], (b, n, MLA_HEADS, MLA_ROPE))
    k = rms_norm(jnp.concatenate([kv[..., :MLA_NOPE], k_pe], axis=-1), g_kn)
    return rope_tail(k, MLA_NOPE, rope), kv[..., MLA_NOPE:]


def mla_mixer(hp, hs, ckv_cache, kpe_cache, rope, w_qa, g_qa, w_qb, g_qn, w_kva, g_kva, w_kvb, g_kn, w_o):
    ckv_p, kpe_p = mla_compress(hp, w_kva, g_kva)
    k_p, v_p = mla_expand(ckv_p, kpe_p, w_kvb, g_kn, None)
    o_p = block_attention(mla_queries(hp, w_qa, g_qa, w_qb, g_qn, None), k_p, v_p)
    ckv_s, kpe_s = mla_compress(hs, w_kva, g_kva)
    k_s, v_s = mla_expand(ckv_s, kpe_s, w_kvb, g_kn, rope)
    k_c, v_c = mla_expand(ckv_cache, kpe_cache, w_kvb, g_kn, None)
    o_s = block_attention(mla_queries(hs, w_qa, g_qa, w_qb, g_qn, rope),
                          jnp.concatenate([k_s, k_c], axis=1), jnp.concatenate([v_s, v_c], axis=1))
    return merge_heads(o_p) @ w_o, merge_heads(o_s) @ w_o, ckv_p, kpe_p


def hgrn_chunk_scan(q, k, v, log_f, s0):
    b, n, h, dk = q.shape
    dv = v.shape[-1]
    nc = n // HG_CHUNK

    def chunks(a):
        return a.reshape(b, nc, HG_CHUNK, h, a.shape[-1]).transpose(1, 0, 3, 2, 4)

    tri = jnp.tril(jnp.ones((HG_CHUNK, HG_CHUNK), dtype=bool))[:, :, None]

    def step(S, inp):
        qc, kc, vc, gc = inp
        cum = jnp.cumsum(gc, axis=2)
        rel = jnp.exp(jnp.where(tri, cum[:, :, :, None, :] - cum[:, :, None, :, :], -jnp.inf))
        att = jnp.einsum('bhtk,bhsk,bhtsk->bhts', qc, kc, rel)
        o = jnp.einsum('bhts,bhsv->bhtv', att, vc) + jnp.einsum('bhtk,bhkv->bhtv', qc * jnp.exp(cum), S)
        last = cum[:, :, -1, :]
        S = S * jnp.exp(last)[..., None] + jnp.einsum('bhsk,bhsv->bhkv', kc * jnp.exp(last[:, :, None, :] - cum), vc)
        return S, o

    S, o = lax.scan(step, s0, tuple(chunks(a) for a in (q, k, v, log_f)))
    return o.transpose(1, 0, 3, 2, 4).reshape(b, n, h, dv), S


def hgrn_mixer(h, s0, lb, w_q, w_f, w_i, w_g, g_o, w_o):
    b, n, _ = h.shape
    q = jax.nn.silu((h @ w_q).astype(jnp.float32)).reshape(b, n, HG_HEADS, HG_K)
    v = (h @ w_i).astype(jnp.float32).reshape(b, n, HG_HEADS, HG_V)
    outs, states = [], []
    for d in range(2):
        f = lb[d] + (1.0 - lb[d]) * jax.nn.sigmoid((h @ w_f[d]).astype(jnp.float32))
        f = f.reshape(b, n, HG_HEADS, HG_K)
        seq = (q, 1.0 - f, v, jnp.log(f))
        if d == 1:
            seq = tuple(jnp.flip(a, axis=1) for a in seq)
        o, s_fin = hgrn_chunk_scan(*seq, s0[:, d].astype(jnp.float32))
        outs.append(jnp.flip(o, axis=1) if d == 1 else o)
        states.append(s_fin)
    o = rms_norm(outs[0] + outs[1], g_o).reshape(b, n, D_MODEL).astype(h.dtype)
    o = o * jax.nn.silu(h @ w_g)
    return o @ w_o, jnp.stack(states, axis=1)


def nat_qkv(h, w_qkv, g_q, g_k):
    b, n, _ = h.shape
    qkv = (h @ w_qkv).reshape(b, n, 3, NAT_HEADS, NAT_HD)
    return rms_norm(qkv[:, :, 0], g_q), rms_norm(qkv[:, :, 1], g_k), qkv[:, :, 2]


def neighbourhood_attention(q, k, v, k_ctx, v_ctx, rpb):
    b, n, h, d = q.shape
    rows = n // GRID_W
    wr = min(NAT_WIN_ROWS, rows)
    nw = wr * NAT_WIN_COLS
    scale = d ** -0.5
    qg = q.reshape(b, rows, GRID_W, h, d)
    kg = k.reshape(b, rows, GRID_W, h, d)
    vg = v.reshape(b, rows, GRID_W, h, d)
    col = jnp.arange(GRID_W)
    col_idx = jnp.clip(col - NAT_WIN_COLS // 2, 0, GRID_W - NAT_WIN_COLS)[:, None] + jnp.arange(NAT_WIN_COLS)[None, :]
    dc = col_idx - col[:, None] + NAT_WIN_COLS - 1

    def one_row(args):
        r, q_r = args
        r0 = jnp.clip(r - wr // 2, 0, rows - wr)
        k_win = lax.dynamic_slice_in_dim(kg, r0, wr, axis=1)[:, :, col_idx]
        v_win = lax.dynamic_slice_in_dim(vg, r0, wr, axis=1)[:, :, col_idx]
        dr = r0 + jnp.arange(wr) - r + NAT_WIN_ROWS - 1
        bias = jnp.transpose(rpb[:, dr[:, None, None], dc[None, :, :]], (0, 2, 1, 3))
        s_win = jnp.einsum('bqhd,brqchd->bhqrc', q_r, k_win).astype(jnp.float32) * scale + bias.astype(jnp.float32)
        s_ctx = jnp.einsum('bqhd,bkhd->bhqk', q_r, k_ctx).astype(jnp.float32) * scale
        p = jax.nn.softmax(jnp.concatenate([s_win.reshape(b, h, GRID_W, nw), s_ctx], axis=-1), axis=-1).astype(v.dtype)
        p_win = p[..., :nw].reshape(b, h, GRID_W, wr, NAT_WIN_COLS)
        return jnp.einsum('bhqrc,brqchd->bqhd', p_win, v_win) + jnp.einsum('bhqk,bkhd->bqhd', p[..., nw:], v_ctx)

    o = lax.map(one_row, (jnp.arange(rows), jnp.moveaxis(qg, 1, 0)))
    return jnp.moveaxis(o, 0, 1).reshape(b, n, h, d)


def nat_mixer(hp, hs, k_cache, v_cache, w_qkv, g_q, g_k, rpb, w_o):
    q_p, k_p, v_p = nat_qkv(hp, w_qkv, g_q, g_k)
    o_p = block_attention(q_p, k_p, v_p)
    q_s, k_s, v_s = nat_qkv(hs, w_qkv, g_q, g_k)
    o_s = neighbourhood_attention(q_s, k_s, v_s, k_cache, v_cache, rpb)
    return merge_heads(o_p) @ w_o, merge_heads(o_s) @ w_o, k_p, v_p


def setup_inputs(seed: int = 0) -> dict:
    key = jax.random.key(seed)
    ks = iter(jax.random.split(key, 40))

    def nrm(shape, s=1.0):
        return jax.random.normal(next(ks), shape, jnp.float32) * s

    def lin(shape, g=1.0):
        return nrm(shape, g * shape[-2] ** -0.5)

    def gain(shape):
        return 1.0 + nrm(shape, 0.01)

    D = D_MODEL
    return {
        'x_prompt': nrm((BATCH, SEQ, D)),
        'x_sample': nrm((DEC_BATCH, DEC_SEQ, D)),
        'cache_mla_ckv': nrm((DEC_BATCH, N_MLA, PAST_LEN, MLA_KV_LORA)),
        'cache_mla_kpe': nrm((DEC_BATCH, N_MLA, PAST_LEN, MLA_ROPE)),
        'state_hgrn': nrm((DEC_BATCH, N_HGRN, 2, HG_HEADS, HG_K, HG_V), 0.5),
        'cache_nat_k': nrm((DEC_BATCH, N_NAT, PAST_LEN, NAT_HEADS, NAT_HD)),
        'cache_nat_v': nrm((DEC_BATCH, N_NAT, PAST_LEN, NAT_HEADS, NAT_HD)),
        'c': nrm((DEC_BATCH, D)),
        'c_ctx': nrm((D,)),
        'w_mod': lin((DEPTH, D, N_MOD * D), 0.5),
        'b_mod': nrm((DEPTH, N_MOD * D), 0.01),
        'g_norm_mix': gain((DEPTH, D)),
        'g_norm_ffn': gain((DEPTH, D)),
        'w_mla_qa': lin((N_MLA, D, MLA_Q_LORA)),
        'g_mla_qa': gain((N_MLA, MLA_Q_LORA)),
        'w_mla_qb': lin((N_MLA, MLA_Q_LORA, MLA_HEADS * MLA_QK)),
        'g_mla_qn': gain((N_MLA, MLA_QK)),
        'w_mla_kva': lin((N_MLA, D, MLA_KV_LORA + MLA_ROPE)),
        'g_mla_kva': gain((N_MLA, MLA_KV_LORA)),
        'w_mla_kvb': lin((N_MLA, MLA_KV_LORA, MLA_HEADS * (MLA_NOPE + MLA_V))),
        'g_mla_kn': gain((N_MLA, MLA_QK)),
        'w_mla_o': lin((N_MLA, MLA_HEADS * MLA_V, D)),
        'w_hg_q': lin((N_HGRN, D, HG_HEADS * HG_K)),
        'w_hg_f': lin((N_HGRN, 2, D, HG_HEADS * HG_K)),
        'hg_lower_bounds': nrm((2, DEPTH, HG_HEADS * HG_K)),
        'w_hg_i': lin((N_HGRN, D, HG_HEADS * HG_V)),
        'w_hg_g': lin((N_HGRN, D, D)),
        'g_hg_o': gain((N_HGRN, HG_V)),
        'w_hg_o': lin((N_HGRN, D, D)),
        'w_nat_qkv': lin((N_NAT, D, 3 * D)),
        'g_nat_q': gain((N_NAT, NAT_HD)),
        'g_nat_k': gain((N_NAT, NAT_HD)),
        'nat_rpb': nrm((N_NAT, NAT_HEADS, 2 * NAT_WIN_ROWS - 1, 2 * NAT_WIN_COLS - 1), 0.5),
        'w_nat_o': lin((N_NAT, D, D)),
        'w_ff1': lin((DEPTH, D, D_FF)),
        'w_ff2': lin((DEPTH, D_FF, D)),
    }


def reference(x_prompt, x_sample, cache_mla_ckv, cache_mla_kpe, state_hgrn, cache_nat_k, cache_nat_v, c, c_ctx,
              w_mod, b_mod, g_norm_mix, g_norm_ffn,
              w_mla_qa, g_mla_qa, w_mla_qb, g_mla_qn, w_mla_kva, g_mla_kva, w_mla_kvb, g_mla_kn, w_mla_o,
              w_hg_q, w_hg_f, hg_lower_bounds, w_hg_i, w_hg_g, g_hg_o, w_hg_o,
              w_nat_qkv, g_nat_q, g_nat_k, nat_rpb, w_nat_o,
              w_ff1, w_ff2):
    b_p = x_prompt.shape[0]
    rope = axial_rope(x_sample.shape[1])
    lb_all = jnp.cumsum(jax.nn.softmax(hg_lower_bounds.astype(jnp.float32), axis=1), axis=1)
    lb_all = lb_all - lb_all[:, :1]
    xp, xs = x_prompt, x_sample
    new_ckv, new_kpe, new_hg, new_nat_k, new_nat_v = [], [], [], [], []
    for i in range(DEPTH):
        kind, j = i % N_MIXERS, i // N_MIXERS
        mod_p = adaln(c_ctx[None, :], w_mod[i], b_mod[i])
        mod_s = adaln(c, w_mod[i], b_mod[i])
        hp = modulate(rms_norm(xp, g_norm_mix[i]), mod_p[0], mod_p[1])
        hs = modulate(rms_norm(xs, g_norm_mix[i]), mod_s[0], mod_s[1])
        if kind == 0:
            dp, ds, ckv_p, kpe_p = mla_mixer(hp, hs, cache_mla_ckv[:, j], cache_mla_kpe[:, j], rope,
                                             w_mla_qa[j], g_mla_qa[j], w_mla_qb[j], g_mla_qn[j],
                                             w_mla_kva[j], g_mla_kva[j], w_mla_kvb[j], g_mla_kn[j], w_mla_o[j])
            new_ckv.append(ckv_p)
            new_kpe.append(kpe_p)
        elif kind == 1:
            zero_state = jnp.zeros((b_p, 2, HG_HEADS, HG_K, HG_V), jnp.float32)
            dp, s_ctx = hgrn_mixer(hp, zero_state, lb_all[:, i], w_hg_q[j], w_hg_f[j], w_hg_i[j], w_hg_g[j], g_hg_o[j], w_hg_o[j])
            ds, _ = hgrn_mixer(hs, state_hgrn[:, j], lb_all[:, i], w_hg_q[j], w_hg_f[j], w_hg_i[j], w_hg_g[j], g_hg_o[j], w_hg_o[j])
            new_hg.append(s_ctx.astype(x_prompt.dtype))
        else:
            dp, ds, k_p, v_p = nat_mixer(hp, hs, cache_nat_k[:, j], cache_nat_v[:, j],
                                         w_nat_qkv[j], g_nat_q[j], g_nat_k[j], nat_rpb[j], w_nat_o[j])
            new_nat_k.append(k_p)
            new_nat_v.append(v_p)
        xp = xp + mod_p[2] * dp
        xs = xs + mod_s[2] * ds
        xp = xp + mod_p[5] * sqrelu_mlp(modulate(rms_norm(xp, g_norm_ffn[i]), mod_p[3], mod_p[4]), w_ff1[i], w_ff2[i])
        xs = xs + mod_s[5] * sqrelu_mlp(modulate(rms_norm(xs, g_norm_ffn[i]), mod_s[3], mod_s[4]), w_ff1[i], w_ff2[i])
    return (xp, xs, jnp.stack(new_ckv, axis=1), jnp.stack(new_kpe, axis=1), jnp.stack(new_hg, axis=1),
            jnp.stack(new_nat_k, axis=1), jnp.stack(new_nat_v, axis=1))
```

```cpp
#define MK_SINGLE 0
#define MK_LAST_PHASE 1000
#include <hip/hip_runtime.h>
#include <cstdio>
#include <cstdint>

#ifndef MK_SINGLE
#define MK_SINGLE 0
#endif
#ifndef MK_LAST_PHASE
#define MK_LAST_PHASE 1000
#endif
namespace pg8 {
#define PG8_LAS __attribute__((address_space(3)))
typedef unsigned short bf16_t;
typedef short bf16x8 __attribute__((ext_vector_type(8)));
typedef float f32x4 __attribute__((ext_vector_type(4)));
typedef unsigned u32x4 __attribute__((ext_vector_type(4)));
constexpr int BM = 256, BK = 64, HALF = 128, HTB = HALF * BK * 2  , STAGE_BYTES = 8 * HTB, NXCD = 8, WGM = 8;

__host__ __device__ __forceinline__ int lds_byte(int r, int c) { const int st = (r >> 4) * 2 + (c >> 5), rr = r & 15, cc = c & 31, ob = rr * 64 + cc * 2; return st * 1024 + (ob ^ (((ob >> 9) & 1) << 5)); }
__host__ __device__ __forceinline__ void stage_rc(int b, int& R, int& C) { const int st = b / 1024, sb = b % 1024, swz = sb ^ (((sb >> 9) & 1) << 5); R = (st >> 1) * 16 + swz / 64; C = (st & 1) * 32 + (swz % 64) / 2; }
__host__ __device__ __forceinline__ int perm32(int rho) { const int n = rho >> 4, i = rho & 15; return 8 * (i >> 2) + 4 * n + (i & 3); }

struct Unit { int pm, pn, ks; };
struct Gemm { const bf16_t* A; const bf16_t* Bt; int M, N, K, lda, ldb, nsplit; };

struct StaticOrder {
    int nM, nN, nNv, nwg, G, c;
    __host__ __device__ void init(int M, int N, int nsplit, int G_, int c_) { nM = M / BM; nN = N / BM; nNv = nN * nsplit; nwg = nM * nNv; G = G_; c = c_; }
    __host__ __device__ bool next(int i, Unit& u) const {
        const long L = (long)i * G + c; if (L >= nwg) return false;
        int wgid = (int)L; { const int q = nwg / NXCD, r = nwg % NXCD, xcd = wgid % NXCD, off = wgid / NXCD; wgid = (xcd < r ? xcd * (q + 1) : r * (q + 1) + (xcd - r) * q) + off; }
        const int nig = WGM * nNv, gid = wgid / nig, fm = gid * WGM, gsz = (nM - fm) < WGM ? (nM - fm) : WGM;
        u.pm = fm + ((wgid % nig) % gsz); const int pv = (wgid % nig) / gsz; u.pn = pv % nN; u.ks = pv / nN; return true;
    }
    __device__ __forceinline__ void a_ready(const Unit&) const {}
    __device__ __forceinline__ void done(const Unit&) const {}
};

__device__ __forceinline__ unsigned cvt_pk_bf16(float lo, float hi) { unsigned r; asm("v_cvt_pk_bf16_f32 %0, %1, %2" : "=v"(r) : "v"(lo), "v"(hi)); return r; }


template <class Epi, class Sched, bool ALIGN_EPI = true, bool SP2 = true>
__device__ __forceinline__ void gemm_phase(PG8_LAS unsigned char* lds, const Gemm g, const Sched& S, const Epi& E) {
    int tid_ = threadIdx.x; asm volatile("" : "+v"(tid_));
    const int tid = tid_, wid = __builtin_amdgcn_readfirstlane(tid >> 6), lane = tid & 63, wr = wid >> 2, wc = wid & 3, fr = lane & 15, fq = lane >> 4;
    const int K = g.K, nt = K / BK;
    unsigned voffA[2], voffB[2];
#pragma unroll
    for (int i = 0; i < 2; ++i) { int R, C; stage_rc(tid * 16 + i * 8192, R, C); const int Rb = Epi::PERM ? ((R & ~31) + perm32(R & 31)) : R;
        voffA[i] = (unsigned)(R * g.lda + C) * 2u; voffB[i] = (unsigned)(Rb * g.ldb + C) * 2u; }
    const size_t kstep = (size_t)(BK * 2);
    const size_t hstepA = (size_t)HALF * g.lda * 2, hstepB = (size_t)HALF * g.ldb * 2;
    const size_t tstepA = 2 * hstepA, tstepB = 2 * hstepB;
    const size_t sstep = (size_t)K * 2;
    const unsigned ldsw = (unsigned)wid * 1024u;
    const int aoff = lds_byte(wr * 64 + fr, fq * 8), boff = lds_byte(wc * 32 + fr, fq * 8);
#define PG8_SA(b, h) (((b) * 2 + (h)) * HTB)
#define PG8_SB(b, h) ((4 + (b) * 2 + (h)) * HTB)
#define PG8_STAGE(bufoff, gbase, voff) do { _Pragma("unroll") for (int _i = 0; _i < 2; ++_i) \
        __builtin_amdgcn_global_load_lds((const unsigned*)((const char*)(gbase) + (voff)[_i]), (PG8_LAS unsigned*)(lds + (bufoff) + ldsw + _i * 8192), 16, 0, 0); } while (0)
#define PG8_LDA(dst, b, h) do { _Pragma("unroll") for (int m = 0; m < 4; ++m) _Pragma("unroll") for (int k = 0; k < 2; ++k) dst[m][k] = *(const PG8_LAS bf16x8*)(lds + PG8_SA(b, h) + aoff + m * 2048 + k * 1024); } while (0)
#define PG8_LDB(dst, b, h) do { _Pragma("unroll") for (int n = 0; n < 2; ++n) _Pragma("unroll") for (int k = 0; k < 2; ++k) dst[n][k] = *(const PG8_LAS bf16x8*)(lds + PG8_SB(b, h) + boff + n * 2048 + k * 1024); } while (0)
#define PG8_MMA(ai, bj, At, Bt) do { __builtin_amdgcn_s_setprio(1); _Pragma("unroll") for (int m = 0; m < 4; ++m) _Pragma("unroll") for (int n = 0; n < 2; ++n) _Pragma("unroll") for (int k = 0; k < 2; ++k) \
        acc[ai][bj][m][n] = __builtin_amdgcn_mfma_f32_16x16x32_bf16(Bt[n][k], At[m][k], acc[ai][bj][m][n], 0, 0, 0); __builtin_amdgcn_s_setprio(0); } while (0)
#define PG8_WAIT_V(n) asm volatile("s_waitcnt vmcnt(" #n ")" ::: "memory")
#define PG8_WAIT_L(n) asm volatile("s_waitcnt lgkmcnt(" #n ")" ::: "memory")
#define PG8_BAR __builtin_amdgcn_s_barrier()
#define PG8_SCHED __builtin_amdgcn_sched_barrier(0)
    Unit cur, nxt; int ui = 0;
    if (!S.next(0, cur)) return;
    f32x4 acc[2][2][4][2];
#pragma unroll
    for (int a = 0; a < 2; ++a)
#pragma unroll
        for (int b = 0; b < 2; ++b)
#pragma unroll
            for (int m = 0; m < 4; ++m)
#pragma unroll
                for (int n = 0; n < 2; ++n) acc[a][b][m][n] = (f32x4){0.f, 0.f, 0.f, 0.f};
    bf16x8 At[4][2], B0[2][2], B1[2][2];
    const char* cA = (const char*)g.A + (size_t)cur.pm * tstepA + (size_t)cur.ks * sstep; const char* cB = (const char*)g.Bt + (size_t)cur.pn * tstepB + (size_t)cur.ks * sstep;
    S.a_ready(cur);
    if constexpr (SP2) {
        PG8_STAGE(PG8_SB(0, 0), cB, voffB); PG8_STAGE(PG8_SB(0, 1), cB + hstepB, voffB); PG8_STAGE(PG8_SA(0, 0), cA, voffA); PG8_STAGE(PG8_SA(0, 1), cA + hstepA, voffA);
        if (wr == 1) PG8_BAR;
        PG8_WAIT_V(2); PG8_BAR;
        PG8_STAGE(PG8_SB(1, 0), cB + kstep, voffB); PG8_STAGE(PG8_SA(1, 0), cA + kstep, voffA); PG8_STAGE(PG8_SB(1, 1), cB + hstepB + kstep, voffB);
        PG8_WAIT_V(6); PG8_BAR;
    } else {
        PG8_STAGE(PG8_SB(0, 0), cB, voffB); PG8_STAGE(PG8_SA(0, 0), cA, voffA); PG8_STAGE(PG8_SB(0, 1), cB + hstepB, voffB); PG8_STAGE(PG8_SA(0, 1), cA + hstepA, voffA);
        if (wr == 1) PG8_BAR;
        PG8_WAIT_V(4); PG8_BAR;
        PG8_STAGE(PG8_SB(1, 0), cB + kstep, voffB); PG8_STAGE(PG8_SA(1, 0), cA + kstep, voffA); PG8_STAGE(PG8_SB(1, 1), cB + hstepB + kstep, voffB);
        PG8_WAIT_V(6); PG8_BAR;
    }
    for (;;) {
        const bool has_next = S.next(ui + 1, nxt);
        const char* nA = has_next ? (const char*)g.A + (size_t)nxt.pm * tstepA + (size_t)nxt.ks * sstep : cA; const char* nB = has_next ? (const char*)g.Bt + (size_t)nxt.pn * tstepB + (size_t)nxt.ks * sstep : cB;
        for (int t = 0; t < nt; t += 2) {
            const bool last = (t == nt - 2);
            const char* a1 = cA + (size_t)(t + 1) * kstep;
            const char* a2 = last ? nA : cA + (size_t)(t + 2) * kstep; const char* b2 = last ? nB : cB + (size_t)(t + 2) * kstep;
            const char* a3 = a2 + kstep; const char* b3 = b2 + kstep;
            if (last && has_next) S.a_ready(nxt);
            if constexpr (SP2) {
            PG8_LDB(B0, 0, 0); PG8_LDB(B1, 0, 1); PG8_SCHED; PG8_LDA(At, 0, 0); PG8_STAGE(PG8_SA(1, 1), a1 + hstepA, voffA);
            PG8_WAIT_V(8); PG8_WAIT_L(0); PG8_BAR; PG8_MMA(0, 0, At, B0); PG8_MMA(0, 1, At, B1); PG8_BAR; PG8_SCHED;
            PG8_LDA(At, 0, 1); PG8_STAGE(PG8_SB(0, 0), b2, voffB); PG8_STAGE(PG8_SB(0, 1), b2 + hstepB, voffB); PG8_STAGE(PG8_SA(0, 0), a2, voffA);
            PG8_WAIT_V(8); PG8_WAIT_L(0); PG8_BAR; PG8_MMA(1, 0, At, B0); PG8_MMA(1, 1, At, B1); PG8_BAR; PG8_SCHED;
            PG8_LDB(B0, 1, 0); PG8_LDB(B1, 1, 1); PG8_SCHED; PG8_LDA(At, 1, 0); PG8_STAGE(PG8_SA(0, 1), a2 + hstepA, voffA);
            PG8_WAIT_V(8); PG8_WAIT_L(0); PG8_BAR; PG8_MMA(0, 0, At, B0); PG8_MMA(0, 1, At, B1); PG8_BAR; PG8_SCHED;
            PG8_LDA(At, 1, 1); PG8_STAGE(PG8_SB(1, 0), b3, voffB); PG8_STAGE(PG8_SB(1, 1), b3 + hstepB, voffB); PG8_STAGE(PG8_SA(1, 0), a3, voffA);
            PG8_WAIT_V(8); PG8_WAIT_L(0); PG8_BAR; PG8_MMA(1, 0, At, B0); PG8_MMA(1, 1, At, B1); PG8_BAR; PG8_SCHED;
            } else {
            PG8_LDB(B0, 0, 0); PG8_SCHED; PG8_LDA(At, 0, 0); PG8_STAGE(PG8_SA(1, 1), a1 + hstepA, voffA);
            PG8_WAIT_L(8); PG8_BAR; PG8_WAIT_L(0); PG8_MMA(0, 0, At, B0); PG8_BAR; PG8_SCHED;
            PG8_LDB(B1, 0, 1); PG8_STAGE(PG8_SB(0, 0), b2, voffB);
            PG8_BAR; PG8_WAIT_L(0); PG8_MMA(0, 1, At, B1); PG8_BAR;
            PG8_LDA(At, 0, 1); PG8_STAGE(PG8_SA(0, 0), a2, voffA);
            PG8_BAR; PG8_WAIT_L(0); PG8_MMA(1, 0, At, B0); PG8_BAR; PG8_SCHED;
            PG8_STAGE(PG8_SB(0, 1), b2 + hstepB, voffB);
            PG8_WAIT_V(6); PG8_BAR; PG8_MMA(1, 1, At, B1); PG8_BAR;
            PG8_LDB(B0, 1, 0); PG8_SCHED; PG8_LDA(At, 1, 0); PG8_STAGE(PG8_SA(0, 1), a2 + hstepA, voffA);
            PG8_WAIT_L(8); PG8_BAR; PG8_WAIT_L(0); PG8_MMA(0, 0, At, B0); PG8_BAR; PG8_SCHED;
            PG8_LDB(B1, 1, 1); PG8_STAGE(PG8_SB(1, 0), b3, voffB);
            PG8_BAR; PG8_WAIT_L(0); PG8_MMA(0, 1, At, B1); PG8_BAR;
            PG8_LDA(At, 1, 1); PG8_STAGE(PG8_SA(1, 0), a3, voffA);
            PG8_BAR; PG8_WAIT_L(0); PG8_MMA(1, 0, At, B0); PG8_BAR; PG8_SCHED;
            PG8_STAGE(PG8_SB(1, 1), b3 + hstepB, voffB);
            PG8_WAIT_V(6); PG8_BAR; PG8_MMA(1, 1, At, B1); PG8_BAR;
            }
        }
        if constexpr (ALIGN_EPI) { if (wr == 0) PG8_BAR; }
        E(acc, cur, wr, wc, fr, fq); S.done(cur);
        if (!has_next) break;
#pragma unroll
        for (int a = 0; a < 2; ++a)
#pragma unroll
            for (int b = 0; b < 2; ++b)
#pragma unroll
                for (int m = 0; m < 4; ++m)
#pragma unroll
                    for (int n = 0; n < 2; ++n) acc[a][b][m][n] = (f32x4){0.f, 0.f, 0.f, 0.f};
        cur = nxt; cA = nA; cB = nB; ++ui;
        if constexpr (ALIGN_EPI) { if (wr == 1) PG8_BAR; }
    }
    PG8_WAIT_V(0);
    if constexpr (!ALIGN_EPI) { if (wr == 0) PG8_BAR; }
    PG8_BAR;
#undef PG8_SA
#undef PG8_SB
#undef PG8_STAGE
#undef PG8_LDA
#undef PG8_LDB
#undef PG8_MMA
#undef PG8_WAIT_V
#undef PG8_WAIT_L
#undef PG8_BAR
#undef PG8_SCHED
}
}
constexpr int DM = 2048, MP = 8192, MS = 4096, MALL = 12288, MKV = 12800, FF = 8192, NMOD = 12288;
constexpr int NWAVES = 8, NTHR = 512, DEPTH = 4;
constexpr float EPS = 1e-6f;
constexpr size_t O_X = 0, O_CKV = 25165824, O_KPE = 33554432, O_HG = 34603008, O_NK = 51380224, O_NV = 68157440, O_END = 84934656;
enum { I_XP = 0, I_XS, I_CCKV, I_CKPE, I_SHG, I_CNK, I_CNV, I_C, I_CCTX, I_WMOD, I_BMOD, I_GMIX, I_GFFN, I_WQA, I_GQA, I_WQB, I_GQN, I_WKVA, I_GKVA, I_WKVB, I_GKN, I_WMO,
       I_WHQ, I_WHF, I_HLB, I_WHI, I_WHG, I_GHO, I_WHO, I_WNQKV, I_GNQ, I_GNK, I_RPB, I_WNO, I_WFF1, I_WFF2, N_IN };

constexpr size_t MiB = 1u << 20;
constexpr size_t WS_CTL = 0, CTL_ZERO_BYTES = 65536;
constexpr size_t WS_MODS = 2 * MiB;
constexpr size_t WS_LB = 3 * MiB;
constexpr size_t WS_SSK = 3 * MiB + 65536;
constexpr size_t WS_ROPE = 3 * MiB + 131072;
constexpr size_t WS_WFF1 = 4 * MiB, WS_WFF2 = 132 * MiB;
constexpr size_t WS_WMLA = 260 * MiB, WMLA_STRIDE = 24 * MiB;
constexpr size_t WMLA_QB = 6 * MiB, WMLA_KVB = 11 * MiB, WMLA_WO = 15 * MiB;
constexpr size_t WS_WHG = 308 * MiB, WHG_WO = 40 * MiB;
constexpr size_t WS_WNAT = 356 * MiB, WNAT_WO = 24 * MiB;
constexpr size_t WS_H = 388 * MiB;
constexpr size_t WS_U = 436 * MiB;
constexpr size_t WS_S = 628 * MiB;
constexpr size_t S_AO = 0;
constexpr size_t S_QAKV = 48 * MiB, S_QAN = 120 * MiB, S_CKVN = 138 * MiB, S_KPE = 151 * MiB, S_QRAW = 155 * MiB, S_KVRAW = 227 * MiB, S_QN = 327 * MiB, S_KF = 399 * MiB;
constexpr size_t S_HQ = 48 * MiB, S_HK = 96 * MiB, S_HV = 192 * MiB, S_HGS = 240 * MiB, S_OF = 288 * MiB;
constexpr size_t S_NQKV = 48 * MiB, S_NQN = 198 * MiB, S_NKN = 246 * MiB;
constexpr size_t WS_END = WS_S + 480 * MiB;
constexpr int CW_TMO = 0, CW_CODE = 1, CW_BAR = 4096;

constexpr int RING_BYTES = 131072;
constexpr int LDSCTL_OFF = RING_BYTES, MISC_OFF = LDSCTL_OFF + 320;
constexpr int LDS_BYTES = 147456;

#define GAS __attribute__((address_space(1)))
#define LAS __attribute__((address_space(3)))
typedef unsigned short bf16;
typedef unsigned v4u __attribute__((ext_vector_type(4)));
typedef unsigned v2u __attribute__((ext_vector_type(2)));
typedef float f32x4 __attribute__((ext_vector_type(4)));
typedef float f32x2 __attribute__((ext_vector_type(2)));
typedef short bf16x8 __attribute__((ext_vector_type(8)));
typedef GAS unsigned gu32;
#define RLX_AGENT __ATOMIC_RELAXED, __HIP_MEMORY_SCOPE_AGENT
#define LDS_WAIT() asm volatile("s_waitcnt lgkmcnt(0)" ::: "memory")
#define VM_WAIT() asm volatile("s_waitcnt vmcnt(0)" ::: "memory")
#ifndef DBG_SCALE
#define DBG_SCALE 1.0f
#endif
#define OPAQUE_S(x) asm volatile("" : "+s"(x))
#define PH_PTRS unsigned char* ws = a.ws; float* out = a.out; OPAQUE_S(ws); OPAQUE_S(out)
#define OPAQUE_V(x) asm volatile("" : "+v"(x))
__device__ __forceinline__ unsigned pk2(float lo, float hi) { unsigned r; asm("v_cvt_pk_bf16_f32 %0, %1, %2" : "=v"(r) : "v"(lo), "v"(hi)); return r; }
__device__ __forceinline__ float bf_lo(unsigned w) { return __uint_as_float(w << 16); }
__device__ __forceinline__ float bf_hi(unsigned w) { return __uint_as_float(w & 0xffff0000u); }
__device__ __forceinline__ float wave_sum(float v) {
#pragma unroll
    for (int o = 1; o < 64; o <<= 1) v += __shfl_xor(v, o);
    return v;
}
__device__ __forceinline__ float sum16(float v) {
#pragma unroll
    for (int o = 1; o < 16; o <<= 1) v += __shfl_xor(v, o);
    return v;
}

#define XB_TMO      128
#define XB_XCNT(j)  (256  + 64 * (j))
#define XB_XSUB(j)  (1280 + 64 * (j))
#define XB_XGEN(j)  (2304 + 64 * (j))
#define XB_TOP      3328
#define XB_TOPGEN   3392
#define XCD_BAR_WORDS 3456
#define XB_SPIN_CAP (1u << 18)
__device__ __forceinline__ unsigned xb_ld(unsigned* p)              { return __hip_atomic_load(p, __ATOMIC_RELAXED, __HIP_MEMORY_SCOPE_AGENT); }
__device__ __forceinline__ unsigned xb_add(unsigned* p, unsigned v) { return __hip_atomic_fetch_add(p, v, __ATOMIC_RELAXED, __HIP_MEMORY_SCOPE_AGENT); }
__device__ __forceinline__ unsigned xb_xcc_id() { return (unsigned)__builtin_amdgcn_s_getreg((3 << 11) | 20) & 0xFu; }
#define XB_SPIN(cond, bar) do { unsigned _sp = 0; while (cond) { __builtin_amdgcn_s_sleep(1); \
    if ((++_sp & 255u) == 0u) { if (xb_ld(&(bar)[XB_TMO])) break; if (_sp > XB_SPIN_CAP) { atomicAdd(&(bar)[XB_TMO], 1u); break; } } } } while (0)
struct XcdBarrier { unsigned* bar; unsigned x; volatile LAS unsigned* st; };
__device__ __forceinline__ XcdBarrier xcd_barrier_post(unsigned* bar, volatile LAS unsigned* st) {
    XcdBarrier b; b.bar = bar; b.x = xb_xcc_id(); b.st = st;
    if (threadIdx.x == 0) (void)xb_add(&bar[XB_XCNT(b.x)], 1u);
    return b;
}
__device__ __forceinline__ void xcd_barrier_complete(unsigned* bar, unsigned x, unsigned& nloc, unsigned& nx) {
    const unsigned G = gridDim.x * gridDim.y * gridDim.z;
    unsigned sum, cnt, mine, sp = 0u;
    for (;;) {
        sum = 0u; cnt = 0u; mine = 0u;
#pragma unroll
        for (unsigned j = 0; j < 16; ++j) { const unsigned c = xb_ld(&bar[XB_XCNT(j)]); sum += c; cnt += (c > 0u) ? 1u : 0u; mine = (j == x) ? c : mine; }
        if (sum == G) break;
        __builtin_amdgcn_s_sleep(1);
        if ((++sp & 255u) == 0u) { if (xb_ld(&bar[XB_TMO])) break; if (sp > XB_SPIN_CAP) { atomicAdd(&bar[XB_TMO], 1u); break; } }
    }
    nloc = mine > 0u ? mine : 1u; nx = cnt > 0u ? cnt : 1u;
}
__device__ __forceinline__ void xcd_barrier(const XcdBarrier& b) {
    asm volatile("s_waitcnt vmcnt(0)" ::: "memory");
    __syncthreads();
    if (threadIdx.x == 0) {
        unsigned* bar = b.bar;
        __builtin_amdgcn_s_waitcnt(0);
        unsigned nloc = b.st[0], nx = b.st[1];
        if (nloc == 0u) { xcd_barrier_complete(bar, b.x, nloc, nx); b.st[0] = nloc; b.st[1] = nx; }
        const unsigned old = xb_add(&bar[XB_XSUB(b.x)], 1u);
        const unsigned gen = old / nloc;
        if (old + 1u == (gen + 1u) * nloc) {
            __builtin_amdgcn_fence(__ATOMIC_RELEASE, "agent");
            asm volatile("s_waitcnt vmcnt(0)" ::: "memory");
            const unsigned og = xb_add(&bar[XB_TOP], 1u);
            const unsigned tg = og / nx;
            if (og + 1u == (tg + 1u) * nx) xb_add(&bar[XB_TOPGEN], 1u);
            else XB_SPIN(xb_ld(&bar[XB_TOPGEN]) == tg, bar);
            __builtin_amdgcn_fence(__ATOMIC_ACQUIRE, "agent");
            xb_add(&bar[XB_XGEN(b.x)], 1u);
            asm volatile("s_waitcnt vmcnt(0)" ::: "memory");
        } else {
            XB_SPIN(xb_ld(&bar[XB_XGEN(b.x)]) == gen, bar);
            __builtin_amdgcn_fence(__ATOMIC_ACQUIRE, "agent");
            asm volatile("s_waitcnt vmcnt(0)" ::: "memory");
        }
    }
    __syncthreads();
}

struct TJob { const float* src; bf16* dst; int K, N, row_off, start; };
constexpr int MAX_TJ = 32;
struct Args { const float* in[N_IN]; float* out; unsigned char* ws; TJob tj[MAX_TJ]; int ntj, nitems, ph_lo, ph_hi; };

__device__ __forceinline__ void p0_transpose_item(const float* W, int K, int N, bf16* WT, int row_off, LAS float* scr, int item, int lane) {
    const int nblk = N / 32, kb = item / nblk, nb = item % nblk, k0 = 64 * kb, n0 = 32 * nb;
#pragma unroll 8
    for (int i = 0; i < 32; ++i) { const int kk = 2 * i + (lane >> 5); scr[kk * 33 + (lane & 31)] = W[(size_t)(k0 + kk) * N + n0 + (lane & 31)]; }
    LDS_WAIT(); asm volatile("" ::: "memory");
    const int c = lane & 7;
#pragma unroll
    for (int j = 0; j < 4; ++j) { const int n = (lane >> 3) + 8 * j; const LAS float* s = scr + (8 * c) * 33 + n;
        v4u o; o.x = pk2(s[0 * 33], s[1 * 33]); o.y = pk2(s[2 * 33], s[3 * 33]); o.z = pk2(s[4 * 33], s[5 * 33]); o.w = pk2(s[6 * 33], s[7 * 33]);
        *(GAS v4u*)(WT + (size_t)(row_off + n0 + n) * K + k0 + 8 * c) = o; }
    LDS_WAIT(); asm volatile("" ::: "memory");
}

__device__ __forceinline__ float silu_f(float x) { return x / (1.f + __expf(-x)); }

__device__ __forceinline__ void p0_prologue(const Args& a, LAS unsigned char* lds, int tid, int lane, int wave, int vcu, int G) {
    OPAQUE_V(tid); OPAQUE_V(lane);
    float* mods = (float*)(a.ws + WS_MODS);
    if (vcu < 768) {
        LAS f32x4* S3 = (LAS f32x4*)lds;
        LAS float* RED = (LAS float*)(lds + 32768);
        const float* cc = a.in[I_C]; const float* cx = a.in[I_CCTX];
        for (int k = tid; k < DM; k += NTHR) S3[k] = (f32x4){silu_f(cx[k]), silu_f(cc[k]), silu_f(cc[DM + k]), 0.f};
        __syncthreads();
        for (int tl = vcu; tl < 768; tl += G) {
            const int l = tl / 192, n = (tl % 192) * 64 + lane;
            const float* Wp = a.in[I_WMOD] + ((size_t)l * DM + wave * 256) * NMOD + n;
            float a0 = 0.f, a1 = 0.f, a2 = 0.f;
#pragma unroll 16
            for (int k = 0; k < 256; ++k) { const float wv = Wp[(size_t)k * NMOD]; const f32x4 s = S3[wave * 256 + k]; a0 += s.x * wv; a1 += s.y * wv; a2 += s.z * wv; }
            RED[(wave * 3 + 0) * 64 + lane] = a0; RED[(wave * 3 + 1) * 64 + lane] = a1; RED[(wave * 3 + 2) * 64 + lane] = a2;
            __syncthreads();
            if (wave < 3) { float s = 0.f;
#pragma unroll
                for (int w = 0; w < 8; ++w) s += RED[(w * 3 + wave) * 64 + lane];
                mods[((size_t)l * 3 + wave) * NMOD + n] = s + a.in[I_BMOD][(size_t)l * NMOD + n]; }
            __syncthreads();
        }
    }
    { const int gt = vcu * NTHR + tid;
      if (gt < 2 * DM) { const int d = gt >> 11, c = gt & 2047; const float* hl = a.in[I_HLB] + (size_t)d * 4 * DM + c;
          const float x0 = hl[0], x1 = hl[DM], x2 = hl[2 * DM], x3 = hl[3 * DM]; const float m = fmaxf(fmaxf(x0, x1), fmaxf(x2, x3));
          const float e0 = __expf(x0 - m), e1 = __expf(x1 - m), e2 = __expf(x2 - m), e3 = __expf(x3 - m);
          ((float*)(a.ws + WS_LB))[gt] = e1 / (e0 + e1 + e2 + e3); } }
    __syncthreads();
    LAS float* scr = (LAS float*)(lds + wave * 16384);
    const int gw = vcu * NWAVES + wave, NGW = G * NWAVES;
    for (int it = gw; it < a.nitems; it += NGW) {
        int j = 0;
        while (j + 1 < a.ntj && it >= a.tj[j + 1].start) ++j;
        p0_transpose_item(a.tj[j].src, a.tj[j].K, a.tj[j].N, a.tj[j].dst, a.tj[j].row_off, scr, it - a.tj[j].start, lane);
    }
#if defined(DBG_ZERO_OUT)
    { const size_t gt = (size_t)vcu * NTHR + tid, NT = (size_t)G * NTHR;
      for (size_t i = gt; i < (O_END - O_CKV) / 4; i += NT) *(GAS f32x4*)(a.out + O_CKV + 4 * i) = (f32x4){0.f, 0.f, 0.f, 0.f}; }
#endif
    { const int gt = vcu * NTHR + tid, NT = G * NTHR;
      for (int i = gt; i < 2 * 192 * DM / 8; i += NT) { const int j = i / (192 * DM / 8), r = i % (192 * DM / 8);
          *(GAS v4u*)(a.ws + WS_WMLA + j * WMLA_STRIDE + (size_t)1344 * DM * 2 + (size_t)r * 16) = (v4u){0u, 0u, 0u, 0u}; } }
}

__device__ __forceinline__ int cond_of_row(int row) { return row < MP ? 0 : 1 + ((row - MP) >> 11); }

__device__ __forceinline__ void norm_phase(const Args& a, int l, bool ffn, int lane, int gw, int NGW) {
    OPAQUE_V(lane); PH_PTRS; OPAQUE_S(gw); OPAQUE_S(NGW);
    const float* g = a.in[ffn ? I_GFFN : I_GMIX] + (size_t)l * DM;
    const float* mods = (const float*)(ws + WS_MODS) + (size_t)l * 3 * NMOD + (ffn ? 3 * DM : 0);
    bf16* H = (bf16*)(ws + WS_H);
    const bool first = (l == 0 && !ffn);
    for (int row = gw; row < MALL; row += NGW) {
        const float* xr = first ? (row < MP ? a.in[I_XP] + (size_t)row * DM : a.in[I_XS] + (size_t)(row - MP) * DM) : out + O_X + (size_t)row * DM;
        const float* md = mods + (size_t)cond_of_row(row) * NMOD;
        f32x4 v[8]; float ss = 0.f;
#pragma unroll
        for (int j = 0; j < 8; ++j) { v[j] = *(const GAS f32x4*)(xr + 4 * (lane + 64 * j)); ss += (v[j].x * v[j].x + v[j].y * v[j].y) + (v[j].z * v[j].z + v[j].w * v[j].w); }
        const float rs = rsqrtf(wave_sum(ss) * (1.f / DM) + EPS);
#pragma unroll
        for (int j = 0; j < 8; ++j) { const int c = 4 * (lane + 64 * j);
            const f32x4 gg = *(const GAS f32x4*)(g + c), sh = *(const GAS f32x4*)(md + c), sc = *(const GAS f32x4*)(md + DM + c);
            const f32x4 y = v[j] * rs * gg * (sc + 1.f) + sh;
            *(GAS v2u*)(H + (size_t)row * DM + c) = (v2u){pk2(y.x, y.y), pk2(y.z, y.w)};
            if (first) *(GAS f32x4*)(out + O_X + (size_t)row * DM + c) = v[j]; }
    }
}

__device__ __forceinline__ void mla_thin_a(const Args& a, int j, int lane, int gw, int NGW) {
    OPAQUE_V(lane); PH_PTRS; OPAQUE_S(gw); OPAQUE_S(NGW);
    const float* QAKV = (const float*)(ws + WS_S + S_QAKV);
    bf16* QAN = (bf16*)(ws + WS_S + S_QAN); bf16* CKVN = (bf16*)(ws + WS_S + S_CKVN); float* KPE = (float*)(ws + WS_S + S_KPE); float* SSK = (float*)(ws + WS_SSK);
    const float* gqa = a.in[I_GQA] + (size_t)j * 768; const float* gkva = a.in[I_GKVA] + (size_t)j * 512;
    for (int row = gw; row < MKV; row += NGW) {
        if (row < MALL) {
            const float* r = QAKV + (size_t)row * 1536;
            { f32x4 v[3]; float ss = 0.f;
#pragma unroll
              for (int i = 0; i < 3; ++i) { v[i] = *(const GAS f32x4*)(r + 4 * (lane + 64 * i)); ss += (v[i].x * v[i].x + v[i].y * v[i].y) + (v[i].z * v[i].z + v[i].w * v[i].w); }
              const float rs = rsqrtf(wave_sum(ss) * (1.f / 768.f) + EPS);
#pragma unroll
              for (int i = 0; i < 3; ++i) { const int c = 4 * (lane + 64 * i); const f32x4 y = v[i] * rs * *(const GAS f32x4*)(gqa + c);
                  *(GAS v2u*)(QAN + (size_t)row * 768 + c) = (v2u){pk2(y.x, y.y), pk2(y.z, y.w)}; } }
            { f32x4 v[2]; float ss = 0.f;
#pragma unroll
              for (int i = 0; i < 2; ++i) { v[i] = *(const GAS f32x4*)(r + 768 + 4 * (lane + 64 * i)); ss += (v[i].x * v[i].x + v[i].y * v[i].y) + (v[i].z * v[i].z + v[i].w * v[i].w); }
              const float rs = rsqrtf(wave_sum(ss) * (1.f / 512.f) + EPS);
#pragma unroll
              for (int i = 0; i < 2; ++i) { const int c = 4 * (lane + 64 * i); const f32x4 y = v[i] * rs * *(const GAS f32x4*)(gkva + c);
                  *(GAS v2u*)(CKVN + (size_t)row * 512 + c) = (v2u){pk2(y.x, y.y), pk2(y.z, y.w)};
                  if (row < MP) *(GAS f32x4*)(out + O_CKV + ((size_t)((row >> 8) * 2 + j) * 256 + (row & 255)) * 512 + c) = y * DBG_SCALE; } }
            { const float kp = r[1280 + lane]; KPE[(size_t)row * 64 + lane] = kp;
              if (row < MP) out[O_KPE + ((size_t)((row >> 8) * 2 + j) * 256 + (row & 255)) * 64 + lane] = kp * DBG_SCALE;
              const float s = wave_sum(kp * kp); if (lane == 0) SSK[row] = s; }
        } else {
            const int cr = row - MALL, b = cr >> 8, t = cr & 255; const size_t src = (size_t)((b * 2 + j) * 256 + t);
            const float* ck = a.in[I_CCKV] + src * 512;
#pragma unroll
            for (int i = 0; i < 2; ++i) { const int c = 4 * (lane + 64 * i); const f32x4 y = *(const GAS f32x4*)(ck + c);
                *(GAS v2u*)(CKVN + (size_t)row * 512 + c) = (v2u){pk2(y.x, y.y), pk2(y.z, y.w)}; }
            const float kp = a.in[I_CKPE][src * 64 + lane]; KPE[(size_t)row * 64 + lane] = kp;
            const float s = wave_sum(kp * kp); if (lane == 0) SSK[row] = s;
        }
    }
}
namespace pg8 {
struct EpiF32 {
    static constexpr bool PERM = false;
    float* C; int ldc;
    __device__ __forceinline__ void operator()(const f32x4 (&acc)[2][2][4][2], const Unit& u, int wr, int wc, int fr, int fq) const {
        const int row0 = u.pm * BM + wr * 64 + fr, col0 = u.pn * BM + wc * 32 + 4 * fq;
#pragma unroll
        for (int ai = 0; ai < 2; ++ai)
#pragma unroll
            for (int m = 0; m < 4; ++m) { float* rowp = C + (size_t)(row0 + ai * HALF + m * 16) * ldc + col0;
#pragma unroll
                for (int bj = 0; bj < 2; ++bj)
#pragma unroll
                    for (int n = 0; n < 2; ++n) *(f32x4*)(rowp + bj * HALF + n * 16) = acc[ai][bj][m][n]; }
    }
};
template <int ACT  > struct EpiBf16 {
    static constexpr bool PERM = true;
    bf16_t* O; int ldc;
    __device__ __forceinline__ void operator()(const f32x4 (&acc)[2][2][4][2], const Unit& u, int wr, int wc, int fr, int fq) const {
        const int row0 = u.pm * BM + wr * 64 + fr, col0 = u.pn * BM + wc * 32 + 8 * fq;
#pragma unroll
        for (int ai = 0; ai < 2; ++ai)
#pragma unroll
            for (int m = 0; m < 4; ++m) { bf16_t* rowp = O + (size_t)(row0 + ai * HALF + m * 16) * ldc + col0;
#pragma unroll
                for (int bj = 0; bj < 2; ++bj) { f32x4 v0 = acc[ai][bj][m][0], v1 = acc[ai][bj][m][1];
                    if (ACT == 1) {
#pragma unroll
                        for (int e = 0; e < 4; ++e) { const float x0 = fmaxf(v0[e], 0.f), x1 = fmaxf(v1[e], 0.f); v0[e] = x0 * x0; v1[e] = x1 * x1; } }
                    u32x4 w; w.x = cvt_pk_bf16(v0[0], v0[1]); w.y = cvt_pk_bf16(v0[2], v0[3]); w.z = cvt_pk_bf16(v1[0], v1[1]); w.w = cvt_pk_bf16(v1[2], v1[3]);
                    *(u32x4*)(rowp + bj * HALF) = w; } }
    }
};
template <bool ATOMIC> struct EpiRes {
    static constexpr bool PERM = false;
    float* X; const float* gate;
    __device__ __forceinline__ void operator()(const f32x4 (&acc)[2][2][4][2], const Unit& u, int wr, int wc, int fr, int fq) const {
        const int rb = u.pm * BM, row0 = rb + wr * 64 + fr, col0 = u.pn * BM + wc * 32 + 4 * fq;
        const int cond = rb < 8192 ? 0 : 1 + ((rb - 8192) >> 11);
        const float* gp = gate + (size_t)cond * 12288 + col0;
        f32x4 gv[2][2];
#pragma unroll
        for (int bj = 0; bj < 2; ++bj)
#pragma unroll
            for (int n = 0; n < 2; ++n) gv[bj][n] = *(const f32x4*)(gp + bj * HALF + n * 16);
#pragma unroll
        for (int ai = 0; ai < 2; ++ai)
#pragma unroll
            for (int m = 0; m < 4; ++m) { float* rowp = X + (size_t)(row0 + ai * HALF + m * 16) * 2048 + col0;
#pragma unroll
                for (int bj = 0; bj < 2; ++bj)
#pragma unroll
                    for (int n = 0; n < 2; ++n) { float* p = rowp + bj * HALF + n * 16; const f32x4 d = gv[bj][n] * acc[ai][bj][m][n];
                        if (ATOMIC) {
#pragma unroll
                            for (int e = 0; e < 4; ++e) __hip_atomic_fetch_add(p + e, d[e], __ATOMIC_RELAXED, __HIP_MEMORY_SCOPE_AGENT);
                        } else { *(f32x4*)p = *(const f32x4*)p + d; } }
                asm volatile("" ::: "memory"); }
    }
};
}
namespace att {
using bf16x8 = __attribute__((ext_vector_type(8))) short;
using s16x4  = __attribute__((ext_vector_type(4))) short;
using f32x16 = __attribute__((ext_vector_type(16))) float;
using u32x4  = __attribute__((ext_vector_type(4))) unsigned;
constexpr int NW = 8, QBLK = 32, KVBLK = 64, DV = 128;
constexpr float THR = 8.f;
constexpr int SHM_V = KVBLK * DV * 2;
constexpr int RPB_OFF = 2 * SHM_V + 2 * KVBLK * 192 * 2 + 2048;
#define ATT_SBAR() __builtin_amdgcn_sched_barrier(0)
__device__ __forceinline__ int crow(int r, int hi) { return (r & 3) + 8 * (r >> 2) + 4 * hi; }
__device__ __forceinline__ unsigned cvtpk(float lo, float hi) { unsigned r; asm volatile("v_cvt_pk_bf16_f32 %0, %1, %2" : "=v"(r) : "v"(lo), "v"(hi)); return r; }
__device__ __forceinline__ int v_st(int k, int c) { const int kk = (k & ~0xC) | ((k & 4) << 1) | ((k & 8) >> 1); return ((kk >> 3) * 4 + (c >> 5)) * 512 + ((kk & 7) * 32 + (c & 31)) * 2; }
__device__ __forceinline__ int v_rd_base(int lane) { return ((lane & 3) << 3) | (((lane >> 2) & 3) << 6) | (((lane >> 4) & 1) << 5) | (((lane >> 5) & 1) << 8); }
constexpr int v_rd_off(int d0, int ks, int half) { return d0 * 512 + ks * 4096 + half * 2048; }
template <int OFF> __device__ __forceinline__ s16x4 tr_read(int vb) { s16x4 r; asm volatile("ds_read_b64_tr_b16 %0, %1 offset:%2" : "=&v"(r) : "v"(vb), "i"(OFF) : "memory"); return r; }
template <int D0> __device__ __forceinline__ void pv_one(f32x16& od, int vb, bf16x8 pa0, bf16x8 pa1, bf16x8 pa2, bf16x8 pa3) {
  const s16x4 l0 = tr_read<v_rd_off(D0, 0, 0)>(vb), h0 = tr_read<v_rd_off(D0, 0, 1)>(vb), l1 = tr_read<v_rd_off(D0, 1, 0)>(vb), h1 = tr_read<v_rd_off(D0, 1, 1)>(vb);
  const s16x4 l2 = tr_read<v_rd_off(D0, 2, 0)>(vb), h2 = tr_read<v_rd_off(D0, 2, 1)>(vb), l3 = tr_read<v_rd_off(D0, 3, 0)>(vb), h3 = tr_read<v_rd_off(D0, 3, 1)>(vb);
  asm volatile("s_waitcnt lgkmcnt(0)" ::: "memory"); ATT_SBAR();
#define ATT_PK(L, H) (bf16x8){L[0], L[1], L[2], L[3], H[0], H[1], H[2], H[3]}
  od = __builtin_amdgcn_mfma_f32_32x32x16_bf16(pa0, ATT_PK(l0, h0), od, 0, 0, 0);
  od = __builtin_amdgcn_mfma_f32_32x32x16_bf16(pa1, ATT_PK(l1, h1), od, 0, 0, 0);
  od = __builtin_amdgcn_mfma_f32_32x32x16_bf16(pa2, ATT_PK(l2, h2), od, 0, 0, 0);
  od = __builtin_amdgcn_mfma_f32_32x32x16_bf16(pa3, ATT_PK(l3, h3), od, 0, 0, 0);
#undef ATT_PK
}
__device__ __forceinline__ void pv_d0(f32x16* o, int vb, bf16x8 pa0, bf16x8 pa1, bf16x8 pa2, bf16x8 pa3) {
  pv_one<0>(o[0], vb, pa0, pa1, pa2, pa3); pv_one<1>(o[1], vb, pa0, pa1, pa2, pa3); pv_one<2>(o[2], vb, pa0, pa1, pa2, pa3); pv_one<3>(o[3], vb, pa0, pa1, pa2, pa3);
}
struct KvSrc { int row0, n0, row1, n1; __device__ __forceinline__ int row(int t) const { const int u = t - n0; return t < n0 ? row0 + 64 * t : row1 + 64 * (u < n1 ? u : n1 - 1); } };
struct NatMask { int rlo, qrow, qcol; const LAS float* rpb; };

template <int DQK, int MODE, int ldq, int ldk, int ldv, int ldo>
__device__ __forceinline__ void attn_unit(const bf16* __restrict__ Qb, const bf16* __restrict__ Kh, const bf16* __restrict__ Vh,
                                          bf16* __restrict__ Ob, const KvSrc src, int NT, const NatMask nm, LAS char* lds, int tid) {
  constexpr float SCALE = DQK == 128 ? 0.088388347648318440f : 0.072168783648703220f;
  constexpr float C = SCALE * 1.4426950408889634f;
  constexpr int KROW = DQK * 2, SHM_K = KVBLK * KROW, NKC = DQK / 8, KCH = KVBLK * NKC / 512, ND0 = DQK / 16;
  const int wid = tid >> 6, lane = tid & 63, r32 = lane & 31, hi = lane >> 5;
  LAS char* V_lds = lds; LAS char* K_lds = lds + 2 * SHM_V;
  LAS float* ws = (LAS float*)(lds + 2 * SHM_V + 2 * SHM_K) + wid * 64; LAS float* li_l = ws; LAS float* al_l = ws + 32;
  float m_reg = -1e30f, l_reg = 0; f32x16 o[4] = {}; bf16x8 qr[ND0];
  { const bf16* Qw = Qb + (size_t)(wid * QBLK + r32) * ldq + hi * 8;
#pragma unroll
    for (int d0 = 0; d0 < ND0; ++d0) qr[d0] = *reinterpret_cast<const bf16x8*>(Qw + d0 * 16); }
  const int sr = tid >> 4, sc = (tid & 15) * 8, vst0 = v_st(sr, sc), vst1 = v_st(32 + sr, sc);
  unsigned koff_[KCH], kst_[KCH]; const unsigned voff0 = (unsigned)(sr * ldv + sc);
#pragma unroll
  for (int i = 0; i < KCH; ++i) { const int c = tid + 512 * i, kr = c / NKC, kc = c % NKC; koff_[i] = (unsigned)(kr * ldk + kc * 8); kst_[i] = (unsigned)(kr * KROW + ((kc * 16) ^ ((kr & 7) << 4))); }
  const int vb0 = (int)(uintptr_t)V_lds + v_rd_base(lane);
  bf16x8 svs0, svs1, sks[KCH];
#define ATT_SLOAD(t) do { const int _r = __builtin_amdgcn_readfirstlane(src.row(t)); const bf16* _vt = Vh + (size_t)_r * ldv; const bf16* _kt = Kh + (size_t)_r * ldk; \
    svs0 = *reinterpret_cast<const bf16x8*>(_vt + voff0); svs1 = *reinterpret_cast<const bf16x8*>(_vt + 32 * ldv + voff0); \
    _Pragma("unroll") for (int _i = 0; _i < KCH; ++_i) sks[_i] = *reinterpret_cast<const bf16x8*>(_kt + koff_[_i]); } while (0)
#define ATT_SWRITE(b) do { *(LAS bf16x8*)(V_lds + (b) * SHM_V + vst0) = svs0; *(LAS bf16x8*)(V_lds + (b) * SHM_V + vst1) = svs1; \
    _Pragma("unroll") for (int _i = 0; _i < KCH; ++_i) *(LAS bf16x8*)(K_lds + (b) * SHM_K + kst_[_i]) = sks[_i]; } while (0)
#define ATT_RESC(a) do { if (__any((a) < 1.f)) { if (hi == 0) al_l[r32] = (a); asm volatile("s_waitcnt lgkmcnt(0)" ::: "memory"); \
    _Pragma("unroll") for (int d = 0; d < 4; ++d) _Pragma("unroll") for (int r = 0; r < 16; ++r) o[d][r] *= al_l[crow(r, hi)]; } } while (0)
  auto qkt = [&](f32x16& p0, f32x16& p1, int b, int t) {
    const LAS char* Ks = K_lds + b * SHM_K;
    p0 = f32x16{}; p1 = f32x16{};
#pragma unroll
    for (int d0 = 0; d0 < ND0; ++d0) { const int cb = (d0 * 16 + hi * 8) * 2;
      const bf16x8 b0 = *reinterpret_cast<const LAS bf16x8*>(Ks + r32 * KROW + (cb ^ ((r32 & 7) << 4)));
      const bf16x8 b1 = *reinterpret_cast<const LAS bf16x8*>(Ks + (32 + r32) * KROW + (cb ^ ((r32 & 7) << 4)));
      p0 = __builtin_amdgcn_mfma_f32_32x32x16_bf16(b0, qr[d0], p0, 0, 0, 0);
      p1 = __builtin_amdgcn_mfma_f32_32x32x16_bf16(b1, qr[d0], p1, 0, 0, 0); }
    if constexpr (MODE == 1) {
      const int i = t - src.n0;
      if (i >= 0) {
        const int kr = nm.rlo + i, r0q = min(max(nm.qrow - 4, 0), 24), c0q = min(max(nm.qcol - 8, 0), 48);
        const bool rowok = (i < src.n1) && (kr >= r0q) && (kr < r0q + 8);
        const int rowoff = (kr - nm.qrow + 7) * 31 + 15 - nm.qcol;
#pragma unroll
        for (int r = 0; r < 16; ++r) {
          const int kc0 = crow(r, hi), kc1 = kc0 + 32;
          const bool ok0 = rowok && ((unsigned)(kc0 - c0q) < 16u), ok1 = rowok && ((unsigned)(kc1 - c0q) < 16u);
          const float b0 = nm.rpb[ok0 ? rowoff + kc0 : 0], b1 = nm.rpb[ok1 ? rowoff + kc1 : 0];
          p0[r] = ok0 ? p0[r] + b0 : -1e30f; p1[r] = ok1 ? p1[r] + b1 : -1e30f; }
      }
    }
  };
  auto partialSM = [&](f32x16& p0, f32x16& p1, float& mn, float& alpha) {
    float pmax = p0[0];
#pragma unroll
    for (int r = 1; r < 16; ++r) pmax = fmaxf(pmax, p0[r]);
#pragma unroll
    for (int r = 0; r < 16; ++r) pmax = fmaxf(pmax, p1[r]);
    { auto rr = __builtin_amdgcn_permlane32_swap(__float_as_uint(pmax), __float_as_uint(pmax), false, false); pmax = fmaxf(__uint_as_float(rr[0]), __uint_as_float(rr[1])); }
    if (__builtin_expect(__all(pmax - m_reg <= THR / SCALE), 1)) { mn = m_reg; alpha = 1.f; }
    else { mn = fmaxf(m_reg, pmax); alpha = __builtin_amdgcn_exp2f((m_reg - mn) * C); m_reg = mn; }
    const float mnC = -mn * C;
#pragma unroll
    for (int r = 0; r < 16; ++r) p0[r] = fmaf(p0[r], C, mnC);
#pragma unroll
    for (int r = 0; r < 16; ++r) p1[r] = fmaf(p1[r], C, mnC);
#pragma unroll
    for (int r = 0; r < 16; ++r) p0[r] = __builtin_amdgcn_exp2f(p0[r]);
  };
  auto finishSM = [&](f32x16& p0, f32x16& p1, float alpha, bf16x8& pa0, bf16x8& pa1, bf16x8& pa2, bf16x8& pa3) {
#pragma unroll
    for (int r = 0; r < 16; ++r) p1[r] = __builtin_amdgcn_exp2f(p1[r]);
    float ps = 0;
#pragma unroll
    for (int r = 0; r < 16; ++r) ps += p0[r];
#pragma unroll
    for (int r = 0; r < 16; ++r) ps += p1[r];
    { auto rr = __builtin_amdgcn_permlane32_swap(__float_as_uint(ps), __float_as_uint(ps), false, false); ps = __uint_as_float(rr[0]) + __uint_as_float(rr[1]); }
    l_reg = l_reg * alpha + ps;
#define ATT_PK4(P, BASE, OUT) do { unsigned a0 = cvtpk(P[BASE + 0], P[BASE + 1]), a1 = cvtpk(P[BASE + 2], P[BASE + 3]); \
    unsigned b0 = cvtpk(P[BASE + 4], P[BASE + 5]), b1 = cvtpk(P[BASE + 6], P[BASE + 7]); \
    auto r0 = __builtin_amdgcn_permlane32_swap(a0, b0, false, false); auto r1 = __builtin_amdgcn_permlane32_swap(a1, b1, false, false); \
    u32x4 w = {r0[0], r1[0], r0[1], r1[1]}; OUT = *reinterpret_cast<bf16x8*>(&w); } while (0)
    ATT_PK4(p0, 0, pa0); ATT_PK4(p0, 8, pa1); ATT_PK4(p1, 0, pa2); ATT_PK4(p1, 8, pa3);
#undef ATT_PK4
  };
  f32x16 p0, p1; float mn, al; bf16x8 pa0, pa1, pa2, pa3;
  ATT_SLOAD(0); asm volatile("s_waitcnt vmcnt(0)" ::: "memory"); ATT_SWRITE(0); if (NT > 1) ATT_SLOAD(1); __syncthreads();
  for (int t = 0; t < NT; ++t) {
    const int b = t & 1;
    ATT_SBAR(); qkt(p0, p1, b, t); ATT_SBAR();
    if (t + 1 < NT) { asm volatile("s_waitcnt vmcnt(0)" ::: "memory"); ATT_SWRITE(b ^ 1); if (t + 2 < NT) ATT_SLOAD(t + 2); }
    ATT_SBAR();
    partialSM(p0, p1, mn, al); ATT_RESC(al);
    finishSM(p0, p1, al, pa0, pa1, pa2, pa3); ATT_SBAR();
    pv_d0(o, vb0 + b * SHM_V, pa0, pa1, pa2, pa3);
    __syncthreads();
  }
  if (hi == 0) li_l[r32] = l_reg; asm volatile("s_waitcnt lgkmcnt(0)" ::: "memory");
  int hi_o = hi; asm volatile("" : "+v"(hi_o));
  bf16* Ow = Ob + (size_t)(wid * QBLK + 4 * hi_o) * ldo;
#pragma unroll
  for (int r = 0; r < 16; ++r) { const int orow = crow(r, 0); const float rl = __builtin_amdgcn_rcpf(li_l[orow + 4 * hi_o]);
#pragma unroll
    for (int d0 = 0; d0 < 4; ++d0) { const float v = o[d0][r] * rl; Ow[(size_t)orow * ldo + d0 * 32 + r32] = (bf16)(cvtpk(v, v) & 0xffffu); } }
#undef ATT_SLOAD
#undef ATT_SWRITE
#undef ATT_RESC
}
}
__device__ __forceinline__ void rope_table(const Args& a, int tid, int vcu, int G) {
    f32x2* RT = (f32x2*)(a.ws + WS_ROPE);
    for (int e = vcu * NTHR + tid; e < 2048 * 32; e += G * NTHR) { const int t = e >> 5, i = e & 31;
        const float inv = exp2f(-(float)(i & 15) * (13.287712379549449f / 16.f));
        const float ang = (float)(i < 16 ? (t >> 6) : (t & 63)) * inv; float s, c; sincosf(ang, &s, &c); RT[e] = (f32x2){c, s}; }
}
__device__ __forceinline__ void mla_thin_b(const Args& a, int j, int lane, int gw, int NGW) {
    OPAQUE_V(lane); PH_PTRS; OPAQUE_S(gw); OPAQUE_S(NGW);
    const bf16* QRAW = (const bf16*)(ws + WS_S + S_QRAW); bf16* QN = (bf16*)(ws + WS_S + S_QN);
    const bf16* KVRAW = (const bf16*)(ws + WS_S + S_KVRAW); bf16* KF = (bf16*)(ws + WS_S + S_KF);
    const float* KPE = (const float*)(ws + WS_S + S_KPE); const float* SSK = (const float*)(ws + WS_SSK);
    const f32x2* RT = (const f32x2*)(ws + WS_ROPE);
    const float* gqn = a.in[I_GQN] + (size_t)j * 192; const float* gkn = a.in[I_GKN] + (size_t)j * 192;
    const int grp = lane >> 4, s = lane & 15;
    float gq[12], gk[12];
#pragma unroll
    for (int e = 0; e < 8; ++e) { gq[e] = gqn[8 * s + e]; gk[e] = gkn[8 * s + e]; }
    gq[8] = gqn[128 + 2 * s]; gq[9] = gqn[129 + 2 * s]; gq[10] = gqn[160 + 2 * s]; gq[11] = gqn[161 + 2 * s];
    gk[8] = gkn[128 + 2 * s]; gk[9] = gkn[129 + 2 * s]; gk[10] = gkn[160 + 2 * s]; gk[11] = gkn[161 + 2 * s];
    const int NQI = MALL * 4, NKI = MKV * 4;
    for (int it = gw; it < NQI + NKI; it += NGW) {
        const bool isq = it < NQI; const int r4 = isq ? it : it - NQI; const int row = r4 >> 2, h = (r4 & 3) * 4 + grp;
        float x[12];
        if (isq) {
            const bf16* p = QRAW + (size_t)row * 3072 + h * 192;
            const v4u w = *(const GAS v4u*)(p + 8 * s); const unsigned w1 = *(const GAS unsigned*)(p + 128 + 2 * s), w2 = *(const GAS unsigned*)(p + 160 + 2 * s);
            x[0] = bf_lo(w.x); x[1] = bf_hi(w.x); x[2] = bf_lo(w.y); x[3] = bf_hi(w.y); x[4] = bf_lo(w.z); x[5] = bf_hi(w.z); x[6] = bf_lo(w.w); x[7] = bf_hi(w.w);
            x[8] = bf_lo(w1); x[9] = bf_hi(w1); x[10] = bf_lo(w2); x[11] = bf_hi(w2);
        } else {
            const bf16* p = KVRAW + (size_t)row * 4096 + h * 256;
            const v4u w = *(const GAS v4u*)(p + 8 * s);
            x[0] = bf_lo(w.x); x[1] = bf_hi(w.x); x[2] = bf_lo(w.y); x[3] = bf_hi(w.y); x[4] = bf_lo(w.z); x[5] = bf_hi(w.z); x[6] = bf_lo(w.w); x[7] = bf_hi(w.w);
            const f32x2 k1 = *(const GAS f32x2*)(KPE + (size_t)row * 64 + 2 * s), k2 = *(const GAS f32x2*)(KPE + (size_t)row * 64 + 32 + 2 * s);
            x[8] = k1.x; x[9] = k1.y; x[10] = k2.x; x[11] = k2.y;
        }
        float ss = 0.f;
#pragma unroll
        for (int e = 0; e < 8; ++e) ss += x[e] * x[e];
        if (isq) { ss += x[8] * x[8] + x[9] * x[9] + x[10] * x[10] + x[11] * x[11]; ss = sum16(ss); }
        else { ss = sum16(ss) + SSK[row]; }
        const float rs = rsqrtf(ss * (1.f / 192.f) + EPS);
#pragma unroll
        for (int e = 0; e < 12; ++e) x[e] = x[e] * rs * (isq ? gq[e] : gk[e]);
        if (row >= MP && row < MALL) {
            const int t = (row - MP) & 2047; const f32x2 cs0 = RT[t * 32 + 2 * s], cs1 = RT[t * 32 + 2 * s + 1];
            const float a0 = x[8] * cs0.x - x[10] * cs0.y, b0 = x[8] * cs0.y + x[10] * cs0.x, a1 = x[9] * cs1.x - x[11] * cs1.y, b1 = x[9] * cs1.y + x[11] * cs1.x;
            x[8] = a0; x[9] = a1; x[10] = b0; x[11] = b1;
        }
        bf16* o = (isq ? QN : KF) + (size_t)row * 3072 + h * 192;
        *(GAS v4u*)(o + 8 * s) = (v4u){pk2(x[0], x[1]), pk2(x[2], x[3]), pk2(x[4], x[5]), pk2(x[6], x[7])};
        *(GAS unsigned*)(o + 128 + 2 * s) = pk2(x[8], x[9]); *(GAS unsigned*)(o + 160 + 2 * s) = pk2(x[10], x[11]);
    }
}
__device__ __forceinline__ void mla_attn_phase(const Args& a, LAS unsigned char* lds, int tid, int vcu, int G) {
    OPAQUE_V(tid); PH_PTRS; OPAQUE_S(vcu); OPAQUE_S(G);
    const bf16* QN = (const bf16*)(ws + WS_S + S_QN); const bf16* KF = (const bf16*)(ws + WS_S + S_KF); const bf16* KVRAW = (const bf16*)(ws + WS_S + S_KVRAW);
    bf16* AO = (bf16*)(ws + WS_S + S_AO);
    for (int u = vcu; u < 768; u += G) {
        int q0, h, NT; att::KvSrc src;
        if (u < 256) { const int b = u >> 7, qb = u & 7; h = (u >> 3) & 15; q0 = MP + b * 2048 + qb * 256; src = att::KvSrc{MP + b * 2048, 32, MALL + b * 256, 4}; NT = 36; }
        else { const int v = u - 256, b = v >> 4; h = v & 15; q0 = b * 256; src = att::KvSrc{b * 256, 4, 0, 1}; NT = 4; }
        att::attn_unit<192, 0, 3072, 3072, 4096, DM>(QN + (size_t)q0 * 3072 + h * 192, KF + h * 192, KVRAW + h * 256 + 128, AO + (size_t)q0 * DM + h * 128, src, NT, att::NatMask{0, 0, 0, nullptr}, (LAS char*)lds, tid);
    }
}
namespace pg8 {
struct EpiHg {
    static constexpr bool PERM = true;
    unsigned char* ws;
    __device__ __forceinline__ void operator()(const f32x4 (&acc)[2][2][4][2], const Unit& u, int wr, int wc, int fr, int fq) const {
        const int region = u.pn >> 3, row0 = u.pm * BM + wr * 64 + fr, col0 = (u.pn & 7) * BM + wc * 32 + 8 * fq;
        if (region == 1 || region == 2) {
            const int d = region - 1;
            f32x4 lbv[2][2];
#pragma unroll
            for (int bj = 0; bj < 2; ++bj)
#pragma unroll
                for (int n = 0; n < 2; ++n) lbv[bj][n] = *(const f32x4*)((const float*)(ws + WS_LB) + d * 2048 + col0 + bj * HALF + 4 * n);
            bf16_t* K = (bf16_t*)(ws + WS_S + S_HK) + (size_t)d * 12288 * 2048; float* Gd = (float*)(ws + WS_U) + (size_t)d * 12288 * 2048;
#pragma unroll
            for (int ai = 0; ai < 2; ++ai)
#pragma unroll
                for (int m = 0; m < 4; ++m) { const size_t ro = (size_t)(row0 + ai * HALF + m * 16) * 2048 + col0;
#pragma unroll
                    for (int bj = 0; bj < 2; ++bj) { f32x4 kk[2], gg[2];
#pragma unroll
                        for (int n = 0; n < 2; ++n)
#pragma unroll
                            for (int e = 0; e < 4; ++e) { const float z = acc[ai][bj][m][n][e]; const float sn = __builtin_amdgcn_rcpf(1.f + __expf(z));
                                const float k = (1.f - lbv[bj][n][e]) * sn; kk[n][e] = k; gg[n][e] = __log2f(1.f - k); }
                        u32x4 w; w.x = cvt_pk_bf16(kk[0][0], kk[0][1]); w.y = cvt_pk_bf16(kk[0][2], kk[0][3]); w.z = cvt_pk_bf16(kk[1][0], kk[1][1]); w.w = cvt_pk_bf16(kk[1][2], kk[1][3]);
                        *(u32x4*)(K + ro + bj * HALF) = w; *(f32x4*)(Gd + ro + bj * HALF) = gg[0]; *(f32x4*)(Gd + ro + bj * HALF + 4) = gg[1]; } }
        } else {
            bf16_t* O = (bf16_t*)(ws + WS_S + (region == 0 ? S_HQ : region == 3 ? S_HV : S_HGS)); const bool act = region != 3;
#pragma unroll
            for (int ai = 0; ai < 2; ++ai)
#pragma unroll
                for (int m = 0; m < 4; ++m) { bf16_t* rowp = O + (size_t)(row0 + ai * HALF + m * 16) * 2048 + col0;
#pragma unroll
                    for (int bj = 0; bj < 2; ++bj) { f32x4 v0 = acc[ai][bj][m][0], v1 = acc[ai][bj][m][1];
                        if (act) {
#pragma unroll
                            for (int e = 0; e < 4; ++e) { v0[e] = v0[e] * __builtin_amdgcn_rcpf(1.f + __expf(-v0[e])); v1[e] = v1[e] * __builtin_amdgcn_rcpf(1.f + __expf(-v1[e])); } }
                        u32x4 w; w.x = cvt_pk_bf16(v0[0], v0[1]); w.y = cvt_pk_bf16(v0[2], v0[3]); w.z = cvt_pk_bf16(v1[0], v1[1]); w.w = cvt_pk_bf16(v1[2], v1[3]);
                        *(u32x4*)(rowp + bj * HALF) = w; } }
        }
    }
};
}

namespace hg {
constexpr int PQ = 272, PK = 80;
constexpr int OFF_QS = 0, OFF_QM = 32 * PQ, OFF_KM = 2 * 32 * PQ, OFF_KE = 3 * 32 * PQ, OFF_VT = OFF_KE + 128 * PK, OFF_ATT = OFF_VT + 128 * PK, OFF_EL = OFF_ATT + 32 * PK, BUF = OFF_EL + 512;
constexpr int OFF_TOT = 2 * BUF;
static_assert(OFF_TOT + 2048 <= 131072, "scan LDS");
typedef short bf16x8 __attribute__((ext_vector_type(8)));
struct Chain { int rb, N, d, h; const float* S0; float* Sout; };

__device__ __forceinline__ void scan_chain(const Chain ch, const bf16* __restrict__ HQ, const bf16* __restrict__ HK, const float* __restrict__ HG, const bf16* __restrict__ HV,
                                           float* __restrict__ OD, LAS unsigned char* lds, int tid) {
    const int lane = tid & 63, w = tid >> 6, l15 = lane & 15, q4 = lane >> 4;
    const int k = tid & 127, seg = tid >> 7;
    const int vt = tid >> 4, v8 = (tid & 15) * 8;
    const int nc = ch.N >> 5, hc = ch.h * 128;
    f32x4 S[8];
    if (ch.S0) {
#pragma unroll
        for (int kt = 0; kt < 8; ++kt)
#pragma unroll
            for (int r = 0; r < 4; ++r) S[kt][r] = ch.S0[(size_t)(16 * kt + 4 * q4 + r) * 128 + 16 * w + l15];
    } else {
#pragma unroll
        for (int kt = 0; kt < 8; ++kt) S[kt] = (f32x4){0.f, 0.f, 0.f, 0.f};
    }
    float g_[8]; unsigned short q_[8], k_[8]; v4u v_;
#define HG_ROW(c, t) (ch.rb + (ch.d ? ch.N - 1 - (32 * (c) + (t)) : 32 * (c) + (t)))
#define HG_LOAD(c) do { _Pragma("unroll") for (int i = 0; i < 8; ++i) { const size_t o_ = (size_t)HG_ROW(c, 8 * seg + i) * 2048 + hc + k; g_[i] = HG[o_]; q_[i] = HQ[o_]; k_[i] = HK[o_]; } \
        v_ = *(const GAS v4u*)(HV + (size_t)HG_ROW(c, vt) * 2048 + hc + v8); } while (0)
    HG_LOAD(0);
    LAS float* TOT = (LAS float*)(lds + hg::OFF_TOT);
    for (int c = 0; c < nc; ++c) {
        LAS unsigned char* B = lds + (c & 1) * BUF;
        float cl[8]; float run = 0.f;
#pragma unroll
        for (int i = 0; i < 8; ++i) { run += g_[i]; cl[i] = run; }
        TOT[seg * 128 + k] = run;
        float qf[8], kf[8];
#pragma unroll
        for (int i = 0; i < 8; ++i) { qf[i] = __uint_as_float((unsigned)q_[i] << 16); kf[i] = __uint_as_float((unsigned)k_[i] << 16); }
        const v4u vv = v_;
        if (c + 1 < nc) HG_LOAD(c + 1);
        LDS_WAIT(); __builtin_amdgcn_s_barrier(); asm volatile("" ::: "memory");
        const float t0 = TOT[k], t1 = TOT[128 + k], t2 = TOT[256 + k], t3 = TOT[384 + k];
        const float off = seg == 0 ? 0.f : seg == 1 ? t0 : seg == 2 ? t0 + t1 : t0 + t1 + t2;
        const float cm = t0 + t1, last = (t0 + t1) + (t2 + t3);
        unsigned short ke[8];
#pragma unroll
        for (int i = 0; i < 8; ++i) { const float cu = off + cl[i]; const int t = 8 * seg + i;
            const float eq = __builtin_amdgcn_exp2f(cu), eqm = __builtin_amdgcn_exp2f(cu - cm), ekm = __builtin_amdgcn_exp2f(cm - cu), eke = __builtin_amdgcn_exp2f(last - cu);
            *(LAS unsigned short*)(B + OFF_QS + t * PQ + k * 2) = (unsigned short)(pk2(qf[i] * eq, 0.f) & 0xffffu);
            *(LAS unsigned short*)(B + OFF_QM + t * PQ + k * 2) = (unsigned short)(pk2(qf[i] * eqm, 0.f) & 0xffffu);
            *(LAS unsigned short*)(B + OFF_KM + t * PQ + k * 2) = (unsigned short)(pk2(kf[i] * ekm, 0.f) & 0xffffu);
            ke[i] = (unsigned short)(pk2(kf[i] * eke, 0.f) & 0xffffu); }
        *(LAS v4u*)(B + OFF_KE + k * PK + seg * 16) = (v4u){(unsigned)ke[0] | ((unsigned)ke[1] << 16), (unsigned)ke[2] | ((unsigned)ke[3] << 16), (unsigned)ke[4] | ((unsigned)ke[5] << 16), (unsigned)ke[6] | ((unsigned)ke[7] << 16)};
        if (seg == 0) *(LAS float*)(B + OFF_EL + k * 4) = __builtin_amdgcn_exp2f(last);
        { const unsigned vw[4] = {vv.x, vv.y, vv.z, vv.w};
#pragma unroll
          for (int e = 0; e < 8; ++e) *(LAS unsigned short*)(B + OFF_VT + (v8 + e) * PK + vt * 2) = (unsigned short)((vw[e >> 1] >> ((e & 1) * 16)) & 0xffffu); }
        LDS_WAIT(); __builtin_amdgcn_s_barrier(); asm volatile("" ::: "memory");
        if (w < 4) {
            const int tt = w >> 1, st = w & 1; f32x4 at = (f32x4){0.f, 0.f, 0.f, 0.f};
            if (!(tt == 0 && st == 1)) {
#pragma unroll
                for (int ks = 0; ks < 4; ++ks) {
                    const bf16x8 af = *(const LAS bf16x8*)(B + OFF_QM + (16 * tt + l15) * PQ + (32 * ks + 8 * q4) * 2);
                    const bf16x8 bfr = *(const LAS bf16x8*)(B + OFF_KM + (16 * st + l15) * PQ + (32 * ks + 8 * q4) * 2);
                    at = __builtin_amdgcn_mfma_f32_16x16x32_bf16(af, bfr, at, 0, 0, 0); }
            }
            const int s = 16 * st + l15;
#pragma unroll
            for (int r = 0; r < 4; ++r) { const int t = 16 * tt + 4 * q4 + r; const float val = (s <= t) ? at[r] : 0.f;
                *(LAS unsigned short*)(B + OFF_ATT + t * PK + s * 2) = (unsigned short)(pk2(val, 0.f) & 0xffffu); }
        }
        LDS_WAIT(); __builtin_amdgcn_s_barrier(); asm volatile("" ::: "memory");
        const bf16x8 bv = *(const LAS bf16x8*)(B + OFF_VT + (16 * w + l15) * PK + 16 * q4);
        f32x4 o2[2];
#pragma unroll
        for (int tt = 0; tt < 2; ++tt) { const bf16x8 aa = *(const LAS bf16x8*)(B + OFF_ATT + (16 * tt + l15) * PK + 16 * q4);
            o2[tt] = __builtin_amdgcn_mfma_f32_16x16x32_bf16(aa, bv, (f32x4){0.f, 0.f, 0.f, 0.f}, 0, 0, 0); }
#pragma unroll
        for (int ks = 0; ks < 4; ++ks) {
            const v4u sb = (v4u){pk2(S[2 * ks][0], S[2 * ks][1]), pk2(S[2 * ks][2], S[2 * ks][3]), pk2(S[2 * ks + 1][0], S[2 * ks + 1][1]), pk2(S[2 * ks + 1][2], S[2 * ks + 1][3])};
            const bf16x8 bs = __builtin_bit_cast(bf16x8, sb);
#pragma unroll
            for (int tt = 0; tt < 2; ++tt) {
                const v2u a0 = *(const LAS v2u*)(B + OFF_QS + (16 * tt + l15) * PQ + (32 * ks + 4 * q4) * 2), a1 = *(const LAS v2u*)(B + OFF_QS + (16 * tt + l15) * PQ + (32 * ks + 16 + 4 * q4) * 2);
                const bf16x8 aq = __builtin_bit_cast(bf16x8, ((v4u){a0.x, a0.y, a1.x, a1.y}));
                o2[tt] = __builtin_amdgcn_mfma_f32_16x16x32_bf16(aq, bs, o2[tt], 0, 0, 0); }
        }
#pragma unroll
        for (int kt = 0; kt < 8; ++kt) { const f32x4 el = *(const LAS f32x4*)(B + OFF_EL + (16 * kt + 4 * q4) * 4);
            const bf16x8 ak = *(const LAS bf16x8*)(B + OFF_KE + (16 * kt + l15) * PK + 16 * q4);
            S[kt] = __builtin_amdgcn_mfma_f32_16x16x32_bf16(ak, bv, S[kt] * el, 0, 0, 0); }
#pragma unroll
        for (int tt = 0; tt < 2; ++tt)
#pragma unroll
            for (int r = 0; r < 4; ++r) OD[(size_t)HG_ROW(c, 16 * tt + 4 * q4 + r) * 2048 + hc + 16 * w + l15] = o2[tt][r];
    }
    if (ch.Sout) {
#pragma unroll
        for (int kt = 0; kt < 8; ++kt)
#pragma unroll
            for (int r = 0; r < 4; ++r) ch.Sout[(size_t)(16 * kt + 4 * q4 + r) * 128 + 16 * w + l15] = S[kt][r] * DBG_SCALE;
    }
#undef HG_ROW
#undef HG_LOAD
}
}

__device__ __forceinline__ void hg_scan_phase(const Args& a, LAS unsigned char* lds, int tid, int vcu, int G) {
    OPAQUE_V(tid); PH_PTRS; OPAQUE_S(vcu); OPAQUE_S(G);
    const bf16* HQ = (const bf16*)(ws + WS_S + S_HQ); const bf16* HK = (const bf16*)(ws + WS_S + S_HK); const float* HGp = (const float*)(ws + WS_U);
    const bf16* HV = (const bf16*)(ws + WS_S + S_HV); float* OF = (float*)(ws + WS_S + S_OF);
    const int NS = G > 128 ? 64 : 0;
    if (vcu < NS) {
        const int b = vcu >> 5, d = (vcu >> 4) & 1, h = vcu & 15;
        hg::Chain ch{MP + b * 2048, 2048, d, h, a.in[I_SHG] + ((size_t)((b * 2 + d) * 16 + h)) * 16384, nullptr};
        hg::scan_chain(ch, HQ, HK + (size_t)d * MALL * DM, HGp + (size_t)d * MALL * DM, HV, OF + (size_t)d * MALL * DM, lds, tid);
    } else {
        for (int pc = vcu - NS; pc < 1024 + (NS ? 0 : 64); pc += G - NS) {
            if (pc >= 1024) { const int sc = pc - 1024, b = sc >> 5, d = (sc >> 4) & 1, h = sc & 15;
                hg::Chain ch{MP + b * 2048, 2048, d, h, a.in[I_SHG] + ((size_t)((b * 2 + d) * 16 + h)) * 16384, nullptr};
                hg::scan_chain(ch, HQ, HK + (size_t)d * MALL * DM, HGp + (size_t)d * MALL * DM, HV, OF + (size_t)d * MALL * DM, lds, tid);
            } else { const int b = pc >> 5, d = (pc >> 4) & 1, h = pc & 15;
                hg::Chain ch{b * 256, 256, d, h, nullptr, out + O_HG + ((size_t)((b * 2 + d) * 16 + h)) * 16384};
                hg::scan_chain(ch, HQ, HK + (size_t)d * MALL * DM, HGp + (size_t)d * MALL * DM, HV, OF + (size_t)d * MALL * DM, lds, tid); }
        }
    }
}

__device__ __forceinline__ void hg_thin_c(const Args& a, int lane, int gw, int NGW) {
    OPAQUE_V(lane); PH_PTRS; OPAQUE_S(gw); OPAQUE_S(NGW);
    const float* OF = (const float*)(ws + WS_S + S_OF); const bf16* HGS = (const bf16*)(ws + WS_S + S_HGS); bf16* AO = (bf16*)(ws + WS_S + S_AO);
    const int grp = lane >> 4, s = lane & 15;
    const f32x4 g0 = *(const GAS f32x4*)(a.in[I_GHO] + 8 * s), g1 = *(const GAS f32x4*)(a.in[I_GHO] + 8 * s + 4);
    for (int it = gw; it < MALL * 4; it += NGW) {
        const int row = it >> 2, h = (it & 3) * 4 + grp; const size_t o_ = (size_t)row * DM + h * 128 + 8 * s;
        const f32x4 a0 = *(const GAS f32x4*)(OF + o_) + *(const GAS f32x4*)(OF + (size_t)MALL * DM + o_), a1 = *(const GAS f32x4*)(OF + o_ + 4) + *(const GAS f32x4*)(OF + (size_t)MALL * DM + o_ + 4);
        float ss = (a0.x * a0.x + a0.y * a0.y) + (a0.z * a0.z + a0.w * a0.w) + (a1.x * a1.x + a1.y * a1.y) + (a1.z * a1.z + a1.w * a1.w);
        const float rs = rsqrtf(sum16(ss) * (1.f / 128.f) + EPS);
        const v4u gw_ = *(const GAS v4u*)(HGS + o_);
        const f32x4 y0 = a0 * rs * g0 * (f32x4){bf_lo(gw_.x), bf_hi(gw_.x), bf_lo(gw_.y), bf_hi(gw_.y)}, y1 = a1 * rs * g1 * (f32x4){bf_lo(gw_.z), bf_hi(gw_.z), bf_lo(gw_.w), bf_hi(gw_.w)};
        *(GAS v4u*)(AO + o_) = (v4u){pk2(y0.x, y0.y), pk2(y0.z, y0.w), pk2(y1.x, y1.y), pk2(y1.z, y1.w)};
    }
}
__device__ __forceinline__ void nat_thin_d(const Args& a, int lane, int gw, int NGW) {
    OPAQUE_V(lane); PH_PTRS; OPAQUE_S(gw); OPAQUE_S(NGW);
    bf16* QKV = (bf16*)(ws + WS_S + S_NQKV); bf16* QN = (bf16*)(ws + WS_S + S_NQN); bf16* KN = (bf16*)(ws + WS_S + S_NKN);
    const int grp = lane >> 4, s = lane & 15;
    const f32x4 gq0 = *(const GAS f32x4*)(a.in[I_GNQ] + 8 * s), gq1 = *(const GAS f32x4*)(a.in[I_GNQ] + 8 * s + 4), gk0 = *(const GAS f32x4*)(a.in[I_GNK] + 8 * s), gk1 = *(const GAS f32x4*)(a.in[I_GNK] + 8 * s + 4);
    for (int it = gw; it < MKV * 4; it += NGW) {
        const int row = it >> 2, h = (it & 3) * 4 + grp, c = h * 128 + 8 * s;
        if (row < MALL) {
            const v4u qw = *(const GAS v4u*)(QKV + (size_t)row * 6144 + c), kw = *(const GAS v4u*)(QKV + (size_t)row * 6144 + 2048 + c);
            f32x4 q0 = {bf_lo(qw.x), bf_hi(qw.x), bf_lo(qw.y), bf_hi(qw.y)}, q1 = {bf_lo(qw.z), bf_hi(qw.z), bf_lo(qw.w), bf_hi(qw.w)};
            f32x4 k0 = {bf_lo(kw.x), bf_hi(kw.x), bf_lo(kw.y), bf_hi(kw.y)}, k1 = {bf_lo(kw.z), bf_hi(kw.z), bf_lo(kw.w), bf_hi(kw.w)};
            const float sq = (q0.x * q0.x + q0.y * q0.y) + (q0.z * q0.z + q0.w * q0.w) + (q1.x * q1.x + q1.y * q1.y) + (q1.z * q1.z + q1.w * q1.w);
            const float sk = (k0.x * k0.x + k0.y * k0.y) + (k0.z * k0.z + k0.w * k0.w) + (k1.x * k1.x + k1.y * k1.y) + (k1.z * k1.z + k1.w * k1.w);
            const float rq = rsqrtf(sum16(sq) * (1.f / 128.f) + EPS), rk = rsqrtf(sum16(sk) * (1.f / 128.f) + EPS);
            q0 = q0 * rq * gq0; q1 = q1 * rq * gq1; k0 = k0 * rk * gk0; k1 = k1 * rk * gk1;
            *(GAS v4u*)(QN + (size_t)row * DM + c) = (v4u){pk2(q0.x, q0.y), pk2(q0.z, q0.w), pk2(q1.x, q1.y), pk2(q1.z, q1.w)};
            *(GAS v4u*)(KN + (size_t)row * DM + c) = (v4u){pk2(k0.x, k0.y), pk2(k0.z, k0.w), pk2(k1.x, k1.y), pk2(k1.z, k1.w)};
            if (row < MP) {
                *(GAS f32x4*)(out + O_NK + (size_t)row * DM + c) = k0 * DBG_SCALE; *(GAS f32x4*)(out + O_NK + (size_t)row * DM + c + 4) = k1 * DBG_SCALE;
                const v4u vw = *(const GAS v4u*)(QKV + (size_t)row * 6144 + 4096 + c);
                *(GAS f32x4*)(out + O_NV + (size_t)row * DM + c) = (f32x4){bf_lo(vw.x), bf_hi(vw.x), bf_lo(vw.y), bf_hi(vw.y)} * DBG_SCALE;
                *(GAS f32x4*)(out + O_NV + (size_t)row * DM + c + 4) = (f32x4){bf_lo(vw.z), bf_hi(vw.z), bf_lo(vw.w), bf_hi(vw.w)} * DBG_SCALE;
            }
        } else {
            const size_t so = (size_t)(row - MALL) * DM + c;
            const f32x4 k0 = *(const GAS f32x4*)(a.in[I_CNK] + so), k1 = *(const GAS f32x4*)(a.in[I_CNK] + so + 4), v0 = *(const GAS f32x4*)(a.in[I_CNV] + so), v1 = *(const GAS f32x4*)(a.in[I_CNV] + so + 4);
            *(GAS v4u*)(KN + (size_t)row * DM + c) = (v4u){pk2(k0.x, k0.y), pk2(k0.z, k0.w), pk2(k1.x, k1.y), pk2(k1.z, k1.w)};
            *(GAS v4u*)(QKV + (size_t)row * 6144 + 4096 + c) = (v4u){pk2(v0.x, v0.y), pk2(v0.z, v0.w), pk2(v1.x, v1.y), pk2(v1.z, v1.w)};
        }
    }
}
__device__ __forceinline__ void nat_attn_phase(const Args& a, LAS unsigned char* lds, int tid, int vcu, int G) {
    OPAQUE_V(tid); PH_PTRS; OPAQUE_S(vcu); OPAQUE_S(G);
    const bf16* QKV = (const bf16*)(ws + WS_S + S_NQKV); const bf16* QN = (const bf16*)(ws + WS_S + S_NQN); const bf16* KN = (const bf16*)(ws + WS_S + S_NKN); bf16* AO = (bf16*)(ws + WS_S + S_AO);
    LAS float* rpb = (LAS float*)(lds + att::RPB_OFF);
    for (int u = vcu; u < 768; u += G) {
        if (u < 256) {
            const int b = u >> 7, h = (u >> 3) & 15, i = u & 7, q0 = MP + b * 2048 + i * 256;
            const int rlo = min(max(4 * i - 4, 0), 24), rhi = min(max(4 * i - 1, 0), 24) + 8, nrows = rhi - rlo;
            __syncthreads();
            for (int e = tid; e < 465; e += NTHR) rpb[e] = a.in[I_RPB][h * 465 + e] * 11.313708498984761f;
            __syncthreads();
            const att::KvSrc src{MALL + b * 256, 4, MP + b * 2048 + 64 * rlo, nrows};
            const att::NatMask nm{rlo, 4 * i + ((tid >> 6) >> 1), 32 * ((tid >> 6) & 1) + (tid & 31), rpb};
            att::attn_unit<128, 1, DM, DM, 6144, DM>(QN + (size_t)q0 * DM + h * 128, KN + h * 128, QKV + 4096 + h * 128, AO + (size_t)q0 * DM + h * 128, src, 4 + nrows, nm, (LAS char*)lds, tid);
        } else {
            const int v = u - 256, b = v >> 4, h = v & 15, q0 = b * 256;
            const att::KvSrc src{b * 256, 4, 0, 1};
            att::attn_unit<128, 0, DM, DM, 6144, DM>(QN + (size_t)q0 * DM + h * 128, KN + h * 128, QKV + 4096 + h * 128, AO + (size_t)q0 * DM + h * 128, src, 4, att::NatMask{0, 0, 0, nullptr}, (LAS char*)lds, tid);
        }
    }
}
constexpr int NPHASE = 1 + 10 * DEPTH;
__host__ __device__ constexpr bool phase_exists(int ph) {
    if (ph == 0) return true;
    const int l = (ph - 1) / 10, k = (ph - 1) % 10, kind = l % 3;
    if (k == 3) return kind == 0;
    if (k == 4) return kind != 2;
    if (k == 5) return kind != 1;
    return true;
}

__global__ void __launch_bounds__(NTHR, 2) fwd(Args a) {
    extern __shared__ __attribute__((aligned(16))) unsigned char lds_[];
    LAS unsigned char* lds = (LAS unsigned char*)lds_;
    const int tid = threadIdx.x, lane = tid & 63, wave = __builtin_amdgcn_readfirstlane(tid >> 6);
    const int G = gridDim.x, bx = blockIdx.x, vcu = (G % 8 == 0) ? (bx % 8) * (G / 8) + bx / 8 : bx;
    const int gw = vcu * NWAVES + wave, NGW = G * NWAVES;
    volatile LAS unsigned* MISC = (volatile LAS unsigned*)(lds + MISC_OFF);
    unsigned* ctl = (unsigned*)(a.ws + WS_CTL);
    for (int u = tid; u < (LDS_BYTES - LDSCTL_OFF) / 4; u += NTHR) ((LAS unsigned*)(lds + LDSCTL_OFF))[u] = 0u;
    __syncthreads();
    XcdBarrier bar; bar.bar = ctl + CW_BAR; bar.x = 0; bar.st = nullptr;
    if (MK_SINGLE) bar = xcd_barrier_post(ctl + CW_BAR, MISC + 8);
    const int lo = a.ph_lo, hi = a.ph_hi;
#define IN(k) (lo <= (k) && (k) < hi)
#define SEAM(k) do { if (MK_SINGLE && (k) + 1 < hi) xcd_barrier(bar); } while (0)
#define GEMM_PTRS PH_PTRS; int gG = G, gbx = bx; OPAQUE_S(gG); OPAQUE_S(gbx); bf16* const H = (bf16*)(ws + WS_H); bf16* const U = (bf16*)(ws + WS_U); bf16* const AO = (bf16*)(ws + WS_S + S_AO); float* const X = out + O_X; \
    const float* const MODS = (const float*)(ws + WS_MODS); (void)H; (void)U; (void)AO; (void)X; (void)MODS

    if (IN(0)) { p0_prologue(a, lds, tid, lane, wave, vcu, G); rope_table(a, tid, vcu, G); SEAM(0); }

    for (int l = 0; l < DEPTH; ++l) {
        const int kind = l % 3, j = l / 3, pb = 1 + 10 * l;
        if (IN(pb + 0)) { norm_phase(a, l, false, lane, gw, NGW); SEAM(pb + 0); }
        if (kind == 0) {
            if (IN(pb + 1)) {
                GEMM_PTRS; unsigned char* wm = ws + WS_WMLA + (size_t)j * WMLA_STRIDE;
                pg8::Gemm g{H, (const bf16*)wm, MALL, 1536, DM, DM, DM, 1}; pg8::StaticOrder S; S.init(MALL, 1536, 1, gG, gbx);
                pg8::EpiF32 E{(float*)(ws + WS_S + S_QAKV), 1536};
                pg8::gemm_phase<pg8::EpiF32, pg8::StaticOrder>(lds, g, S, E);
                SEAM(pb + 1);
            }
            if (IN(pb + 2)) { mla_thin_a(a, j, lane, gw, NGW); SEAM(pb + 2); }
            if (IN(pb + 3)) {
                GEMM_PTRS; unsigned char* wm = ws + WS_WMLA + (size_t)j * WMLA_STRIDE;
                { pg8::Gemm g{(const bf16*)(ws + WS_S + S_QAN), (const bf16*)(wm + WMLA_QB), MALL, 3072, 768, 768, 768, 1}; pg8::StaticOrder S; S.init(MALL, 3072, 1, gG, gbx);
                  pg8::EpiBf16<0> E{(bf16*)(ws + WS_S + S_QRAW), 3072};
                  pg8::gemm_phase<pg8::EpiBf16<0>, pg8::StaticOrder>(lds, g, S, E); }
                { pg8::Gemm g{(const bf16*)(ws + WS_S + S_CKVN), (const bf16*)(wm + WMLA_KVB), MKV, 4096, 512, 512, 512, 1}; pg8::StaticOrder S; S.init(MKV, 4096, 1, gG, gbx);
                  pg8::EpiBf16<0> E{(bf16*)(ws + WS_S + S_KVRAW), 4096};
                  pg8::gemm_phase<pg8::EpiBf16<0>, pg8::StaticOrder>(lds, g, S, E); }
                SEAM(pb + 3);
            }
            if (IN(pb + 4)) { mla_thin_b(a, j, lane, gw, NGW); SEAM(pb + 4); }
            if (IN(pb + 5)) { mla_attn_phase(a, lds, tid, vcu, G); SEAM(pb + 5); }
        }
        if (kind == 1) {
            if (IN(pb + 1)) {
                GEMM_PTRS;
                pg8::Gemm g{H, (const bf16*)(ws + WS_WHG), MALL, 10240, DM, DM, DM, 1}; pg8::StaticOrder S; S.init(MALL, 10240, 1, gG, gbx);
                pg8::EpiHg E{ws};
                pg8::gemm_phase<pg8::EpiHg, pg8::StaticOrder>(lds, g, S, E);
                SEAM(pb + 1);
            }
            if (IN(pb + 2)) { hg_scan_phase(a, lds, tid, vcu, G); SEAM(pb + 2); }
            if (IN(pb + 4)) { hg_thin_c(a, lane, gw, NGW); SEAM(pb + 4); }
        }
        if (kind == 2) {
            if (IN(pb + 1)) {
                GEMM_PTRS;
                pg8::Gemm g{H, (const bf16*)(ws + WS_WNAT), MALL, 6144, DM, DM, DM, 1}; pg8::StaticOrder S; S.init(MALL, 6144, 1, gG, gbx);
                pg8::EpiBf16<0> E{(bf16*)(ws + WS_S + S_NQKV), 6144};
                pg8::gemm_phase<pg8::EpiBf16<0>, pg8::StaticOrder>(lds, g, S, E);
                SEAM(pb + 1);
            }
            if (IN(pb + 2)) { nat_thin_d(a, lane, gw, NGW); SEAM(pb + 2); }
            if (IN(pb + 5)) { nat_attn_phase(a, lds, tid, vcu, G); SEAM(pb + 5); }
        }
        if (IN(pb + 6)) {
            GEMM_PTRS;
            const bf16* wo = (const bf16*)(kind == 0 ? ws + WS_WMLA + (size_t)j * WMLA_STRIDE + WMLA_WO : kind == 1 ? ws + WS_WHG + WHG_WO : ws + WS_WNAT + WNAT_WO);
            pg8::Gemm g{AO, wo, MALL, DM, DM, DM, DM, 1}; pg8::StaticOrder S; S.init(MALL, DM, 1, gG, gbx);
            pg8::EpiRes<false> E{X, MODS + (size_t)l * 3 * NMOD + 2 * DM};
            pg8::gemm_phase<pg8::EpiRes<false>, pg8::StaticOrder>(lds, g, S, E);
            SEAM(pb + 6);
        }
        if (IN(pb + 7)) { norm_phase(a, l, true, lane, gw, NGW); SEAM(pb + 7); }
        if (IN(pb + 8)) {
            GEMM_PTRS;
            pg8::Gemm g{H, (const bf16*)(ws + WS_WFF1) + (size_t)l * DM * FF, MALL, FF, DM, DM, DM, 1}; pg8::StaticOrder S; S.init(MALL, FF, 1, gG, gbx);
            pg8::EpiBf16<1> E{U, FF};
            pg8::gemm_phase<pg8::EpiBf16<1>, pg8::StaticOrder>(lds, g, S, E);
            SEAM(pb + 8);
        }
        if (IN(pb + 9)) {
            GEMM_PTRS;
            pg8::Gemm g{U, (const bf16*)(ws + WS_WFF2) + (size_t)l * DM * FF, MALL, DM, FF, FF, FF, 1}; pg8::StaticOrder S; S.init(MALL, DM, 1, gG, gbx);
            pg8::EpiRes<false> E{X, MODS + (size_t)l * 3 * NMOD + 5 * DM};
            pg8::gemm_phase<pg8::EpiRes<false>, pg8::StaticOrder>(lds, g, S, E);
            SEAM(pb + 9);
        }
    }
#undef IN
#undef SEAM
}

extern "C" void kernel_launch(void* const* d_in, const int* in_sizes, int n_in, void* d_out, int out_size, void* d_ws, size_t ws_size, hipStream_t stream) {
    static int grid = 0;
    if (grid == 0) {
        if (n_in != N_IN || (size_t)out_size != O_END || ws_size < WS_END) { fprintf(stderr, "kernel_launch: shape mismatch n_in %d out %d ws %zu (need %zu); nothing launched\n", n_in, out_size, ws_size, (size_t)WS_END); grid = -1; return; }
        int dev = 0, cus = 0, per_cu = 0;
        if (hipGetDevice(&dev) != hipSuccess || hipDeviceGetAttribute(&cus, hipDeviceAttributeMultiprocessorCount, dev) != hipSuccess) { fprintf(stderr, "kernel_launch: device query failed\n"); grid = -1; return; }
        if (hipFuncSetAttribute((const void*)fwd, hipFuncAttributeMaxDynamicSharedMemorySize, LDS_BYTES) != hipSuccess) { fprintf(stderr, "kernel_launch: hipFuncSetAttribute failed\n"); grid = -1; return; }
        if (hipOccupancyMaxActiveBlocksPerMultiprocessor(&per_cu, (const void*)fwd, NTHR, LDS_BYTES) != hipSuccess || per_cu < 1) { fprintf(stderr, "kernel_launch: occupancy query says %d blocks/CU\n", per_cu); }
        (void)hipGetLastError();
        grid = cus;
    }
    if (grid < 0) return;
    if (hipMemsetAsync((char*)d_ws + WS_CTL, 0, CTL_ZERO_BYTES, stream) != hipSuccess) { fprintf(stderr, "kernel_launch: memset failed\n"); return; }
    Args a{};
    for (int i = 0; i < N_IN; ++i) a.in[i] = (const float*)d_in[i];
    a.out = (float*)d_out; a.ws = (unsigned char*)d_ws;
    int nt = 0, items = 0;
    auto add = [&](const float* src, size_t dst_off, int K, int N, int row_off) { TJob& t = a.tj[nt++]; t.src = src; t.dst = (bf16*)((unsigned char*)d_ws + dst_off); t.K = K; t.N = N; t.row_off = row_off; t.start = items; items += (K / 64) * (N / 32); };
    for (int l = 0; l < DEPTH; ++l) { add(a.in[I_WFF1] + (size_t)l * DM * FF, WS_WFF1 + (size_t)l * DM * FF * 2, DM, FF, 0); add(a.in[I_WFF2] + (size_t)l * DM * FF, WS_WFF2 + (size_t)l * DM * FF * 2, FF, DM, 0); }
    for (int j = 0; j < 2; ++j) { const size_t wb = WS_WMLA + (size_t)j * WMLA_STRIDE;
        add(a.in[I_WQA] + (size_t)j * DM * 768, wb, DM, 768, 0); add(a.in[I_WKVA] + (size_t)j * DM * 576, wb, DM, 576, 768);
        add(a.in[I_WQB] + (size_t)j * 768 * 3072, wb + WMLA_QB, 768, 3072, 0); add(a.in[I_WKVB] + (size_t)j * 512 * 4096, wb + WMLA_KVB, 512, 4096, 0);
        add(a.in[I_WMO] + (size_t)j * DM * DM, wb + WMLA_WO, DM, DM, 0); }
    add(a.in[I_WHQ], WS_WHG, DM, DM, 0); add(a.in[I_WHF], WS_WHG, DM, DM, 2048); add(a.in[I_WHF] + (size_t)DM * DM, WS_WHG, DM, DM, 4096);
    add(a.in[I_WHI], WS_WHG, DM, DM, 6144); add(a.in[I_WHG], WS_WHG, DM, DM, 8192); add(a.in[I_WHO], WS_WHG + WHG_WO, DM, DM, 0);
    add(a.in[I_WNQKV], WS_WNAT, DM, 3 * DM, 0); add(a.in[I_WNO], WS_WNAT + WNAT_WO, DM, DM, 0);
    a.ntj = nt; a.nitems = items;
#if MK_SINGLE
    a.ph_lo = 0; a.ph_hi = NPHASE < MK_LAST_PHASE ? NPHASE : MK_LAST_PHASE;
    hipLaunchKernelGGL(fwd, dim3(grid), dim3(NTHR), LDS_BYTES, stream, a);
#else
    for (int ph = 0; ph < NPHASE && ph < MK_LAST_PHASE; ++ph) {
        if (!phase_exists(ph)) continue;
        a.ph_lo = ph; a.ph_hi = ph + 1;
        hipLaunchKernelGGL(fwd, dim3(grid), dim3(NTHR), LDS_BYTES, stream, a);
    }
#endif
    const hipError_t le = hipPeekAtLastError();
    if (le != hipSuccess) fprintf(stderr, "kernel_launch: launch failed: %s\n", hipGetErrorName(le));
}
```

```cpp
#define MK_SINGLE 1
#define MK_LAST_PHASE 1000
#include <hip/hip_runtime.h>
#include <cstdio>
#include <cstdint>

#ifndef MK_SINGLE
#define MK_SINGLE 0
#endif
#ifndef MK_LAST_PHASE
#define MK_LAST_PHASE 1000
#endif
namespace pg8 {
#define PG8_LAS __attribute__((address_space(3)))
typedef unsigned short bf16_t;
typedef short bf16x8 __attribute__((ext_vector_type(8)));
typedef float f32x4 __attribute__((ext_vector_type(4)));
typedef unsigned u32x4 __attribute__((ext_vector_type(4)));
constexpr int BM = 256, BK = 64, HALF = 128, HTB = HALF * BK * 2  , STAGE_BYTES = 8 * HTB, NXCD = 8, WGM = 8;

__host__ __device__ __forceinline__ int lds_byte(int r, int c) { const int st = (r >> 4) * 2 + (c >> 5), rr = r & 15, cc = c & 31, ob = rr * 64 + cc * 2; return st * 1024 + (ob ^ (((ob >> 9) & 1) << 5)); }
__host__ __device__ __forceinline__ void stage_rc(int b, int& R, int& C) { const int st = b / 1024, sb = b % 1024, swz = sb ^ (((sb >> 9) & 1) << 5); R = (st >> 1) * 16 + swz / 64; C = (st & 1) * 32 + (swz % 64) / 2; }
__host__ __device__ __forceinline__ int perm32(int rho) { const int n = rho >> 4, i = rho & 15; return 8 * (i >> 2) + 4 * n + (i & 3); }

struct Unit { int pm, pn, ks; };
struct Gemm { const bf16_t* A; const bf16_t* Bt; int M, N, K, lda, ldb, nsplit; };

struct StaticOrder {
    int nM, nN, nNv, nwg, G, c;
    __host__ __device__ void init(int M, int N, int nsplit, int G_, int c_) { nM = M / BM; nN = N / BM; nNv = nN * nsplit; nwg = nM * nNv; G = G_; c = c_; }
    __host__ __device__ bool next(int i, Unit& u) const {
        const long L = (long)i * G + c; if (L >= nwg) return false;
        int wgid = (int)L; { const int q = nwg / NXCD, r = nwg % NXCD, xcd = wgid % NXCD, off = wgid / NXCD; wgid = (xcd < r ? xcd * (q + 1) : r * (q + 1) + (xcd - r) * q) + off; }
        const int nig = WGM * nNv, gid = wgid / nig, fm = gid * WGM, gsz = (nM - fm) < WGM ? (nM - fm) : WGM;
        u.pm = fm + ((wgid % nig) % gsz); const int pv = (wgid % nig) / gsz; u.pn = pv % nN; u.ks = pv / nN; return true;
    }
    __device__ __forceinline__ void a_ready(const Unit&) const {}
    __device__ __forceinline__ void done(const Unit&) const {}
};

__device__ __forceinline__ unsigned cvt_pk_bf16(float lo, float hi) { unsigned r; asm("v_cvt_pk_bf16_f32 %0, %1, %2" : "=v"(r) : "v"(lo), "v"(hi)); return r; }


template <class Epi, class Sched, bool ALIGN_EPI = true, bool SP2 = true>
__device__ __forceinline__ void gemm_phase(PG8_LAS unsigned char* lds, const Gemm g, const Sched& S, const Epi& E) {
    int tid_ = threadIdx.x; asm volatile("" : "+v"(tid_));
    const int tid = tid_, wid = __builtin_amdgcn_readfirstlane(tid >> 6), lane = tid & 63, wr = wid >> 2, wc = wid & 3, fr = lane & 15, fq = lane >> 4;
    const int K = g.K, nt = K / BK;
    unsigned voffA[2], voffB[2];
#pragma unroll
    for (int i = 0; i < 2; ++i) { int R, C; stage_rc(tid * 16 + i * 8192, R, C); const int Rb = Epi::PERM ? ((R & ~31) + perm32(R & 31)) : R;
        voffA[i] = (unsigned)(R * g.lda + C) * 2u; voffB[i] = (unsigned)(Rb * g.ldb + C) * 2u; }
    const size_t kstep = (size_t)(BK * 2);
    const size_t hstepA = (size_t)HALF * g.lda * 2, hstepB = (size_t)HALF * g.ldb * 2;
    const size_t tstepA = 2 * hstepA, tstepB = 2 * hstepB;
    const size_t sstep = (size_t)K * 2;
    const unsigned ldsw = (unsigned)wid * 1024u;
    const int aoff = lds_byte(wr * 64 + fr, fq * 8), boff = lds_byte(wc * 32 + fr, fq * 8);
#define PG8_SA(b, h) (((b) * 2 + (h)) * HTB)
#define PG8_SB(b, h) ((4 + (b) * 2 + (h)) * HTB)
#define PG8_STAGE(bufoff, gbase, voff) do { _Pragma("unroll") for (int _i = 0; _i < 2; ++_i) \
        __builtin_amdgcn_global_load_lds((const unsigned*)((const char*)(gbase) + (voff)[_i]), (PG8_LAS unsigned*)(lds + (bufoff) + ldsw + _i * 8192), 16, 0, 0); } while (0)
#define PG8_LDA(dst, b, h) do { _Pragma("unroll") for (int m = 0; m < 4; ++m) _Pragma("unroll") for (int k = 0; k < 2; ++k) dst[m][k] = *(const PG8_LAS bf16x8*)(lds + PG8_SA(b, h) + aoff + m * 2048 + k * 1024); } while (0)
#define PG8_LDB(dst, b, h) do { _Pragma("unroll") for (int n = 0; n < 2; ++n) _Pragma("unroll") for (int k = 0; k < 2; ++k) dst[n][k] = *(const PG8_LAS bf16x8*)(lds + PG8_SB(b, h) + boff + n * 2048 + k * 1024); } while (0)
#define PG8_MMA(ai, bj, At, Bt) do { __builtin_amdgcn_s_setprio(1); _Pragma("unroll") for (int m = 0; m < 4; ++m) _Pragma("unroll") for (int n = 0; n < 2; ++n) _Pragma("unroll") for (int k = 0; k < 2; ++k) \
        acc[ai][bj][m][n] = __builtin_amdgcn_mfma_f32_16x16x32_bf16(Bt[n][k], At[m][k], acc[ai][bj][m][n], 0, 0, 0); __builtin_amdgcn_s_setprio(0); } while (0)
#define PG8_WAIT_V(n) asm volatile("s_waitcnt vmcnt(" #n ")" ::: "memory")
#define PG8_WAIT_L(n) asm volatile("s_waitcnt lgkmcnt(" #n ")" ::: "memory")
#define PG8_BAR __builtin_amdgcn_s_barrier()
#define PG8_SCHED __builtin_amdgcn_sched_barrier(0)
    Unit cur, nxt; int ui = 0;
    if (!S.next(0, cur)) return;
    f32x4 acc[2][2][4][2];
#pragma unroll
    for (int a = 0; a < 2; ++a)
#pragma unroll
        for (int b = 0; b < 2; ++b)
#pragma unroll
            for (int m = 0; m < 4; ++m)
#pragma unroll
                for (int n = 0; n < 2; ++n) acc[a][b][m][n] = (f32x4){0.f, 0.f, 0.f, 0.f};
    bf16x8 At[4][2], B0[2][2], B1[2][2];
    const char* cA = (const char*)g.A + (size_t)cur.pm * tstepA + (size_t)cur.ks * sstep; const char* cB = (const char*)g.Bt + (size_t)cur.pn * tstepB + (size_t)cur.ks * sstep;
    S.a_ready(cur);
    if constexpr (SP2) {
        PG8_STAGE(PG8_SB(0, 0), cB, voffB); PG8_STAGE(PG8_SB(0, 1), cB + hstepB, voffB); PG8_STAGE(PG8_SA(0, 0), cA, voffA); PG8_STAGE(PG8_SA(0, 1), cA + hstepA, voffA);
        if (wr == 1) PG8_BAR;
        PG8_WAIT_V(2); PG8_BAR;
        PG8_STAGE(PG8_SB(1, 0), cB + kstep, voffB); PG8_STAGE(PG8_SA(1, 0), cA + kstep, voffA); PG8_STAGE(PG8_SB(1, 1), cB + hstepB + kstep, voffB);
        PG8_WAIT_V(6); PG8_BAR;
    } else {
        PG8_STAGE(PG8_SB(0, 0), cB, voffB); PG8_STAGE(PG8_SA(0, 0), cA, voffA); PG8_STAGE(PG8_SB(0, 1), cB + hstepB, voffB); PG8_STAGE(PG8_SA(0, 1), cA + hstepA, voffA);
        if (wr == 1) PG8_BAR;
        PG8_WAIT_V(4); PG8_BAR;
        PG8_STAGE(PG8_SB(1, 0), cB + kstep, voffB); PG8_STAGE(PG8_SA(1, 0), cA + kstep, voffA); PG8_STAGE(PG8_SB(1, 1), cB + hstepB + kstep, voffB);
        PG8_WAIT_V(6); PG8_BAR;
    }
    for (;;) {
        const bool has_next = S.next(ui + 1, nxt);
        const char* nA = has_next ? (const char*)g.A + (size_t)nxt.pm * tstepA + (size_t)nxt.ks * sstep : cA; const char* nB = has_next ? (const char*)g.Bt + (size_t)nxt.pn * tstepB + (size_t)nxt.ks * sstep : cB;
        for (int t = 0; t < nt; t += 2) {
            const bool last = (t == nt - 2);
            const char* a1 = cA + (size_t)(t + 1) * kstep;
            const char* a2 = last ? nA : cA + (size_t)(t + 2) * kstep; const char* b2 = last ? nB : cB + (size_t)(t + 2) * kstep;
            const char* a3 = a2 + kstep; const char* b3 = b2 + kstep;
            if (last && has_next) S.a_ready(nxt);
            if constexpr (SP2) {
            PG8_LDB(B0, 0, 0); PG8_LDB(B1, 0, 1); PG8_SCHED; PG8_LDA(At, 0, 0); PG8_STAGE(PG8_SA(1, 1), a1 + hstepA, voffA);
            PG8_WAIT_V(8); PG8_WAIT_L(0); PG8_BAR; PG8_MMA(0, 0, At, B0); PG8_MMA(0, 1, At, B1); PG8_BAR; PG8_SCHED;
            PG8_LDA(At, 0, 1); PG8_STAGE(PG8_SB(0, 0), b2, voffB); PG8_STAGE(PG8_SB(0, 1), b2 + hstepB, voffB); PG8_STAGE(PG8_SA(0, 0), a2, voffA);
            PG8_WAIT_V(8); PG8_WAIT_L(0); PG8_BAR; PG8_MMA(1, 0, At, B0); PG8_MMA(1, 1, At, B1); PG8_BAR; PG8_SCHED;
            PG8_LDB(B0, 1, 0); PG8_LDB(B1, 1, 1); PG8_SCHED; PG8_LDA(At, 1, 0); PG8_STAGE(PG8_SA(0, 1), a2 + hstepA, voffA);
            PG8_WAIT_V(8); PG8_WAIT_L(0); PG8_BAR; PG8_MMA(0, 0, At, B0); PG8_MMA(0, 1, At, B1); PG8_BAR; PG8_SCHED;
            PG8_LDA(At, 1, 1); PG8_STAGE(PG8_SB(1, 0), b3, voffB); PG8_STAGE(PG8_SB(1, 1), b3 + hstepB, voffB); PG8_STAGE(PG8_SA(1, 0), a3, voffA);
            PG8_WAIT_V(8); PG8_WAIT_L(0); PG8_BAR; PG8_MMA(1, 0, At, B0); PG8_MMA(1, 1, At, B1); PG8_BAR; PG8_SCHED;
            } else {
            PG8_LDB(B0, 0, 0); PG8_SCHED; PG8_LDA(At, 0, 0); PG8_STAGE(PG8_SA(1, 1), a1 + hstepA, voffA);
            PG8_WAIT_L(8); PG8_BAR; PG8_WAIT_L(0); PG8_MMA(0, 0, At, B0); PG8_BAR; PG8_SCHED;
            PG8_LDB(B1, 0, 1); PG8_STAGE(PG8_SB(0, 0), b2, voffB);
            PG8_BAR; PG8_WAIT_L(0); PG8_MMA(0, 1, At, B1); PG8_BAR;
            PG8_LDA(At, 0, 1); PG8_STAGE(PG8_SA(0, 0), a2, voffA);
            PG8_BAR; PG8_WAIT_L(0); PG8_MMA(1, 0, At, B0); PG8_BAR; PG8_SCHED;
            PG8_STAGE(PG8_SB(0, 1), b2 + hstepB, voffB);
            PG8_WAIT_V(6); PG8_BAR; PG8_MMA(1, 1, At, B1); PG8_BAR;
            PG8_LDB(B0, 1, 0); PG8_SCHED; PG8_LDA(At, 1, 0); PG8_STAGE(PG8_SA(0, 1), a2 + hstepA, voffA);
            PG8_WAIT_L(8); PG8_BAR; PG8_WAIT_L(0); PG8_MMA(0, 0, At, B0); PG8_BAR; PG8_SCHED;
            PG8_LDB(B1, 1, 1); PG8_STAGE(PG8_SB(1, 0), b3, voffB);
            PG8_BAR; PG8_WAIT_L(0); PG8_MMA(0, 1, At, B1); PG8_BAR;
            PG8_LDA(At, 1, 1); PG8_STAGE(PG8_SA(1, 0), a3, voffA);
            PG8_BAR; PG8_WAIT_L(0); PG8_MMA(1, 0, At, B0); PG8_BAR; PG8_SCHED;
            PG8_STAGE(PG8_SB(1, 1), b3 + hstepB, voffB);
            PG8_WAIT_V(6); PG8_BAR; PG8_MMA(1, 1, At, B1); PG8_BAR;
            }
        }
        if constexpr (ALIGN_EPI) { if (wr == 0) PG8_BAR; }
        E(acc, cur, wr, wc, fr, fq); S.done(cur);
        if (!has_next) break;
#pragma unroll
        for (int a = 0; a < 2; ++a)
#pragma unroll
            for (int b = 0; b < 2; ++b)
#pragma unroll
                for (int m = 0; m < 4; ++m)
#pragma unroll
                    for (int n = 0; n < 2; ++n) acc[a][b][m][n] = (f32x4){0.f, 0.f, 0.f, 0.f};
        cur = nxt; cA = nA; cB = nB; ++ui;
        if constexpr (ALIGN_EPI) { if (wr == 1) PG8_BAR; }
    }
    PG8_WAIT_V(0);
    if constexpr (!ALIGN_EPI) { if (wr == 0) PG8_BAR; }
    PG8_BAR;
#undef PG8_SA
#undef PG8_SB
#undef PG8_STAGE
#undef PG8_LDA
#undef PG8_LDB
#undef PG8_MMA
#undef PG8_WAIT_V
#undef PG8_WAIT_L
#undef PG8_BAR
#undef PG8_SCHED
}
}
constexpr int DM = 2048, MP = 8192, MS = 4096, MALL = 12288, MKV = 12800, FF = 8192, NMOD = 12288;
constexpr int NWAVES = 8, NTHR = 512, DEPTH = 4;
constexpr float EPS = 1e-6f;
constexpr size_t O_X = 0, O_CKV = 25165824, O_KPE = 33554432, O_HG = 34603008, O_NK = 51380224, O_NV = 68157440, O_END = 84934656;
enum { I_XP = 0, I_XS, I_CCKV, I_CKPE, I_SHG, I_CNK, I_CNV, I_C, I_CCTX, I_WMOD, I_BMOD, I_GMIX, I_GFFN, I_WQA, I_GQA, I_WQB, I_GQN, I_WKVA, I_GKVA, I_WKVB, I_GKN, I_WMO,
       I_WHQ, I_WHF, I_HLB, I_WHI, I_WHG, I_GHO, I_WHO, I_WNQKV, I_GNQ, I_GNK, I_RPB, I_WNO, I_WFF1, I_WFF2, N_IN };

constexpr size_t MiB = 1u << 20;
constexpr size_t WS_CTL = 0, CTL_ZERO_BYTES = 65536;
constexpr size_t WS_MODS = 2 * MiB;
constexpr size_t WS_LB = 3 * MiB;
constexpr size_t WS_SSK = 3 * MiB + 65536;
constexpr size_t WS_ROPE = 3 * MiB + 131072;
constexpr size_t WS_WFF1 = 4 * MiB, WS_WFF2 = 132 * MiB;
constexpr size_t WS_WMLA = 260 * MiB, WMLA_STRIDE = 24 * MiB;
constexpr size_t WMLA_QB = 6 * MiB, WMLA_KVB = 11 * MiB, WMLA_WO = 15 * MiB;
constexpr size_t WS_WHG = 308 * MiB, WHG_WO = 40 * MiB;
constexpr size_t WS_WNAT = 356 * MiB, WNAT_WO = 24 * MiB;
constexpr size_t WS_H = 388 * MiB;
constexpr size_t WS_U = 436 * MiB;
constexpr size_t WS_S = 628 * MiB;
constexpr size_t S_AO = 0;
constexpr size_t S_QAKV = 48 * MiB, S_QAN = 120 * MiB, S_CKVN = 138 * MiB, S_KPE = 151 * MiB, S_QRAW = 155 * MiB, S_KVRAW = 227 * MiB, S_QN = 327 * MiB, S_KF = 399 * MiB;
constexpr size_t S_HQ = 48 * MiB, S_HK = 96 * MiB, S_HV = 192 * MiB, S_HGS = 240 * MiB, S_OF = 288 * MiB;
constexpr size_t S_NQKV = 48 * MiB, S_NQN = 198 * MiB, S_NKN = 246 * MiB;
constexpr size_t WS_END = WS_S + 480 * MiB;
constexpr int CW_TMO = 0, CW_CODE = 1, CW_BAR = 4096;

constexpr int RING_BYTES = 131072;
constexpr int LDSCTL_OFF = RING_BYTES, MISC_OFF = LDSCTL_OFF + 320;
constexpr int LDS_BYTES = 147456;

#define GAS __attribute__((address_space(1)))
#define LAS __attribute__((address_space(3)))
typedef unsigned short bf16;
typedef unsigned v4u __attribute__((ext_vector_type(4)));
typedef unsigned v2u __attribute__((ext_vector_type(2)));
typedef float f32x4 __attribute__((ext_vector_type(4)));
typedef float f32x2 __attribute__((ext_vector_type(2)));
typedef short bf16x8 __attribute__((ext_vector_type(8)));
typedef GAS unsigned gu32;
#define RLX_AGENT __ATOMIC_RELAXED, __HIP_MEMORY_SCOPE_AGENT
#define LDS_WAIT() asm volatile("s_waitcnt lgkmcnt(0)" ::: "memory")
#define VM_WAIT() asm volatile("s_waitcnt vmcnt(0)" ::: "memory")
#ifndef DBG_SCALE
#define DBG_SCALE 1.0f
#endif
#define OPAQUE_S(x) asm volatile("" : "+s"(x))
#define PH_PTRS unsigned char* ws = a.ws; float* out = a.out; OPAQUE_S(ws); OPAQUE_S(out)
#define OPAQUE_V(x) asm volatile("" : "+v"(x))
__device__ __forceinline__ unsigned pk2(float lo, float hi) { unsigned r; asm("v_cvt_pk_bf16_f32 %0, %1, %2" : "=v"(r) : "v"(lo), "v"(hi)); return r; }
__device__ __forceinline__ float bf_lo(unsigned w) { return __uint_as_float(w << 16); }
__device__ __forceinline__ float bf_hi(unsigned w) { return __uint_as_float(w & 0xffff0000u); }
__device__ __forceinline__ float wave_sum(float v) {
#pragma unroll
    for (int o = 1; o < 64; o <<= 1) v += __shfl_xor(v, o);
    return v;
}
__device__ __forceinline__ float sum16(float v) {
#pragma unroll
    for (int o = 1; o < 16; o <<= 1) v += __shfl_xor(v, o);
    return v;
}

#define XB_TMO      128
#define XB_XCNT(j)  (256  + 64 * (j))
#define XB_XSUB(j)  (1280 + 64 * (j))
#define XB_XGEN(j)  (2304 + 64 * (j))
#define XB_TOP      3328
#define XB_TOPGEN   3392
#define XCD_BAR_WORDS 3456
#define XB_SPIN_CAP (1u << 18)
__device__ __forceinline__ unsigned xb_ld(unsigned* p)              { return __hip_atomic_load(p, __ATOMIC_RELAXED, __HIP_MEMORY_SCOPE_AGENT); }
__device__ __forceinline__ unsigned xb_add(unsigned* p, unsigned v) { return __hip_atomic_fetch_add(p, v, __ATOMIC_RELAXED, __HIP_MEMORY_SCOPE_AGENT); }
__device__ __forceinline__ unsigned xb_xcc_id() { return (unsigned)__builtin_amdgcn_s_getreg((3 << 11) | 20) & 0xFu; }
#define XB_SPIN(cond, bar) do { unsigned _sp = 0; while (cond) { __builtin_amdgcn_s_sleep(1); \
    if ((++_sp & 255u) == 0u) { if (xb_ld(&(bar)[XB_TMO])) break; if (_sp > XB_SPIN_CAP) { atomicAdd(&(bar)[XB_TMO], 1u); break; } } } } while (0)
struct XcdBarrier { unsigned* bar; unsigned x; volatile LAS unsigned* st; };
__device__ __forceinline__ XcdBarrier xcd_barrier_post(unsigned* bar, volatile LAS unsigned* st) {
    XcdBarrier b; b.bar = bar; b.x = xb_xcc_id(); b.st = st;
    if (threadIdx.x == 0) (void)xb_add(&bar[XB_XCNT(b.x)], 1u);
    return b;
}
__device__ __forceinline__ void xcd_barrier_complete(unsigned* bar, unsigned x, unsigned& nloc, unsigned& nx) {
    const unsigned G = gridDim.x * gridDim.y * gridDim.z;
    unsigned sum, cnt, mine, sp = 0u;
    for (;;) {
        sum = 0u; cnt = 0u; mine = 0u;
#pragma unroll
        for (unsigned j = 0; j < 16; ++j) { const unsigned c = xb_ld(&bar[XB_XCNT(j)]); sum += c; cnt += (c > 0u) ? 1u : 0u; mine = (j == x) ? c : mine; }
        if (sum == G) break;
        __builtin_amdgcn_s_sleep(1);
        if ((++sp & 255u) == 0u) { if (xb_ld(&bar[XB_TMO])) break; if (sp > XB_SPIN_CAP) { atomicAdd(&bar[XB_TMO], 1u); break; } }
    }
    nloc = mine > 0u ? mine : 1u; nx = cnt > 0u ? cnt : 1u;
}
__device__ __forceinline__ void xcd_barrier(const XcdBarrier& b) {
    asm volatile("s_waitcnt vmcnt(0)" ::: "memory");
    __syncthreads();
    if (threadIdx.x == 0) {
        unsigned* bar = b.bar;
        __builtin_amdgcn_s_waitcnt(0);
        unsigned nloc = b.st[0], nx = b.st[1];
        if (nloc == 0u) { xcd_barrier_complete(bar, b.x, nloc, nx); b.st[0] = nloc; b.st[1] = nx; }
        const unsigned old = xb_add(&bar[XB_XSUB(b.x)], 1u);
        const unsigned gen = old / nloc;
        if (old + 1u == (gen + 1u) * nloc) {
            __builtin_amdgcn_fence(__ATOMIC_RELEASE, "agent");
            asm volatile("s_waitcnt vmcnt(0)" ::: "memory");
            const unsigned og = xb_add(&bar[XB_TOP], 1u);
            const unsigned tg = og / nx;
            if (og + 1u == (tg + 1u) * nx) xb_add(&bar[XB_TOPGEN], 1u);
            else XB_SPIN(xb_ld(&bar[XB_TOPGEN]) == tg, bar);
            __builtin_amdgcn_fence(__ATOMIC_ACQUIRE, "agent");
            xb_add(&bar[XB_XGEN(b.x)], 1u);
            asm volatile("s_waitcnt vmcnt(0)" ::: "memory");
        } else {
            XB_SPIN(xb_ld(&bar[XB_XGEN(b.x)]) == gen, bar);
            __builtin_amdgcn_fence(__ATOMIC_ACQUIRE, "agent");
            asm volatile("s_waitcnt vmcnt(0)" ::: "memory");
        }
    }
    __syncthreads();
}

struct TJob { const float* src; bf16* dst; int K, N, row_off, start; };
constexpr int MAX_TJ = 32;
struct Args { const float* in[N_IN]; float* out; unsigned char* ws; TJob tj[MAX_TJ]; int ntj, nitems, ph_lo, ph_hi; };

__device__ __forceinline__ void p0_transpose_item(const float* W, int K, int N, bf16* WT, int row_off, LAS float* scr, int item, int lane) {
    const int nblk = N / 32, kb = item / nblk, nb = item % nblk, k0 = 64 * kb, n0 = 32 * nb;
#pragma unroll 8
    for (int i = 0; i < 32; ++i) { const int kk = 2 * i + (lane >> 5); scr[kk * 33 + (lane & 31)] = W[(size_t)(k0 + kk) * N + n0 + (lane & 31)]; }
    LDS_WAIT(); asm volatile("" ::: "memory");
    const int c = lane & 7;
#pragma unroll
    for (int j = 0; j < 4; ++j) { const int n = (lane >> 3) + 8 * j; const LAS float* s = scr + (8 * c) * 33 + n;
        v4u o; o.x = pk2(s[0 * 33], s[1 * 33]); o.y = pk2(s[2 * 33], s[3 * 33]); o.z = pk2(s[4 * 33], s[5 * 33]); o.w = pk2(s[6 * 33], s[7 * 33]);
        *(GAS v4u*)(WT + (size_t)(row_off + n0 + n) * K + k0 + 8 * c) = o; }
    LDS_WAIT(); asm volatile("" ::: "memory");
}

__device__ __forceinline__ float silu_f(float x) { return x / (1.f + __expf(-x)); }

__device__ __forceinline__ void p0_prologue(const Args& a, LAS unsigned char* lds, int tid, int lane, int wave, int vcu, int G) {
    OPAQUE_V(tid); OPAQUE_V(lane);
    float* mods = (float*)(a.ws + WS_MODS);
    if (vcu < 768) {
        LAS f32x4* S3 = (LAS f32x4*)lds;
        LAS float* RED = (LAS float*)(lds + 32768);
        const float* cc = a.in[I_C]; const float* cx = a.in[I_CCTX];
        for (int k = tid; k < DM; k += NTHR) S3[k] = (f32x4){silu_f(cx[k]), silu_f(cc[k]), silu_f(cc[DM + k]), 0.f};
        __syncthreads();
        for (int tl = vcu; tl < 768; tl += G) {
            const int l = tl / 192, n = (tl % 192) * 64 + lane;
            const float* Wp = a.in[I_WMOD] + ((size_t)l * DM + wave * 256) * NMOD + n;
            float a0 = 0.f, a1 = 0.f, a2 = 0.f;
#pragma unroll 16
            for (int k = 0; k < 256; ++k) { const float wv = Wp[(size_t)k * NMOD]; const f32x4 s = S3[wave * 256 + k]; a0 += s.x * wv; a1 += s.y * wv; a2 += s.z * wv; }
            RED[(wave * 3 + 0) * 64 + lane] = a0; RED[(wave * 3 + 1) * 64 + lane] = a1; RED[(wave * 3 + 2) * 64 + lane] = a2;
            __syncthreads();
            if (wave < 3) { float s = 0.f;
#pragma unroll
                for (int w = 0; w < 8; ++w) s += RED[(w * 3 + wave) * 64 + lane];
                mods[((size_t)l * 3 + wave) * NMOD + n] = s + a.in[I_BMOD][(size_t)l * NMOD + n]; }
            __syncthreads();
        }
    }
    { const int gt = vcu * NTHR + tid;
      if (gt < 2 * DM) { const int d = gt >> 11, c = gt & 2047; const float* hl = a.in[I_HLB] + (size_t)d * 4 * DM + c;
          const float x0 = hl[0], x1 = hl[DM], x2 = hl[2 * DM], x3 = hl[3 * DM]; const float m = fmaxf(fmaxf(x0, x1), fmaxf(x2, x3));
          const float e0 = __expf(x0 - m), e1 = __expf(x1 - m), e2 = __expf(x2 - m), e3 = __expf(x3 - m);
          ((float*)(a.ws + WS_LB))[gt] = e1 / (e0 + e1 + e2 + e3); } }
    __syncthreads();
    LAS float* scr = (LAS float*)(lds + wave * 16384);
    const int gw = vcu * NWAVES + wave, NGW = G * NWAVES;
    for (int it = gw; it < a.nitems; it += NGW) {
        int j = 0;
        while (j + 1 < a.ntj && it >= a.tj[j + 1].start) ++j;
        p0_transpose_item(a.tj[j].src, a.tj[j].K, a.tj[j].N, a.tj[j].dst, a.tj[j].row_off, scr, it - a.tj[j].start, lane);
    }
#if defined(DBG_ZERO_OUT)
    { const size_t gt = (size_t)vcu * NTHR + tid, NT = (size_t)G * NTHR;
      for (size_t i = gt; i < (O_END - O_CKV) / 4; i += NT) *(GAS f32x4*)(a.out + O_CKV + 4 * i) = (f32x4){0.f, 0.f, 0.f, 0.f}; }
#endif
    { const int gt = vcu * NTHR + tid, NT = G * NTHR;
      for (int i = gt; i < 2 * 192 * DM / 8; i += NT) { const int j = i / (192 * DM / 8), r = i % (192 * DM / 8);
          *(GAS v4u*)(a.ws + WS_WMLA + j * WMLA_STRIDE + (size_t)1344 * DM * 2 + (size_t)r * 16) = (v4u){0u, 0u, 0u, 0u}; } }
}

__device__ __forceinline__ int cond_of_row(int row) { return row < MP ? 0 : 1 + ((row - MP) >> 11); }

__device__ __forceinline__ void norm_phase(const Args& a, int l, bool ffn, int lane, int gw, int NGW) {
    OPAQUE_V(lane); PH_PTRS; OPAQUE_S(gw); OPAQUE_S(NGW);
    const float* g = a.in[ffn ? I_GFFN : I_GMIX] + (size_t)l * DM;
    const float* mods = (const float*)(ws + WS_MODS) + (size_t)l * 3 * NMOD + (ffn ? 3 * DM : 0);
    bf16* H = (bf16*)(ws + WS_H);
    const bool first = (l == 0 && !ffn);
    for (int row = gw; row < MALL; row += NGW) {
        const float* xr = first ? (row < MP ? a.in[I_XP] + (size_t)row * DM : a.in[I_XS] + (size_t)(row - MP) * DM) : out + O_X + (size_t)row * DM;
        const float* md = mods + (size_t)cond_of_row(row) * NMOD;
        f32x4 v[8]; float ss = 0.f;
#pragma unroll
        for (int j = 0; j < 8; ++j) { v[j] = *(const GAS f32x4*)(xr + 4 * (lane + 64 * j)); ss += (v[j].x * v[j].x + v[j].y * v[j].y) + (v[j].z * v[j].z + v[j].w * v[j].w); }
        const float rs = rsqrtf(wave_sum(ss) * (1.f / DM) + EPS);
#pragma unroll
        for (int j = 0; j < 8; ++j) { const int c = 4 * (lane + 64 * j);
            const f32x4 gg = *(const GAS f32x4*)(g + c), sh = *(const GAS f32x4*)(md + c), sc = *(const GAS f32x4*)(md + DM + c);
            const f32x4 y = v[j] * rs * gg * (sc + 1.f) + sh;
            *(GAS v2u*)(H + (size_t)row * DM + c) = (v2u){pk2(y.x, y.y), pk2(y.z, y.w)};
            if (first) *(GAS f32x4*)(out + O_X + (size_t)row * DM + c) = v[j]; }
    }
}

__device__ __forceinline__ void mla_thin_a(const Args& a, int j, int lane, int gw, int NGW) {
    OPAQUE_V(lane); PH_PTRS; OPAQUE_S(gw); OPAQUE_S(NGW);
    const float* QAKV = (const float*)(ws + WS_S + S_QAKV);
    bf16* QAN = (bf16*)(ws + WS_S + S_QAN); bf16* CKVN = (bf16*)(ws + WS_S + S_CKVN); float* KPE = (float*)(ws + WS_S + S_KPE); float* SSK = (float*)(ws + WS_SSK);
    const float* gqa = a.in[I_GQA] + (size_t)j * 768; const float* gkva = a.in[I_GKVA] + (size_t)j * 512;
    for (int row = gw; row < MKV; row += NGW) {
        if (row < MALL) {
            const float* r = QAKV + (size_t)row * 1536;
            { f32x4 v[3]; float ss = 0.f;
#pragma unroll
              for (int i = 0; i < 3; ++i) { v[i] = *(const GAS f32x4*)(r + 4 * (lane + 64 * i)); ss += (v[i].x * v[i].x + v[i].y * v[i].y) + (v[i].z * v[i].z + v[i].w * v[i].w); }
              const float rs = rsqrtf(wave_sum(ss) * (1.f / 768.f) + EPS);
#pragma unroll
              for (int i = 0; i < 3; ++i) { const int c = 4 * (lane + 64 * i); const f32x4 y = v[i] * rs * *(const GAS f32x4*)(gqa + c);
                  *(GAS v2u*)(QAN + (size_t)row * 768 + c) = (v2u){pk2(y.x, y.y), pk2(y.z, y.w)}; } }
            { f32x4 v[2]; float ss = 0.f;
#pragma unroll
              for (int i = 0; i < 2; ++i) { v[i] = *(const GAS f32x4*)(r + 768 + 4 * (lane + 64 * i)); ss += (v[i].x * v[i].x + v[i].y * v[i].y) + (v[i].z * v[i].z + v[i].w * v[i].w); }
              const float rs = rsqrtf(wave_sum(ss) * (1.f / 512.f) + EPS);
#pragma unroll
              for (int i = 0; i < 2; ++i) { const int c = 4 * (lane + 64 * i); const f32x4 y = v[i] * rs * *(const GAS f32x4*)(gkva + c);
                  *(GAS v2u*)(CKVN + (size_t)row * 512 + c) = (v2u){pk2(y.x, y.y), pk2(y.z, y.w)};
                  if (row < MP) *(GAS f32x4*)(out + O_CKV + ((size_t)((row >> 8) * 2 + j) * 256 + (row & 255)) * 512 + c) = y * DBG_SCALE; } }
            { const float kp = r[1280 + lane]; KPE[(size_t)row * 64 + lane] = kp;
              if (row < MP) out[O_KPE + ((size_t)((row >> 8) * 2 + j) * 256 + (row & 255)) * 64 + lane] = kp * DBG_SCALE;
              const float s = wave_sum(kp * kp); if (lane == 0) SSK[row] = s; }
        } else {
            const int cr = row - MALL, b = cr >> 8, t = cr & 255; const size_t src = (size_t)((b * 2 + j) * 256 + t);
            const float* ck = a.in[I_CCKV] + src * 512;
#pragma unroll
            for (int i = 0; i < 2; ++i) { const int c = 4 * (lane + 64 * i); const f32x4 y = *(const GAS f32x4*)(ck + c);
                *(GAS v2u*)(CKVN + (size_t)row * 512 + c) = (v2u){pk2(y.x, y.y), pk2(y.z, y.w)}; }
            const float kp = a.in[I_CKPE][src * 64 + lane]; KPE[(size_t)row * 64 + lane] = kp;
            const float s = wave_sum(kp * kp); if (lane == 0) SSK[row] = s;
        }
    }
}
namespace pg8 {
struct EpiF32 {
    static constexpr bool PERM = false;
    float* C; int ldc;
    __device__ __forceinline__ void operator()(const f32x4 (&acc)[2][2][4][2], const Unit& u, int wr, int wc, int fr, int fq) const {
        const int row0 = u.pm * BM + wr * 64 + fr, col0 = u.pn * BM + wc * 32 + 4 * fq;
#pragma unroll
        for (int ai = 0; ai < 2; ++ai)
#pragma unroll
            for (int m = 0; m < 4; ++m) { float* rowp = C + (size_t)(row0 + ai * HALF + m * 16) * ldc + col0;
#pragma unroll
                for (int bj = 0; bj < 2; ++bj)
#pragma unroll
                    for (int n = 0; n < 2; ++n) *(f32x4*)(rowp + bj * HALF + n * 16) = acc[ai][bj][m][n]; }
    }
};
template <int ACT  > struct EpiBf16 {
    static constexpr bool PERM = true;
    bf16_t* O; int ldc;
    __device__ __forceinline__ void operator()(const f32x4 (&acc)[2][2][4][2], const Unit& u, int wr, int wc, int fr, int fq) const {
        const int row0 = u.pm * BM + wr * 64 + fr, col0 = u.pn * BM + wc * 32 + 8 * fq;
#pragma unroll
        for (int ai = 0; ai < 2; ++ai)
#pragma unroll
            for (int m = 0; m < 4; ++m) { bf16_t* rowp = O + (size_t)(row0 + ai * HALF + m * 16) * ldc + col0;
#pragma unroll
                for (int bj = 0; bj < 2; ++bj) { f32x4 v0 = acc[ai][bj][m][0], v1 = acc[ai][bj][m][1];
                    if (ACT == 1) {
#pragma unroll
                        for (int e = 0; e < 4; ++e) { const float x0 = fmaxf(v0[e], 0.f), x1 = fmaxf(v1[e], 0.f); v0[e] = x0 * x0; v1[e] = x1 * x1; } }
                    u32x4 w; w.x = cvt_pk_bf16(v0[0], v0[1]); w.y = cvt_pk_bf16(v0[2], v0[3]); w.z = cvt_pk_bf16(v1[0], v1[1]); w.w = cvt_pk_bf16(v1[2], v1[3]);
                    *(u32x4*)(rowp + bj * HALF) = w; } }
    }
};
template <bool ATOMIC> struct EpiRes {
    static constexpr bool PERM = false;
    float* X; const float* gate;
    __device__ __forceinline__ void operator()(const f32x4 (&acc)[2][2][4][2], const Unit& u, int wr, int wc, int fr, int fq) const {
        const int rb = u.pm * BM, row0 = rb + wr * 64 + fr, col0 = u.pn * BM + wc * 32 + 4 * fq;
        const int cond = rb < 8192 ? 0 : 1 + ((rb - 8192) >> 11);
        const float* gp = gate + (size_t)cond * 12288 + col0;
        f32x4 gv[2][2];
#pragma unroll
        for (int bj = 0; bj < 2; ++bj)
#pragma unroll
            for (int n = 0; n < 2; ++n) gv[bj][n] = *(const f32x4*)(gp + bj * HALF + n * 16);
#pragma unroll
        for (int ai = 0; ai < 2; ++ai)
#pragma unroll
            for (int m = 0; m < 4; ++m) { float* rowp = X + (size_t)(row0 + ai * HALF + m * 16) * 2048 + col0;
#pragma unroll
                for (int bj = 0; bj < 2; ++bj)
#pragma unroll
                    for (int n = 0; n < 2; ++n) { float* p = rowp + bj * HALF + n * 16; const f32x4 d = gv[bj][n] * acc[ai][bj][m][n];
                        if (ATOMIC) {
#pragma unroll
                            for (int e = 0; e < 4; ++e) __hip_atomic_fetch_add(p + e, d[e], __ATOMIC_RELAXED, __HIP_MEMORY_SCOPE_AGENT);
                        } else { *(f32x4*)p = *(const f32x4*)p + d; } }
                asm volatile("" ::: "memory"); }
    }
};
}
namespace att {
using bf16x8 = __attribute__((ext_vector_type(8))) short;
using s16x4  = __attribute__((ext_vector_type(4))) short;
using f32x16 = __attribute__((ext_vector_type(16))) float;
using u32x4  = __attribute__((ext_vector_type(4))) unsigned;
constexpr int NW = 8, QBLK = 32, KVBLK = 64, DV = 128;
constexpr float THR = 8.f;
constexpr int SHM_V = KVBLK * DV * 2;
constexpr int RPB_OFF = 2 * SHM_V + 2 * KVBLK * 192 * 2 + 2048;
#define ATT_SBAR() __builtin_amdgcn_sched_barrier(0)
__device__ __forceinline__ int crow(int r, int hi) { return (r & 3) + 8 * (r >> 2) + 4 * hi; }
__device__ __forceinline__ unsigned cvtpk(float lo, float hi) { unsigned r; asm volatile("v_cvt_pk_bf16_f32 %0, %1, %2" : "=v"(r) : "v"(lo), "v"(hi)); return r; }
__device__ __forceinline__ int v_st(int k, int c) { const int kk = (k & ~0xC) | ((k & 4) << 1) | ((k & 8) >> 1); return ((kk >> 3) * 4 + (c >> 5)) * 512 + ((kk & 7) * 32 + (c & 31)) * 2; }
__device__ __forceinline__ int v_rd_base(int lane) { return ((lane & 3) << 3) | (((lane >> 2) & 3) << 6) | (((lane >> 4) & 1) << 5) | (((lane >> 5) & 1) << 8); }
constexpr int v_rd_off(int d0, int ks, int half) { return d0 * 512 + ks * 4096 + half * 2048; }
template <int OFF> __device__ __forceinline__ s16x4 tr_read(int vb) { s16x4 r; asm volatile("ds_read_b64_tr_b16 %0, %1 offset:%2" : "=&v"(r) : "v"(vb), "i"(OFF) : "memory"); return r; }
template <int D0> __device__ __forceinline__ void pv_one(f32x16& od, int vb, bf16x8 pa0, bf16x8 pa1, bf16x8 pa2, bf16x8 pa3) {
  const s16x4 l0 = tr_read<v_rd_off(D0, 0, 0)>(vb), h0 = tr_read<v_rd_off(D0, 0, 1)>(vb), l1 = tr_read<v_rd_off(D0, 1, 0)>(vb), h1 = tr_read<v_rd_off(D0, 1, 1)>(vb);
  const s16x4 l2 = tr_read<v_rd_off(D0, 2, 0)>(vb), h2 = tr_read<v_rd_off(D0, 2, 1)>(vb), l3 = tr_read<v_rd_off(D0, 3, 0)>(vb), h3 = tr_read<v_rd_off(D0, 3, 1)>(vb);
  asm volatile("s_waitcnt lgkmcnt(0)" ::: "memory"); ATT_SBAR();
#define ATT_PK(L, H) (bf16x8){L[0], L[1], L[2], L[3], H[0], H[1], H[2], H[3]}
  od = __builtin_amdgcn_mfma_f32_32x32x16_bf16(pa0, ATT_PK(l0, h0), od, 0, 0, 0);
  od = __builtin_amdgcn_mfma_f32_32x32x16_bf16(pa1, ATT_PK(l1, h1), od, 0, 0, 0);
  od = __builtin_amdgcn_mfma_f32_32x32x16_bf16(pa2, ATT_PK(l2, h2), od, 0, 0, 0);
  od = __builtin_amdgcn_mfma_f32_32x32x16_bf16(pa3, ATT_PK(l3, h3), od, 0, 0, 0);
#undef ATT_PK
}
__device__ __forceinline__ void pv_d0(f32x16* o, int vb, bf16x8 pa0, bf16x8 pa1, bf16x8 pa2, bf16x8 pa3) {
  pv_one<0>(o[0], vb, pa0, pa1, pa2, pa3); pv_one<1>(o[1], vb, pa0, pa1, pa2, pa3); pv_one<2>(o[2], vb, pa0, pa1, pa2, pa3); pv_one<3>(o[3], vb, pa0, pa1, pa2, pa3);
}
struct KvSrc { int row0, n0, row1, n1; __device__ __forceinline__ int row(int t) const { const int u = t - n0; return t < n0 ? row0 + 64 * t : row1 + 64 * (u < n1 ? u : n1 - 1); } };
struct NatMask { int rlo, qrow, qcol; const LAS float* rpb; };

template <int DQK, int MODE, int ldq, int ldk, int ldv, int ldo>
__device__ __forceinline__ void attn_unit(const bf16* __restrict__ Qb, const bf16* __restrict__ Kh, const bf16* __restrict__ Vh,
                                          bf16* __restrict__ Ob, const KvSrc src, int NT, const NatMask nm, LAS char* lds, int tid) {
  constexpr float SCALE = DQK == 128 ? 0.088388347648318440f : 0.072168783648703220f;
  constexpr float C = SCALE * 1.4426950408889634f;
  constexpr int KROW = DQK * 2, SHM_K = KVBLK * KROW, NKC = DQK / 8, KCH = KVBLK * NKC / 512, ND0 = DQK / 16;
  const int wid = tid >> 6, lane = tid & 63, r32 = lane & 31, hi = lane >> 5;
  LAS char* V_lds = lds; LAS char* K_lds = lds + 2 * SHM_V;
  LAS float* ws = (LAS float*)(lds + 2 * SHM_V + 2 * SHM_K) + wid * 64; LAS float* li_l = ws; LAS float* al_l = ws + 32;
  float m_reg = -1e30f, l_reg = 0; f32x16 o[4] = {}; bf16x8 qr[ND0];
  { const bf16* Qw = Qb + (size_t)(wid * QBLK + r32) * ldq + hi * 8;
#pragma unroll
    for (int d0 = 0; d0 < ND0; ++d0) qr[d0] = *reinterpret_cast<const bf16x8*>(Qw + d0 * 16); }
  const int sr = tid >> 4, sc = (tid & 15) * 8, vst0 = v_st(sr, sc), vst1 = v_st(32 + sr, sc);
  unsigned koff_[KCH], kst_[KCH]; const unsigned voff0 = (unsigned)(sr * ldv + sc);
#pragma unroll
  for (int i = 0; i < KCH; ++i) { const int c = tid + 512 * i, kr = c / NKC, kc = c % NKC; koff_[i] = (unsigned)(kr * ldk + kc * 8); kst_[i] = (unsigned)(kr * KROW + ((kc * 16) ^ ((kr & 7) << 4))); }
  const int vb0 = (int)(uintptr_t)V_lds + v_rd_base(lane);
  bf16x8 svs0, svs1, sks[KCH];
#define ATT_SLOAD(t) do { const int _r = __builtin_amdgcn_readfirstlane(src.row(t)); const bf16* _vt = Vh + (size_t)_r * ldv; const bf16* _kt = Kh + (size_t)_r * ldk; \
    svs0 = *reinterpret_cast<const bf16x8*>(_vt + voff0); svs1 = *reinterpret_cast<const bf16x8*>(_vt + 32 * ldv + voff0); \
    _Pragma("unroll") for (int _i = 0; _i < KCH; ++_i) sks[_i] = *reinterpret_cast<const bf16x8*>(_kt + koff_[_i]); } while (0)
#define ATT_SWRITE(b) do { *(LAS bf16x8*)(V_lds + (b) * SHM_V + vst0) = svs0; *(LAS bf16x8*)(V_lds + (b) * SHM_V + vst1) = svs1; \
    _Pragma("unroll") for (int _i = 0; _i < KCH; ++_i) *(LAS bf16x8*)(K_lds + (b) * SHM_K + kst_[_i]) = sks[_i]; } while (0)
#define ATT_RESC(a) do { if (__any((a) < 1.f)) { if (hi == 0) al_l[r32] = (a); asm volatile("s_waitcnt lgkmcnt(0)" ::: "memory"); \
    _Pragma("unroll") for (int d = 0; d < 4; ++d) _Pragma("unroll") for (int r = 0; r < 16; ++r) o[d][r] *= al_l[crow(r, hi)]; } } while (0)
  auto qkt = [&](f32x16& p0, f32x16& p1, int b, int t) {
    const LAS char* Ks = K_lds + b * SHM_K;
    p0 = f32x16{}; p1 = f32x16{};
#pragma unroll
    for (int d0 = 0; d0 < ND0; ++d0) { const int cb = (d0 * 16 + hi * 8) * 2;
      const bf16x8 b0 = *reinterpret_cast<const LAS bf16x8*>(Ks + r32 * KROW + (cb ^ ((r32 & 7) << 4)));
      const bf16x8 b1 = *reinterpret_cast<const LAS bf16x8*>(Ks + (32 + r32) * KROW + (cb ^ ((r32 & 7) << 4)));
      p0 = __builtin_amdgcn_mfma_f32_32x32x16_bf16(b0, qr[d0], p0, 0, 0, 0);
      p1 = __builtin_amdgcn_mfma_f32_32x32x16_bf16(b1, qr[d0], p1, 0, 0, 0); }
    if constexpr (MODE == 1) {
      const int i = t - src.n0;
      if (i >= 0) {
        const int kr = nm.rlo + i, r0q = min(max(nm.qrow - 4, 0), 24), c0q = min(max(nm.qcol - 8, 0), 48);
        const bool rowok = (i < src.n1) && (kr >= r0q) && (kr < r0q + 8);
        const int rowoff = (kr - nm.qrow + 7) * 31 + 15 - nm.qcol;
#pragma unroll
        for (int r = 0; r < 16; ++r) {
          const int kc0 = crow(r, hi), kc1 = kc0 + 32;
          const bool ok0 = rowok && ((unsigned)(kc0 - c0q) < 16u), ok1 = rowok && ((unsigned)(kc1 - c0q) < 16u);
          const float b0 = nm.rpb[ok0 ? rowoff + kc0 : 0], b1 = nm.rpb[ok1 ? rowoff + kc1 : 0];
          p0[r] = ok0 ? p0[r] + b0 : -1e30f; p1[r] = ok1 ? p1[r] + b1 : -1e30f; }
      }
    }
  };
  auto partialSM = [&](f32x16& p0, f32x16& p1, float& mn, float& alpha) {
    float pmax = p0[0];
#pragma unroll
    for (int r = 1; r < 16; ++r) pmax = fmaxf(pmax, p0[r]);
#pragma unroll
    for (int r = 0; r < 16; ++r) pmax = fmaxf(pmax, p1[r]);
    { auto rr = __builtin_amdgcn_permlane32_swap(__float_as_uint(pmax), __float_as_uint(pmax), false, false); pmax = fmaxf(__uint_as_float(rr[0]), __uint_as_float(rr[1])); }
    if (__builtin_expect(__all(pmax - m_reg <= THR / SCALE), 1)) { mn = m_reg; alpha = 1.f; }
    else { mn = fmaxf(m_reg, pmax); alpha = __builtin_amdgcn_exp2f((m_reg - mn) * C); m_reg = mn; }
    const float mnC = -mn * C;
#pragma unroll
    for (int r = 0; r < 16; ++r) p0[r] = fmaf(p0[r], C, mnC);
#pragma unroll
    for (int r = 0; r < 16; ++r) p1[r] = fmaf(p1[r], C, mnC);
#pragma unroll
    for (int r = 0; r < 16; ++r) p0[r] = __builtin_amdgcn_exp2f(p0[r]);
  };
  auto finishSM = [&](f32x16& p0, f32x16& p1, float alpha, bf16x8& pa0, bf16x8& pa1, bf16x8& pa2, bf16x8& pa3) {
#pragma unroll
    for (int r = 0; r < 16; ++r) p1[r] = __builtin_amdgcn_exp2f(p1[r]);
    float ps = 0;
#pragma unroll
    for (int r = 0; r < 16; ++r) ps += p0[r];
#pragma unroll
    for (int r = 0; r < 16; ++r) ps += p1[r];
    { auto rr = __builtin_amdgcn_permlane32_swap(__float_as_uint(ps), __float_as_uint(ps), false, false); ps = __uint_as_float(rr[0]) + __uint_as_float(rr[1]); }
    l_reg = l_reg * alpha + ps;
#define ATT_PK4(P, BASE, OUT) do { unsigned a0 = cvtpk(P[BASE + 0], P[BASE + 1]), a1 = cvtpk(P[BASE + 2], P[BASE + 3]); \
    unsigned b0 = cvtpk(P[BASE + 4], P[BASE + 5]), b1 = cvtpk(P[BASE + 6], P[BASE + 7]); \
    auto r0 = __builtin_amdgcn_permlane32_swap(a0, b0, false, false); auto r1 = __builtin_amdgcn_permlane32_swap(a1, b1, false, false); \
    u32x4 w = {r0[0], r1[0], r0[1], r1[1]}; OUT = *reinterpret_cast<bf16x8*>(&w); } while (0)
    ATT_PK4(p0, 0, pa0); ATT_PK4(p0, 8, pa1); ATT_PK4(p1, 0, pa2); ATT_PK4(p1, 8, pa3);
#undef ATT_PK4
  };
  f32x16 p0, p1; float mn, al; bf16x8 pa0, pa1, pa2, pa3;
  ATT_SLOAD(0); asm volatile("s_waitcnt vmcnt(0)" ::: "memory"); ATT_SWRITE(0); if (NT > 1) ATT_SLOAD(1); __syncthreads();
  for (int t = 0; t < NT; ++t) {
    const int b = t & 1;
    ATT_SBAR(); qkt(p0, p1, b, t); ATT_SBAR();
    if (t + 1 < NT) { asm volatile("s_waitcnt vmcnt(0)" ::: "memory"); ATT_SWRITE(b ^ 1); if (t + 2 < NT) ATT_SLOAD(t + 2); }
    ATT_SBAR();
    partialSM(p0, p1, mn, al); ATT_RESC(al);
    finishSM(p0, p1, al, pa0, pa1, pa2, pa3); ATT_SBAR();
    pv_d0(o, vb0 + b * SHM_V, pa0, pa1, pa2, pa3);
    __syncthreads();
  }
  if (hi == 0) li_l[r32] = l_reg; asm volatile("s_waitcnt lgkmcnt(0)" ::: "memory");
  int hi_o = hi; asm volatile("" : "+v"(hi_o));
  bf16* Ow = Ob + (size_t)(wid * QBLK + 4 * hi_o) * ldo;
#pragma unroll
  for (int r = 0; r < 16; ++r) { const int orow = crow(r, 0); const float rl = __builtin_amdgcn_rcpf(li_l[orow + 4 * hi_o]);
#pragma unroll
    for (int d0 = 0; d0 < 4; ++d0) { const float v = o[d0][r] * rl; Ow[(size_t)orow * ldo + d0 * 32 + r32] = (bf16)(cvtpk(v, v) & 0xffffu); } }
#undef ATT_SLOAD
#undef ATT_SWRITE
#undef ATT_RESC
}
}
__device__ __forceinline__ void rope_table(const Args& a, int tid, int vcu, int G) {
    f32x2* RT = (f32x2*)(a.ws + WS_ROPE);
    for (int e = vcu * NTHR + tid; e < 2048 * 32; e += G * NTHR) { const int t = e >> 5, i = e & 31;
        const float inv = exp2f(-(float)(i & 15) * (13.287712379549449f / 16.f));
        const float ang = (float)(i < 16 ? (t >> 6) : (t & 63)) * inv; float s, c; sincosf(ang, &s, &c); RT[e] = (f32x2){c, s}; }
}
__device__ __forceinline__ void mla_thin_b(const Args& a, int j, int lane, int gw, int NGW) {
    OPAQUE_V(lane); PH_PTRS; OPAQUE_S(gw); OPAQUE_S(NGW);
    const bf16* QRAW = (const bf16*)(ws + WS_S + S_QRAW); bf16* QN = (bf16*)(ws + WS_S + S_QN);
    const bf16* KVRAW = (const bf16*)(ws + WS_S + S_KVRAW); bf16* KF = (bf16*)(ws + WS_S + S_KF);
    const float* KPE = (const float*)(ws + WS_S + S_KPE); const float* SSK = (const float*)(ws + WS_SSK);
    const f32x2* RT = (const f32x2*)(ws + WS_ROPE);
    const float* gqn = a.in[I_GQN] + (size_t)j * 192; const float* gkn = a.in[I_GKN] + (size_t)j * 192;
    const int grp = lane >> 4, s = lane & 15;
    float gq[12], gk[12];
#pragma unroll
    for (int e = 0; e < 8; ++e) { gq[e] = gqn[8 * s + e]; gk[e] = gkn[8 * s + e]; }
    gq[8] = gqn[128 + 2 * s]; gq[9] = gqn[129 + 2 * s]; gq[10] = gqn[160 + 2 * s]; gq[11] = gqn[161 + 2 * s];
    gk[8] = gkn[128 + 2 * s]; gk[9] = gkn[129 + 2 * s]; gk[10] = gkn[160 + 2 * s]; gk[11] = gkn[161 + 2 * s];
    const int NQI = MALL * 4, NKI = MKV * 4;
    for (int it = gw; it < NQI + NKI; it += NGW) {
        const bool isq = it < NQI; const int r4 = isq ? it : it - NQI; const int row = r4 >> 2, h = (r4 & 3) * 4 + grp;
        float x[12];
        if (isq) {
            const bf16* p = QRAW + (size_t)row * 3072 + h * 192;
            const v4u w = *(const GAS v4u*)(p + 8 * s); const unsigned w1 = *(const GAS unsigned*)(p + 128 + 2 * s), w2 = *(const GAS unsigned*)(p + 160 + 2 * s);
            x[0] = bf_lo(w.x); x[1] = bf_hi(w.x); x[2] = bf_lo(w.y); x[3] = bf_hi(w.y); x[4] = bf_lo(w.z); x[5] = bf_hi(w.z); x[6] = bf_lo(w.w); x[7] = bf_hi(w.w);
            x[8] = bf_lo(w1); x[9] = bf_hi(w1); x[10] = bf_lo(w2); x[11] = bf_hi(w2);
        } else {
            const bf16* p = KVRAW + (size_t)row * 4096 + h * 256;
            const v4u w = *(const GAS v4u*)(p + 8 * s);
            x[0] = bf_lo(w.x); x[1] = bf_hi(w.x); x[2] = bf_lo(w.y); x[3] = bf_hi(w.y); x[4] = bf_lo(w.z); x[5] = bf_hi(w.z); x[6] = bf_lo(w.w); x[7] = bf_hi(w.w);
            const f32x2 k1 = *(const GAS f32x2*)(KPE + (size_t)row * 64 + 2 * s), k2 = *(const GAS f32x2*)(KPE + (size_t)row * 64 + 32 + 2 * s);
            x[8] = k1.x; x[9] = k1.y; x[10] = k2.x; x[11] = k2.y;
        }
        float ss = 0.f;
#pragma unroll
        for (int e = 0; e < 8; ++e) ss += x[e] * x[e];
        if (isq) { ss += x[8] * x[8] + x[9] * x[9] + x[10] * x[10] + x[11] * x[11]; ss = sum16(ss); }
        else { ss = sum16(ss) + SSK[row]; }
        const float rs = rsqrtf(ss * (1.f / 192.f) + EPS);
#pragma unroll
        for (int e = 0; e < 12; ++e) x[e] = x[e] * rs * (isq ? gq[e] : gk[e]);
        if (row >= MP && row < MALL) {
            const int t = (row - MP) & 2047; const f32x2 cs0 = RT[t * 32 + 2 * s], cs1 = RT[t * 32 + 2 * s + 1];
            const float a0 = x[8] * cs0.x - x[10] * cs0.y, b0 = x[8] * cs0.y + x[10] * cs0.x, a1 = x[9] * cs1.x - x[11] * cs1.y, b1 = x[9] * cs1.y + x[11] * cs1.x;
            x[8] = a0; x[9] = a1; x[10] = b0; x[11] = b1;
        }
        bf16* o = (isq ? QN : KF) + (size_t)row * 3072 + h * 192;
        *(GAS v4u*)(o + 8 * s) = (v4u){pk2(x[0], x[1]), pk2(x[2], x[3]), pk2(x[4], x[5]), pk2(x[6], x[7])};
        *(GAS unsigned*)(o + 128 + 2 * s) = pk2(x[8], x[9]); *(GAS unsigned*)(o + 160 + 2 * s) = pk2(x[10], x[11]);
    }
}
__device__ __forceinline__ void mla_attn_phase(const Args& a, LAS unsigned char* lds, int tid, int vcu, int G) {
    OPAQUE_V(tid); PH_PTRS; OPAQUE_S(vcu); OPAQUE_S(G);
    const bf16* QN = (const bf16*)(ws + WS_S + S_QN); const bf16* KF = (const bf16*)(ws + WS_S + S_KF); const bf16* KVRAW = (const bf16*)(ws + WS_S + S_KVRAW);
    bf16* AO = (bf16*)(ws + WS_S + S_AO);
    for (int u = vcu; u < 768; u += G) {
        int q0, h, NT; att::KvSrc src;
        if (u < 256) { const int b = u >> 7, qb = u & 7; h = (u >> 3) & 15; q0 = MP + b * 2048 + qb * 256; src = att::KvSrc{MP + b * 2048, 32, MALL + b * 256, 4}; NT = 36; }
        else { const int v = u - 256, b = v >> 4; h = v & 15; q0 = b * 256; src = att::KvSrc{b * 256, 4, 0, 1}; NT = 4; }
        att::attn_unit<192, 0, 3072, 3072, 4096, DM>(QN + (size_t)q0 * 3072 + h * 192, KF + h * 192, KVRAW + h * 256 + 128, AO + (size_t)q0 * DM + h * 128, src, NT, att::NatMask{0, 0, 0, nullptr}, (LAS char*)lds, tid);
    }
}
namespace pg8 {
struct EpiHg {
    static constexpr bool PERM = true;
    unsigned char* ws;
    __device__ __forceinline__ void operator()(const f32x4 (&acc)[2][2][4][2], const Unit& u, int wr, int wc, int fr, int fq) const {
        const int region = u.pn >> 3, row0 = u.pm * BM + wr * 64 + fr, col0 = (u.pn & 7) * BM + wc * 32 + 8 * fq;
        if (region == 1 || region == 2) {
            const int d = region - 1;
            f32x4 lbv[2][2];
#pragma unroll
            for (int bj = 0; bj < 2; ++bj)
#pragma unroll
                for (int n = 0; n < 2; ++n) lbv[bj][n] = *(const f32x4*)((const float*)(ws + WS_LB) + d * 2048 + col0 + bj * HALF + 4 * n);
            bf16_t* K = (bf16_t*)(ws + WS_S + S_HK) + (size_t)d * 12288 * 2048; float* Gd = (float*)(ws + WS_U) + (size_t)d * 12288 * 2048;
#pragma unroll
            for (int ai = 0; ai < 2; ++ai)
#pragma unroll
                for (int m = 0; m < 4; ++m) { const size_t ro = (size_t)(row0 + ai * HALF + m * 16) * 2048 + col0;
#pragma unroll
                    for (int bj = 0; bj < 2; ++bj) { f32x4 kk[2], gg[2];
#pragma unroll
                        for (int n = 0; n < 2; ++n)
#pragma unroll
                            for (int e = 0; e < 4; ++e) { const float z = acc[ai][bj][m][n][e]; const float sn = __builtin_amdgcn_rcpf(1.f + __expf(z));
                                const float k = (1.f - lbv[bj][n][e]) * sn; kk[n][e] = k; gg[n][e] = __log2f(1.f - k); }
                        u32x4 w; w.x = cvt_pk_bf16(kk[0][0], kk[0][1]); w.y = cvt_pk_bf16(kk[0][2], kk[0][3]); w.z = cvt_pk_bf16(kk[1][0], kk[1][1]); w.w = cvt_pk_bf16(kk[1][2], kk[1][3]);
                        *(u32x4*)(K + ro + bj * HALF) = w; *(f32x4*)(Gd + ro + bj * HALF) = gg[0]; *(f32x4*)(Gd + ro + bj * HALF + 4) = gg[1]; } }
        } else {
            bf16_t* O = (bf16_t*)(ws + WS_S + (region == 0 ? S_HQ : region == 3 ? S_HV : S_HGS)); const bool act = region != 3;
#pragma unroll
            for (int ai = 0; ai < 2; ++ai)
#pragma unroll
                for (int m = 0; m < 4; ++m) { bf16_t* rowp = O + (size_t)(row0 + ai * HALF + m * 16) * 2048 + col0;
#pragma unroll
                    for (int bj = 0; bj < 2; ++bj) { f32x4 v0 = acc[ai][bj][m][0], v1 = acc[ai][bj][m][1];
                        if (act) {
#pragma unroll
                            for (int e = 0; e < 4; ++e) { v0[e] = v0[e] * __builtin_amdgcn_rcpf(1.f + __expf(-v0[e])); v1[e] = v1[e] * __builtin_amdgcn_rcpf(1.f + __expf(-v1[e])); } }
                        u32x4 w; w.x = cvt_pk_bf16(v0[0], v0[1]); w.y = cvt_pk_bf16(v0[2], v0[3]); w.z = cvt_pk_bf16(v1[0], v1[1]); w.w = cvt_pk_bf16(v1[2], v1[3]);
                        *(u32x4*)(rowp + bj * HALF) = w; } }
        }
    }
};
}

namespace hg {
constexpr int PQ = 272, PK = 80;
constexpr int OFF_QS = 0, OFF_QM = 32 * PQ, OFF_KM = 2 * 32 * PQ, OFF_KE = 3 * 32 * PQ, OFF_VT = OFF_KE + 128 * PK, OFF_ATT = OFF_VT + 128 * PK, OFF_EL = OFF_ATT + 32 * PK, BUF = OFF_EL + 512;
constexpr int OFF_TOT = 2 * BUF;
static_assert(OFF_TOT + 2048 <= 131072, "scan LDS");
typedef short bf16x8 __attribute__((ext_vector_type(8)));
struct Chain { int rb, N, d, h; const float* S0; float* Sout; };

__device__ __forceinline__ void scan_chain(const Chain ch, const bf16* __restrict__ HQ, const bf16* __restrict__ HK, const float* __restrict__ HG, const bf16* __restrict__ HV,
                                           float* __restrict__ OD, LAS unsigned char* lds, int tid) {
    const int lane = tid & 63, w = tid >> 6, l15 = lane & 15, q4 = lane >> 4;
    const int k = tid & 127, seg = tid >> 7;
    const int vt = tid >> 4, v8 = (tid & 15) * 8;
    const int nc = ch.N >> 5, hc = ch.h * 128;
    f32x4 S[8];
    if (ch.S0) {
#pragma unroll
        for (int kt = 0; kt < 8; ++kt)
#pragma unroll
            for (int r = 0; r < 4; ++r) S[kt][r] = ch.S0[(size_t)(16 * kt + 4 * q4 + r) * 128 + 16 * w + l15];
    } else {
#pragma unroll
        for (int kt = 0; kt < 8; ++kt) S[kt] = (f32x4){0.f, 0.f, 0.f, 0.f};
    }
    float g_[8]; unsigned short q_[8], k_[8]; v4u v_;
#define HG_ROW(c, t) (ch.rb + (ch.d ? ch.N - 1 - (32 * (c) + (t)) : 32 * (c) + (t)))
#define HG_LOAD(c) do { _Pragma("unroll") for (int i = 0; i < 8; ++i) { const size_t o_ = (size_t)HG_ROW(c, 8 * seg + i) * 2048 + hc + k; g_[i] = HG[o_]; q_[i] = HQ[o_]; k_[i] = HK[o_]; } \
        v_ = *(const GAS v4u*)(HV + (size_t)HG_ROW(c, vt) * 2048 + hc + v8); } while (0)
    HG_LOAD(0);
    LAS float* TOT = (LAS float*)(lds + hg::OFF_TOT);
    for (int c = 0; c < nc; ++c) {
        LAS unsigned char* B = lds + (c & 1) * BUF;
        float cl[8]; float run = 0.f;
#pragma unroll
        for (int i = 0; i < 8; ++i) { run += g_[i]; cl[i] = run; }
        TOT[seg * 128 + k] = run;
        float qf[8], kf[8];
#pragma unroll
        for (int i = 0; i < 8; ++i) { qf[i] = __uint_as_float((unsigned)q_[i] << 16); kf[i] = __uint_as_float((unsigned)k_[i] << 16); }
        const v4u vv = v_;
        if (c + 1 < nc) HG_LOAD(c + 1);
        LDS_WAIT(); __builtin_amdgcn_s_barrier(); asm volatile("" ::: "memory");
        const float t0 = TOT[k], t1 = TOT[128 + k], t2 = TOT[256 + k], t3 = TOT[384 + k];
        const float off = seg == 0 ? 0.f : seg == 1 ? t0 : seg == 2 ? t0 + t1 : t0 + t1 + t2;
        const float cm = t0 + t1, last = (t0 + t1) + (t2 + t3);
        unsigned short ke[8];
#pragma unroll
        for (int i = 0; i < 8; ++i) { const float cu = off + cl[i]; const int t = 8 * seg + i;
            const float eq = __builtin_amdgcn_exp2f(cu), eqm = __builtin_amdgcn_exp2f(cu - cm), ekm = __builtin_amdgcn_exp2f(cm - cu), eke = __builtin_amdgcn_exp2f(last - cu);
            *(LAS unsigned short*)(B + OFF_QS + t * PQ + k * 2) = (unsigned short)(pk2(qf[i] * eq, 0.f) & 0xffffu);
            *(LAS unsigned short*)(B + OFF_QM + t * PQ + k * 2) = (unsigned short)(pk2(qf[i] * eqm, 0.f) & 0xffffu);
            *(LAS unsigned short*)(B + OFF_KM + t * PQ + k * 2) = (unsigned short)(pk2(kf[i] * ekm, 0.f) & 0xffffu);
            ke[i] = (unsigned short)(pk2(kf[i] * eke, 0.f) & 0xffffu); }
        *(LAS v4u*)(B + OFF_KE + k * PK + seg * 16) = (v4u){(unsigned)ke[0] | ((unsigned)ke[1] << 16), (unsigned)ke[2] | ((unsigned)ke[3] << 16), (unsigned)ke[4] | ((unsigned)ke[5] << 16), (unsigned)ke[6] | ((unsigned)ke[7] << 16)};
        if (seg == 0) *(LAS float*)(B + OFF_EL + k * 4) = __builtin_amdgcn_exp2f(last);
        { const unsigned vw[4] = {vv.x, vv.y, vv.z, vv.w};
#pragma unroll
          for (int e = 0; e < 8; ++e) *(LAS unsigned short*)(B + OFF_VT + (v8 + e) * PK + vt * 2) = (unsigned short)((vw[e >> 1] >> ((e & 1) * 16)) & 0xffffu); }
        LDS_WAIT(); __builtin_amdgcn_s_barrier(); asm volatile("" ::: "memory");
        if (w < 4) {
            const int tt = w >> 1, st = w & 1; f32x4 at = (f32x4){0.f, 0.f, 0.f, 0.f};
            if (!(tt == 0 && st == 1)) {
#pragma unroll
                for (int ks = 0; ks < 4; ++ks) {
                    const bf16x8 af = *(const LAS bf16x8*)(B + OFF_QM + (16 * tt + l15) * PQ + (32 * ks + 8 * q4) * 2);
                    const bf16x8 bfr = *(const LAS bf16x8*)(B + OFF_KM + (16 * st + l15) * PQ + (32 * ks + 8 * q4) * 2);
                    at = __builtin_amdgcn_mfma_f32_16x16x32_bf16(af, bfr, at, 0, 0, 0); }
            }
            const int s = 16 * st + l15;
#pragma unroll
            for (int r = 0; r < 4; ++r) { const int t = 16 * tt + 4 * q4 + r; const float val = (s <= t) ? at[r] : 0.f;
                *(LAS unsigned short*)(B + OFF_ATT + t * PK + s * 2) = (unsigned short)(pk2(val, 0.f) & 0xffffu); }
        }
        LDS_WAIT(); __builtin_amdgcn_s_barrier(); asm volatile("" ::: "memory");
        const bf16x8 bv = *(const LAS bf16x8*)(B + OFF_VT + (16 * w + l15) * PK + 16 * q4);
        f32x4 o2[2];
#pragma unroll
        for (int tt = 0; tt < 2; ++tt) { const bf16x8 aa = *(const LAS bf16x8*)(B + OFF_ATT + (16 * tt + l15) * PK + 16 * q4);
            o2[tt] = __builtin_amdgcn_mfma_f32_16x16x32_bf16(aa, bv, (f32x4){0.f, 0.f, 0.f, 0.f}, 0, 0, 0); }
#pragma unroll
        for (int ks = 0; ks < 4; ++ks) {
            const v4u sb = (v4u){pk2(S[2 * ks][0], S[2 * ks][1]), pk2(S[2 * ks][2], S[2 * ks][3]), pk2(S[2 * ks + 1][0], S[2 * ks + 1][1]), pk2(S[2 * ks + 1][2], S[2 * ks + 1][3])};
            const bf16x8 bs = __builtin_bit_cast(bf16x8, sb);
#pragma unroll
            for (int tt = 0; tt < 2; ++tt) {
                const v2u a0 = *(const LAS v2u*)(B + OFF_QS + (16 * tt + l15) * PQ + (32 * ks + 4 * q4) * 2), a1 = *(const LAS v2u*)(B + OFF_QS + (16 * tt + l15) * PQ + (32 * ks + 16 + 4 * q4) * 2);
                const bf16x8 aq = __builtin_bit_cast(bf16x8, ((v4u){a0.x, a0.y, a1.x, a1.y}));
                o2[tt] = __builtin_amdgcn_mfma_f32_16x16x32_bf16(aq, bs, o2[tt], 0, 0, 0); }
        }
#pragma unroll
        for (int kt = 0; kt < 8; ++kt) { const f32x4 el = *(const LAS f32x4*)(B + OFF_EL + (16 * kt + 4 * q4) * 4);
            const bf16x8 ak = *(const LAS bf16x8*)(B + OFF_KE + (16 * kt + l15) * PK + 16 * q4);
            S[kt] = __builtin_amdgcn_mfma_f32_16x16x32_bf16(ak, bv, S[kt] * el, 0, 0, 0); }
#pragma unroll
        for (int tt = 0; tt < 2; ++tt)
#pragma unroll
            for (int r = 0; r < 4; ++r) OD[(size_t)HG_ROW(c, 16 * tt + 4 * q4 + r) * 2048 + hc + 16 * w + l15] = o2[tt][r];
    }
    if (ch.Sout) {
#pragma unroll
        for (int kt = 0; kt < 8; ++kt)
#pragma unroll
            for (int r = 0; r < 4; ++r) ch.Sout[(size_t)(16 * kt + 4 * q4 + r) * 128 + 16 * w + l15] = S[kt][r] * DBG_SCALE;
    }
#undef HG_ROW
#undef HG_LOAD
}
}

__device__ __forceinline__ void hg_scan_phase(const Args& a, LAS unsigned char* lds, int tid, int vcu, int G) {
    OPAQUE_V(tid); PH_PTRS; OPAQUE_S(vcu); OPAQUE_S(G);
    const bf16* HQ = (const bf16*)(ws + WS_S + S_HQ); const bf16* HK = (const bf16*)(ws + WS_S + S_HK); const float* HGp = (const float*)(ws + WS_U);
    const bf16* HV = (const bf16*)(ws + WS_S + S_HV); float* OF = (float*)(ws + WS_S + S_OF);
    const int NS = G > 128 ? 64 : 0;
    if (vcu < NS) {
        const int b = vcu >> 5, d = (vcu >> 4) & 1, h = vcu & 15;
        hg::Chain ch{MP + b * 2048, 2048, d, h, a.in[I_SHG] + ((size_t)((b * 2 + d) * 16 + h)) * 16384, nullptr};
        hg::scan_chain(ch, HQ, HK + (size_t)d * MALL * DM, HGp + (size_t)d * MALL * DM, HV, OF + (size_t)d * MALL * DM, lds, tid);
    } else {
        for (int pc = vcu - NS; pc < 1024 + (NS ? 0 : 64); pc += G - NS) {
            if (pc >= 1024) { const int sc = pc - 1024, b = sc >> 5, d = (sc >> 4) & 1, h = sc & 15;
                hg::Chain ch{MP + b * 2048, 2048, d, h, a.in[I_SHG] + ((size_t)((b * 2 + d) * 16 + h)) * 16384, nullptr};
                hg::scan_chain(ch, HQ, HK + (size_t)d * MALL * DM, HGp + (size_t)d * MALL * DM, HV, OF + (size_t)d * MALL * DM, lds, tid);
            } else { const int b = pc >> 5, d = (pc >> 4) & 1, h = pc & 15;
                hg::Chain ch{b * 256, 256, d, h, nullptr, out + O_HG + ((size_t)((b * 2 + d) * 16 + h)) * 16384};
                hg::scan_chain(ch, HQ, HK + (size_t)d * MALL * DM, HGp + (size_t)d * MALL * DM, HV, OF + (size_t)d * MALL * DM, lds, tid); }
        }
    }
}

__device__ __forceinline__ void hg_thin_c(const Args& a, int lane, int gw, int NGW) {
    OPAQUE_V(lane); PH_PTRS; OPAQUE_S(gw); OPAQUE_S(NGW);
    const float* OF = (const float*)(ws + WS_S + S_OF); const bf16* HGS = (const bf16*)(ws + WS_S + S_HGS); bf16* AO = (bf16*)(ws + WS_S + S_AO);
    const int grp = lane >> 4, s = lane & 15;
    const f32x4 g0 = *(const GAS f32x4*)(a.in[I_GHO] + 8 * s), g1 = *(const GAS f32x4*)(a.in[I_GHO] + 8 * s + 4);
    for (int it = gw; it < MALL * 4; it += NGW) {
        const int row = it >> 2, h = (it & 3) * 4 + grp; const size_t o_ = (size_t)row * DM + h * 128 + 8 * s;
        const f32x4 a0 = *(const GAS f32x4*)(OF + o_) + *(const GAS f32x4*)(OF + (size_t)MALL * DM + o_), a1 = *(const GAS f32x4*)(OF + o_ + 4) + *(const GAS f32x4*)(OF + (size_t)MALL * DM + o_ + 4);
        float ss = (a0.x * a0.x + a0.y * a0.y) + (a0.z * a0.z + a0.w * a0.w) + (a1.x * a1.x + a1.y * a1.y) + (a1.z * a1.z + a1.w * a1.w);
        const float rs = rsqrtf(sum16(ss) * (1.f / 128.f) + EPS);
        const v4u gw_ = *(const GAS v4u*)(HGS + o_);
        const f32x4 y0 = a0 * rs * g0 * (f32x4){bf_lo(gw_.x), bf_hi(gw_.x), bf_lo(gw_.y), bf_hi(gw_.y)}, y1 = a1 * rs * g1 * (f32x4){bf_lo(gw_.z), bf_hi(gw_.z), bf_lo(gw_.w), bf_hi(gw_.w)};
        *(GAS v4u*)(AO + o_) = (v4u){pk2(y0.x, y0.y), pk2(y0.z, y0.w), pk2(y1.x, y1.y), pk2(y1.z, y1.w)};
    }
}
__device__ __forceinline__ void nat_thin_d(const Args& a, int lane, int gw, int NGW) {
    OPAQUE_V(lane); PH_PTRS; OPAQUE_S(gw); OPAQUE_S(NGW);
    bf16* QKV = (bf16*)(ws + WS_S + S_NQKV); bf16* QN = (bf16*)(ws + WS_S + S_NQN); bf16* KN = (bf16*)(ws + WS_S + S_NKN);
    const int grp = lane >> 4, s = lane & 15;
    const f32x4 gq0 = *(const GAS f32x4*)(a.in[I_GNQ] + 8 * s), gq1 = *(const GAS f32x4*)(a.in[I_GNQ] + 8 * s + 4), gk0 = *(const GAS f32x4*)(a.in[I_GNK] + 8 * s), gk1 = *(const GAS f32x4*)(a.in[I_GNK] + 8 * s + 4);
    for (int it = gw; it < MKV * 4; it += NGW) {
        const int row = it >> 2, h = (it & 3) * 4 + grp, c = h * 128 + 8 * s;
        if (row < MALL) {
            const v4u qw = *(const GAS v4u*)(QKV + (size_t)row * 6144 + c), kw = *(const GAS v4u*)(QKV + (size_t)row * 6144 + 2048 + c);
            f32x4 q0 = {bf_lo(qw.x), bf_hi(qw.x), bf_lo(qw.y), bf_hi(qw.y)}, q1 = {bf_lo(qw.z), bf_hi(qw.z), bf_lo(qw.w), bf_hi(qw.w)};
            f32x4 k0 = {bf_lo(kw.x), bf_hi(kw.x), bf_lo(kw.y), bf_hi(kw.y)}, k1 = {bf_lo(kw.z), bf_hi(kw.z), bf_lo(kw.w), bf_hi(kw.w)};
            const float sq = (q0.x * q0.x + q0.y * q0.y) + (q0.z * q0.z + q0.w * q0.w) + (q1.x * q1.x + q1.y * q1.y) + (q1.z * q1.z + q1.w * q1.w);
            const float sk = (k0.x * k0.x + k0.y * k0.y) + (k0.z * k0.z + k0.w * k0.w) + (k1.x * k1.x + k1.y * k1.y) + (k1.z * k1.z + k1.w * k1.w);
            const float rq = rsqrtf(sum16(sq) * (1.f / 128.f) + EPS), rk = rsqrtf(sum16(sk) * (1.f / 128.f) + EPS);
            q0 = q0 * rq * gq0; q1 = q1 * rq * gq1; k0 = k0 * rk * gk0; k1 = k1 * rk * gk1;
            *(GAS v4u*)(QN + (size_t)row * DM + c) = (v4u){pk2(q0.x, q0.y), pk2(q0.z, q0.w), pk2(q1.x, q1.y), pk2(q1.z, q1.w)};
            *(GAS v4u*)(KN + (size_t)row * DM + c) = (v4u){pk2(k0.x, k0.y), pk2(k0.z, k0.w), pk2(k1.x, k1.y), pk2(k1.z, k1.w)};
            if (row < MP) {
                *(GAS f32x4*)(out + O_NK + (size_t)row * DM + c) = k0 * DBG_SCALE; *(GAS f32x4*)(out + O_NK + (size_t)row * DM + c + 4) = k1 * DBG_SCALE;
                const v4u vw = *(const GAS v4u*)(QKV + (size_t)row * 6144 + 4096 + c);
                *(GAS f32x4*)(out + O_NV + (size_t)row * DM + c) = (f32x4){bf_lo(vw.x), bf_hi(vw.x), bf_lo(vw.y), bf_hi(vw.y)} * DBG_SCALE;
                *(GAS f32x4*)(out + O_NV + (size_t)row * DM + c + 4) = (f32x4){bf_lo(vw.z), bf_hi(vw.z), bf_lo(vw.w), bf_hi(vw.w)} * DBG_SCALE;
            }
        } else {
            const size_t so = (size_t)(row - MALL) * DM + c;
            const f32x4 k0 = *(const GAS f32x4*)(a.in[I_CNK] + so), k1 = *(const GAS f32x4*)(a.in[I_CNK] + so + 4), v0 = *(const GAS f32x4*)(a.in[I_CNV] + so), v1 = *(const GAS f32x4*)(a.in[I_CNV] + so + 4);
            *(GAS v4u*)(KN + (size_t)row * DM + c) = (v4u){pk2(k0.x, k0.y), pk2(k0.z, k0.w), pk2(k1.x, k1.y), pk2(k1.z, k1.w)};
            *(GAS v4u*)(QKV + (size_t)row * 6144 + 4096 + c) = (v4u){pk2(v0.x, v0.y), pk2(v0.z, v0.w), pk2(v1.x, v1.y), pk2(v1.z, v1.w)};
        }
    }
}
__device__ __forceinline__ void nat_attn_phase(const Args& a, LAS unsigned char* lds, int tid, int vcu, int G) {
    OPAQUE_V(tid); PH_PTRS; OPAQUE_S(vcu); OPAQUE_S(G);
    const bf16* QKV = (const bf16*)(ws + WS_S + S_NQKV); const bf16* QN = (const bf16*)(ws + WS_S + S_NQN); const bf16* KN = (const bf16*)(ws + WS_S + S_NKN); bf16* AO = (bf16*)(ws + WS_S + S_AO);
    LAS float* rpb = (LAS float*)(lds + att::RPB_OFF);
    for (int u = vcu; u < 768; u += G) {
        if (u < 256) {
            const int b = u >> 7, h = (u >> 3) & 15, i = u & 7, q0 = MP + b * 2048 + i * 256;
            const int rlo = min(max(4 * i - 4, 0), 24), rhi = min(max(4 * i - 1, 0), 24) + 8, nrows = rhi - rlo;
            __syncthreads();
            for (int e = tid; e < 465; e += NTHR) rpb[e] = a.in[I_RPB][h * 465 + e] * 11.313708498984761f;
            __syncthreads();
            const att::KvSrc src{MALL + b * 256, 4, MP + b * 2048 + 64 * rlo, nrows};
            const att::NatMask nm{rlo, 4 * i + ((tid >> 6) >> 1), 32 * ((tid >> 6) & 1) + (tid & 31), rpb};
            att::attn_unit<128, 1, DM, DM, 6144, DM>(QN + (size_t)q0 * DM + h * 128, KN + h * 128, QKV + 4096 + h * 128, AO + (size_t)q0 * DM + h * 128, src, 4 + nrows, nm, (LAS char*)lds, tid);
        } else {
            const int v = u - 256, b = v >> 4, h = v & 15, q0 = b * 256;
            const att::KvSrc src{b * 256, 4, 0, 1};
            att::attn_unit<128, 0, DM, DM, 6144, DM>(QN + (size_t)q0 * DM + h * 128, KN + h * 128, QKV + 4096 + h * 128, AO + (size_t)q0 * DM + h * 128, src, 4, att::NatMask{0, 0, 0, nullptr}, (LAS char*)lds, tid);
        }
    }
}
constexpr int NPHASE = 1 + 10 * DEPTH;
__host__ __device__ constexpr bool phase_exists(int ph) {
    if (ph == 0) return true;
    const int l = (ph - 1) / 10, k = (ph - 1) % 10, kind = l % 3;
    if (k == 3) return kind == 0;
    if (k == 4) return kind != 2;
    if (k == 5) return kind != 1;
    return true;
}

__global__ void __launch_bounds__(NTHR, 2) fwd(Args a) {
    extern __shared__ __attribute__((aligned(16))) unsigned char lds_[];
    LAS unsigned char* lds = (LAS unsigned char*)lds_;
    const int tid = threadIdx.x, lane = tid & 63, wave = __builtin_amdgcn_readfirstlane(tid >> 6);
    const int G = gridDim.x, bx = blockIdx.x, vcu = (G % 8 == 0) ? (bx % 8) * (G / 8) + bx / 8 : bx;
    const int gw = vcu * NWAVES + wave, NGW = G * NWAVES;
    volatile LAS unsigned* MISC = (volatile LAS unsigned*)(lds + MISC_OFF);
    unsigned* ctl = (unsigned*)(a.ws + WS_CTL);
    for (int u = tid; u < (LDS_BYTES - LDSCTL_OFF) / 4; u += NTHR) ((LAS unsigned*)(lds + LDSCTL_OFF))[u] = 0u;
    __syncthreads();
    XcdBarrier bar; bar.bar = ctl + CW_BAR; bar.x = 0; bar.st = nullptr;
    if (MK_SINGLE) bar = xcd_barrier_post(ctl + CW_BAR, MISC + 8);
    const int lo = a.ph_lo, hi = a.ph_hi;
#define IN(k) (lo <= (k) && (k) < hi)
#define SEAM(k) do { if (MK_SINGLE && (k) + 1 < hi) xcd_barrier(bar); } while (0)
#define GEMM_PTRS PH_PTRS; int gG = G, gbx = bx; OPAQUE_S(gG); OPAQUE_S(gbx); bf16* const H = (bf16*)(ws + WS_H); bf16* const U = (bf16*)(ws + WS_U); bf16* const AO = (bf16*)(ws + WS_S + S_AO); float* const X = out + O_X; \
    const float* const MODS = (const float*)(ws + WS_MODS); (void)H; (void)U; (void)AO; (void)X; (void)MODS

    if (IN(0)) { p0_prologue(a, lds, tid, lane, wave, vcu, G); rope_table(a, tid, vcu, G); SEAM(0); }

    for (int l = 0; l < DEPTH; ++l) {
        const int kind = l % 3, j = l / 3, pb = 1 + 10 * l;
        if (IN(pb + 0)) { norm_phase(a, l, false, lane, gw, NGW); SEAM(pb + 0); }
        if (kind == 0) {
            if (IN(pb + 1)) {
                GEMM_PTRS; unsigned char* wm = ws + WS_WMLA + (size_t)j * WMLA_STRIDE;
                pg8::Gemm g{H, (const bf16*)wm, MALL, 1536, DM, DM, DM, 1}; pg8::StaticOrder S; S.init(MALL, 1536, 1, gG, gbx);
                pg8::EpiF32 E{(float*)(ws + WS_S + S_QAKV), 1536};
                pg8::gemm_phase<pg8::EpiF32, pg8::StaticOrder>(lds, g, S, E);
                SEAM(pb + 1);
            }
            if (IN(pb + 2)) { mla_thin_a(a, j, lane, gw, NGW); SEAM(pb + 2); }
            if (IN(pb + 3)) {
                GEMM_PTRS; unsigned char* wm = ws + WS_WMLA + (size_t)j * WMLA_STRIDE;
                { pg8::Gemm g{(const bf16*)(ws + WS_S + S_QAN), (const bf16*)(wm + WMLA_QB), MALL, 3072, 768, 768, 768, 1}; pg8::StaticOrder S; S.init(MALL, 3072, 1, gG, gbx);
                  pg8::EpiBf16<0> E{(bf16*)(ws + WS_S + S_QRAW), 3072};
                  pg8::gemm_phase<pg8::EpiBf16<0>, pg8::StaticOrder>(lds, g, S, E); }
                { pg8::Gemm g{(const bf16*)(ws + WS_S + S_CKVN), (const bf16*)(wm + WMLA_KVB), MKV, 4096, 512, 512, 512, 1}; pg8::StaticOrder S; S.init(MKV, 4096, 1, gG, gbx);
                  pg8::EpiBf16<0> E{(bf16*)(ws + WS_S + S_KVRAW), 4096};
                  pg8::gemm_phase<pg8::EpiBf16<0>, pg8::StaticOrder>(lds, g, S, E); }
                SEAM(pb + 3);
            }
            if (IN(pb + 4)) { mla_thin_b(a, j, lane, gw, NGW); SEAM(pb + 4); }
            if (IN(pb + 5)) { mla_attn_phase(a, lds, tid, vcu, G); SEAM(pb + 5); }
        }
        if (kind == 1) {
            if (IN(pb + 1)) {
                GEMM_PTRS;
                pg8::Gemm g{H, (const bf16*)(ws + WS_WHG), MALL, 10240, DM, DM, DM, 1}; pg8::StaticOrder S; S.init(MALL, 10240, 1, gG, gbx);
                pg8::EpiHg E{ws};
                pg8::gemm_phase<pg8::EpiHg, pg8::StaticOrder>(lds, g, S, E);
                SEAM(pb + 1);
            }
            if (IN(pb + 2)) { hg_scan_phase(a, lds, tid, vcu, G); SEAM(pb + 2); }
            if (IN(pb + 4)) { hg_thin_c(a, lane, gw, NGW); SEAM(pb + 4); }
        }
        if (kind == 2) {
            if (IN(pb + 1)) {
                GEMM_PTRS;
                pg8::Gemm g{H, (const bf16*)(ws + WS_WNAT), MALL, 6144, DM, DM, DM, 1}; pg8::StaticOrder S; S.init(MALL, 6144, 1, gG, gbx);
                pg8::EpiBf16<0> E{(bf16*)(ws + WS_S + S_NQKV), 6144};
                pg8::gemm_phase<pg8::EpiBf16<0>, pg8::StaticOrder>(lds, g, S, E);
                SEAM(pb + 1);
            }
            if (IN(pb + 2)) { nat_thin_d(a, lane, gw, NGW); SEAM(pb + 2); }
            if (IN(pb + 5)) { nat_attn_phase(a, lds, tid, vcu, G); SEAM(pb + 5); }
        }
        if (IN(pb + 6)) {
            GEMM_PTRS;
            const bf16* wo = (const bf16*)(kind == 0 ? ws + WS_WMLA + (size_t)j * WMLA_STRIDE + WMLA_WO : kind == 1 ? ws + WS_WHG + WHG_WO : ws + WS_WNAT + WNAT_WO);
            pg8::Gemm g{AO, wo, MALL, DM, DM, DM, DM, 1}; pg8::StaticOrder S; S.init(MALL, DM, 1, gG, gbx);
            pg8::EpiRes<false> E{X, MODS + (size_t)l * 3 * NMOD + 2 * DM};
            pg8::gemm_phase<pg8::EpiRes<false>, pg8::StaticOrder>(lds, g, S, E);
            SEAM(pb + 6);
        }
        if (IN(pb + 7)) { norm_phase(a, l, true, lane, gw, NGW); SEAM(pb + 7); }
        if (IN(pb + 8)) {
            GEMM_PTRS;
            pg8::Gemm g{H, (const bf16*)(ws + WS_WFF1) + (size_t)l * DM * FF, MALL, FF, DM, DM, DM, 1}; pg8::StaticOrder S; S.init(MALL, FF, 1, gG, gbx);
            pg8::EpiBf16<1> E{U, FF};
            pg8::gemm_phase<pg8::EpiBf16<1>, pg8::StaticOrder>(lds, g, S, E);
            SEAM(pb + 8);
        }
        if (IN(pb + 9)) {
            GEMM_PTRS;
            pg8::Gemm g{U, (const bf16*)(ws + WS_WFF2) + (size_t)l * DM * FF, MALL, DM, FF, FF, FF, 1}; pg8::StaticOrder S; S.init(MALL, DM, 1, gG, gbx);
            pg8::EpiRes<false> E{X, MODS + (size_t)l * 3 * NMOD + 5 * DM};
            pg8::gemm_phase<pg8::EpiRes<false>, pg8::StaticOrder>(lds, g, S, E);
            SEAM(pb + 9);
        }
    }
#undef IN
#undef SEAM
}

extern "C" void kernel_launch(void* const* d_in, const int* in_sizes, int n_in, void* d_out, int out_size, void* d_ws, size_t ws_size, hipStream_t stream) {
    static int grid = 0;
    if (grid == 0) {
        if (n_in != N_IN || (size_t)out_size != O_END || ws_size < WS_END) { fprintf(stderr, "kernel_launch: shape mismatch n_in %d out %d ws %zu (need %zu); nothing launched\n", n_in, out_size, ws_size, (size_t)WS_END); grid = -1; return; }
        int dev = 0, cus = 0, per_cu = 0;
        if (hipGetDevice(&dev) != hipSuccess || hipDeviceGetAttribute(&cus, hipDeviceAttributeMultiprocessorCount, dev) != hipSuccess) { fprintf(stderr, "kernel_launch: device query failed\n"); grid = -1; return; }
        if (hipFuncSetAttribute((const void*)fwd, hipFuncAttributeMaxDynamicSharedMemorySize, LDS_BYTES) != hipSuccess) { fprintf(stderr, "kernel_launch: hipFuncSetAttribute failed\n"); grid = -1; return; }
        if (hipOccupancyMaxActiveBlocksPerMultiprocessor(&per_cu, (const void*)fwd, NTHR, LDS_BYTES) != hipSuccess || per_cu < 1) { fprintf(stderr, "kernel_launch: occupancy query says %d blocks/CU\n", per_cu); }
        (void)hipGetLastError();
        grid = cus;
    }
    if (grid < 0) return;
    if (hipMemsetAsync((char*)d_ws + WS_CTL, 0, CTL_ZERO_BYTES, stream) != hipSuccess) { fprintf(stderr, "kernel_launch: memset failed\n"); return; }
    Args a{};
    for (int i = 0; i < N_IN; ++i) a.in[i] = (const float*)d_in[i];
    a.out = (float*)d_out; a.ws = (unsigned char*)d_ws;
    int nt = 0, items = 0;
    auto add = [&](const float* src, size_t dst_off, int K, int N, int row_off) { TJob& t = a.tj[nt++]; t.src = src; t.dst = (bf16*)((unsigned char*)d_ws + dst_off); t.K = K; t.N = N; t.row_off = row_off; t.start = items; items += (K / 64) * (N / 32); };
    for (int l = 0; l < DEPTH; ++l) { add(a.in[I_WFF1] + (size_t)l * DM * FF, WS_WFF1 + (size_t)l * DM * FF * 2, DM, FF, 0); add(a.in[I_WFF2] + (size_t)l * DM * FF, WS_WFF2 + (size_t)l * DM * FF * 2, FF, DM, 0); }
    for (int j = 0; j < 2; ++j) { const size_t wb = WS_WMLA + (size_t)j * WMLA_STRIDE;
        add(a.in[I_WQA] + (size_t)j * DM * 768, wb, DM, 768, 0); add(a.in[I_WKVA] + (size_t)j * DM * 576, wb, DM, 576, 768);
        add(a.in[I_WQB] + (size_t)j * 768 * 3072, wb + WMLA_QB, 768, 3072, 0); add(a.in[I_WKVB] + (size_t)j * 512 * 4096, wb + WMLA_KVB, 512, 4096, 0);
        add(a.in[I_WMO] + (size_t)j * DM * DM, wb + WMLA_WO, DM, DM, 0); }
    add(a.in[I_WHQ], WS_WHG, DM, DM, 0); add(a.in[I_WHF], WS_WHG, DM, DM, 2048); add(a.in[I_WHF] + (size_t)DM * DM, WS_WHG, DM, DM, 4096);
    add(a.in[I_WHI], WS_WHG, DM, DM, 6144); add(a.in[I_WHG], WS_WHG, DM, DM, 8192); add(a.in[I_WHO], WS_WHG + WHG_WO, DM, DM, 0);
    add(a.in[I_WNQKV], WS_WNAT, DM, 3 * DM, 0); add(a.in[I_WNO], WS_WNAT + WNAT_WO, DM, DM, 0);
    a.ntj = nt; a.nitems = items;
#if MK_SINGLE
    a.ph_lo = 0; a.ph_hi = NPHASE < MK_LAST_PHASE ? NPHASE : MK_LAST_PHASE;
    hipLaunchKernelGGL(fwd, dim3(grid), dim3(NTHR), LDS_BYTES, stream, a);
#else
    for (int ph = 0; ph < NPHASE && ph < MK_LAST_PHASE; ++ph) {
        if (!phase_exists(ph)) continue;
        a.ph_lo = ph; a.ph_hi = ph + 1;
        hipLaunchKernelGGL(fwd, dim3(grid), dim3(NTHR), LDS_BYTES, stream, a);
    }
#endif
    const hipError_t le = hipPeekAtLastError();
    if (le != hipSuccess) fprintf(stderr, "kernel_launch: launch failed: %s\n", hipGetErrorName(le));
}
```

```cpp
#define MK_SINGLE 1
#define MK_LAST_PHASE 1000
#include <hip/hip_runtime.h>
#include <cstdio>
#include <cstdint>

#ifndef MK_SINGLE
#define MK_SINGLE 0
#endif
#ifndef MK_LAST_PHASE
#define MK_LAST_PHASE 1000
#endif
namespace pg8 {
#define PG8_LAS __attribute__((address_space(3)))
typedef unsigned short bf16_t;
typedef short bf16x8 __attribute__((ext_vector_type(8)));
typedef float f32x4 __attribute__((ext_vector_type(4)));
typedef unsigned u32x4 __attribute__((ext_vector_type(4)));
constexpr int BM = 256, BK = 64, HALF = 128, HTB = HALF * BK * 2  , STAGE_BYTES = 8 * HTB, NXCD = 8, WGM = 8;

__host__ __device__ __forceinline__ int lds_byte(int r, int c) { const int st = (r >> 4) * 2 + (c >> 5), rr = r & 15, cc = c & 31, ob = rr * 64 + cc * 2; return st * 1024 + (ob ^ (((ob >> 9) & 1) << 5)); }
__host__ __device__ __forceinline__ void stage_rc(int b, int& R, int& C) { const int st = b / 1024, sb = b % 1024, swz = sb ^ (((sb >> 9) & 1) << 5); R = (st >> 1) * 16 + swz / 64; C = (st & 1) * 32 + (swz % 64) / 2; }
__host__ __device__ __forceinline__ int perm32(int rho) { const int n = rho >> 4, i = rho & 15; return 8 * (i >> 2) + 4 * n + (i & 3); }

struct Unit { int pm, pn, ks, nkt, part; };
struct Gemm { const bf16_t* A; const bf16_t* Bt; int M, N, K, lda, ldb, nsplit; };

struct StaticOrder {
    int nM, nN, nNv, nwg, G, c, nkt, split;
    __host__ __device__ void init(int M, int N, int nsplit, int G_, int c_, int K = 0) { nM = M / BM; nN = N / BM; nNv = nN * nsplit; nwg = nM * nNv; G = G_; c = c_; nkt = K / BK; split = nsplit; }
    __host__ __device__ bool next(int i, Unit& u) const {
        const long L = (long)i * G + c; if (L >= nwg) return false;
        int wgid = (int)L; { const int q = nwg / NXCD, r = nwg % NXCD, xcd = wgid % NXCD, off = wgid / NXCD; wgid = (xcd < r ? xcd * (q + 1) : r * (q + 1) + (xcd - r) * q) + off; }
        const int nig = WGM * nNv, gid = wgid / nig, fm = gid * WGM, gsz = (nM - fm) < WGM ? (nM - fm) : WGM;
        u.pm = fm + ((wgid % nig) % gsz); const int pv = (wgid % nig) / gsz; u.pn = pv % nN; u.ks = pv / nN; u.nkt = nkt; u.part = split > 1 ? u.ks : -1; return true;
    }
    __device__ __forceinline__ void a_ready(const Unit&) const {}
    __device__ __forceinline__ void done(const Unit&) const {}
};

struct ResOrder {
    int G, c, nkF, nkH;
    __host__ __device__ void init(int G_, int c_, int K) { G = G_; c = c_; nkF = K / BK; nkH = K / (2 * BK); }
    __host__ __device__ bool next(int i, Unit& u) const {
        const int L = i * G + c; if (L >= 512) return false;
        const bool half = L >= 256; int w = half ? L - 256 : L;
        w = (w & 7) * 32 + (w >> 3);
        const int sh = half ? 7 : 6, e = w & ((1 << sh) - 1), pv = e >> 3;
        u.pm = (half ? 32 : 0) + ((w >> sh) << 3) + (e & 7); u.pn = pv & 7; u.ks = pv >> 3; u.nkt = half ? nkH : nkF; u.part = half ? u.ks : -1; return true;
    }
    __device__ __forceinline__ void a_ready(const Unit&) const {}
    __device__ __forceinline__ void done(const Unit&) const {}
};

__device__ __forceinline__ unsigned cvt_pk_bf16(float lo, float hi) { unsigned r; asm("v_cvt_pk_bf16_f32 %0, %1, %2" : "=v"(r) : "v"(lo), "v"(hi)); return r; }


template <class Epi, class Sched, bool ALIGN_EPI = true, bool SP2 = true>
__device__ __forceinline__ void gemm_phase(PG8_LAS unsigned char* lds, const Gemm g, const Sched& S, const Epi& E) {
    int tid_ = threadIdx.x; asm volatile("" : "+v"(tid_));
    const int tid = tid_, wid = __builtin_amdgcn_readfirstlane(tid >> 6), lane = tid & 63, wr = wid >> 2, wc = wid & 3, fr = lane & 15, fq = lane >> 4;
    const int K = g.K;
    unsigned voffA[2], voffB[2];
#pragma unroll
    for (int i = 0; i < 2; ++i) { int R, C; stage_rc(tid * 16 + i * 8192, R, C); const int Rb = Epi::PERM ? ((R & ~31) + perm32(R & 31)) : R;
        voffA[i] = (unsigned)(R * g.lda + C) * 2u; voffB[i] = (unsigned)(Rb * g.ldb + C) * 2u; }
    const size_t kstep = (size_t)(BK * 2);
    const size_t hstepA = (size_t)HALF * g.lda * 2, hstepB = (size_t)HALF * g.ldb * 2;
    const size_t tstepA = 2 * hstepA, tstepB = 2 * hstepB;
    const size_t sstep = (size_t)K * 2;
    const unsigned ldsw = (unsigned)wid * 1024u;
    const int aoff = lds_byte(wr * 64 + fr, fq * 8), boff = lds_byte(wc * 32 + fr, fq * 8);
#define PG8_SA(b, h) (((b) * 2 + (h)) * HTB)
#define PG8_SB(b, h) ((4 + (b) * 2 + (h)) * HTB)
#define PG8_STAGE(bufoff, gbase, voff) do { _Pragma("unroll") for (int _i = 0; _i < 2; ++_i) \
        __builtin_amdgcn_global_load_lds((const unsigned*)((const char*)(gbase) + (voff)[_i]), (PG8_LAS unsigned*)(lds + (bufoff) + ldsw + _i * 8192), 16, 0, 0); } while (0)
#define PG8_LDA(dst, b, h) do { _Pragma("unroll") for (int m = 0; m < 4; ++m) _Pragma("unroll") for (int k = 0; k < 2; ++k) dst[m][k] = *(const PG8_LAS bf16x8*)(lds + PG8_SA(b, h) + aoff + m * 2048 + k * 1024); } while (0)
#define PG8_LDB(dst, b, h) do { _Pragma("unroll") for (int n = 0; n < 2; ++n) _Pragma("unroll") for (int k = 0; k < 2; ++k) dst[n][k] = *(const PG8_LAS bf16x8*)(lds + PG8_SB(b, h) + boff + n * 2048 + k * 1024); } while (0)
#define PG8_MMA(ai, bj, At, Bt) do { __builtin_amdgcn_s_setprio(1); _Pragma("unroll") for (int m = 0; m < 4; ++m) _Pragma("unroll") for (int n = 0; n < 2; ++n) _Pragma("unroll") for (int k = 0; k < 2; ++k) \
        acc[ai][bj][m][n] = __builtin_amdgcn_mfma_f32_16x16x32_bf16(Bt[n][k], At[m][k], acc[ai][bj][m][n], 0, 0, 0); __builtin_amdgcn_s_setprio(0); } while (0)
#define PG8_WAIT_V(n) asm volatile("s_waitcnt vmcnt(" #n ")" ::: "memory")
#define PG8_WAIT_L(n) asm volatile("s_waitcnt lgkmcnt(" #n ")" ::: "memory")
#define PG8_BAR __builtin_amdgcn_s_barrier()
#define PG8_SCHED __builtin_amdgcn_sched_barrier(0)
    Unit cur, nxt; int ui = 0;
    if (!S.next(0, cur)) return;
    f32x4 acc[2][2][4][2];
#pragma unroll
    for (int a = 0; a < 2; ++a)
#pragma unroll
        for (int b = 0; b < 2; ++b)
#pragma unroll
            for (int m = 0; m < 4; ++m)
#pragma unroll
                for (int n = 0; n < 2; ++n) acc[a][b][m][n] = (f32x4){0.f, 0.f, 0.f, 0.f};
    bf16x8 At[4][2], B0[2][2], B1[2][2];
    const char* cA = (const char*)g.A + (size_t)cur.pm * tstepA + (size_t)cur.ks * sstep; const char* cB = (const char*)g.Bt + (size_t)cur.pn * tstepB + (size_t)cur.ks * sstep;
    S.a_ready(cur);
    if constexpr (SP2) {
        PG8_STAGE(PG8_SB(0, 0), cB, voffB); PG8_STAGE(PG8_SB(0, 1), cB + hstepB, voffB); PG8_STAGE(PG8_SA(0, 0), cA, voffA); PG8_STAGE(PG8_SA(0, 1), cA + hstepA, voffA);
        if (wr == 1) PG8_BAR;
        PG8_WAIT_V(2); PG8_BAR;
        PG8_STAGE(PG8_SB(1, 0), cB + kstep, voffB); PG8_STAGE(PG8_SA(1, 0), cA + kstep, voffA); PG8_STAGE(PG8_SB(1, 1), cB + hstepB + kstep, voffB);
        PG8_WAIT_V(6); PG8_BAR;
    } else {
        PG8_STAGE(PG8_SB(0, 0), cB, voffB); PG8_STAGE(PG8_SA(0, 0), cA, voffA); PG8_STAGE(PG8_SB(0, 1), cB + hstepB, voffB); PG8_STAGE(PG8_SA(0, 1), cA + hstepA, voffA);
        if (wr == 1) PG8_BAR;
        PG8_WAIT_V(4); PG8_BAR;
        PG8_STAGE(PG8_SB(1, 0), cB + kstep, voffB); PG8_STAGE(PG8_SA(1, 0), cA + kstep, voffA); PG8_STAGE(PG8_SB(1, 1), cB + hstepB + kstep, voffB);
        PG8_WAIT_V(6); PG8_BAR;
    }
    for (;;) {
        const bool has_next = S.next(ui + 1, nxt);
        const char* nA = has_next ? (const char*)g.A + (size_t)nxt.pm * tstepA + (size_t)nxt.ks * sstep : cA; const char* nB = has_next ? (const char*)g.Bt + (size_t)nxt.pn * tstepB + (size_t)nxt.ks * sstep : cB;
        const int nt = cur.nkt;
        for (int t = 0; t < nt; t += 2) {
            const bool last = (t == nt - 2);
            const char* a1 = cA + (size_t)(t + 1) * kstep;
            const char* a2 = last ? nA : cA + (size_t)(t + 2) * kstep; const char* b2 = last ? nB : cB + (size_t)(t + 2) * kstep;
            const char* a3 = a2 + kstep; const char* b3 = b2 + kstep;
            if (last && has_next) S.a_ready(nxt);
            if constexpr (SP2) {
            PG8_LDB(B0, 0, 0); PG8_LDB(B1, 0, 1); PG8_SCHED; PG8_LDA(At, 0, 0); PG8_STAGE(PG8_SA(1, 1), a1 + hstepA, voffA);
            PG8_WAIT_V(8); PG8_WAIT_L(0); PG8_BAR; PG8_MMA(0, 0, At, B0); PG8_MMA(0, 1, At, B1); PG8_BAR; PG8_SCHED;
            PG8_LDA(At, 0, 1); PG8_STAGE(PG8_SB(0, 0), b2, voffB); PG8_STAGE(PG8_SB(0, 1), b2 + hstepB, voffB); PG8_STAGE(PG8_SA(0, 0), a2, voffA);
            PG8_WAIT_V(8); PG8_WAIT_L(0); PG8_BAR; PG8_MMA(1, 0, At, B0); PG8_MMA(1, 1, At, B1); PG8_BAR; PG8_SCHED;
            PG8_LDB(B0, 1, 0); PG8_LDB(B1, 1, 1); PG8_SCHED; PG8_LDA(At, 1, 0); PG8_STAGE(PG8_SA(0, 1), a2 + hstepA, voffA);
            PG8_WAIT_V(8); PG8_WAIT_L(0); PG8_BAR; PG8_MMA(0, 0, At, B0); PG8_MMA(0, 1, At, B1); PG8_BAR; PG8_SCHED;
            PG8_LDA(At, 1, 1); PG8_STAGE(PG8_SB(1, 0), b3, voffB); PG8_STAGE(PG8_SB(1, 1), b3 + hstepB, voffB); PG8_STAGE(PG8_SA(1, 0), a3, voffA);
            PG8_WAIT_V(8); PG8_WAIT_L(0); PG8_BAR; PG8_MMA(1, 0, At, B0); PG8_MMA(1, 1, At, B1); PG8_BAR; PG8_SCHED;
            } else {
            PG8_LDB(B0, 0, 0); PG8_SCHED; PG8_LDA(At, 0, 0); PG8_STAGE(PG8_SA(1, 1), a1 + hstepA, voffA);
            PG8_WAIT_L(8); PG8_BAR; PG8_WAIT_L(0); PG8_MMA(0, 0, At, B0); PG8_BAR; PG8_SCHED;
            PG8_LDB(B1, 0, 1); PG8_STAGE(PG8_SB(0, 0), b2, voffB);
            PG8_BAR; PG8_WAIT_L(0); PG8_MMA(0, 1, At, B1); PG8_BAR;
            PG8_LDA(At, 0, 1); PG8_STAGE(PG8_SA(0, 0), a2, voffA);
            PG8_BAR; PG8_WAIT_L(0); PG8_MMA(1, 0, At, B0); PG8_BAR; PG8_SCHED;
            PG8_STAGE(PG8_SB(0, 1), b2 + hstepB, voffB);
            PG8_WAIT_V(6); PG8_BAR; PG8_MMA(1, 1, At, B1); PG8_BAR;
            PG8_LDB(B0, 1, 0); PG8_SCHED; PG8_LDA(At, 1, 0); PG8_STAGE(PG8_SA(0, 1), a2 + hstepA, voffA);
            PG8_WAIT_L(8); PG8_BAR; PG8_WAIT_L(0); PG8_MMA(0, 0, At, B0); PG8_BAR; PG8_SCHED;
            PG8_LDB(B1, 1, 1); PG8_STAGE(PG8_SB(1, 0), b3, voffB);
            PG8_BAR; PG8_WAIT_L(0); PG8_MMA(0, 1, At, B1); PG8_BAR;
            PG8_LDA(At, 1, 1); PG8_STAGE(PG8_SA(1, 0), a3, voffA);
            PG8_BAR; PG8_WAIT_L(0); PG8_MMA(1, 0, At, B0); PG8_BAR; PG8_SCHED;
            PG8_STAGE(PG8_SB(1, 1), b3 + hstepB, voffB);
            PG8_WAIT_V(6); PG8_BAR; PG8_MMA(1, 1, At, B1); PG8_BAR;
            }
        }
        if constexpr (ALIGN_EPI) { if (wr == 0) PG8_BAR; }
        E(acc, cur, wr, wc, fr, fq); S.done(cur);
        if (!has_next) break;
#pragma unroll
        for (int a = 0; a < 2; ++a)
#pragma unroll
            for (int b = 0; b < 2; ++b)
#pragma unroll
                for (int m = 0; m < 4; ++m)
#pragma unroll
                    for (int n = 0; n < 2; ++n) acc[a][b][m][n] = (f32x4){0.f, 0.f, 0.f, 0.f};
        cur = nxt; cA = nA; cB = nB; ++ui;
        if constexpr (ALIGN_EPI) { if (wr == 1) PG8_BAR; }
    }
    PG8_WAIT_V(0);
    if constexpr (!ALIGN_EPI) { if (wr == 0) PG8_BAR; }
    PG8_BAR;
#undef PG8_SA
#undef PG8_SB
#undef PG8_STAGE
#undef PG8_LDA
#undef PG8_LDB
#undef PG8_MMA
#undef PG8_WAIT_V
#undef PG8_WAIT_L
#undef PG8_BAR
#undef PG8_SCHED
}
}
constexpr int DM = 2048, MP = 8192, MS = 4096, MALL = 12288, MKV = 12800, FF = 8192, NMOD = 12288;
constexpr int NWAVES = 8, NTHR = 512, DEPTH = 4;
constexpr float EPS = 1e-6f;
constexpr size_t O_X = 0, O_CKV = 25165824, O_KPE = 33554432, O_HG = 34603008, O_NK = 51380224, O_NV = 68157440, O_END = 84934656;
enum { I_XP = 0, I_XS, I_CCKV, I_CKPE, I_SHG, I_CNK, I_CNV, I_C, I_CCTX, I_WMOD, I_BMOD, I_GMIX, I_GFFN, I_WQA, I_GQA, I_WQB, I_GQN, I_WKVA, I_GKVA, I_WKVB, I_GKN, I_WMO,
       I_WHQ, I_WHF, I_HLB, I_WHI, I_WHG, I_GHO, I_WHO, I_WNQKV, I_GNQ, I_GNK, I_RPB, I_WNO, I_WFF1, I_WFF2, N_IN };

constexpr size_t MiB = 1u << 20;
constexpr size_t WS_CTL = 0, CTL_ZERO_BYTES = 65536;
constexpr size_t WS_MODS = 2 * MiB;
constexpr size_t WS_LB = 3 * MiB;
constexpr size_t WS_SSK = 3 * MiB + 65536;
constexpr size_t WS_ROPE = 3 * MiB + 131072;
constexpr size_t WS_WFF1 = 4 * MiB, WS_WFF2 = 132 * MiB;
constexpr size_t WS_WMLA = 260 * MiB, WMLA_STRIDE = 24 * MiB;
constexpr size_t WMLA_QB = 6 * MiB, WMLA_KVB = 11 * MiB, WMLA_WO = 15 * MiB;
constexpr size_t WS_WHG = 308 * MiB, WHG_WO = 40 * MiB;
constexpr size_t WS_WNAT = 356 * MiB, WNAT_WO = 24 * MiB;
constexpr size_t WS_H = 388 * MiB;
constexpr size_t WS_U = 436 * MiB;
constexpr size_t WS_S = 628 * MiB;
constexpr size_t S_AO = 0;
constexpr size_t S_QAKV = 48 * MiB, S_QAN = 120 * MiB, S_CKVN = 138 * MiB, S_KPE = 151 * MiB, S_QRAW = 155 * MiB, S_KVRAW = 227 * MiB, S_QN = 327 * MiB, S_KF = 399 * MiB;
constexpr size_t S_HQ = 48 * MiB, S_HK = 96 * MiB, S_HV = 192 * MiB, S_HGS = 240 * MiB, S_OF = 288 * MiB;
constexpr size_t S_NQKV = 48 * MiB, S_NQN = 198 * MiB, S_NKN = 246 * MiB;
constexpr size_t S_PART = 480 * MiB;
constexpr size_t WS_END = WS_S + 512 * MiB;
constexpr int CW_TMO = 0, CW_CODE = 1, CW_BAR = 4096;

constexpr int RING_BYTES = 131072;
constexpr int LDSCTL_OFF = RING_BYTES, MISC_OFF = LDSCTL_OFF + 320;
constexpr int LDS_BYTES = 147456;

#define GAS __attribute__((address_space(1)))
#define LAS __attribute__((address_space(3)))
typedef unsigned short bf16;
typedef unsigned v4u __attribute__((ext_vector_type(4)));
typedef unsigned v2u __attribute__((ext_vector_type(2)));
typedef float f32x4 __attribute__((ext_vector_type(4)));
typedef float f32x2 __attribute__((ext_vector_type(2)));
typedef short bf16x8 __attribute__((ext_vector_type(8)));
typedef GAS unsigned gu32;
#define RLX_AGENT __ATOMIC_RELAXED, __HIP_MEMORY_SCOPE_AGENT
#define LDS_WAIT() asm volatile("s_waitcnt lgkmcnt(0)" ::: "memory")
#define VM_WAIT() asm volatile("s_waitcnt vmcnt(0)" ::: "memory")
#ifndef DBG_SCALE
#define DBG_SCALE 1.0f
#endif
#define OPAQUE_S(x) asm volatile("" : "+s"(x))
#define PH_PTRS unsigned char* ws = a.ws; float* out = a.out; OPAQUE_S(ws); OPAQUE_S(out)
#define OPAQUE_V(x) asm volatile("" : "+v"(x))
__device__ __forceinline__ unsigned pk2(float lo, float hi) { unsigned r; asm("v_cvt_pk_bf16_f32 %0, %1, %2" : "=v"(r) : "v"(lo), "v"(hi)); return r; }
__device__ __forceinline__ float bf_lo(unsigned w) { return __uint_as_float(w << 16); }
__device__ __forceinline__ float bf_hi(unsigned w) { return __uint_as_float(w & 0xffff0000u); }
__device__ __forceinline__ float wave_sum(float v) {
#pragma unroll
    for (int o = 1; o < 64; o <<= 1) v += __shfl_xor(v, o);
    return v;
}
__device__ __forceinline__ float sum16(float v) {
#pragma unroll
    for (int o = 1; o < 16; o <<= 1) v += __shfl_xor(v, o);
    return v;
}

#define XB_TMO      128
#define XB_XCNT(j)  (256  + 64 * (j))
#define XB_XSUB(j)  (1280 + 64 * (j))
#define XB_XGEN(j)  (2304 + 64 * (j))
#define XB_TOP      3328
#define XB_TOPGEN   3392
#define XCD_BAR_WORDS 3456
#define XB_SPIN_CAP (1u << 18)
__device__ __forceinline__ unsigned xb_ld(unsigned* p)              { return __hip_atomic_load(p, __ATOMIC_RELAXED, __HIP_MEMORY_SCOPE_AGENT); }
__device__ __forceinline__ unsigned xb_add(unsigned* p, unsigned v) { return __hip_atomic_fetch_add(p, v, __ATOMIC_RELAXED, __HIP_MEMORY_SCOPE_AGENT); }
__device__ __forceinline__ unsigned xb_xcc_id() { return (unsigned)__builtin_amdgcn_s_getreg((3 << 11) | 20) & 0xFu; }
#define XB_SPIN(cond, bar) do { unsigned _sp = 0; while (cond) { __builtin_amdgcn_s_sleep(1); \
    if ((++_sp & 255u) == 0u) { if (xb_ld(&(bar)[XB_TMO])) break; if (_sp > XB_SPIN_CAP) { atomicAdd(&(bar)[XB_TMO], 1u); break; } } } } while (0)
struct XcdBarrier { unsigned* bar; unsigned x; volatile LAS unsigned* st; };
__device__ __forceinline__ XcdBarrier xcd_barrier_post(unsigned* bar, volatile LAS unsigned* st) {
    XcdBarrier b; b.bar = bar; b.x = xb_xcc_id(); b.st = st;
    if (threadIdx.x == 0) (void)xb_add(&bar[XB_XCNT(b.x)], 1u);
    return b;
}
__device__ __forceinline__ void xcd_barrier_complete(unsigned* bar, unsigned x, unsigned& nloc, unsigned& nx) {
    const unsigned G = gridDim.x * gridDim.y * gridDim.z;
    unsigned sum, cnt, mine, sp = 0u;
    for (;;) {
        sum = 0u; cnt = 0u; mine = 0u;
#pragma unroll
        for (unsigned j = 0; j < 16; ++j) { const unsigned c = xb_ld(&bar[XB_XCNT(j)]); sum += c; cnt += (c > 0u) ? 1u : 0u; mine = (j == x) ? c : mine; }
        if (sum == G) break;
        __builtin_amdgcn_s_sleep(1);
        if ((++sp & 255u) == 0u) { if (xb_ld(&bar[XB_TMO])) break; if (sp > XB_SPIN_CAP) { atomicAdd(&bar[XB_TMO], 1u); break; } }
    }
    nloc = mine > 0u ? mine : 1u; nx = cnt > 0u ? cnt : 1u;
}
__device__ __forceinline__ void xcd_barrier(const XcdBarrier& b) {
    asm volatile("s_waitcnt vmcnt(0)" ::: "memory");
    __syncthreads();
    if (threadIdx.x == 0) {
        unsigned* bar = b.bar;
        __builtin_amdgcn_s_waitcnt(0);
        unsigned nloc = b.st[0], nx = b.st[1];
        if (nloc == 0u) { xcd_barrier_complete(bar, b.x, nloc, nx); b.st[0] = nloc; b.st[1] = nx; }
        const unsigned old = xb_add(&bar[XB_XSUB(b.x)], 1u);
        const unsigned gen = old / nloc;
        if (old + 1u == (gen + 1u) * nloc) {
            __builtin_amdgcn_fence(__ATOMIC_RELEASE, "agent");
            asm volatile("s_waitcnt vmcnt(0)" ::: "memory");
            const unsigned og = xb_add(&bar[XB_TOP], 1u);
            const unsigned tg = og / nx;
            if (og + 1u == (tg + 1u) * nx) xb_add(&bar[XB_TOPGEN], 1u);
            else XB_SPIN(xb_ld(&bar[XB_TOPGEN]) == tg, bar);
            __builtin_amdgcn_fence(__ATOMIC_ACQUIRE, "agent");
            xb_add(&bar[XB_XGEN(b.x)], 1u);
            asm volatile("s_waitcnt vmcnt(0)" ::: "memory");
        } else {
            XB_SPIN(xb_ld(&bar[XB_XGEN(b.x)]) == gen, bar);
            __builtin_amdgcn_fence(__ATOMIC_ACQUIRE, "agent");
            asm volatile("s_waitcnt vmcnt(0)" ::: "memory");
        }
    }
    __syncthreads();
}

struct TJob { const float* src; bf16* dst; int K, N, row_off, start; };
constexpr int MAX_TJ = 32;
struct Args { const float* in[N_IN]; float* out; unsigned char* ws; TJob tj[MAX_TJ]; int ntj, nitems, ph_lo, ph_hi; };

__device__ __forceinline__ void p0_transpose_item(const float* W, int K, int N, bf16* WT, int row_off, LAS float* scr, int item, int lane) {
    const int nblk = N / 32, kb = item / nblk, nb = item % nblk, k0 = 64 * kb, n0 = 32 * nb;
#pragma unroll 8
    for (int i = 0; i < 32; ++i) { const int kk = 2 * i + (lane >> 5); scr[kk * 33 + (lane & 31)] = W[(size_t)(k0 + kk) * N + n0 + (lane & 31)]; }
    LDS_WAIT(); asm volatile("" ::: "memory");
    const int c = lane & 7;
#pragma unroll
    for (int j = 0; j < 4; ++j) { const int n = (lane >> 3) + 8 * j; const LAS float* s = scr + (8 * c) * 33 + n;
        v4u o; o.x = pk2(s[0 * 33], s[1 * 33]); o.y = pk2(s[2 * 33], s[3 * 33]); o.z = pk2(s[4 * 33], s[5 * 33]); o.w = pk2(s[6 * 33], s[7 * 33]);
        *(GAS v4u*)(WT + (size_t)(row_off + n0 + n) * K + k0 + 8 * c) = o; }
    LDS_WAIT(); asm volatile("" ::: "memory");
}

__device__ __forceinline__ float silu_f(float x) { return x / (1.f + __expf(-x)); }

__device__ __forceinline__ void p0_prologue(const Args& a, LAS unsigned char* lds, int tid, int lane, int wave, int vcu, int G) {
    OPAQUE_V(tid); OPAQUE_V(lane);
    float* mods = (float*)(a.ws + WS_MODS);
    if (vcu < 768) {
        LAS f32x4* S3 = (LAS f32x4*)lds;
        LAS float* RED = (LAS float*)(lds + 32768);
        const float* cc = a.in[I_C]; const float* cx = a.in[I_CCTX];
        for (int k = tid; k < DM; k += NTHR) S3[k] = (f32x4){silu_f(cx[k]), silu_f(cc[k]), silu_f(cc[DM + k]), 0.f};
        __syncthreads();
        for (int tl = vcu; tl < 768; tl += G) {
            const int l = tl / 192, n = (tl % 192) * 64 + lane;
            const float* Wp = a.in[I_WMOD] + ((size_t)l * DM + wave * 256) * NMOD + n;
            float a0 = 0.f, a1 = 0.f, a2 = 0.f;
#pragma unroll 16
            for (int k = 0; k < 256; ++k) { const float wv = Wp[(size_t)k * NMOD]; const f32x4 s = S3[wave * 256 + k]; a0 += s.x * wv; a1 += s.y * wv; a2 += s.z * wv; }
            RED[(wave * 3 + 0) * 64 + lane] = a0; RED[(wave * 3 + 1) * 64 + lane] = a1; RED[(wave * 3 + 2) * 64 + lane] = a2;
            __syncthreads();
            if (wave < 3) { float s = 0.f;
#pragma unroll
                for (int w = 0; w < 8; ++w) s += RED[(w * 3 + wave) * 64 + lane];
                mods[((size_t)l * 3 + wave) * NMOD + n] = s + a.in[I_BMOD][(size_t)l * NMOD + n]; }
            __syncthreads();
        }
    }
    { const int gt = vcu * NTHR + tid;
      if (gt < 2 * DM) { const int d = gt >> 11, c = gt & 2047; const float* hl = a.in[I_HLB] + (size_t)d * 4 * DM + c;
          const float x0 = hl[0], x1 = hl[DM], x2 = hl[2 * DM], x3 = hl[3 * DM]; const float m = fmaxf(fmaxf(x0, x1), fmaxf(x2, x3));
          const float e0 = __expf(x0 - m), e1 = __expf(x1 - m), e2 = __expf(x2 - m), e3 = __expf(x3 - m);
          ((float*)(a.ws + WS_LB))[gt] = e1 / (e0 + e1 + e2 + e3); } }
    __syncthreads();
    LAS float* scr = (LAS float*)(lds + wave * 16384);
    const int gw = vcu * NWAVES + wave, NGW = G * NWAVES;
    for (int it = gw; it < a.nitems; it += NGW) {
        int j = 0;
        while (j + 1 < a.ntj && it >= a.tj[j + 1].start) ++j;
        p0_transpose_item(a.tj[j].src, a.tj[j].K, a.tj[j].N, a.tj[j].dst, a.tj[j].row_off, scr, it - a.tj[j].start, lane);
    }
#if defined(DBG_ZERO_OUT)
    { const size_t gt = (size_t)vcu * NTHR + tid, NT = (size_t)G * NTHR;
      for (size_t i = gt; i < (O_END - O_CKV) / 4; i += NT) *(GAS f32x4*)(a.out + O_CKV + 4 * i) = (f32x4){0.f, 0.f, 0.f, 0.f}; }
#endif
    { const int gt = vcu * NTHR + tid, NT = G * NTHR;
      for (int i = gt; i < 2 * 192 * DM / 8; i += NT) { const int j = i / (192 * DM / 8), r = i % (192 * DM / 8);
          *(GAS v4u*)(a.ws + WS_WMLA + j * WMLA_STRIDE + (size_t)1344 * DM * 2 + (size_t)r * 16) = (v4u){0u, 0u, 0u, 0u}; } }
}

__device__ __forceinline__ int cond_of_row(int row) { return row < MP ? 0 : 1 + ((row - MP) >> 11); }

__device__ __forceinline__ void norm_phase(const Args& a, int l, bool ffn, const float* fixgate, int lane, int gw, int NGW) {
    OPAQUE_V(lane); PH_PTRS; OPAQUE_S(gw); OPAQUE_S(NGW);
    const float* g = a.in[ffn ? I_GFFN : I_GMIX] + (size_t)l * DM;
    const float* mods = (const float*)(ws + WS_MODS) + (size_t)l * 3 * NMOD + (ffn ? 3 * DM : 0);
    bf16* H = (bf16*)(ws + WS_H);
    const bool first = (l == 0 && !ffn);
    for (int row = gw; row < MALL; row += NGW) {
        const float* xr = first ? (row < MP ? a.in[I_XP] + (size_t)row * DM : a.in[I_XS] + (size_t)(row - MP) * DM) : out + O_X + (size_t)row * DM;
        const float* md = mods + (size_t)cond_of_row(row) * NMOD;
        f32x4 v[8]; float ss = 0.f;
        const bool fix = fixgate != nullptr && row >= MP;
        const float* P0 = (const float*)(ws + WS_S + S_PART) + (size_t)(row - MP) * DM; const float* fg = fixgate + (size_t)cond_of_row(row) * NMOD;
#pragma unroll
        for (int j = 0; j < 8; ++j) { v[j] = *(const GAS f32x4*)(xr + 4 * (lane + 64 * j));
            if (fix) { const int c = 4 * (lane + 64 * j); v[j] = v[j] + *(const GAS f32x4*)(fg + c) * *(const GAS f32x4*)(P0 + c); }
            ss += (v[j].x * v[j].x + v[j].y * v[j].y) + (v[j].z * v[j].z + v[j].w * v[j].w); }
        const float rs = rsqrtf(wave_sum(ss) * (1.f / DM) + EPS);
#pragma unroll
        for (int j = 0; j < 8; ++j) { const int c = 4 * (lane + 64 * j);
            const f32x4 gg = *(const GAS f32x4*)(g + c), sh = *(const GAS f32x4*)(md + c), sc = *(const GAS f32x4*)(md + DM + c);
            const f32x4 y = v[j] * rs * gg * (sc + 1.f) + sh;
            *(GAS v2u*)(H + (size_t)row * DM + c) = (v2u){pk2(y.x, y.y), pk2(y.z, y.w)};
            if (first || fix) *(GAS f32x4*)(out + O_X + (size_t)row * DM + c) = v[j]; }
    }
}

__device__ __forceinline__ void final_fix_phase(const Args& a, const float* fixgate, int lane, int gw, int NGW) {
    OPAQUE_V(lane); PH_PTRS; OPAQUE_S(gw); OPAQUE_S(NGW);
    for (int row = MP + gw; row < MALL; row += NGW) {
        const float* P0 = (const float*)(ws + WS_S + S_PART) + (size_t)(row - MP) * DM; const float* fg = fixgate + (size_t)cond_of_row(row) * NMOD; float* xr = out + O_X + (size_t)row * DM;
#pragma unroll
        for (int j = 0; j < 8; ++j) { const int c = 4 * (lane + 64 * j);
            *(GAS f32x4*)(xr + c) = *(const GAS f32x4*)(xr + c) + *(const GAS f32x4*)(fg + c) * *(const GAS f32x4*)(P0 + c); }
    }
}
__device__ __forceinline__ void mla_thin_a(const Args& a, int j, int lane, int gw, int NGW) {
    OPAQUE_V(lane); PH_PTRS; OPAQUE_S(gw); OPAQUE_S(NGW);
    const float* QAKV = (const float*)(ws + WS_S + S_QAKV);
    bf16* QAN = (bf16*)(ws + WS_S + S_QAN); bf16* CKVN = (bf16*)(ws + WS_S + S_CKVN); float* KPE = (float*)(ws + WS_S + S_KPE); float* SSK = (float*)(ws + WS_SSK);
    const float* gqa = a.in[I_GQA] + (size_t)j * 768; const float* gkva = a.in[I_GKVA] + (size_t)j * 512;
    for (int row = gw; row < MKV; row += NGW) {
        if (row < MALL) {
            const float* r = QAKV + (size_t)row * 1536;
            { f32x4 v[3]; float ss = 0.f;
#pragma unroll
              for (int i = 0; i < 3; ++i) { v[i] = *(const GAS f32x4*)(r + 4 * (lane + 64 * i)); ss += (v[i].x * v[i].x + v[i].y * v[i].y) + (v[i].z * v[i].z + v[i].w * v[i].w); }
              const float rs = rsqrtf(wave_sum(ss) * (1.f / 768.f) + EPS);
#pragma unroll
              for (int i = 0; i < 3; ++i) { const int c = 4 * (lane + 64 * i); const f32x4 y = v[i] * rs * *(const GAS f32x4*)(gqa + c);
                  *(GAS v2u*)(QAN + (size_t)row * 768 + c) = (v2u){pk2(y.x, y.y), pk2(y.z, y.w)}; } }
            { f32x4 v[2]; float ss = 0.f;
#pragma unroll
              for (int i = 0; i < 2; ++i) { v[i] = *(const GAS f32x4*)(r + 768 + 4 * (lane + 64 * i)); ss += (v[i].x * v[i].x + v[i].y * v[i].y) + (v[i].z * v[i].z + v[i].w * v[i].w); }
              const float rs = rsqrtf(wave_sum(ss) * (1.f / 512.f) + EPS);
#pragma unroll
              for (int i = 0; i < 2; ++i) { const int c = 4 * (lane + 64 * i); const f32x4 y = v[i] * rs * *(const GAS f32x4*)(gkva + c);
                  *(GAS v2u*)(CKVN + (size_t)row * 512 + c) = (v2u){pk2(y.x, y.y), pk2(y.z, y.w)};
                  if (row < MP) *(GAS f32x4*)(out + O_CKV + ((size_t)((row >> 8) * 2 + j) * 256 + (row & 255)) * 512 + c) = y * DBG_SCALE; } }
            { const float kp = r[1280 + lane]; KPE[(size_t)row * 64 + lane] = kp;
              if (row < MP) out[O_KPE + ((size_t)((row >> 8) * 2 + j) * 256 + (row & 255)) * 64 + lane] = kp * DBG_SCALE;
              const float s = wave_sum(kp * kp); if (lane == 0) SSK[row] = s; }
        } else {
            const int cr = row - MALL, b = cr >> 8, t = cr & 255; const size_t src = (size_t)((b * 2 + j) * 256 + t);
            const float* ck = a.in[I_CCKV] + src * 512;
#pragma unroll
            for (int i = 0; i < 2; ++i) { const int c = 4 * (lane + 64 * i); const f32x4 y = *(const GAS f32x4*)(ck + c);
                *(GAS v2u*)(CKVN + (size_t)row * 512 + c) = (v2u){pk2(y.x, y.y), pk2(y.z, y.w)}; }
            const float kp = a.in[I_CKPE][src * 64 + lane]; KPE[(size_t)row * 64 + lane] = kp;
            const float s = wave_sum(kp * kp); if (lane == 0) SSK[row] = s;
        }
    }
}
namespace pg8 {
struct EpiF32 {
    static constexpr bool PERM = false;
    float* C; int ldc;
    __device__ __forceinline__ void operator()(const f32x4 (&acc)[2][2][4][2], const Unit& u, int wr, int wc, int fr, int fq) const {
        const int row0 = u.pm * BM + wr * 64 + fr, col0 = u.pn * BM + wc * 32 + 4 * fq;
#pragma unroll
        for (int ai = 0; ai < 2; ++ai)
#pragma unroll
            for (int m = 0; m < 4; ++m) { float* rowp = C + (size_t)(row0 + ai * HALF + m * 16) * ldc + col0;
#pragma unroll
                for (int bj = 0; bj < 2; ++bj)
#pragma unroll
                    for (int n = 0; n < 2; ++n) *(f32x4*)(rowp + bj * HALF + n * 16) = acc[ai][bj][m][n]; }
    }
};
template <int ACT  > struct EpiBf16 {
    static constexpr bool PERM = true;
    bf16_t* O; int ldc;
    __device__ __forceinline__ void operator()(const f32x4 (&acc)[2][2][4][2], const Unit& u, int wr, int wc, int fr, int fq) const {
        const int row0 = u.pm * BM + wr * 64 + fr, col0 = u.pn * BM + wc * 32 + 8 * fq;
#pragma unroll
        for (int ai = 0; ai < 2; ++ai)
#pragma unroll
            for (int m = 0; m < 4; ++m) { bf16_t* rowp = O + (size_t)(row0 + ai * HALF + m * 16) * ldc + col0;
#pragma unroll
                for (int bj = 0; bj < 2; ++bj) { f32x4 v0 = acc[ai][bj][m][0], v1 = acc[ai][bj][m][1];
                    if (ACT == 1) {
#pragma unroll
                        for (int e = 0; e < 4; ++e) { const float x0 = fmaxf(v0[e], 0.f), x1 = fmaxf(v1[e], 0.f); v0[e] = x0 * x0; v1[e] = x1 * x1; } }
                    u32x4 w; w.x = cvt_pk_bf16(v0[0], v0[1]); w.y = cvt_pk_bf16(v0[2], v0[3]); w.z = cvt_pk_bf16(v1[0], v1[1]); w.w = cvt_pk_bf16(v1[2], v1[3]);
                    *(u32x4*)(rowp + bj * HALF) = w; } }
    }
};
template <bool ATOMIC> struct EpiRes {
    static constexpr bool PERM = false;
    float* X; const float* gate;
    __device__ __forceinline__ void operator()(const f32x4 (&acc)[2][2][4][2], const Unit& u, int wr, int wc, int fr, int fq) const {
        const int rb = u.pm * BM, row0 = rb + wr * 64 + fr, col0 = u.pn * BM + wc * 32 + 4 * fq;
        const int cond = rb < 8192 ? 0 : 1 + ((rb - 8192) >> 11);
        const float* gp = gate + (size_t)cond * 12288 + col0;
        f32x4 gv[2][2];
#pragma unroll
        for (int bj = 0; bj < 2; ++bj)
#pragma unroll
            for (int n = 0; n < 2; ++n) gv[bj][n] = *(const f32x4*)(gp + bj * HALF + n * 16);
#pragma unroll
        for (int ai = 0; ai < 2; ++ai)
#pragma unroll
            for (int m = 0; m < 4; ++m) { float* rowp = X + (size_t)(row0 + ai * HALF + m * 16) * 2048 + col0;
#pragma unroll
                for (int bj = 0; bj < 2; ++bj)
#pragma unroll
                    for (int n = 0; n < 2; ++n) { float* p = rowp + bj * HALF + n * 16; const f32x4 d = gv[bj][n] * acc[ai][bj][m][n];
                        if (ATOMIC) {
#pragma unroll
                            for (int e = 0; e < 4; ++e) __hip_atomic_fetch_add(p + e, d[e], __ATOMIC_RELAXED, __HIP_MEMORY_SCOPE_AGENT);
                        } else { *(f32x4*)p = *(const f32x4*)p + d; } }
                asm volatile("" ::: "memory"); }
    }
};
struct EpiRes2 {
    static constexpr bool PERM = false;
    float* X; const float* gate; float* P;
    __device__ __forceinline__ void operator()(const f32x4 (&acc)[2][2][4][2], const Unit& u, int wr, int wc, int fr, int fq) const {
        const int rb = u.pm * BM, row0 = rb + wr * 64 + fr, col0 = u.pn * BM + wc * 32 + 4 * fq;
        if (u.part <= 0) {
            const int cond = rb < 8192 ? 0 : 1 + ((rb - 8192) >> 11);
            const float* gp = gate + (size_t)cond * 12288 + col0;
            f32x4 gv[2][2];
#pragma unroll
            for (int bj = 0; bj < 2; ++bj)
#pragma unroll
                for (int n = 0; n < 2; ++n) gv[bj][n] = *(const f32x4*)(gp + bj * HALF + n * 16);
#pragma unroll
            for (int ai = 0; ai < 2; ++ai)
#pragma unroll
                for (int m = 0; m < 4; ++m) { float* rowp = X + (size_t)(row0 + ai * HALF + m * 16) * 2048 + col0;
#pragma unroll
                    for (int bj = 0; bj < 2; ++bj)
#pragma unroll
                        for (int n = 0; n < 2; ++n) { float* p = rowp + bj * HALF + n * 16; *(f32x4*)p = *(const f32x4*)p + gv[bj][n] * acc[ai][bj][m][n]; }
                    asm volatile("" ::: "memory"); }
        } else {
            float* Pp = P + (size_t)(row0 - 8192) * 2048 + col0;
#pragma unroll
            for (int ai = 0; ai < 2; ++ai)
#pragma unroll
                for (int m = 0; m < 4; ++m) { float* rowp = Pp + (size_t)(ai * HALF + m * 16) * 2048;
#pragma unroll
                    for (int bj = 0; bj < 2; ++bj)
#pragma unroll
                        for (int n = 0; n < 2; ++n) *(f32x4*)(rowp + bj * HALF + n * 16) = acc[ai][bj][m][n]; }
        }
    }
};
}
namespace att {
using bf16x8 = __attribute__((ext_vector_type(8))) short;
using s16x4  = __attribute__((ext_vector_type(4))) short;
using f32x16 = __attribute__((ext_vector_type(16))) float;
using u32x4  = __attribute__((ext_vector_type(4))) unsigned;
constexpr int NW = 8, QBLK = 32, KVBLK = 64, DV = 128;
constexpr float THR = 8.f;
constexpr int SHM_V = KVBLK * DV * 2;
constexpr int RPB_OFF = 2 * SHM_V + 2 * KVBLK * 192 * 2 + 2048;
#define ATT_SBAR() __builtin_amdgcn_sched_barrier(0)
__device__ __forceinline__ int crow(int r, int hi) { return (r & 3) + 8 * (r >> 2) + 4 * hi; }
__device__ __forceinline__ unsigned cvtpk(float lo, float hi) { unsigned r; asm volatile("v_cvt_pk_bf16_f32 %0, %1, %2" : "=v"(r) : "v"(lo), "v"(hi)); return r; }
__device__ __forceinline__ int v_st(int k, int c) { const int kk = (k & ~0xC) | ((k & 4) << 1) | ((k & 8) >> 1); return ((kk >> 3) * 4 + (c >> 5)) * 512 + ((kk & 7) * 32 + (c & 31)) * 2; }
__device__ __forceinline__ int v_rd_base(int lane) { return ((lane & 3) << 3) | (((lane >> 2) & 3) << 6) | (((lane >> 4) & 1) << 5) | (((lane >> 5) & 1) << 8); }
constexpr int v_rd_off(int d0, int ks, int half) { return d0 * 512 + ks * 4096 + half * 2048; }
template <int OFF> __device__ __forceinline__ s16x4 tr_read(int vb) { s16x4 r; asm volatile("ds_read_b64_tr_b16 %0, %1 offset:%2" : "=&v"(r) : "v"(vb), "i"(OFF) : "memory"); return r; }
template <int D0> __device__ __forceinline__ void pv_one(f32x16& od, int vb, bf16x8 pa0, bf16x8 pa1, bf16x8 pa2, bf16x8 pa3) {
  const s16x4 l0 = tr_read<v_rd_off(D0, 0, 0)>(vb), h0 = tr_read<v_rd_off(D0, 0, 1)>(vb), l1 = tr_read<v_rd_off(D0, 1, 0)>(vb), h1 = tr_read<v_rd_off(D0, 1, 1)>(vb);
  const s16x4 l2 = tr_read<v_rd_off(D0, 2, 0)>(vb), h2 = tr_read<v_rd_off(D0, 2, 1)>(vb), l3 = tr_read<v_rd_off(D0, 3, 0)>(vb), h3 = tr_read<v_rd_off(D0, 3, 1)>(vb);
  asm volatile("s_waitcnt lgkmcnt(0)" ::: "memory"); ATT_SBAR();
#define ATT_PK(L, H) (bf16x8){L[0], L[1], L[2], L[3], H[0], H[1], H[2], H[3]}
  od = __builtin_amdgcn_mfma_f32_32x32x16_bf16(pa0, ATT_PK(l0, h0), od, 0, 0, 0);
  od = __builtin_amdgcn_mfma_f32_32x32x16_bf16(pa1, ATT_PK(l1, h1), od, 0, 0, 0);
  od = __builtin_amdgcn_mfma_f32_32x32x16_bf16(pa2, ATT_PK(l2, h2), od, 0, 0, 0);
  od = __builtin_amdgcn_mfma_f32_32x32x16_bf16(pa3, ATT_PK(l3, h3), od, 0, 0, 0);
#undef ATT_PK
}
__device__ __forceinline__ void pv_d0(f32x16* o, int vb, bf16x8 pa0, bf16x8 pa1, bf16x8 pa2, bf16x8 pa3) {
  pv_one<0>(o[0], vb, pa0, pa1, pa2, pa3); pv_one<1>(o[1], vb, pa0, pa1, pa2, pa3); pv_one<2>(o[2], vb, pa0, pa1, pa2, pa3); pv_one<3>(o[3], vb, pa0, pa1, pa2, pa3);
}
struct KvSrc { int row0, n0, row1, n1; __device__ __forceinline__ int row(int t) const { const int u = t - n0; return t < n0 ? row0 + 64 * t : row1 + 64 * (u < n1 ? u : n1 - 1); } };
struct NatMask { int rlo, qrow, qcol; const LAS float* rpb; };

template <int DQK, int MODE, int ldq, int ldk, int ldv, int ldo>
__device__ __forceinline__ void attn_unit(const bf16* __restrict__ Qb, const bf16* __restrict__ Kh, const bf16* __restrict__ Vh,
                                          bf16* __restrict__ Ob, const KvSrc src, int NT, const NatMask nm, LAS char* lds, int tid) {
  constexpr float SCALE = DQK == 128 ? 0.088388347648318440f : 0.072168783648703220f;
  constexpr float C = SCALE * 1.4426950408889634f;
  constexpr int KROW = DQK * 2, SHM_K = KVBLK * KROW, NKC = DQK / 8, KCH = KVBLK * NKC / 512, ND0 = DQK / 16;
  const int wid = tid >> 6, lane = tid & 63, r32 = lane & 31, hi = lane >> 5;
  LAS char* V_lds = lds; LAS char* K_lds = lds + 2 * SHM_V;
  LAS float* ws = (LAS float*)(lds + 2 * SHM_V + 2 * SHM_K) + wid * 64; LAS float* li_l = ws; LAS float* al_l = ws + 32;
  float m_reg = -1e30f, l_reg = 0; f32x16 o[4] = {}; bf16x8 qr[ND0];
  { const bf16* Qw = Qb + (size_t)(wid * QBLK + r32) * ldq + hi * 8;
#pragma unroll
    for (int d0 = 0; d0 < ND0; ++d0) qr[d0] = *reinterpret_cast<const bf16x8*>(Qw + d0 * 16); }
  const int sr = tid >> 4, sc = (tid & 15) * 8, vst0 = v_st(sr, sc), vst1 = v_st(32 + sr, sc);
  unsigned koff_[KCH], kst_[KCH]; const unsigned voff0 = (unsigned)(sr * ldv + sc);
#pragma unroll
  for (int i = 0; i < KCH; ++i) { const int c = tid + 512 * i, kr = c / NKC, kc = c % NKC; koff_[i] = (unsigned)(kr * ldk + kc * 8); kst_[i] = (unsigned)(kr * KROW + ((kc * 16) ^ ((kr & 7) << 4))); }
  const int vb0 = (int)(uintptr_t)V_lds + v_rd_base(lane);
  bf16x8 svs0, svs1, sks[KCH];
#define ATT_SLOAD(t) do { const int _r = __builtin_amdgcn_readfirstlane(src.row(t)); const bf16* _vt = Vh + (size_t)_r * ldv; const bf16* _kt = Kh + (size_t)_r * ldk; \
    svs0 = *reinterpret_cast<const bf16x8*>(_vt + voff0); svs1 = *reinterpret_cast<const bf16x8*>(_vt + 32 * ldv + voff0); \
    _Pragma("unroll") for (int _i = 0; _i < KCH; ++_i) sks[_i] = *reinterpret_cast<const bf16x8*>(_kt + koff_[_i]); } while (0)
#define ATT_SWRITE(b) do { *(LAS bf16x8*)(V_lds + (b) * SHM_V + vst0) = svs0; *(LAS bf16x8*)(V_lds + (b) * SHM_V + vst1) = svs1; \
    _Pragma("unroll") for (int _i = 0; _i < KCH; ++_i) *(LAS bf16x8*)(K_lds + (b) * SHM_K + kst_[_i]) = sks[_i]; } while (0)
#define ATT_RESC(a) do { if (__any((a) < 1.f)) { if (hi == 0) al_l[r32] = (a); asm volatile("s_waitcnt lgkmcnt(0)" ::: "memory"); \
    _Pragma("unroll") for (int d = 0; d < 4; ++d) _Pragma("unroll") for (int r = 0; r < 16; ++r) o[d][r] *= al_l[crow(r, hi)]; } } while (0)
  auto qkt = [&](f32x16& p0, f32x16& p1, int b, int t) {
    const LAS char* Ks = K_lds + b * SHM_K;
    p0 = f32x16{}; p1 = f32x16{};
#pragma unroll
    for (int d0 = 0; d0 < ND0; ++d0) { const int cb = (d0 * 16 + hi * 8) * 2;
      const bf16x8 b0 = *reinterpret_cast<const LAS bf16x8*>(Ks + r32 * KROW + (cb ^ ((r32 & 7) << 4)));
      const bf16x8 b1 = *reinterpret_cast<const LAS bf16x8*>(Ks + (32 + r32) * KROW + (cb ^ ((r32 & 7) << 4)));
      p0 = __builtin_amdgcn_mfma_f32_32x32x16_bf16(b0, qr[d0], p0, 0, 0, 0);
      p1 = __builtin_amdgcn_mfma_f32_32x32x16_bf16(b1, qr[d0], p1, 0, 0, 0); }
    if constexpr (MODE == 1) {
      const int i = t - src.n0;
      if (i >= 0) {
        const int kr = nm.rlo + i, r0q = min(max(nm.qrow - 4, 0), 24), c0q = min(max(nm.qcol - 8, 0), 48);
        const bool rowok = (i < src.n1) && (kr >= r0q) && (kr < r0q + 8);
        const int rowoff = (kr - nm.qrow + 7) * 31 + 15 - nm.qcol;
#pragma unroll
        for (int r = 0; r < 16; ++r) {
          const int kc0 = crow(r, hi), kc1 = kc0 + 32;
          const bool ok0 = rowok && ((unsigned)(kc0 - c0q) < 16u), ok1 = rowok && ((unsigned)(kc1 - c0q) < 16u);
          const float b0 = nm.rpb[ok0 ? rowoff + kc0 : 0], b1 = nm.rpb[ok1 ? rowoff + kc1 : 0];
          p0[r] = ok0 ? p0[r] + b0 : -1e30f; p1[r] = ok1 ? p1[r] + b1 : -1e30f; }
      }
    }
  };
  auto partialSM = [&](f32x16& p0, f32x16& p1, float& mn, float& alpha) {
    float pmax = p0[0];
#pragma unroll
    for (int r = 1; r < 16; ++r) pmax = fmaxf(pmax, p0[r]);
#pragma unroll
    for (int r = 0; r < 16; ++r) pmax = fmaxf(pmax, p1[r]);
    { auto rr = __builtin_amdgcn_permlane32_swap(__float_as_uint(pmax), __float_as_uint(pmax), false, false); pmax = fmaxf(__uint_as_float(rr[0]), __uint_as_float(rr[1])); }
    if (__builtin_expect(__all(pmax - m_reg <= THR / SCALE), 1)) { mn = m_reg; alpha = 1.f; }
    else { mn = fmaxf(m_reg, pmax); alpha = __builtin_amdgcn_exp2f((m_reg - mn) * C); m_reg = mn; }
    const float mnC = -mn * C;
#pragma unroll
    for (int r = 0; r < 16; ++r) p0[r] = fmaf(p0[r], C, mnC);
#pragma unroll
    for (int r = 0; r < 16; ++r) p1[r] = fmaf(p1[r], C, mnC);
#pragma unroll
    for (int r = 0; r < 16; ++r) p0[r] = __builtin_amdgcn_exp2f(p0[r]);
  };
  auto finishSM = [&](f32x16& p0, f32x16& p1, float alpha, bf16x8& pa0, bf16x8& pa1, bf16x8& pa2, bf16x8& pa3) {
#pragma unroll
    for (int r = 0; r < 16; ++r) p1[r] = __builtin_amdgcn_exp2f(p1[r]);
    float ps = 0;
#pragma unroll
    for (int r = 0; r < 16; ++r) ps += p0[r];
#pragma unroll
    for (int r = 0; r < 16; ++r) ps += p1[r];
    { auto rr = __builtin_amdgcn_permlane32_swap(__float_as_uint(ps), __float_as_uint(ps), false, false); ps = __uint_as_float(rr[0]) + __uint_as_float(rr[1]); }
    l_reg = l_reg * alpha + ps;
#define ATT_PK4(P, BASE, OUT) do { unsigned a0 = cvtpk(P[BASE + 0], P[BASE + 1]), a1 = cvtpk(P[BASE + 2], P[BASE + 3]); \
    unsigned b0 = cvtpk(P[BASE + 4], P[BASE + 5]), b1 = cvtpk(P[BASE + 6], P[BASE + 7]); \
    auto r0 = __builtin_amdgcn_permlane32_swap(a0, b0, false, false); auto r1 = __builtin_amdgcn_permlane32_swap(a1, b1, false, false); \
    u32x4 w = {r0[0], r1[0], r0[1], r1[1]}; OUT = *reinterpret_cast<bf16x8*>(&w); } while (0)
    ATT_PK4(p0, 0, pa0); ATT_PK4(p0, 8, pa1); ATT_PK4(p1, 0, pa2); ATT_PK4(p1, 8, pa3);
#undef ATT_PK4
  };
  f32x16 p0, p1; float mn, al; bf16x8 pa0, pa1, pa2, pa3;
  ATT_SLOAD(0); asm volatile("s_waitcnt vmcnt(0)" ::: "memory"); ATT_SWRITE(0); if (NT > 1) ATT_SLOAD(1); __syncthreads();
  for (int t = 0; t < NT; ++t) {
    const int b = t & 1;
    ATT_SBAR(); qkt(p0, p1, b, t); ATT_SBAR();
    if (t + 1 < NT) { asm volatile("s_waitcnt vmcnt(0)" ::: "memory"); ATT_SWRITE(b ^ 1); if (t + 2 < NT) ATT_SLOAD(t + 2); }
    ATT_SBAR();
    partialSM(p0, p1, mn, al); ATT_RESC(al);
    finishSM(p0, p1, al, pa0, pa1, pa2, pa3); ATT_SBAR();
    pv_d0(o, vb0 + b * SHM_V, pa0, pa1, pa2, pa3);
    __syncthreads();
  }
  if (hi == 0) li_l[r32] = l_reg; asm volatile("s_waitcnt lgkmcnt(0)" ::: "memory");
  int hi_o = hi; asm volatile("" : "+v"(hi_o));
  bf16* Ow = Ob + (size_t)(wid * QBLK + 4 * hi_o) * ldo;
#pragma unroll
  for (int r = 0; r < 16; ++r) { const int orow = crow(r, 0); const float rl = __builtin_amdgcn_rcpf(li_l[orow + 4 * hi_o]);
#pragma unroll
    for (int d0 = 0; d0 < 4; ++d0) { const float v = o[d0][r] * rl; Ow[(size_t)orow * ldo + d0 * 32 + r32] = (bf16)(cvtpk(v, v) & 0xffffu); } }
#undef ATT_SLOAD
#undef ATT_SWRITE
#undef ATT_RESC
}
}
__device__ __forceinline__ void rope_table(const Args& a, int tid, int vcu, int G) {
    f32x2* RT = (f32x2*)(a.ws + WS_ROPE);
    for (int e = vcu * NTHR + tid; e < 2048 * 32; e += G * NTHR) { const int t = e >> 5, i = e & 31;
        const float inv = exp2f(-(float)(i & 15) * (13.287712379549449f / 16.f));
        const float ang = (float)(i < 16 ? (t >> 6) : (t & 63)) * inv; float s, c; sincosf(ang, &s, &c); RT[e] = (f32x2){c, s}; }
}
__device__ __forceinline__ void mla_thin_b(const Args& a, int j, int lane, int gw, int NGW) {
    OPAQUE_V(lane); PH_PTRS; OPAQUE_S(gw); OPAQUE_S(NGW);
    const bf16* QRAW = (const bf16*)(ws + WS_S + S_QRAW); bf16* QN = (bf16*)(ws + WS_S + S_QN);
    const bf16* KVRAW = (const bf16*)(ws + WS_S + S_KVRAW); bf16* KF = (bf16*)(ws + WS_S + S_KF);
    const float* KPE = (const float*)(ws + WS_S + S_KPE); const float* SSK = (const float*)(ws + WS_SSK);
    const f32x2* RT = (const f32x2*)(ws + WS_ROPE);
    const float* gqn = a.in[I_GQN] + (size_t)j * 192; const float* gkn = a.in[I_GKN] + (size_t)j * 192;
    const int grp = lane >> 4, s = lane & 15;
    float gq[12], gk[12];
#pragma unroll
    for (int e = 0; e < 8; ++e) { gq[e] = gqn[8 * s + e]; gk[e] = gkn[8 * s + e]; }
    gq[8] = gqn[128 + 2 * s]; gq[9] = gqn[129 + 2 * s]; gq[10] = gqn[160 + 2 * s]; gq[11] = gqn[161 + 2 * s];
    gk[8] = gkn[128 + 2 * s]; gk[9] = gkn[129 + 2 * s]; gk[10] = gkn[160 + 2 * s]; gk[11] = gkn[161 + 2 * s];
    const int NQI = MALL * 4, NKI = MKV * 4;
    for (int it = gw; it < NQI + NKI; it += NGW) {
        const bool isq = it < NQI; const int r4 = isq ? it : it - NQI; const int row = r4 >> 2, h = (r4 & 3) * 4 + grp;
        float x[12];
        if (isq) {
            const bf16* p = QRAW + (size_t)row * 3072 + h * 192;
            const v4u w = *(const GAS v4u*)(p + 8 * s); const unsigned w1 = *(const GAS unsigned*)(p + 128 + 2 * s), w2 = *(const GAS unsigned*)(p + 160 + 2 * s);
            x[0] = bf_lo(w.x); x[1] = bf_hi(w.x); x[2] = bf_lo(w.y); x[3] = bf_hi(w.y); x[4] = bf_lo(w.z); x[5] = bf_hi(w.z); x[6] = bf_lo(w.w); x[7] = bf_hi(w.w);
            x[8] = bf_lo(w1); x[9] = bf_hi(w1); x[10] = bf_lo(w2); x[11] = bf_hi(w2);
        } else {
            const bf16* p = KVRAW + (size_t)row * 4096 + h * 256;
            const v4u w = *(const GAS v4u*)(p + 8 * s);
            x[0] = bf_lo(w.x); x[1] = bf_hi(w.x); x[2] = bf_lo(w.y); x[3] = bf_hi(w.y); x[4] = bf_lo(w.z); x[5] = bf_hi(w.z); x[6] = bf_lo(w.w); x[7] = bf_hi(w.w);
            const f32x2 k1 = *(const GAS f32x2*)(KPE + (size_t)row * 64 + 2 * s), k2 = *(const GAS f32x2*)(KPE + (size_t)row * 64 + 32 + 2 * s);
            x[8] = k1.x; x[9] = k1.y; x[10] = k2.x; x[11] = k2.y;
        }
        float ss = 0.f;
#pragma unroll
        for (int e = 0; e < 8; ++e) ss += x[e] * x[e];
        if (isq) { ss += x[8] * x[8] + x[9] * x[9] + x[10] * x[10] + x[11] * x[11]; ss = sum16(ss); }
        else { ss = sum16(ss) + SSK[row]; }
        const float rs = rsqrtf(ss * (1.f / 192.f) + EPS);
#pragma unroll
        for (int e = 0; e < 12; ++e) x[e] = x[e] * rs * (isq ? gq[e] : gk[e]);
        if (row >= MP && row < MALL) {
            const int t = (row - MP) & 2047; const f32x2 cs0 = RT[t * 32 + 2 * s], cs1 = RT[t * 32 + 2 * s + 1];
            const float a0 = x[8] * cs0.x - x[10] * cs0.y, b0 = x[8] * cs0.y + x[10] * cs0.x, a1 = x[9] * cs1.x - x[11] * cs1.y, b1 = x[9] * cs1.y + x[11] * cs1.x;
            x[8] = a0; x[9] = a1; x[10] = b0; x[11] = b1;
        }
        bf16* o = (isq ? QN : KF) + (size_t)row * 3072 + h * 192;
        *(GAS v4u*)(o + 8 * s) = (v4u){pk2(x[0], x[1]), pk2(x[2], x[3]), pk2(x[4], x[5]), pk2(x[6], x[7])};
        *(GAS unsigned*)(o + 128 + 2 * s) = pk2(x[8], x[9]); *(GAS unsigned*)(o + 160 + 2 * s) = pk2(x[10], x[11]);
    }
}
__device__ __forceinline__ void mla_attn_phase(const Args& a, LAS unsigned char* lds, int tid, int vcu, int G) {
    OPAQUE_V(tid); PH_PTRS; OPAQUE_S(vcu); OPAQUE_S(G);
    const bf16* QN = (const bf16*)(ws + WS_S + S_QN); const bf16* KF = (const bf16*)(ws + WS_S + S_KF); const bf16* KVRAW = (const bf16*)(ws + WS_S + S_KVRAW);
    bf16* AO = (bf16*)(ws + WS_S + S_AO);
    for (int u = vcu; u < 768; u += G) {
        int q0, h, NT; att::KvSrc src;
        if (u < 256) { const int b = u >> 7, qb = u & 7; h = (u >> 3) & 15; q0 = MP + b * 2048 + qb * 256; src = att::KvSrc{MP + b * 2048, 32, MALL + b * 256, 4}; NT = 36; }
        else { const int v = u - 256, b = v >> 4; h = v & 15; q0 = b * 256; src = att::KvSrc{b * 256, 4, 0, 1}; NT = 4; }
        att::attn_unit<192, 0, 3072, 3072, 4096, DM>(QN + (size_t)q0 * 3072 + h * 192, KF + h * 192, KVRAW + h * 256 + 128, AO + (size_t)q0 * DM + h * 128, src, NT, att::NatMask{0, 0, 0, nullptr}, (LAS char*)lds, tid);
    }
}
namespace pg8 {
struct EpiHg {
    static constexpr bool PERM = true;
    unsigned char* ws;
    __device__ __forceinline__ void operator()(const f32x4 (&acc)[2][2][4][2], const Unit& u, int wr, int wc, int fr, int fq) const {
        const int region = u.pn >> 3, row0 = u.pm * BM + wr * 64 + fr, col0 = (u.pn & 7) * BM + wc * 32 + 8 * fq;
        if (region == 1 || region == 2) {
            const int d = region - 1;
            f32x4 lbv[2][2];
#pragma unroll
            for (int bj = 0; bj < 2; ++bj)
#pragma unroll
                for (int n = 0; n < 2; ++n) lbv[bj][n] = *(const f32x4*)((const float*)(ws + WS_LB) + d * 2048 + col0 + bj * HALF + 4 * n);
            bf16_t* K = (bf16_t*)(ws + WS_S + S_HK) + (size_t)d * 12288 * 2048; float* Gd = (float*)(ws + WS_U) + (size_t)d * 12288 * 2048;
#pragma unroll
            for (int ai = 0; ai < 2; ++ai)
#pragma unroll
                for (int m = 0; m < 4; ++m) { const size_t ro = (size_t)(row0 + ai * HALF + m * 16) * 2048 + col0;
#pragma unroll
                    for (int bj = 0; bj < 2; ++bj) { f32x4 kk[2], gg[2];
#pragma unroll
                        for (int n = 0; n < 2; ++n)
#pragma unroll
                            for (int e = 0; e < 4; ++e) { const float z = acc[ai][bj][m][n][e]; const float sn = __builtin_amdgcn_rcpf(1.f + __expf(z));
                                const float k = (1.f - lbv[bj][n][e]) * sn; kk[n][e] = k; gg[n][e] = __log2f(1.f - k); }
                        u32x4 w; w.x = cvt_pk_bf16(kk[0][0], kk[0][1]); w.y = cvt_pk_bf16(kk[0][2], kk[0][3]); w.z = cvt_pk_bf16(kk[1][0], kk[1][1]); w.w = cvt_pk_bf16(kk[1][2], kk[1][3]);
                        *(u32x4*)(K + ro + bj * HALF) = w; *(f32x4*)(Gd + ro + bj * HALF) = gg[0]; *(f32x4*)(Gd + ro + bj * HALF + 4) = gg[1]; } }
        } else {
            bf16_t* O = (bf16_t*)(ws + WS_S + (region == 0 ? S_HQ : region == 3 ? S_HV : S_HGS)); const bool act = region != 3;
#pragma unroll
            for (int ai = 0; ai < 2; ++ai)
#pragma unroll
                for (int m = 0; m < 4; ++m) { bf16_t* rowp = O + (size_t)(row0 + ai * HALF + m * 16) * 2048 + col0;
#pragma unroll
                    for (int bj = 0; bj < 2; ++bj) { f32x4 v0 = acc[ai][bj][m][0], v1 = acc[ai][bj][m][1];
                        if (act) {
#pragma unroll
                            for (int e = 0; e < 4; ++e) { v0[e] = v0[e] * __builtin_amdgcn_rcpf(1.f + __expf(-v0[e])); v1[e] = v1[e] * __builtin_amdgcn_rcpf(1.f + __expf(-v1[e])); } }
                        u32x4 w; w.x = cvt_pk_bf16(v0[0], v0[1]); w.y = cvt_pk_bf16(v0[2], v0[3]); w.z = cvt_pk_bf16(v1[0], v1[1]); w.w = cvt_pk_bf16(v1[2], v1[3]);
                        *(u32x4*)(rowp + bj * HALF) = w; } }
        }
    }
};
}

namespace hg {
constexpr int PQ = 272, PK = 80;
constexpr int OFF_QS = 0, OFF_QM = 32 * PQ, OFF_KM = 2 * 32 * PQ, OFF_KE = 3 * 32 * PQ, OFF_VT = OFF_KE + 128 * PK, OFF_ATT = OFF_VT + 128 * PK, OFF_EL = OFF_ATT + 32 * PK, BUF = OFF_EL + 512;
constexpr int OFF_TOT = 2 * BUF;
static_assert(OFF_TOT + 2048 <= 131072, "scan LDS");
typedef short bf16x8 __attribute__((ext_vector_type(8)));
struct Chain { int rb, N, d, h; const float* S0; float* Sout; };

__device__ __forceinline__ void scan_chain(const Chain ch, const bf16* __restrict__ HQ, const bf16* __restrict__ HK, const float* __restrict__ HG, const bf16* __restrict__ HV,
                                           float* __restrict__ OD, LAS unsigned char* lds, int tid) {
    const int lane = tid & 63, w = tid >> 6, l15 = lane & 15, q4 = lane >> 4;
    const int k = tid & 127, seg = tid >> 7;
    const int vt = tid >> 4, v8 = (tid & 15) * 8;
    const int nc = ch.N >> 5, hc = ch.h * 128;
    f32x4 S[8];
    if (ch.S0) {
#pragma unroll
        for (int kt = 0; kt < 8; ++kt)
#pragma unroll
            for (int r = 0; r < 4; ++r) S[kt][r] = ch.S0[(size_t)(16 * kt + 4 * q4 + r) * 128 + 16 * w + l15];
    } else {
#pragma unroll
        for (int kt = 0; kt < 8; ++kt) S[kt] = (f32x4){0.f, 0.f, 0.f, 0.f};
    }
    float g_[8]; unsigned short q_[8], k_[8]; v4u v_;
#define HG_ROW(c, t) (ch.rb + (ch.d ? ch.N - 1 - (32 * (c) + (t)) : 32 * (c) + (t)))
#define HG_LOAD(c) do { _Pragma("unroll") for (int i = 0; i < 8; ++i) { const size_t o_ = (size_t)HG_ROW(c, 8 * seg + i) * 2048 + hc + k; g_[i] = HG[o_]; q_[i] = HQ[o_]; k_[i] = HK[o_]; } \
        v_ = *(const GAS v4u*)(HV + (size_t)HG_ROW(c, vt) * 2048 + hc + v8); } while (0)
    HG_LOAD(0);
    LAS float* TOT = (LAS float*)(lds + hg::OFF_TOT);
    for (int c = 0; c < nc; ++c) {
        LAS unsigned char* B = lds + (c & 1) * BUF;
        float cl[8]; float run = 0.f;
#pragma unroll
        for (int i = 0; i < 8; ++i) { run += g_[i]; cl[i] = run; }
        TOT[seg * 128 + k] = run;
        float qf[8], kf[8];
#pragma unroll
        for (int i = 0; i < 8; ++i) { qf[i] = __uint_as_float((unsigned)q_[i] << 16); kf[i] = __uint_as_float((unsigned)k_[i] << 16); }
        const v4u vv = v_;
        if (c + 1 < nc) HG_LOAD(c + 1);
        LDS_WAIT(); __builtin_amdgcn_s_barrier(); asm volatile("" ::: "memory");
        const float t0 = TOT[k], t1 = TOT[128 + k], t2 = TOT[256 + k], t3 = TOT[384 + k];
        const float off = seg == 0 ? 0.f : seg == 1 ? t0 : seg == 2 ? t0 + t1 : t0 + t1 + t2;
        const float cm = t0 + t1, last = (t0 + t1) + (t2 + t3);
        unsigned short ke[8];
#pragma unroll
        for (int i = 0; i < 8; ++i) { const float cu = off + cl[i]; const int t = 8 * seg + i;
            const float eq = __builtin_amdgcn_exp2f(cu), eqm = __builtin_amdgcn_exp2f(cu - cm), ekm = __builtin_amdgcn_exp2f(cm - cu), eke = __builtin_amdgcn_exp2f(last - cu);
            *(LAS unsigned short*)(B + OFF_QS + t * PQ + k * 2) = (unsigned short)(pk2(qf[i] * eq, 0.f) & 0xffffu);
            *(LAS unsigned short*)(B + OFF_QM + t * PQ + k * 2) = (unsigned short)(pk2(qf[i] * eqm, 0.f) & 0xffffu);
            *(LAS unsigned short*)(B + OFF_KM + t * PQ + k * 2) = (unsigned short)(pk2(kf[i] * ekm, 0.f) & 0xffffu);
            ke[i] = (unsigned short)(pk2(kf[i] * eke, 0.f) & 0xffffu); }
        *(LAS v4u*)(B + OFF_KE + k * PK + seg * 16) = (v4u){(unsigned)ke[0] | ((unsigned)ke[1] << 16), (unsigned)ke[2] | ((unsigned)ke[3] << 16), (unsigned)ke[4] | ((unsigned)ke[5] << 16), (unsigned)ke[6] | ((unsigned)ke[7] << 16)};
        if (seg == 0) *(LAS float*)(B + OFF_EL + k * 4) = __builtin_amdgcn_exp2f(last);
        { const unsigned vw[4] = {vv.x, vv.y, vv.z, vv.w};
#pragma unroll
          for (int e = 0; e < 8; ++e) *(LAS unsigned short*)(B + OFF_VT + (v8 + e) * PK + vt * 2) = (unsigned short)((vw[e >> 1] >> ((e & 1) * 16)) & 0xffffu); }
        LDS_WAIT(); __builtin_amdgcn_s_barrier(); asm volatile("" ::: "memory");
        if (w < 4) {
            const int tt = w >> 1, st = w & 1; f32x4 at = (f32x4){0.f, 0.f, 0.f, 0.f};
            if (!(tt == 0 && st == 1)) {
#pragma unroll
                for (int ks = 0; ks < 4; ++ks) {
                    const bf16x8 af = *(const LAS bf16x8*)(B + OFF_QM + (16 * tt + l15) * PQ + (32 * ks + 8 * q4) * 2);
                    const bf16x8 bfr = *(const LAS bf16x8*)(B + OFF_KM + (16 * st + l15) * PQ + (32 * ks + 8 * q4) * 2);
                    at = __builtin_amdgcn_mfma_f32_16x16x32_bf16(af, bfr, at, 0, 0, 0); }
            }
            const int s = 16 * st + l15;
#pragma unroll
            for (int r = 0; r < 4; ++r) { const int t = 16 * tt + 4 * q4 + r; const float val = (s <= t) ? at[r] : 0.f;
                *(LAS unsigned short*)(B + OFF_ATT + t * PK + s * 2) = (unsigned short)(pk2(val, 0.f) & 0xffffu); }
        }
        LDS_WAIT(); __builtin_amdgcn_s_barrier(); asm volatile("" ::: "memory");
        const bf16x8 bv = *(const LAS bf16x8*)(B + OFF_VT + (16 * w + l15) * PK + 16 * q4);
        f32x4 o2[2];
#pragma unroll
        for (int tt = 0; tt < 2; ++tt) { const bf16x8 aa = *(const LAS bf16x8*)(B + OFF_ATT + (16 * tt + l15) * PK + 16 * q4);
            o2[tt] = __builtin_amdgcn_mfma_f32_16x16x32_bf16(aa, bv, (f32x4){0.f, 0.f, 0.f, 0.f}, 0, 0, 0); }
#pragma unroll
        for (int ks = 0; ks < 4; ++ks) {
            const v4u sb = (v4u){pk2(S[2 * ks][0], S[2 * ks][1]), pk2(S[2 * ks][2], S[2 * ks][3]), pk2(S[2 * ks + 1][0], S[2 * ks + 1][1]), pk2(S[2 * ks + 1][2], S[2 * ks + 1][3])};
            const bf16x8 bs = __builtin_bit_cast(bf16x8, sb);
#pragma unroll
            for (int tt = 0; tt < 2; ++tt) {
                const v2u a0 = *(const LAS v2u*)(B + OFF_QS + (16 * tt + l15) * PQ + (32 * ks + 4 * q4) * 2), a1 = *(const LAS v2u*)(B + OFF_QS + (16 * tt + l15) * PQ + (32 * ks + 16 + 4 * q4) * 2);
                const bf16x8 aq = __builtin_bit_cast(bf16x8, ((v4u){a0.x, a0.y, a1.x, a1.y}));
                o2[tt] = __builtin_amdgcn_mfma_f32_16x16x32_bf16(aq, bs, o2[tt], 0, 0, 0); }
        }
#pragma unroll
        for (int kt = 0; kt < 8; ++kt) { const f32x4 el = *(const LAS f32x4*)(B + OFF_EL + (16 * kt + 4 * q4) * 4);
            const bf16x8 ak = *(const LAS bf16x8*)(B + OFF_KE + (16 * kt + l15) * PK + 16 * q4);
            S[kt] = __builtin_amdgcn_mfma_f32_16x16x32_bf16(ak, bv, S[kt] * el, 0, 0, 0); }
#pragma unroll
        for (int tt = 0; tt < 2; ++tt)
#pragma unroll
            for (int r = 0; r < 4; ++r) OD[(size_t)HG_ROW(c, 16 * tt + 4 * q4 + r) * 2048 + hc + 16 * w + l15] = o2[tt][r];
    }
    if (ch.Sout) {
#pragma unroll
        for (int kt = 0; kt < 8; ++kt)
#pragma unroll
            for (int r = 0; r < 4; ++r) ch.Sout[(size_t)(16 * kt + 4 * q4 + r) * 128 + 16 * w + l15] = S[kt][r] * DBG_SCALE;
    }
#undef HG_ROW
#undef HG_LOAD
}
}

__device__ __forceinline__ void hg_scan_phase(const Args& a, LAS unsigned char* lds, int tid, int vcu, int G) {
    OPAQUE_V(tid); PH_PTRS; OPAQUE_S(vcu); OPAQUE_S(G);
    const bf16* HQ = (const bf16*)(ws + WS_S + S_HQ); const bf16* HK = (const bf16*)(ws + WS_S + S_HK); const float* HGp = (const float*)(ws + WS_U);
    const bf16* HV = (const bf16*)(ws + WS_S + S_HV); float* OF = (float*)(ws + WS_S + S_OF);
    const int NS = G > 128 ? 64 : 0;
    if (vcu < NS) {
        const int b = vcu >> 5, d = (vcu >> 4) & 1, h = vcu & 15;
        hg::Chain ch{MP + b * 2048, 2048, d, h, a.in[I_SHG] + ((size_t)((b * 2 + d) * 16 + h)) * 16384, nullptr};
        hg::scan_chain(ch, HQ, HK + (size_t)d * MALL * DM, HGp + (size_t)d * MALL * DM, HV, OF + (size_t)d * MALL * DM, lds, tid);
    } else {
        for (int pc = vcu - NS; pc < 1024 + (NS ? 0 : 64); pc += G - NS) {
            if (pc >= 1024) { const int sc = pc - 1024, b = sc >> 5, d = (sc >> 4) & 1, h = sc & 15;
                hg::Chain ch{MP + b * 2048, 2048, d, h, a.in[I_SHG] + ((size_t)((b * 2 + d) * 16 + h)) * 16384, nullptr};
                hg::scan_chain(ch, HQ, HK + (size_t)d * MALL * DM, HGp + (size_t)d * MALL * DM, HV, OF + (size_t)d * MALL * DM, lds, tid);
            } else { const int b = pc >> 5, d = (pc >> 4) & 1, h = pc & 15;
                hg::Chain ch{b * 256, 256, d, h, nullptr, out + O_HG + ((size_t)((b * 2 + d) * 16 + h)) * 16384};
                hg::scan_chain(ch, HQ, HK + (size_t)d * MALL * DM, HGp + (size_t)d * MALL * DM, HV, OF + (size_t)d * MALL * DM, lds, tid); }
        }
    }
}

__device__ __forceinline__ void hg_thin_c(const Args& a, int lane, int gw, int NGW) {
    OPAQUE_V(lane); PH_PTRS; OPAQUE_S(gw); OPAQUE_S(NGW);
    const float* OF = (const float*)(ws + WS_S + S_OF); const bf16* HGS = (const bf16*)(ws + WS_S + S_HGS); bf16* AO = (bf16*)(ws + WS_S + S_AO);
    const int grp = lane >> 4, s = lane & 15;
    const f32x4 g0 = *(const GAS f32x4*)(a.in[I_GHO] + 8 * s), g1 = *(const GAS f32x4*)(a.in[I_GHO] + 8 * s + 4);
    for (int it = gw; it < MALL * 4; it += NGW) {
        const int row = it >> 2, h = (it & 3) * 4 + grp; const size_t o_ = (size_t)row * DM + h * 128 + 8 * s;
        const f32x4 a0 = *(const GAS f32x4*)(OF + o_) + *(const GAS f32x4*)(OF + (size_t)MALL * DM + o_), a1 = *(const GAS f32x4*)(OF + o_ + 4) + *(const GAS f32x4*)(OF + (size_t)MALL * DM + o_ + 4);
        float ss = (a0.x * a0.x + a0.y * a0.y) + (a0.z * a0.z + a0.w * a0.w) + (a1.x * a1.x + a1.y * a1.y) + (a1.z * a1.z + a1.w * a1.w);
        const float rs = rsqrtf(sum16(ss) * (1.f / 128.f) + EPS);
        const v4u gw_ = *(const GAS v4u*)(HGS + o_);
        const f32x4 y0 = a0 * rs * g0 * (f32x4){bf_lo(gw_.x), bf_hi(gw_.x), bf_lo(gw_.y), bf_hi(gw_.y)}, y1 = a1 * rs * g1 * (f32x4){bf_lo(gw_.z), bf_hi(gw_.z), bf_lo(gw_.w), bf_hi(gw_.w)};
        *(GAS v4u*)(AO + o_) = (v4u){pk2(y0.x, y0.y), pk2(y0.z, y0.w), pk2(y1.x, y1.y), pk2(y1.z, y1.w)};
    }
}
__device__ __forceinline__ void nat_thin_d(const Args& a, int lane, int gw, int NGW) {
    OPAQUE_V(lane); PH_PTRS; OPAQUE_S(gw); OPAQUE_S(NGW);
    bf16* QKV = (bf16*)(ws + WS_S + S_NQKV); bf16* QN = (bf16*)(ws + WS_S + S_NQN); bf16* KN = (bf16*)(ws + WS_S + S_NKN);
    const int grp = lane >> 4, s = lane & 15;
    const f32x4 gq0 = *(const GAS f32x4*)(a.in[I_GNQ] + 8 * s), gq1 = *(const GAS f32x4*)(a.in[I_GNQ] + 8 * s + 4), gk0 = *(const GAS f32x4*)(a.in[I_GNK] + 8 * s), gk1 = *(const GAS f32x4*)(a.in[I_GNK] + 8 * s + 4);
    for (int it = gw; it < MKV * 4; it += NGW) {
        const int row = it >> 2, h = (it & 3) * 4 + grp, c = h * 128 + 8 * s;
        if (row < MALL) {
            const v4u qw = *(const GAS v4u*)(QKV + (size_t)row * 6144 + c), kw = *(const GAS v4u*)(QKV + (size_t)row * 6144 + 2048 + c);
            f32x4 q0 = {bf_lo(qw.x), bf_hi(qw.x), bf_lo(qw.y), bf_hi(qw.y)}, q1 = {bf_lo(qw.z), bf_hi(qw.z), bf_lo(qw.w), bf_hi(qw.w)};
            f32x4 k0 = {bf_lo(kw.x), bf_hi(kw.x), bf_lo(kw.y), bf_hi(kw.y)}, k1 = {bf_lo(kw.z), bf_hi(kw.z), bf_lo(kw.w), bf_hi(kw.w)};
            const float sq = (q0.x * q0.x + q0.y * q0.y) + (q0.z * q0.z + q0.w * q0.w) + (q1.x * q1.x + q1.y * q1.y) + (q1.z * q1.z + q1.w * q1.w);
            const float sk = (k0.x * k0.x + k0.y * k0.y) + (k0.z * k0.z + k0.w * k0.w) + (k1.x * k1.x + k1.y * k1.y) + (k1.z * k1.z + k1.w * k1.w);
            const float rq = rsqrtf(sum16(sq) * (1.f / 128.f) + EPS), rk = rsqrtf(sum16(sk) * (1.f / 128.f) + EPS);
            q0 = q0 * rq * gq0; q1 = q1 * rq * gq1; k0 = k0 * rk * gk0; k1 = k1 * rk * gk1;
            *(GAS v4u*)(QN + (size_t)row * DM + c) = (v4u){pk2(q0.x, q0.y), pk2(q0.z, q0.w), pk2(q1.x, q1.y), pk2(q1.z, q1.w)};
            *(GAS v4u*)(KN + (size_t)row * DM + c) = (v4u){pk2(k0.x, k0.y), pk2(k0.z, k0.w), pk2(k1.x, k1.y), pk2(k1.z, k1.w)};
            if (row < MP) {
                *(GAS f32x4*)(out + O_NK + (size_t)row * DM + c) = k0 * DBG_SCALE; *(GAS f32x4*)(out + O_NK + (size_t)row * DM + c + 4) = k1 * DBG_SCALE;
                const v4u vw = *(const GAS v4u*)(QKV + (size_t)row * 6144 + 4096 + c);
                *(GAS f32x4*)(out + O_NV + (size_t)row * DM + c) = (f32x4){bf_lo(vw.x), bf_hi(vw.x), bf_lo(vw.y), bf_hi(vw.y)} * DBG_SCALE;
                *(GAS f32x4*)(out + O_NV + (size_t)row * DM + c + 4) = (f32x4){bf_lo(vw.z), bf_hi(vw.z), bf_lo(vw.w), bf_hi(vw.w)} * DBG_SCALE;
            }
        } else {
            const size_t so = (size_t)(row - MALL) * DM + c;
            const f32x4 k0 = *(const GAS f32x4*)(a.in[I_CNK] + so), k1 = *(const GAS f32x4*)(a.in[I_CNK] + so + 4), v0 = *(const GAS f32x4*)(a.in[I_CNV] + so), v1 = *(const GAS f32x4*)(a.in[I_CNV] + so + 4);
            *(GAS v4u*)(KN + (size_t)row * DM + c) = (v4u){pk2(k0.x, k0.y), pk2(k0.z, k0.w), pk2(k1.x, k1.y), pk2(k1.z, k1.w)};
            *(GAS v4u*)(QKV + (size_t)row * 6144 + 4096 + c) = (v4u){pk2(v0.x, v0.y), pk2(v0.z, v0.w), pk2(v1.x, v1.y), pk2(v1.z, v1.w)};
        }
    }
}
__device__ __forceinline__ void nat_attn_phase(const Args& a, LAS unsigned char* lds, int tid, int vcu, int G) {
    OPAQUE_V(tid); PH_PTRS; OPAQUE_S(vcu); OPAQUE_S(G);
    const bf16* QKV = (const bf16*)(ws + WS_S + S_NQKV); const bf16* QN = (const bf16*)(ws + WS_S + S_NQN); const bf16* KN = (const bf16*)(ws + WS_S + S_NKN); bf16* AO = (bf16*)(ws + WS_S + S_AO);
    LAS float* rpb = (LAS float*)(lds + att::RPB_OFF);
    for (int u = vcu; u < 768; u += G) {
        if (u < 256) {
            const int b = u >> 7, h = (u >> 3) & 15, i = u & 7, q0 = MP + b * 2048 + i * 256;
            const int rlo = min(max(4 * i - 4, 0), 24), rhi = min(max(4 * i - 1, 0), 24) + 8, nrows = rhi - rlo;
            __syncthreads();
            for (int e = tid; e < 465; e += NTHR) rpb[e] = a.in[I_RPB][h * 465 + e] * 11.313708498984761f;
            __syncthreads();
            const att::KvSrc src{MALL + b * 256, 4, MP + b * 2048 + 64 * rlo, nrows};
            const att::NatMask nm{rlo, 4 * i + ((tid >> 6) >> 1), 32 * ((tid >> 6) & 1) + (tid & 31), rpb};
            att::attn_unit<128, 1, DM, DM, 6144, DM>(QN + (size_t)q0 * DM + h * 128, KN + h * 128, QKV + 4096 + h * 128, AO + (size_t)q0 * DM + h * 128, src, 4 + nrows, nm, (LAS char*)lds, tid);
        } else {
            const int v = u - 256, b = v >> 4, h = v & 15, q0 = b * 256;
            const att::KvSrc src{b * 256, 4, 0, 1};
            att::attn_unit<128, 0, DM, DM, 6144, DM>(QN + (size_t)q0 * DM + h * 128, KN + h * 128, QKV + 4096 + h * 128, AO + (size_t)q0 * DM + h * 128, src, 4, att::NatMask{0, 0, 0, nullptr}, (LAS char*)lds, tid);
        }
    }
}
constexpr int NPHASE = 2 + 10 * DEPTH;
__host__ __device__ constexpr bool phase_exists(int ph) {
    if (ph == 0 || ph == NPHASE - 1) return true;
    const int l = (ph - 1) / 10, k = (ph - 1) % 10, kind = l % 3;
    if (k == 3) return kind == 0;
    if (k == 4) return kind != 2;
    if (k == 5) return kind != 1;
    return true;
}

__global__ void __launch_bounds__(NTHR, 2) fwd(Args a) {
    extern __shared__ __attribute__((aligned(16))) unsigned char lds_[];
    LAS unsigned char* lds = (LAS unsigned char*)lds_;
    const int tid = threadIdx.x, lane = tid & 63, wave = __builtin_amdgcn_readfirstlane(tid >> 6);
    const int G = gridDim.x, bx = blockIdx.x, vcu = (G % 8 == 0) ? (bx % 8) * (G / 8) + bx / 8 : bx;
    const int gw = vcu * NWAVES + wave, NGW = G * NWAVES;
    volatile LAS unsigned* MISC = (volatile LAS unsigned*)(lds + MISC_OFF);
    unsigned* ctl = (unsigned*)(a.ws + WS_CTL);
    for (int u = tid; u < (LDS_BYTES - LDSCTL_OFF) / 4; u += NTHR) ((LAS unsigned*)(lds + LDSCTL_OFF))[u] = 0u;
    __syncthreads();
    XcdBarrier bar; bar.bar = ctl + CW_BAR; bar.x = 0; bar.st = nullptr;
    if (MK_SINGLE) bar = xcd_barrier_post(ctl + CW_BAR, MISC + 8);
    const int lo = a.ph_lo, hi = a.ph_hi;
#define IN(k) (lo <= (k) && (k) < hi)
#ifndef DBG_REP_MASK
#define DBG_REP_MASK 0
#endif
#define REPEAT(id) for (int rep_ = 0; rep_ < (((DBG_REP_MASK >> (id)) & 1) ? 3 : 1); ++rep_)
#define SEAM(k) do { if (MK_SINGLE && (k) + 1 < hi) xcd_barrier(bar); } while (0)
#define GEMM_PTRS PH_PTRS; int gG = G, gbx = bx; OPAQUE_S(gG); OPAQUE_S(gbx); bf16* const H = (bf16*)(ws + WS_H); bf16* const U = (bf16*)(ws + WS_U); bf16* const AO = (bf16*)(ws + WS_S + S_AO); float* const X = out + O_X; \
    const float* const MODS = (const float*)(ws + WS_MODS); (void)H; (void)U; (void)AO; (void)X; (void)MODS

    if (IN(0)) { REPEAT(0) { p0_prologue(a, lds, tid, lane, wave, vcu, G); rope_table(a, tid, vcu, G); if (DBG_REP_MASK & 1) __syncthreads(); } SEAM(0); }

    for (int l = 0; l < DEPTH; ++l) {
        const int kind = l % 3, j = l / 3, pb = 1 + 10 * l;
        if (IN(pb + 0)) { REPEAT(1) norm_phase(a, l, false, l > 0 ? (const float*)(a.ws + WS_MODS) + (size_t)(l - 1) * 3 * NMOD + 5 * DM : nullptr, lane, gw, NGW); SEAM(pb + 0); }
        if (kind == 0) {
            if (IN(pb + 1)) {
                GEMM_PTRS; unsigned char* wm = ws + WS_WMLA + (size_t)j * WMLA_STRIDE;
                pg8::Gemm g{H, (const bf16*)wm, MALL, 1536, DM, DM, DM, 1}; pg8::StaticOrder S; S.init(MALL, 1536, 1, gG, gbx, g.K);
                pg8::EpiF32 E{(float*)(ws + WS_S + S_QAKV), 1536};
                REPEAT(2) pg8::gemm_phase<pg8::EpiF32, pg8::StaticOrder>(lds, g, S, E);
                SEAM(pb + 1);
            }
            if (IN(pb + 2)) { REPEAT(3) mla_thin_a(a, j, lane, gw, NGW); SEAM(pb + 2); }
            if (IN(pb + 3)) {
                GEMM_PTRS; unsigned char* wm = ws + WS_WMLA + (size_t)j * WMLA_STRIDE;
                REPEAT(4) {
                { pg8::Gemm g{(const bf16*)(ws + WS_S + S_QAN), (const bf16*)(wm + WMLA_QB), MALL, 3072, 768, 768, 768, 1}; pg8::StaticOrder S; S.init(MALL, 3072, 1, gG, gbx, g.K);
                  pg8::EpiBf16<0> E{(bf16*)(ws + WS_S + S_QRAW), 3072};
                  pg8::gemm_phase<pg8::EpiBf16<0>, pg8::StaticOrder>(lds, g, S, E); }
                { pg8::Gemm g{(const bf16*)(ws + WS_S + S_CKVN), (const bf16*)(wm + WMLA_KVB), MKV, 4096, 512, 512, 512, 1}; pg8::StaticOrder S; S.init(MKV, 4096, 1, gG, gbx, g.K);
                  pg8::EpiBf16<0> E{(bf16*)(ws + WS_S + S_KVRAW), 4096};
                  pg8::gemm_phase<pg8::EpiBf16<0>, pg8::StaticOrder>(lds, g, S, E); }
                }
                SEAM(pb + 3);
            }
            if (IN(pb + 4)) { REPEAT(5) mla_thin_b(a, j, lane, gw, NGW); SEAM(pb + 4); }
            if (IN(pb + 5)) { REPEAT(6) mla_attn_phase(a, lds, tid, vcu, G); SEAM(pb + 5); }
        }
        if (kind == 1) {
            if (IN(pb + 1)) {
                GEMM_PTRS;
                pg8::Gemm g{H, (const bf16*)(ws + WS_WHG), MALL, 10240, DM, DM, DM, 1}; pg8::StaticOrder S; S.init(MALL, 10240, 1, gG, gbx, g.K);
                pg8::EpiHg E{ws};
                REPEAT(8) pg8::gemm_phase<pg8::EpiHg, pg8::StaticOrder>(lds, g, S, E);
                SEAM(pb + 1);
            }
            if (IN(pb + 2)) { REPEAT(9) hg_scan_phase(a, lds, tid, vcu, G); SEAM(pb + 2); }
            if (IN(pb + 4)) { REPEAT(10) hg_thin_c(a, lane, gw, NGW); SEAM(pb + 4); }
        }
        if (kind == 2) {
            if (IN(pb + 1)) {
                GEMM_PTRS;
                pg8::Gemm g{H, (const bf16*)(ws + WS_WNAT), MALL, 6144, DM, DM, DM, 1}; pg8::StaticOrder S; S.init(MALL, 6144, 1, gG, gbx, g.K);
                pg8::EpiBf16<0> E{(bf16*)(ws + WS_S + S_NQKV), 6144};
                REPEAT(11) pg8::gemm_phase<pg8::EpiBf16<0>, pg8::StaticOrder>(lds, g, S, E);
                SEAM(pb + 1);
            }
            if (IN(pb + 2)) { REPEAT(12) nat_thin_d(a, lane, gw, NGW); SEAM(pb + 2); }
            if (IN(pb + 5)) { REPEAT(13) nat_attn_phase(a, lds, tid, vcu, G); SEAM(pb + 5); }
        }
        if (IN(pb + 6)) {
            GEMM_PTRS;
            const bf16* wo = (const bf16*)(kind == 0 ? ws + WS_WMLA + (size_t)j * WMLA_STRIDE + WMLA_WO : kind == 1 ? ws + WS_WHG + WHG_WO : ws + WS_WNAT + WNAT_WO);
            pg8::Gemm g{AO, wo, MALL, DM, DM / 2, DM, DM, 2}; pg8::ResOrder S; S.init(gG, gbx, DM);
            pg8::EpiRes2 E{X, MODS + (size_t)l * 3 * NMOD + 2 * DM, (float*)(ws + WS_S + S_PART)};
            pg8::gemm_phase<pg8::EpiRes2, pg8::ResOrder>(lds, g, S, E);
            SEAM(pb + 6);
        }
        if (IN(pb + 7)) { REPEAT(1) norm_phase(a, l, true, (const float*)(a.ws + WS_MODS) + (size_t)l * 3 * NMOD + 2 * DM, lane, gw, NGW); SEAM(pb + 7); }
        if (IN(pb + 8)) {
            GEMM_PTRS;
            pg8::Gemm g{H, (const bf16*)(ws + WS_WFF1) + (size_t)l * DM * FF, MALL, FF, DM, DM, DM, 1}; pg8::StaticOrder S; S.init(MALL, FF, 1, gG, gbx, g.K);
            pg8::EpiBf16<1> E{U, FF};
            REPEAT(7) pg8::gemm_phase<pg8::EpiBf16<1>, pg8::StaticOrder>(lds, g, S, E);
            SEAM(pb + 8);
        }
        if (IN(pb + 9)) {
            GEMM_PTRS;
            pg8::Gemm g{U, (const bf16*)(ws + WS_WFF2) + (size_t)l * DM * FF, MALL, DM, FF / 2, FF, FF, 2}; pg8::ResOrder S; S.init(gG, gbx, FF);
            pg8::EpiRes2 E{X, MODS + (size_t)l * 3 * NMOD + 5 * DM, (float*)(ws + WS_S + S_PART)};
            pg8::gemm_phase<pg8::EpiRes2, pg8::ResOrder>(lds, g, S, E);
            SEAM(pb + 9);
        }
    }
    if (IN(NPHASE - 1)) final_fix_phase(a, (const float*)(a.ws + WS_MODS) + (size_t)(DEPTH - 1) * 3 * NMOD + 5 * DM, lane, gw, NGW);
#undef IN
#undef SEAM
}

extern "C" void kernel_launch(void* const* d_in, const int* in_sizes, int n_in, void* d_out, int out_size, void* d_ws, size_t ws_size, hipStream_t stream) {
    static int grid = 0;
    if (grid == 0) {
        if (n_in != N_IN || (size_t)out_size != O_END || ws_size < WS_END) { fprintf(stderr, "kernel_launch: shape mismatch n_in %d out %d ws %zu (need %zu); nothing launched\n", n_in, out_size, ws_size, (size_t)WS_END); grid = -1; return; }
        int dev = 0, cus = 0, per_cu = 0;
        if (hipGetDevice(&dev) != hipSuccess || hipDeviceGetAttribute(&cus, hipDeviceAttributeMultiprocessorCount, dev) != hipSuccess) { fprintf(stderr, "kernel_launch: device query failed\n"); grid = -1; return; }
        if (hipFuncSetAttribute((const void*)fwd, hipFuncAttributeMaxDynamicSharedMemorySize, LDS_BYTES) != hipSuccess) { fprintf(stderr, "kernel_launch: hipFuncSetAttribute failed\n"); grid = -1; return; }
        if (hipOccupancyMaxActiveBlocksPerMultiprocessor(&per_cu, (const void*)fwd, NTHR, LDS_BYTES) != hipSuccess || per_cu < 1) { fprintf(stderr, "kernel_launch: occupancy query says %d blocks/CU\n", per_cu); }
        (void)hipGetLastError();
        grid = cus;
    }
    if (grid < 0) return;
    if (hipMemsetAsync((char*)d_ws + WS_CTL, 0, CTL_ZERO_BYTES, stream) != hipSuccess) { fprintf(stderr, "kernel_launch: memset failed\n"); return; }
    Args a{};
    for (int i = 0; i < N_IN; ++i) a.in[i] = (const float*)d_in[i];
    a.out = (float*)d_out; a.ws = (unsigned char*)d_ws;
    int nt = 0, items = 0;
    auto add = [&](const float* src, size_t dst_off, int K, int N, int row_off) { TJob& t = a.tj[nt++]; t.src = src; t.dst = (bf16*)((unsigned char*)d_ws + dst_off); t.K = K; t.N = N; t.row_off = row_off; t.start = items; items += (K / 64) * (N / 32); };
    for (int l = 0; l < DEPTH; ++l) { add(a.in[I_WFF1] + (size_t)l * DM * FF, WS_WFF1 + (size_t)l * DM * FF * 2, DM, FF, 0); add(a.in[I_WFF2] + (size_t)l * DM * FF, WS_WFF2 + (size_t)l * DM * FF * 2, FF, DM, 0); }
    for (int j = 0; j < 2; ++j) { const size_t wb = WS_WMLA + (size_t)j * WMLA_STRIDE;
        add(a.in[I_WQA] + (size_t)j * DM * 768, wb, DM, 768, 0); add(a.in[I_WKVA] + (size_t)j * DM * 576, wb, DM, 576, 768);
        add(a.in[I_WQB] + (size_t)j * 768 * 3072, wb + WMLA_QB, 768, 3072, 0); add(a.in[I_WKVB] + (size_t)j * 512 * 4096, wb + WMLA_KVB, 512, 4096, 0);
        add(a.in[I_WMO] + (size_t)j * DM * DM, wb + WMLA_WO, DM, DM, 0); }
    add(a.in[I_WHQ], WS_WHG, DM, DM, 0); add(a.in[I_WHF], WS_WHG, DM, DM, 2048); add(a.in[I_WHF] + (size_t)DM * DM, WS_WHG, DM, DM, 4096);
    add(a.in[I_WHI], WS_WHG, DM, DM, 6144); add(a.in[I_WHG], WS_WHG, DM, DM, 8192); add(a.in[I_WHO], WS_WHG + WHG_WO, DM, DM, 0);
    add(a.in[I_WNQKV], WS_WNAT, DM, 3 * DM, 0); add(a.in[I_WNO], WS_WNAT + WNAT_WO, DM, DM, 0);
    a.ntj = nt; a.nitems = items;
#if MK_SINGLE
    a.ph_lo = 0; a.ph_hi = NPHASE < MK_LAST_PHASE ? NPHASE : MK_LAST_PHASE;
    hipLaunchKernelGGL(fwd, dim3(grid), dim3(NTHR), LDS_BYTES, stream, a);
#else
    for (int ph = 0; ph < NPHASE && ph < MK_LAST_PHASE; ++ph) {
        if (!phase_exists(ph)) continue;
        a.ph_lo = ph; a.ph_hi = ph + 1;
        hipLaunchKernelGGL(fwd, dim3(grid), dim3(NTHR), LDS_BYTES, stream, a);
    }
#endif
    const hipError_t le = hipPeekAtLastError();
    if (le != hipSuccess) fprintf(stderr, "kernel_launch: launch failed: %s\n", hipGetErrorName(le));
}
```

```cpp
#define MK_SINGLE 1
#define MK_LAST_PHASE 1000
#include <hip/hip_runtime.h>
#include <cstdio>
#include <cstdint>

#ifndef MK_SINGLE
#define MK_SINGLE 1
#endif
#ifndef WQA
#define WQA 12
#endif
#ifndef MK_LAST_PHASE
#define MK_LAST_PHASE 1000
#endif
namespace pg8 {
#define PG8_LAS __attribute__((address_space(3)))
#define PG8_GAS __attribute__((address_space(1)))
typedef unsigned short bf16_t;
typedef short bf16x8 __attribute__((ext_vector_type(8)));
typedef float f32x4 __attribute__((ext_vector_type(4)));
typedef unsigned u32x4 __attribute__((ext_vector_type(4)));
constexpr int BM = 256, BK = 64, HALF = 128, HTB = HALF * BK * 2  , STAGE_BYTES = 8 * HTB, NXCD = 8, WGM = 8;

__host__ __device__ __forceinline__ int lds_byte(int r, int c) { const int st = (r >> 4) * 2 + (c >> 5), rr = r & 15, cc = c & 31, ob = rr * 64 + cc * 2; return st * 1024 + (ob ^ (((ob >> 9) & 1) << 5)); }
__host__ __device__ __forceinline__ void stage_rc(int b, int& R, int& C) { const int st = b / 1024, sb = b % 1024, swz = sb ^ (((sb >> 9) & 1) << 5); R = (st >> 1) * 16 + swz / 64; C = (st & 1) * 32 + (swz % 64) / 2; }
__host__ __device__ __forceinline__ int perm32(int rho) { const int n = rho >> 4, i = rho & 15; return 8 * (i >> 2) + 4 * n + (i & 3); }

struct Unit { int pm, pn, ks, nkt, part, nh; };
struct Gemm { const bf16_t* A; const bf16_t* Bt; int M, N, K, lda, ldb, nsplit; };

struct StaticOrder {
    static constexpr bool HAS_NH = false;
    int nM, nN, nNv, nwg, G, c, nkt, split;
    __host__ __device__ void init(int M, int N, int nsplit, int G_, int c_, int K = 0) { nM = M / BM; nN = N / BM; nNv = nN * nsplit; nwg = nM * nNv; G = G_; c = c_; nkt = K / BK; split = nsplit; }
    __host__ __device__ bool next(int i, Unit& u) const {
        const long L = (long)i * G + c; if (L >= nwg) return false;
        int wgid = (int)L; { const int q = nwg / NXCD, r = nwg % NXCD, xcd = wgid % NXCD, off = wgid / NXCD; wgid = (xcd < r ? xcd * (q + 1) : r * (q + 1) + (xcd - r) * q) + off; }
        const int nig = WGM * nNv, gid = wgid / nig, fm = gid * WGM, gsz = (nM - fm) < WGM ? (nM - fm) : WGM;
        u.pm = fm + ((wgid % nig) % gsz); const int pv = (wgid % nig) / gsz; u.pn = pv % nN; u.ks = pv / nN; u.nkt = nkt; u.part = split > 1 ? u.ks : -1; u.nh = 0; return true;
    }
    __device__ __forceinline__ void a_ready(const Unit&) const {}
    __device__ __forceinline__ void done(const Unit&) const {}
};

struct QaOrder {
    static constexpr bool HAS_NH = true;
    StaticOrder M5; int G, c, nkt;
    __host__ __device__ void init(int G_, int c_, int K) { M5.init(12288, 1280, 1, G_, c_, K); G = G_; c = c_; nkt = K / BK; }
    __host__ __device__ bool next(int i, Unit& u) const {
        const int L = i * G + c;
        if (L < 240) return M5.next(i, u);
        if (L >= 288) return false;
        u.pm = L - 240; u.pn = 5; u.ks = 0; u.nkt = nkt; u.part = -1; u.nh = 1; return true;
    }
    __device__ __forceinline__ void a_ready(const Unit&) const {}
    __device__ __forceinline__ void done(const Unit&) const {}
};
struct ResOrder {
    static constexpr bool HAS_NH = false;
    int G, c, nkF, nkH;
    __host__ __device__ void init(int G_, int c_, int K) { G = G_; c = c_; nkF = K / BK; nkH = K / (2 * BK); }
    __host__ __device__ bool next(int i, Unit& u) const {
        const int L = i * G + c; if (L >= 512) return false;
        const bool half = L >= 256; int w = half ? L - 256 : L;
        w = (w & 7) * 32 + (w >> 3);
        const int sh = half ? 7 : 6, e = w & ((1 << sh) - 1), pv = e >> 3;
        u.pm = (half ? 32 : 0) + ((w >> sh) << 3) + (e & 7); u.pn = pv & 7; u.ks = pv >> 3; u.nkt = half ? nkH : nkF; u.part = half ? u.ks : -1; u.nh = 0; return true;
    }
    __device__ __forceinline__ void a_ready(const Unit&) const {}
    __device__ __forceinline__ void done(const Unit&) const {}
};

__device__ __forceinline__ unsigned cvt_pk_bf16(float lo, float hi) { unsigned r; asm("v_cvt_pk_bf16_f32 %0, %1, %2" : "=v"(r) : "v"(lo), "v"(hi)); return r; }


template <class Epi, class Sched, bool ALIGN_EPI = true, bool SP2 = true>
__device__ __forceinline__ void gemm_phase(PG8_LAS unsigned char* lds, const Gemm g, const Sched& S, const Epi& E) {
    int tid_ = threadIdx.x; asm volatile("" : "+v"(tid_));
    const int tid = tid_, wid = __builtin_amdgcn_readfirstlane(tid >> 6), lane = tid & 63, wr = wid >> 2, wc = wid & 3, fr = lane & 15, fq = lane >> 4;
    const int K = g.K;
    unsigned voffA[2], voffB[2];
#pragma unroll
    for (int i = 0; i < 2; ++i) { int R, C; stage_rc(tid * 16 + i * 8192, R, C); const int Rb = Epi::PERM ? ((R & ~31) + perm32(R & 31)) : R;
        voffA[i] = (unsigned)(R * g.lda + C) * 2u; voffB[i] = (unsigned)(Rb * g.ldb + C) * 2u; }
    const size_t kstep = (size_t)(BK * 2);
    const size_t hstepA = (size_t)HALF * g.lda * 2, hstepB = (size_t)HALF * g.ldb * 2;
    const size_t tstepA = 2 * hstepA, tstepB = 2 * hstepB;
    const size_t sstep = (size_t)K * 2;
    const unsigned ldsw = (unsigned)wid * 1024u;
    const int aoff = lds_byte(wr * 64 + fr, fq * 8), boff = lds_byte(wc * 32 + fr, fq * 8);
#define PG8_SA(b, h) (((b) * 2 + (h)) * HTB)
#define PG8_SB(b, h) ((4 + (b) * 2 + (h)) * HTB)
#define PG8_STAGE(bufoff, gbase, voff) do { _Pragma("unroll") for (int _i = 0; _i < 2; ++_i) \
        __builtin_amdgcn_global_load_lds((const unsigned*)((const char*)(gbase) + (voff)[_i]), (PG8_LAS unsigned*)(lds + (bufoff) + ldsw + _i * 8192), 16, 0, 0); } while (0)
#define PG8_LDA(dst, b, h) do { _Pragma("unroll") for (int m = 0; m < 4; ++m) _Pragma("unroll") for (int k = 0; k < 2; ++k) dst[m][k] = *(const PG8_LAS bf16x8*)(lds + PG8_SA(b, h) + aoff + m * 2048 + k * 1024); } while (0)
#define PG8_LDB(dst, b, h) do { _Pragma("unroll") for (int n = 0; n < 2; ++n) _Pragma("unroll") for (int k = 0; k < 2; ++k) dst[n][k] = *(const PG8_LAS bf16x8*)(lds + PG8_SB(b, h) + boff + n * 2048 + k * 1024); } while (0)
#define PG8_MMA(ai, bj, At, Bt) do { __builtin_amdgcn_s_setprio(1); _Pragma("unroll") for (int m = 0; m < 4; ++m) _Pragma("unroll") for (int n = 0; n < 2; ++n) _Pragma("unroll") for (int k = 0; k < 2; ++k) \
        acc[ai][bj][m][n] = __builtin_amdgcn_mfma_f32_16x16x32_bf16(Bt[n][k], At[m][k], acc[ai][bj][m][n], 0, 0, 0); __builtin_amdgcn_s_setprio(0); } while (0)
#define PG8_WAIT_V(n) asm volatile("s_waitcnt vmcnt(" #n ")" ::: "memory")
#define PG8_WAIT_L(n) asm volatile("s_waitcnt lgkmcnt(" #n ")" ::: "memory")
#define PG8_BAR __builtin_amdgcn_s_barrier()
#define PG8_SCHED __builtin_amdgcn_sched_barrier(0)
    Unit cur, nxt; int ui = 0;
    if (!S.next(0, cur)) return;
    f32x4 acc[2][2][4][2];
#pragma unroll
    for (int a = 0; a < 2; ++a)
#pragma unroll
        for (int b = 0; b < 2; ++b)
#pragma unroll
            for (int m = 0; m < 4; ++m)
#pragma unroll
                for (int n = 0; n < 2; ++n) acc[a][b][m][n] = (f32x4){0.f, 0.f, 0.f, 0.f};
    bf16x8 At[4][2], B0[2][2], B1[2][2];
    const char* cA = (const char*)g.A + (size_t)cur.pm * tstepA + (size_t)cur.ks * sstep; const char* cB = (const char*)g.Bt + (size_t)cur.pn * tstepB + (size_t)cur.ks * sstep;
    S.a_ready(cur);
    if constexpr (SP2) {
        PG8_STAGE(PG8_SB(0, 0), cB, voffB); PG8_STAGE(PG8_SB(0, 1), cB + hstepB, voffB); PG8_STAGE(PG8_SA(0, 0), cA, voffA); PG8_STAGE(PG8_SA(0, 1), cA + hstepA, voffA);
        if (wr == 1) PG8_BAR;
        PG8_WAIT_V(2); PG8_BAR;
        PG8_STAGE(PG8_SB(1, 0), cB + kstep, voffB); PG8_STAGE(PG8_SA(1, 0), cA + kstep, voffA); PG8_STAGE(PG8_SB(1, 1), cB + hstepB + kstep, voffB);
        PG8_WAIT_V(6); PG8_BAR;
    } else {
        PG8_STAGE(PG8_SB(0, 0), cB, voffB); PG8_STAGE(PG8_SA(0, 0), cA, voffA); PG8_STAGE(PG8_SB(0, 1), cB + hstepB, voffB); PG8_STAGE(PG8_SA(0, 1), cA + hstepA, voffA);
        if (wr == 1) PG8_BAR;
        PG8_WAIT_V(4); PG8_BAR;
        PG8_STAGE(PG8_SB(1, 0), cB + kstep, voffB); PG8_STAGE(PG8_SA(1, 0), cA + kstep, voffA); PG8_STAGE(PG8_SB(1, 1), cB + hstepB + kstep, voffB);
        PG8_WAIT_V(6); PG8_BAR;
    }
    for (;;) {
        const bool has_next = S.next(ui + 1, nxt);
        const char* nA = has_next ? (const char*)g.A + (size_t)nxt.pm * tstepA + (size_t)nxt.ks * sstep : cA; const char* nB = has_next ? (const char*)g.Bt + (size_t)nxt.pn * tstepB + (size_t)nxt.ks * sstep : cB;
        const int nt = cur.nkt; const bool nh = cur.nh != 0;
        for (int t = 0; t < nt; t += 2) {
            const bool last = (t == nt - 2);
            const char* a1 = cA + (size_t)(t + 1) * kstep;
            const char* a2 = last ? nA : cA + (size_t)(t + 2) * kstep; const char* b2 = last ? nB : cB + (size_t)(t + 2) * kstep;
            const char* a3 = a2 + kstep; const char* b3 = b2 + kstep;
            if (last && has_next) S.a_ready(nxt);
            if constexpr (SP2) {
            PG8_LDB(B0, 0, 0); PG8_LDB(B1, 0, 1); PG8_SCHED; PG8_LDA(At, 0, 0); PG8_STAGE(PG8_SA(1, 1), a1 + hstepA, voffA);
            PG8_WAIT_V(8); PG8_WAIT_L(0); PG8_BAR; PG8_MMA(0, 0, At, B0); if (!Sched::HAS_NH || !nh) PG8_MMA(0, 1, At, B1); PG8_BAR; PG8_SCHED;
            PG8_LDA(At, 0, 1); PG8_STAGE(PG8_SB(0, 0), b2, voffB); PG8_STAGE(PG8_SB(0, 1), b2 + hstepB, voffB); PG8_STAGE(PG8_SA(0, 0), a2, voffA);
            PG8_WAIT_V(8); PG8_WAIT_L(0); PG8_BAR; PG8_MMA(1, 0, At, B0); if (!Sched::HAS_NH || !nh) PG8_MMA(1, 1, At, B1); PG8_BAR; PG8_SCHED;
            PG8_LDB(B0, 1, 0); PG8_LDB(B1, 1, 1); PG8_SCHED; PG8_LDA(At, 1, 0); PG8_STAGE(PG8_SA(0, 1), a2 + hstepA, voffA);
            PG8_WAIT_V(8); PG8_WAIT_L(0); PG8_BAR; PG8_MMA(0, 0, At, B0); if (!Sched::HAS_NH || !nh) PG8_MMA(0, 1, At, B1); PG8_BAR; PG8_SCHED;
            PG8_LDA(At, 1, 1); PG8_STAGE(PG8_SB(1, 0), b3, voffB); PG8_STAGE(PG8_SB(1, 1), b3 + hstepB, voffB); PG8_STAGE(PG8_SA(1, 0), a3, voffA);
            PG8_WAIT_V(8); PG8_WAIT_L(0); PG8_BAR; PG8_MMA(1, 0, At, B0); if (!Sched::HAS_NH || !nh) PG8_MMA(1, 1, At, B1); PG8_BAR; PG8_SCHED;
            } else {
            PG8_LDB(B0, 0, 0); PG8_SCHED; PG8_LDA(At, 0, 0); PG8_STAGE(PG8_SA(1, 1), a1 + hstepA, voffA);
            PG8_WAIT_L(8); PG8_BAR; PG8_WAIT_L(0); PG8_MMA(0, 0, At, B0); PG8_BAR; PG8_SCHED;
            PG8_LDB(B1, 0, 1); PG8_STAGE(PG8_SB(0, 0), b2, voffB);
            PG8_BAR; PG8_WAIT_L(0); PG8_MMA(0, 1, At, B1); PG8_BAR;
            PG8_LDA(At, 0, 1); PG8_STAGE(PG8_SA(0, 0), a2, voffA);
            PG8_BAR; PG8_WAIT_L(0); PG8_MMA(1, 0, At, B0); PG8_BAR; PG8_SCHED;
            PG8_STAGE(PG8_SB(0, 1), b2 + hstepB, voffB);
            PG8_WAIT_V(6); PG8_BAR; PG8_MMA(1, 1, At, B1); PG8_BAR;
            PG8_LDB(B0, 1, 0); PG8_SCHED; PG8_LDA(At, 1, 0); PG8_STAGE(PG8_SA(0, 1), a2 + hstepA, voffA);
            PG8_WAIT_L(8); PG8_BAR; PG8_WAIT_L(0); PG8_MMA(0, 0, At, B0); PG8_BAR; PG8_SCHED;
            PG8_LDB(B1, 1, 1); PG8_STAGE(PG8_SB(1, 0), b3, voffB);
            PG8_BAR; PG8_WAIT_L(0); PG8_MMA(0, 1, At, B1); PG8_BAR;
            PG8_LDA(At, 1, 1); PG8_STAGE(PG8_SA(1, 0), a3, voffA);
            PG8_BAR; PG8_WAIT_L(0); PG8_MMA(1, 0, At, B0); PG8_BAR; PG8_SCHED;
            PG8_STAGE(PG8_SB(1, 1), b3 + hstepB, voffB);
            PG8_WAIT_V(6); PG8_BAR; PG8_MMA(1, 1, At, B1); PG8_BAR;
            }
        }
        if constexpr (ALIGN_EPI) { if (wr == 0) PG8_BAR; }
        E(acc, cur, wr, wc, fr, fq); S.done(cur);
        if (!has_next) break;
#pragma unroll
        for (int a = 0; a < 2; ++a)
#pragma unroll
            for (int b = 0; b < 2; ++b)
#pragma unroll
                for (int m = 0; m < 4; ++m)
#pragma unroll
                    for (int n = 0; n < 2; ++n) acc[a][b][m][n] = (f32x4){0.f, 0.f, 0.f, 0.f};
        cur = nxt; cA = nA; cB = nB; ++ui;
        if constexpr (ALIGN_EPI) { if (wr == 1) PG8_BAR; }
    }
    PG8_WAIT_V(0);
    if constexpr (!ALIGN_EPI) { if (wr == 0) PG8_BAR; }
    PG8_BAR;
#undef PG8_SA
#undef PG8_SB
#undef PG8_STAGE
#undef PG8_LDA
#undef PG8_LDB
#undef PG8_MMA
#undef PG8_WAIT_V
#undef PG8_WAIT_L
#undef PG8_BAR
#undef PG8_SCHED
}
}
constexpr int DM = 2048, MP = 8192, MS = 4096, MALL = 12288, MKV = 12800, FF = 8192, NMOD = 12288;
constexpr int NWAVES = 8, NTHR = 512, DEPTH = 4;
constexpr float EPS = 1e-6f;
constexpr size_t O_X = 0, O_CKV = 25165824, O_KPE = 33554432, O_HG = 34603008, O_NK = 51380224, O_NV = 68157440, O_END = 84934656;
enum { I_XP = 0, I_XS, I_CCKV, I_CKPE, I_SHG, I_CNK, I_CNV, I_C, I_CCTX, I_WMOD, I_BMOD, I_GMIX, I_GFFN, I_WQA, I_GQA, I_WQB, I_GQN, I_WKVA, I_GKVA, I_WKVB, I_GKN, I_WMO,
       I_WHQ, I_WHF, I_HLB, I_WHI, I_WHG, I_GHO, I_WHO, I_WNQKV, I_GNQ, I_GNK, I_RPB, I_WNO, I_WFF1, I_WFF2, N_IN };

constexpr size_t MiB = 1u << 20;
constexpr size_t WS_CTL = 0, CTL_ZERO_BYTES = 65536;
constexpr size_t WS_MODS = 2 * MiB;
constexpr size_t WS_LB = 3 * MiB;
constexpr size_t WS_SSK = 3 * MiB + 65536;
constexpr size_t WS_PROF = 3 * MiB + 786432;
constexpr size_t WS_ROPE = 3 * MiB + 131072;
constexpr size_t WS_WFF1 = 4 * MiB, WS_WFF2 = 132 * MiB;
constexpr size_t WS_WMLA = 260 * MiB, WMLA_STRIDE = 24 * MiB;
constexpr size_t WMLA_QB = 6 * MiB, WMLA_KVB = 11 * MiB, WMLA_WO = 15 * MiB;
constexpr size_t WS_WHG = 308 * MiB, WHG_WO = 40 * MiB;
constexpr size_t WS_WNAT = 356 * MiB, WNAT_WO = 24 * MiB;
constexpr size_t WS_H = 388 * MiB;
constexpr size_t WS_U = 436 * MiB;
constexpr size_t WS_S = 628 * MiB;
constexpr size_t S_AO = 0;
constexpr size_t S_QAKV = 48 * MiB, S_QAN = 120 * MiB, S_CKVN = 138 * MiB, S_KPE = 151 * MiB, S_QRAW = 155 * MiB, S_KVRAW = 227 * MiB, S_QN = 327 * MiB, S_KF = 399 * MiB;
constexpr size_t S_HQ = 48 * MiB, S_HK = 96 * MiB, S_HV = 192 * MiB, S_HGS = 240 * MiB, S_OF = 288 * MiB;
constexpr size_t S_NQKV = 48 * MiB, S_NQN = 198 * MiB, S_NKN = 246 * MiB;
constexpr size_t S_PART = 480 * MiB;
constexpr size_t S_X = 512 * MiB;
constexpr size_t WS_END = WS_S + 560 * MiB;
constexpr int CW_TMO = 0, CW_CODE = 1, CW_BAR = 4096;

constexpr int RING_BYTES = 131072;
constexpr int LDSCTL_OFF = 163840 - 512, MISC_OFF = LDSCTL_OFF + 320;
constexpr int EPI_TAB_OFF = LDSCTL_OFF - 8192;
constexpr int LDS_BYTES = 163840;

#define GAS __attribute__((address_space(1)))
#define LAS __attribute__((address_space(3)))
typedef unsigned short bf16;
typedef unsigned v4u __attribute__((ext_vector_type(4)));
typedef unsigned v2u __attribute__((ext_vector_type(2)));
typedef float f32x4 __attribute__((ext_vector_type(4)));
typedef float f32x2 __attribute__((ext_vector_type(2)));
typedef short bf16x8 __attribute__((ext_vector_type(8)));
typedef GAS unsigned gu32;
#define RLX_AGENT __ATOMIC_RELAXED, __HIP_MEMORY_SCOPE_AGENT
#define LDS_WAIT() asm volatile("s_waitcnt lgkmcnt(0)" ::: "memory")
#define VM_WAIT() asm volatile("s_waitcnt vmcnt(0)" ::: "memory")
#ifndef DBG_SCALE
#define DBG_SCALE 1.0f
#endif
#define OPAQUE_S(x) asm volatile("" : "+s"(x))
#define PH_PTRS unsigned char* ws = a.ws; float* out = a.out; OPAQUE_S(ws); OPAQUE_S(out)
#define OPAQUE_V(x) asm volatile("" : "+v"(x))
__device__ __forceinline__ unsigned pk2(float lo, float hi) { unsigned r; asm("v_cvt_pk_bf16_f32 %0, %1, %2" : "=v"(r) : "v"(lo), "v"(hi)); return r; }
__device__ __forceinline__ float bf_lo(unsigned w) { return __uint_as_float(w << 16); }
__device__ __forceinline__ float bf_hi(unsigned w) { return __uint_as_float(w & 0xffff0000u); }
__device__ __forceinline__ float wave_sum(float v) {
#pragma unroll
    for (int o = 1; o < 64; o <<= 1) v += __shfl_xor(v, o);
    return v;
}
__device__ __forceinline__ float sum16(float v) {
#pragma unroll
    for (int o = 1; o < 16; o <<= 1) v += __shfl_xor(v, o);
    return v;
}

#define XB_TMO      128
#define XB_XCNT(j)  (256  + 64 * (j))
#define XB_XSUB(j)  (1280 + 64 * (j))
#define XB_XGEN(j)  (2304 + 64 * (j))
#define XB_TOP      3328
#define XB_TOPGEN   3392
#define XCD_BAR_WORDS 3456
#define XB_SPIN_CAP (1u << 18)
__device__ __forceinline__ unsigned xb_ld(unsigned* p)              { return __hip_atomic_load(p, __ATOMIC_RELAXED, __HIP_MEMORY_SCOPE_AGENT); }
__device__ __forceinline__ unsigned xb_add(unsigned* p, unsigned v) { return __hip_atomic_fetch_add(p, v, __ATOMIC_RELAXED, __HIP_MEMORY_SCOPE_AGENT); }
__device__ __forceinline__ unsigned xb_xcc_id() { return (unsigned)__builtin_amdgcn_s_getreg((3 << 11) | 20) & 0xFu; }
#define XB_SPIN(cond, bar) do { unsigned _sp = 0; while (cond) { __builtin_amdgcn_s_sleep(1); \
    if ((++_sp & 255u) == 0u) { if (xb_ld(&(bar)[XB_TMO])) break; if (_sp > XB_SPIN_CAP) { atomicAdd(&(bar)[XB_TMO], 1u); break; } } } } while (0)
struct XcdBarrier { unsigned* bar; unsigned x; volatile LAS unsigned* st; };
__device__ __forceinline__ XcdBarrier xcd_barrier_post(unsigned* bar, volatile LAS unsigned* st) {
    XcdBarrier b; b.bar = bar; b.x = xb_xcc_id(); b.st = st;
    if (threadIdx.x == 0) (void)xb_add(&bar[XB_XCNT(b.x)], 1u);
    return b;
}
__device__ __forceinline__ void xcd_barrier_complete(unsigned* bar, unsigned x, unsigned& nloc, unsigned& nx) {
    const unsigned G = gridDim.x * gridDim.y * gridDim.z;
    unsigned sum, cnt, mine, sp = 0u;
    for (;;) {
        sum = 0u; cnt = 0u; mine = 0u;
#pragma unroll
        for (unsigned j = 0; j < 16; ++j) { const unsigned c = xb_ld(&bar[XB_XCNT(j)]); sum += c; cnt += (c > 0u) ? 1u : 0u; mine = (j == x) ? c : mine; }
        if (sum == G) break;
        __builtin_amdgcn_s_sleep(1);
        if ((++sp & 255u) == 0u) { if (xb_ld(&bar[XB_TMO])) break; if (sp > XB_SPIN_CAP) { atomicAdd(&bar[XB_TMO], 1u); break; } }
    }
    nloc = mine > 0u ? mine : 1u; nx = cnt > 0u ? cnt : 1u;
}
__device__ __forceinline__ void xcd_barrier(const XcdBarrier& b) {
    asm volatile("s_waitcnt vmcnt(0)" ::: "memory");
    __syncthreads();
    if (threadIdx.x == 0) {
        unsigned* bar = b.bar;
        __builtin_amdgcn_s_waitcnt(0);
        unsigned nloc = b.st[0], nx = b.st[1];
        if (nloc == 0u) { xcd_barrier_complete(bar, b.x, nloc, nx); b.st[0] = nloc; b.st[1] = nx; }
        const unsigned old = xb_add(&bar[XB_XSUB(b.x)], 1u);
        const unsigned gen = old / nloc;
        if (old + 1u == (gen + 1u) * nloc) {
            __builtin_amdgcn_fence(__ATOMIC_RELEASE, "agent");
            asm volatile("s_waitcnt vmcnt(0)" ::: "memory");
            const unsigned og = xb_add(&bar[XB_TOP], 1u);
            const unsigned tg = og / nx;
            if (og + 1u == (tg + 1u) * nx) xb_add(&bar[XB_TOPGEN], 1u);
            else XB_SPIN(xb_ld(&bar[XB_TOPGEN]) == tg, bar);
            __builtin_amdgcn_fence(__ATOMIC_ACQUIRE, "agent");
            xb_add(&bar[XB_XGEN(b.x)], 1u);
            asm volatile("s_waitcnt vmcnt(0)" ::: "memory");
        } else {
            XB_SPIN(xb_ld(&bar[XB_XGEN(b.x)]) == gen, bar);
            __builtin_amdgcn_fence(__ATOMIC_ACQUIRE, "agent");
            asm volatile("s_waitcnt vmcnt(0)" ::: "memory");
        }
    }
    __syncthreads();
}

struct TJob { const float* src; bf16* dst; int K, N, row_off, start; };
constexpr int MAX_TJ = 32;
struct Args { const float* in[N_IN]; float* out; unsigned char* ws; TJob tj[MAX_TJ]; int ntj, nitems, ph_lo, ph_hi;
              int wnd[12]; };

__device__ __forceinline__ void p0_transpose_item(const float* W, int K, int N, bf16* WT, int row_off, LAS float* scr, int item, int lane) {
    const int nblk = N / 32, kb = item / nblk, nb = item % nblk, k0 = 64 * kb, n0 = 32 * nb;
    { const int kr = lane >> 3, ns = (lane & 7) * 4;
      f32x4 t[8];
#pragma unroll
      for (int i = 0; i < 8; ++i) t[i] = __builtin_nontemporal_load((const GAS f32x4*)(W + (size_t)(k0 + kr + 8 * i) * N + n0 + ns));
#pragma unroll
      for (int i = 0; i < 8; ++i) { LAS float* d = scr + (kr + 8 * i) * 33 + ns; d[0] = t[i].x; d[1] = t[i].y; d[2] = t[i].z; d[3] = t[i].w; } }
    LDS_WAIT(); asm volatile("" ::: "memory");
    const int c = lane & 7;
#pragma unroll
    for (int j = 0; j < 4; ++j) { const int n = (lane >> 3) + 8 * j; const LAS float* s = scr + (8 * c) * 33 + n;
        v4u o; o.x = pk2(s[0 * 33], s[1 * 33]); o.y = pk2(s[2 * 33], s[3 * 33]); o.z = pk2(s[4 * 33], s[5 * 33]); o.w = pk2(s[6 * 33], s[7 * 33]);
        __builtin_nontemporal_store(o, (GAS v4u*)(WT + (size_t)(row_off + n0 + n) * K + k0 + 8 * c)); }
    LDS_WAIT(); asm volatile("" ::: "memory");
}

__device__ __forceinline__ void p0_convert_range(const Args& a, LAS unsigned char* lds, int lo, int hi, int idx, int stride, int lane, int wave) {
    OPAQUE_V(lane);
    LAS float* scr = (LAS float*)(lds + wave * 17408);
    const int kr = lane >> 3, ns = (lane & 7) * 4, c = lane & 7, nr = lane >> 3;
    for (int it = lo + idx; it < hi; it += 2 * stride) {
        const int it2 = it + stride < hi ? it + stride : it;
        int j = 0, j2 = 0;
        while (j + 1 < a.ntj && it >= a.tj[j + 1].start) ++j;
        while (j2 + 1 < a.ntj && it2 >= a.tj[j2 + 1].start) ++j2;
        const int N0 = a.tj[j].N, K0 = a.tj[j].K, e0 = it - a.tj[j].start, nb0 = N0 / 32, k00 = 64 * (e0 / nb0), n00 = 32 * (e0 % nb0);
        const int N1 = a.tj[j2].N, K1 = a.tj[j2].K, e1 = it2 - a.tj[j2].start, nb1 = N1 / 32, k01 = 64 * (e1 / nb1), n01 = 32 * (e1 % nb1);
        const float* W0 = a.tj[j].src + (size_t)(k00 + kr) * N0 + n00 + ns; const float* W1 = a.tj[j2].src + (size_t)(k01 + kr) * N1 + n01 + ns;
        f32x4 t0[8], t1[8];
#pragma unroll
        for (int i = 0; i < 8; ++i) t0[i] = __builtin_nontemporal_load((const GAS f32x4*)(W0 + (size_t)(8 * i) * N0));
#pragma unroll
        for (int i = 0; i < 8; ++i) t1[i] = __builtin_nontemporal_load((const GAS f32x4*)(W1 + (size_t)(8 * i) * N1));
#pragma unroll
        for (int i = 0; i < 8; ++i) { LAS float* d = scr + (kr + 8 * i) * 33 + ns; d[0] = t0[i].x; d[1] = t0[i].y; d[2] = t0[i].z; d[3] = t0[i].w; }
#pragma unroll
        for (int i = 0; i < 8; ++i) { LAS float* d = scr + 2112 + (kr + 8 * i) * 33 + ns; d[0] = t1[i].x; d[1] = t1[i].y; d[2] = t1[i].z; d[3] = t1[i].w; }
        LDS_WAIT(); asm volatile("" ::: "memory");
        bf16* D0 = a.tj[j].dst + (size_t)(a.tj[j].row_off + n00) * K0 + k00 + 8 * c; bf16* D1 = a.tj[j2].dst + (size_t)(a.tj[j2].row_off + n01) * K1 + k01 + 8 * c;
#pragma unroll
        for (int q = 0; q < 4; ++q) { const int n = nr + 8 * q; const LAS float* sp = scr + (8 * c) * 33 + n;
            v4u o; o.x = pk2(sp[0 * 33], sp[1 * 33]); o.y = pk2(sp[2 * 33], sp[3 * 33]); o.z = pk2(sp[4 * 33], sp[5 * 33]); o.w = pk2(sp[6 * 33], sp[7 * 33]);
            __builtin_nontemporal_store(o, (GAS v4u*)(D0 + (size_t)n * K0)); }
#pragma unroll
        for (int q = 0; q < 4; ++q) { const int n = nr + 8 * q; const LAS float* sp = scr + 2112 + (8 * c) * 33 + n;
            v4u o; o.x = pk2(sp[0 * 33], sp[1 * 33]); o.y = pk2(sp[2 * 33], sp[3 * 33]); o.z = pk2(sp[4 * 33], sp[5 * 33]); o.w = pk2(sp[6 * 33], sp[7 * 33]);
            __builtin_nontemporal_store(o, (GAS v4u*)(D1 + (size_t)n * K1)); }
        LDS_WAIT(); asm volatile("" ::: "memory");
    }
}

__device__ __forceinline__ float silu_f(float x) { return x / (1.f + __expf(-x)); }

__device__ __forceinline__ void p0_prologue(const Args& a, LAS unsigned char* lds, int tid, int lane, int wave, int vcu, int G) {
    OPAQUE_V(tid); OPAQUE_V(lane);
    float* mods = (float*)(a.ws + WS_MODS);
#ifndef DBG_REP_MASK
#define DBG_REP_MASK 0
#endif
    for (int rep_ = 0; rep_ < (((DBG_REP_MASK >> 14) & 1) ? 3 : 1); ++rep_)
    if (vcu < 768) {
        LAS f32x4* S3 = (LAS f32x4*)lds;
        LAS float* RED = (LAS float*)(lds + 32768);
        const float* cc = a.in[I_C]; const float* cx = a.in[I_CCTX];
        for (int k = tid; k < DM; k += NTHR) S3[k] = (f32x4){silu_f(cx[k]), silu_f(cc[k]), silu_f(cc[DM + k]), 0.f};
        __syncthreads();
        for (int tl = vcu; tl < 768; tl += G) {
            const int l = tl / 192, n = (tl % 192) * 64 + lane;
            const float* Wp = a.in[I_WMOD] + ((size_t)l * DM + wave * 256) * NMOD + n;
            float a0 = 0.f, a1 = 0.f, a2 = 0.f;
#pragma unroll 16
            for (int k = 0; k < 256; ++k) { const float wv = __builtin_nontemporal_load((const GAS float*)(Wp + (size_t)k * NMOD)); const f32x4 s = S3[wave * 256 + k]; a0 += s.x * wv; a1 += s.y * wv; a2 += s.z * wv; }
            RED[(wave * 3 + 0) * 64 + lane] = a0; RED[(wave * 3 + 1) * 64 + lane] = a1; RED[(wave * 3 + 2) * 64 + lane] = a2;
            __syncthreads();
            if (wave < 3) { float s = 0.f;
#pragma unroll
                for (int w = 0; w < 8; ++w) s += RED[(w * 3 + wave) * 64 + lane];
                mods[((size_t)l * 3 + wave) * NMOD + n] = s + a.in[I_BMOD][(size_t)l * NMOD + n]; }
            __syncthreads();
        }
    }
    { const int gt = vcu * NTHR + tid;
      if (gt < 2 * DM) { const int d = gt >> 11, c = gt & 2047; const float* hl = a.in[I_HLB] + (size_t)d * 4 * DM + c;
          const float x0 = hl[0], x1 = hl[DM], x2 = hl[2 * DM], x3 = hl[3 * DM]; const float m = fmaxf(fmaxf(x0, x1), fmaxf(x2, x3));
          const float e0 = __expf(x0 - m), e1 = __expf(x1 - m), e2 = __expf(x2 - m), e3 = __expf(x3 - m);
          ((float*)(a.ws + WS_LB))[gt] = e1 / (e0 + e1 + e2 + e3); } }
    __syncthreads();
    const int gw = vcu * NWAVES + wave, NGW = G * NWAVES;
    for (int rep_ = 0; rep_ < (((DBG_REP_MASK >> 15) & 1) ? 3 : 1); ++rep_)
    p0_convert_range(a, lds, a.wnd[0], a.wnd[1], gw, NGW, lane, wave);
#if defined(DBG_ZERO_OUT)
    { const size_t gt = (size_t)vcu * NTHR + tid, NT = (size_t)G * NTHR;
      for (size_t i = gt; i < (O_END - O_CKV) / 4; i += NT) *(GAS f32x4*)(a.out + O_CKV + 4 * i) = (f32x4){0.f, 0.f, 0.f, 0.f}; }
#endif
    { const int gt = vcu * NTHR + tid, NT = G * NTHR;
      for (int i = gt; i < 2 * 192 * DM / 8; i += NT) { const int j = i / (192 * DM / 8), r = i % (192 * DM / 8);
          *(GAS v4u*)(a.ws + WS_WMLA + j * WMLA_STRIDE + (size_t)1344 * DM * 2 + (size_t)r * 16) = (v4u){0u, 0u, 0u, 0u}; } }
}

__device__ __forceinline__ int cond_of_row(int row) { return row < MP ? 0 : 1 + ((row - MP) >> 11); }

__device__ __forceinline__ void norm_phase(const Args& a, int l, bool ffn, const float* fixgate, int lane, int gw, int NGW) {
    OPAQUE_V(lane); PH_PTRS; OPAQUE_S(gw); OPAQUE_S(NGW);
    const float* g = a.in[ffn ? I_GFFN : I_GMIX] + (size_t)l * DM;
    const float* mods = (const float*)(ws + WS_MODS) + (size_t)l * 3 * NMOD + (ffn ? 3 * DM : 0);
    bf16* H = (bf16*)(ws + WS_H); bf16* X = (bf16*)(ws + WS_S + S_X);
    const bool first = (l == 0 && !ffn);
    for (int row = gw; row < MALL; row += NGW) {
        const float* md = mods + (size_t)cond_of_row(row) * NMOD;
        f32x4 v[8]; float ss = 0.f;
        const bool fix = fixgate != nullptr && row >= MP;
        const bf16* P0 = (const bf16*)(ws + WS_S + S_PART) + (size_t)(row - MP) * DM; const float* fg = fixgate + (size_t)cond_of_row(row) * NMOD;
        if (first) { const float* xr = row < MP ? a.in[I_XP] + (size_t)row * DM : a.in[I_XS] + (size_t)(row - MP) * DM;
#pragma unroll
            for (int j = 0; j < 8; ++j) v[j] = __builtin_nontemporal_load((const GAS f32x4*)(xr + 4 * (lane + 64 * j)));
        } else { const bf16* xr = X + (size_t)row * DM;
#pragma unroll
            for (int j = 0; j < 8; ++j) { const v2u w = *(const GAS v2u*)(xr + 4 * (lane + 64 * j)); v[j] = (f32x4){bf_lo(w.x), bf_hi(w.x), bf_lo(w.y), bf_hi(w.y)}; } }
#pragma unroll
        for (int j = 0; j < 8; ++j) {
            if (fix) { const int c = 4 * (lane + 64 * j); const v2u pw = __builtin_nontemporal_load((const GAS v2u*)(P0 + c)); v[j] = v[j] + *(const GAS f32x4*)(fg + c) * (f32x4){bf_lo(pw.x), bf_hi(pw.x), bf_lo(pw.y), bf_hi(pw.y)}; }
            ss += (v[j].x * v[j].x + v[j].y * v[j].y) + (v[j].z * v[j].z + v[j].w * v[j].w); }
        const float rs = rsqrtf(wave_sum(ss) * (1.f / DM) + EPS);
#pragma unroll
        for (int j = 0; j < 8; ++j) { const int c = 4 * (lane + 64 * j);
            const f32x4 gg = *(const GAS f32x4*)(g + c), sh = *(const GAS f32x4*)(md + c), sc = *(const GAS f32x4*)(md + DM + c);
            const f32x4 y = v[j] * rs * gg * (sc + 1.f) + sh;
            *(GAS v2u*)(H + (size_t)row * DM + c) = (v2u){pk2(y.x, y.y), pk2(y.z, y.w)};
            if (first || fix) *(GAS v2u*)(X + (size_t)row * DM + c) = (v2u){pk2(v[j].x, v[j].y), pk2(v[j].z, v[j].w)}; }
    }
}
__device__ __forceinline__ void final_fix_phase(const Args& a, const float* fixgate, int lane, int gw, int NGW) {
    OPAQUE_V(lane); PH_PTRS; OPAQUE_S(gw); OPAQUE_S(NGW);
    for (int row = MP + gw; row < MALL; row += NGW) {
        const bf16* P0 = (const bf16*)(ws + WS_S + S_PART) + (size_t)(row - MP) * DM; const float* fg = fixgate + (size_t)cond_of_row(row) * NMOD; float* xr = out + O_X + (size_t)row * DM;
#pragma unroll
        for (int j = 0; j < 8; ++j) { const int c = 4 * (lane + 64 * j); const v2u pw = *(const GAS v2u*)(P0 + c);
            *(GAS f32x4*)(xr + c) = *(const GAS f32x4*)(xr + c) + *(const GAS f32x4*)(fg + c) * (f32x4){bf_lo(pw.x), bf_hi(pw.x), bf_lo(pw.y), bf_hi(pw.y)}; }
    }
}
__device__ __forceinline__ void mla_thin_a(const Args& a, int j, int lane, int gw, int NGW) {
    OPAQUE_V(lane); PH_PTRS; OPAQUE_S(gw); OPAQUE_S(NGW);
    const bf16* QAKV = (const bf16*)(ws + WS_S + S_QAKV);
    bf16* QAN = (bf16*)(ws + WS_S + S_QAN); bf16* CKVN = (bf16*)(ws + WS_S + S_CKVN); float* KPE = (float*)(ws + WS_S + S_KPE); float* SSK = (float*)(ws + WS_SSK);
    const float* gqa = a.in[I_GQA] + (size_t)j * 768; const float* gkva = a.in[I_GKVA] + (size_t)j * 512;
    for (int row = gw; row < MKV; row += NGW) {
        if (row < MALL) {
            const bf16* r = QAKV + (size_t)row * 1536;
#define LD4(p_) ({ const v2u w_ = *(const GAS v2u*)(p_); (f32x4){bf_lo(w_.x), bf_hi(w_.x), bf_lo(w_.y), bf_hi(w_.y)}; })
            { f32x4 v[3]; float ss = 0.f;
#pragma unroll
              for (int i = 0; i < 3; ++i) { v[i] = LD4(r + 4 * (lane + 64 * i)); ss += (v[i].x * v[i].x + v[i].y * v[i].y) + (v[i].z * v[i].z + v[i].w * v[i].w); }
              const float rs = rsqrtf(wave_sum(ss) * (1.f / 768.f) + EPS);
#pragma unroll
              for (int i = 0; i < 3; ++i) { const int c = 4 * (lane + 64 * i); const f32x4 y = v[i] * rs * *(const GAS f32x4*)(gqa + c);
                  *(GAS v2u*)(QAN + (size_t)row * 768 + c) = (v2u){pk2(y.x, y.y), pk2(y.z, y.w)}; } }
            { f32x4 v[2]; float ss = 0.f;
#pragma unroll
              for (int i = 0; i < 2; ++i) { v[i] = LD4(r + 768 + 4 * (lane + 64 * i)); ss += (v[i].x * v[i].x + v[i].y * v[i].y) + (v[i].z * v[i].z + v[i].w * v[i].w); }
              const float rs = rsqrtf(wave_sum(ss) * (1.f / 512.f) + EPS);
#pragma unroll
              for (int i = 0; i < 2; ++i) { const int c = 4 * (lane + 64 * i); const f32x4 y = v[i] * rs * *(const GAS f32x4*)(gkva + c);
                  *(GAS v2u*)(CKVN + (size_t)row * 512 + c) = (v2u){pk2(y.x, y.y), pk2(y.z, y.w)};
                  if (row < MP) __builtin_nontemporal_store(y * DBG_SCALE, (GAS f32x4*)(out + O_CKV + ((size_t)((row >> 8) * 2 + j) * 256 + (row & 255)) * 512 + c)); } }
            { const float kp = __uint_as_float((unsigned)r[1280 + lane] << 16); KPE[(size_t)row * 64 + lane] = kp;
              if (row < MP) out[O_KPE + ((size_t)((row >> 8) * 2 + j) * 256 + (row & 255)) * 64 + lane] = kp * DBG_SCALE;
              const float s = wave_sum(kp * kp); if (lane == 0) SSK[row] = s; }
#undef LD4
        } else {
            const int cr = row - MALL, b = cr >> 8, t = cr & 255; const size_t src = (size_t)((b * 2 + j) * 256 + t);
            const float* ck = a.in[I_CCKV] + src * 512;
#pragma unroll
            for (int i = 0; i < 2; ++i) { const int c = 4 * (lane + 64 * i); const f32x4 y = *(const GAS f32x4*)(ck + c);
                *(GAS v2u*)(CKVN + (size_t)row * 512 + c) = (v2u){pk2(y.x, y.y), pk2(y.z, y.w)}; }
            const float kp = a.in[I_CKPE][src * 64 + lane]; KPE[(size_t)row * 64 + lane] = kp;
            const float s = wave_sum(kp * kp); if (lane == 0) SSK[row] = s;
        }
    }
}
namespace pg8 {
struct EpiF32 {
    static constexpr bool PERM = false;
    float* C; int ldc;
    __device__ __forceinline__ void operator()(const f32x4 (&acc)[2][2][4][2], const Unit& u, int wr, int wc, int fr, int fq) const {
        const int row0 = u.pm * BM + wr * 64 + fr, col0 = u.pn * BM + wc * 32 + 4 * fq;
#pragma unroll
        for (int ai = 0; ai < 2; ++ai)
#pragma unroll
            for (int m = 0; m < 4; ++m) { float* rowp = C + (size_t)(row0 + ai * HALF + m * 16) * ldc + col0;
#pragma unroll
                for (int bj = 0; bj < 2; ++bj)
#pragma unroll
                    for (int n = 0; n < 2; ++n) *(PG8_GAS f32x4*)(rowp + bj * HALF + n * 16) = acc[ai][bj][m][n]; }
    }
};
template <int ACT  > struct EpiBf16 {
    static constexpr bool PERM = true;
    bf16_t* O; int ldc;
    __device__ __forceinline__ void operator()(const f32x4 (&acc)[2][2][4][2], const Unit& u, int wr, int wc, int fr, int fq) const {
        const int row0 = u.pm * BM + wr * 64 + fr, col0 = u.pn * BM + wc * 32 + 8 * fq;
#pragma unroll
        for (int ai = 0; ai < 2; ++ai)
#pragma unroll
            for (int m = 0; m < 4; ++m) { bf16_t* rowp = O + (size_t)(row0 + ai * HALF + m * 16) * ldc + col0;
#pragma unroll
                for (int bj = 0; bj < 2; ++bj) { f32x4 v0 = acc[ai][bj][m][0], v1 = acc[ai][bj][m][1];
                    if (ACT == 1) {
#pragma unroll
                        for (int e = 0; e < 4; ++e) { const float x0 = fmaxf(v0[e], 0.f), x1 = fmaxf(v1[e], 0.f); v0[e] = x0 * x0; v1[e] = x1 * x1; } }
                    u32x4 w; w.x = cvt_pk_bf16(v0[0], v0[1]); w.y = cvt_pk_bf16(v0[2], v0[3]); w.z = cvt_pk_bf16(v1[0], v1[1]); w.w = cvt_pk_bf16(v1[2], v1[3]);
                    *(PG8_GAS u32x4*)(rowp + bj * HALF) = w; } }
    }
};
template <bool ATOMIC> struct EpiRes {
    static constexpr bool PERM = false;
    float* X; const float* gate;
    __device__ __forceinline__ void operator()(const f32x4 (&acc)[2][2][4][2], const Unit& u, int wr, int wc, int fr, int fq) const {
        const int rb = u.pm * BM, row0 = rb + wr * 64 + fr, col0 = u.pn * BM + wc * 32 + 4 * fq;
        const int cond = rb < 8192 ? 0 : 1 + ((rb - 8192) >> 11);
        const float* gp = gate + (size_t)cond * 12288 + col0;
        f32x4 gv[2][2];
#pragma unroll
        for (int bj = 0; bj < 2; ++bj)
#pragma unroll
            for (int n = 0; n < 2; ++n) gv[bj][n] = *(const PG8_GAS f32x4*)(gp + bj * HALF + n * 16);
#pragma unroll
        for (int ai = 0; ai < 2; ++ai)
#pragma unroll
            for (int m = 0; m < 4; ++m) { float* rowp = X + (size_t)(row0 + ai * HALF + m * 16) * 2048 + col0;
#pragma unroll
                for (int bj = 0; bj < 2; ++bj)
#pragma unroll
                    for (int n = 0; n < 2; ++n) { float* p = rowp + bj * HALF + n * 16; const f32x4 d = gv[bj][n] * acc[ai][bj][m][n];
                        if (ATOMIC) {
#pragma unroll
                            for (int e = 0; e < 4; ++e) __hip_atomic_fetch_add((PG8_GAS float*)(p + e), d[e], __ATOMIC_RELAXED, __HIP_MEMORY_SCOPE_AGENT);
                        } else { *(PG8_GAS f32x4*)p = *(const PG8_GAS f32x4*)p + d; } }
                asm volatile("" ::: "memory"); }
    }
};
struct EpiRes2 {
    static constexpr bool PERM = false;
    bf16_t* X; const float* gate; bf16_t* P; float* Yout;
    __device__ __forceinline__ void operator()(const f32x4 (&acc)[2][2][4][2], const Unit& u, int wr, int wc, int fr, int fq) const {
        typedef unsigned u32x2_ __attribute__((ext_vector_type(2)));
        const int rb = u.pm * BM, row0 = rb + wr * 64 + fr, col0 = u.pn * BM + wc * 32 + 4 * fq;
        if (u.part <= 0) {
            const int cond = rb < 8192 ? 0 : 1 + ((rb - 8192) >> 11);
            const float* gp = gate + (size_t)cond * 12288 + col0;
            f32x4 gv[2][2];
#pragma unroll
            for (int bj = 0; bj < 2; ++bj)
#pragma unroll
                for (int n = 0; n < 2; ++n) gv[bj][n] = *(const PG8_GAS f32x4*)(gp + bj * HALF + n * 16);
#pragma unroll
            for (int ai = 0; ai < 2; ++ai)
#pragma unroll
                for (int m = 0; m < 4; ++m) { const size_t ro = (size_t)(row0 + ai * HALF + m * 16) * 2048 + col0;
#pragma unroll
                    for (int bj = 0; bj < 2; ++bj)
#pragma unroll
                        for (int n = 0; n < 2; ++n) { const size_t o = ro + bj * HALF + n * 16; const u32x2_ w = *(const PG8_GAS u32x2_*)(X + o);
                            const f32x4 xn = (f32x4){__uint_as_float(w.x << 16), __uint_as_float(w.x & 0xffff0000u), __uint_as_float(w.y << 16), __uint_as_float(w.y & 0xffff0000u)} + gv[bj][n] * acc[ai][bj][m][n];
                            if (Yout != nullptr) *(PG8_GAS f32x4*)(Yout + o) = xn; else *(PG8_GAS u32x2_*)(X + o) = (u32x2_){cvt_pk_bf16(xn[0], xn[1]), cvt_pk_bf16(xn[2], xn[3])}; }
                    asm volatile("" ::: "memory"); }
        } else {
            bf16_t* Pp = P + (size_t)(row0 - 8192) * 2048 + col0;
#pragma unroll
            for (int ai = 0; ai < 2; ++ai)
#pragma unroll
                for (int m = 0; m < 4; ++m) { bf16_t* rowp = Pp + (size_t)(ai * HALF + m * 16) * 2048;
#pragma unroll
                    for (int bj = 0; bj < 2; ++bj)
#pragma unroll
                        for (int n = 0; n < 2; ++n) { const f32x4 v = acc[ai][bj][m][n]; *(PG8_GAS u32x2_*)(rowp + bj * HALF + n * 16) = (u32x2_){cvt_pk_bf16(v[0], v[1]), cvt_pk_bf16(v[2], v[3])}; } }
        }
    }
};
}
#ifndef DBG_REP_MASK
#define DBG_REP_MASK 0
#endif
namespace att {
using bf16x8 = __attribute__((ext_vector_type(8))) short;
using s16x4  = __attribute__((ext_vector_type(4))) short;
using f32x16 = __attribute__((ext_vector_type(16))) float;
using u32x4  = __attribute__((ext_vector_type(4))) unsigned;
constexpr int NW = 8, QBLK = 32, KVBLK = 64, DV = 128;
constexpr float THR = 8.f;
constexpr int SHM_V = KVBLK * DV * 2;
constexpr int RPB_OFF = 2 * SHM_V + 2 * KVBLK * 512 + 2048;
#define ATT_SBAR() __builtin_amdgcn_sched_barrier(0)
__device__ __forceinline__ int crow(int r, int hi) { return (r & 3) + 8 * (r >> 2) + 4 * hi; }
__device__ __forceinline__ unsigned cvtpk(float lo, float hi) { unsigned r; asm volatile("v_cvt_pk_bf16_f32 %0, %1, %2" : "=v"(r) : "v"(lo), "v"(hi)); return r; }
__device__ __forceinline__ int v_st(int k, int c) { const int kk = (k & ~0xC) | ((k & 4) << 1) | ((k & 8) >> 1); return ((kk >> 3) * 4 + (c >> 5)) * 512 + ((kk & 7) * 32 + (c & 31)) * 2; }
__device__ __forceinline__ int v_rd_base(int lane) { return ((lane & 3) << 3) | (((lane >> 2) & 3) << 6) | (((lane >> 4) & 1) << 5) | (((lane >> 5) & 1) << 8); }
constexpr int v_rd_off(int d0, int ks, int half) { return d0 * 512 + ks * 4096 + half * 2048; }
template <int OFF> __device__ __forceinline__ s16x4 tr_read(int vb) { s16x4 r; asm volatile("ds_read_b64_tr_b16 %0, %1 offset:%2" : "=&v"(r) : "v"(vb), "i"(OFF) : "memory"); return r; }
template <int D0> __device__ __forceinline__ void pv_one(f32x16& od, int vb, bf16x8 pa0, bf16x8 pa1, bf16x8 pa2, bf16x8 pa3) {
  const s16x4 l0 = tr_read<v_rd_off(D0, 0, 0)>(vb), h0 = tr_read<v_rd_off(D0, 0, 1)>(vb), l1 = tr_read<v_rd_off(D0, 1, 0)>(vb), h1 = tr_read<v_rd_off(D0, 1, 1)>(vb);
  const s16x4 l2 = tr_read<v_rd_off(D0, 2, 0)>(vb), h2 = tr_read<v_rd_off(D0, 2, 1)>(vb), l3 = tr_read<v_rd_off(D0, 3, 0)>(vb), h3 = tr_read<v_rd_off(D0, 3, 1)>(vb);
  asm volatile("s_waitcnt lgkmcnt(0)" ::: "memory"); ATT_SBAR();
#define ATT_PK(L, H) (bf16x8){L[0], L[1], L[2], L[3], H[0], H[1], H[2], H[3]}
  od = __builtin_amdgcn_mfma_f32_32x32x16_bf16(pa0, ATT_PK(l0, h0), od, 0, 0, 0);
  od = __builtin_amdgcn_mfma_f32_32x32x16_bf16(pa1, ATT_PK(l1, h1), od, 0, 0, 0);
  od = __builtin_amdgcn_mfma_f32_32x32x16_bf16(pa2, ATT_PK(l2, h2), od, 0, 0, 0);
  od = __builtin_amdgcn_mfma_f32_32x32x16_bf16(pa3, ATT_PK(l3, h3), od, 0, 0, 0);
#undef ATT_PK
}
__device__ __forceinline__ void pv_d0(f32x16* o, int vb, bf16x8 pa0, bf16x8 pa1, bf16x8 pa2, bf16x8 pa3) {
  pv_one<0>(o[0], vb, pa0, pa1, pa2, pa3); pv_one<1>(o[1], vb, pa0, pa1, pa2, pa3); pv_one<2>(o[2], vb, pa0, pa1, pa2, pa3); pv_one<3>(o[3], vb, pa0, pa1, pa2, pa3);
}
struct KvSrc { int row0, n0, row1, n1; __device__ __forceinline__ int row(int t) const { const int u = t - n0; return t < n0 ? row0 + 64 * t : row1 + 64 * (u < n1 ? u : n1 - 1); } };
struct NatMask { int rlo, qrow, qcol; const LAS float* rpb; };

template <int DQK, int MODE, int ldq, int ldk, int ldv, int ldo, int QP = 0>
__device__ __forceinline__ void attn_unit(const bf16* __restrict__ Qb, const bf16* __restrict__ Kh, const bf16* __restrict__ Vh,
                                          bf16* __restrict__ Ob, const KvSrc src, int NT, const NatMask nm, LAS char* lds, int tid,
                                          const float* __restrict__ qgain = nullptr, const float* __restrict__ qrope = nullptr) {
  constexpr float SCALE = DQK == 128 ? 0.088388347648318440f : 0.072168783648703220f;
  constexpr float C = SCALE * 1.4426950408889634f;
  constexpr int KROW = DQK == 128 ? 256 : 512  , SHM_K = KVBLK * KROW, NKC = DQK / 8, KCH = KVBLK * NKC / 512, ND0 = DQK / 16;
  const int wid = tid >> 6, lane = tid & 63, r32 = lane & 31, hi = lane >> 5;
  LAS char* V_lds = lds; LAS char* K_lds = lds + 2 * SHM_V;
  LAS float* ws = (LAS float*)(lds + 2 * SHM_V + 2 * SHM_K) + wid * 64; LAS float* li_l = ws; LAS float* al_l = ws + 32;
  float m_reg = -1e30f, l_reg = 0; f32x16 o[4] = {}; bf16x8 qr[ND0];
  { const bf16* Qw = Qb + (size_t)(wid * QBLK + r32) * ldq + hi * 8;
#pragma unroll
    for (int d0 = 0; d0 < ND0; ++d0) qr[d0] = *(const GAS bf16x8*)(Qw + d0 * 16); }
  if constexpr (QP == 1) {
    float ss = 0.f;
#pragma unroll
    for (int d0 = 0; d0 < ND0; ++d0) { const u32x4 w = __builtin_bit_cast(u32x4, qr[d0]);
#pragma unroll
      for (int e = 0; e < 4; ++e) { const float a = __uint_as_float(w[e] << 16), b = __uint_as_float(w[e] & 0xffff0000u); ss += a * a + b * b; } }
    ss += __shfl_xor(ss, 32);
    const float rs = rsqrtf(ss * (1.f / DQK) + 1e-6f);
    float xv[ND0 < 12 ? 1 : 4][8];
#pragma unroll
    for (int d0 = 0; d0 < ND0; ++d0) { const u32x4 w = __builtin_bit_cast(u32x4, qr[d0]);
      const f32x4 g0 = *(const GAS f32x4*)(qgain + d0 * 16 + hi * 8), g1 = *(const GAS f32x4*)(qgain + d0 * 16 + hi * 8 + 4);
      float x[8];
#pragma unroll
      for (int e = 0; e < 4; ++e) { x[2 * e] = __uint_as_float(w[e] << 16) * rs; x[2 * e + 1] = __uint_as_float(w[e] & 0xffff0000u) * rs; }
      x[0] *= g0.x; x[1] *= g0.y; x[2] *= g0.z; x[3] *= g0.w; x[4] *= g1.x; x[5] *= g1.y; x[6] *= g1.z; x[7] *= g1.w;
      if (ND0 == 12 && d0 >= 8) {
#pragma unroll
        for (int e = 0; e < 8; ++e) xv[ND0 < 12 ? 0 : d0 - 8][e] = x[e];
      } else { const u32x4 o_ = {cvtpk(x[0], x[1]), cvtpk(x[2], x[3]), cvtpk(x[4], x[5]), cvtpk(x[6], x[7])}; qr[d0] = __builtin_bit_cast(bf16x8, o_); } }
    if constexpr (ND0 == 12) {
#pragma unroll
      for (int pp = 0; pp < 2; ++pp) {
        float y1[8], y2[8];
#pragma unroll
        for (int e = 0; e < 8; ++e) { y1[e] = xv[pp][e]; y2[e] = xv[2 + pp][e]; }
        if (qrope != nullptr) { const float* rt = qrope + ((size_t)(wid * QBLK + r32) * 32 + 16 * pp + 8 * hi) * 2;
#pragma unroll
          for (int e2 = 0; e2 < 4; ++e2) { const f32x4 cs = *(const GAS f32x4*)(rt + 4 * e2);
            const float a0 = y1[2 * e2] * cs.x - y2[2 * e2] * cs.y, b0 = y1[2 * e2] * cs.y + y2[2 * e2] * cs.x;
            const float a1 = y1[2 * e2 + 1] * cs.z - y2[2 * e2 + 1] * cs.w, b1 = y1[2 * e2 + 1] * cs.w + y2[2 * e2 + 1] * cs.z;
            y1[2 * e2] = a0; y2[2 * e2] = b0; y1[2 * e2 + 1] = a1; y2[2 * e2 + 1] = b1; } }
        const u32x4 o1 = {cvtpk(y1[0], y1[1]), cvtpk(y1[2], y1[3]), cvtpk(y1[4], y1[5]), cvtpk(y1[6], y1[7])}, o2 = {cvtpk(y2[0], y2[1]), cvtpk(y2[2], y2[3]), cvtpk(y2[4], y2[5]), cvtpk(y2[6], y2[7])};
        qr[8 + pp] = __builtin_bit_cast(bf16x8, o1); qr[10 + pp] = __builtin_bit_cast(bf16x8, o2); }
    }
  }
  const int sr = tid >> 4, sc = (tid & 15) * 8, vst0 = v_st(sr, sc), vst1 = v_st(32 + sr, sc);
  unsigned koff_[KCH], kst_[KCH]; const unsigned voff0 = (unsigned)(sr * ldv + sc);
#pragma unroll
  for (int i = 0; i < KCH; ++i) { const int c = tid + 512 * i, kr = c / NKC, kc = c % NKC; koff_[i] = (unsigned)(kr * ldk + kc * 8); kst_[i] = (unsigned)(kr * KROW + ((kc * 16) ^ ((kr & 15) << 4))); }
  const int vb0 = (int)(uintptr_t)V_lds + v_rd_base(lane);
  bf16x8 svs0, svs1, sks[KCH];
#define ATT_SLOAD(t) do { const int _r = __builtin_amdgcn_readfirstlane(src.row(t)); const bf16* _vt = Vh + (size_t)_r * ldv; const bf16* _kt = Kh + (size_t)_r * ldk; \
    svs0 = *(const GAS bf16x8*)(_vt + voff0); svs1 = *(const GAS bf16x8*)(_vt + 32 * ldv + voff0); \
    _Pragma("unroll") for (int _i = 0; _i < KCH; ++_i) sks[_i] = *(const GAS bf16x8*)(_kt + koff_[_i]); } while (0)
#define ATT_SWRITE(b) do { *(LAS bf16x8*)(V_lds + (b) * SHM_V + vst0) = svs0; *(LAS bf16x8*)(V_lds + (b) * SHM_V + vst1) = svs1; \
    _Pragma("unroll") for (int _i = 0; _i < KCH; ++_i) *(LAS bf16x8*)(K_lds + (b) * SHM_K + kst_[_i]) = sks[_i]; } while (0)
#define ATT_RESC(a) do { if (__any((a) < 1.f)) { if (hi == 0) al_l[r32] = (a); asm volatile("s_waitcnt lgkmcnt(0)" ::: "memory"); \
    _Pragma("unroll") for (int d = 0; d < 4; ++d) _Pragma("unroll") for (int r = 0; r < 16; ++r) o[d][r] *= al_l[crow(r, hi)]; } } while (0)
  auto qkt = [&](f32x16& p0, f32x16& p1, int b, int t) {
    const LAS char* Ks = K_lds + b * SHM_K;
    p0 = f32x16{}; p1 = f32x16{};
    const LAS char* k0p = Ks + r32 * KROW; const LAS char* k1p = Ks + (32 + r32) * KROW; const int sw = (r32 & 15) << 4;
    bf16x8 ka[2], kb[2];
    ka[0] = *reinterpret_cast<const LAS bf16x8*>(k0p + ((hi * 16) ^ sw)); kb[0] = *reinterpret_cast<const LAS bf16x8*>(k1p + ((hi * 16) ^ sw));
#pragma unroll
    for (int d0 = 0; d0 < ND0; ++d0) {
      if (d0 + 1 < ND0) { const int cb = ((d0 + 1) * 16 + hi * 8) * 2;
        ka[(d0 + 1) & 1] = *reinterpret_cast<const LAS bf16x8*>(k0p + (cb ^ sw)); kb[(d0 + 1) & 1] = *reinterpret_cast<const LAS bf16x8*>(k1p + (cb ^ sw)); }
      __builtin_amdgcn_sched_barrier(0);
      p0 = __builtin_amdgcn_mfma_f32_32x32x16_bf16(ka[d0 & 1], qr[d0], p0, 0, 0, 0);
      p1 = __builtin_amdgcn_mfma_f32_32x32x16_bf16(kb[d0 & 1], qr[d0], p1, 0, 0, 0);
      __builtin_amdgcn_sched_barrier(0); }
    if constexpr (MODE == 1) {
      const int i = t - src.n0;
      if (i >= 0) {
        const int kr = nm.rlo + i, r0q = min(max(nm.qrow - 4, 0), 24), c0q = min(max(nm.qcol - 8, 0), 48);
        const bool rowok = (i < src.n1) && (kr >= r0q) && (kr < r0q + 8);
        const int rowoff = (kr - nm.qrow + 7) * 31 + 15 - nm.qcol;
#pragma unroll
        for (int r = 0; r < 16; ++r) {
          const int kc0 = crow(r, hi), kc1 = kc0 + 32;
          const bool ok0 = rowok && ((unsigned)(kc0 - c0q) < 16u), ok1 = rowok && ((unsigned)(kc1 - c0q) < 16u);
          const float b0 = nm.rpb[ok0 ? rowoff + kc0 : 0], b1 = nm.rpb[ok1 ? rowoff + kc1 : 0];
          p0[r] = ok0 ? p0[r] + b0 : -1e30f; p1[r] = ok1 ? p1[r] + b1 : -1e30f; }
      }
    }
  };
  auto partialSM = [&](f32x16& p0, f32x16& p1, float& mn, float& alpha) {
    float pmax = p0[0];
#pragma unroll
    for (int r = 1; r < 16; ++r) pmax = fmaxf(pmax, p0[r]);
#pragma unroll
    for (int r = 0; r < 16; ++r) pmax = fmaxf(pmax, p1[r]);
    { auto rr = __builtin_amdgcn_permlane32_swap(__float_as_uint(pmax), __float_as_uint(pmax), false, false); pmax = fmaxf(__uint_as_float(rr[0]), __uint_as_float(rr[1])); }
    if (__builtin_expect(__all(pmax - m_reg <= THR / SCALE), 1)) { mn = m_reg; alpha = 1.f; }
    else { mn = fmaxf(m_reg, pmax); alpha = __builtin_amdgcn_exp2f((m_reg - mn) * C); m_reg = mn; }
    const float mnC = -mn * C;
#pragma unroll
    for (int r = 0; r < 16; ++r) p0[r] = fmaf(p0[r], C, mnC);
#pragma unroll
    for (int r = 0; r < 16; ++r) p1[r] = fmaf(p1[r], C, mnC);
#pragma unroll
    for (int r = 0; r < 16; ++r) p0[r] = __builtin_amdgcn_exp2f(p0[r]);
  };
  auto finishSM = [&](f32x16& p0, f32x16& p1, float alpha, bf16x8& pa0, bf16x8& pa1, bf16x8& pa2, bf16x8& pa3) {
#pragma unroll
    for (int r = 0; r < 16; ++r) p1[r] = __builtin_amdgcn_exp2f(p1[r]);
    float ps = 0;
#pragma unroll
    for (int r = 0; r < 16; ++r) ps += p0[r];
#pragma unroll
    for (int r = 0; r < 16; ++r) ps += p1[r];
    { auto rr = __builtin_amdgcn_permlane32_swap(__float_as_uint(ps), __float_as_uint(ps), false, false); ps = __uint_as_float(rr[0]) + __uint_as_float(rr[1]); }
    l_reg = l_reg * alpha + ps;
#define ATT_PK4(P, BASE, OUT) do { unsigned a0 = cvtpk(P[BASE + 0], P[BASE + 1]), a1 = cvtpk(P[BASE + 2], P[BASE + 3]); \
    unsigned b0 = cvtpk(P[BASE + 4], P[BASE + 5]), b1 = cvtpk(P[BASE + 6], P[BASE + 7]); \
    auto r0 = __builtin_amdgcn_permlane32_swap(a0, b0, false, false); auto r1 = __builtin_amdgcn_permlane32_swap(a1, b1, false, false); \
    u32x4 w = {r0[0], r1[0], r0[1], r1[1]}; OUT = *reinterpret_cast<bf16x8*>(&w); } while (0)
    ATT_PK4(p0, 0, pa0); ATT_PK4(p0, 8, pa1); ATT_PK4(p1, 0, pa2); ATT_PK4(p1, 8, pa3);
#undef ATT_PK4
  };
  f32x16 p0, p1; float mn, al; bf16x8 pa0, pa1, pa2, pa3;
  ATT_SLOAD(0); asm volatile("s_waitcnt vmcnt(0)" ::: "memory"); ATT_SWRITE(0); if (NT > 1) ATT_SLOAD(1); __syncthreads();
  for (int t = 0; t < NT; ++t) {
    const int b = t & 1;
    ATT_SBAR(); qkt(p0, p1, b, t); ATT_SBAR();
    if (t + 1 < NT) { asm volatile("s_waitcnt vmcnt(0)" ::: "memory"); ATT_SWRITE(b ^ 1); if (t + 2 < NT) ATT_SLOAD(t + 2); }
    ATT_SBAR();
    partialSM(p0, p1, mn, al); ATT_RESC(al);
    finishSM(p0, p1, al, pa0, pa1, pa2, pa3); ATT_SBAR();
    pv_d0(o, vb0 + b * SHM_V, pa0, pa1, pa2, pa3);
    __syncthreads();
  }
  if (hi == 0) li_l[r32] = l_reg; asm volatile("s_waitcnt lgkmcnt(0)" ::: "memory");
  int hi_o = hi; asm volatile("" : "+v"(hi_o));
  bf16* Ow = Ob + (size_t)(wid * QBLK + 4 * hi_o) * ldo;
#pragma unroll
  for (int r = 0; r < 16; ++r) { const int orow = crow(r, 0); const float rl = __builtin_amdgcn_rcpf(li_l[orow + 4 * hi_o]);
#pragma unroll
    for (int d0 = 0; d0 < 4; ++d0) { const float v = o[d0][r] * rl; ((GAS bf16*)Ow)[(size_t)orow * ldo + d0 * 32 + r32] = (bf16)(cvtpk(v, v) & 0xffffu); } }
#undef ATT_SLOAD
#undef ATT_SWRITE
#undef ATT_RESC
}
}
namespace pg8 {
struct EpiKV {
    static constexpr bool PERM = true;
    bf16_t* KV; bf16_t* KF; const float* gkn; const float* KPE; const float* SSK; const float* RT; PG8_LAS float* tab;
    __device__ __forceinline__ void operator()(const f32x4 (&acc)[2][2][4][2], const Unit& u, int wr, int wc, int fr, int fq) const {
        const int h = u.pn, row0 = u.pm * BM + wr * 64 + fr, c8 = wc * 32 + 8 * fq;
        float sk[2][4];
#pragma unroll
        for (int ai = 0; ai < 2; ++ai)
#pragma unroll
            for (int m = 0; m < 4; ++m) { const f32x4 a = acc[ai][0][m][0], b = acc[ai][0][m][1]; sk[ai][m] = ((const PG8_GAS float*)SSK)[row0 + ai * HALF + m * 16];
                float s = (a[0] * a[0] + a[1] * a[1]) + (a[2] * a[2] + a[3] * a[3]) + (b[0] * b[0] + b[1] * b[1]) + (b[2] * b[2] + b[3] * b[3]);
                s += __shfl_xor(s, 16); s += __shfl_xor(s, 32);
                if (fq == 0) tab[(ai * HALF + wr * 64 + m * 16 + fr) * 4 + wc] = s; }
#pragma unroll
        for (int ai = 0; ai < 2; ++ai)
#pragma unroll
            for (int m = 0; m < 4; ++m) { const f32x4 v0 = acc[ai][1][m][0], v1 = acc[ai][1][m][1];
                u32x4 w; w.x = cvt_pk_bf16(v0[0], v0[1]); w.y = cvt_pk_bf16(v0[2], v0[3]); w.z = cvt_pk_bf16(v1[0], v1[1]); w.w = cvt_pk_bf16(v1[2], v1[3]);
                *(PG8_GAS u32x4*)(KV + (size_t)(row0 + ai * HALF + m * 16) * 4096 + h * 256 + 128 + c8) = w; }
        asm volatile("s_waitcnt lgkmcnt(0)" ::: "memory"); __builtin_amdgcn_s_barrier(); asm volatile("" ::: "memory");
        const f32x4 g0 = *(const PG8_GAS f32x4*)(gkn + c8), g1 = *(const PG8_GAS f32x4*)(gkn + c8 + 4);
#pragma unroll
        for (int ai = 0; ai < 2; ++ai)
#pragma unroll
            for (int m = 0; m < 4; ++m) { const int row = row0 + ai * HALF + m * 16; const f32x4 p = *(const PG8_LAS f32x4*)(tab + (ai * HALF + wr * 64 + m * 16 + fr) * 4);
                const float rs = rsqrtf(((p[0] + p[1]) + (p[2] + p[3]) + sk[ai][m]) * (1.f / 192.f) + 1e-6f);
                const f32x4 k0 = acc[ai][0][m][0] * rs * g0, k1 = acc[ai][0][m][1] * rs * g1;
                u32x4 w; w.x = cvt_pk_bf16(k0[0], k0[1]); w.y = cvt_pk_bf16(k0[2], k0[3]); w.z = cvt_pk_bf16(k1[0], k1[1]); w.w = cvt_pk_bf16(k1[2], k1[3]);
                *(PG8_GAS u32x4*)(KF + (size_t)row * 3072 + h * 192 + c8) = w; }
        { const int t_ = (wr * 4 + wc) * 64 + fq * 16 + fr, r = t_ >> 1, hf = t_ & 1, row = u.pm * BM + r;
          const f32x4 p = *(const PG8_LAS f32x4*)(tab + r * 4);
          const float rs = rsqrtf(((p[0] + p[1]) + (p[2] + p[3]) + ((const PG8_GAS float*)SSK)[row]) * (1.f / 192.f) + 1e-6f);
          const bool rot = row >= 8192 && row < 12288; const float* rt = RT + ((size_t)((row - 8192) & 2047) * 32 + 16 * hf) * 2;
          const float* kp = KPE + (size_t)row * 64 + 16 * hf; bf16_t* o = KF + (size_t)row * 3072 + h * 192 + 128 + 16 * hf;
#pragma unroll
          for (int q = 0; q < 2; ++q) {
              f32x4 a0 = *(const PG8_GAS f32x4*)(kp + 8 * q), a1 = *(const PG8_GAS f32x4*)(kp + 8 * q + 4), b0 = *(const PG8_GAS f32x4*)(kp + 32 + 8 * q), b1 = *(const PG8_GAS f32x4*)(kp + 32 + 8 * q + 4);
              a0 = a0 * rs * *(const PG8_GAS f32x4*)(gkn + 128 + 16 * hf + 8 * q); a1 = a1 * rs * *(const PG8_GAS f32x4*)(gkn + 128 + 16 * hf + 8 * q + 4);
              b0 = b0 * rs * *(const PG8_GAS f32x4*)(gkn + 160 + 16 * hf + 8 * q); b1 = b1 * rs * *(const PG8_GAS f32x4*)(gkn + 160 + 16 * hf + 8 * q + 4);
              float x1[8] = {a0[0], a0[1], a0[2], a0[3], a1[0], a1[1], a1[2], a1[3]}, x2[8] = {b0[0], b0[1], b0[2], b0[3], b1[0], b1[1], b1[2], b1[3]};
              if (rot) {
#pragma unroll
                  for (int e2 = 0; e2 < 4; ++e2) { const f32x4 cs = *(const PG8_GAS f32x4*)(rt + (8 * q + 2 * e2) * 2);
                      const float y0 = x1[2 * e2] * cs[0] - x2[2 * e2] * cs[1], z0 = x1[2 * e2] * cs[1] + x2[2 * e2] * cs[0];
                      const float y1 = x1[2 * e2 + 1] * cs[2] - x2[2 * e2 + 1] * cs[3], z1 = x1[2 * e2 + 1] * cs[3] + x2[2 * e2 + 1] * cs[2];
                      x1[2 * e2] = y0; x2[2 * e2] = z0; x1[2 * e2 + 1] = y1; x2[2 * e2 + 1] = z1; } }
              u32x4 w1, w2; w1.x = cvt_pk_bf16(x1[0], x1[1]); w1.y = cvt_pk_bf16(x1[2], x1[3]); w1.z = cvt_pk_bf16(x1[4], x1[5]); w1.w = cvt_pk_bf16(x1[6], x1[7]);
              w2.x = cvt_pk_bf16(x2[0], x2[1]); w2.y = cvt_pk_bf16(x2[2], x2[3]); w2.z = cvt_pk_bf16(x2[4], x2[5]); w2.w = cvt_pk_bf16(x2[6], x2[7]);
              *(PG8_GAS u32x4*)(o + 8 * q) = w1; *(PG8_GAS u32x4*)(o + 32 + 8 * q) = w2; } }
    }
};
}
__device__ __forceinline__ void rope_table(const Args& a, int tid, int vcu, int G) {
    f32x2* RT = (f32x2*)(a.ws + WS_ROPE);
    for (int e = vcu * NTHR + tid; e < 2048 * 32; e += G * NTHR) { const int t = e >> 5, i = e & 31;
        const float inv = exp2f(-(float)(i & 15) * (13.287712379549449f / 16.f));
        const float ang = (float)(i < 16 ? (t >> 6) : (t & 63)) * inv; float s, c; sincosf(ang, &s, &c); RT[e] = (f32x2){c, s}; }
}
__device__ __forceinline__ void mla_thin_b(const Args& a, int j, int lane, int gw, int NGW) {
    OPAQUE_V(lane); PH_PTRS; OPAQUE_S(gw); OPAQUE_S(NGW);
    const bf16* QRAW = (const bf16*)(ws + WS_S + S_QRAW); bf16* QN = (bf16*)(ws + WS_S + S_QN);
    const bf16* KVRAW = (const bf16*)(ws + WS_S + S_KVRAW); bf16* KF = (bf16*)(ws + WS_S + S_KF);
    const float* KPE = (const float*)(ws + WS_S + S_KPE); const float* SSK = (const float*)(ws + WS_SSK);
    const f32x2* RT = (const f32x2*)(ws + WS_ROPE);
    const float* gqn = a.in[I_GQN] + (size_t)j * 192; const float* gkn = a.in[I_GKN] + (size_t)j * 192;
    const int grp = lane >> 4, s = lane & 15;
    float gq[12], gk[12];
#pragma unroll
    for (int e = 0; e < 8; ++e) { gq[e] = gqn[8 * s + e]; gk[e] = gkn[8 * s + e]; }
    gq[8] = gqn[128 + 2 * s]; gq[9] = gqn[129 + 2 * s]; gq[10] = gqn[160 + 2 * s]; gq[11] = gqn[161 + 2 * s];
    gk[8] = gkn[128 + 2 * s]; gk[9] = gkn[129 + 2 * s]; gk[10] = gkn[160 + 2 * s]; gk[11] = gkn[161 + 2 * s];
    const int NQI = 0, NKI = MKV * 4;
    for (int it = gw; it < NQI + NKI; it += NGW) {
        const bool isq = it < NQI; const int r4 = isq ? it : it - NQI; const int row = r4 >> 2, h = (r4 & 3) * 4 + grp;
        float x[12];
        if (isq) {
            const bf16* p = QRAW + (size_t)row * 3072 + h * 192;
            const v4u w = *(const GAS v4u*)(p + 8 * s); const unsigned w1 = *(const GAS unsigned*)(p + 128 + 2 * s), w2 = *(const GAS unsigned*)(p + 160 + 2 * s);
            x[0] = bf_lo(w.x); x[1] = bf_hi(w.x); x[2] = bf_lo(w.y); x[3] = bf_hi(w.y); x[4] = bf_lo(w.z); x[5] = bf_hi(w.z); x[6] = bf_lo(w.w); x[7] = bf_hi(w.w);
            x[8] = bf_lo(w1); x[9] = bf_hi(w1); x[10] = bf_lo(w2); x[11] = bf_hi(w2);
        } else {
            const bf16* p = KVRAW + (size_t)row * 4096 + h * 256;
            const v4u w = *(const GAS v4u*)(p + 8 * s);
            x[0] = bf_lo(w.x); x[1] = bf_hi(w.x); x[2] = bf_lo(w.y); x[3] = bf_hi(w.y); x[4] = bf_lo(w.z); x[5] = bf_hi(w.z); x[6] = bf_lo(w.w); x[7] = bf_hi(w.w);
            const f32x2 k1 = *(const GAS f32x2*)(KPE + (size_t)row * 64 + 2 * s), k2 = *(const GAS f32x2*)(KPE + (size_t)row * 64 + 32 + 2 * s);
            x[8] = k1.x; x[9] = k1.y; x[10] = k2.x; x[11] = k2.y;
        }
        float ss = 0.f;
#pragma unroll
        for (int e = 0; e < 8; ++e) ss += x[e] * x[e];
        if (isq) { ss += x[8] * x[8] + x[9] * x[9] + x[10] * x[10] + x[11] * x[11]; ss = sum16(ss); }
        else { ss = sum16(ss) + SSK[row]; }
        const float rs = rsqrtf(ss * (1.f / 192.f) + EPS);
#pragma unroll
        for (int e = 0; e < 12; ++e) x[e] = x[e] * rs * (isq ? gq[e] : gk[e]);
        if (row >= MP && row < MALL) {
            const int t = (row - MP) & 2047; const f32x2 cs0 = RT[t * 32 + 2 * s], cs1 = RT[t * 32 + 2 * s + 1];
            const float a0 = x[8] * cs0.x - x[10] * cs0.y, b0 = x[8] * cs0.y + x[10] * cs0.x, a1 = x[9] * cs1.x - x[11] * cs1.y, b1 = x[9] * cs1.y + x[11] * cs1.x;
            x[8] = a0; x[9] = a1; x[10] = b0; x[11] = b1;
        }
        bf16* o = (isq ? QN : KF) + (size_t)row * 3072 + h * 192;
        *(GAS v4u*)(o + 8 * s) = (v4u){pk2(x[0], x[1]), pk2(x[2], x[3]), pk2(x[4], x[5]), pk2(x[6], x[7])};
        *(GAS unsigned*)(o + 128 + 2 * s) = pk2(x[8], x[9]); *(GAS unsigned*)(o + 160 + 2 * s) = pk2(x[10], x[11]);
    }
}
__device__ __forceinline__ void mla_attn_phase(const Args& a, int j, LAS unsigned char* lds, int tid, int vcu, int G) {
    OPAQUE_V(tid); PH_PTRS; OPAQUE_S(vcu); OPAQUE_S(G);
    const bf16* QN = (const bf16*)(ws + WS_S + S_QRAW); const bf16* KF = (const bf16*)(ws + WS_S + S_KF); const bf16* KVRAW = (const bf16*)(ws + WS_S + S_KVRAW);
    bf16* AO = (bf16*)(ws + WS_S + S_AO); const float* gqn = a.in[I_GQN] + (size_t)j * 192; const float* RT = (const float*)(ws + WS_ROPE);
    for (int u = vcu; u < 768; u += G) {
        int q0, h, NT; att::KvSrc src; const float* qrope = nullptr;
        if (u < 256) { const int b = u >> 7, qb = u & 7; h = (u >> 3) & 15; q0 = MP + b * 2048 + qb * 256; src = att::KvSrc{MP + b * 2048, 32, MALL + b * 256, 4}; NT = 36; qrope = RT + (size_t)(qb * 256) * 64; }
        else { const int v = u - 256, b = v >> 4; h = v & 15; q0 = b * 256; src = att::KvSrc{b * 256, 4, 0, 1}; NT = 4; }
        att::attn_unit<192, 0, 3072, 3072, 4096, DM, 1>(QN + (size_t)q0 * 3072 + h * 192, KF + h * 192, KVRAW + h * 256 + 128, AO + (size_t)q0 * DM + h * 128, src, NT, att::NatMask{0, 0, 0, nullptr}, (LAS char*)lds, tid, gqn, qrope);
    }
}
namespace pg8 {
struct EpiHg {
    static constexpr bool PERM = true;
    unsigned char* ws;
    __device__ __forceinline__ void operator()(const f32x4 (&acc)[2][2][4][2], const Unit& u, int wr, int wc, int fr, int fq) const {
        const int region = u.pn >> 3, row0 = u.pm * BM + wr * 64 + fr, col0 = (u.pn & 7) * BM + wc * 32 + 8 * fq;
        if (region == 1 || region == 2) {
            const int d = region - 1;
            f32x4 lbv[2][2];
#pragma unroll
            for (int bj = 0; bj < 2; ++bj)
#pragma unroll
                for (int n = 0; n < 2; ++n) lbv[bj][n] = *(const PG8_GAS f32x4*)((const float*)(ws + WS_LB) + d * 2048 + col0 + bj * HALF + 4 * n);
            bf16_t* K = (bf16_t*)(ws + WS_S + S_HK) + (size_t)d * 12288 * 2048; float* Gd = (float*)(ws + WS_U) + (size_t)d * 12288 * 2048;
#pragma unroll
            for (int ai = 0; ai < 2; ++ai)
#pragma unroll
                for (int m = 0; m < 4; ++m) { const size_t ro = (size_t)(row0 + ai * HALF + m * 16) * 2048 + col0;
#pragma unroll
                    for (int bj = 0; bj < 2; ++bj) { f32x4 kk[2], gg[2];
#pragma unroll
                        for (int n = 0; n < 2; ++n)
#pragma unroll
                            for (int e = 0; e < 4; ++e) { const float z = acc[ai][bj][m][n][e]; const float sn = __builtin_amdgcn_rcpf(1.f + __expf(z));
                                const float k = (1.f - lbv[bj][n][e]) * sn; kk[n][e] = k; gg[n][e] = __log2f(1.f - k); }
                        u32x4 w; w.x = cvt_pk_bf16(kk[0][0], kk[0][1]); w.y = cvt_pk_bf16(kk[0][2], kk[0][3]); w.z = cvt_pk_bf16(kk[1][0], kk[1][1]); w.w = cvt_pk_bf16(kk[1][2], kk[1][3]);
                        *(PG8_GAS u32x4*)(K + ro + bj * HALF) = w; *(PG8_GAS f32x4*)(Gd + ro + bj * HALF) = gg[0]; *(PG8_GAS f32x4*)(Gd + ro + bj * HALF + 4) = gg[1]; } }
        } else {
            bf16_t* O = (bf16_t*)(ws + WS_S + (region == 0 ? S_HQ : region == 3 ? S_HV : S_HGS)); const bool act = region != 3;
#pragma unroll
            for (int ai = 0; ai < 2; ++ai)
#pragma unroll
                for (int m = 0; m < 4; ++m) { bf16_t* rowp = O + (size_t)(row0 + ai * HALF + m * 16) * 2048 + col0;
#pragma unroll
                    for (int bj = 0; bj < 2; ++bj) { f32x4 v0 = acc[ai][bj][m][0], v1 = acc[ai][bj][m][1];
                        if (act) {
#pragma unroll
                            for (int e = 0; e < 4; ++e) { v0[e] = v0[e] * __builtin_amdgcn_rcpf(1.f + __expf(-v0[e])); v1[e] = v1[e] * __builtin_amdgcn_rcpf(1.f + __expf(-v1[e])); } }
                        u32x4 w; w.x = cvt_pk_bf16(v0[0], v0[1]); w.y = cvt_pk_bf16(v0[2], v0[3]); w.z = cvt_pk_bf16(v1[0], v1[1]); w.w = cvt_pk_bf16(v1[2], v1[3]);
                        *(PG8_GAS u32x4*)(rowp + bj * HALF) = w; } }
        }
    }
};
}

namespace hg {
constexpr int PQ = 272, PK = 80;
constexpr int OFF_QM = 0, OFF_KM = 32 * PQ, OFF_V = 2 * 32 * PQ, OFF_ATT = 3 * 32 * PQ, OFF_C2 = OFF_ATT + 32 * PK, OFF_C3 = OFF_C2 + 512, BUF = OFF_C3 + 512;
constexpr int OFF_TOT = 2 * BUF, TOT_BYTES = 8 * 128 * 4;
constexpr int OFF_OST = OFF_TOT + 2 * TOT_BYTES;
constexpr int OFF_STG = OFF_OST + 32 * PQ, STG_SLOT = 40960;
static_assert(OFF_STG + 2 * STG_SLOT <= LDSCTL_OFF, "scan LDS (must stay below the control words)");
typedef short bf16x8 __attribute__((ext_vector_type(8)));
typedef short s16x4 __attribute__((ext_vector_type(4)));
struct Chain { int rb, N, d, h; const float* S0; float* Sout; };
template <int OFF> __device__ __forceinline__ s16x4 tr_read(int addr) { s16x4 r; asm volatile("ds_read_b64_tr_b16 %0, %1 offset:%2" : "=&v"(r) : "v"(addr), "i"(OFF) : "memory"); return r; }
__device__ __forceinline__ unsigned bfmul2(unsigned w, float e0, float e1) { return pk2(bf_lo(w) * e0, bf_hi(w) * e1); }

__device__ __forceinline__ void scan_chain(const Chain ch, const bf16* __restrict__ HQ, const bf16* __restrict__ HK, const float* __restrict__ HG, const bf16* __restrict__ HV,
                                           bf16* __restrict__ OD, LAS unsigned char* lds, int tid) {
    const int lane = tid & 63, w = tid >> 6, l15 = lane & 15, q4 = lane >> 4;
    const int k2 = lane;
    const int vt = tid >> 4, v8 = (tid & 15) * 8;
    const int nc = ch.N >> 5, hc = ch.h * 128;
    f32x4 S[8];
    if (ch.S0) {
#pragma unroll
        for (int kt = 0; kt < 8; ++kt)
#pragma unroll
            for (int r = 0; r < 4; ++r) S[kt][r] = ((const GAS float*)ch.S0)[(size_t)(16 * kt + 4 * q4 + r) * 128 + 16 * w + l15];
    } else {
#pragma unroll
        for (int kt = 0; kt < 8; ++kt) S[kt] = (f32x4){0.f, 0.f, 0.f, 0.f};
    }
#define HG_ROW(c, t) (ch.rb + (ch.d ? ch.N - 1 - (32 * (c) + (t)) : 32 * (c) + (t)))
    struct InSet { f32x2 g[4]; unsigned q[4], k[4]; v4u v; };
    f32x2 cl[4]; unsigned cq[4], ck[4]; v4u cv;
#define HG_DMA(c) do { LAS unsigned char* sl_ = lds + OFF_STG + ((c) & 1) * STG_SLOT; \
        _Pragma("unroll") for (int i_ = 0; i_ < 2; ++i_) __builtin_amdgcn_global_load_lds((const unsigned*)(HG + (size_t)HG_ROW(c, 4 * w + 2 * i_ + (lane >> 5)) * 2048 + hc + (lane & 31) * 4), (LAS unsigned*)(sl_ + (4 * w + 2 * i_) * 512), 16, 0, 0); \
        { const size_t ro_ = (size_t)HG_ROW(c, 4 * w + (lane >> 4)) * 2048 + hc + (lane & 15) * 8; \
          __builtin_amdgcn_global_load_lds((const unsigned*)(HQ + ro_), (LAS unsigned*)(sl_ + 16384 + 4 * w * 256), 16, 0, 0); \
          __builtin_amdgcn_global_load_lds((const unsigned*)(HK + ro_), (LAS unsigned*)(sl_ + 24576 + 4 * w * 256), 16, 0, 0); \
          __builtin_amdgcn_global_load_lds((const unsigned*)(HV + ro_), (LAS unsigned*)(sl_ + 32768 + 4 * w * 256), 16, 0, 0); } } while (0)
#define HG_P1(c) do { const LAS unsigned char* sl_ = lds + OFF_STG + ((c) & 1) * STG_SLOT; f32x2 run = (f32x2){0.f, 0.f}; \
        _Pragma("unroll") for (int i = 0; i < 4; ++i) { run = run + *(const LAS f32x2*)(sl_ + (4 * w + i) * 512 + k2 * 8); cl[i] = run; cq[i] = *(const LAS unsigned*)(sl_ + 16384 + (4 * w + i) * 256 + k2 * 4); ck[i] = *(const LAS unsigned*)(sl_ + 24576 + (4 * w + i) * 256 + k2 * 4); } \
        cv = *(const LAS v4u*)(sl_ + 32768 + vt * 256 + v8 * 2); \
        *(LAS f32x2*)(lds + OFF_TOT + ((c) & 1) * TOT_BYTES + (w * 128 + 2 * k2) * 4) = run; } while (0)
    HG_DMA(0); HG_DMA(1);
    asm volatile("s_waitcnt vmcnt(0)" ::: "memory"); HG_P1(0); LDS_WAIT(); asm volatile("" ::: "memory");
    HG_DMA(2);
    LDS_WAIT(); __builtin_amdgcn_s_barrier(); asm volatile("" ::: "memory");
    const int traddr = (int)(uintptr_t)lds + (8 * q4 + (l15 >> 2)) * PQ + (l15 & 3) * 8;
    auto mstage = [&](const int pc) {
        { LAS unsigned char* B = lds + (pc & 1) * BUF; const int tb = traddr + (pc & 1) * BUF;
            const s16x4 v0 = tr_read<0>(tb + OFF_V + 32 * w), v1 = tr_read<4 * PQ>(tb + OFF_V + 32 * w);
            bf16x8 aat[2]; v2u aq0[2][4], aq1[2][4];
#pragma unroll
            for (int tt = 0; tt < 2; ++tt) { aat[tt] = *(const LAS bf16x8*)(B + OFF_ATT + (16 * tt + l15) * PK + 16 * q4);
#pragma unroll
                for (int ks = 0; ks < 4; ++ks) { aq0[tt][ks] = *(const LAS v2u*)(B + OFF_QM + (16 * tt + l15) * PQ + (32 * ks + 4 * q4) * 2); aq1[tt][ks] = *(const LAS v2u*)(B + OFF_QM + (16 * tt + l15) * PQ + (32 * ks + 16 + 4 * q4) * 2); } }
            f32x4 c2v[8];
#pragma unroll
            for (int kt = 0; kt < 8; ++kt) c2v[kt] = *(const LAS f32x4*)(B + OFF_C2 + (16 * kt + 4 * q4) * 4);
            LDS_WAIT(); __builtin_amdgcn_sched_barrier(0);
            const bf16x8 bv = (bf16x8){v0[0], v0[1], v0[2], v0[3], v1[0], v1[1], v1[2], v1[3]};
            f32x4 o2[2];
#pragma unroll
            for (int kt = 0; kt < 8; ++kt) S[kt] = S[kt] * c2v[kt];
#pragma unroll
            for (int tt = 0; tt < 2; ++tt) o2[tt] = __builtin_amdgcn_mfma_f32_16x16x32_bf16(aat[tt], bv, (f32x4){0.f, 0.f, 0.f, 0.f}, 0, 0, 0);
#pragma unroll
            for (int ks = 0; ks < 4; ++ks) {
                const v4u sb = (v4u){pk2(S[2 * ks][0], S[2 * ks][1]), pk2(S[2 * ks][2], S[2 * ks][3]), pk2(S[2 * ks + 1][0], S[2 * ks + 1][1]), pk2(S[2 * ks + 1][2], S[2 * ks + 1][3])};
                const bf16x8 bs = __builtin_bit_cast(bf16x8, sb);
#pragma unroll
                for (int tt = 0; tt < 2; ++tt) { const bf16x8 aq = __builtin_bit_cast(bf16x8, ((v4u){aq0[tt][ks].x, aq0[tt][ks].y, aq1[tt][ks].x, aq1[tt][ks].y}));
                    o2[tt] = __builtin_amdgcn_mfma_f32_16x16x32_bf16(aq, bs, o2[tt], 0, 0, 0); }
            }
            s16x4 ke0[8], ke1[8]; f32x4 elv[8];
#define HG_KRD(kt) ke0[kt] = tr_read<32 * (kt)>(tb + OFF_KM); ke1[kt] = tr_read<32 * (kt) + 4 * PQ>(tb + OFF_KM)
            HG_KRD(0); HG_KRD(1); HG_KRD(2); HG_KRD(3); HG_KRD(4); HG_KRD(5); HG_KRD(6); HG_KRD(7);
#undef HG_KRD
#pragma unroll
            for (int kt = 0; kt < 8; ++kt) elv[kt] = *(const LAS f32x4*)(B + OFF_C3 + (16 * kt + 4 * q4) * 4);
            LDS_WAIT(); __builtin_amdgcn_sched_barrier(0);
#pragma unroll
            for (int kt = 0; kt < 8; ++kt) { const bf16x8 ak = (bf16x8){ke0[kt][0], ke0[kt][1], ke0[kt][2], ke0[kt][3], ke1[kt][0], ke1[kt][1], ke1[kt][2], ke1[kt][3]};
                S[kt] = __builtin_amdgcn_mfma_f32_16x16x32_bf16(ak, bv, S[kt], 0, 0, 0) * elv[kt]; }
#pragma unroll
            for (int tt = 0; tt < 2; ++tt)
#pragma unroll
                for (int r = 0; r < 4; ++r) *(LAS unsigned short*)(lds + OFF_OST + (16 * tt + 4 * q4 + r) * PQ + (16 * w + l15) * 2) = (unsigned short)(pk2(o2[tt][r], 0.f) & 0xffffu);
        }
    };
    for (int c = 0; c < nc; ++c) {
        if (c > 0) mstage(c - 1);
        LAS unsigned char* B = lds + (c & 1) * BUF;
        { const LAS f32x2* T = (const LAS f32x2*)(lds + OFF_TOT + (c & 1) * TOT_BYTES) + k2;
          f32x2 off = (f32x2){0.f, 0.f}, cm = (f32x2){0.f, 0.f}, last = (f32x2){0.f, 0.f};
#pragma unroll
          for (int sgm = 0; sgm < 8; ++sgm) { const f32x2 tv = T[sgm * 64]; if (sgm < w) off = off + tv; if (sgm < 4) cm = cm + tv; last = last + tv; }
#pragma unroll
          for (int i = 0; i < 4; ++i) { const f32x2 cu = off + cl[i]; const int t = 4 * w + i;
              *(LAS unsigned*)(B + OFF_QM + t * PQ + k2 * 4) = bfmul2(cq[i], __builtin_amdgcn_exp2f(cu.x - cm.x), __builtin_amdgcn_exp2f(cu.y - cm.y));
              *(LAS unsigned*)(B + OFF_KM + t * PQ + k2 * 4) = bfmul2(ck[i], __builtin_amdgcn_exp2f(cm.x - cu.x), __builtin_amdgcn_exp2f(cm.y - cu.y));
 }
          if (w == 0) { *(LAS f32x2*)(B + OFF_C2 + k2 * 8) = (f32x2){__builtin_amdgcn_exp2f(cm.x), __builtin_amdgcn_exp2f(cm.y)}; *(LAS f32x2*)(B + OFF_C3 + k2 * 8) = (f32x2){__builtin_amdgcn_exp2f(last.x - cm.x), __builtin_amdgcn_exp2f(last.y - cm.y)}; }
          *(LAS v4u*)(B + OFF_V + vt * PQ + v8 * 2) = cv; }
        { asm volatile("s_waitcnt vmcnt(5)" ::: "memory"); HG_P1(c + 1); LDS_WAIT(); asm volatile("" ::: "memory");
          const int cn = c + 3 < nc ? c + 3 : nc - 1; HG_DMA(cn); }
        LDS_WAIT(); __builtin_amdgcn_s_barrier(); asm volatile("" ::: "memory");
        if (c > 0) *(GAS v4u*)(OD + (size_t)HG_ROW(c - 1, vt) * 2048 + hc + v8) = *(const LAS v4u*)(lds + OFF_OST + vt * PQ + v8 * 2);
        if (w < 4) {
            const int tt = w >> 1, st = w & 1; f32x4 at = (f32x4){0.f, 0.f, 0.f, 0.f};
            if (!(tt == 0 && st == 1)) {
                bf16x8 af[4], bfr[4];
#pragma unroll
                for (int ks = 0; ks < 4; ++ks) { af[ks] = *(const LAS bf16x8*)(B + OFF_QM + (16 * tt + l15) * PQ + (32 * ks + 8 * q4) * 2); bfr[ks] = *(const LAS bf16x8*)(B + OFF_KM + (16 * st + l15) * PQ + (32 * ks + 8 * q4) * 2); }
                LDS_WAIT(); __builtin_amdgcn_sched_barrier(0);
#pragma unroll
                for (int ks = 0; ks < 4; ++ks) at = __builtin_amdgcn_mfma_f32_16x16x32_bf16(af[ks], bfr[ks], at, 0, 0, 0);
            }
            const int s_ = 16 * st + l15;
#pragma unroll
            for (int r = 0; r < 4; ++r) { const int t = 16 * tt + 4 * q4 + r; const float val = (s_ <= t) ? at[r] : 0.f;
                *(LAS unsigned short*)(B + OFF_ATT + t * PK + s_ * 2) = (unsigned short)(pk2(val, 0.f) & 0xffffu); }
        }
        LDS_WAIT(); __builtin_amdgcn_s_barrier(); asm volatile("" ::: "memory");
    }
    mstage(nc - 1);
    LDS_WAIT(); __builtin_amdgcn_s_barrier(); asm volatile("" ::: "memory");
    *(GAS v4u*)(OD + (size_t)HG_ROW(nc - 1, vt) * 2048 + hc + v8) = *(const LAS v4u*)(lds + OFF_OST + vt * PQ + v8 * 2);
    if (ch.Sout) {
#pragma unroll
        for (int kt = 0; kt < 8; ++kt)
#pragma unroll
            for (int r = 0; r < 4; ++r) __builtin_nontemporal_store(S[kt][r] * DBG_SCALE, (GAS float*)ch.Sout + (size_t)(16 * kt + 4 * q4 + r) * 128 + 16 * w + l15);
    }
    __builtin_amdgcn_s_barrier();
#undef HG_ROW
#undef HG_LOAD
#undef HG_P1
}
}

__device__ __forceinline__ void hg_scan_phase(const Args& a, LAS unsigned char* lds, int tid, int vcu, int G) {
    OPAQUE_V(tid); PH_PTRS; OPAQUE_S(vcu); OPAQUE_S(G);
    const bf16* HQ = (const bf16*)(ws + WS_S + S_HQ); const bf16* HK = (const bf16*)(ws + WS_S + S_HK); const float* HGp = (const float*)(ws + WS_U);
    const bf16* HV = (const bf16*)(ws + WS_S + S_HV); bf16* OF = (bf16*)(ws + WS_S + S_OF);
    const int NS = G > 128 ? 64 : 0;
    int first = vcu < NS ? vcu : NS + (vcu - NS), step = vcu < NS ? 1088 : G - NS, last = 1088;
    if (G == 256) { if (vcu < 64) step = 1024; else last = 1024; }
    const int reps = ((DBG_REP_MASK >> 16) & 1) && vcu < NS ? 3 : ((DBG_REP_MASK >> 17) & 1) && vcu >= NS ? 3 : 1;
    for (int rep_ = 0; rep_ < reps; ++rep_)
    for (int ci = first; ci < last; ci += step) {
        const bool lat = ci < 64; const int e = lat ? ci : ci - 64, b = e >> 5, d = (e >> 4) & 1, h = e & 15;
        const size_t so = ((size_t)((b * 2 + d) * 16 + h)) * 16384;
        hg::Chain ch{lat ? MP + b * 2048 : b * 256, lat ? 2048 : 256, d, h, lat ? a.in[I_SHG] + so : nullptr, lat ? nullptr : out + O_HG + so};
        hg::scan_chain(ch, HQ, HK + (size_t)d * MALL * DM, HGp + (size_t)d * MALL * DM, HV, OF + (size_t)d * MALL * DM, lds, tid);
    }
}

__device__ __forceinline__ void hg_thin_c(const Args& a, int lane, int gw, int NGW) {
    OPAQUE_V(lane); PH_PTRS; OPAQUE_S(gw); OPAQUE_S(NGW);
    const bf16* OF = (const bf16*)(ws + WS_S + S_OF); const bf16* HGS = (const bf16*)(ws + WS_S + S_HGS); bf16* AO = (bf16*)(ws + WS_S + S_AO);
    const int grp = lane >> 4, s = lane & 15;
    const f32x4 g0 = *(const GAS f32x4*)(a.in[I_GHO] + 8 * s), g1 = *(const GAS f32x4*)(a.in[I_GHO] + 8 * s + 4);
    for (int it = gw; it < MALL * 4; it += NGW) {
        const int row = it >> 2, h = (it & 3) * 4 + grp; const size_t o_ = (size_t)row * DM + h * 128 + 8 * s;
        const v4u of = *(const GAS v4u*)(OF + o_), ob = *(const GAS v4u*)(OF + (size_t)MALL * DM + o_);
        const f32x4 a0 = (f32x4){bf_lo(of.x) + bf_lo(ob.x), bf_hi(of.x) + bf_hi(ob.x), bf_lo(of.y) + bf_lo(ob.y), bf_hi(of.y) + bf_hi(ob.y)}, a1 = (f32x4){bf_lo(of.z) + bf_lo(ob.z), bf_hi(of.z) + bf_hi(ob.z), bf_lo(of.w) + bf_lo(ob.w), bf_hi(of.w) + bf_hi(ob.w)};
        float ss = (a0.x * a0.x + a0.y * a0.y) + (a0.z * a0.z + a0.w * a0.w) + (a1.x * a1.x + a1.y * a1.y) + (a1.z * a1.z + a1.w * a1.w);
        const float rs = rsqrtf(sum16(ss) * (1.f / 128.f) + EPS);
        const v4u gw_ = *(const GAS v4u*)(HGS + o_);
        const f32x4 y0 = a0 * rs * g0 * (f32x4){bf_lo(gw_.x), bf_hi(gw_.x), bf_lo(gw_.y), bf_hi(gw_.y)}, y1 = a1 * rs * g1 * (f32x4){bf_lo(gw_.z), bf_hi(gw_.z), bf_lo(gw_.w), bf_hi(gw_.w)};
        *(GAS v4u*)(AO + o_) = (v4u){pk2(y0.x, y0.y), pk2(y0.z, y0.w), pk2(y1.x, y1.y), pk2(y1.z, y1.w)};
    }
}
namespace pg8 {
struct EpiNat {
    static constexpr bool PERM = true;
    bf16_t* QKV; bf16_t* KN; float* outk; float* outv; const float* gk; PG8_LAS float* tab;
    __device__ __forceinline__ void operator()(const f32x4 (&acc)[2][2][4][2], const Unit& u, int wr, int wc, int fr, int fq) const {
        const int region = u.pn >> 3, row0 = u.pm * BM + wr * 64 + fr, ct = (u.pn & 7) * BM + wc * 32 + 8 * fq;
        if (region == 1) {
#pragma unroll
            for (int ai = 0; ai < 2; ++ai)
#pragma unroll
                for (int m = 0; m < 4; ++m)
#pragma unroll
                    for (int bj = 0; bj < 2; ++bj) { const f32x4 a = acc[ai][bj][m][0], b = acc[ai][bj][m][1];
                        float s = (a[0] * a[0] + a[1] * a[1]) + (a[2] * a[2] + a[3] * a[3]) + (b[0] * b[0] + b[1] * b[1]) + (b[2] * b[2] + b[3] * b[3]);
                        s += __shfl_xor(s, 16); s += __shfl_xor(s, 32);
                        if (fq == 0) tab[((ai * HALF + wr * 64 + m * 16 + fr) * 2 + bj) * 4 + wc] = s; }
            asm volatile("s_waitcnt lgkmcnt(0)" ::: "memory"); __builtin_amdgcn_s_barrier(); asm volatile("" ::: "memory");
            f32x4 g0[2], g1[2];
#pragma unroll
            for (int bj = 0; bj < 2; ++bj) { g0[bj] = *(const PG8_GAS f32x4*)(gk + wc * 32 + 8 * fq); g1[bj] = *(const PG8_GAS f32x4*)(gk + wc * 32 + 8 * fq + 4); }
#pragma unroll
            for (int ai = 0; ai < 2; ++ai)
#pragma unroll
                for (int m = 0; m < 4; ++m) { const int row = row0 + ai * HALF + m * 16;
#pragma unroll
                    for (int bj = 0; bj < 2; ++bj) { const f32x4 p = *(const PG8_LAS f32x4*)(tab + ((ai * HALF + wr * 64 + m * 16 + fr) * 2 + bj) * 4);
                        const float rs = rsqrtf(((p[0] + p[1]) + (p[2] + p[3])) * (1.f / 128.f) + 1e-6f);
                        const f32x4 k0 = acc[ai][bj][m][0] * rs * g0[bj], k1 = acc[ai][bj][m][1] * rs * g1[bj];
                        u32x4 w; w.x = cvt_pk_bf16(k0[0], k0[1]); w.y = cvt_pk_bf16(k0[2], k0[3]); w.z = cvt_pk_bf16(k1[0], k1[1]); w.w = cvt_pk_bf16(k1[2], k1[3]);
                        *(PG8_GAS u32x4*)(KN + (size_t)row * 2048 + ct + bj * HALF) = w;
                        if (row < 8192) { __builtin_nontemporal_store(k0 * DBG_SCALE, (PG8_GAS f32x4*)(outk + (size_t)row * 2048 + ct + bj * HALF)); __builtin_nontemporal_store(k1 * DBG_SCALE, (PG8_GAS f32x4*)(outk + (size_t)row * 2048 + ct + bj * HALF + 4)); } } }
        } else {
#pragma unroll
            for (int ai = 0; ai < 2; ++ai)
#pragma unroll
                for (int m = 0; m < 4; ++m) { const int row = row0 + ai * HALF + m * 16;
#pragma unroll
                    for (int bj = 0; bj < 2; ++bj) { const f32x4 v0 = acc[ai][bj][m][0], v1 = acc[ai][bj][m][1];
                        u32x4 w; w.x = cvt_pk_bf16(v0[0], v0[1]); w.y = cvt_pk_bf16(v0[2], v0[3]); w.z = cvt_pk_bf16(v1[0], v1[1]); w.w = cvt_pk_bf16(v1[2], v1[3]);
                        *(PG8_GAS u32x4*)(QKV + (size_t)row * 6144 + region * 2048 + ct + bj * HALF) = w;
                        if (region == 2 && row < 8192) { __builtin_nontemporal_store(v0 * DBG_SCALE, (PG8_GAS f32x4*)(outv + (size_t)row * 2048 + ct + bj * HALF)); __builtin_nontemporal_store(v1 * DBG_SCALE, (PG8_GAS f32x4*)(outv + (size_t)row * 2048 + ct + bj * HALF + 4)); } } }
        }
    }
};
}
__device__ __forceinline__ void nat_cache_rows(const Args& a, int lane, int gw, int NGW) {
    OPAQUE_V(lane); PH_PTRS; OPAQUE_S(gw); OPAQUE_S(NGW);
    bf16* QKV = (bf16*)(ws + WS_S + S_NQKV); bf16* KN = (bf16*)(ws + WS_S + S_NKN);
    for (int it = gw; it < 512 * 4; it += NGW) {
        const int row = MALL + (it >> 2), c = (it & 3) * 512 + 8 * lane; const size_t so = (size_t)(row - MALL) * DM + c;
        const f32x4 k0 = *(const GAS f32x4*)(a.in[I_CNK] + so), k1 = *(const GAS f32x4*)(a.in[I_CNK] + so + 4), v0 = *(const GAS f32x4*)(a.in[I_CNV] + so), v1 = *(const GAS f32x4*)(a.in[I_CNV] + so + 4);
        *(GAS v4u*)(KN + (size_t)row * DM + c) = (v4u){pk2(k0.x, k0.y), pk2(k0.z, k0.w), pk2(k1.x, k1.y), pk2(k1.z, k1.w)};
        *(GAS v4u*)(QKV + (size_t)row * 6144 + 4096 + c) = (v4u){pk2(v0.x, v0.y), pk2(v0.z, v0.w), pk2(v1.x, v1.y), pk2(v1.z, v1.w)};
    }
}
__device__ __forceinline__ void nat_attn_phase(const Args& a, LAS unsigned char* lds, int tid, int vcu, int G) {
    OPAQUE_V(tid); PH_PTRS; OPAQUE_S(vcu); OPAQUE_S(G);
    const bf16* QKV = (const bf16*)(ws + WS_S + S_NQKV); const bf16* KN = (const bf16*)(ws + WS_S + S_NKN); bf16* AO = (bf16*)(ws + WS_S + S_AO); const float* gq = a.in[I_GNQ];
    LAS float* rpb = (LAS float*)(lds + att::RPB_OFF);
    for (int u = vcu; u < 768; u += G) {
        if (u < 256) {
            const int b = u >> 7, h = (u >> 3) & 15, i = u & 7, q0 = MP + b * 2048 + i * 256;
            const int rlo = min(max(4 * i - 4, 0), 24), rhi = min(max(4 * i - 1, 0), 24) + 8, nrows = rhi - rlo;
            __syncthreads();
            for (int e = tid; e < 465; e += NTHR) rpb[e] = a.in[I_RPB][h * 465 + e] * 11.313708498984761f;
            __syncthreads();
            const att::KvSrc src{MALL + b * 256, 4, MP + b * 2048 + 64 * rlo, nrows};
            const att::NatMask nm{rlo, 4 * i + ((tid >> 6) >> 1), 32 * ((tid >> 6) & 1) + (tid & 31), rpb};
            att::attn_unit<128, 1, 6144, DM, 6144, DM, 1>(QKV + (size_t)q0 * 6144 + h * 128, KN + h * 128, QKV + 4096 + h * 128, AO + (size_t)q0 * DM + h * 128, src, 4 + nrows, nm, (LAS char*)lds, tid, gq, nullptr);
        } else {
            const int v = u - 256, b = v >> 4, h = v & 15, q0 = b * 256;
            const att::KvSrc src{b * 256, 4, 0, 1};
            att::attn_unit<128, 0, 6144, DM, 6144, DM, 1>(QKV + (size_t)q0 * 6144 + h * 128, KN + h * 128, QKV + 4096 + h * 128, AO + (size_t)q0 * DM + h * 128, src, 4, att::NatMask{0, 0, 0, nullptr}, (LAS char*)lds, tid, gq, nullptr);
        }
    }
}
constexpr int NPHASE = 2 + 10 * DEPTH;
__host__ __device__ constexpr bool phase_exists(int ph) {
    if (ph == 0 || ph == NPHASE - 1) return true;
    const int l = (ph - 1) / 10, k = (ph - 1) % 10, kind = l % 3;
    if (k == 2) return kind != 2;
    if (k == 3) return kind == 0;
    if (k == 4) return kind == 1;
    if (k == 5) return kind != 1;
    return true;
}

__global__ void __launch_bounds__(NTHR, 2) fwd(Args a) {
    extern __shared__ __attribute__((aligned(16))) unsigned char lds_[];
    LAS unsigned char* lds = (LAS unsigned char*)lds_;
#define tid ({ int t_ = threadIdx.x; asm volatile("" : "+v"(t_)); t_; })
#define lane (tid & 63)
#define wave (__builtin_amdgcn_readfirstlane(tid >> 6))
    const int G = gridDim.x, bx = blockIdx.x, vcu = (G % 8 == 0) ? (bx % 8) * (G / 8) + bx / 8 : bx;
    const int NGW = G * NWAVES;
#define gw (vcu * NWAVES + wave)
    volatile LAS unsigned* MISC = (volatile LAS unsigned*)(lds + MISC_OFF);
    unsigned* ctl = (unsigned*)(a.ws + WS_CTL);
    for (int u = tid; u < (LDS_BYTES - LDSCTL_OFF) / 4; u += NTHR) ((LAS unsigned*)(lds + LDSCTL_OFF))[u] = 0u;
    __syncthreads();
    XcdBarrier bar; bar.bar = ctl + CW_BAR; bar.x = 0; bar.st = nullptr;
    if (MK_SINGLE) bar = xcd_barrier_post(ctl + CW_BAR, MISC + 8);
    const int lo = a.ph_lo, hi = a.ph_hi;
#define IN(k) (lo <= (k) && (k) < hi)
#ifndef DBG_REP_MASK
#define DBG_REP_MASK 0
#endif
#define REPEAT(id) for (int rep_ = 0; rep_ < (((DBG_REP_MASK >> (id)) & 1) ? 3 : 1); ++rep_)
#if defined(DBG_PROF)
    { unsigned long long* prof = (unsigned long long*)((unsigned char*)ctl + WS_PROF); float* po_ = a.out;
      if (bx == 0 && tid == 0) { prof[200] = (unsigned long long)*(volatile unsigned*)(po_ + O_END - 1); prof[100] = wall_clock64(); prof[300] = clock64(); } }
#define SEAM(k) do { if (MK_SINGLE && (k) + 1 < hi) xcd_barrier(bar); if (bx == 0 && tid == 0) { unsigned long long* prof = (unsigned long long*)((unsigned char*)bar.bar - CW_BAR * 4 + WS_PROF); prof[100 + (k) + 1] = wall_clock64(); prof[300 + (k) + 1] = clock64(); } } while (0)
#else
#define SEAM(k) do { if (MK_SINGLE && (k) + 1 < hi) xcd_barrier(bar); } while (0)
#endif
#define GEMM_PTRS PH_PTRS; int gG = G, gbx = bx; OPAQUE_S(gG); OPAQUE_S(gbx); bf16* const H = (bf16*)(ws + WS_H); bf16* const U = (bf16*)(ws + WS_U); bf16* const AO = (bf16*)(ws + WS_S + S_AO); bf16* const X = (bf16*)(ws + WS_S + S_X); \
    const float* const MODS = (const float*)(ws + WS_MODS); (void)H; (void)U; (void)AO; (void)X; (void)MODS

#define CONVERT_WINDOW(wi_, nunits) do { const int from_ = (nunits) % gG; if (!from_ || gbx >= from_) p0_convert_range(a, lds, a.wnd[wi_], a.wnd[(wi_) + 1], (gbx - from_) * NWAVES + wave, (gG - from_) * NWAVES, lane, wave); } while (0)

    if (IN(0)) { REPEAT(0) { p0_prologue(a, lds, tid, lane, wave, vcu, G); rope_table(a, tid, vcu, G); if (DBG_REP_MASK & 1) __syncthreads(); } SEAM(0); }

    for (int l = 0; l < DEPTH; ++l) {
        const int kind = l % 3, j = l / 3, pb = 1 + 10 * l;
        if (IN(pb + 0)) { REPEAT(1) norm_phase(a, l, false, l > 0 ? (const float*)(a.ws + WS_MODS) + (size_t)(l - 1) * 3 * NMOD + 5 * DM : nullptr, lane, gw, NGW); if (kind == 2) nat_cache_rows(a, lane, gw, NGW); SEAM(pb + 0); }
        if (kind == 0) {
            if (IN(pb + 1)) {
                GEMM_PTRS; unsigned char* wm = ws + WS_WMLA + (size_t)j * WMLA_STRIDE;
                pg8::Gemm g{H, (const bf16*)wm, MALL, 1536, DM, DM, DM, 1}; pg8::QaOrder S; S.init(gG, gbx, g.K);
                pg8::EpiBf16<0> E{(bf16*)(ws + WS_S + S_QAKV), 1536};
                REPEAT(2) pg8::gemm_phase<pg8::EpiBf16<0>, pg8::QaOrder>(lds, g, S, E);
                CONVERT_WINDOW(l == 0 ? 1 : 6, 288);
                SEAM(pb + 1);
            }
            if (IN(pb + 2)) { REPEAT(3) mla_thin_a(a, j, lane, gw, NGW); SEAM(pb + 2); }
            if (IN(pb + 3)) {
                GEMM_PTRS; unsigned char* wm = ws + WS_WMLA + (size_t)j * WMLA_STRIDE;
                REPEAT(4) {
                { pg8::Gemm g{(const bf16*)(ws + WS_S + S_QAN), (const bf16*)(wm + WMLA_QB), MALL, 3072, 768, 768, 768, 1}; pg8::StaticOrder S; S.init(MALL, 3072, 1, gG, gbx, g.K);
                  pg8::EpiBf16<0> E{(bf16*)(ws + WS_S + S_QRAW), 3072};
                  pg8::gemm_phase<pg8::EpiBf16<0>, pg8::StaticOrder>(lds, g, S, E); }
                { pg8::Gemm g{(const bf16*)(ws + WS_S + S_CKVN), (const bf16*)(wm + WMLA_KVB), MKV, 4096, 512, 512, 512, 1}; pg8::StaticOrder S; S.init(MKV, 4096, 1, gG, (gbx + gG / 2) % gG, g.K);
                  pg8::EpiKV E{(bf16*)(ws + WS_S + S_KVRAW), (bf16*)(ws + WS_S + S_KF), a.in[I_GKN] + (size_t)j * 192, (const float*)(ws + WS_S + S_KPE), (const float*)(ws + WS_SSK), (const float*)(ws + WS_ROPE), (LAS float*)(lds + EPI_TAB_OFF)};
                  pg8::gemm_phase<pg8::EpiKV, pg8::StaticOrder>(lds, g, S, E); }
                }
                {
                    int p_ = gbx, np_ = gG;
                    if (gG == 256) { p_ = gbx < 64 ? -1 : gbx < 128 ? gbx - 64 : gbx < 160 ? -1 : gbx - 96; np_ = 160; }
                    if (p_ >= 0) p0_convert_range(a, lds, a.wnd[l == 0 ? 2 : 7], a.wnd[l == 0 ? 3 : 8], p_ * NWAVES + wave, np_ * NWAVES, lane, wave);
                }
                SEAM(pb + 3);
            }
            if (IN(pb + 5)) { REPEAT(6) mla_attn_phase(a, j, lds, tid, vcu, G); SEAM(pb + 5); }
        }
        if (kind == 1) {
            if (IN(pb + 1)) {
                GEMM_PTRS;
                pg8::Gemm g{H, (const bf16*)(ws + WS_WHG), MALL, 10240, DM, DM, DM, 1}; pg8::StaticOrder S; S.init(MALL, 10240, 1, gG, gbx, g.K);
                pg8::EpiHg E{ws};
                REPEAT(8) pg8::gemm_phase<pg8::EpiHg, pg8::StaticOrder, false>(lds, g, S, E);
                CONVERT_WINDOW(3, 1920);
                SEAM(pb + 1);
            }
            if (IN(pb + 2)) { REPEAT(9) hg_scan_phase(a, lds, tid, vcu, G); SEAM(pb + 2); }
            if (IN(pb + 4)) { REPEAT(10) hg_thin_c(a, lane, gw, NGW); SEAM(pb + 4); }
        }
        if (kind == 2) {
            if (IN(pb + 1)) {
                GEMM_PTRS;
                pg8::Gemm g{H, (const bf16*)(ws + WS_WNAT), MALL, 6144, DM, DM, DM, 1}; pg8::StaticOrder S; S.init(MALL, 6144, 1, gG, gbx, g.K);
                pg8::EpiNat E{(bf16*)(ws + WS_S + S_NQKV), (bf16*)(ws + WS_S + S_NKN), out + O_NK, out + O_NV, a.in[I_GNK], (LAS float*)(lds + EPI_TAB_OFF)};
                REPEAT(11) pg8::gemm_phase<pg8::EpiNat, pg8::StaticOrder>(lds, g, S, E);
                CONVERT_WINDOW(5, 1152);
                SEAM(pb + 1);
            }
            if (IN(pb + 5)) { REPEAT(13) nat_attn_phase(a, lds, tid, vcu, G); SEAM(pb + 5); }
        }
        if (IN(pb + 6)) {
            GEMM_PTRS;
            const bf16* wo = (const bf16*)(kind == 0 ? ws + WS_WMLA + (size_t)j * WMLA_STRIDE + WMLA_WO : kind == 1 ? ws + WS_WHG + WHG_WO : ws + WS_WNAT + WNAT_WO);
            pg8::Gemm g{AO, wo, MALL, DM, DM / 2, DM, DM, 2}; pg8::ResOrder S; S.init(gG, gbx, DM);
            pg8::EpiRes2 E{X, MODS + (size_t)l * 3 * NMOD + 2 * DM, (bf16*)(ws + WS_S + S_PART), nullptr};
            pg8::gemm_phase<pg8::EpiRes2, pg8::ResOrder>(lds, g, S, E);
            SEAM(pb + 6);
        }
        if (IN(pb + 7)) { REPEAT(1) norm_phase(a, l, true, (const float*)(a.ws + WS_MODS) + (size_t)l * 3 * NMOD + 2 * DM, lane, gw, NGW); SEAM(pb + 7); }
        if (IN(pb + 8)) {
            GEMM_PTRS;
            pg8::Gemm g{H, (const bf16*)(ws + WS_WFF1) + (size_t)l * DM * FF, MALL, FF, DM, DM, DM, 1}; pg8::StaticOrder S; S.init(MALL, FF, 1, gG, gbx, g.K);
            pg8::EpiBf16<1> E{U, FF};
            REPEAT(7) pg8::gemm_phase<pg8::EpiBf16<1>, pg8::StaticOrder>(lds, g, S, E);
            SEAM(pb + 8);
        }
        if (IN(pb + 9)) {
            GEMM_PTRS;
            pg8::Gemm g{U, (const bf16*)(ws + WS_WFF2) + (size_t)l * DM * FF, MALL, DM, FF / 2, FF, FF, 2}; pg8::ResOrder S; S.init(gG, gbx, FF);
            pg8::EpiRes2 E{X, MODS + (size_t)l * 3 * NMOD + 5 * DM, (bf16*)(ws + WS_S + S_PART), l + 1 == DEPTH ? out + O_X : nullptr};
            pg8::gemm_phase<pg8::EpiRes2, pg8::ResOrder>(lds, g, S, E);
            SEAM(pb + 9);
        }
    }
    if (IN(NPHASE - 1)) final_fix_phase(a, (const float*)(a.ws + WS_MODS) + (size_t)(DEPTH - 1) * 3 * NMOD + 5 * DM, lane, gw, NGW);
#if defined(DBG_PROF)
    xcd_barrier(bar);
    { unsigned long long* prof = (unsigned long long*)((unsigned char*)bar.bar - CW_BAR * 4 + WS_PROF); float* po_ = a.out;
    if (bx == 0) {
        if (tid == 0) { prof[100 + NPHASE] = wall_clock64(); prof[300 + NPHASE] = clock64(); }
        __syncthreads();
        if (tid == 0) { constexpr int p = DBG_PROF; const unsigned long long dw = prof[100 + p + 1] - prof[100 + p], dc = prof[300 + p + 1] - prof[300 + p];
            float mant = (float)dw * 1e-4f; mant = mant < 1.f ? 1.f : mant > 9.9f ? 9.9f : mant; const int expo = dw ? (int)(dc / dw) : 0;
            po_[O_X + 7] = mant * __builtin_powif(10.f, expo); }
    } }
#endif
#undef IN
#undef SEAM
#undef tid
#undef lane
#undef wave
#undef gw
}

extern "C" void kernel_launch(void* const* d_in, const int* in_sizes, int n_in, void* d_out, int out_size, void* d_ws, size_t ws_size, hipStream_t stream) {
    static int grid = 0;
    if (grid == 0) {
        if (n_in != N_IN || (size_t)out_size != O_END || ws_size < WS_END) { fprintf(stderr, "kernel_launch: shape mismatch n_in %d out %d ws %zu (need %zu); nothing launched\n", n_in, out_size, ws_size, (size_t)WS_END); grid = -1; return; }
        int dev = 0, cus = 0, per_cu = 0;
        if (hipGetDevice(&dev) != hipSuccess || hipDeviceGetAttribute(&cus, hipDeviceAttributeMultiprocessorCount, dev) != hipSuccess) { fprintf(stderr, "kernel_launch: device query failed\n"); grid = -1; return; }
        if (hipFuncSetAttribute((const void*)fwd, hipFuncAttributeMaxDynamicSharedMemorySize, LDS_BYTES) != hipSuccess) { fprintf(stderr, "kernel_launch: hipFuncSetAttribute failed\n"); grid = -1; return; }
        if (hipOccupancyMaxActiveBlocksPerMultiprocessor(&per_cu, (const void*)fwd, NTHR, LDS_BYTES) != hipSuccess || per_cu < 1) { fprintf(stderr, "kernel_launch: occupancy query says %d blocks/CU\n", per_cu); }
        (void)hipGetLastError();
        grid = cus;
    }
    if (grid < 0) return;
    if (hipMemsetAsync((char*)d_ws + WS_CTL, 0, CTL_ZERO_BYTES, stream) != hipSuccess) { fprintf(stderr, "kernel_launch: memset failed\n"); return; }
    Args a{};
    for (int i = 0; i < N_IN; ++i) a.in[i] = (const float*)d_in[i];
    a.out = (float*)d_out; a.ws = (unsigned char*)d_ws;
    int nt = 0, items = 0;
    auto add = [&](const float* src, size_t dst_off, int K, int N, int row_off) { TJob& t = a.tj[nt++]; t.src = src; t.dst = (bf16*)((unsigned char*)d_ws + dst_off); t.K = K; t.N = N; t.row_off = row_off; t.start = items; items += (K / 64) * (N / 32); };
    auto add_mixer = [&](int l) {
        if (l % 3 == 0) { const int j = l / 3; const size_t wb = WS_WMLA + (size_t)j * WMLA_STRIDE;
            add(a.in[I_WQA] + (size_t)j * DM * 768, wb, DM, 768, 0); add(a.in[I_WKVA] + (size_t)j * DM * 576, wb, DM, 576, 768);
            add(a.in[I_WQB] + (size_t)j * 768 * 3072, wb + WMLA_QB, 768, 3072, 0); add(a.in[I_WKVB] + (size_t)j * 512 * 4096, wb + WMLA_KVB, 512, 4096, 0);
            add(a.in[I_WMO] + (size_t)j * DM * DM, wb + WMLA_WO, DM, DM, 0); }
        if (l % 3 == 1) { add(a.in[I_WHQ], WS_WHG, DM, DM, 0); add(a.in[I_WHF], WS_WHG, DM, DM, 2048); add(a.in[I_WHF] + (size_t)DM * DM, WS_WHG, DM, DM, 4096);
            add(a.in[I_WHI], WS_WHG, DM, DM, 6144); add(a.in[I_WHG], WS_WHG, DM, DM, 8192); add(a.in[I_WHO], WS_WHG + WHG_WO, DM, DM, 0); }
        if (l % 3 == 2) { add(a.in[I_WNQKV], WS_WNAT, DM, 3 * DM, 0); add(a.in[I_WNO], WS_WNAT + WNAT_WO, DM, DM, 0); } };
    static_assert(DEPTH == 4, "the window program below is written for the 4-layer MLA / HGRN2 / NAT / MLA stack");
    auto ff1 = [&](int l) { add(a.in[I_WFF1] + (size_t)l * DM * FF, WS_WFF1 + (size_t)l * DM * FF * 2, DM, FF, 0); };
    auto ff2 = [&](int l) { add(a.in[I_WFF2] + (size_t)l * DM * FF, WS_WFF2 + (size_t)l * DM * FF * 2, FF, DM, 0); };
    const int fromA = 288 % grid, partA = (fromA ? grid - fromA : grid) * NWAVES;
    auto split = [&](int lo, int hi) { long n = (long)WQA * partA; if (n > hi - lo) n = hi - lo; return lo + (int)n; };
    a.wnd[0] = 0; add_mixer(0);
    a.wnd[1] = items; ff1(0); ff2(0); add_mixer(1); a.wnd[3] = items; a.wnd[2] = split(a.wnd[1], a.wnd[3]);
    ff1(1); ff2(1); add_mixer(2); a.wnd[4] = items; a.wnd[5] = items;
    ff1(2); ff2(2); add_mixer(3); a.wnd[6] = items;
    ff1(3); ff2(3); a.wnd[8] = items; a.wnd[7] = split(a.wnd[6], a.wnd[8]);
    for (int w = 9; w < 12; ++w) a.wnd[w] = items;
    a.ntj = nt; a.nitems = items;
#if MK_SINGLE
    a.ph_lo = 0; a.ph_hi = NPHASE < MK_LAST_PHASE ? NPHASE : MK_LAST_PHASE;
    hipLaunchKernelGGL(fwd, dim3(grid), dim3(NTHR), LDS_BYTES, stream, a);
#else
    for (int ph = 0; ph < NPHASE && ph < MK_LAST_PHASE; ++ph) {
        if (!phase_exists(ph)) continue;
        a.ph_lo = ph; a.ph_hi = ph + 1;
        hipLaunchKernelGGL(fwd, dim3(grid), dim3(NTHR), LDS_BYTES, stream, a);
    }
#endif
    const hipError_t le = hipPeekAtLastError();
    if (le != hipSuccess) fprintf(stderr, "kernel_launch: launch failed: %s\n", hipGetErrorName(le));
}
```

```cpp
#define MK_SINGLE 1
#define MK_LAST_PHASE 1000
#include <hip/hip_runtime.h>
#include <cstdio>
#include <cstdint>

#ifndef MK_SINGLE
#define MK_SINGLE 1
#endif
#ifndef WQA
#define WQA 12
#endif
#ifndef MK_LAST_PHASE
#define MK_LAST_PHASE 1000
#endif
namespace pg8 {
#define PG8_LAS __attribute__((address_space(3)))
#define PG8_GAS __attribute__((address_space(1)))
typedef unsigned short bf16_t;
typedef short bf16x8 __attribute__((ext_vector_type(8)));
typedef float f32x4 __attribute__((ext_vector_type(4)));
typedef unsigned u32x4 __attribute__((ext_vector_type(4)));
constexpr int BM = 256, BK = 64, HALF = 128, HTB = HALF * BK * 2  , STAGE_BYTES = 8 * HTB, NXCD = 8, WGM = 8;

__host__ __device__ __forceinline__ int lds_byte(int r, int c) { const int st = (r >> 4) * 2 + (c >> 5), rr = r & 15, cc = c & 31, ob = rr * 64 + cc * 2; return st * 1024 + (ob ^ (((ob >> 9) & 1) << 5)); }
__host__ __device__ __forceinline__ void stage_rc(int b, int& R, int& C) { const int st = b / 1024, sb = b % 1024, swz = sb ^ (((sb >> 9) & 1) << 5); R = (st >> 1) * 16 + swz / 64; C = (st & 1) * 32 + (swz % 64) / 2; }
__host__ __device__ __forceinline__ int perm32(int rho) { const int n = rho >> 4, i = rho & 15; return 8 * (i >> 2) + 4 * n + (i & 3); }

struct Unit { int pm, pn, ks, nkt, part, nh; };
struct Gemm { const bf16_t* A; const bf16_t* Bt; int M, N, K, lda, ldb, nsplit; };

struct StaticOrder {
    static constexpr bool HAS_NH = false;
    int nM, nN, nNv, nwg, G, c, nkt, split;
    __host__ __device__ void init(int M, int N, int nsplit, int G_, int c_, int K = 0) { nM = M / BM; nN = N / BM; nNv = nN * nsplit; nwg = nM * nNv; G = G_; c = c_; nkt = K / BK; split = nsplit; }
    __host__ __device__ bool next(int i, Unit& u) const {
        const long L = (long)i * G + c; if (L >= nwg) return false;
        int wgid = (int)L; { const int q = nwg / NXCD, r = nwg % NXCD, xcd = wgid % NXCD, off = wgid / NXCD; wgid = (xcd < r ? xcd * (q + 1) : r * (q + 1) + (xcd - r) * q) + off; }
        const int nig = WGM * nNv, gid = wgid / nig, fm = gid * WGM, gsz = (nM - fm) < WGM ? (nM - fm) : WGM;
        u.pm = fm + ((wgid % nig) % gsz); const int pv = (wgid % nig) / gsz; u.pn = pv % nN; u.ks = pv / nN; u.nkt = nkt; u.part = split > 1 ? u.ks : -1; u.nh = 0; return true;
    }
    __device__ __forceinline__ void a_ready(const Unit&) const {}
    __device__ __forceinline__ void done(const Unit&) const {}
};

struct QaOrder {
    static constexpr bool HAS_NH = true;
    StaticOrder M5; int G, c, nkt;
    __host__ __device__ void init(int G_, int c_, int K) { M5.init(12288, 1280, 1, G_, c_, K); G = G_; c = c_; nkt = K / BK; }
    __host__ __device__ bool next(int i, Unit& u) const {
        const int L = i * G + c;
        if (L < 240) return M5.next(i, u);
        if (L >= 288) return false;
        u.pm = L - 240; u.pn = 5; u.ks = 0; u.nkt = nkt; u.part = -1; u.nh = 1; return true;
    }
    __device__ __forceinline__ void a_ready(const Unit&) const {}
    __device__ __forceinline__ void done(const Unit&) const {}
};
struct ResOrder {
    static constexpr bool HAS_NH = false;
    int G, c, nkF, nkH;
    __host__ __device__ void init(int G_, int c_, int K) { G = G_; c = c_; nkF = K / BK; nkH = K / (2 * BK); }
    __host__ __device__ bool next(int i, Unit& u) const {
        const int L = i * G + c; if (L >= 512) return false;
        const bool half = L >= 256; int w = half ? L - 256 : L;
        w = (w & 7) * 32 + (w >> 3);
        const int sh = half ? 7 : 6, e = w & ((1 << sh) - 1), pv = e >> 3;
        u.pm = (half ? 32 : 0) + ((w >> sh) << 3) + (e & 7); u.pn = pv & 7; u.ks = pv >> 3; u.nkt = half ? nkH : nkF; u.part = half ? u.ks : -1; u.nh = 0; return true;
    }
    __device__ __forceinline__ void a_ready(const Unit&) const {}
    __device__ __forceinline__ void done(const Unit&) const {}
};

__device__ __forceinline__ unsigned cvt_pk_bf16(float lo, float hi) { unsigned r; asm("v_cvt_pk_bf16_f32 %0, %1, %2" : "=v"(r) : "v"(lo), "v"(hi)); return r; }


template <class Epi, class Sched, bool ALIGN_EPI = true, bool SP2 = true>
__device__ __forceinline__ void gemm_phase(PG8_LAS unsigned char* lds, const Gemm g, const Sched& S, const Epi& E) {
    int tid_ = threadIdx.x; asm volatile("" : "+v"(tid_));
    const int tid = tid_, wid = __builtin_amdgcn_readfirstlane(tid >> 6), lane = tid & 63, wr = wid >> 2, wc = wid & 3, fr = lane & 15, fq = lane >> 4;
    const int K = g.K;
    unsigned voffA[2], voffB[2];
#pragma unroll
    for (int i = 0; i < 2; ++i) { int R, C; stage_rc(tid * 16 + i * 8192, R, C); const int Rb = Epi::PERM ? ((R & ~31) + perm32(R & 31)) : R;
        voffA[i] = (unsigned)(R * g.lda + C) * 2u; voffB[i] = (unsigned)(Rb * g.ldb + C) * 2u; }
    const size_t kstep = (size_t)(BK * 2);
    const size_t hstepA = (size_t)HALF * g.lda * 2, hstepB = (size_t)HALF * g.ldb * 2;
    const size_t tstepA = 2 * hstepA, tstepB = 2 * hstepB;
    const size_t sstep = (size_t)K * 2;
    const unsigned ldsw = (unsigned)wid * 1024u;
    const int aoff = lds_byte(wr * 64 + fr, fq * 8), boff = lds_byte(wc * 32 + fr, fq * 8);
#define PG8_SA(b, h) (((b) * 2 + (h)) * HTB)
#define PG8_SB(b, h) ((4 + (b) * 2 + (h)) * HTB)
#define PG8_STAGE(bufoff, gbase, voff) do { _Pragma("unroll") for (int _i = 0; _i < 2; ++_i) \
        __builtin_amdgcn_global_load_lds((const unsigned*)((const char*)(gbase) + (voff)[_i]), (PG8_LAS unsigned*)(lds + (bufoff) + ldsw + _i * 8192), 16, 0, 0); } while (0)
#define PG8_LDA(dst, b, h) do { _Pragma("unroll") for (int m = 0; m < 4; ++m) _Pragma("unroll") for (int k = 0; k < 2; ++k) dst[m][k] = *(const PG8_LAS bf16x8*)(lds + PG8_SA(b, h) + aoff + m * 2048 + k * 1024); } while (0)
#define PG8_LDB(dst, b, h) do { _Pragma("unroll") for (int n = 0; n < 2; ++n) _Pragma("unroll") for (int k = 0; k < 2; ++k) dst[n][k] = *(const PG8_LAS bf16x8*)(lds + PG8_SB(b, h) + boff + n * 2048 + k * 1024); } while (0)
#define PG8_MMA(ai, bj, At, Bt) do { __builtin_amdgcn_s_setprio(1); _Pragma("unroll") for (int m = 0; m < 4; ++m) _Pragma("unroll") for (int n = 0; n < 2; ++n) _Pragma("unroll") for (int k = 0; k < 2; ++k) \
        acc[ai][bj][m][n] = __builtin_amdgcn_mfma_f32_16x16x32_bf16(Bt[n][k], At[m][k], acc[ai][bj][m][n], 0, 0, 0); __builtin_amdgcn_s_setprio(0); } while (0)
#define PG8_WAIT_V(n) asm volatile("s_waitcnt vmcnt(" #n ")" ::: "memory")
#define PG8_WAIT_L(n) asm volatile("s_waitcnt lgkmcnt(" #n ")" ::: "memory")
#define PG8_BAR __builtin_amdgcn_s_barrier()
#define PG8_SCHED __builtin_amdgcn_sched_barrier(0)
    Unit cur, nxt; int ui = 0;
    if (!S.next(0, cur)) return;
    f32x4 acc[2][2][4][2];
#pragma unroll
    for (int a = 0; a < 2; ++a)
#pragma unroll
        for (int b = 0; b < 2; ++b)
#pragma unroll
            for (int m = 0; m < 4; ++m)
#pragma unroll
                for (int n = 0; n < 2; ++n) acc[a][b][m][n] = (f32x4){0.f, 0.f, 0.f, 0.f};
    bf16x8 At[4][2], B0[2][2], B1[2][2];
    const char* cA = (const char*)g.A + (size_t)cur.pm * tstepA + (size_t)cur.ks * sstep; const char* cB = (const char*)g.Bt + (size_t)cur.pn * tstepB + (size_t)cur.ks * sstep;
    S.a_ready(cur);
    if constexpr (SP2) {
        PG8_STAGE(PG8_SB(0, 0), cB, voffB); PG8_STAGE(PG8_SB(0, 1), cB + hstepB, voffB); PG8_STAGE(PG8_SA(0, 0), cA, voffA); PG8_STAGE(PG8_SA(0, 1), cA + hstepA, voffA);
        if (wr == 1) PG8_BAR;
        PG8_WAIT_V(2); PG8_BAR;
        PG8_STAGE(PG8_SB(1, 0), cB + kstep, voffB); PG8_STAGE(PG8_SA(1, 0), cA + kstep, voffA); PG8_STAGE(PG8_SB(1, 1), cB + hstepB + kstep, voffB);
        PG8_WAIT_V(6); PG8_BAR;
    } else {
        PG8_STAGE(PG8_SB(0, 0), cB, voffB); PG8_STAGE(PG8_SA(0, 0), cA, voffA); PG8_STAGE(PG8_SB(0, 1), cB + hstepB, voffB); PG8_STAGE(PG8_SA(0, 1), cA + hstepA, voffA);
        if (wr == 1) PG8_BAR;
        PG8_WAIT_V(4); PG8_BAR;
        PG8_STAGE(PG8_SB(1, 0), cB + kstep, voffB); PG8_STAGE(PG8_SA(1, 0), cA + kstep, voffA); PG8_STAGE(PG8_SB(1, 1), cB + hstepB + kstep, voffB);
        PG8_WAIT_V(6); PG8_BAR;
    }
    for (;;) {
        const bool has_next = S.next(ui + 1, nxt);
        const char* nA = has_next ? (const char*)g.A + (size_t)nxt.pm * tstepA + (size_t)nxt.ks * sstep : cA; const char* nB = has_next ? (const char*)g.Bt + (size_t)nxt.pn * tstepB + (size_t)nxt.ks * sstep : cB;
        const int nt = cur.nkt; const bool nh = cur.nh != 0;
        for (int t = 0; t < nt; t += 2) {
            const bool last = (t == nt - 2);
            const char* a1 = cA + (size_t)(t + 1) * kstep;
            const char* a2 = last ? nA : cA + (size_t)(t + 2) * kstep; const char* b2 = last ? nB : cB + (size_t)(t + 2) * kstep;
            const char* a3 = a2 + kstep; const char* b3 = b2 + kstep;
            if (last && has_next) S.a_ready(nxt);
            if constexpr (SP2) {
            PG8_LDB(B0, 0, 0); PG8_LDB(B1, 0, 1); PG8_SCHED; PG8_LDA(At, 0, 0); PG8_STAGE(PG8_SA(1, 1), a1 + hstepA, voffA);
            PG8_WAIT_V(8); PG8_WAIT_L(0); PG8_BAR; PG8_MMA(0, 0, At, B0); if (!Sched::HAS_NH || !nh) PG8_MMA(0, 1, At, B1); PG8_BAR; PG8_SCHED;
            PG8_LDA(At, 0, 1); PG8_STAGE(PG8_SB(0, 0), b2, voffB); PG8_STAGE(PG8_SB(0, 1), b2 + hstepB, voffB); PG8_STAGE(PG8_SA(0, 0), a2, voffA);
            PG8_WAIT_V(8); PG8_WAIT_L(0); PG8_BAR; PG8_MMA(1, 0, At, B0); if (!Sched::HAS_NH || !nh) PG8_MMA(1, 1, At, B1); PG8_BAR; PG8_SCHED;
            PG8_LDB(B0, 1, 0); PG8_LDB(B1, 1, 1); PG8_SCHED; PG8_LDA(At, 1, 0); PG8_STAGE(PG8_SA(0, 1), a2 + hstepA, voffA);
            PG8_WAIT_V(8); PG8_WAIT_L(0); PG8_BAR; PG8_MMA(0, 0, At, B0); if (!Sched::HAS_NH || !nh) PG8_MMA(0, 1, At, B1); PG8_BAR; PG8_SCHED;
            PG8_LDA(At, 1, 1); PG8_STAGE(PG8_SB(1, 0), b3, voffB); PG8_STAGE(PG8_SB(1, 1), b3 + hstepB, voffB); PG8_STAGE(PG8_SA(1, 0), a3, voffA);
            PG8_WAIT_V(8); PG8_WAIT_L(0); PG8_BAR; PG8_MMA(1, 0, At, B0); if (!Sched::HAS_NH || !nh) PG8_MMA(1, 1, At, B1); PG8_BAR; PG8_SCHED;
            } else {
            PG8_LDB(B0, 0, 0); PG8_SCHED; PG8_LDA(At, 0, 0); PG8_STAGE(PG8_SA(1, 1), a1 + hstepA, voffA);
            PG8_WAIT_L(8); PG8_BAR; PG8_WAIT_L(0); PG8_MMA(0, 0, At, B0); PG8_BAR; PG8_SCHED;
            PG8_LDB(B1, 0, 1); PG8_STAGE(PG8_SB(0, 0), b2, voffB);
            PG8_BAR; PG8_WAIT_L(0); PG8_MMA(0, 1, At, B1); PG8_BAR;
            PG8_LDA(At, 0, 1); PG8_STAGE(PG8_SA(0, 0), a2, voffA);
            PG8_BAR; PG8_WAIT_L(0); PG8_MMA(1, 0, At, B0); PG8_BAR; PG8_SCHED;
            PG8_STAGE(PG8_SB(0, 1), b2 + hstepB, voffB);
            PG8_WAIT_V(6); PG8_BAR; PG8_MMA(1, 1, At, B1); PG8_BAR;
            PG8_LDB(B0, 1, 0); PG8_SCHED; PG8_LDA(At, 1, 0); PG8_STAGE(PG8_SA(0, 1), a2 + hstepA, voffA);
            PG8_WAIT_L(8); PG8_BAR; PG8_WAIT_L(0); PG8_MMA(0, 0, At, B0); PG8_BAR; PG8_SCHED;
            PG8_LDB(B1, 1, 1); PG8_STAGE(PG8_SB(1, 0), b3, voffB);
            PG8_BAR; PG8_WAIT_L(0); PG8_MMA(0, 1, At, B1); PG8_BAR;
            PG8_LDA(At, 1, 1); PG8_STAGE(PG8_SA(1, 0), a3, voffA);
            PG8_BAR; PG8_WAIT_L(0); PG8_MMA(1, 0, At, B0); PG8_BAR; PG8_SCHED;
            PG8_STAGE(PG8_SB(1, 1), b3 + hstepB, voffB);
            PG8_WAIT_V(6); PG8_BAR; PG8_MMA(1, 1, At, B1); PG8_BAR;
            }
        }
        if constexpr (ALIGN_EPI) { if (wr == 0) PG8_BAR; }
        E(acc, cur, wr, wc, fr, fq); S.done(cur);
        if (!has_next) break;
#pragma unroll
        for (int a = 0; a < 2; ++a)
#pragma unroll
            for (int b = 0; b < 2; ++b)
#pragma unroll
                for (int m = 0; m < 4; ++m)
#pragma unroll
                    for (int n = 0; n < 2; ++n) acc[a][b][m][n] = (f32x4){0.f, 0.f, 0.f, 0.f};
        cur = nxt; cA = nA; cB = nB; ++ui;
        if constexpr (ALIGN_EPI) { if (wr == 1) PG8_BAR; }
    }
    PG8_WAIT_V(0);
    if constexpr (!ALIGN_EPI) { if (wr == 0) PG8_BAR; }
    PG8_BAR;
#undef PG8_SA
#undef PG8_SB
#undef PG8_STAGE
#undef PG8_LDA
#undef PG8_LDB
#undef PG8_MMA
#undef PG8_WAIT_V
#undef PG8_WAIT_L
#undef PG8_BAR
#undef PG8_SCHED
}
}
constexpr int DM = 2048, MP = 8192, MS = 4096, MALL = 12288, MKV = 12800, FF = 8192, NMOD = 12288;
constexpr int NWAVES = 8, NTHR = 512, DEPTH = 4;
constexpr float EPS = 1e-6f;
constexpr size_t O_X = 0, O_CKV = 25165824, O_KPE = 33554432, O_HG = 34603008, O_NK = 51380224, O_NV = 68157440, O_END = 84934656;
enum { I_XP = 0, I_XS, I_CCKV, I_CKPE, I_SHG, I_CNK, I_CNV, I_C, I_CCTX, I_WMOD, I_BMOD, I_GMIX, I_GFFN, I_WQA, I_GQA, I_WQB, I_GQN, I_WKVA, I_GKVA, I_WKVB, I_GKN, I_WMO,
       I_WHQ, I_WHF, I_HLB, I_WHI, I_WHG, I_GHO, I_WHO, I_WNQKV, I_GNQ, I_GNK, I_RPB, I_WNO, I_WFF1, I_WFF2, N_IN };

constexpr size_t MiB = 1u << 20;
constexpr size_t WS_CTL = 0, CTL_ZERO_BYTES = 65536;
constexpr size_t WS_MODS = 2 * MiB;
constexpr size_t WS_LB = 3 * MiB;
constexpr size_t WS_SSK = 3 * MiB + 65536;
constexpr size_t WS_PROF = 3 * MiB + 786432;
constexpr size_t WS_ROPE = 3 * MiB + 131072;
constexpr size_t WS_WFF1 = 4 * MiB, WS_WFF2 = 132 * MiB;
constexpr size_t WS_WMLA = 260 * MiB, WMLA_STRIDE = 24 * MiB;
constexpr size_t WMLA_QB = 6 * MiB, WMLA_KVB = 11 * MiB, WMLA_WO = 15 * MiB;
constexpr size_t WS_WHG = 308 * MiB, WHG_WO = 40 * MiB;
constexpr size_t WS_WNAT = 356 * MiB, WNAT_WO = 24 * MiB;
constexpr size_t WS_H = 388 * MiB;
constexpr size_t WS_U = 436 * MiB;
constexpr size_t WS_S = 628 * MiB;
constexpr size_t S_AO = 0;
constexpr size_t S_QAKV = 48 * MiB, S_QAN = 120 * MiB, S_CKVN = 138 * MiB, S_KPE = 151 * MiB, S_QRAW = 155 * MiB, S_KVRAW = 227 * MiB, S_QN = 327 * MiB, S_KF = 399 * MiB;
constexpr size_t S_HQ = 48 * MiB, S_HK = 96 * MiB, S_HV = 192 * MiB, S_HGS = 240 * MiB, S_OF = 288 * MiB;
constexpr size_t S_NQKV = 48 * MiB, S_NQN = 198 * MiB, S_NKN = 246 * MiB;
constexpr size_t S_PART = 480 * MiB;
constexpr size_t S_X = 512 * MiB;
constexpr size_t WS_END = WS_S + 560 * MiB;
constexpr int CW_TMO = 0, CW_CODE = 1, CW_BAR = 4096;

constexpr int RING_BYTES = 131072;
constexpr int LDSCTL_OFF = 163840 - 512, MISC_OFF = LDSCTL_OFF + 320;
constexpr int EPI_TAB_OFF = LDSCTL_OFF - 8192;
constexpr int LDS_BYTES = 163840;

#define GAS __attribute__((address_space(1)))
#define LAS __attribute__((address_space(3)))
typedef unsigned short bf16;
typedef unsigned v4u __attribute__((ext_vector_type(4)));
typedef unsigned v2u __attribute__((ext_vector_type(2)));
typedef float f32x4 __attribute__((ext_vector_type(4)));
typedef float f32x2 __attribute__((ext_vector_type(2)));
typedef short bf16x8 __attribute__((ext_vector_type(8)));
typedef GAS unsigned gu32;
#define RLX_AGENT __ATOMIC_RELAXED, __HIP_MEMORY_SCOPE_AGENT
#define LDS_WAIT() asm volatile("s_waitcnt lgkmcnt(0)" ::: "memory")
#define VM_WAIT() asm volatile("s_waitcnt vmcnt(0)" ::: "memory")
#ifndef DBG_SCALE
#define DBG_SCALE 1.0f
#endif
#define OPAQUE_S(x) asm volatile("" : "+s"(x))
#define PH_PTRS unsigned char* ws = a.ws; float* out = a.out; OPAQUE_S(ws); OPAQUE_S(out)
#define OPAQUE_V(x) asm volatile("" : "+v"(x))
__device__ __forceinline__ unsigned pk2(float lo, float hi) { unsigned r; asm("v_cvt_pk_bf16_f32 %0, %1, %2" : "=v"(r) : "v"(lo), "v"(hi)); return r; }
__device__ __forceinline__ float bf_lo(unsigned w) { return __uint_as_float(w << 16); }
__device__ __forceinline__ float bf_hi(unsigned w) { return __uint_as_float(w & 0xffff0000u); }
__device__ __forceinline__ float wave_sum(float v) {
#pragma unroll
    for (int o = 1; o < 64; o <<= 1) v += __shfl_xor(v, o);
    return v;
}
__device__ __forceinline__ float sum16(float v) {
#pragma unroll
    for (int o = 1; o < 16; o <<= 1) v += __shfl_xor(v, o);
    return v;
}

#define XB_TMO      128
#define XB_XCNT(j)  (256  + 64 * (j))
#define XB_XSUB(j)  (1280 + 64 * (j))
#define XB_XGEN(j)  (2304 + 64 * (j))
#define XB_TOP      3328
#define XB_TOPGEN   3392
#define XCD_BAR_WORDS 3456
#define XB_SPIN_CAP (1u << 18)
__device__ __forceinline__ unsigned xb_ld(unsigned* p)              { return __hip_atomic_load(p, __ATOMIC_RELAXED, __HIP_MEMORY_SCOPE_AGENT); }
__device__ __forceinline__ unsigned xb_add(unsigned* p, unsigned v) { return __hip_atomic_fetch_add(p, v, __ATOMIC_RELAXED, __HIP_MEMORY_SCOPE_AGENT); }
__device__ __forceinline__ unsigned xb_xcc_id() { return (unsigned)__builtin_amdgcn_s_getreg((3 << 11) | 20) & 0xFu; }
#define XB_SPIN(cond, bar) do { unsigned _sp = 0; while (cond) { __builtin_amdgcn_s_sleep(1); \
    if ((++_sp & 255u) == 0u) { if (xb_ld(&(bar)[XB_TMO])) break; if (_sp > XB_SPIN_CAP) { atomicAdd(&(bar)[XB_TMO], 1u); break; } } } } while (0)
struct XcdBarrier { unsigned* bar; unsigned x; volatile LAS unsigned* st; };
__device__ __forceinline__ XcdBarrier xcd_barrier_post(unsigned* bar, volatile LAS unsigned* st) {
    XcdBarrier b; b.bar = bar; b.x = xb_xcc_id(); b.st = st;
    if (threadIdx.x == 0) (void)xb_add(&bar[XB_XCNT(b.x)], 1u);
    return b;
}
__device__ __forceinline__ void xcd_barrier_complete(unsigned* bar, unsigned x, unsigned& nloc, unsigned& nx) {
    const unsigned G = gridDim.x * gridDim.y * gridDim.z;
    unsigned sum, cnt, mine, sp = 0u;
    for (;;) {
        sum = 0u; cnt = 0u; mine = 0u;
#pragma unroll
        for (unsigned j = 0; j < 16; ++j) { const unsigned c = xb_ld(&bar[XB_XCNT(j)]); sum += c; cnt += (c > 0u) ? 1u : 0u; mine = (j == x) ? c : mine; }
        if (sum == G) break;
        __builtin_amdgcn_s_sleep(1);
        if ((++sp & 255u) == 0u) { if (xb_ld(&bar[XB_TMO])) break; if (sp > XB_SPIN_CAP) { atomicAdd(&bar[XB_TMO], 1u); break; } }
    }
    nloc = mine > 0u ? mine : 1u; nx = cnt > 0u ? cnt : 1u;
}
__device__ __forceinline__ void xcd_barrier(const XcdBarrier& b) {
    asm volatile("s_waitcnt vmcnt(0)" ::: "memory");
    __syncthreads();
    if (threadIdx.x == 0) {
        unsigned* bar = b.bar;
        __builtin_amdgcn_s_waitcnt(0);
        unsigned nloc = b.st[0], nx = b.st[1];
        if (nloc == 0u) { xcd_barrier_complete(bar, b.x, nloc, nx); b.st[0] = nloc; b.st[1] = nx; }
        const unsigned old = xb_add(&bar[XB_XSUB(b.x)], 1u);
        const unsigned gen = old / nloc;
        if (old + 1u == (gen + 1u) * nloc) {
            __builtin_amdgcn_fence(__ATOMIC_RELEASE, "agent");
            asm volatile("s_waitcnt vmcnt(0)" ::: "memory");
            const unsigned og = xb_add(&bar[XB_TOP], 1u);
            const unsigned tg = og / nx;
            if (og + 1u == (tg + 1u) * nx) xb_add(&bar[XB_TOPGEN], 1u);
            else XB_SPIN(xb_ld(&bar[XB_TOPGEN]) == tg, bar);
            __builtin_amdgcn_fence(__ATOMIC_ACQUIRE, "agent");
            xb_add(&bar[XB_XGEN(b.x)], 1u);
            asm volatile("s_waitcnt vmcnt(0)" ::: "memory");
        } else {
            XB_SPIN(xb_ld(&bar[XB_XGEN(b.x)]) == gen, bar);
            __builtin_amdgcn_fence(__ATOMIC_ACQUIRE, "agent");
            asm volatile("s_waitcnt vmcnt(0)" ::: "memory");
        }
    }
    __syncthreads();
}

struct TJob { const float* src; bf16* dst; int K, N, row_off, start; };
constexpr int MAX_TJ = 32;
struct Args { const float* in[N_IN]; float* out; unsigned char* ws; TJob tj[MAX_TJ]; int ntj, nitems, ph_lo, ph_hi;
              int wstart[8], wmid[8]; };

__device__ __forceinline__ void p0_transpose_item(const float* W, int K, int N, bf16* WT, int row_off, LAS float* scr, int item, int lane) {
    const int nblk = N / 32, kb = item / nblk, nb = item % nblk, k0 = 64 * kb, n0 = 32 * nb;
    { const int kr = lane >> 3, ns = (lane & 7) * 4;
      f32x4 t[8];
#pragma unroll
      for (int i = 0; i < 8; ++i) t[i] = __builtin_nontemporal_load((const GAS f32x4*)(W + (size_t)(k0 + kr + 8 * i) * N + n0 + ns));
#pragma unroll
      for (int i = 0; i < 8; ++i) { LAS float* d = scr + (kr + 8 * i) * 33 + ns; d[0] = t[i].x; d[1] = t[i].y; d[2] = t[i].z; d[3] = t[i].w; } }
    LDS_WAIT(); asm volatile("" ::: "memory");
    const int c = lane & 7;
#pragma unroll
    for (int j = 0; j < 4; ++j) { const int n = (lane >> 3) + 8 * j; const LAS float* s = scr + (8 * c) * 33 + n;
        v4u o; o.x = pk2(s[0 * 33], s[1 * 33]); o.y = pk2(s[2 * 33], s[3 * 33]); o.z = pk2(s[4 * 33], s[5 * 33]); o.w = pk2(s[6 * 33], s[7 * 33]);
        __builtin_nontemporal_store(o, (GAS v4u*)(WT + (size_t)(row_off + n0 + n) * K + k0 + 8 * c)); }
    LDS_WAIT(); asm volatile("" ::: "memory");
}

__device__ __forceinline__ void p0_convert_range(const Args& a, LAS unsigned char* lds, int lo, int hi, int idx, int stride, int lane, int wave) {
    OPAQUE_V(lane);
    LAS float* scr = (LAS float*)(lds + wave * 16384);
    for (int it = lo + idx; it < hi; it += stride) {
        int j = 0;
        while (j + 1 < a.ntj && it >= a.tj[j + 1].start) ++j;
        p0_transpose_item(a.tj[j].src, a.tj[j].K, a.tj[j].N, a.tj[j].dst, a.tj[j].row_off, scr, it - a.tj[j].start, lane);
    }
}

__device__ __forceinline__ float silu_f(float x) { return x / (1.f + __expf(-x)); }

__device__ __forceinline__ void p0_prologue(const Args& a, LAS unsigned char* lds, int tid, int lane, int wave, int vcu, int G) {
    OPAQUE_V(tid); OPAQUE_V(lane);
    float* mods = (float*)(a.ws + WS_MODS);
#ifndef DBG_REP_MASK
#define DBG_REP_MASK 0
#endif
    for (int rep_ = 0; rep_ < (((DBG_REP_MASK >> 14) & 1) ? 3 : 1); ++rep_)
    if (vcu < 768) {
        LAS f32x4* S3 = (LAS f32x4*)lds;
        LAS float* RED = (LAS float*)(lds + 32768);
        const float* cc = a.in[I_C]; const float* cx = a.in[I_CCTX];
        for (int k = tid; k < DM; k += NTHR) S3[k] = (f32x4){silu_f(cx[k]), silu_f(cc[k]), silu_f(cc[DM + k]), 0.f};
        __syncthreads();
        for (int tl = vcu; tl < 768; tl += G) {
            const int l = tl / 192, n = (tl % 192) * 64 + lane;
            const float* Wp = a.in[I_WMOD] + ((size_t)l * DM + wave * 256) * NMOD + n;
            float a0 = 0.f, a1 = 0.f, a2 = 0.f;
#pragma unroll 16
            for (int k = 0; k < 256; ++k) { const float wv = __builtin_nontemporal_load((const GAS float*)(Wp + (size_t)k * NMOD)); const f32x4 s = S3[wave * 256 + k]; a0 += s.x * wv; a1 += s.y * wv; a2 += s.z * wv; }
            RED[(wave * 3 + 0) * 64 + lane] = a0; RED[(wave * 3 + 1) * 64 + lane] = a1; RED[(wave * 3 + 2) * 64 + lane] = a2;
            __syncthreads();
            if (wave < 3) { float s = 0.f;
#pragma unroll
                for (int w = 0; w < 8; ++w) s += RED[(w * 3 + wave) * 64 + lane];
                mods[((size_t)l * 3 + wave) * NMOD + n] = s + a.in[I_BMOD][(size_t)l * NMOD + n]; }
            __syncthreads();
        }
    }
    { const int gt = vcu * NTHR + tid;
      if (gt < 2 * DM) { const int d = gt >> 11, c = gt & 2047; const float* hl = a.in[I_HLB] + (size_t)d * 4 * DM + c;
          const float x0 = hl[0], x1 = hl[DM], x2 = hl[2 * DM], x3 = hl[3 * DM]; const float m = fmaxf(fmaxf(x0, x1), fmaxf(x2, x3));
          const float e0 = __expf(x0 - m), e1 = __expf(x1 - m), e2 = __expf(x2 - m), e3 = __expf(x3 - m);
          ((float*)(a.ws + WS_LB))[gt] = e1 / (e0 + e1 + e2 + e3); } }
    __syncthreads();
    LAS float* scr = (LAS float*)(lds + wave * 16384);
    const int gw = vcu * NWAVES + wave, NGW = G * NWAVES;
    for (int rep_ = 0; rep_ < (((DBG_REP_MASK >> 15) & 1) ? 3 : 1); ++rep_)
    for (int it = gw; it < a.wstart[1]; it += NGW) {
        int j = 0;
        while (j + 1 < a.ntj && it >= a.tj[j + 1].start) ++j;
        p0_transpose_item(a.tj[j].src, a.tj[j].K, a.tj[j].N, a.tj[j].dst, a.tj[j].row_off, scr, it - a.tj[j].start, lane);
    }
#if defined(DBG_ZERO_OUT)
    { const size_t gt = (size_t)vcu * NTHR + tid, NT = (size_t)G * NTHR;
      for (size_t i = gt; i < (O_END - O_CKV) / 4; i += NT) *(GAS f32x4*)(a.out + O_CKV + 4 * i) = (f32x4){0.f, 0.f, 0.f, 0.f}; }
#endif
    { const int gt = vcu * NTHR + tid, NT = G * NTHR;
      for (int i = gt; i < 2 * 192 * DM / 8; i += NT) { const int j = i / (192 * DM / 8), r = i % (192 * DM / 8);
          *(GAS v4u*)(a.ws + WS_WMLA + j * WMLA_STRIDE + (size_t)1344 * DM * 2 + (size_t)r * 16) = (v4u){0u, 0u, 0u, 0u}; } }
}

__device__ __forceinline__ int cond_of_row(int row) { return row < MP ? 0 : 1 + ((row - MP) >> 11); }

__device__ __forceinline__ void norm_phase(const Args& a, int l, bool ffn, const float* fixgate, int lane, int gw, int NGW) {
    OPAQUE_V(lane); PH_PTRS; OPAQUE_S(gw); OPAQUE_S(NGW);
    const float* g = a.in[ffn ? I_GFFN : I_GMIX] + (size_t)l * DM;
    const float* mods = (const float*)(ws + WS_MODS) + (size_t)l * 3 * NMOD + (ffn ? 3 * DM : 0);
    bf16* H = (bf16*)(ws + WS_H); bf16* X = (bf16*)(ws + WS_S + S_X);
    const bool first = (l == 0 && !ffn);
    for (int row = gw; row < MALL; row += NGW) {
        const float* md = mods + (size_t)cond_of_row(row) * NMOD;
        f32x4 v[8]; float ss = 0.f;
        const bool fix = fixgate != nullptr && row >= MP;
        const bf16* P0 = (const bf16*)(ws + WS_S + S_PART) + (size_t)(row - MP) * DM; const float* fg = fixgate + (size_t)cond_of_row(row) * NMOD;
        if (first) { const float* xr = row < MP ? a.in[I_XP] + (size_t)row * DM : a.in[I_XS] + (size_t)(row - MP) * DM;
#pragma unroll
            for (int j = 0; j < 8; ++j) v[j] = __builtin_nontemporal_load((const GAS f32x4*)(xr + 4 * (lane + 64 * j)));
        } else { const bf16* xr = X + (size_t)row * DM;
#pragma unroll
            for (int j = 0; j < 8; ++j) { const v2u w = *(const GAS v2u*)(xr + 4 * (lane + 64 * j)); v[j] = (f32x4){bf_lo(w.x), bf_hi(w.x), bf_lo(w.y), bf_hi(w.y)}; } }
#pragma unroll
        for (int j = 0; j < 8; ++j) {
            if (fix) { const int c = 4 * (lane + 64 * j); const v2u pw = __builtin_nontemporal_load((const GAS v2u*)(P0 + c)); v[j] = v[j] + *(const GAS f32x4*)(fg + c) * (f32x4){bf_lo(pw.x), bf_hi(pw.x), bf_lo(pw.y), bf_hi(pw.y)}; }
            ss += (v[j].x * v[j].x + v[j].y * v[j].y) + (v[j].z * v[j].z + v[j].w * v[j].w); }
        const float rs = rsqrtf(wave_sum(ss) * (1.f / DM) + EPS);
#pragma unroll
        for (int j = 0; j < 8; ++j) { const int c = 4 * (lane + 64 * j);
            const f32x4 gg = *(const GAS f32x4*)(g + c), sh = *(const GAS f32x4*)(md + c), sc = *(const GAS f32x4*)(md + DM + c);
            const f32x4 y = v[j] * rs * gg * (sc + 1.f) + sh;
            *(GAS v2u*)(H + (size_t)row * DM + c) = (v2u){pk2(y.x, y.y), pk2(y.z, y.w)};
            if (first || fix) *(GAS v2u*)(X + (size_t)row * DM + c) = (v2u){pk2(v[j].x, v[j].y), pk2(v[j].z, v[j].w)}; }
    }
}
__device__ __forceinline__ void final_fix_phase(const Args& a, const float* fixgate, int lane, int gw, int NGW) {
    OPAQUE_V(lane); PH_PTRS; OPAQUE_S(gw); OPAQUE_S(NGW);
    for (int row = MP + gw; row < MALL; row += NGW) {
        const bf16* P0 = (const bf16*)(ws + WS_S + S_PART) + (size_t)(row - MP) * DM; const float* fg = fixgate + (size_t)cond_of_row(row) * NMOD; float* xr = out + O_X + (size_t)row * DM;
#pragma unroll
        for (int j = 0; j < 8; ++j) { const int c = 4 * (lane + 64 * j); const v2u pw = *(const GAS v2u*)(P0 + c);
            *(GAS f32x4*)(xr + c) = *(const GAS f32x4*)(xr + c) + *(const GAS f32x4*)(fg + c) * (f32x4){bf_lo(pw.x), bf_hi(pw.x), bf_lo(pw.y), bf_hi(pw.y)}; }
    }
}
__device__ __forceinline__ void mla_thin_a(const Args& a, int j, int lane, int gw, int NGW) {
    OPAQUE_V(lane); PH_PTRS; OPAQUE_S(gw); OPAQUE_S(NGW);
    const bf16* QAKV = (const bf16*)(ws + WS_S + S_QAKV);
    bf16* QAN = (bf16*)(ws + WS_S + S_QAN); bf16* CKVN = (bf16*)(ws + WS_S + S_CKVN); float* KPE = (float*)(ws + WS_S + S_KPE); float* SSK = (float*)(ws + WS_SSK);
    const float* gqa = a.in[I_GQA] + (size_t)j * 768; const float* gkva = a.in[I_GKVA] + (size_t)j * 512;
    for (int row = gw; row < MKV; row += NGW) {
        if (row < MALL) {
            const bf16* r = QAKV + (size_t)row * 1536;
#define LD4(p_) ({ const v2u w_ = *(const GAS v2u*)(p_); (f32x4){bf_lo(w_.x), bf_hi(w_.x), bf_lo(w_.y), bf_hi(w_.y)}; })
            { f32x4 v[3]; float ss = 0.f;
#pragma unroll
              for (int i = 0; i < 3; ++i) { v[i] = LD4(r + 4 * (lane + 64 * i)); ss += (v[i].x * v[i].x + v[i].y * v[i].y) + (v[i].z * v[i].z + v[i].w * v[i].w); }
              const float rs = rsqrtf(wave_sum(ss) * (1.f / 768.f) + EPS);
#pragma unroll
              for (int i = 0; i < 3; ++i) { const int c = 4 * (lane + 64 * i); const f32x4 y = v[i] * rs * *(const GAS f32x4*)(gqa + c);
                  *(GAS v2u*)(QAN + (size_t)row * 768 + c) = (v2u){pk2(y.x, y.y), pk2(y.z, y.w)}; } }
            { f32x4 v[2]; float ss = 0.f;
#pragma unroll
              for (int i = 0; i < 2; ++i) { v[i] = LD4(r + 768 + 4 * (lane + 64 * i)); ss += (v[i].x * v[i].x + v[i].y * v[i].y) + (v[i].z * v[i].z + v[i].w * v[i].w); }
              const float rs = rsqrtf(wave_sum(ss) * (1.f / 512.f) + EPS);
#pragma unroll
              for (int i = 0; i < 2; ++i) { const int c = 4 * (lane + 64 * i); const f32x4 y = v[i] * rs * *(const GAS f32x4*)(gkva + c);
                  *(GAS v2u*)(CKVN + (size_t)row * 512 + c) = (v2u){pk2(y.x, y.y), pk2(y.z, y.w)};
                  if (row < MP) __builtin_nontemporal_store(y * DBG_SCALE, (GAS f32x4*)(out + O_CKV + ((size_t)((row >> 8) * 2 + j) * 256 + (row & 255)) * 512 + c)); } }
            { const float kp = __uint_as_float((unsigned)r[1280 + lane] << 16); KPE[(size_t)row * 64 + lane] = kp;
              if (row < MP) out[O_KPE + ((size_t)((row >> 8) * 2 + j) * 256 + (row & 255)) * 64 + lane] = kp * DBG_SCALE;
              const float s = wave_sum(kp * kp); if (lane == 0) SSK[row] = s; }
#undef LD4
        } else {
            const int cr = row - MALL, b = cr >> 8, t = cr & 255; const size_t src = (size_t)((b * 2 + j) * 256 + t);
            const float* ck = a.in[I_CCKV] + src * 512;
#pragma unroll
            for (int i = 0; i < 2; ++i) { const int c = 4 * (lane + 64 * i); const f32x4 y = *(const GAS f32x4*)(ck + c);
                *(GAS v2u*)(CKVN + (size_t)row * 512 + c) = (v2u){pk2(y.x, y.y), pk2(y.z, y.w)}; }
            const float kp = a.in[I_CKPE][src * 64 + lane]; KPE[(size_t)row * 64 + lane] = kp;
            const float s = wave_sum(kp * kp); if (lane == 0) SSK[row] = s;
        }
    }
}
namespace pg8 {
struct EpiF32 {
    static constexpr bool PERM = false;
    float* C; int ldc;
    __device__ __forceinline__ void operator()(const f32x4 (&acc)[2][2][4][2], const Unit& u, int wr, int wc, int fr, int fq) const {
        const int row0 = u.pm * BM + wr * 64 + fr, col0 = u.pn * BM + wc * 32 + 4 * fq;
#pragma unroll
        for (int ai = 0; ai < 2; ++ai)
#pragma unroll
            for (int m = 0; m < 4; ++m) { float* rowp = C + (size_t)(row0 + ai * HALF + m * 16) * ldc + col0;
#pragma unroll
                for (int bj = 0; bj < 2; ++bj)
#pragma unroll
                    for (int n = 0; n < 2; ++n) *(PG8_GAS f32x4*)(rowp + bj * HALF + n * 16) = acc[ai][bj][m][n]; }
    }
};
template <int ACT  > struct EpiBf16 {
    static constexpr bool PERM = true;
    bf16_t* O; int ldc;
    __device__ __forceinline__ void operator()(const f32x4 (&acc)[2][2][4][2], const Unit& u, int wr, int wc, int fr, int fq) const {
        const int row0 = u.pm * BM + wr * 64 + fr, col0 = u.pn * BM + wc * 32 + 8 * fq;
#pragma unroll
        for (int ai = 0; ai < 2; ++ai)
#pragma unroll
            for (int m = 0; m < 4; ++m) { bf16_t* rowp = O + (size_t)(row0 + ai * HALF + m * 16) * ldc + col0;
#pragma unroll
                for (int bj = 0; bj < 2; ++bj) { f32x4 v0 = acc[ai][bj][m][0], v1 = acc[ai][bj][m][1];
                    if (ACT == 1) {
#pragma unroll
                        for (int e = 0; e < 4; ++e) { const float x0 = fmaxf(v0[e], 0.f), x1 = fmaxf(v1[e], 0.f); v0[e] = x0 * x0; v1[e] = x1 * x1; } }
                    u32x4 w; w.x = cvt_pk_bf16(v0[0], v0[1]); w.y = cvt_pk_bf16(v0[2], v0[3]); w.z = cvt_pk_bf16(v1[0], v1[1]); w.w = cvt_pk_bf16(v1[2], v1[3]);
                    *(PG8_GAS u32x4*)(rowp + bj * HALF) = w; } }
    }
};
template <bool ATOMIC> struct EpiRes {
    static constexpr bool PERM = false;
    float* X; const float* gate;
    __device__ __forceinline__ void operator()(const f32x4 (&acc)[2][2][4][2], const Unit& u, int wr, int wc, int fr, int fq) const {
        const int rb = u.pm * BM, row0 = rb + wr * 64 + fr, col0 = u.pn * BM + wc * 32 + 4 * fq;
        const int cond = rb < 8192 ? 0 : 1 + ((rb - 8192) >> 11);
        const float* gp = gate + (size_t)cond * 12288 + col0;
        f32x4 gv[2][2];
#pragma unroll
        for (int bj = 0; bj < 2; ++bj)
#pragma unroll
            for (int n = 0; n < 2; ++n) gv[bj][n] = *(const PG8_GAS f32x4*)(gp + bj * HALF + n * 16);
#pragma unroll
        for (int ai = 0; ai < 2; ++ai)
#pragma unroll
            for (int m = 0; m < 4; ++m) { float* rowp = X + (size_t)(row0 + ai * HALF + m * 16) * 2048 + col0;
#pragma unroll
                for (int bj = 0; bj < 2; ++bj)
#pragma unroll
                    for (int n = 0; n < 2; ++n) { float* p = rowp + bj * HALF + n * 16; const f32x4 d = gv[bj][n] * acc[ai][bj][m][n];
                        if (ATOMIC) {
#pragma unroll
                            for (int e = 0; e < 4; ++e) __hip_atomic_fetch_add((PG8_GAS float*)(p + e), d[e], __ATOMIC_RELAXED, __HIP_MEMORY_SCOPE_AGENT);
                        } else { *(PG8_GAS f32x4*)p = *(const PG8_GAS f32x4*)p + d; } }
                asm volatile("" ::: "memory"); }
    }
};
struct EpiRes2 {
    static constexpr bool PERM = false;
    bf16_t* X; const float* gate; bf16_t* P; float* Yout;
    __device__ __forceinline__ void operator()(const f32x4 (&acc)[2][2][4][2], const Unit& u, int wr, int wc, int fr, int fq) const {
        typedef unsigned u32x2_ __attribute__((ext_vector_type(2)));
        const int rb = u.pm * BM, row0 = rb + wr * 64 + fr, col0 = u.pn * BM + wc * 32 + 4 * fq;
        if (u.part <= 0) {
            const int cond = rb < 8192 ? 0 : 1 + ((rb - 8192) >> 11);
            const float* gp = gate + (size_t)cond * 12288 + col0;
            f32x4 gv[2][2];
#pragma unroll
            for (int bj = 0; bj < 2; ++bj)
#pragma unroll
                for (int n = 0; n < 2; ++n) gv[bj][n] = *(const PG8_GAS f32x4*)(gp + bj * HALF + n * 16);
#pragma unroll
            for (int ai = 0; ai < 2; ++ai)
#pragma unroll
                for (int m = 0; m < 4; ++m) { const size_t ro = (size_t)(row0 + ai * HALF + m * 16) * 2048 + col0;
#pragma unroll
                    for (int bj = 0; bj < 2; ++bj)
#pragma unroll
                        for (int n = 0; n < 2; ++n) { const size_t o = ro + bj * HALF + n * 16; const u32x2_ w = *(const PG8_GAS u32x2_*)(X + o);
                            const f32x4 xn = (f32x4){__uint_as_float(w.x << 16), __uint_as_float(w.x & 0xffff0000u), __uint_as_float(w.y << 16), __uint_as_float(w.y & 0xffff0000u)} + gv[bj][n] * acc[ai][bj][m][n];
                            if (Yout != nullptr) *(PG8_GAS f32x4*)(Yout + o) = xn; else *(PG8_GAS u32x2_*)(X + o) = (u32x2_){cvt_pk_bf16(xn[0], xn[1]), cvt_pk_bf16(xn[2], xn[3])}; }
                    asm volatile("" ::: "memory"); }
        } else {
            bf16_t* Pp = P + (size_t)(row0 - 8192) * 2048 + col0;
#pragma unroll
            for (int ai = 0; ai < 2; ++ai)
#pragma unroll
                for (int m = 0; m < 4; ++m) { bf16_t* rowp = Pp + (size_t)(ai * HALF + m * 16) * 2048;
#pragma unroll
                    for (int bj = 0; bj < 2; ++bj)
#pragma unroll
                        for (int n = 0; n < 2; ++n) { const f32x4 v = acc[ai][bj][m][n]; *(PG8_GAS u32x2_*)(rowp + bj * HALF + n * 16) = (u32x2_){cvt_pk_bf16(v[0], v[1]), cvt_pk_bf16(v[2], v[3])}; } }
        }
    }
};
}
#ifndef DBG_REP_MASK
#define DBG_REP_MASK 0
#endif
namespace att {
using bf16x8 = __attribute__((ext_vector_type(8))) short;
using s16x4  = __attribute__((ext_vector_type(4))) short;
using f32x16 = __attribute__((ext_vector_type(16))) float;
using u32x4  = __attribute__((ext_vector_type(4))) unsigned;
constexpr int NW = 8, QBLK = 32, KVBLK = 64, DV = 128;
constexpr float THR = 8.f;
constexpr int SHM_V = KVBLK * DV * 2;
constexpr int RPB_OFF = 2 * SHM_V + 2 * KVBLK * 512 + 2048;
#define ATT_SBAR() __builtin_amdgcn_sched_barrier(0)
__device__ __forceinline__ int crow(int r, int hi) { return (r & 3) + 8 * (r >> 2) + 4 * hi; }
__device__ __forceinline__ unsigned cvtpk(float lo, float hi) { unsigned r; asm volatile("v_cvt_pk_bf16_f32 %0, %1, %2" : "=v"(r) : "v"(lo), "v"(hi)); return r; }
__device__ __forceinline__ int v_st(int k, int c) { const int kk = (k & ~0xC) | ((k & 4) << 1) | ((k & 8) >> 1); return ((kk >> 3) * 4 + (c >> 5)) * 512 + ((kk & 7) * 32 + (c & 31)) * 2; }
__device__ __forceinline__ int v_rd_base(int lane) { return ((lane & 3) << 3) | (((lane >> 2) & 3) << 6) | (((lane >> 4) & 1) << 5) | (((lane >> 5) & 1) << 8); }
constexpr int v_rd_off(int d0, int ks, int half) { return d0 * 512 + ks * 4096 + half * 2048; }
template <int OFF> __device__ __forceinline__ s16x4 tr_read(int vb) { s16x4 r; asm volatile("ds_read_b64_tr_b16 %0, %1 offset:%2" : "=&v"(r) : "v"(vb), "i"(OFF) : "memory"); return r; }
template <int D0> __device__ __forceinline__ void pv_one(f32x16& od, int vb, bf16x8 pa0, bf16x8 pa1, bf16x8 pa2, bf16x8 pa3) {
  const s16x4 l0 = tr_read<v_rd_off(D0, 0, 0)>(vb), h0 = tr_read<v_rd_off(D0, 0, 1)>(vb), l1 = tr_read<v_rd_off(D0, 1, 0)>(vb), h1 = tr_read<v_rd_off(D0, 1, 1)>(vb);
  const s16x4 l2 = tr_read<v_rd_off(D0, 2, 0)>(vb), h2 = tr_read<v_rd_off(D0, 2, 1)>(vb), l3 = tr_read<v_rd_off(D0, 3, 0)>(vb), h3 = tr_read<v_rd_off(D0, 3, 1)>(vb);
  asm volatile("s_waitcnt lgkmcnt(0)" ::: "memory"); ATT_SBAR();
#define ATT_PK(L, H) (bf16x8){L[0], L[1], L[2], L[3], H[0], H[1], H[2], H[3]}
  od = __builtin_amdgcn_mfma_f32_32x32x16_bf16(pa0, ATT_PK(l0, h0), od, 0, 0, 0);
  od = __builtin_amdgcn_mfma_f32_32x32x16_bf16(pa1, ATT_PK(l1, h1), od, 0, 0, 0);
  od = __builtin_amdgcn_mfma_f32_32x32x16_bf16(pa2, ATT_PK(l2, h2), od, 0, 0, 0);
  od = __builtin_amdgcn_mfma_f32_32x32x16_bf16(pa3, ATT_PK(l3, h3), od, 0, 0, 0);
#undef ATT_PK
}
__device__ __forceinline__ void pv_d0(f32x16* o, int vb, bf16x8 pa0, bf16x8 pa1, bf16x8 pa2, bf16x8 pa3) {
  pv_one<0>(o[0], vb, pa0, pa1, pa2, pa3); pv_one<1>(o[1], vb, pa0, pa1, pa2, pa3); pv_one<2>(o[2], vb, pa0, pa1, pa2, pa3); pv_one<3>(o[3], vb, pa0, pa1, pa2, pa3);
}
struct KvSrc { int row0, n0, row1, n1; __device__ __forceinline__ int row(int t) const { const int u = t - n0; return t < n0 ? row0 + 64 * t : row1 + 64 * (u < n1 ? u : n1 - 1); } };
struct NatMask { int rlo, qrow, qcol; const LAS float* rpb; };

template <int DQK, int MODE, int ldq, int ldk, int ldv, int ldo, int QP = 0>
__device__ __forceinline__ void attn_unit(const bf16* __restrict__ Qb, const bf16* __restrict__ Kh, const bf16* __restrict__ Vh,
                                          bf16* __restrict__ Ob, const KvSrc src, int NT, const NatMask nm, LAS char* lds, int tid,
                                          const float* __restrict__ qgain = nullptr, const float* __restrict__ qrope = nullptr) {
  constexpr float SCALE = DQK == 128 ? 0.088388347648318440f : 0.072168783648703220f;
  constexpr float C = SCALE * 1.4426950408889634f;
  constexpr int KROW = DQK == 128 ? 256 : 512  , SHM_K = KVBLK * KROW, NKC = DQK / 8, KCH = KVBLK * NKC / 512, ND0 = DQK / 16;
  const int wid = tid >> 6, lane = tid & 63, r32 = lane & 31, hi = lane >> 5;
  LAS char* V_lds = lds; LAS char* K_lds = lds + 2 * SHM_V;
  LAS float* ws = (LAS float*)(lds + 2 * SHM_V + 2 * SHM_K) + wid * 64; LAS float* li_l = ws; LAS float* al_l = ws + 32;
  float m_reg = -1e30f, l_reg = 0; f32x16 o[4] = {}; bf16x8 qr[ND0];
  { const bf16* Qw = Qb + (size_t)(wid * QBLK + r32) * ldq + hi * 8;
#pragma unroll
    for (int d0 = 0; d0 < ND0; ++d0) qr[d0] = *(const GAS bf16x8*)(Qw + d0 * 16); }
  if constexpr (QP == 1) {
    float ss = 0.f;
#pragma unroll
    for (int d0 = 0; d0 < ND0; ++d0) { const u32x4 w = __builtin_bit_cast(u32x4, qr[d0]);
#pragma unroll
      for (int e = 0; e < 4; ++e) { const float a = __uint_as_float(w[e] << 16), b = __uint_as_float(w[e] & 0xffff0000u); ss += a * a + b * b; } }
    ss += __shfl_xor(ss, 32);
    const float rs = rsqrtf(ss * (1.f / DQK) + 1e-6f);
    float xv[ND0 < 12 ? 1 : 4][8];
#pragma unroll
    for (int d0 = 0; d0 < ND0; ++d0) { const u32x4 w = __builtin_bit_cast(u32x4, qr[d0]);
      const f32x4 g0 = *(const GAS f32x4*)(qgain + d0 * 16 + hi * 8), g1 = *(const GAS f32x4*)(qgain + d0 * 16 + hi * 8 + 4);
      float x[8];
#pragma unroll
      for (int e = 0; e < 4; ++e) { x[2 * e] = __uint_as_float(w[e] << 16) * rs; x[2 * e + 1] = __uint_as_float(w[e] & 0xffff0000u) * rs; }
      x[0] *= g0.x; x[1] *= g0.y; x[2] *= g0.z; x[3] *= g0.w; x[4] *= g1.x; x[5] *= g1.y; x[6] *= g1.z; x[7] *= g1.w;
      if (ND0 == 12 && d0 >= 8) {
#pragma unroll
        for (int e = 0; e < 8; ++e) xv[ND0 < 12 ? 0 : d0 - 8][e] = x[e];
      } else { const u32x4 o_ = {cvtpk(x[0], x[1]), cvtpk(x[2], x[3]), cvtpk(x[4], x[5]), cvtpk(x[6], x[7])}; qr[d0] = __builtin_bit_cast(bf16x8, o_); } }
    if constexpr (ND0 == 12) {
#pragma unroll
      for (int pp = 0; pp < 2; ++pp) {
        float y1[8], y2[8];
#pragma unroll
        for (int e = 0; e < 8; ++e) { y1[e] = xv[pp][e]; y2[e] = xv[2 + pp][e]; }
        if (qrope != nullptr) { const float* rt = qrope + ((size_t)(wid * QBLK + r32) * 32 + 16 * pp + 8 * hi) * 2;
#pragma unroll
          for (int e2 = 0; e2 < 4; ++e2) { const f32x4 cs = *(const GAS f32x4*)(rt + 4 * e2);
            const float a0 = y1[2 * e2] * cs.x - y2[2 * e2] * cs.y, b0 = y1[2 * e2] * cs.y + y2[2 * e2] * cs.x;
            const float a1 = y1[2 * e2 + 1] * cs.z - y2[2 * e2 + 1] * cs.w, b1 = y1[2 * e2 + 1] * cs.w + y2[2 * e2 + 1] * cs.z;
            y1[2 * e2] = a0; y2[2 * e2] = b0; y1[2 * e2 + 1] = a1; y2[2 * e2 + 1] = b1; } }
        const u32x4 o1 = {cvtpk(y1[0], y1[1]), cvtpk(y1[2], y1[3]), cvtpk(y1[4], y1[5]), cvtpk(y1[6], y1[7])}, o2 = {cvtpk(y2[0], y2[1]), cvtpk(y2[2], y2[3]), cvtpk(y2[4], y2[5]), cvtpk(y2[6], y2[7])};
        qr[8 + pp] = __builtin_bit_cast(bf16x8, o1); qr[10 + pp] = __builtin_bit_cast(bf16x8, o2); }
    }
  }
  const int sr = tid >> 4, sc = (tid & 15) * 8, vst0 = v_st(sr, sc), vst1 = v_st(32 + sr, sc);
  unsigned koff_[KCH], kst_[KCH]; const unsigned voff0 = (unsigned)(sr * ldv + sc);
#pragma unroll
  for (int i = 0; i < KCH; ++i) { const int c = tid + 512 * i, kr = c / NKC, kc = c % NKC; koff_[i] = (unsigned)(kr * ldk + kc * 8); kst_[i] = (unsigned)(kr * KROW + ((kc * 16) ^ ((kr & 15) << 4))); }
  const int vb0 = (int)(uintptr_t)V_lds + v_rd_base(lane);
  bf16x8 svs0, svs1, sks[KCH];
#define ATT_SLOAD(t) do { const int _r = __builtin_amdgcn_readfirstlane(src.row(t)); const bf16* _vt = Vh + (size_t)_r * ldv; const bf16* _kt = Kh + (size_t)_r * ldk; \
    svs0 = *(const GAS bf16x8*)(_vt + voff0); svs1 = *(const GAS bf16x8*)(_vt + 32 * ldv + voff0); \
    _Pragma("unroll") for (int _i = 0; _i < KCH; ++_i) sks[_i] = *(const GAS bf16x8*)(_kt + koff_[_i]); } while (0)
#define ATT_SWRITE(b) do { *(LAS bf16x8*)(V_lds + (b) * SHM_V + vst0) = svs0; *(LAS bf16x8*)(V_lds + (b) * SHM_V + vst1) = svs1; \
    _Pragma("unroll") for (int _i = 0; _i < KCH; ++_i) *(LAS bf16x8*)(K_lds + (b) * SHM_K + kst_[_i]) = sks[_i]; } while (0)
#define ATT_RESC(a) do { if (__any((a) < 1.f)) { if (hi == 0) al_l[r32] = (a); asm volatile("s_waitcnt lgkmcnt(0)" ::: "memory"); \
    _Pragma("unroll") for (int d = 0; d < 4; ++d) _Pragma("unroll") for (int r = 0; r < 16; ++r) o[d][r] *= al_l[crow(r, hi)]; } } while (0)
  auto qkt = [&](f32x16& p0, f32x16& p1, int b, int t) {
    const LAS char* Ks = K_lds + b * SHM_K;
    p0 = f32x16{}; p1 = f32x16{};
    const LAS char* k0p = Ks + r32 * KROW; const LAS char* k1p = Ks + (32 + r32) * KROW; const int sw = (r32 & 15) << 4;
    bf16x8 ka[2], kb[2];
    ka[0] = *reinterpret_cast<const LAS bf16x8*>(k0p + ((hi * 16) ^ sw)); kb[0] = *reinterpret_cast<const LAS bf16x8*>(k1p + ((hi * 16) ^ sw));
#pragma unroll
    for (int d0 = 0; d0 < ND0; ++d0) {
      if (d0 + 1 < ND0) { const int cb = ((d0 + 1) * 16 + hi * 8) * 2;
        ka[(d0 + 1) & 1] = *reinterpret_cast<const LAS bf16x8*>(k0p + (cb ^ sw)); kb[(d0 + 1) & 1] = *reinterpret_cast<const LAS bf16x8*>(k1p + (cb ^ sw)); }
      __builtin_amdgcn_sched_barrier(0);
      p0 = __builtin_amdgcn_mfma_f32_32x32x16_bf16(ka[d0 & 1], qr[d0], p0, 0, 0, 0);
      p1 = __builtin_amdgcn_mfma_f32_32x32x16_bf16(kb[d0 & 1], qr[d0], p1, 0, 0, 0);
      __builtin_amdgcn_sched_barrier(0); }
    if constexpr (MODE == 1) {
      const int i = t - src.n0;
      if (i >= 0) {
        const int kr = nm.rlo + i, r0q = min(max(nm.qrow - 4, 0), 24), c0q = min(max(nm.qcol - 8, 0), 48);
        const bool rowok = (i < src.n1) && (kr >= r0q) && (kr < r0q + 8);
        const int rowoff = (kr - nm.qrow + 7) * 31 + 15 - nm.qcol;
#pragma unroll
        for (int r = 0; r < 16; ++r) {
          const int kc0 = crow(r, hi), kc1 = kc0 + 32;
          const bool ok0 = rowok && ((unsigned)(kc0 - c0q) < 16u), ok1 = rowok && ((unsigned)(kc1 - c0q) < 16u);
          const float b0 = nm.rpb[ok0 ? rowoff + kc0 : 0], b1 = nm.rpb[ok1 ? rowoff + kc1 : 0];
          p0[r] = ok0 ? p0[r] + b0 : -1e30f; p1[r] = ok1 ? p1[r] + b1 : -1e30f; }
      }
    }
  };
  auto partialSM = [&](f32x16& p0, f32x16& p1, float& mn, float& alpha) {
    float pmax = p0[0];
#pragma unroll
    for (int r = 1; r < 16; ++r) pmax = fmaxf(pmax, p0[r]);
#pragma unroll
    for (int r = 0; r < 16; ++r) pmax = fmaxf(pmax, p1[r]);
    { auto rr = __builtin_amdgcn_permlane32_swap(__float_as_uint(pmax), __float_as_uint(pmax), false, false); pmax = fmaxf(__uint_as_float(rr[0]), __uint_as_float(rr[1])); }
    if (__builtin_expect(__all(pmax - m_reg <= THR / SCALE), 1)) { mn = m_reg; alpha = 1.f; }
    else { mn = fmaxf(m_reg, pmax); alpha = __builtin_amdgcn_exp2f((m_reg - mn) * C); m_reg = mn; }
    const float mnC = -mn * C;
#pragma unroll
    for (int r = 0; r < 16; ++r) p0[r] = fmaf(p0[r], C, mnC);
#pragma unroll
    for (int r = 0; r < 16; ++r) p1[r] = fmaf(p1[r], C, mnC);
#pragma unroll
    for (int r = 0; r < 16; ++r) p0[r] = __builtin_amdgcn_exp2f(p0[r]);
  };
  auto finishSM = [&](f32x16& p0, f32x16& p1, float alpha, bf16x8& pa0, bf16x8& pa1, bf16x8& pa2, bf16x8& pa3) {
#pragma unroll
    for (int r = 0; r < 16; ++r) p1[r] = __builtin_amdgcn_exp2f(p1[r]);
    float ps = 0;
#pragma unroll
    for (int r = 0; r < 16; ++r) ps += p0[r];
#pragma unroll
    for (int r = 0; r < 16; ++r) ps += p1[r];
    { auto rr = __builtin_amdgcn_permlane32_swap(__float_as_uint(ps), __float_as_uint(ps), false, false); ps = __uint_as_float(rr[0]) + __uint_as_float(rr[1]); }
    l_reg = l_reg * alpha + ps;
#define ATT_PK4(P, BASE, OUT) do { unsigned a0 = cvtpk(P[BASE + 0], P[BASE + 1]), a1 = cvtpk(P[BASE + 2], P[BASE + 3]); \
    unsigned b0 = cvtpk(P[BASE + 4], P[BASE + 5]), b1 = cvtpk(P[BASE + 6], P[BASE + 7]); \
    auto r0 = __builtin_amdgcn_permlane32_swap(a0, b0, false, false); auto r1 = __builtin_amdgcn_permlane32_swap(a1, b1, false, false); \
    u32x4 w = {r0[0], r1[0], r0[1], r1[1]}; OUT = *reinterpret_cast<bf16x8*>(&w); } while (0)
    ATT_PK4(p0, 0, pa0); ATT_PK4(p0, 8, pa1); ATT_PK4(p1, 0, pa2); ATT_PK4(p1, 8, pa3);
#undef ATT_PK4
  };
  f32x16 p0, p1; float mn, al; bf16x8 pa0, pa1, pa2, pa3;
  ATT_SLOAD(0); asm volatile("s_waitcnt vmcnt(0)" ::: "memory"); ATT_SWRITE(0); if (NT > 1) ATT_SLOAD(1); __syncthreads();
  for (int t = 0; t < NT; ++t) {
    const int b = t & 1;
    ATT_SBAR(); qkt(p0, p1, b, t); ATT_SBAR();
    if (t + 1 < NT) { asm volatile("s_waitcnt vmcnt(0)" ::: "memory"); ATT_SWRITE(b ^ 1); if (t + 2 < NT) ATT_SLOAD(t + 2); }
    ATT_SBAR();
    partialSM(p0, p1, mn, al); ATT_RESC(al);
    finishSM(p0, p1, al, pa0, pa1, pa2, pa3); ATT_SBAR();
    pv_d0(o, vb0 + b * SHM_V, pa0, pa1, pa2, pa3);
    __syncthreads();
  }
  if (hi == 0) li_l[r32] = l_reg; asm volatile("s_waitcnt lgkmcnt(0)" ::: "memory");
  int hi_o = hi; asm volatile("" : "+v"(hi_o));
  bf16* Ow = Ob + (size_t)(wid * QBLK + 4 * hi_o) * ldo;
#pragma unroll
  for (int r = 0; r < 16; ++r) { const int orow = crow(r, 0); const float rl = __builtin_amdgcn_rcpf(li_l[orow + 4 * hi_o]);
#pragma unroll
    for (int d0 = 0; d0 < 4; ++d0) { const float v = o[d0][r] * rl; ((GAS bf16*)Ow)[(size_t)orow * ldo + d0 * 32 + r32] = (bf16)(cvtpk(v, v) & 0xffffu); } }
#undef ATT_SLOAD
#undef ATT_SWRITE
#undef ATT_RESC
}
}
namespace pg8 {
struct EpiKV {
    static constexpr bool PERM = true;
    bf16_t* KV; bf16_t* KF; const float* gkn; const float* KPE; const float* SSK; const float* RT; PG8_LAS float* tab;
    __device__ __forceinline__ void operator()(const f32x4 (&acc)[2][2][4][2], const Unit& u, int wr, int wc, int fr, int fq) const {
        const int h = u.pn, row0 = u.pm * BM + wr * 64 + fr, c8 = wc * 32 + 8 * fq;
        float sk[2][4];
#pragma unroll
        for (int ai = 0; ai < 2; ++ai)
#pragma unroll
            for (int m = 0; m < 4; ++m) { const f32x4 a = acc[ai][0][m][0], b = acc[ai][0][m][1]; sk[ai][m] = ((const PG8_GAS float*)SSK)[row0 + ai * HALF + m * 16];
                float s = (a[0] * a[0] + a[1] * a[1]) + (a[2] * a[2] + a[3] * a[3]) + (b[0] * b[0] + b[1] * b[1]) + (b[2] * b[2] + b[3] * b[3]);
                s += __shfl_xor(s, 16); s += __shfl_xor(s, 32);
                if (fq == 0) tab[(ai * HALF + wr * 64 + m * 16 + fr) * 4 + wc] = s; }
#pragma unroll
        for (int ai = 0; ai < 2; ++ai)
#pragma unroll
            for (int m = 0; m < 4; ++m) { const f32x4 v0 = acc[ai][1][m][0], v1 = acc[ai][1][m][1];
                u32x4 w; w.x = cvt_pk_bf16(v0[0], v0[1]); w.y = cvt_pk_bf16(v0[2], v0[3]); w.z = cvt_pk_bf16(v1[0], v1[1]); w.w = cvt_pk_bf16(v1[2], v1[3]);
                *(PG8_GAS u32x4*)(KV + (size_t)(row0 + ai * HALF + m * 16) * 4096 + h * 256 + 128 + c8) = w; }
        asm volatile("s_waitcnt lgkmcnt(0)" ::: "memory"); __builtin_amdgcn_s_barrier(); asm volatile("" ::: "memory");
        const f32x4 g0 = *(const PG8_GAS f32x4*)(gkn + c8), g1 = *(const PG8_GAS f32x4*)(gkn + c8 + 4);
#pragma unroll
        for (int ai = 0; ai < 2; ++ai)
#pragma unroll
            for (int m = 0; m < 4; ++m) { const int row = row0 + ai * HALF + m * 16; const f32x4 p = *(const PG8_LAS f32x4*)(tab + (ai * HALF + wr * 64 + m * 16 + fr) * 4);
                const float rs = rsqrtf(((p[0] + p[1]) + (p[2] + p[3]) + sk[ai][m]) * (1.f / 192.f) + 1e-6f);
                const f32x4 k0 = acc[ai][0][m][0] * rs * g0, k1 = acc[ai][0][m][1] * rs * g1;
                u32x4 w; w.x = cvt_pk_bf16(k0[0], k0[1]); w.y = cvt_pk_bf16(k0[2], k0[3]); w.z = cvt_pk_bf16(k1[0], k1[1]); w.w = cvt_pk_bf16(k1[2], k1[3]);
                *(PG8_GAS u32x4*)(KF + (size_t)row * 3072 + h * 192 + c8) = w; }
        { const int t_ = (wr * 4 + wc) * 64 + fq * 16 + fr, r = t_ >> 1, hf = t_ & 1, row = u.pm * BM + r;
          const f32x4 p = *(const PG8_LAS f32x4*)(tab + r * 4);
          const float rs = rsqrtf(((p[0] + p[1]) + (p[2] + p[3]) + ((const PG8_GAS float*)SSK)[row]) * (1.f / 192.f) + 1e-6f);
          const bool rot = row >= 8192 && row < 12288; const float* rt = RT + ((size_t)((row - 8192) & 2047) * 32 + 16 * hf) * 2;
          const float* kp = KPE + (size_t)row * 64 + 16 * hf; bf16_t* o = KF + (size_t)row * 3072 + h * 192 + 128 + 16 * hf;
#pragma unroll
          for (int q = 0; q < 2; ++q) {
              f32x4 a0 = *(const PG8_GAS f32x4*)(kp + 8 * q), a1 = *(const PG8_GAS f32x4*)(kp + 8 * q + 4), b0 = *(const PG8_GAS f32x4*)(kp + 32 + 8 * q), b1 = *(const PG8_GAS f32x4*)(kp + 32 + 8 * q + 4);
              a0 = a0 * rs * *(const PG8_GAS f32x4*)(gkn + 128 + 16 * hf + 8 * q); a1 = a1 * rs * *(const PG8_GAS f32x4*)(gkn + 128 + 16 * hf + 8 * q + 4);
              b0 = b0 * rs * *(const PG8_GAS f32x4*)(gkn + 160 + 16 * hf + 8 * q); b1 = b1 * rs * *(const PG8_GAS f32x4*)(gkn + 160 + 16 * hf + 8 * q + 4);
              float x1[8] = {a0[0], a0[1], a0[2], a0[3], a1[0], a1[1], a1[2], a1[3]}, x2[8] = {b0[0], b0[1], b0[2], b0[3], b1[0], b1[1], b1[2], b1[3]};
              if (rot) {
#pragma unroll
                  for (int e2 = 0; e2 < 4; ++e2) { const f32x4 cs = *(const PG8_GAS f32x4*)(rt + (8 * q + 2 * e2) * 2);
                      const float y0 = x1[2 * e2] * cs[0] - x2[2 * e2] * cs[1], z0 = x1[2 * e2] * cs[1] + x2[2 * e2] * cs[0];
                      const float y1 = x1[2 * e2 + 1] * cs[2] - x2[2 * e2 + 1] * cs[3], z1 = x1[2 * e2 + 1] * cs[3] + x2[2 * e2 + 1] * cs[2];
                      x1[2 * e2] = y0; x2[2 * e2] = z0; x1[2 * e2 + 1] = y1; x2[2 * e2 + 1] = z1; } }
              u32x4 w1, w2; w1.x = cvt_pk_bf16(x1[0], x1[1]); w1.y = cvt_pk_bf16(x1[2], x1[3]); w1.z = cvt_pk_bf16(x1[4], x1[5]); w1.w = cvt_pk_bf16(x1[6], x1[7]);
              w2.x = cvt_pk_bf16(x2[0], x2[1]); w2.y = cvt_pk_bf16(x2[2], x2[3]); w2.z = cvt_pk_bf16(x2[4], x2[5]); w2.w = cvt_pk_bf16(x2[6], x2[7]);
              *(PG8_GAS u32x4*)(o + 8 * q) = w1; *(PG8_GAS u32x4*)(o + 32 + 8 * q) = w2; } }
    }
};
}
__device__ __forceinline__ void rope_table(const Args& a, int tid, int vcu, int G) {
    f32x2* RT = (f32x2*)(a.ws + WS_ROPE);
    for (int e = vcu * NTHR + tid; e < 2048 * 32; e += G * NTHR) { const int t = e >> 5, i = e & 31;
        const float inv = exp2f(-(float)(i & 15) * (13.287712379549449f / 16.f));
        const float ang = (float)(i < 16 ? (t >> 6) : (t & 63)) * inv; float s, c; sincosf(ang, &s, &c); RT[e] = (f32x2){c, s}; }
}
__device__ __forceinline__ void mla_thin_b(const Args& a, int j, int lane, int gw, int NGW) {
    OPAQUE_V(lane); PH_PTRS; OPAQUE_S(gw); OPAQUE_S(NGW);
    const bf16* QRAW = (const bf16*)(ws + WS_S + S_QRAW); bf16* QN = (bf16*)(ws + WS_S + S_QN);
    const bf16* KVRAW = (const bf16*)(ws + WS_S + S_KVRAW); bf16* KF = (bf16*)(ws + WS_S + S_KF);
    const float* KPE = (const float*)(ws + WS_S + S_KPE); const float* SSK = (const float*)(ws + WS_SSK);
    const f32x2* RT = (const f32x2*)(ws + WS_ROPE);
    const float* gqn = a.in[I_GQN] + (size_t)j * 192; const float* gkn = a.in[I_GKN] + (size_t)j * 192;
    const int grp = lane >> 4, s = lane & 15;
    float gq[12], gk[12];
#pragma unroll
    for (int e = 0; e < 8; ++e) { gq[e] = gqn[8 * s + e]; gk[e] = gkn[8 * s + e]; }
    gq[8] = gqn[128 + 2 * s]; gq[9] = gqn[129 + 2 * s]; gq[10] = gqn[160 + 2 * s]; gq[11] = gqn[161 + 2 * s];
    gk[8] = gkn[128 + 2 * s]; gk[9] = gkn[129 + 2 * s]; gk[10] = gkn[160 + 2 * s]; gk[11] = gkn[161 + 2 * s];
    const int NQI = 0, NKI = MKV * 4;
    for (int it = gw; it < NQI + NKI; it += NGW) {
        const bool isq = it < NQI; const int r4 = isq ? it : it - NQI; const int row = r4 >> 2, h = (r4 & 3) * 4 + grp;
        float x[12];
        if (isq) {
            const bf16* p = QRAW + (size_t)row * 3072 + h * 192;
            const v4u w = *(const GAS v4u*)(p + 8 * s); const unsigned w1 = *(const GAS unsigned*)(p + 128 + 2 * s), w2 = *(const GAS unsigned*)(p + 160 + 2 * s);
            x[0] = bf_lo(w.x); x[1] = bf_hi(w.x); x[2] = bf_lo(w.y); x[3] = bf_hi(w.y); x[4] = bf_lo(w.z); x[5] = bf_hi(w.z); x[6] = bf_lo(w.w); x[7] = bf_hi(w.w);
            x[8] = bf_lo(w1); x[9] = bf_hi(w1); x[10] = bf_lo(w2); x[11] = bf_hi(w2);
        } else {
            const bf16* p = KVRAW + (size_t)row * 4096 + h * 256;
            const v4u w = *(const GAS v4u*)(p + 8 * s);
            x[0] = bf_lo(w.x); x[1] = bf_hi(w.x); x[2] = bf_lo(w.y); x[3] = bf_hi(w.y); x[4] = bf_lo(w.z); x[5] = bf_hi(w.z); x[6] = bf_lo(w.w); x[7] = bf_hi(w.w);
            const f32x2 k1 = *(const GAS f32x2*)(KPE + (size_t)row * 64 + 2 * s), k2 = *(const GAS f32x2*)(KPE + (size_t)row * 64 + 32 + 2 * s);
            x[8] = k1.x; x[9] = k1.y; x[10] = k2.x; x[11] = k2.y;
        }
        float ss = 0.f;
#pragma unroll
        for (int e = 0; e < 8; ++e) ss += x[e] * x[e];
        if (isq) { ss += x[8] * x[8] + x[9] * x[9] + x[10] * x[10] + x[11] * x[11]; ss = sum16(ss); }
        else { ss = sum16(ss) + SSK[row]; }
        const float rs = rsqrtf(ss * (1.f / 192.f) + EPS);
#pragma unroll
        for (int e = 0; e < 12; ++e) x[e] = x[e] * rs * (isq ? gq[e] : gk[e]);
        if (row >= MP && row < MALL) {
            const int t = (row - MP) & 2047; const f32x2 cs0 = RT[t * 32 + 2 * s], cs1 = RT[t * 32 + 2 * s + 1];
            const float a0 = x[8] * cs0.x - x[10] * cs0.y, b0 = x[8] * cs0.y + x[10] * cs0.x, a1 = x[9] * cs1.x - x[11] * cs1.y, b1 = x[9] * cs1.y + x[11] * cs1.x;
            x[8] = a0; x[9] = a1; x[10] = b0; x[11] = b1;
        }
        bf16* o = (isq ? QN : KF) + (size_t)row * 3072 + h * 192;
        *(GAS v4u*)(o + 8 * s) = (v4u){pk2(x[0], x[1]), pk2(x[2], x[3]), pk2(x[4], x[5]), pk2(x[6], x[7])};
        *(GAS unsigned*)(o + 128 + 2 * s) = pk2(x[8], x[9]); *(GAS unsigned*)(o + 160 + 2 * s) = pk2(x[10], x[11]);
    }
}
__device__ __forceinline__ void mla_attn_phase(const Args& a, int j, LAS unsigned char* lds, int tid, int vcu, int G) {
    OPAQUE_V(tid); PH_PTRS; OPAQUE_S(vcu); OPAQUE_S(G);
    const bf16* QN = (const bf16*)(ws + WS_S + S_QRAW); const bf16* KF = (const bf16*)(ws + WS_S + S_KF); const bf16* KVRAW = (const bf16*)(ws + WS_S + S_KVRAW);
    bf16* AO = (bf16*)(ws + WS_S + S_AO); const float* gqn = a.in[I_GQN] + (size_t)j * 192; const float* RT = (const float*)(ws + WS_ROPE);
    for (int u = vcu; u < 768; u += G) {
        int q0, h, NT; att::KvSrc src; const float* qrope = nullptr;
        if (u < 256) { const int b = u >> 7, qb = u & 7; h = (u >> 3) & 15; q0 = MP + b * 2048 + qb * 256; src = att::KvSrc{MP + b * 2048, 32, MALL + b * 256, 4}; NT = 36; qrope = RT + (size_t)(qb * 256) * 64; }
        else { const int v = u - 256, b = v >> 4; h = v & 15; q0 = b * 256; src = att::KvSrc{b * 256, 4, 0, 1}; NT = 4; }
        att::attn_unit<192, 0, 3072, 3072, 4096, DM, 1>(QN + (size_t)q0 * 3072 + h * 192, KF + h * 192, KVRAW + h * 256 + 128, AO + (size_t)q0 * DM + h * 128, src, NT, att::NatMask{0, 0, 0, nullptr}, (LAS char*)lds, tid, gqn, qrope);
    }
}
namespace pg8 {
struct EpiHg {
    static constexpr bool PERM = true;
    unsigned char* ws;
    __device__ __forceinline__ void operator()(const f32x4 (&acc)[2][2][4][2], const Unit& u, int wr, int wc, int fr, int fq) const {
        const int region = u.pn >> 3, row0 = u.pm * BM + wr * 64 + fr, col0 = (u.pn & 7) * BM + wc * 32 + 8 * fq;
        if (region == 1 || region == 2) {
            const int d = region - 1;
            f32x4 lbv[2][2];
#pragma unroll
            for (int bj = 0; bj < 2; ++bj)
#pragma unroll
                for (int n = 0; n < 2; ++n) lbv[bj][n] = *(const PG8_GAS f32x4*)((const float*)(ws + WS_LB) + d * 2048 + col0 + bj * HALF + 4 * n);
            bf16_t* K = (bf16_t*)(ws + WS_S + S_HK) + (size_t)d * 12288 * 2048; float* Gd = (float*)(ws + WS_U) + (size_t)d * 12288 * 2048;
#pragma unroll
            for (int ai = 0; ai < 2; ++ai)
#pragma unroll
                for (int m = 0; m < 4; ++m) { const size_t ro = (size_t)(row0 + ai * HALF + m * 16) * 2048 + col0;
#pragma unroll
                    for (int bj = 0; bj < 2; ++bj) { f32x4 kk[2], gg[2];
#pragma unroll
                        for (int n = 0; n < 2; ++n)
#pragma unroll
                            for (int e = 0; e < 4; ++e) { const float z = acc[ai][bj][m][n][e]; const float sn = __builtin_amdgcn_rcpf(1.f + __expf(z));
                                const float k = (1.f - lbv[bj][n][e]) * sn; kk[n][e] = k; gg[n][e] = __log2f(1.f - k); }
                        u32x4 w; w.x = cvt_pk_bf16(kk[0][0], kk[0][1]); w.y = cvt_pk_bf16(kk[0][2], kk[0][3]); w.z = cvt_pk_bf16(kk[1][0], kk[1][1]); w.w = cvt_pk_bf16(kk[1][2], kk[1][3]);
                        *(PG8_GAS u32x4*)(K + ro + bj * HALF) = w; *(PG8_GAS f32x4*)(Gd + ro + bj * HALF) = gg[0]; *(PG8_GAS f32x4*)(Gd + ro + bj * HALF + 4) = gg[1]; } }
        } else {
            bf16_t* O = (bf16_t*)(ws + WS_S + (region == 0 ? S_HQ : region == 3 ? S_HV : S_HGS)); const bool act = region != 3;
#pragma unroll
            for (int ai = 0; ai < 2; ++ai)
#pragma unroll
                for (int m = 0; m < 4; ++m) { bf16_t* rowp = O + (size_t)(row0 + ai * HALF + m * 16) * 2048 + col0;
#pragma unroll
                    for (int bj = 0; bj < 2; ++bj) { f32x4 v0 = acc[ai][bj][m][0], v1 = acc[ai][bj][m][1];
                        if (act) {
#pragma unroll
                            for (int e = 0; e < 4; ++e) { v0[e] = v0[e] * __builtin_amdgcn_rcpf(1.f + __expf(-v0[e])); v1[e] = v1[e] * __builtin_amdgcn_rcpf(1.f + __expf(-v1[e])); } }
                        u32x4 w; w.x = cvt_pk_bf16(v0[0], v0[1]); w.y = cvt_pk_bf16(v0[2], v0[3]); w.z = cvt_pk_bf16(v1[0], v1[1]); w.w = cvt_pk_bf16(v1[2], v1[3]);
                        *(PG8_GAS u32x4*)(rowp + bj * HALF) = w; } }
        }
    }
};
}

namespace hg {
constexpr int PQ = 272, PK = 80;
constexpr int OFF_QM = 0, OFF_KM = 32 * PQ, OFF_V = 2 * 32 * PQ, OFF_ATT = 3 * 32 * PQ, OFF_C2 = OFF_ATT + 32 * PK, OFF_C3 = OFF_C2 + 512, BUF = OFF_C3 + 512;
constexpr int OFF_TOT = 2 * BUF, TOT_BYTES = 8 * 128 * 4;
constexpr int OFF_OST = OFF_TOT + 2 * TOT_BYTES;
constexpr int OFF_STG = OFF_OST + 32 * PQ, STG_SLOT = 40960;
static_assert(OFF_STG + 2 * STG_SLOT <= LDSCTL_OFF, "scan LDS (must stay below the control words)");
typedef short bf16x8 __attribute__((ext_vector_type(8)));
typedef short s16x4 __attribute__((ext_vector_type(4)));
struct Chain { int rb, N, d, h; const float* S0; float* Sout; };
template <int OFF> __device__ __forceinline__ s16x4 tr_read(int addr) { s16x4 r; asm volatile("ds_read_b64_tr_b16 %0, %1 offset:%2" : "=&v"(r) : "v"(addr), "i"(OFF) : "memory"); return r; }
__device__ __forceinline__ unsigned bfmul2(unsigned w, float e0, float e1) { return pk2(bf_lo(w) * e0, bf_hi(w) * e1); }

__device__ __forceinline__ void scan_chain(const Chain ch, const bf16* __restrict__ HQ, const bf16* __restrict__ HK, const float* __restrict__ HG, const bf16* __restrict__ HV,
                                           bf16* __restrict__ OD, LAS unsigned char* lds, int tid) {
    const int lane = tid & 63, w = tid >> 6, l15 = lane & 15, q4 = lane >> 4;
    const int k2 = lane;
    const int vt = tid >> 4, v8 = (tid & 15) * 8;
    const int nc = ch.N >> 5, hc = ch.h * 128;
    f32x4 S[8];
    if (ch.S0) {
#pragma unroll
        for (int kt = 0; kt < 8; ++kt)
#pragma unroll
            for (int r = 0; r < 4; ++r) S[kt][r] = ((const GAS float*)ch.S0)[(size_t)(16 * kt + 4 * q4 + r) * 128 + 16 * w + l15];
    } else {
#pragma unroll
        for (int kt = 0; kt < 8; ++kt) S[kt] = (f32x4){0.f, 0.f, 0.f, 0.f};
    }
#define HG_ROW(c, t) (ch.rb + (ch.d ? ch.N - 1 - (32 * (c) + (t)) : 32 * (c) + (t)))
    struct InSet { f32x2 g[4]; unsigned q[4], k[4]; v4u v; };
    f32x2 cl[4]; unsigned cq[4], ck[4]; v4u cv;
#define HG_DMA(c) do { LAS unsigned char* sl_ = lds + OFF_STG + ((c) & 1) * STG_SLOT; \
        _Pragma("unroll") for (int i_ = 0; i_ < 2; ++i_) __builtin_amdgcn_global_load_lds((const unsigned*)(HG + (size_t)HG_ROW(c, 4 * w + 2 * i_ + (lane >> 5)) * 2048 + hc + (lane & 31) * 4), (LAS unsigned*)(sl_ + (4 * w + 2 * i_) * 512), 16, 0, 0); \
        { const size_t ro_ = (size_t)HG_ROW(c, 4 * w + (lane >> 4)) * 2048 + hc + (lane & 15) * 8; \
          __builtin_amdgcn_global_load_lds((const unsigned*)(HQ + ro_), (LAS unsigned*)(sl_ + 16384 + 4 * w * 256), 16, 0, 0); \
          __builtin_amdgcn_global_load_lds((const unsigned*)(HK + ro_), (LAS unsigned*)(sl_ + 24576 + 4 * w * 256), 16, 0, 0); \
          __builtin_amdgcn_global_load_lds((const unsigned*)(HV + ro_), (LAS unsigned*)(sl_ + 32768 + 4 * w * 256), 16, 0, 0); } } while (0)
#define HG_P1(c) do { const LAS unsigned char* sl_ = lds + OFF_STG + ((c) & 1) * STG_SLOT; f32x2 run = (f32x2){0.f, 0.f}; \
        _Pragma("unroll") for (int i = 0; i < 4; ++i) { run = run + *(const LAS f32x2*)(sl_ + (4 * w + i) * 512 + k2 * 8); cl[i] = run; cq[i] = *(const LAS unsigned*)(sl_ + 16384 + (4 * w + i) * 256 + k2 * 4); ck[i] = *(const LAS unsigned*)(sl_ + 24576 + (4 * w + i) * 256 + k2 * 4); } \
        cv = *(const LAS v4u*)(sl_ + 32768 + vt * 256 + v8 * 2); \
        *(LAS f32x2*)(lds + OFF_TOT + ((c) & 1) * TOT_BYTES + (w * 128 + 2 * k2) * 4) = run; } while (0)
    HG_DMA(0); HG_DMA(1);
    asm volatile("s_waitcnt vmcnt(0)" ::: "memory"); HG_P1(0); LDS_WAIT(); asm volatile("" ::: "memory");
    HG_DMA(2);
    LDS_WAIT(); __builtin_amdgcn_s_barrier(); asm volatile("" ::: "memory");
    const int traddr = (int)(uintptr_t)lds + (8 * q4 + (l15 >> 2)) * PQ + (l15 & 3) * 8;
    auto mstage = [&](const int pc) {
        { LAS unsigned char* B = lds + (pc & 1) * BUF; const int tb = traddr + (pc & 1) * BUF;
            const s16x4 v0 = tr_read<0>(tb + OFF_V + 32 * w), v1 = tr_read<4 * PQ>(tb + OFF_V + 32 * w);
            bf16x8 aat[2]; v2u aq0[2][4], aq1[2][4];
#pragma unroll
            for (int tt = 0; tt < 2; ++tt) { aat[tt] = *(const LAS bf16x8*)(B + OFF_ATT + (16 * tt + l15) * PK + 16 * q4);
#pragma unroll
                for (int ks = 0; ks < 4; ++ks) { aq0[tt][ks] = *(const LAS v2u*)(B + OFF_QM + (16 * tt + l15) * PQ + (32 * ks + 4 * q4) * 2); aq1[tt][ks] = *(const LAS v2u*)(B + OFF_QM + (16 * tt + l15) * PQ + (32 * ks + 16 + 4 * q4) * 2); } }
            f32x4 c2v[8];
#pragma unroll
            for (int kt = 0; kt < 8; ++kt) c2v[kt] = *(const LAS f32x4*)(B + OFF_C2 + (16 * kt + 4 * q4) * 4);
            LDS_WAIT(); __builtin_amdgcn_sched_barrier(0);
            const bf16x8 bv = (bf16x8){v0[0], v0[1], v0[2], v0[3], v1[0], v1[1], v1[2], v1[3]};
            f32x4 o2[2];
#pragma unroll
            for (int kt = 0; kt < 8; ++kt) S[kt] = S[kt] * c2v[kt];
#pragma unroll
            for (int tt = 0; tt < 2; ++tt) o2[tt] = __builtin_amdgcn_mfma_f32_16x16x32_bf16(aat[tt], bv, (f32x4){0.f, 0.f, 0.f, 0.f}, 0, 0, 0);
#pragma unroll
            for (int ks = 0; ks < 4; ++ks) {
                const v4u sb = (v4u){pk2(S[2 * ks][0], S[2 * ks][1]), pk2(S[2 * ks][2], S[2 * ks][3]), pk2(S[2 * ks + 1][0], S[2 * ks + 1][1]), pk2(S[2 * ks + 1][2], S[2 * ks + 1][3])};
                const bf16x8 bs = __builtin_bit_cast(bf16x8, sb);
#pragma unroll
                for (int tt = 0; tt < 2; ++tt) { const bf16x8 aq = __builtin_bit_cast(bf16x8, ((v4u){aq0[tt][ks].x, aq0[tt][ks].y, aq1[tt][ks].x, aq1[tt][ks].y}));
                    o2[tt] = __builtin_amdgcn_mfma_f32_16x16x32_bf16(aq, bs, o2[tt], 0, 0, 0); }
            }
            s16x4 ke0[8], ke1[8]; f32x4 elv[8];
#define HG_KRD(kt) ke0[kt] = tr_read<32 * (kt)>(tb + OFF_KM); ke1[kt] = tr_read<32 * (kt) + 4 * PQ>(tb + OFF_KM)
            HG_KRD(0); HG_KRD(1); HG_KRD(2); HG_KRD(3); HG_KRD(4); HG_KRD(5); HG_KRD(6); HG_KRD(7);
#undef HG_KRD
#pragma unroll
            for (int kt = 0; kt < 8; ++kt) elv[kt] = *(const LAS f32x4*)(B + OFF_C3 + (16 * kt + 4 * q4) * 4);
            LDS_WAIT(); __builtin_amdgcn_sched_barrier(0);
#pragma unroll
            for (int kt = 0; kt < 8; ++kt) { const bf16x8 ak = (bf16x8){ke0[kt][0], ke0[kt][1], ke0[kt][2], ke0[kt][3], ke1[kt][0], ke1[kt][1], ke1[kt][2], ke1[kt][3]};
                S[kt] = __builtin_amdgcn_mfma_f32_16x16x32_bf16(ak, bv, S[kt], 0, 0, 0) * elv[kt]; }
#pragma unroll
            for (int tt = 0; tt < 2; ++tt)
#pragma unroll
                for (int r = 0; r < 4; ++r) *(LAS unsigned short*)(lds + OFF_OST + (16 * tt + 4 * q4 + r) * PQ + (16 * w + l15) * 2) = (unsigned short)(pk2(o2[tt][r], 0.f) & 0xffffu);
        }
    };
    for (int c = 0; c < nc; ++c) {
        if (c > 0) mstage(c - 1);
        LAS unsigned char* B = lds + (c & 1) * BUF;
        { const LAS f32x2* T = (const LAS f32x2*)(lds + OFF_TOT + (c & 1) * TOT_BYTES) + k2;
          f32x2 off = (f32x2){0.f, 0.f}, cm = (f32x2){0.f, 0.f}, last = (f32x2){0.f, 0.f};
#pragma unroll
          for (int sgm = 0; sgm < 8; ++sgm) { const f32x2 tv = T[sgm * 64]; if (sgm < w) off = off + tv; if (sgm < 4) cm = cm + tv; last = last + tv; }
#pragma unroll
          for (int i = 0; i < 4; ++i) { const f32x2 cu = off + cl[i]; const int t = 4 * w + i;
              *(LAS unsigned*)(B + OFF_QM + t * PQ + k2 * 4) = bfmul2(cq[i], __builtin_amdgcn_exp2f(cu.x - cm.x), __builtin_amdgcn_exp2f(cu.y - cm.y));
              *(LAS unsigned*)(B + OFF_KM + t * PQ + k2 * 4) = bfmul2(ck[i], __builtin_amdgcn_exp2f(cm.x - cu.x), __builtin_amdgcn_exp2f(cm.y - cu.y));
 }
          if (w == 0) { *(LAS f32x2*)(B + OFF_C2 + k2 * 8) = (f32x2){__builtin_amdgcn_exp2f(cm.x), __builtin_amdgcn_exp2f(cm.y)}; *(LAS f32x2*)(B + OFF_C3 + k2 * 8) = (f32x2){__builtin_amdgcn_exp2f(last.x - cm.x), __builtin_amdgcn_exp2f(last.y - cm.y)}; }
          *(LAS v4u*)(B + OFF_V + vt * PQ + v8 * 2) = cv; }
        { asm volatile("s_waitcnt vmcnt(5)" ::: "memory"); HG_P1(c + 1); LDS_WAIT(); asm volatile("" ::: "memory");
          const int cn = c + 3 < nc ? c + 3 : nc - 1; HG_DMA(cn); }
        LDS_WAIT(); __builtin_amdgcn_s_barrier(); asm volatile("" ::: "memory");
        if (c > 0) *(GAS v4u*)(OD + (size_t)HG_ROW(c - 1, vt) * 2048 + hc + v8) = *(const LAS v4u*)(lds + OFF_OST + vt * PQ + v8 * 2);
        if (w < 4) {
            const int tt = w >> 1, st = w & 1; f32x4 at = (f32x4){0.f, 0.f, 0.f, 0.f};
            if (!(tt == 0 && st == 1)) {
                bf16x8 af[4], bfr[4];
#pragma unroll
                for (int ks = 0; ks < 4; ++ks) { af[ks] = *(const LAS bf16x8*)(B + OFF_QM + (16 * tt + l15) * PQ + (32 * ks + 8 * q4) * 2); bfr[ks] = *(const LAS bf16x8*)(B + OFF_KM + (16 * st + l15) * PQ + (32 * ks + 8 * q4) * 2); }
                LDS_WAIT(); __builtin_amdgcn_sched_barrier(0);
#pragma unroll
                for (int ks = 0; ks < 4; ++ks) at = __builtin_amdgcn_mfma_f32_16x16x32_bf16(af[ks], bfr[ks], at, 0, 0, 0);
            }
            const int s_ = 16 * st + l15;
#pragma unroll
            for (int r = 0; r < 4; ++r) { const int t = 16 * tt + 4 * q4 + r; const float val = (s_ <= t) ? at[r] : 0.f;
                *(LAS unsigned short*)(B + OFF_ATT + t * PK + s_ * 2) = (unsigned short)(pk2(val, 0.f) & 0xffffu); }
        }
        LDS_WAIT(); __builtin_amdgcn_s_barrier(); asm volatile("" ::: "memory");
    }
    mstage(nc - 1);
    LDS_WAIT(); __builtin_amdgcn_s_barrier(); asm volatile("" ::: "memory");
    *(GAS v4u*)(OD + (size_t)HG_ROW(nc - 1, vt) * 2048 + hc + v8) = *(const LAS v4u*)(lds + OFF_OST + vt * PQ + v8 * 2);
    if (ch.Sout) {
#pragma unroll
        for (int kt = 0; kt < 8; ++kt)
#pragma unroll
            for (int r = 0; r < 4; ++r) __builtin_nontemporal_store(S[kt][r] * DBG_SCALE, (GAS float*)ch.Sout + (size_t)(16 * kt + 4 * q4 + r) * 128 + 16 * w + l15);
    }
    __builtin_amdgcn_s_barrier();
#undef HG_ROW
#undef HG_LOAD
#undef HG_P1
}
}

__device__ __forceinline__ void hg_scan_phase(const Args& a, LAS unsigned char* lds, int tid, int vcu, int G) {
    OPAQUE_V(tid); PH_PTRS; OPAQUE_S(vcu); OPAQUE_S(G);
    const bf16* HQ = (const bf16*)(ws + WS_S + S_HQ); const bf16* HK = (const bf16*)(ws + WS_S + S_HK); const float* HGp = (const float*)(ws + WS_U);
    const bf16* HV = (const bf16*)(ws + WS_S + S_HV); bf16* OF = (bf16*)(ws + WS_S + S_OF);
    const int NS = G > 128 ? 64 : 0;
    int first = vcu < NS ? vcu : NS + (vcu - NS), step = vcu < NS ? 1088 : G - NS, last = 1088;
    if (G == 256) { if (vcu < 64) step = 1024; else last = 1024; }
    const int reps = ((DBG_REP_MASK >> 16) & 1) && vcu < NS ? 3 : ((DBG_REP_MASK >> 17) & 1) && vcu >= NS ? 3 : 1;
    for (int rep_ = 0; rep_ < reps; ++rep_)
    for (int ci = first; ci < last; ci += step) {
        const bool lat = ci < 64; const int e = lat ? ci : ci - 64, b = e >> 5, d = (e >> 4) & 1, h = e & 15;
        const size_t so = ((size_t)((b * 2 + d) * 16 + h)) * 16384;
        hg::Chain ch{lat ? MP + b * 2048 : b * 256, lat ? 2048 : 256, d, h, lat ? a.in[I_SHG] + so : nullptr, lat ? nullptr : out + O_HG + so};
        hg::scan_chain(ch, HQ, HK + (size_t)d * MALL * DM, HGp + (size_t)d * MALL * DM, HV, OF + (size_t)d * MALL * DM, lds, tid);
    }
}

__device__ __forceinline__ void hg_thin_c(const Args& a, int lane, int gw, int NGW) {
    OPAQUE_V(lane); PH_PTRS; OPAQUE_S(gw); OPAQUE_S(NGW);
    const bf16* OF = (const bf16*)(ws + WS_S + S_OF); const bf16* HGS = (const bf16*)(ws + WS_S + S_HGS); bf16* AO = (bf16*)(ws + WS_S + S_AO);
    const int grp = lane >> 4, s = lane & 15;
    const f32x4 g0 = *(const GAS f32x4*)(a.in[I_GHO] + 8 * s), g1 = *(const GAS f32x4*)(a.in[I_GHO] + 8 * s + 4);
    for (int it = gw; it < MALL * 4; it += NGW) {
        const int row = it >> 2, h = (it & 3) * 4 + grp; const size_t o_ = (size_t)row * DM + h * 128 + 8 * s;
        const v4u of = *(const GAS v4u*)(OF + o_), ob = *(const GAS v4u*)(OF + (size_t)MALL * DM + o_);
        const f32x4 a0 = (f32x4){bf_lo(of.x) + bf_lo(ob.x), bf_hi(of.x) + bf_hi(ob.x), bf_lo(of.y) + bf_lo(ob.y), bf_hi(of.y) + bf_hi(ob.y)}, a1 = (f32x4){bf_lo(of.z) + bf_lo(ob.z), bf_hi(of.z) + bf_hi(ob.z), bf_lo(of.w) + bf_lo(ob.w), bf_hi(of.w) + bf_hi(ob.w)};
        float ss = (a0.x * a0.x + a0.y * a0.y) + (a0.z * a0.z + a0.w * a0.w) + (a1.x * a1.x + a1.y * a1.y) + (a1.z * a1.z + a1.w * a1.w);
        const float rs = rsqrtf(sum16(ss) * (1.f / 128.f) + EPS);
        const v4u gw_ = *(const GAS v4u*)(HGS + o_);
        const f32x4 y0 = a0 * rs * g0 * (f32x4){bf_lo(gw_.x), bf_hi(gw_.x), bf_lo(gw_.y), bf_hi(gw_.y)}, y1 = a1 * rs * g1 * (f32x4){bf_lo(gw_.z), bf_hi(gw_.z), bf_lo(gw_.w), bf_hi(gw_.w)};
        *(GAS v4u*)(AO + o_) = (v4u){pk2(y0.x, y0.y), pk2(y0.z, y0.w), pk2(y1.x, y1.y), pk2(y1.z, y1.w)};
    }
}
namespace pg8 {
struct EpiNat {
    static constexpr bool PERM = true;
    bf16_t* QKV; bf16_t* KN; float* outk; float* outv; const float* gk; PG8_LAS float* tab;
    __device__ __forceinline__ void operator()(const f32x4 (&acc)[2][2][4][2], const Unit& u, int wr, int wc, int fr, int fq) const {
        const int region = u.pn >> 3, row0 = u.pm * BM + wr * 64 + fr, ct = (u.pn & 7) * BM + wc * 32 + 8 * fq;
        if (region == 1) {
#pragma unroll
            for (int ai = 0; ai < 2; ++ai)
#pragma unroll
                for (int m = 0; m < 4; ++m)
#pragma unroll
                    for (int bj = 0; bj < 2; ++bj) { const f32x4 a = acc[ai][bj][m][0], b = acc[ai][bj][m][1];
                        float s = (a[0] * a[0] + a[1] * a[1]) + (a[2] * a[2] + a[3] * a[3]) + (b[0] * b[0] + b[1] * b[1]) + (b[2] * b[2] + b[3] * b[3]);
                        s += __shfl_xor(s, 16); s += __shfl_xor(s, 32);
                        if (fq == 0) tab[((ai * HALF + wr * 64 + m * 16 + fr) * 2 + bj) * 4 + wc] = s; }
            asm volatile("s_waitcnt lgkmcnt(0)" ::: "memory"); __builtin_amdgcn_s_barrier(); asm volatile("" ::: "memory");
            f32x4 g0[2], g1[2];
#pragma unroll
            for (int bj = 0; bj < 2; ++bj) { g0[bj] = *(const PG8_GAS f32x4*)(gk + wc * 32 + 8 * fq); g1[bj] = *(const PG8_GAS f32x4*)(gk + wc * 32 + 8 * fq + 4); }
#pragma unroll
            for (int ai = 0; ai < 2; ++ai)
#pragma unroll
                for (int m = 0; m < 4; ++m) { const int row = row0 + ai * HALF + m * 16;
#pragma unroll
                    for (int bj = 0; bj < 2; ++bj) { const f32x4 p = *(const PG8_LAS f32x4*)(tab + ((ai * HALF + wr * 64 + m * 16 + fr) * 2 + bj) * 4);
                        const float rs = rsqrtf(((p[0] + p[1]) + (p[2] + p[3])) * (1.f / 128.f) + 1e-6f);
                        const f32x4 k0 = acc[ai][bj][m][0] * rs * g0[bj], k1 = acc[ai][bj][m][1] * rs * g1[bj];
                        u32x4 w; w.x = cvt_pk_bf16(k0[0], k0[1]); w.y = cvt_pk_bf16(k0[2], k0[3]); w.z = cvt_pk_bf16(k1[0], k1[1]); w.w = cvt_pk_bf16(k1[2], k1[3]);
                        *(PG8_GAS u32x4*)(KN + (size_t)row * 2048 + ct + bj * HALF) = w;
                        if (row < 8192) { __builtin_nontemporal_store(k0 * DBG_SCALE, (PG8_GAS f32x4*)(outk + (size_t)row * 2048 + ct + bj * HALF)); __builtin_nontemporal_store(k1 * DBG_SCALE, (PG8_GAS f32x4*)(outk + (size_t)row * 2048 + ct + bj * HALF + 4)); } } }
        } else {
#pragma unroll
            for (int ai = 0; ai < 2; ++ai)
#pragma unroll
                for (int m = 0; m < 4; ++m) { const int row = row0 + ai * HALF + m * 16;
#pragma unroll
                    for (int bj = 0; bj < 2; ++bj) { const f32x4 v0 = acc[ai][bj][m][0], v1 = acc[ai][bj][m][1];
                        u32x4 w; w.x = cvt_pk_bf16(v0[0], v0[1]); w.y = cvt_pk_bf16(v0[2], v0[3]); w.z = cvt_pk_bf16(v1[0], v1[1]); w.w = cvt_pk_bf16(v1[2], v1[3]);
                        *(PG8_GAS u32x4*)(QKV + (size_t)row * 6144 + region * 2048 + ct + bj * HALF) = w;
                        if (region == 2 && row < 8192) { __builtin_nontemporal_store(v0 * DBG_SCALE, (PG8_GAS f32x4*)(outv + (size_t)row * 2048 + ct + bj * HALF)); __builtin_nontemporal_store(v1 * DBG_SCALE, (PG8_GAS f32x4*)(outv + (size_t)row * 2048 + ct + bj * HALF + 4)); } } }
        }
    }
};
}
__device__ __forceinline__ void nat_cache_rows(const Args& a, int lane, int gw, int NGW) {
    OPAQUE_V(lane); PH_PTRS; OPAQUE_S(gw); OPAQUE_S(NGW);
    bf16* QKV = (bf16*)(ws + WS_S + S_NQKV); bf16* KN = (bf16*)(ws + WS_S + S_NKN);
    for (int it = gw; it < 512 * 4; it += NGW) {
        const int row = MALL + (it >> 2), c = (it & 3) * 512 + 8 * lane; const size_t so = (size_t)(row - MALL) * DM + c;
        const f32x4 k0 = *(const GAS f32x4*)(a.in[I_CNK] + so), k1 = *(const GAS f32x4*)(a.in[I_CNK] + so + 4), v0 = *(const GAS f32x4*)(a.in[I_CNV] + so), v1 = *(const GAS f32x4*)(a.in[I_CNV] + so + 4);
        *(GAS v4u*)(KN + (size_t)row * DM + c) = (v4u){pk2(k0.x, k0.y), pk2(k0.z, k0.w), pk2(k1.x, k1.y), pk2(k1.z, k1.w)};
        *(GAS v4u*)(QKV + (size_t)row * 6144 + 4096 + c) = (v4u){pk2(v0.x, v0.y), pk2(v0.z, v0.w), pk2(v1.x, v1.y), pk2(v1.z, v1.w)};
    }
}
__device__ __forceinline__ void nat_attn_phase(const Args& a, LAS unsigned char* lds, int tid, int vcu, int G) {
    OPAQUE_V(tid); PH_PTRS; OPAQUE_S(vcu); OPAQUE_S(G);
    const bf16* QKV = (const bf16*)(ws + WS_S + S_NQKV); const bf16* KN = (const bf16*)(ws + WS_S + S_NKN); bf16* AO = (bf16*)(ws + WS_S + S_AO); const float* gq = a.in[I_GNQ];
    LAS float* rpb = (LAS float*)(lds + att::RPB_OFF);
    for (int u = vcu; u < 768; u += G) {
        if (u < 256) {
            const int b = u >> 7, h = (u >> 3) & 15, i = u & 7, q0 = MP + b * 2048 + i * 256;
            const int rlo = min(max(4 * i - 4, 0), 24), rhi = min(max(4 * i - 1, 0), 24) + 8, nrows = rhi - rlo;
            __syncthreads();
            for (int e = tid; e < 465; e += NTHR) rpb[e] = a.in[I_RPB][h * 465 + e] * 11.313708498984761f;
            __syncthreads();
            const att::KvSrc src{MALL + b * 256, 4, MP + b * 2048 + 64 * rlo, nrows};
            const att::NatMask nm{rlo, 4 * i + ((tid >> 6) >> 1), 32 * ((tid >> 6) & 1) + (tid & 31), rpb};
            att::attn_unit<128, 1, 6144, DM, 6144, DM, 1>(QKV + (size_t)q0 * 6144 + h * 128, KN + h * 128, QKV + 4096 + h * 128, AO + (size_t)q0 * DM + h * 128, src, 4 + nrows, nm, (LAS char*)lds, tid, gq, nullptr);
        } else {
            const int v = u - 256, b = v >> 4, h = v & 15, q0 = b * 256;
            const att::KvSrc src{b * 256, 4, 0, 1};
            att::attn_unit<128, 0, 6144, DM, 6144, DM, 1>(QKV + (size_t)q0 * 6144 + h * 128, KN + h * 128, QKV + 4096 + h * 128, AO + (size_t)q0 * DM + h * 128, src, 4, att::NatMask{0, 0, 0, nullptr}, (LAS char*)lds, tid, gq, nullptr);
        }
    }
}
constexpr int NPHASE = 2 + 10 * DEPTH;
__host__ __device__ constexpr bool phase_exists(int ph) {
    if (ph == 0 || ph == NPHASE - 1) return true;
    const int l = (ph - 1) / 10, k = (ph - 1) % 10, kind = l % 3;
    if (k == 2) return kind != 2;
    if (k == 3) return kind == 0;
    if (k == 4) return kind == 1;
    if (k == 5) return kind != 1;
    return true;
}

__global__ void __launch_bounds__(NTHR, 2) fwd(Args a) {
    extern __shared__ __attribute__((aligned(16))) unsigned char lds_[];
    LAS unsigned char* lds = (LAS unsigned char*)lds_;
#define tid ({ int t_ = threadIdx.x; asm volatile("" : "+v"(t_)); t_; })
#define lane (tid & 63)
#define wave (__builtin_amdgcn_readfirstlane(tid >> 6))
    const int G = gridDim.x, bx = blockIdx.x, vcu = (G % 8 == 0) ? (bx % 8) * (G / 8) + bx / 8 : bx;
    const int NGW = G * NWAVES;
#define gw (vcu * NWAVES + wave)
    volatile LAS unsigned* MISC = (volatile LAS unsigned*)(lds + MISC_OFF);
    unsigned* ctl = (unsigned*)(a.ws + WS_CTL);
    for (int u = tid; u < (LDS_BYTES - LDSCTL_OFF) / 4; u += NTHR) ((LAS unsigned*)(lds + LDSCTL_OFF))[u] = 0u;
    __syncthreads();
    XcdBarrier bar; bar.bar = ctl + CW_BAR; bar.x = 0; bar.st = nullptr;
    if (MK_SINGLE) bar = xcd_barrier_post(ctl + CW_BAR, MISC + 8);
    const int lo = a.ph_lo, hi = a.ph_hi;
#define IN(k) (lo <= (k) && (k) < hi)
#ifndef DBG_REP_MASK
#define DBG_REP_MASK 0
#endif
#define REPEAT(id) for (int rep_ = 0; rep_ < (((DBG_REP_MASK >> (id)) & 1) ? 3 : 1); ++rep_)
#if defined(DBG_PROF)
    { unsigned long long* prof = (unsigned long long*)((unsigned char*)ctl + WS_PROF); float* po_ = a.out;
      if (bx == 0 && tid == 0) { prof[200] = (unsigned long long)*(volatile unsigned*)(po_ + O_END - 1); prof[100] = wall_clock64(); prof[300] = clock64(); } }
#define SEAM(k) do { if (MK_SINGLE && (k) + 1 < hi) xcd_barrier(bar); if (bx == 0 && tid == 0) { unsigned long long* prof = (unsigned long long*)((unsigned char*)bar.bar - CW_BAR * 4 + WS_PROF); prof[100 + (k) + 1] = wall_clock64(); prof[300 + (k) + 1] = clock64(); } } while (0)
#else
#define SEAM(k) do { if (MK_SINGLE && (k) + 1 < hi) xcd_barrier(bar); } while (0)
#endif
#define GEMM_PTRS PH_PTRS; int gG = G, gbx = bx; OPAQUE_S(gG); OPAQUE_S(gbx); bf16* const H = (bf16*)(ws + WS_H); bf16* const U = (bf16*)(ws + WS_U); bf16* const AO = (bf16*)(ws + WS_S + S_AO); bf16* const X = (bf16*)(ws + WS_S + S_X); \
    const float* const MODS = (const float*)(ws + WS_MODS); (void)H; (void)U; (void)AO; (void)X; (void)MODS

#define CONVERT_WINDOW(lo_, hi_, nunits) do { const int from_ = (nunits) % gG; if (!from_ || gbx >= from_) p0_convert_range(a, lds, lo_, hi_, (gbx - from_) * NWAVES + wave, (gG - from_) * NWAVES, lane, wave); } while (0)

    if (IN(0)) { REPEAT(0) { p0_prologue(a, lds, tid, lane, wave, vcu, G); rope_table(a, tid, vcu, G); if (DBG_REP_MASK & 1) __syncthreads(); } SEAM(0); }

    for (int l = 0; l < DEPTH; ++l) {
        const int kind = l % 3, j = l / 3, pb = 1 + 10 * l;
        if (IN(pb + 0)) { REPEAT(1) norm_phase(a, l, false, l > 0 ? (const float*)(a.ws + WS_MODS) + (size_t)(l - 1) * 3 * NMOD + 5 * DM : nullptr, lane, gw, NGW); if (kind == 2) nat_cache_rows(a, lane, gw, NGW); SEAM(pb + 0); }
        if (kind == 0) {
            if (IN(pb + 1)) {
                GEMM_PTRS; unsigned char* wm = ws + WS_WMLA + (size_t)j * WMLA_STRIDE;
                pg8::Gemm g{H, (const bf16*)wm, MALL, 1536, DM, DM, DM, 1}; pg8::QaOrder S; S.init(gG, gbx, g.K);
                pg8::EpiBf16<0> E{(bf16*)(ws + WS_S + S_QAKV), 1536};
                REPEAT(2) pg8::gemm_phase<pg8::EpiBf16<0>, pg8::QaOrder>(lds, g, S, E);
                CONVERT_WINDOW(a.wstart[l + 1], a.wmid[l + 1], 288);
                SEAM(pb + 1);
            }
            if (IN(pb + 2)) { REPEAT(3) mla_thin_a(a, j, lane, gw, NGW); SEAM(pb + 2); }
            if (IN(pb + 3)) {
                GEMM_PTRS; unsigned char* wm = ws + WS_WMLA + (size_t)j * WMLA_STRIDE;
                REPEAT(4) {
                { pg8::Gemm g{(const bf16*)(ws + WS_S + S_QAN), (const bf16*)(wm + WMLA_QB), MALL, 3072, 768, 768, 768, 1}; pg8::StaticOrder S; S.init(MALL, 3072, 1, gG, gbx, g.K);
                  pg8::EpiBf16<0> E{(bf16*)(ws + WS_S + S_QRAW), 3072};
                  pg8::gemm_phase<pg8::EpiBf16<0>, pg8::StaticOrder>(lds, g, S, E); }
                { pg8::Gemm g{(const bf16*)(ws + WS_S + S_CKVN), (const bf16*)(wm + WMLA_KVB), MKV, 4096, 512, 512, 512, 1}; pg8::StaticOrder S; S.init(MKV, 4096, 1, gG, (gbx + gG / 2) % gG, g.K);
                  pg8::EpiKV E{(bf16*)(ws + WS_S + S_KVRAW), (bf16*)(ws + WS_S + S_KF), a.in[I_GKN] + (size_t)j * 192, (const float*)(ws + WS_S + S_KPE), (const float*)(ws + WS_SSK), (const float*)(ws + WS_ROPE), (LAS float*)(lds + EPI_TAB_OFF)};
                  pg8::gemm_phase<pg8::EpiKV, pg8::StaticOrder>(lds, g, S, E); }
                }
                {
                    int p_ = gbx, np_ = gG;
                    if (gG == 256) { p_ = gbx < 64 ? -1 : gbx < 128 ? gbx - 64 : gbx < 160 ? -1 : gbx - 96; np_ = 160; }
                    if (p_ >= 0) p0_convert_range(a, lds, a.wmid[l + 1], a.wstart[l + 2], p_ * NWAVES + wave, np_ * NWAVES, lane, wave);
                }
                SEAM(pb + 3);
            }
            if (IN(pb + 5)) { REPEAT(6) mla_attn_phase(a, j, lds, tid, vcu, G); SEAM(pb + 5); }
        }
        if (kind == 1) {
            if (IN(pb + 1)) {
                GEMM_PTRS;
                pg8::Gemm g{H, (const bf16*)(ws + WS_WHG), MALL, 10240, DM, DM, DM, 1}; pg8::StaticOrder S; S.init(MALL, 10240, 1, gG, gbx, g.K);
                pg8::EpiHg E{ws};
                REPEAT(8) pg8::gemm_phase<pg8::EpiHg, pg8::StaticOrder, false>(lds, g, S, E);
                CONVERT_WINDOW(a.wstart[l + 1], a.wstart[l + 2], 1920);
                SEAM(pb + 1);
            }
            if (IN(pb + 2)) { REPEAT(9) hg_scan_phase(a, lds, tid, vcu, G); SEAM(pb + 2); }
            if (IN(pb + 4)) { REPEAT(10) hg_thin_c(a, lane, gw, NGW); SEAM(pb + 4); }
        }
        if (kind == 2) {
            if (IN(pb + 1)) {
                GEMM_PTRS;
                pg8::Gemm g{H, (const bf16*)(ws + WS_WNAT), MALL, 6144, DM, DM, DM, 1}; pg8::StaticOrder S; S.init(MALL, 6144, 1, gG, gbx, g.K);
                pg8::EpiNat E{(bf16*)(ws + WS_S + S_NQKV), (bf16*)(ws + WS_S + S_NKN), out + O_NK, out + O_NV, a.in[I_GNK], (LAS float*)(lds + EPI_TAB_OFF)};
                REPEAT(11) pg8::gemm_phase<pg8::EpiNat, pg8::StaticOrder>(lds, g, S, E);
                CONVERT_WINDOW(a.wstart[l + 1], a.wstart[l + 2], 1152);
                SEAM(pb + 1);
            }
            if (IN(pb + 5)) { REPEAT(13) nat_attn_phase(a, lds, tid, vcu, G); SEAM(pb + 5); }
        }
        if (IN(pb + 6)) {
            GEMM_PTRS;
            const bf16* wo = (const bf16*)(kind == 0 ? ws + WS_WMLA + (size_t)j * WMLA_STRIDE + WMLA_WO : kind == 1 ? ws + WS_WHG + WHG_WO : ws + WS_WNAT + WNAT_WO);
            pg8::Gemm g{AO, wo, MALL, DM, DM / 2, DM, DM, 2}; pg8::ResOrder S; S.init(gG, gbx, DM);
            pg8::EpiRes2 E{X, MODS + (size_t)l * 3 * NMOD + 2 * DM, (bf16*)(ws + WS_S + S_PART), nullptr};
            pg8::gemm_phase<pg8::EpiRes2, pg8::ResOrder>(lds, g, S, E);
            SEAM(pb + 6);
        }
        if (IN(pb + 7)) { REPEAT(1) norm_phase(a, l, true, (const float*)(a.ws + WS_MODS) + (size_t)l * 3 * NMOD + 2 * DM, lane, gw, NGW); SEAM(pb + 7); }
        if (IN(pb + 8)) {
            GEMM_PTRS;
            pg8::Gemm g{H, (const bf16*)(ws + WS_WFF1) + (size_t)l * DM * FF, MALL, FF, DM, DM, DM, 1}; pg8::StaticOrder S; S.init(MALL, FF, 1, gG, gbx, g.K);
            pg8::EpiBf16<1> E{U, FF};
            REPEAT(7) pg8::gemm_phase<pg8::EpiBf16<1>, pg8::StaticOrder>(lds, g, S, E);
            SEAM(pb + 8);
        }
        if (IN(pb + 9)) {
            GEMM_PTRS;
            pg8::Gemm g{U, (const bf16*)(ws + WS_WFF2) + (size_t)l * DM * FF, MALL, DM, FF / 2, FF, FF, 2}; pg8::ResOrder S; S.init(gG, gbx, FF);
            pg8::EpiRes2 E{X, MODS + (size_t)l * 3 * NMOD + 5 * DM, (bf16*)(ws + WS_S + S_PART), l + 1 == DEPTH ? out + O_X : nullptr};
            pg8::gemm_phase<pg8::EpiRes2, pg8::ResOrder>(lds, g, S, E);
            SEAM(pb + 9);
        }
    }
    if (IN(NPHASE - 1)) final_fix_phase(a, (const float*)(a.ws + WS_MODS) + (size_t)(DEPTH - 1) * 3 * NMOD + 5 * DM, lane, gw, NGW);
#if defined(DBG_PROF)
    xcd_barrier(bar);
    { unsigned long long* prof = (unsigned long long*)((unsigned char*)bar.bar - CW_BAR * 4 + WS_PROF); float* po_ = a.out;
    if (bx == 0) {
        if (tid == 0) { prof[100 + NPHASE] = wall_clock64(); prof[300 + NPHASE] = clock64(); }
        __syncthreads();
        if (tid == 0) { constexpr int p = DBG_PROF; const unsigned long long dw = prof[100 + p + 1] - prof[100 + p], dc = prof[300 + p + 1] - prof[300 + p];
            float mant = (float)dw * 1e-4f; mant = mant < 1.f ? 1.f : mant > 9.9f ? 9.9f : mant; const int expo = dw ? (int)(dc / dw) : 0;
            po_[O_X + 7] = mant * __builtin_powif(10.f, expo); }
    } }
#endif
#undef IN
#undef SEAM
#undef tid
#undef lane
#undef wave
#undef gw
}

extern "C" void kernel_launch(void* const* d_in, const int* in_sizes, int n_in, void* d_out, int out_size, void* d_ws, size_t ws_size, hipStream_t stream) {
    static int grid = 0;
    if (grid == 0) {
        if (n_in != N_IN || (size_t)out_size != O_END || ws_size < WS_END) { fprintf(stderr, "kernel_launch: shape mismatch n_in %d out %d ws %zu (need %zu); nothing launched\n", n_in, out_size, ws_size, (size_t)WS_END); grid = -1; return; }
        int dev = 0, cus = 0, per_cu = 0;
        if (hipGetDevice(&dev) != hipSuccess || hipDeviceGetAttribute(&cus, hipDeviceAttributeMultiprocessorCount, dev) != hipSuccess) { fprintf(stderr, "kernel_launch: device query failed\n"); grid = -1; return; }
        if (hipFuncSetAttribute((const void*)fwd, hipFuncAttributeMaxDynamicSharedMemorySize, LDS_BYTES) != hipSuccess) { fprintf(stderr, "kernel_launch: hipFuncSetAttribute failed\n"); grid = -1; return; }
        if (hipOccupancyMaxActiveBlocksPerMultiprocessor(&per_cu, (const void*)fwd, NTHR, LDS_BYTES) != hipSuccess || per_cu < 1) { fprintf(stderr, "kernel_launch: occupancy query says %d blocks/CU\n", per_cu); }
        (void)hipGetLastError();
        grid = cus;
    }
    if (grid < 0) return;
    if (hipMemsetAsync((char*)d_ws + WS_CTL, 0, CTL_ZERO_BYTES, stream) != hipSuccess) { fprintf(stderr, "kernel_launch: memset failed\n"); return; }
    Args a{};
    for (int i = 0; i < N_IN; ++i) a.in[i] = (const float*)d_in[i];
    a.out = (float*)d_out; a.ws = (unsigned char*)d_ws;
    int nt = 0, items = 0;
    auto add = [&](const float* src, size_t dst_off, int K, int N, int row_off) { TJob& t = a.tj[nt++]; t.src = src; t.dst = (bf16*)((unsigned char*)d_ws + dst_off); t.K = K; t.N = N; t.row_off = row_off; t.start = items; items += (K / 64) * (N / 32); };
    auto add_mixer = [&](int l) {
        if (l % 3 == 0) { const int j = l / 3; const size_t wb = WS_WMLA + (size_t)j * WMLA_STRIDE;
            add(a.in[I_WQA] + (size_t)j * DM * 768, wb, DM, 768, 0); add(a.in[I_WKVA] + (size_t)j * DM * 576, wb, DM, 576, 768);
            add(a.in[I_WQB] + (size_t)j * 768 * 3072, wb + WMLA_QB, 768, 3072, 0); add(a.in[I_WKVB] + (size_t)j * 512 * 4096, wb + WMLA_KVB, 512, 4096, 0);
            add(a.in[I_WMO] + (size_t)j * DM * DM, wb + WMLA_WO, DM, DM, 0); }
        if (l % 3 == 1) { add(a.in[I_WHQ], WS_WHG, DM, DM, 0); add(a.in[I_WHF], WS_WHG, DM, DM, 2048); add(a.in[I_WHF] + (size_t)DM * DM, WS_WHG, DM, DM, 4096);
            add(a.in[I_WHI], WS_WHG, DM, DM, 6144); add(a.in[I_WHG], WS_WHG, DM, DM, 8192); add(a.in[I_WHO], WS_WHG + WHG_WO, DM, DM, 0); }
        if (l % 3 == 2) { add(a.in[I_WNQKV], WS_WNAT, DM, 3 * DM, 0); add(a.in[I_WNO], WS_WNAT + WNAT_WO, DM, DM, 0); } };
    a.wstart[0] = 0; add_mixer(0);
    for (int l = 0; l < DEPTH; ++l) {
        a.wstart[l + 1] = items;
        add(a.in[I_WFF1] + (size_t)l * DM * FF, WS_WFF1 + (size_t)l * DM * FF * 2, DM, FF, 0); add(a.in[I_WFF2] + (size_t)l * DM * FF, WS_WFF2 + (size_t)l * DM * FF * 2, FF, DM, 0);
        if (l + 1 < DEPTH) add_mixer(l + 1);
    }
    for (int w = DEPTH + 1; w < 8; ++w) a.wstart[w] = items;
    for (int w = 0; w < 8; ++w) a.wmid[w] = a.wstart[w];
    for (int l = 0; l < DEPTH; ++l) if (l % 3 == 0) {
        const int from = 288 % grid, part = (from ? grid - from : grid) * NWAVES; long n = (long)WQA * part; const long tot = a.wstart[l + 2] - a.wstart[l + 1]; if (n > tot) n = tot;
        a.wmid[l + 1] = a.wstart[l + 1] + (int)n; }
    a.ntj = nt; a.nitems = items;
#if MK_SINGLE
    a.ph_lo = 0; a.ph_hi = NPHASE < MK_LAST_PHASE ? NPHASE : MK_LAST_PHASE;
    hipLaunchKernelGGL(fwd, dim3(grid), dim3(NTHR), LDS_BYTES, stream, a);
#else
    for (int ph = 0; ph < NPHASE && ph < MK_LAST_PHASE; ++ph) {
        if (!phase_exists(ph)) continue;
        a.ph_lo = ph; a.ph_hi = ph + 1;
        hipLaunchKernelGGL(fwd, dim3(grid), dim3(NTHR), LDS_BYTES, stream, a);
    }
#endif
    const hipError_t le = hipPeekAtLastError();
    if (le != hipSuccess) fprintf(stderr, "kernel_launch: launch failed: %s\n", hipGetErrorName(le));
}
```

```cpp
#define MK_SINGLE 1
#define MK_LAST_PHASE 1000
#include <hip/hip_runtime.h>
#include <cstdio>
#include <cstdint>

#ifndef MK_SINGLE
#define MK_SINGLE 1
#endif
#ifndef WQA
#define WQA 12
#endif
#ifndef MK_LAST_PHASE
#define MK_LAST_PHASE 1000
#endif
namespace pg8 {
#define PG8_LAS __attribute__((address_space(3)))
#define PG8_GAS __attribute__((address_space(1)))
typedef unsigned short bf16_t;
typedef short bf16x8 __attribute__((ext_vector_type(8)));
typedef float f32x4 __attribute__((ext_vector_type(4)));
typedef unsigned u32x4 __attribute__((ext_vector_type(4)));
constexpr int BM = 256, BK = 64, HALF = 128, HTB = HALF * BK * 2  , STAGE_BYTES = 8 * HTB, NXCD = 8, WGM = 8;

__host__ __device__ __forceinline__ int lds_byte(int r, int c) { const int st = (r >> 4) * 2 + (c >> 5), rr = r & 15, cc = c & 31, ob = rr * 64 + cc * 2; return st * 1024 + (ob ^ (((ob >> 9) & 1) << 5)); }
__host__ __device__ __forceinline__ void stage_rc(int b, int& R, int& C) { const int st = b / 1024, sb = b % 1024, swz = sb ^ (((sb >> 9) & 1) << 5); R = (st >> 1) * 16 + swz / 64; C = (st & 1) * 32 + (swz % 64) / 2; }
__host__ __device__ __forceinline__ int perm32(int rho) { const int n = rho >> 4, i = rho & 15; return 8 * (i >> 2) + 4 * n + (i & 3); }

struct Unit { int pm, pn, ks, nkt, part, nh; };
struct Gemm { const bf16_t* A; const bf16_t* Bt; int M, N, K, lda, ldb, nsplit; };

struct StaticOrder {
    static constexpr bool HAS_NH = false;
    int nM, nN, nNv, nwg, G, c, nkt, split;
    __host__ __device__ void init(int M, int N, int nsplit, int G_, int c_, int K = 0) { nM = M / BM; nN = N / BM; nNv = nN * nsplit; nwg = nM * nNv; G = G_; c = c_; nkt = K / BK; split = nsplit; }
    __host__ __device__ bool next(int i, Unit& u) const {
        const long L = (long)i * G + c; if (L >= nwg) return false;
        int wgid = (int)L; { const int q = nwg / NXCD, r = nwg % NXCD, xcd = wgid % NXCD, off = wgid / NXCD; wgid = (xcd < r ? xcd * (q + 1) : r * (q + 1) + (xcd - r) * q) + off; }
        const int nig = WGM * nNv, gid = wgid / nig, fm = gid * WGM, gsz = (nM - fm) < WGM ? (nM - fm) : WGM;
        u.pm = fm + ((wgid % nig) % gsz); const int pv = (wgid % nig) / gsz; u.pn = pv % nN; u.ks = pv / nN; u.nkt = nkt; u.part = split > 1 ? u.ks : -1; u.nh = 0; return true;
    }
    __device__ __forceinline__ void a_ready(const Unit&) const {}
    __device__ __forceinline__ void done(const Unit&) const {}
};

struct QaOrder {
    static constexpr bool HAS_NH = true;
    StaticOrder M5; int G, c, nkt;
    __host__ __device__ void init(int G_, int c_, int K) { M5.init(12288, 1280, 1, G_, c_, K); G = G_; c = c_; nkt = K / BK; }
    __host__ __device__ bool next(int i, Unit& u) const {
        const int L = i * G + c;
        if (L < 240) return M5.next(i, u);
        if (L >= 288) return false;
        u.pm = L - 240; u.pn = 5; u.ks = 0; u.nkt = nkt; u.part = -1; u.nh = 1; return true;
    }
    __device__ __forceinline__ void a_ready(const Unit&) const {}
    __device__ __forceinline__ void done(const Unit&) const {}
};
struct ResOrder {
    static constexpr bool HAS_NH = false;
    int G, c, nkF, nkH;
    __host__ __device__ void init(int G_, int c_, int K) { G = G_; c = c_; nkF = K / BK; nkH = K / (2 * BK); }
    __host__ __device__ bool next(int i, Unit& u) const {
        const int L = i * G + c; if (L >= 512) return false;
        const bool half = L >= 256; int w = half ? L - 256 : L;
        w = (w & 7) * 32 + (w >> 3);
        const int sh = half ? 7 : 6, e = w & ((1 << sh) - 1), pv = e >> 3;
        u.pm = (half ? 32 : 0) + ((w >> sh) << 3) + (e & 7); u.pn = pv & 7; u.ks = pv >> 3; u.nkt = half ? nkH : nkF; u.part = half ? u.ks : -1; u.nh = 0; return true;
    }
    __device__ __forceinline__ void a_ready(const Unit&) const {}
    __device__ __forceinline__ void done(const Unit&) const {}
};

__device__ __forceinline__ unsigned cvt_pk_bf16(float lo, float hi) { unsigned r; asm("v_cvt_pk_bf16_f32 %0, %1, %2" : "=v"(r) : "v"(lo), "v"(hi)); return r; }


template <class Epi, class Sched, bool ALIGN_EPI = true, bool SP2 = true>
__device__ __forceinline__ void gemm_phase(PG8_LAS unsigned char* lds, const Gemm g, const Sched& S, const Epi& E) {
    int tid_ = threadIdx.x; asm volatile("" : "+v"(tid_));
    const int tid = tid_, wid = __builtin_amdgcn_readfirstlane(tid >> 6), lane = tid & 63, wr = wid >> 2, wc = wid & 3, fr = lane & 15, fq = lane >> 4;
    const int K = g.K;
    unsigned voffA[2], voffB[2];
#pragma unroll
    for (int i = 0; i < 2; ++i) { int R, C; stage_rc(tid * 16 + i * 8192, R, C); const int Rb = Epi::PERM ? ((R & ~31) + perm32(R & 31)) : R;
        voffA[i] = (unsigned)(R * g.lda + C) * 2u; voffB[i] = (unsigned)(Rb * g.ldb + C) * 2u; }
    const size_t kstep = (size_t)(BK * 2);
    const size_t hstepA = (size_t)HALF * g.lda * 2, hstepB = (size_t)HALF * g.ldb * 2;
    const size_t tstepA = 2 * hstepA, tstepB = 2 * hstepB;
    const size_t sstep = (size_t)K * 2;
    const unsigned ldsw = (unsigned)wid * 1024u;
    const int aoff = lds_byte(wr * 64 + fr, fq * 8), boff = lds_byte(wc * 32 + fr, fq * 8);
#define PG8_SA(b, h) (((b) * 2 + (h)) * HTB)
#define PG8_SB(b, h) ((4 + (b) * 2 + (h)) * HTB)
#define PG8_STAGE(bufoff, gbase, voff) do { _Pragma("unroll") for (int _i = 0; _i < 2; ++_i) \
        __builtin_amdgcn_global_load_lds((const unsigned*)((const char*)(gbase) + (voff)[_i]), (PG8_LAS unsigned*)(lds + (bufoff) + ldsw + _i * 8192), 16, 0, 0); } while (0)
#define PG8_LDA(dst, b, h) do { _Pragma("unroll") for (int m = 0; m < 4; ++m) _Pragma("unroll") for (int k = 0; k < 2; ++k) dst[m][k] = *(const PG8_LAS bf16x8*)(lds + PG8_SA(b, h) + aoff + m * 2048 + k * 1024); } while (0)
#define PG8_LDB(dst, b, h) do { _Pragma("unroll") for (int n = 0; n < 2; ++n) _Pragma("unroll") for (int k = 0; k < 2; ++k) dst[n][k] = *(const PG8_LAS bf16x8*)(lds + PG8_SB(b, h) + boff + n * 2048 + k * 1024); } while (0)
#define PG8_MMA(ai, bj, At, Bt) do { __builtin_amdgcn_s_setprio(1); _Pragma("unroll") for (int m = 0; m < 4; ++m) _Pragma("unroll") for (int n = 0; n < 2; ++n) _Pragma("unroll") for (int k = 0; k < 2; ++k) \
        acc[ai][bj][m][n] = __builtin_amdgcn_mfma_f32_16x16x32_bf16(Bt[n][k], At[m][k], acc[ai][bj][m][n], 0, 0, 0); __builtin_amdgcn_s_setprio(0); } while (0)
#define PG8_WAIT_V(n) asm volatile("s_waitcnt vmcnt(" #n ")" ::: "memory")
#define PG8_WAIT_L(n) asm volatile("s_waitcnt lgkmcnt(" #n ")" ::: "memory")
#define PG8_BAR __builtin_amdgcn_s_barrier()
#define PG8_SCHED __builtin_amdgcn_sched_barrier(0)
    Unit cur, nxt; int ui = 0;
    if (!S.next(0, cur)) return;
    f32x4 acc[2][2][4][2];
#pragma unroll
    for (int a = 0; a < 2; ++a)
#pragma unroll
        for (int b = 0; b < 2; ++b)
#pragma unroll
            for (int m = 0; m < 4; ++m)
#pragma unroll
                for (int n = 0; n < 2; ++n) acc[a][b][m][n] = (f32x4){0.f, 0.f, 0.f, 0.f};
    bf16x8 At[4][2], B0[2][2], B1[2][2];
    const char* cA = (const char*)g.A + (size_t)cur.pm * tstepA + (size_t)cur.ks * sstep; const char* cB = (const char*)g.Bt + (size_t)cur.pn * tstepB + (size_t)cur.ks * sstep;
    S.a_ready(cur);
    if constexpr (SP2) {
        PG8_STAGE(PG8_SB(0, 0), cB, voffB); PG8_STAGE(PG8_SB(0, 1), cB + hstepB, voffB); PG8_STAGE(PG8_SA(0, 0), cA, voffA); PG8_STAGE(PG8_SA(0, 1), cA + hstepA, voffA);
        if (wr == 1) PG8_BAR;
        PG8_WAIT_V(2); PG8_BAR;
        PG8_STAGE(PG8_SB(1, 0), cB + kstep, voffB); PG8_STAGE(PG8_SA(1, 0), cA + kstep, voffA); PG8_STAGE(PG8_SB(1, 1), cB + hstepB + kstep, voffB);
        PG8_WAIT_V(6); PG8_BAR;
    } else {
        PG8_STAGE(PG8_SB(0, 0), cB, voffB); PG8_STAGE(PG8_SA(0, 0), cA, voffA); PG8_STAGE(PG8_SB(0, 1), cB + hstepB, voffB); PG8_STAGE(PG8_SA(0, 1), cA + hstepA, voffA);
        if (wr == 1) PG8_BAR;
        PG8_WAIT_V(4); PG8_BAR;
        PG8_STAGE(PG8_SB(1, 0), cB + kstep, voffB); PG8_STAGE(PG8_SA(1, 0), cA + kstep, voffA); PG8_STAGE(PG8_SB(1, 1), cB + hstepB + kstep, voffB);
        PG8_WAIT_V(6); PG8_BAR;
    }
    for (;;) {
        const bool has_next = S.next(ui + 1, nxt);
        const char* nA = has_next ? (const char*)g.A + (size_t)nxt.pm * tstepA + (size_t)nxt.ks * sstep : cA; const char* nB = has_next ? (const char*)g.Bt + (size_t)nxt.pn * tstepB + (size_t)nxt.ks * sstep : cB;
        const int nt = cur.nkt; const bool nh = cur.nh != 0;
        for (int t = 0; t < nt; t += 2) {
            const bool last = (t == nt - 2);
            const char* a1 = cA + (size_t)(t + 1) * kstep;
            const char* a2 = last ? nA : cA + (size_t)(t + 2) * kstep; const char* b2 = last ? nB : cB + (size_t)(t + 2) * kstep;
            const char* a3 = a2 + kstep; const char* b3 = b2 + kstep;
            if (last && has_next) S.a_ready(nxt);
            if constexpr (SP2) {
            PG8_LDB(B0, 0, 0); PG8_LDB(B1, 0, 1); PG8_SCHED; PG8_LDA(At, 0, 0); PG8_STAGE(PG8_SA(1, 1), a1 + hstepA, voffA);
            PG8_WAIT_V(8); PG8_WAIT_L(0); PG8_BAR; PG8_MMA(0, 0, At, B0); if (!Sched::HAS_NH || !nh) PG8_MMA(0, 1, At, B1); PG8_BAR; PG8_SCHED;
            PG8_LDA(At, 0, 1); PG8_STAGE(PG8_SB(0, 0), b2, voffB); PG8_STAGE(PG8_SB(0, 1), b2 + hstepB, voffB); PG8_STAGE(PG8_SA(0, 0), a2, voffA);
            PG8_WAIT_V(8); PG8_WAIT_L(0); PG8_BAR; PG8_MMA(1, 0, At, B0); if (!Sched::HAS_NH || !nh) PG8_MMA(1, 1, At, B1); PG8_BAR; PG8_SCHED;
            PG8_LDB(B0, 1, 0); PG8_LDB(B1, 1, 1); PG8_SCHED; PG8_LDA(At, 1, 0); PG8_STAGE(PG8_SA(0, 1), a2 + hstepA, voffA);
            PG8_WAIT_V(8); PG8_WAIT_L(0); PG8_BAR; PG8_MMA(0, 0, At, B0); if (!Sched::HAS_NH || !nh) PG8_MMA(0, 1, At, B1); PG8_BAR; PG8_SCHED;
            PG8_LDA(At, 1, 1); PG8_STAGE(PG8_SB(1, 0), b3, voffB); PG8_STAGE(PG8_SB(1, 1), b3 + hstepB, voffB); PG8_STAGE(PG8_SA(1, 0), a3, voffA);
            PG8_WAIT_V(8); PG8_WAIT_L(0); PG8_BAR; PG8_MMA(1, 0, At, B0); if (!Sched::HAS_NH || !nh) PG8_MMA(1, 1, At, B1); PG8_BAR; PG8_SCHED;
            } else {
            PG8_LDB(B0, 0, 0); PG8_SCHED; PG8_LDA(At, 0, 0); PG8_STAGE(PG8_SA(1, 1), a1 + hstepA, voffA);
            PG8_WAIT_L(8); PG8_BAR; PG8_WAIT_L(0); PG8_MMA(0, 0, At, B0); PG8_BAR; PG8_SCHED;
            PG8_LDB(B1, 0, 1); PG8_STAGE(PG8_SB(0, 0), b2, voffB);
            PG8_BAR; PG8_WAIT_L(0); PG8_MMA(0, 1, At, B1); PG8_BAR;
            PG8_LDA(At, 0, 1); PG8_STAGE(PG8_SA(0, 0), a2, voffA);
            PG8_BAR; PG8_WAIT_L(0); PG8_MMA(1, 0, At, B0); PG8_BAR; PG8_SCHED;
            PG8_STAGE(PG8_SB(0, 1), b2 + hstepB, voffB);
            PG8_WAIT_V(6); PG8_BAR; PG8_MMA(1, 1, At, B1); PG8_BAR;
            PG8_LDB(B0, 1, 0); PG8_SCHED; PG8_LDA(At, 1, 0); PG8_STAGE(PG8_SA(0, 1), a2 + hstepA, voffA);
            PG8_WAIT_L(8); PG8_BAR; PG8_WAIT_L(0); PG8_MMA(0, 0, At, B0); PG8_BAR; PG8_SCHED;
            PG8_LDB(B1, 1, 1); PG8_STAGE(PG8_SB(1, 0), b3, voffB);
            PG8_BAR; PG8_WAIT_L(0); PG8_MMA(0, 1, At, B1); PG8_BAR;
            PG8_LDA(At, 1, 1); PG8_STAGE(PG8_SA(1, 0), a3, voffA);
            PG8_BAR; PG8_WAIT_L(0); PG8_MMA(1, 0, At, B0); PG8_BAR; PG8_SCHED;
            PG8_STAGE(PG8_SB(1, 1), b3 + hstepB, voffB);
            PG8_WAIT_V(6); PG8_BAR; PG8_MMA(1, 1, At, B1); PG8_BAR;
            }
        }
        if constexpr (ALIGN_EPI) { if (wr == 0) PG8_BAR; }
        E(acc, cur, wr, wc, fr, fq); S.done(cur);
        if (!has_next) break;
#pragma unroll
        for (int a = 0; a < 2; ++a)
#pragma unroll
            for (int b = 0; b < 2; ++b)
#pragma unroll
                for (int m = 0; m < 4; ++m)
#pragma unroll
                    for (int n = 0; n < 2; ++n) acc[a][b][m][n] = (f32x4){0.f, 0.f, 0.f, 0.f};
        cur = nxt; cA = nA; cB = nB; ++ui;
        if constexpr (ALIGN_EPI) { if (wr == 1) PG8_BAR; }
    }
    PG8_WAIT_V(0);
    if constexpr (!ALIGN_EPI) { if (wr == 0) PG8_BAR; }
    PG8_BAR;
#undef PG8_SA
#undef PG8_SB
#undef PG8_STAGE
#undef PG8_LDA
#undef PG8_LDB
#undef PG8_MMA
#undef PG8_WAIT_V
#undef PG8_WAIT_L
#undef PG8_BAR
#undef PG8_SCHED
}
}
constexpr int DM = 2048, MP = 8192, MS = 4096, MALL = 12288, MKV = 12800, FF = 8192, NMOD = 12288;
constexpr int NWAVES = 8, NTHR = 512, DEPTH = 4;
constexpr float EPS = 1e-6f;
constexpr size_t O_X = 0, O_CKV = 25165824, O_KPE = 33554432, O_HG = 34603008, O_NK = 51380224, O_NV = 68157440, O_END = 84934656;
enum { I_XP = 0, I_XS, I_CCKV, I_CKPE, I_SHG, I_CNK, I_CNV, I_C, I_CCTX, I_WMOD, I_BMOD, I_GMIX, I_GFFN, I_WQA, I_GQA, I_WQB, I_GQN, I_WKVA, I_GKVA, I_WKVB, I_GKN, I_WMO,
       I_WHQ, I_WHF, I_HLB, I_WHI, I_WHG, I_GHO, I_WHO, I_WNQKV, I_GNQ, I_GNK, I_RPB, I_WNO, I_WFF1, I_WFF2, N_IN };

constexpr size_t MiB = 1u << 20;
constexpr size_t WS_CTL = 0, CTL_ZERO_BYTES = 65536;
constexpr size_t WS_MODS = 2 * MiB;
constexpr size_t WS_LB = 3 * MiB;
constexpr size_t WS_SSK = 3 * MiB + 65536;
constexpr size_t WS_PROF = 3 * MiB + 786432;
constexpr size_t WS_ROPE = 3 * MiB + 131072;
constexpr size_t WS_WFF1 = 4 * MiB, WS_WFF2 = 132 * MiB;
constexpr size_t WS_WMLA = 260 * MiB, WMLA_STRIDE = 24 * MiB;
constexpr size_t WMLA_QB = 6 * MiB, WMLA_KVB = 11 * MiB, WMLA_WO = 15 * MiB;
constexpr size_t WS_WHG = 308 * MiB, WHG_WO = 40 * MiB;
constexpr size_t WS_WNAT = 356 * MiB, WNAT_WO = 24 * MiB;
constexpr size_t WS_H = 388 * MiB;
constexpr size_t WS_U = 436 * MiB;
constexpr size_t WS_S = 628 * MiB;
constexpr size_t S_AO = 0;
constexpr size_t S_QAKV = 48 * MiB, S_QAN = 120 * MiB, S_CKVN = 138 * MiB, S_KPE = 151 * MiB, S_QRAW = 155 * MiB, S_KVRAW = 227 * MiB, S_QN = 327 * MiB, S_KF = 399 * MiB;
constexpr size_t S_HQ = 48 * MiB, S_HK = 96 * MiB, S_HV = 192 * MiB, S_HGS = 240 * MiB, S_OF = 288 * MiB;
constexpr size_t S_NQKV = 48 * MiB, S_NQN = 198 * MiB, S_NKN = 246 * MiB;
constexpr size_t S_PART = 480 * MiB;
constexpr size_t S_X = 512 * MiB;
constexpr size_t WS_END = WS_S + 560 * MiB;
constexpr int CW_TMO = 0, CW_CODE = 1, CW_BAR = 4096;

constexpr int RING_BYTES = 131072;
constexpr int LDSCTL_OFF = 163840 - 512, MISC_OFF = LDSCTL_OFF + 320;
constexpr int EPI_TAB_OFF = LDSCTL_OFF - 8192;
constexpr int LDS_BYTES = 163840;

#define GAS __attribute__((address_space(1)))
#define LAS __attribute__((address_space(3)))
typedef unsigned short bf16;
typedef unsigned v4u __attribute__((ext_vector_type(4)));
typedef unsigned v2u __attribute__((ext_vector_type(2)));
typedef float f32x4 __attribute__((ext_vector_type(4)));
typedef float f32x2 __attribute__((ext_vector_type(2)));
typedef short bf16x8 __attribute__((ext_vector_type(8)));
typedef GAS unsigned gu32;
#define RLX_AGENT __ATOMIC_RELAXED, __HIP_MEMORY_SCOPE_AGENT
#define LDS_WAIT() asm volatile("s_waitcnt lgkmcnt(0)" ::: "memory")
#define VM_WAIT() asm volatile("s_waitcnt vmcnt(0)" ::: "memory")
#ifndef DBG_SCALE
#define DBG_SCALE 1.0f
#endif
#define OPAQUE_S(x) asm volatile("" : "+s"(x))
#define PH_PTRS unsigned char* ws = a.ws; float* out = a.out; OPAQUE_S(ws); OPAQUE_S(out)
#define OPAQUE_V(x) asm volatile("" : "+v"(x))
__device__ __forceinline__ unsigned pk2(float lo, float hi) { unsigned r; asm("v_cvt_pk_bf16_f32 %0, %1, %2" : "=v"(r) : "v"(lo), "v"(hi)); return r; }
__device__ __forceinline__ float bf_lo(unsigned w) { return __uint_as_float(w << 16); }
__device__ __forceinline__ float bf_hi(unsigned w) { return __uint_as_float(w & 0xffff0000u); }
__device__ __forceinline__ float wave_sum(float v) {
#pragma unroll
    for (int o = 1; o < 64; o <<= 1) v += __shfl_xor(v, o);
    return v;
}
__device__ __forceinline__ float sum16(float v) {
#pragma unroll
    for (int o = 1; o < 16; o <<= 1) v += __shfl_xor(v, o);
    return v;
}

#define XB_TMO      128
#define XB_XCNT(j)  (256  + 64 * (j))
#define XB_XSUB(j)  (1280 + 64 * (j))
#define XB_XGEN(j)  (2304 + 64 * (j))
#define XB_TOP      3328
#define XB_TOPGEN   3392
#define XCD_BAR_WORDS 3456
#define XB_SPIN_CAP (1u << 18)
__device__ __forceinline__ unsigned xb_ld(unsigned* p)              { return __hip_atomic_load(p, __ATOMIC_RELAXED, __HIP_MEMORY_SCOPE_AGENT); }
__device__ __forceinline__ unsigned xb_add(unsigned* p, unsigned v) { return __hip_atomic_fetch_add(p, v, __ATOMIC_RELAXED, __HIP_MEMORY_SCOPE_AGENT); }
__device__ __forceinline__ unsigned xb_xcc_id() { return (unsigned)__builtin_amdgcn_s_getreg((3 << 11) | 20) & 0xFu; }
#define XB_SPIN(cond, bar) do { unsigned _sp = 0; while (cond) { __builtin_amdgcn_s_sleep(1); \
    if ((++_sp & 255u) == 0u) { if (xb_ld(&(bar)[XB_TMO])) break; if (_sp > XB_SPIN_CAP) { atomicAdd(&(bar)[XB_TMO], 1u); break; } } } } while (0)
struct XcdBarrier { unsigned* bar; unsigned x; volatile LAS unsigned* st; };
__device__ __forceinline__ XcdBarrier xcd_barrier_post(unsigned* bar, volatile LAS unsigned* st) {
    XcdBarrier b; b.bar = bar; b.x = xb_xcc_id(); b.st = st;
    if (threadIdx.x == 0) (void)xb_add(&bar[XB_XCNT(b.x)], 1u);
    return b;
}
__device__ __forceinline__ void xcd_barrier_complete(unsigned* bar, unsigned x, unsigned& nloc, unsigned& nx) {
    const unsigned G = gridDim.x * gridDim.y * gridDim.z;
    unsigned sum, cnt, mine, sp = 0u;
    for (;;) {
        sum = 0u; cnt = 0u; mine = 0u;
#pragma unroll
        for (unsigned j = 0; j < 16; ++j) { const unsigned c = xb_ld(&bar[XB_XCNT(j)]); sum += c; cnt += (c > 0u) ? 1u : 0u; mine = (j == x) ? c : mine; }
        if (sum == G) break;
        __builtin_amdgcn_s_sleep(1);
        if ((++sp & 255u) == 0u) { if (xb_ld(&bar[XB_TMO])) break; if (sp > XB_SPIN_CAP) { atomicAdd(&bar[XB_TMO], 1u); break; } }
    }
    nloc = mine > 0u ? mine : 1u; nx = cnt > 0u ? cnt : 1u;
}
__device__ __forceinline__ void xcd_barrier(const XcdBarrier& b) {
    asm volatile("s_waitcnt vmcnt(0)" ::: "memory");
    __syncthreads();
    if (threadIdx.x == 0) {
        unsigned* bar = b.bar;
        __builtin_amdgcn_s_waitcnt(0);
        unsigned nloc = b.st[0], nx = b.st[1];
        if (nloc == 0u) { xcd_barrier_complete(bar, b.x, nloc, nx); b.st[0] = nloc; b.st[1] = nx; }
        const unsigned old = xb_add(&bar[XB_XSUB(b.x)], 1u);
        const unsigned gen = old / nloc;
        if (old + 1u == (gen + 1u) * nloc) {
            __builtin_amdgcn_fence(__ATOMIC_RELEASE, "agent");
            asm volatile("s_waitcnt vmcnt(0)" ::: "memory");
            const unsigned og = xb_add(&bar[XB_TOP], 1u);
            const unsigned tg = og / nx;
            if (og + 1u == (tg + 1u) * nx) xb_add(&bar[XB_TOPGEN], 1u);
            else XB_SPIN(xb_ld(&bar[XB_TOPGEN]) == tg, bar);
            __builtin_amdgcn_fence(__ATOMIC_ACQUIRE, "agent");
            xb_add(&bar[XB_XGEN(b.x)], 1u);
            asm volatile("s_waitcnt vmcnt(0)" ::: "memory");
        } else {
            XB_SPIN(xb_ld(&bar[XB_XGEN(b.x)]) == gen, bar);
            __builtin_amdgcn_fence(__ATOMIC_ACQUIRE, "agent");
            asm volatile("s_waitcnt vmcnt(0)" ::: "memory");
        }
    }
    __syncthreads();
}

struct TJob { const float* src; bf16* dst; int K, N, row_off, start; };
constexpr int MAX_TJ = 32;
struct Args { const float* in[N_IN]; float* out; unsigned char* ws; TJob tj[MAX_TJ]; int ntj, nitems, ph_lo, ph_hi;
              int wstart[8], wmid[8]; };

__device__ __forceinline__ void p0_transpose_item(const float* W, int K, int N, bf16* WT, int row_off, LAS float* scr, int item, int lane) {
    const int nblk = N / 32, kb = item / nblk, nb = item % nblk, k0 = 64 * kb, n0 = 32 * nb;
    { const int kr = lane >> 3, ns = (lane & 7) * 4;
      f32x4 t[8];
#pragma unroll
      for (int i = 0; i < 8; ++i) t[i] = __builtin_nontemporal_load((const GAS f32x4*)(W + (size_t)(k0 + kr + 8 * i) * N + n0 + ns));
#pragma unroll
      for (int i = 0; i < 8; ++i) { LAS float* d = scr + (kr + 8 * i) * 33 + ns; d[0] = t[i].x; d[1] = t[i].y; d[2] = t[i].z; d[3] = t[i].w; } }
    LDS_WAIT(); asm volatile("" ::: "memory");
    const int c = lane & 7;
#pragma unroll
    for (int j = 0; j < 4; ++j) { const int n = (lane >> 3) + 8 * j; const LAS float* s = scr + (8 * c) * 33 + n;
        v4u o; o.x = pk2(s[0 * 33], s[1 * 33]); o.y = pk2(s[2 * 33], s[3 * 33]); o.z = pk2(s[4 * 33], s[5 * 33]); o.w = pk2(s[6 * 33], s[7 * 33]);
        __builtin_nontemporal_store(o, (GAS v4u*)(WT + (size_t)(row_off + n0 + n) * K + k0 + 8 * c)); }
    LDS_WAIT(); asm volatile("" ::: "memory");
}

__device__ __forceinline__ void p0_convert_range(const Args& a, LAS unsigned char* lds, int lo, int hi, int idx, int stride, int lane, int wave) {
    OPAQUE_V(lane);
    LAS float* scr = (LAS float*)(lds + wave * 16384);
    for (int it = lo + idx; it < hi; it += stride) {
        int j = 0;
        while (j + 1 < a.ntj && it >= a.tj[j + 1].start) ++j;
        p0_transpose_item(a.tj[j].src, a.tj[j].K, a.tj[j].N, a.tj[j].dst, a.tj[j].row_off, scr, it - a.tj[j].start, lane);
    }
}

__device__ __forceinline__ float silu_f(float x) { return x / (1.f + __expf(-x)); }

__device__ __forceinline__ void p0_prologue(const Args& a, LAS unsigned char* lds, int tid, int lane, int wave, int vcu, int G) {
    OPAQUE_V(tid); OPAQUE_V(lane);
    float* mods = (float*)(a.ws + WS_MODS);
#ifndef DBG_REP_MASK
#define DBG_REP_MASK 0
#endif
    for (int rep_ = 0; rep_ < (((DBG_REP_MASK >> 14) & 1) ? 3 : 1); ++rep_)
    if (vcu < 768) {
        LAS f32x4* S3 = (LAS f32x4*)lds;
        LAS float* RED = (LAS float*)(lds + 32768);
        const float* cc = a.in[I_C]; const float* cx = a.in[I_CCTX];
        for (int k = tid; k < DM; k += NTHR) S3[k] = (f32x4){silu_f(cx[k]), silu_f(cc[k]), silu_f(cc[DM + k]), 0.f};
        __syncthreads();
        for (int tl = vcu; tl < 768; tl += G) {
            const int l = tl / 192, n = (tl % 192) * 64 + lane;
            const float* Wp = a.in[I_WMOD] + ((size_t)l * DM + wave * 256) * NMOD + n;
            float a0 = 0.f, a1 = 0.f, a2 = 0.f;
#pragma unroll 16
            for (int k = 0; k < 256; ++k) { const float wv = __builtin_nontemporal_load((const GAS float*)(Wp + (size_t)k * NMOD)); const f32x4 s = S3[wave * 256 + k]; a0 += s.x * wv; a1 += s.y * wv; a2 += s.z * wv; }
            RED[(wave * 3 + 0) * 64 + lane] = a0; RED[(wave * 3 + 1) * 64 + lane] = a1; RED[(wave * 3 + 2) * 64 + lane] = a2;
            __syncthreads();
            if (wave < 3) { float s = 0.f;
#pragma unroll
                for (int w = 0; w < 8; ++w) s += RED[(w * 3 + wave) * 64 + lane];
                mods[((size_t)l * 3 + wave) * NMOD + n] = s + a.in[I_BMOD][(size_t)l * NMOD + n]; }
            __syncthreads();
        }
    }
    { const int gt = vcu * NTHR + tid;
      if (gt < 2 * DM) { const int d = gt >> 11, c = gt & 2047; const float* hl = a.in[I_HLB] + (size_t)d * 4 * DM + c;
          const float x0 = hl[0], x1 = hl[DM], x2 = hl[2 * DM], x3 = hl[3 * DM]; const float m = fmaxf(fmaxf(x0, x1), fmaxf(x2, x3));
          const float e0 = __expf(x0 - m), e1 = __expf(x1 - m), e2 = __expf(x2 - m), e3 = __expf(x3 - m);
          ((float*)(a.ws + WS_LB))[gt] = e1 / (e0 + e1 + e2 + e3); } }
    __syncthreads();
    LAS float* scr = (LAS float*)(lds + wave * 16384);
    const int gw = vcu * NWAVES + wave, NGW = G * NWAVES;
    for (int rep_ = 0; rep_ < (((DBG_REP_MASK >> 15) & 1) ? 3 : 1); ++rep_)
    for (int it = gw; it < a.wstart[1]; it += NGW) {
        int j = 0;
        while (j + 1 < a.ntj && it >= a.tj[j + 1].start) ++j;
        p0_transpose_item(a.tj[j].src, a.tj[j].K, a.tj[j].N, a.tj[j].dst, a.tj[j].row_off, scr, it - a.tj[j].start, lane);
    }
#if defined(DBG_ZERO_OUT)
    { const size_t gt = (size_t)vcu * NTHR + tid, NT = (size_t)G * NTHR;
      for (size_t i = gt; i < (O_END - O_CKV) / 4; i += NT) *(GAS f32x4*)(a.out + O_CKV + 4 * i) = (f32x4){0.f, 0.f, 0.f, 0.f}; }
#endif
    { const int gt = vcu * NTHR + tid, NT = G * NTHR;
      for (int i = gt; i < 2 * 192 * DM / 8; i += NT) { const int j = i / (192 * DM / 8), r = i % (192 * DM / 8);
          *(GAS v4u*)(a.ws + WS_WMLA + j * WMLA_STRIDE + (size_t)1344 * DM * 2 + (size_t)r * 16) = (v4u){0u, 0u, 0u, 0u}; } }
}

__device__ __forceinline__ int cond_of_row(int row) { return row < MP ? 0 : 1 + ((row - MP) >> 11); }

__device__ __forceinline__ void norm_phase(const Args& a, int l, bool ffn, const float* fixgate, int lane, int gw, int NGW) {
    OPAQUE_V(lane); PH_PTRS; OPAQUE_S(gw); OPAQUE_S(NGW);
    const float* g = a.in[ffn ? I_GFFN : I_GMIX] + (size_t)l * DM;
    const float* mods = (const float*)(ws + WS_MODS) + (size_t)l * 3 * NMOD + (ffn ? 3 * DM : 0);
    bf16* H = (bf16*)(ws + WS_H); bf16* X = (bf16*)(ws + WS_S + S_X);
    const bool first = (l == 0 && !ffn);
    for (int row = gw; row < MALL; row += NGW) {
        const float* md = mods + (size_t)cond_of_row(row) * NMOD;
        f32x4 v[8]; float ss = 0.f;
        const bool fix = fixgate != nullptr && row >= MP;
        const bf16* P0 = (const bf16*)(ws + WS_S + S_PART) + (size_t)(row - MP) * DM; const float* fg = fixgate + (size_t)cond_of_row(row) * NMOD;
        if (first) { const float* xr = row < MP ? a.in[I_XP] + (size_t)row * DM : a.in[I_XS] + (size_t)(row - MP) * DM;
#pragma unroll
            for (int j = 0; j < 8; ++j) v[j] = __builtin_nontemporal_load((const GAS f32x4*)(xr + 4 * (lane + 64 * j)));
        } else { const bf16* xr = X + (size_t)row * DM;
#pragma unroll
            for (int j = 0; j < 8; ++j) { const v2u w = *(const GAS v2u*)(xr + 4 * (lane + 64 * j)); v[j] = (f32x4){bf_lo(w.x), bf_hi(w.x), bf_lo(w.y), bf_hi(w.y)}; } }
#pragma unroll
        for (int j = 0; j < 8; ++j) {
            if (fix) { const int c = 4 * (lane + 64 * j); const v2u pw = __builtin_nontemporal_load((const GAS v2u*)(P0 + c)); v[j] = v[j] + *(const GAS f32x4*)(fg + c) * (f32x4){bf_lo(pw.x), bf_hi(pw.x), bf_lo(pw.y), bf_hi(pw.y)}; }
            ss += (v[j].x * v[j].x + v[j].y * v[j].y) + (v[j].z * v[j].z + v[j].w * v[j].w); }
        const float rs = rsqrtf(wave_sum(ss) * (1.f / DM) + EPS);
#pragma unroll
        for (int j = 0; j < 8; ++j) { const int c = 4 * (lane + 64 * j);
            const f32x4 gg = *(const GAS f32x4*)(g + c), sh = *(const GAS f32x4*)(md + c), sc = *(const GAS f32x4*)(md + DM + c);
            const f32x4 y = v[j] * rs * gg * (sc + 1.f) + sh;
            *(GAS v2u*)(H + (size_t)row * DM + c) = (v2u){pk2(y.x, y.y), pk2(y.z, y.w)};
            if (first || fix) *(GAS v2u*)(X + (size_t)row * DM + c) = (v2u){pk2(v[j].x, v[j].y), pk2(v[j].z, v[j].w)}; }
    }
}
__device__ __forceinline__ void final_fix_phase(const Args& a, const float* fixgate, int lane, int gw, int NGW) {
    OPAQUE_V(lane); PH_PTRS; OPAQUE_S(gw); OPAQUE_S(NGW);
    for (int row = MP + gw; row < MALL; row += NGW) {
        const bf16* P0 = (const bf16*)(ws + WS_S + S_PART) + (size_t)(row - MP) * DM; const float* fg = fixgate + (size_t)cond_of_row(row) * NMOD; float* xr = out + O_X + (size_t)row * DM;
#pragma unroll
        for (int j = 0; j < 8; ++j) { const int c = 4 * (lane + 64 * j); const v2u pw = *(const GAS v2u*)(P0 + c);
            *(GAS f32x4*)(xr + c) = *(const GAS f32x4*)(xr + c) + *(const GAS f32x4*)(fg + c) * (f32x4){bf_lo(pw.x), bf_hi(pw.x), bf_lo(pw.y), bf_hi(pw.y)}; }
    }
}
__device__ __forceinline__ void mla_thin_a(const Args& a, int j, int lane, int gw, int NGW) {
    OPAQUE_V(lane); PH_PTRS; OPAQUE_S(gw); OPAQUE_S(NGW);
    const bf16* QAKV = (const bf16*)(ws + WS_S + S_QAKV);
    bf16* QAN = (bf16*)(ws + WS_S + S_QAN); bf16* CKVN = (bf16*)(ws + WS_S + S_CKVN); float* KPE = (float*)(ws + WS_S + S_KPE); float* SSK = (float*)(ws + WS_SSK);
    const float* gqa = a.in[I_GQA] + (size_t)j * 768; const float* gkva = a.in[I_GKVA] + (size_t)j * 512;
    for (int row = gw; row < MKV; row += NGW) {
        if (row < MALL) {
            const bf16* r = QAKV + (size_t)row * 1536;
#define LD4(p_) ({ const v2u w_ = *(const GAS v2u*)(p_); (f32x4){bf_lo(w_.x), bf_hi(w_.x), bf_lo(w_.y), bf_hi(w_.y)}; })
            { f32x4 v[3]; float ss = 0.f;
#pragma unroll
              for (int i = 0; i < 3; ++i) { v[i] = LD4(r + 4 * (lane + 64 * i)); ss += (v[i].x * v[i].x + v[i].y * v[i].y) + (v[i].z * v[i].z + v[i].w * v[i].w); }
              const float rs = rsqrtf(wave_sum(ss) * (1.f / 768.f) + EPS);
#pragma unroll
              for (int i = 0; i < 3; ++i) { const int c = 4 * (lane + 64 * i); const f32x4 y = v[i] * rs * *(const GAS f32x4*)(gqa + c);
                  *(GAS v2u*)(QAN + (size_t)row * 768 + c) = (v2u){pk2(y.x, y.y), pk2(y.z, y.w)}; } }
            { f32x4 v[2]; float ss = 0.f;
#pragma unroll
              for (int i = 0; i < 2; ++i) { v[i] = LD4(r + 768 + 4 * (lane + 64 * i)); ss += (v[i].x * v[i].x + v[i].y * v[i].y) + (v[i].z * v[i].z + v[i].w * v[i].w); }
              const float rs = rsqrtf(wave_sum(ss) * (1.f / 512.f) + EPS);
#pragma unroll
              for (int i = 0; i < 2; ++i) { const int c = 4 * (lane + 64 * i); const f32x4 y = v[i] * rs * *(const GAS f32x4*)(gkva + c);
                  *(GAS v2u*)(CKVN + (size_t)row * 512 + c) = (v2u){pk2(y.x, y.y), pk2(y.z, y.w)};
                  if (row < MP) __builtin_nontemporal_store(y * DBG_SCALE, (GAS f32x4*)(out + O_CKV + ((size_t)((row >> 8) * 2 + j) * 256 + (row & 255)) * 512 + c)); } }
            { const float kp = __uint_as_float((unsigned)r[1280 + lane] << 16); KPE[(size_t)row * 64 + lane] = kp;
              if (row < MP) out[O_KPE + ((size_t)((row >> 8) * 2 + j) * 256 + (row & 255)) * 64 + lane] = kp * DBG_SCALE;
              const float s = wave_sum(kp * kp); if (lane == 0) SSK[row] = s; }
#undef LD4
        } else {
            const int cr = row - MALL, b = cr >> 8, t = cr & 255; const size_t src = (size_t)((b * 2 + j) * 256 + t);
            const float* ck = a.in[I_CCKV] + src * 512;
#pragma unroll
            for (int i = 0; i < 2; ++i) { const int c = 4 * (lane + 64 * i); const f32x4 y = *(const GAS f32x4*)(ck + c);
                *(GAS v2u*)(CKVN + (size_t)row * 512 + c) = (v2u){pk2(y.x, y.y), pk2(y.z, y.w)}; }
            const float kp = a.in[I_CKPE][src * 64 + lane]; KPE[(size_t)row * 64 + lane] = kp;
            const float s = wave_sum(kp * kp); if (lane == 0) SSK[row] = s;
        }
    }
}
namespace pg8 {
struct EpiF32 {
    static constexpr bool PERM = false;
    float* C; int ldc;
    __device__ __forceinline__ void operator()(const f32x4 (&acc)[2][2][4][2], const Unit& u, int wr, int wc, int fr, int fq) const {
        const int row0 = u.pm * BM + wr * 64 + fr, col0 = u.pn * BM + wc * 32 + 4 * fq;
#pragma unroll
        for (int ai = 0; ai < 2; ++ai)
#pragma unroll
            for (int m = 0; m < 4; ++m) { float* rowp = C + (size_t)(row0 + ai * HALF + m * 16) * ldc + col0;
#pragma unroll
                for (int bj = 0; bj < 2; ++bj)
#pragma unroll
                    for (int n = 0; n < 2; ++n) *(PG8_GAS f32x4*)(rowp + bj * HALF + n * 16) = acc[ai][bj][m][n]; }
    }
};
template <int ACT  > struct EpiBf16 {
    static constexpr bool PERM = true;
    bf16_t* O; int ldc;
    __device__ __forceinline__ void operator()(const f32x4 (&acc)[2][2][4][2], const Unit& u, int wr, int wc, int fr, int fq) const {
        const int row0 = u.pm * BM + wr * 64 + fr, col0 = u.pn * BM + wc * 32 + 8 * fq;
#pragma unroll
        for (int ai = 0; ai < 2; ++ai)
#pragma unroll
            for (int m = 0; m < 4; ++m) { bf16_t* rowp = O + (size_t)(row0 + ai * HALF + m * 16) * ldc + col0;
#pragma unroll
                for (int bj = 0; bj < 2; ++bj) { f32x4 v0 = acc[ai][bj][m][0], v1 = acc[ai][bj][m][1];
                    if (ACT == 1) {
#pragma unroll
                        for (int e = 0; e < 4; ++e) { const float x0 = fmaxf(v0[e], 0.f), x1 = fmaxf(v1[e], 0.f); v0[e] = x0 * x0; v1[e] = x1 * x1; } }
                    u32x4 w; w.x = cvt_pk_bf16(v0[0], v0[1]); w.y = cvt_pk_bf16(v0[2], v0[3]); w.z = cvt_pk_bf16(v1[0], v1[1]); w.w = cvt_pk_bf16(v1[2], v1[3]);
                    *(PG8_GAS u32x4*)(rowp + bj * HALF) = w; } }
    }
};
template <bool ATOMIC> struct EpiRes {
    static constexpr bool PERM = false;
    float* X; const float* gate;
    __device__ __forceinline__ void operator()(const f32x4 (&acc)[2][2][4][2], const Unit& u, int wr, int wc, int fr, int fq) const {
        const int rb = u.pm * BM, row0 = rb + wr * 64 + fr, col0 = u.pn * BM + wc * 32 + 4 * fq;
        const int cond = rb < 8192 ? 0 : 1 + ((rb - 8192) >> 11);
        const float* gp = gate + (size_t)cond * 12288 + col0;
        f32x4 gv[2][2];
#pragma unroll
        for (int bj = 0; bj < 2; ++bj)
#pragma unroll
            for (int n = 0; n < 2; ++n) gv[bj][n] = *(const PG8_GAS f32x4*)(gp + bj * HALF + n * 16);
#pragma unroll
        for (int ai = 0; ai < 2; ++ai)
#pragma unroll
            for (int m = 0; m < 4; ++m) { float* rowp = X + (size_t)(row0 + ai * HALF + m * 16) * 2048 + col0;
#pragma unroll
                for (int bj = 0; bj < 2; ++bj)
#pragma unroll
                    for (int n = 0; n < 2; ++n) { float* p = rowp + bj * HALF + n * 16; const f32x4 d = gv[bj][n] * acc[ai][bj][m][n];
                        if (ATOMIC) {
#pragma unroll
                            for (int e = 0; e < 4; ++e) __hip_atomic_fetch_add((PG8_GAS float*)(p + e), d[e], __ATOMIC_RELAXED, __HIP_MEMORY_SCOPE_AGENT);
                        } else { *(PG8_GAS f32x4*)p = *(const PG8_GAS f32x4*)p + d; } }
                asm volatile("" ::: "memory"); }
    }
};
struct EpiRes2 {
    static constexpr bool PERM = false;
    bf16_t* X; const float* gate; bf16_t* P; float* Yout;
    __device__ __forceinline__ void operator()(const f32x4 (&acc)[2][2][4][2], const Unit& u, int wr, int wc, int fr, int fq) const {
        typedef unsigned u32x2_ __attribute__((ext_vector_type(2)));
        const int rb = u.pm * BM, row0 = rb + wr * 64 + fr, col0 = u.pn * BM + wc * 32 + 4 * fq;
        if (u.part <= 0) {
            const int cond = rb < 8192 ? 0 : 1 + ((rb - 8192) >> 11);
            const float* gp = gate + (size_t)cond * 12288 + col0;
            f32x4 gv[2][2];
#pragma unroll
            for (int bj = 0; bj < 2; ++bj)
#pragma unroll
                for (int n = 0; n < 2; ++n) gv[bj][n] = *(const PG8_GAS f32x4*)(gp + bj * HALF + n * 16);
#pragma unroll
            for (int ai = 0; ai < 2; ++ai)
#pragma unroll
                for (int m = 0; m < 4; ++m) { const size_t ro = (size_t)(row0 + ai * HALF + m * 16) * 2048 + col0;
#pragma unroll
                    for (int bj = 0; bj < 2; ++bj)
#pragma unroll
                        for (int n = 0; n < 2; ++n) { const size_t o = ro + bj * HALF + n * 16; const u32x2_ w = *(const PG8_GAS u32x2_*)(X + o);
                            const f32x4 xn = (f32x4){__uint_as_float(w.x << 16), __uint_as_float(w.x & 0xffff0000u), __uint_as_float(w.y << 16), __uint_as_float(w.y & 0xffff0000u)} + gv[bj][n] * acc[ai][bj][m][n];
                            if (Yout != nullptr) *(PG8_GAS f32x4*)(Yout + o) = xn; else *(PG8_GAS u32x2_*)(X + o) = (u32x2_){cvt_pk_bf16(xn[0], xn[1]), cvt_pk_bf16(xn[2], xn[3])}; }
                    asm volatile("" ::: "memory"); }
        } else {
            bf16_t* Pp = P + (size_t)(row0 - 8192) * 2048 + col0;
#pragma unroll
            for (int ai = 0; ai < 2; ++ai)
#pragma unroll
                for (int m = 0; m < 4; ++m) { bf16_t* rowp = Pp + (size_t)(ai * HALF + m * 16) * 2048;
#pragma unroll
                    for (int bj = 0; bj < 2; ++bj)
#pragma unroll
                        for (int n = 0; n < 2; ++n) { const f32x4 v = acc[ai][bj][m][n]; *(PG8_GAS u32x2_*)(rowp + bj * HALF + n * 16) = (u32x2_){cvt_pk_bf16(v[0], v[1]), cvt_pk_bf16(v[2], v[3])}; } }
        }
    }
};
}
#ifndef DBG_REP_MASK
#define DBG_REP_MASK 0
#endif
namespace att {
using bf16x8 = __attribute__((ext_vector_type(8))) short;
using s16x4  = __attribute__((ext_vector_type(4))) short;
using f32x16 = __attribute__((ext_vector_type(16))) float;
using u32x4  = __attribute__((ext_vector_type(4))) unsigned;
constexpr int NW = 8, QBLK = 32, KVBLK = 64, DV = 128;
constexpr float THR = 8.f;
constexpr int SHM_V = KVBLK * DV * 2;
constexpr int RPB_OFF = 2 * SHM_V + 2 * KVBLK * 512 + 2048;
#define ATT_SBAR() __builtin_amdgcn_sched_barrier(0)
__device__ __forceinline__ int crow(int r, int hi) { return (r & 3) + 8 * (r >> 2) + 4 * hi; }
__device__ __forceinline__ unsigned cvtpk(float lo, float hi) { unsigned r; asm volatile("v_cvt_pk_bf16_f32 %0, %1, %2" : "=v"(r) : "v"(lo), "v"(hi)); return r; }
__device__ __forceinline__ int v_st(int k, int c) { const int kk = (k & ~0xC) | ((k & 4) << 1) | ((k & 8) >> 1); return ((kk >> 3) * 4 + (c >> 5)) * 512 + ((kk & 7) * 32 + (c & 31)) * 2; }
__device__ __forceinline__ int v_rd_base(int lane) { return ((lane & 3) << 3) | (((lane >> 2) & 3) << 6) | (((lane >> 4) & 1) << 5) | (((lane >> 5) & 1) << 8); }
constexpr int v_rd_off(int d0, int ks, int half) { return d0 * 512 + ks * 4096 + half * 2048; }
template <int OFF> __device__ __forceinline__ s16x4 tr_read(int vb) { s16x4 r; asm volatile("ds_read_b64_tr_b16 %0, %1 offset:%2" : "=&v"(r) : "v"(vb), "i"(OFF) : "memory"); return r; }
template <int D0> __device__ __forceinline__ void pv_one(f32x16& od, int vb, bf16x8 pa0, bf16x8 pa1, bf16x8 pa2, bf16x8 pa3) {
  const s16x4 l0 = tr_read<v_rd_off(D0, 0, 0)>(vb), h0 = tr_read<v_rd_off(D0, 0, 1)>(vb), l1 = tr_read<v_rd_off(D0, 1, 0)>(vb), h1 = tr_read<v_rd_off(D0, 1, 1)>(vb);
  const s16x4 l2 = tr_read<v_rd_off(D0, 2, 0)>(vb), h2 = tr_read<v_rd_off(D0, 2, 1)>(vb), l3 = tr_read<v_rd_off(D0, 3, 0)>(vb), h3 = tr_read<v_rd_off(D0, 3, 1)>(vb);
  asm volatile("s_waitcnt lgkmcnt(0)" ::: "memory"); ATT_SBAR();
#define ATT_PK(L, H) (bf16x8){L[0], L[1], L[2], L[3], H[0], H[1], H[2], H[3]}
  od = __builtin_amdgcn_mfma_f32_32x32x16_bf16(pa0, ATT_PK(l0, h0), od, 0, 0, 0);
  od = __builtin_amdgcn_mfma_f32_32x32x16_bf16(pa1, ATT_PK(l1, h1), od, 0, 0, 0);
  od = __builtin_amdgcn_mfma_f32_32x32x16_bf16(pa2, ATT_PK(l2, h2), od, 0, 0, 0);
  od = __builtin_amdgcn_mfma_f32_32x32x16_bf16(pa3, ATT_PK(l3, h3), od, 0, 0, 0);
#undef ATT_PK
}
__device__ __forceinline__ void pv_d0(f32x16* o, int vb, bf16x8 pa0, bf16x8 pa1, bf16x8 pa2, bf16x8 pa3) {
  pv_one<0>(o[0], vb, pa0, pa1, pa2, pa3); pv_one<1>(o[1], vb, pa0, pa1, pa2, pa3); pv_one<2>(o[2], vb, pa0, pa1, pa2, pa3); pv_one<3>(o[3], vb, pa0, pa1, pa2, pa3);
}
struct KvSrc { int row0, n0, row1, n1; __device__ __forceinline__ int row(int t) const { const int u = t - n0; return t < n0 ? row0 + 64 * t : row1 + 64 * (u < n1 ? u : n1 - 1); } };
struct NatMask { int rlo, qrow, qcol; const LAS float* rpb; };

template <int DQK, int MODE, int ldq, int ldk, int ldv, int ldo, int QP = 0>
__device__ __forceinline__ void attn_unit(const bf16* __restrict__ Qb, const bf16* __restrict__ Kh, const bf16* __restrict__ Vh,
                                          bf16* __restrict__ Ob, const KvSrc src, int NT, const NatMask nm, LAS char* lds, int tid,
                                          const float* __restrict__ qgain = nullptr, const float* __restrict__ qrope = nullptr) {
  constexpr float SCALE = DQK == 128 ? 0.088388347648318440f : 0.072168783648703220f;
  constexpr float C = SCALE * 1.4426950408889634f;
  constexpr int KROW = DQK == 128 ? 256 : 512  , SHM_K = KVBLK * KROW, NKC = DQK / 8, KCH = KVBLK * NKC / 512, ND0 = DQK / 16;
  const int wid = tid >> 6, lane = tid & 63, r32 = lane & 31, hi = lane >> 5;
  LAS char* V_lds = lds; LAS char* K_lds = lds + 2 * SHM_V;
  LAS float* ws = (LAS float*)(lds + 2 * SHM_V + 2 * SHM_K) + wid * 64; LAS float* li_l = ws; LAS float* al_l = ws + 32;
  float m_reg = -1e30f, l_reg = 0; f32x16 o[4] = {}; bf16x8 qr[ND0];
  { const bf16* Qw = Qb + (size_t)(wid * QBLK + r32) * ldq + hi * 8;
#pragma unroll
    for (int d0 = 0; d0 < ND0; ++d0) qr[d0] = *(const GAS bf16x8*)(Qw + d0 * 16); }
  if constexpr (QP == 1) {
    float ss = 0.f;
#pragma unroll
    for (int d0 = 0; d0 < ND0; ++d0) { const u32x4 w = __builtin_bit_cast(u32x4, qr[d0]);
#pragma unroll
      for (int e = 0; e < 4; ++e) { const float a = __uint_as_float(w[e] << 16), b = __uint_as_float(w[e] & 0xffff0000u); ss += a * a + b * b; } }
    ss += __shfl_xor(ss, 32);
    const float rs = rsqrtf(ss * (1.f / DQK) + 1e-6f);
    float xv[ND0 < 12 ? 1 : 4][8];
#pragma unroll
    for (int d0 = 0; d0 < ND0; ++d0) { const u32x4 w = __builtin_bit_cast(u32x4, qr[d0]);
      const f32x4 g0 = *(const GAS f32x4*)(qgain + d0 * 16 + hi * 8), g1 = *(const GAS f32x4*)(qgain + d0 * 16 + hi * 8 + 4);
      float x[8];
#pragma unroll
      for (int e = 0; e < 4; ++e) { x[2 * e] = __uint_as_float(w[e] << 16) * rs; x[2 * e + 1] = __uint_as_float(w[e] & 0xffff0000u) * rs; }
      x[0] *= g0.x; x[1] *= g0.y; x[2] *= g0.z; x[3] *= g0.w; x[4] *= g1.x; x[5] *= g1.y; x[6] *= g1.z; x[7] *= g1.w;
      if (ND0 == 12 && d0 >= 8) {
#pragma unroll
        for (int e = 0; e < 8; ++e) xv[ND0 < 12 ? 0 : d0 - 8][e] = x[e];
      } else { const u32x4 o_ = {cvtpk(x[0], x[1]), cvtpk(x[2], x[3]), cvtpk(x[4], x[5]), cvtpk(x[6], x[7])}; qr[d0] = __builtin_bit_cast(bf16x8, o_); } }
    if constexpr (ND0 == 12) {
#pragma unroll
      for (int pp = 0; pp < 2; ++pp) {
        float y1[8], y2[8];
#pragma unroll
        for (int e = 0; e < 8; ++e) { y1[e] = xv[pp][e]; y2[e] = xv[2 + pp][e]; }
        if (qrope != nullptr) { const float* rt = qrope + ((size_t)(wid * QBLK + r32) * 32 + 16 * pp + 8 * hi) * 2;
#pragma unroll
          for (int e2 = 0; e2 < 4; ++e2) { const f32x4 cs = *(const GAS f32x4*)(rt + 4 * e2);
            const float a0 = y1[2 * e2] * cs.x - y2[2 * e2] * cs.y, b0 = y1[2 * e2] * cs.y + y2[2 * e2] * cs.x;
            const float a1 = y1[2 * e2 + 1] * cs.z - y2[2 * e2 + 1] * cs.w, b1 = y1[2 * e2 + 1] * cs.w + y2[2 * e2 + 1] * cs.z;
            y1[2 * e2] = a0; y2[2 * e2] = b0; y1[2 * e2 + 1] = a1; y2[2 * e2 + 1] = b1; } }
        const u32x4 o1 = {cvtpk(y1[0], y1[1]), cvtpk(y1[2], y1[3]), cvtpk(y1[4], y1[5]), cvtpk(y1[6], y1[7])}, o2 = {cvtpk(y2[0], y2[1]), cvtpk(y2[2], y2[3]), cvtpk(y2[4], y2[5]), cvtpk(y2[6], y2[7])};
        qr[8 + pp] = __builtin_bit_cast(bf16x8, o1); qr[10 + pp] = __builtin_bit_cast(bf16x8, o2); }
    }
  }
  const int sr = tid >> 4, sc = (tid & 15) * 8, vst0 = v_st(sr, sc), vst1 = v_st(32 + sr, sc);
  unsigned koff_[KCH], kst_[KCH]; const unsigned voff0 = (unsigned)(sr * ldv + sc);
#pragma unroll
  for (int i = 0; i < KCH; ++i) { const int c = tid + 512 * i, kr = c / NKC, kc = c % NKC; koff_[i] = (unsigned)(kr * ldk + kc * 8); kst_[i] = (unsigned)(kr * KROW + ((kc * 16) ^ ((kr & 15) << 4))); }
  const int vb0 = (int)(uintptr_t)V_lds + v_rd_base(lane);
  bf16x8 svs0, svs1, sks[KCH];
#define ATT_SLOAD(t) do { const int _r = __builtin_amdgcn_readfirstlane(src.row(t)); const bf16* _vt = Vh + (size_t)_r * ldv; const bf16* _kt = Kh + (size_t)_r * ldk; \
    svs0 = *(const GAS bf16x8*)(_vt + voff0); svs1 = *(const GAS bf16x8*)(_vt + 32 * ldv + voff0); \
    _Pragma("unroll") for (int _i = 0; _i < KCH; ++_i) sks[_i] = *(const GAS bf16x8*)(_kt + koff_[_i]); } while (0)
#define ATT_SWRITE(b) do { *(LAS bf16x8*)(V_lds + (b) * SHM_V + vst0) = svs0; *(LAS bf16x8*)(V_lds + (b) * SHM_V + vst1) = svs1; \
    _Pragma("unroll") for (int _i = 0; _i < KCH; ++_i) *(LAS bf16x8*)(K_lds + (b) * SHM_K + kst_[_i]) = sks[_i]; } while (0)
#define ATT_RESC(a) do { if (__any((a) < 1.f)) { if (hi == 0) al_l[r32] = (a); asm volatile("s_waitcnt lgkmcnt(0)" ::: "memory"); \
    _Pragma("unroll") for (int d = 0; d < 4; ++d) _Pragma("unroll") for (int r = 0; r < 16; ++r) o[d][r] *= al_l[crow(r, hi)]; } } while (0)
  auto qkt = [&](f32x16& p0, f32x16& p1, int b, int t) {
    const LAS char* Ks = K_lds + b * SHM_K;
    p0 = f32x16{}; p1 = f32x16{};
    const LAS char* k0p = Ks + r32 * KROW; const LAS char* k1p = Ks + (32 + r32) * KROW; const int sw = (r32 & 15) << 4;
    bf16x8 ka[2], kb[2];
    ka[0] = *reinterpret_cast<const LAS bf16x8*>(k0p + ((hi * 16) ^ sw)); kb[0] = *reinterpret_cast<const LAS bf16x8*>(k1p + ((hi * 16) ^ sw));
#pragma unroll
    for (int d0 = 0; d0 < ND0; ++d0) {
      if (d0 + 1 < ND0) { const int cb = ((d0 + 1) * 16 + hi * 8) * 2;
        ka[(d0 + 1) & 1] = *reinterpret_cast<const LAS bf16x8*>(k0p + (cb ^ sw)); kb[(d0 + 1) & 1] = *reinterpret_cast<const LAS bf16x8*>(k1p + (cb ^ sw)); }
      __builtin_amdgcn_sched_barrier(0);
      p0 = __builtin_amdgcn_mfma_f32_32x32x16_bf16(ka[d0 & 1], qr[d0], p0, 0, 0, 0);
      p1 = __builtin_amdgcn_mfma_f32_32x32x16_bf16(kb[d0 & 1], qr[d0], p1, 0, 0, 0);
      __builtin_amdgcn_sched_barrier(0); }
    if constexpr (MODE == 1) {
      const int i = t - src.n0;
      if (i >= 0) {
        const int kr = nm.rlo + i, r0q = min(max(nm.qrow - 4, 0), 24), c0q = min(max(nm.qcol - 8, 0), 48);
        const bool rowok = (i < src.n1) && (kr >= r0q) && (kr < r0q + 8);
        const int rowoff = (kr - nm.qrow + 7) * 31 + 15 - nm.qcol;
#pragma unroll
        for (int r = 0; r < 16; ++r) {
          const int kc0 = crow(r, hi), kc1 = kc0 + 32;
          const bool ok0 = rowok && ((unsigned)(kc0 - c0q) < 16u), ok1 = rowok && ((unsigned)(kc1 - c0q) < 16u);
          const float b0 = nm.rpb[ok0 ? rowoff + kc0 : 0], b1 = nm.rpb[ok1 ? rowoff + kc1 : 0];
          p0[r] = ok0 ? p0[r] + b0 : -1e30f; p1[r] = ok1 ? p1[r] + b1 : -1e30f; }
      }
    }
  };
  auto partialSM = [&](f32x16& p0, f32x16& p1, float& mn, float& alpha) {
    float pmax = p0[0];
#pragma unroll
    for (int r = 1; r < 16; ++r) pmax = fmaxf(pmax, p0[r]);
#pragma unroll
    for (int r = 0; r < 16; ++r) pmax = fmaxf(pmax, p1[r]);
    { auto rr = __builtin_amdgcn_permlane32_swap(__float_as_uint(pmax), __float_as_uint(pmax), false, false); pmax = fmaxf(__uint_as_float(rr[0]), __uint_as_float(rr[1])); }
    if (__builtin_expect(__all(pmax - m_reg <= THR / SCALE), 1)) { mn = m_reg; alpha = 1.f; }
    else { mn = fmaxf(m_reg, pmax); alpha = __builtin_amdgcn_exp2f((m_reg - mn) * C); m_reg = mn; }
    const float mnC = -mn * C;
#pragma unroll
    for (int r = 0; r < 16; ++r) p0[r] = fmaf(p0[r], C, mnC);
#pragma unroll
    for (int r = 0; r < 16; ++r) p1[r] = fmaf(p1[r], C, mnC);
#pragma unroll
    for (int r = 0; r < 16; ++r) p0[r] = __builtin_amdgcn_exp2f(p0[r]);
  };
  auto finishSM = [&](f32x16& p0, f32x16& p1, float alpha, bf16x8& pa0, bf16x8& pa1, bf16x8& pa2, bf16x8& pa3) {
#pragma unroll
    for (int r = 0; r < 16; ++r) p1[r] = __builtin_amdgcn_exp2f(p1[r]);
    float ps = 0;
#pragma unroll
    for (int r = 0; r < 16; ++r) ps += p0[r];
#pragma unroll
    for (int r = 0; r < 16; ++r) ps += p1[r];
    { auto rr = __builtin_amdgcn_permlane32_swap(__float_as_uint(ps), __float_as_uint(ps), false, false); ps = __uint_as_float(rr[0]) + __uint_as_float(rr[1]); }
    l_reg = l_reg * alpha + ps;
#define ATT_PK4(P, BASE, OUT) do { unsigned a0 = cvtpk(P[BASE + 0], P[BASE + 1]), a1 = cvtpk(P[BASE + 2], P[BASE + 3]); \
    unsigned b0 = cvtpk(P[BASE + 4], P[BASE + 5]), b1 = cvtpk(P[BASE + 6], P[BASE + 7]); \
    auto r0 = __builtin_amdgcn_permlane32_swap(a0, b0, false, false); auto r1 = __builtin_amdgcn_permlane32_swap(a1, b1, false, false); \
    u32x4 w = {r0[0], r1[0], r0[1], r1[1]}; OUT = *reinterpret_cast<bf16x8*>(&w); } while (0)
    ATT_PK4(p0, 0, pa0); ATT_PK4(p0, 8, pa1); ATT_PK4(p1, 0, pa2); ATT_PK4(p1, 8, pa3);
#undef ATT_PK4
  };
  f32x16 p0, p1; float mn, al; bf16x8 pa0, pa1, pa2, pa3;
  ATT_SLOAD(0); asm volatile("s_waitcnt vmcnt(0)" ::: "memory"); ATT_SWRITE(0); if (NT > 1) ATT_SLOAD(1); __syncthreads();
  for (int t = 0; t < NT; ++t) {
    const int b = t & 1;
    ATT_SBAR(); qkt(p0, p1, b, t); ATT_SBAR();
    if (t + 1 < NT) { asm volatile("s_waitcnt vmcnt(0)" ::: "memory"); ATT_SWRITE(b ^ 1); if (t + 2 < NT) ATT_SLOAD(t + 2); }
    ATT_SBAR();
    partialSM(p0, p1, mn, al); ATT_RESC(al);
    finishSM(p0, p1, al, pa0, pa1, pa2, pa3); ATT_SBAR();
    pv_d0(o, vb0 + b * SHM_V, pa0, pa1, pa2, pa3);
    __syncthreads();
  }
  if (hi == 0) li_l[r32] = l_reg; asm volatile("s_waitcnt lgkmcnt(0)" ::: "memory");
  int hi_o = hi; asm volatile("" : "+v"(hi_o));
  bf16* Ow = Ob + (size_t)(wid * QBLK + 4 * hi_o) * ldo;
#pragma unroll
  for (int r = 0; r < 16; ++r) { const int orow = crow(r, 0); const float rl = __builtin_amdgcn_rcpf(li_l[orow + 4 * hi_o]);
#pragma unroll
    for (int d0 = 0; d0 < 4; ++d0) { const float v = o[d0][r] * rl; ((GAS bf16*)Ow)[(size_t)orow * ldo + d0 * 32 + r32] = (bf16)(cvtpk(v, v) & 0xffffu); } }
#undef ATT_SLOAD
#undef ATT_SWRITE
#undef ATT_RESC
}
}
namespace pg8 {
struct EpiKV {
    static constexpr bool PERM = true;
    bf16_t* KV; bf16_t* KF; const float* gkn; const float* KPE; const float* SSK; const float* RT; PG8_LAS float* tab;
    __device__ __forceinline__ void operator()(const f32x4 (&acc)[2][2][4][2], const Unit& u, int wr, int wc, int fr, int fq) const {
        const int h = u.pn, row0 = u.pm * BM + wr * 64 + fr, c8 = wc * 32 + 8 * fq;
        float sk[2][4];
#pragma unroll
        for (int ai = 0; ai < 2; ++ai)
#pragma unroll
            for (int m = 0; m < 4; ++m) { const f32x4 a = acc[ai][0][m][0], b = acc[ai][0][m][1]; sk[ai][m] = ((const PG8_GAS float*)SSK)[row0 + ai * HALF + m * 16];
                float s = (a[0] * a[0] + a[1] * a[1]) + (a[2] * a[2] + a[3] * a[3]) + (b[0] * b[0] + b[1] * b[1]) + (b[2] * b[2] + b[3] * b[3]);
                s += __shfl_xor(s, 16); s += __shfl_xor(s, 32);
                if (fq == 0) tab[(ai * HALF + wr * 64 + m * 16 + fr) * 4 + wc] = s; }
#pragma unroll
        for (int ai = 0; ai < 2; ++ai)
#pragma unroll
            for (int m = 0; m < 4; ++m) { const f32x4 v0 = acc[ai][1][m][0], v1 = acc[ai][1][m][1];
                u32x4 w; w.x = cvt_pk_bf16(v0[0], v0[1]); w.y = cvt_pk_bf16(v0[2], v0[3]); w.z = cvt_pk_bf16(v1[0], v1[1]); w.w = cvt_pk_bf16(v1[2], v1[3]);
                *(PG8_GAS u32x4*)(KV + (size_t)(row0 + ai * HALF + m * 16) * 4096 + h * 256 + 128 + c8) = w; }
        asm volatile("s_waitcnt lgkmcnt(0)" ::: "memory"); __builtin_amdgcn_s_barrier(); asm volatile("" ::: "memory");
        const f32x4 g0 = *(const PG8_GAS f32x4*)(gkn + c8), g1 = *(const PG8_GAS f32x4*)(gkn + c8 + 4);
#pragma unroll
        for (int ai = 0; ai < 2; ++ai)
#pragma unroll
            for (int m = 0; m < 4; ++m) { const int row = row0 + ai * HALF + m * 16; const f32x4 p = *(const PG8_LAS f32x4*)(tab + (ai * HALF + wr * 64 + m * 16 + fr) * 4);
                const float rs = rsqrtf(((p[0] + p[1]) + (p[2] + p[3]) + sk[ai][m]) * (1.f / 192.f) + 1e-6f);
                const f32x4 k0 = acc[ai][0][m][0] * rs * g0, k1 = acc[ai][0][m][1] * rs * g1;
                u32x4 w; w.x = cvt_pk_bf16(k0[0], k0[1]); w.y = cvt_pk_bf16(k0[2], k0[3]); w.z = cvt_pk_bf16(k1[0], k1[1]); w.w = cvt_pk_bf16(k1[2], k1[3]);
                *(PG8_GAS u32x4*)(KF + (size_t)row * 3072 + h * 192 + c8) = w; }
        { const int t_ = (wr * 4 + wc) * 64 + fq * 16 + fr, r = t_ >> 1, hf = t_ & 1, row = u.pm * BM + r;
          const f32x4 p = *(const PG8_LAS f32x4*)(tab + r * 4);
          const float rs = rsqrtf(((p[0] + p[1]) + (p[2] + p[3]) + ((const PG8_GAS float*)SSK)[row]) * (1.f / 192.f) + 1e-6f);
          const bool rot = row >= 8192 && row < 12288; const float* rt = RT + ((size_t)((row - 8192) & 2047) * 32 + 16 * hf) * 2;
          const float* kp = KPE + (size_t)row * 64 + 16 * hf; bf16_t* o = KF + (size_t)row * 3072 + h * 192 + 128 + 16 * hf;
#pragma unroll
          for (int q = 0; q < 2; ++q) {
              f32x4 a0 = *(const PG8_GAS f32x4*)(kp + 8 * q), a1 = *(const PG8_GAS f32x4*)(kp + 8 * q + 4), b0 = *(const PG8_GAS f32x4*)(kp + 32 + 8 * q), b1 = *(const PG8_GAS f32x4*)(kp + 32 + 8 * q + 4);
              a0 = a0 * rs * *(const PG8_GAS f32x4*)(gkn + 128 + 16 * hf + 8 * q); a1 = a1 * rs * *(const PG8_GAS f32x4*)(gkn + 128 + 16 * hf + 8 * q + 4);
              b0 = b0 * rs * *(const PG8_GAS f32x4*)(gkn + 160 + 16 * hf + 8 * q); b1 = b1 * rs * *(const PG8_GAS f32x4*)(gkn + 160 + 16 * hf + 8 * q + 4);
              float x1[8] = {a0[0], a0[1], a0[2], a0[3], a1[0], a1[1], a1[2], a1[3]}, x2[8] = {b0[0], b0[1], b0[2], b0[3], b1[0], b1[1], b1[2], b1[3]};
              if (rot) {
#pragma unroll
                  for (int e2 = 0; e2 < 4; ++e2) { const f32x4 cs = *(const PG8_GAS f32x4*)(rt + (8 * q + 2 * e2) * 2);
                      const float y0 = x1[2 * e2] * cs[0] - x2[2 * e2] * cs[1], z0 = x1[2 * e2] * cs[1] + x2[2 * e2] * cs[0];
                      const float y1 = x1[2 * e2 + 1] * cs[2] - x2[2 * e2 + 1] * cs[3], z1 = x1[2 * e2 + 1] * cs[3] + x2[2 * e2 + 1] * cs[2];
                      x1[2 * e2] = y0; x2[2 * e2] = z0; x1[2 * e2 + 1] = y1; x2[2 * e2 + 1] = z1; } }
              u32x4 w1, w2; w1.x = cvt_pk_bf16(x1[0], x1[1]); w1.y = cvt_pk_bf16(x1[2], x1[3]); w1.z = cvt_pk_bf16(x1[4], x1[5]); w1.w = cvt_pk_bf16(x1[6], x1[7]);
              w2.x = cvt_pk_bf16(x2[0], x2[1]); w2.y = cvt_pk_bf16(x2[2], x2[3]); w2.z = cvt_pk_bf16(x2[4], x2[5]); w2.w = cvt_pk_bf16(x2[6], x2[7]);
              *(PG8_GAS u32x4*)(o + 8 * q) = w1; *(PG8_GAS u32x4*)(o + 32 + 8 * q) = w2; } }
    }
};
}
__device__ __forceinline__ void rope_table(const Args& a, int tid, int vcu, int G) {
    f32x2* RT = (f32x2*)(a.ws + WS_ROPE);
    for (int e = vcu * NTHR + tid; e < 2048 * 32; e += G * NTHR) { const int t = e >> 5, i = e & 31;
        const float inv = exp2f(-(float)(i & 15) * (13.287712379549449f / 16.f));
        const float ang = (float)(i < 16 ? (t >> 6) : (t & 63)) * inv; float s, c; sincosf(ang, &s, &c); RT[e] = (f32x2){c, s}; }
}
__device__ __forceinline__ void mla_thin_b(const Args& a, int j, int lane, int gw, int NGW) {
    OPAQUE_V(lane); PH_PTRS; OPAQUE_S(gw); OPAQUE_S(NGW);
    const bf16* QRAW = (const bf16*)(ws + WS_S + S_QRAW); bf16* QN = (bf16*)(ws + WS_S + S_QN);
    const bf16* KVRAW = (const bf16*)(ws + WS_S + S_KVRAW); bf16* KF = (bf16*)(ws + WS_S + S_KF);
    const float* KPE = (const float*)(ws + WS_S + S_KPE); const float* SSK = (const float*)(ws + WS_SSK);
    const f32x2* RT = (const f32x2*)(ws + WS_ROPE);
    const float* gqn = a.in[I_GQN] + (size_t)j * 192; const float* gkn = a.in[I_GKN] + (size_t)j * 192;
    const int grp = lane >> 4, s = lane & 15;
    float gq[12], gk[12];
#pragma unroll
    for (int e = 0; e < 8; ++e) { gq[e] = gqn[8 * s + e]; gk[e] = gkn[8 * s + e]; }
    gq[8] = gqn[128 + 2 * s]; gq[9] = gqn[129 + 2 * s]; gq[10] = gqn[160 + 2 * s]; gq[11] = gqn[161 + 2 * s];
    gk[8] = gkn[128 + 2 * s]; gk[9] = gkn[129 + 2 * s]; gk[10] = gkn[160 + 2 * s]; gk[11] = gkn[161 + 2 * s];
    const int NQI = 0, NKI = MKV * 4;
    for (int it = gw; it < NQI + NKI; it += NGW) {
        const bool isq = it < NQI; const int r4 = isq ? it : it - NQI; const int row = r4 >> 2, h = (r4 & 3) * 4 + grp;
        float x[12];
        if (isq) {
            const bf16* p = QRAW + (size_t)row * 3072 + h * 192;
            const v4u w = *(const GAS v4u*)(p + 8 * s); const unsigned w1 = *(const GAS unsigned*)(p + 128 + 2 * s), w2 = *(const GAS unsigned*)(p + 160 + 2 * s);
            x[0] = bf_lo(w.x); x[1] = bf_hi(w.x); x[2] = bf_lo(w.y); x[3] = bf_hi(w.y); x[4] = bf_lo(w.z); x[5] = bf_hi(w.z); x[6] = bf_lo(w.w); x[7] = bf_hi(w.w);
            x[8] = bf_lo(w1); x[9] = bf_hi(w1); x[10] = bf_lo(w2); x[11] = bf_hi(w2);
        } else {
            const bf16* p = KVRAW + (size_t)row * 4096 + h * 256;
            const v4u w = *(const GAS v4u*)(p + 8 * s);
            x[0] = bf_lo(w.x); x[1] = bf_hi(w.x); x[2] = bf_lo(w.y); x[3] = bf_hi(w.y); x[4] = bf_lo(w.z); x[5] = bf_hi(w.z); x[6] = bf_lo(w.w); x[7] = bf_hi(w.w);
            const f32x2 k1 = *(const GAS f32x2*)(KPE + (size_t)row * 64 + 2 * s), k2 = *(const GAS f32x2*)(KPE + (size_t)row * 64 + 32 + 2 * s);
            x[8] = k1.x; x[9] = k1.y; x[10] = k2.x; x[11] = k2.y;
        }
        float ss = 0.f;
#pragma unroll
        for (int e = 0; e < 8; ++e) ss += x[e] * x[e];
        if (isq) { ss += x[8] * x[8] + x[9] * x[9] + x[10] * x[10] + x[11] * x[11]; ss = sum16(ss); }
        else { ss = sum16(ss) + SSK[row]; }
        const float rs = rsqrtf(ss * (1.f / 192.f) + EPS);
#pragma unroll
        for (int e = 0; e < 12; ++e) x[e] = x[e] * rs * (isq ? gq[e] : gk[e]);
        if (row >= MP && row < MALL) {
            const int t = (row - MP) & 2047; const f32x2 cs0 = RT[t * 32 + 2 * s], cs1 = RT[t * 32 + 2 * s + 1];
            const float a0 = x[8] * cs0.x - x[10] * cs0.y, b0 = x[8] * cs0.y + x[10] * cs0.x, a1 = x[9] * cs1.x - x[11] * cs1.y, b1 = x[9] * cs1.y + x[11] * cs1.x;
            x[8] = a0; x[9] = a1; x[10] = b0; x[11] = b1;
        }
        bf16* o = (isq ? QN : KF) + (size_t)row * 3072 + h * 192;
        *(GAS v4u*)(o + 8 * s) = (v4u){pk2(x[0], x[1]), pk2(x[2], x[3]), pk2(x[4], x[5]), pk2(x[6], x[7])};
        *(GAS unsigned*)(o + 128 + 2 * s) = pk2(x[8], x[9]); *(GAS unsigned*)(o + 160 + 2 * s) = pk2(x[10], x[11]);
    }
}
__device__ __forceinline__ void mla_attn_phase(const Args& a, int j, LAS unsigned char* lds, int tid, int vcu, int G) {
    OPAQUE_V(tid); PH_PTRS; OPAQUE_S(vcu); OPAQUE_S(G);
    const bf16* QN = (const bf16*)(ws + WS_S + S_QRAW); const bf16* KF = (const bf16*)(ws + WS_S + S_KF); const bf16* KVRAW = (const bf16*)(ws + WS_S + S_KVRAW);
    bf16* AO = (bf16*)(ws + WS_S + S_AO); const float* gqn = a.in[I_GQN] + (size_t)j * 192; const float* RT = (const float*)(ws + WS_ROPE);
    for (int u = vcu; u < 768; u += G) {
        int q0, h, NT; att::KvSrc src; const float* qrope = nullptr;
        if (u < 256) { const int b = u >> 7, qb = u & 7; h = (u >> 3) & 15; q0 = MP + b * 2048 + qb * 256; src = att::KvSrc{MP + b * 2048, 32, MALL + b * 256, 4}; NT = 36; qrope = RT + (size_t)(qb * 256) * 64; }
        else { const int v = u - 256, b = v >> 4; h = v & 15; q0 = b * 256; src = att::KvSrc{b * 256, 4, 0, 1}; NT = 4; }
        att::attn_unit<192, 0, 3072, 3072, 4096, DM, 1>(QN + (size_t)q0 * 3072 + h * 192, KF + h * 192, KVRAW + h * 256 + 128, AO + (size_t)q0 * DM + h * 128, src, NT, att::NatMask{0, 0, 0, nullptr}, (LAS char*)lds, tid, gqn, qrope);
    }
}
namespace pg8 {
struct EpiHg {
    static constexpr bool PERM = true;
    unsigned char* ws;
    __device__ __forceinline__ void operator()(const f32x4 (&acc)[2][2][4][2], const Unit& u, int wr, int wc, int fr, int fq) const {
        const int region = u.pn >> 3, row0 = u.pm * BM + wr * 64 + fr, col0 = (u.pn & 7) * BM + wc * 32 + 8 * fq;
        if (region == 1 || region == 2) {
            const int d = region - 1;
            f32x4 lbv[2][2];
#pragma unroll
            for (int bj = 0; bj < 2; ++bj)
#pragma unroll
                for (int n = 0; n < 2; ++n) lbv[bj][n] = *(const PG8_GAS f32x4*)((const float*)(ws + WS_LB) + d * 2048 + col0 + bj * HALF + 4 * n);
            bf16_t* K = (bf16_t*)(ws + WS_S + S_HK) + (size_t)d * 12288 * 2048; float* Gd = (float*)(ws + WS_U) + (size_t)d * 12288 * 2048;
#pragma unroll
            for (int ai = 0; ai < 2; ++ai)
#pragma unroll
                for (int m = 0; m < 4; ++m) { const size_t ro = (size_t)(row0 + ai * HALF + m * 16) * 2048 + col0;
#pragma unroll
                    for (int bj = 0; bj < 2; ++bj) { f32x4 kk[2], gg[2];
#pragma unroll
                        for (int n = 0; n < 2; ++n)
#pragma unroll
                            for (int e = 0; e < 4; ++e) { const float z = acc[ai][bj][m][n][e]; const float sn = __builtin_amdgcn_rcpf(1.f + __expf(z));
                                const float k = (1.f - lbv[bj][n][e]) * sn; kk[n][e] = k; gg[n][e] = __log2f(1.f - k); }
                        u32x4 w; w.x = cvt_pk_bf16(kk[0][0], kk[0][1]); w.y = cvt_pk_bf16(kk[0][2], kk[0][3]); w.z = cvt_pk_bf16(kk[1][0], kk[1][1]); w.w = cvt_pk_bf16(kk[1][2], kk[1][3]);
                        *(PG8_GAS u32x4*)(K + ro + bj * HALF) = w; *(PG8_GAS f32x4*)(Gd + ro + bj * HALF) = gg[0]; *(PG8_GAS f32x4*)(Gd + ro + bj * HALF + 4) = gg[1]; } }
        } else {
            bf16_t* O = (bf16_t*)(ws + WS_S + (region == 0 ? S_HQ : region == 3 ? S_HV : S_HGS)); const bool act = region != 3;
#pragma unroll
            for (int ai = 0; ai < 2; ++ai)
#pragma unroll
                for (int m = 0; m < 4; ++m) { bf16_t* rowp = O + (size_t)(row0 + ai * HALF + m * 16) * 2048 + col0;
#pragma unroll
                    for (int bj = 0; bj < 2; ++bj) { f32x4 v0 = acc[ai][bj][m][0], v1 = acc[ai][bj][m][1];
                        if (act) {
#pragma unroll
                            for (int e = 0; e < 4; ++e) { v0[e] = v0[e] * __builtin_amdgcn_rcpf(1.f + __expf(-v0[e])); v1[e] = v1[e] * __builtin_amdgcn_rcpf(1.f + __expf(-v1[e])); } }
                        u32x4 w; w.x = cvt_pk_bf16(v0[0], v0[1]); w.y = cvt_pk_bf16(v0[2], v0[3]); w.z = cvt_pk_bf16(v1[0], v1[1]); w.w = cvt_pk_bf16(v1[2], v1[3]);
                        *(PG8_GAS u32x4*)(rowp + bj * HALF) = w; } }
        }
    }
};
}

namespace hg {
constexpr int PQ = 272, PK = 80;
constexpr int OFF_QM = 0, OFF_KM = 32 * PQ, OFF_V = 2 * 32 * PQ, OFF_ATT = 3 * 32 * PQ, OFF_C2 = OFF_ATT + 32 * PK, OFF_C3 = OFF_C2 + 512, BUF = OFF_C3 + 512;
constexpr int OFF_TOT = 2 * BUF, TOT_BYTES = 8 * 128 * 4;
constexpr int OFF_OST = OFF_TOT + 2 * TOT_BYTES;
constexpr int OFF_STG = OFF_OST + 32 * PQ, STG_SLOT = 40960;
static_assert(OFF_STG + 2 * STG_SLOT <= LDSCTL_OFF, "scan LDS (must stay below the control words)");
typedef short bf16x8 __attribute__((ext_vector_type(8)));
typedef short s16x4 __attribute__((ext_vector_type(4)));
struct Chain { int rb, N, d, h; const float* S0; float* Sout; };
template <int OFF> __device__ __forceinline__ s16x4 tr_read(int addr) { s16x4 r; asm volatile("ds_read_b64_tr_b16 %0, %1 offset:%2" : "=&v"(r) : "v"(addr), "i"(OFF) : "memory"); return r; }
__device__ __forceinline__ unsigned bfmul2(unsigned w, float e0, float e1) { return pk2(bf_lo(w) * e0, bf_hi(w) * e1); }

__device__ __forceinline__ void scan_chain(const Chain ch, const bf16* __restrict__ HQ, const bf16* __restrict__ HK, const float* __restrict__ HG, const bf16* __restrict__ HV,
                                           bf16* __restrict__ OD, LAS unsigned char* lds, int tid) {
    const int lane = tid & 63, w = tid >> 6, l15 = lane & 15, q4 = lane >> 4;
    const int k2 = lane;
    const int vt = tid >> 4, v8 = (tid & 15) * 8;
    const int nc = ch.N >> 5, hc = ch.h * 128;
    f32x4 S[8];
    if (ch.S0) {
#pragma unroll
        for (int kt = 0; kt < 8; ++kt)
#pragma unroll
            for (int r = 0; r < 4; ++r) S[kt][r] = ((const GAS float*)ch.S0)[(size_t)(16 * kt + 4 * q4 + r) * 128 + 16 * w + l15];
    } else {
#pragma unroll
        for (int kt = 0; kt < 8; ++kt) S[kt] = (f32x4){0.f, 0.f, 0.f, 0.f};
    }
#define HG_ROW(c, t) (ch.rb + (ch.d ? ch.N - 1 - (32 * (c) + (t)) : 32 * (c) + (t)))
    struct InSet { f32x2 g[4]; unsigned q[4], k[4]; v4u v; };
    f32x2 cl[4]; unsigned cq[4], ck[4]; v4u cv;
#define HG_DMA(c) do { LAS unsigned char* sl_ = lds + OFF_STG + ((c) & 1) * STG_SLOT; \
        _Pragma("unroll") for (int i_ = 0; i_ < 2; ++i_) __builtin_amdgcn_global_load_lds((const unsigned*)(HG + (size_t)HG_ROW(c, 4 * w + 2 * i_ + (lane >> 5)) * 2048 + hc + (lane & 31) * 4), (LAS unsigned*)(sl_ + (4 * w + 2 * i_) * 512), 16, 0, 0); \
        { const size_t ro_ = (size_t)HG_ROW(c, 4 * w + (lane >> 4)) * 2048 + hc + (lane & 15) * 8; \
          __builtin_amdgcn_global_load_lds((const unsigned*)(HQ + ro_), (LAS unsigned*)(sl_ + 16384 + 4 * w * 256), 16, 0, 0); \
          __builtin_amdgcn_global_load_lds((const unsigned*)(HK + ro_), (LAS unsigned*)(sl_ + 24576 + 4 * w * 256), 16, 0, 0); \
          __builtin_amdgcn_global_load_lds((const unsigned*)(HV + ro_), (LAS unsigned*)(sl_ + 32768 + 4 * w * 256), 16, 0, 0); } } while (0)
#define HG_P1(c) do { const LAS unsigned char* sl_ = lds + OFF_STG + ((c) & 1) * STG_SLOT; f32x2 run = (f32x2){0.f, 0.f}; \
        _Pragma("unroll") for (int i = 0; i < 4; ++i) { run = run + *(const LAS f32x2*)(sl_ + (4 * w + i) * 512 + k2 * 8); cl[i] = run; cq[i] = *(const LAS unsigned*)(sl_ + 16384 + (4 * w + i) * 256 + k2 * 4); ck[i] = *(const LAS unsigned*)(sl_ + 24576 + (4 * w + i) * 256 + k2 * 4); } \
        cv = *(const LAS v4u*)(sl_ + 32768 + vt * 256 + v8 * 2); \
        *(LAS f32x2*)(lds + OFF_TOT + ((c) & 1) * TOT_BYTES + (w * 128 + 2 * k2) * 4) = run; } while (0)
    HG_DMA(0); HG_DMA(1);
    asm volatile("s_waitcnt vmcnt(0)" ::: "memory"); HG_P1(0); LDS_WAIT(); asm volatile("" ::: "memory");
    HG_DMA(2);
    LDS_WAIT(); __builtin_amdgcn_s_barrier(); asm volatile("" ::: "memory");
    const int traddr = (int)(uintptr_t)lds + (8 * q4 + (l15 >> 2)) * PQ + (l15 & 3) * 8;
    auto mstage = [&](const int pc) {
        { LAS unsigned char* B = lds + (pc & 1) * BUF; const int tb = traddr + (pc & 1) * BUF;
            const s16x4 v0 = tr_read<0>(tb + OFF_V + 32 * w), v1 = tr_read<4 * PQ>(tb + OFF_V + 32 * w);
            bf16x8 aat[2]; v2u aq0[2][4], aq1[2][4];
#pragma unroll
            for (int tt = 0; tt < 2; ++tt) { aat[tt] = *(const LAS bf16x8*)(B + OFF_ATT + (16 * tt + l15) * PK + 16 * q4);
#pragma unroll
                for (int ks = 0; ks < 4; ++ks) { aq0[tt][ks] = *(const LAS v2u*)(B + OFF_QM + (16 * tt + l15) * PQ + (32 * ks + 4 * q4) * 2); aq1[tt][ks] = *(const LAS v2u*)(B + OFF_QM + (16 * tt + l15) * PQ + (32 * ks + 16 + 4 * q4) * 2); } }
            f32x4 c2v[8];
#pragma unroll
            for (int kt = 0; kt < 8; ++kt) c2v[kt] = *(const LAS f32x4*)(B + OFF_C2 + (16 * kt + 4 * q4) * 4);
            LDS_WAIT(); __builtin_amdgcn_sched_barrier(0);
            const bf16x8 bv = (bf16x8){v0[0], v0[1], v0[2], v0[3], v1[0], v1[1], v1[2], v1[3]};
            f32x4 o2[2];
#pragma unroll
            for (int kt = 0; kt < 8; ++kt) S[kt] = S[kt] * c2v[kt];
#pragma unroll
            for (int tt = 0; tt < 2; ++tt) o2[tt] = __builtin_amdgcn_mfma_f32_16x16x32_bf16(aat[tt], bv, (f32x4){0.f, 0.f, 0.f, 0.f}, 0, 0, 0);
#pragma unroll
            for (int ks = 0; ks < 4; ++ks) {
                const v4u sb = (v4u){pk2(S[2 * ks][0], S[2 * ks][1]), pk2(S[2 * ks][2], S[2 * ks][3]), pk2(S[2 * ks + 1][0], S[2 * ks + 1][1]), pk2(S[2 * ks + 1][2], S[2 * ks + 1][3])};
                const bf16x8 bs = __builtin_bit_cast(bf16x8, sb);
#pragma unroll
                for (int tt = 0; tt < 2; ++tt) { const bf16x8 aq = __builtin_bit_cast(bf16x8, ((v4u){aq0[tt][ks].x, aq0[tt][ks].y, aq1[tt][ks].x, aq1[tt][ks].y}));
                    o2[tt] = __builtin_amdgcn_mfma_f32_16x16x32_bf16(aq, bs, o2[tt], 0, 0, 0); }
            }
            s16x4 ke0[8], ke1[8]; f32x4 elv[8];
#define HG_KRD(kt) ke0[kt] = tr_read<32 * (kt)>(tb + OFF_KM); ke1[kt] = tr_read<32 * (kt) + 4 * PQ>(tb + OFF_KM)
            HG_KRD(0); HG_KRD(1); HG_KRD(2); HG_KRD(3); HG_KRD(4); HG_KRD(5); HG_KRD(6); HG_KRD(7);
#undef HG_KRD
#pragma unroll
            for (int kt = 0; kt < 8; ++kt) elv[kt] = *(const LAS f32x4*)(B + OFF_C3 + (16 * kt + 4 * q4) * 4);
            LDS_WAIT(); __builtin_amdgcn_sched_barrier(0);
#pragma unroll
            for (int kt = 0; kt < 8; ++kt) { const bf16x8 ak = (bf16x8){ke0[kt][0], ke0[kt][1], ke0[kt][2], ke0[kt][3], ke1[kt][0], ke1[kt][1], ke1[kt][2], ke1[kt][3]};
                S[kt] = __builtin_amdgcn_mfma_f32_16x16x32_bf16(ak, bv, S[kt], 0, 0, 0) * elv[kt]; }
#pragma unroll
            for (int tt = 0; tt < 2; ++tt)
#pragma unroll
                for (int r = 0; r < 4; ++r) *(LAS unsigned short*)(lds + OFF_OST + (16 * tt + 4 * q4 + r) * PQ + (16 * w + l15) * 2) = (unsigned short)(pk2(o2[tt][r], 0.f) & 0xffffu);
        }
    };
    for (int c = 0; c < nc; ++c) {
        if (c > 0) mstage(c - 1);
        LAS unsigned char* B = lds + (c & 1) * BUF;
        { const LAS f32x2* T = (const LAS f32x2*)(lds + OFF_TOT + (c & 1) * TOT_BYTES) + k2;
          f32x2 off = (f32x2){0.f, 0.f}, cm = (f32x2){0.f, 0.f}, last = (f32x2){0.f, 0.f};
#pragma unroll
          for (int sgm = 0; sgm < 8; ++sgm) { const f32x2 tv = T[sgm * 64]; if (sgm < w) off = off + tv; if (sgm < 4) cm = cm + tv; last = last + tv; }
#pragma unroll
          for (int i = 0; i < 4; ++i) { const f32x2 cu = off + cl[i]; const int t = 4 * w + i;
              *(LAS unsigned*)(B + OFF_QM + t * PQ + k2 * 4) = bfmul2(cq[i], __builtin_amdgcn_exp2f(cu.x - cm.x), __builtin_amdgcn_exp2f(cu.y - cm.y));
              *(LAS unsigned*)(B + OFF_KM + t * PQ + k2 * 4) = bfmul2(ck[i], __builtin_amdgcn_exp2f(cm.x - cu.x), __builtin_amdgcn_exp2f(cm.y - cu.y));
 }
          if (w == 0) { *(LAS f32x2*)(B + OFF_C2 + k2 * 8) = (f32x2){__builtin_amdgcn_exp2f(cm.x), __builtin_amdgcn_exp2f(cm.y)}; *(LAS f32x2*)(B + OFF_C3 + k2 * 8) = (f32x2){__builtin_amdgcn_exp2f(last.x - cm.x), __builtin_amdgcn_exp2f(last.y - cm.y)}; }
          *(LAS v4u*)(B + OFF_V + vt * PQ + v8 * 2) = cv; }
        { asm volatile("s_waitcnt vmcnt(5)" ::: "memory"); HG_P1(c + 1); LDS_WAIT(); asm volatile("" ::: "memory");
          const int cn = c + 3 < nc ? c + 3 : nc - 1; HG_DMA(cn); }
        LDS_WAIT(); __builtin_amdgcn_s_barrier(); asm volatile("" ::: "memory");
        if (c > 0) *(GAS v4u*)(OD + (size_t)HG_ROW(c - 1, vt) * 2048 + hc + v8) = *(const LAS v4u*)(lds + OFF_OST + vt * PQ + v8 * 2);
        if (w < 4) {
            const int tt = w >> 1, st = w & 1; f32x4 at = (f32x4){0.f, 0.f, 0.f, 0.f};
            if (!(tt == 0 && st == 1)) {
                bf16x8 af[4], bfr[4];
#pragma unroll
                for (int ks = 0; ks < 4; ++ks) { af[ks] = *(const LAS bf16x8*)(B + OFF_QM + (16 * tt + l15) * PQ + (32 * ks + 8 * q4) * 2); bfr[ks] = *(const LAS bf16x8*)(B + OFF_KM + (16 * st + l15) * PQ + (32 * ks + 8 * q4) * 2); }
                LDS_WAIT(); __builtin_amdgcn_sched_barrier(0);
#pragma unroll
                for (int ks = 0; ks < 4; ++ks) at = __builtin_amdgcn_mfma_f32_16x16x32_bf16(af[ks], bfr[ks], at, 0, 0, 0);
            }
            const int s_ = 16 * st + l15;
#pragma unroll
            for (int r = 0; r < 4; ++r) { const int t = 16 * tt + 4 * q4 + r; const float val = (s_ <= t) ? at[r] : 0.f;
                *(LAS unsigned short*)(B + OFF_ATT + t * PK + s_ * 2) = (unsigned short)(pk2(val, 0.f) & 0xffffu); }
        }
        LDS_WAIT(); __builtin_amdgcn_s_barrier(); asm volatile("" ::: "memory");
    }
    mstage(nc - 1);
    LDS_WAIT(); __builtin_amdgcn_s_barrier(); asm volatile("" ::: "memory");
    *(GAS v4u*)(OD + (size_t)HG_ROW(nc - 1, vt) * 2048 + hc + v8) = *(const LAS v4u*)(lds + OFF_OST + vt * PQ + v8 * 2);
    if (ch.Sout) {
#pragma unroll
        for (int kt = 0; kt < 8; ++kt)
#pragma unroll
            for (int r = 0; r < 4; ++r) __builtin_nontemporal_store(S[kt][r] * DBG_SCALE, (GAS float*)ch.Sout + (size_t)(16 * kt + 4 * q4 + r) * 128 + 16 * w + l15);
    }
    __builtin_amdgcn_s_barrier();
#undef HG_ROW
#undef HG_LOAD
#undef HG_P1
}
}

__device__ __forceinline__ void hg_scan_phase(const Args& a, LAS unsigned char* lds, int tid, int vcu, int G) {
    OPAQUE_V(tid); PH_PTRS; OPAQUE_S(vcu); OPAQUE_S(G);
    const bf16* HQ = (const bf16*)(ws + WS_S + S_HQ); const bf16* HK = (const bf16*)(ws + WS_S + S_HK); const float* HGp = (const float*)(ws + WS_U);
    const bf16* HV = (const bf16*)(ws + WS_S + S_HV); bf16* OF = (bf16*)(ws + WS_S + S_OF);
    const int NS = G > 128 ? 64 : 0;
    const int first = vcu < NS ? vcu : NS + (vcu - NS), step = vcu < NS ? 1088 : G - NS;
    const int reps = ((DBG_REP_MASK >> 16) & 1) && vcu < NS ? 3 : ((DBG_REP_MASK >> 17) & 1) && vcu >= NS ? 3 : 1;
    for (int rep_ = 0; rep_ < reps; ++rep_)
    for (int ci = first; ci < 1088; ci += step) {
        const bool lat = ci < 64; const int e = lat ? ci : ci - 64, b = e >> 5, d = (e >> 4) & 1, h = e & 15;
        const size_t so = ((size_t)((b * 2 + d) * 16 + h)) * 16384;
        hg::Chain ch{lat ? MP + b * 2048 : b * 256, lat ? 2048 : 256, d, h, lat ? a.in[I_SHG] + so : nullptr, lat ? nullptr : out + O_HG + so};
        hg::scan_chain(ch, HQ, HK + (size_t)d * MALL * DM, HGp + (size_t)d * MALL * DM, HV, OF + (size_t)d * MALL * DM, lds, tid);
    }
}

__device__ __forceinline__ void hg_thin_c(const Args& a, int lane, int gw, int NGW) {
    OPAQUE_V(lane); PH_PTRS; OPAQUE_S(gw); OPAQUE_S(NGW);
    const bf16* OF = (const bf16*)(ws + WS_S + S_OF); const bf16* HGS = (const bf16*)(ws + WS_S + S_HGS); bf16* AO = (bf16*)(ws + WS_S + S_AO);
    const int grp = lane >> 4, s = lane & 15;
    const f32x4 g0 = *(const GAS f32x4*)(a.in[I_GHO] + 8 * s), g1 = *(const GAS f32x4*)(a.in[I_GHO] + 8 * s + 4);
    for (int it = gw; it < MALL * 4; it += NGW) {
        const int row = it >> 2, h = (it & 3) * 4 + grp; const size_t o_ = (size_t)row * DM + h * 128 + 8 * s;
        const v4u of = *(const GAS v4u*)(OF + o_), ob = *(const GAS v4u*)(OF + (size_t)MALL * DM + o_);
        const f32x4 a0 = (f32x4){bf_lo(of.x) + bf_lo(ob.x), bf_hi(of.x) + bf_hi(ob.x), bf_lo(of.y) + bf_lo(ob.y), bf_hi(of.y) + bf_hi(ob.y)}, a1 = (f32x4){bf_lo(of.z) + bf_lo(ob.z), bf_hi(of.z) + bf_hi(ob.z), bf_lo(of.w) + bf_lo(ob.w), bf_hi(of.w) + bf_hi(ob.w)};
        float ss = (a0.x * a0.x + a0.y * a0.y) + (a0.z * a0.z + a0.w * a0.w) + (a1.x * a1.x + a1.y * a1.y) + (a1.z * a1.z + a1.w * a1.w);
        const float rs = rsqrtf(sum16(ss) * (1.f / 128.f) + EPS);
        const v4u gw_ = *(const GAS v4u*)(HGS + o_);
        const f32x4 y0 = a0 * rs * g0 * (f32x4){bf_lo(gw_.x), bf_hi(gw_.x), bf_lo(gw_.y), bf_hi(gw_.y)}, y1 = a1 * rs * g1 * (f32x4){bf_lo(gw_.z), bf_hi(gw_.z), bf_lo(gw_.w), bf_hi(gw_.w)};
        *(GAS v4u*)(AO + o_) = (v4u){pk2(y0.x, y0.y), pk2(y0.z, y0.w), pk2(y1.x, y1.y), pk2(y1.z, y1.w)};
    }
}
namespace pg8 {
struct EpiNat {
    static constexpr bool PERM = true;
    bf16_t* QKV; bf16_t* KN; float* outk; float* outv; const float* gk; PG8_LAS float* tab;
    __device__ __forceinline__ void operator()(const f32x4 (&acc)[2][2][4][2], const Unit& u, int wr, int wc, int fr, int fq) const {
        const int region = u.pn >> 3, row0 = u.pm * BM + wr * 64 + fr, ct = (u.pn & 7) * BM + wc * 32 + 8 * fq;
        if (region == 1) {
#pragma unroll
            for (int ai = 0; ai < 2; ++ai)
#pragma unroll
                for (int m = 0; m < 4; ++m)
#pragma unroll
                    for (int bj = 0; bj < 2; ++bj) { const f32x4 a = acc[ai][bj][m][0], b = acc[ai][bj][m][1];
                        float s = (a[0] * a[0] + a[1] * a[1]) + (a[2] * a[2] + a[3] * a[3]) + (b[0] * b[0] + b[1] * b[1]) + (b[2] * b[2] + b[3] * b[3]);
                        s += __shfl_xor(s, 16); s += __shfl_xor(s, 32);
                        if (fq == 0) tab[((ai * HALF + wr * 64 + m * 16 + fr) * 2 + bj) * 4 + wc] = s; }
            asm volatile("s_waitcnt lgkmcnt(0)" ::: "memory"); __builtin_amdgcn_s_barrier(); asm volatile("" ::: "memory");
            f32x4 g0[2], g1[2];
#pragma unroll
            for (int bj = 0; bj < 2; ++bj) { g0[bj] = *(const PG8_GAS f32x4*)(gk + wc * 32 + 8 * fq); g1[bj] = *(const PG8_GAS f32x4*)(gk + wc * 32 + 8 * fq + 4); }
#pragma unroll
            for (int ai = 0; ai < 2; ++ai)
#pragma unroll
                for (int m = 0; m < 4; ++m) { const int row = row0 + ai * HALF + m * 16;
#pragma unroll
                    for (int bj = 0; bj < 2; ++bj) { const f32x4 p = *(const PG8_LAS f32x4*)(tab + ((ai * HALF + wr * 64 + m * 16 + fr) * 2 + bj) * 4);
                        const float rs = rsqrtf(((p[0] + p[1]) + (p[2] + p[3])) * (1.f / 128.f) + 1e-6f);
                        const f32x4 k0 = acc[ai][bj][m][0] * rs * g0[bj], k1 = acc[ai][bj][m][1] * rs * g1[bj];
                        u32x4 w; w.x = cvt_pk_bf16(k0[0], k0[1]); w.y = cvt_pk_bf16(k0[2], k0[3]); w.z = cvt_pk_bf16(k1[0], k1[1]); w.w = cvt_pk_bf16(k1[2], k1[3]);
                        *(PG8_GAS u32x4*)(KN + (size_t)row * 2048 + ct + bj * HALF) = w;
                        if (row < 8192) { __builtin_nontemporal_store(k0 * DBG_SCALE, (PG8_GAS f32x4*)(outk + (size_t)row * 2048 + ct + bj * HALF)); __builtin_nontemporal_store(k1 * DBG_SCALE, (PG8_GAS f32x4*)(outk + (size_t)row * 2048 + ct + bj * HALF + 4)); } } }
        } else {
#pragma unroll
            for (int ai = 0; ai < 2; ++ai)
#pragma unroll
                for (int m = 0; m < 4; ++m) { const int row = row0 + ai * HALF + m * 16;
#pragma unroll
                    for (int bj = 0; bj < 2; ++bj) { const f32x4 v0 = acc[ai][bj][m][0], v1 = acc[ai][bj][m][1];
                        u32x4 w; w.x = cvt_pk_bf16(v0[0], v0[1]); w.y = cvt_pk_bf16(v0[2], v0[3]); w.z = cvt_pk_bf16(v1[0], v1[1]); w.w = cvt_pk_bf16(v1[2], v1[3]);
                        *(PG8_GAS u32x4*)(QKV + (size_t)row * 6144 + region * 2048 + ct + bj * HALF) = w;
                        if (region == 2 && row < 8192) { __builtin_nontemporal_store(v0 * DBG_SCALE, (PG8_GAS f32x4*)(outv + (size_t)row * 2048 + ct + bj * HALF)); __builtin_nontemporal_store(v1 * DBG_SCALE, (PG8_GAS f32x4*)(outv + (size_t)row * 2048 + ct + bj * HALF + 4)); } } }
        }
    }
};
}
__device__ __forceinline__ void nat_cache_rows(const Args& a, int lane, int gw, int NGW) {
    OPAQUE_V(lane); PH_PTRS; OPAQUE_S(gw); OPAQUE_S(NGW);
    bf16* QKV = (bf16*)(ws + WS_S + S_NQKV); bf16* KN = (bf16*)(ws + WS_S + S_NKN);
    for (int it = gw; it < 512 * 4; it += NGW) {
        const int row = MALL + (it >> 2), c = (it & 3) * 512 + 8 * lane; const size_t so = (size_t)(row - MALL) * DM + c;
        const f32x4 k0 = *(const GAS f32x4*)(a.in[I_CNK] + so), k1 = *(const GAS f32x4*)(a.in[I_CNK] + so + 4), v0 = *(const GAS f32x4*)(a.in[I_CNV] + so), v1 = *(const GAS f32x4*)(a.in[I_CNV] + so + 4);
        *(GAS v4u*)(KN + (size_t)row * DM + c) = (v4u){pk2(k0.x, k0.y), pk2(k0.z, k0.w), pk2(k1.x, k1.y), pk2(k1.z, k1.w)};
        *(GAS v4u*)(QKV + (size_t)row * 6144 + 4096 + c) = (v4u){pk2(v0.x, v0.y), pk2(v0.z, v0.w), pk2(v1.x, v1.y), pk2(v1.z, v1.w)};
    }
}
__device__ __forceinline__ void nat_attn_phase(const Args& a, LAS unsigned char* lds, int tid, int vcu, int G) {
    OPAQUE_V(tid); PH_PTRS; OPAQUE_S(vcu); OPAQUE_S(G);
    const bf16* QKV = (const bf16*)(ws + WS_S + S_NQKV); const bf16* KN = (const bf16*)(ws + WS_S + S_NKN); bf16* AO = (bf16*)(ws + WS_S + S_AO); const float* gq = a.in[I_GNQ];
    LAS float* rpb = (LAS float*)(lds + att::RPB_OFF);
    for (int u = vcu; u < 768; u += G) {
        if (u < 256) {
            const int b = u >> 7, h = (u >> 3) & 15, i = u & 7, q0 = MP + b * 2048 + i * 256;
            const int rlo = min(max(4 * i - 4, 0), 24), rhi = min(max(4 * i - 1, 0), 24) + 8, nrows = rhi - rlo;
            __syncthreads();
            for (int e = tid; e < 465; e += NTHR) rpb[e] = a.in[I_RPB][h * 465 + e] * 11.313708498984761f;
            __syncthreads();
            const att::KvSrc src{MALL + b * 256, 4, MP + b * 2048 + 64 * rlo, nrows};
            const att::NatMask nm{rlo, 4 * i + ((tid >> 6) >> 1), 32 * ((tid >> 6) & 1) + (tid & 31), rpb};
            att::attn_unit<128, 1, 6144, DM, 6144, DM, 1>(QKV + (size_t)q0 * 6144 + h * 128, KN + h * 128, QKV + 4096 + h * 128, AO + (size_t)q0 * DM + h * 128, src, 4 + nrows, nm, (LAS char*)lds, tid, gq, nullptr);
        } else {
            const int v = u - 256, b = v >> 4, h = v & 15, q0 = b * 256;
            const att::KvSrc src{b * 256, 4, 0, 1};
            att::attn_unit<128, 0, 6144, DM, 6144, DM, 1>(QKV + (size_t)q0 * 6144 + h * 128, KN + h * 128, QKV + 4096 + h * 128, AO + (size_t)q0 * DM + h * 128, src, 4, att::NatMask{0, 0, 0, nullptr}, (LAS char*)lds, tid, gq, nullptr);
        }
    }
}
constexpr int NPHASE = 2 + 10 * DEPTH;
__host__ __device__ constexpr bool phase_exists(int ph) {
    if (ph == 0 || ph == NPHASE - 1) return true;
    const int l = (ph - 1) / 10, k = (ph - 1) % 10, kind = l % 3;
    if (k == 2) return kind != 2;
    if (k == 3) return kind == 0;
    if (k == 4) return kind == 1;
    if (k == 5) return kind != 1;
    return true;
}

__global__ void __launch_bounds__(NTHR, 2) fwd(Args a) {
    extern __shared__ __attribute__((aligned(16))) unsigned char lds_[];
    LAS unsigned char* lds = (LAS unsigned char*)lds_;
#define tid ({ int t_ = threadIdx.x; asm volatile("" : "+v"(t_)); t_; })
#define lane (tid & 63)
#define wave (__builtin_amdgcn_readfirstlane(tid >> 6))
    const int G = gridDim.x, bx = blockIdx.x, vcu = (G % 8 == 0) ? (bx % 8) * (G / 8) + bx / 8 : bx;
    const int NGW = G * NWAVES;
#define gw (vcu * NWAVES + wave)
    volatile LAS unsigned* MISC = (volatile LAS unsigned*)(lds + MISC_OFF);
    unsigned* ctl = (unsigned*)(a.ws + WS_CTL);
    for (int u = tid; u < (LDS_BYTES - LDSCTL_OFF) / 4; u += NTHR) ((LAS unsigned*)(lds + LDSCTL_OFF))[u] = 0u;
    __syncthreads();
    XcdBarrier bar; bar.bar = ctl + CW_BAR; bar.x = 0; bar.st = nullptr;
    if (MK_SINGLE) bar = xcd_barrier_post(ctl + CW_BAR, MISC + 8);
    const int lo = a.ph_lo, hi = a.ph_hi;
#define IN(k) (lo <= (k) && (k) < hi)
#ifndef DBG_REP_MASK
#define DBG_REP_MASK 0
#endif
#define REPEAT(id) for (int rep_ = 0; rep_ < (((DBG_REP_MASK >> (id)) & 1) ? 3 : 1); ++rep_)
#if defined(DBG_PROF)
    { unsigned long long* prof = (unsigned long long*)((unsigned char*)ctl + WS_PROF); float* po_ = a.out;
      if (bx == 0 && tid == 0) { prof[200] = (unsigned long long)*(volatile unsigned*)(po_ + O_END - 1); prof[100] = wall_clock64(); prof[300] = clock64(); } }
#define SEAM(k) do { if (MK_SINGLE && (k) + 1 < hi) xcd_barrier(bar); if (bx == 0 && tid == 0) { unsigned long long* prof = (unsigned long long*)((unsigned char*)bar.bar - CW_BAR * 4 + WS_PROF); prof[100 + (k) + 1] = wall_clock64(); prof[300 + (k) + 1] = clock64(); } } while (0)
#else
#define SEAM(k) do { if (MK_SINGLE && (k) + 1 < hi) xcd_barrier(bar); } while (0)
#endif
#define GEMM_PTRS PH_PTRS; int gG = G, gbx = bx; OPAQUE_S(gG); OPAQUE_S(gbx); bf16* const H = (bf16*)(ws + WS_H); bf16* const U = (bf16*)(ws + WS_U); bf16* const AO = (bf16*)(ws + WS_S + S_AO); bf16* const X = (bf16*)(ws + WS_S + S_X); \
    const float* const MODS = (const float*)(ws + WS_MODS); (void)H; (void)U; (void)AO; (void)X; (void)MODS

#define CONVERT_WINDOW(lo_, hi_, nunits) do { const int from_ = (nunits) % gG; if (!from_ || gbx >= from_) p0_convert_range(a, lds, lo_, hi_, (gbx - from_) * NWAVES + wave, (gG - from_) * NWAVES, lane, wave); } while (0)

    if (IN(0)) { REPEAT(0) { p0_prologue(a, lds, tid, lane, wave, vcu, G); rope_table(a, tid, vcu, G); if (DBG_REP_MASK & 1) __syncthreads(); } SEAM(0); }

    for (int l = 0; l < DEPTH; ++l) {
        const int kind = l % 3, j = l / 3, pb = 1 + 10 * l;
        if (IN(pb + 0)) { REPEAT(1) norm_phase(a, l, false, l > 0 ? (const float*)(a.ws + WS_MODS) + (size_t)(l - 1) * 3 * NMOD + 5 * DM : nullptr, lane, gw, NGW); if (kind == 2) nat_cache_rows(a, lane, gw, NGW); SEAM(pb + 0); }
        if (kind == 0) {
            if (IN(pb + 1)) {
                GEMM_PTRS; unsigned char* wm = ws + WS_WMLA + (size_t)j * WMLA_STRIDE;
                pg8::Gemm g{H, (const bf16*)wm, MALL, 1536, DM, DM, DM, 1}; pg8::QaOrder S; S.init(gG, gbx, g.K);
                pg8::EpiBf16<0> E{(bf16*)(ws + WS_S + S_QAKV), 1536};
                REPEAT(2) pg8::gemm_phase<pg8::EpiBf16<0>, pg8::QaOrder>(lds, g, S, E);
                CONVERT_WINDOW(a.wstart[l + 1], a.wmid[l + 1], 288);
                SEAM(pb + 1);
            }
            if (IN(pb + 2)) { REPEAT(3) mla_thin_a(a, j, lane, gw, NGW); SEAM(pb + 2); }
            if (IN(pb + 3)) {
                GEMM_PTRS; unsigned char* wm = ws + WS_WMLA + (size_t)j * WMLA_STRIDE;
                REPEAT(4) {
                { pg8::Gemm g{(const bf16*)(ws + WS_S + S_QAN), (const bf16*)(wm + WMLA_QB), MALL, 3072, 768, 768, 768, 1}; pg8::StaticOrder S; S.init(MALL, 3072, 1, gG, gbx, g.K);
                  pg8::EpiBf16<0> E{(bf16*)(ws + WS_S + S_QRAW), 3072};
                  pg8::gemm_phase<pg8::EpiBf16<0>, pg8::StaticOrder>(lds, g, S, E); }
                { pg8::Gemm g{(const bf16*)(ws + WS_S + S_CKVN), (const bf16*)(wm + WMLA_KVB), MKV, 4096, 512, 512, 512, 1}; pg8::StaticOrder S; S.init(MKV, 4096, 1, gG, (gbx + gG / 2) % gG, g.K);
                  pg8::EpiKV E{(bf16*)(ws + WS_S + S_KVRAW), (bf16*)(ws + WS_S + S_KF), a.in[I_GKN] + (size_t)j * 192, (const float*)(ws + WS_S + S_KPE), (const float*)(ws + WS_SSK), (const float*)(ws + WS_ROPE), (LAS float*)(lds + EPI_TAB_OFF)};
                  pg8::gemm_phase<pg8::EpiKV, pg8::StaticOrder>(lds, g, S, E); }
                }
                {
                    int p_ = gbx, np_ = gG;
                    if (gG == 256) { p_ = gbx < 64 ? -1 : gbx < 128 ? gbx - 64 : gbx < 160 ? -1 : gbx - 96; np_ = 160; }
                    if (p_ >= 0) p0_convert_range(a, lds, a.wmid[l + 1], a.wstart[l + 2], p_ * NWAVES + wave, np_ * NWAVES, lane, wave);
                }
                SEAM(pb + 3);
            }
            if (IN(pb + 5)) { REPEAT(6) mla_attn_phase(a, j, lds, tid, vcu, G); SEAM(pb + 5); }
        }
        if (kind == 1) {
            if (IN(pb + 1)) {
                GEMM_PTRS;
                pg8::Gemm g{H, (const bf16*)(ws + WS_WHG), MALL, 10240, DM, DM, DM, 1}; pg8::StaticOrder S; S.init(MALL, 10240, 1, gG, gbx, g.K);
                pg8::EpiHg E{ws};
                REPEAT(8) pg8::gemm_phase<pg8::EpiHg, pg8::StaticOrder, false>(lds, g, S, E);
                CONVERT_WINDOW(a.wstart[l + 1], a.wstart[l + 2], 1920);
                SEAM(pb + 1);
            }
            if (IN(pb + 2)) { REPEAT(9) hg_scan_phase(a, lds, tid, vcu, G); SEAM(pb + 2); }
            if (IN(pb + 4)) { REPEAT(10) hg_thin_c(a, lane, gw, NGW); SEAM(pb + 4); }
        }
        if (kind == 2) {
            if (IN(pb + 1)) {
                GEMM_PTRS;
                pg8::Gemm g{H, (const bf16*)(ws + WS_WNAT), MALL, 6144, DM, DM, DM, 1}; pg8::StaticOrder S; S.init(MALL, 6144, 1, gG, gbx, g.K);
                pg8::EpiNat E{(bf16*)(ws + WS_S + S_NQKV), (bf16*)(ws + WS_S + S_NKN), out + O_NK, out + O_NV, a.in[I_GNK], (LAS float*)(lds + EPI_TAB_OFF)};
                REPEAT(11) pg8::gemm_phase<pg8::EpiNat, pg8::StaticOrder>(lds, g, S, E);
                CONVERT_WINDOW(a.wstart[l + 1], a.wstart[l + 2], 1152);
                SEAM(pb + 1);
            }
            if (IN(pb + 5)) { REPEAT(13) nat_attn_phase(a, lds, tid, vcu, G); SEAM(pb + 5); }
        }
        if (IN(pb + 6)) {
            GEMM_PTRS;
            const bf16* wo = (const bf16*)(kind == 0 ? ws + WS_WMLA + (size_t)j * WMLA_STRIDE + WMLA_WO : kind == 1 ? ws + WS_WHG + WHG_WO : ws + WS_WNAT + WNAT_WO);
            pg8::Gemm g{AO, wo, MALL, DM, DM / 2, DM, DM, 2}; pg8::ResOrder S; S.init(gG, gbx, DM);
            pg8::EpiRes2 E{X, MODS + (size_t)l * 3 * NMOD + 2 * DM, (bf16*)(ws + WS_S + S_PART), nullptr};
            pg8::gemm_phase<pg8::EpiRes2, pg8::ResOrder>(lds, g, S, E);
            SEAM(pb + 6);
        }
        if (IN(pb + 7)) { REPEAT(1) norm_phase(a, l, true, (const float*)(a.ws + WS_MODS) + (size_t)l * 3 * NMOD + 2 * DM, lane, gw, NGW); SEAM(pb + 7); }
        if (IN(pb + 8)) {
            GEMM_PTRS;
            pg8::Gemm g{H, (const bf16*)(ws + WS_WFF1) + (size_t)l * DM * FF, MALL, FF, DM, DM, DM, 1}; pg8::StaticOrder S; S.init(MALL, FF, 1, gG, gbx, g.K);
            pg8::EpiBf16<1> E{U, FF};
            REPEAT(7) pg8::gemm_phase<pg8::EpiBf16<1>, pg8::StaticOrder>(lds, g, S, E);
            SEAM(pb + 8);
        }
        if (IN(pb + 9)) {
            GEMM_PTRS;
            pg8::Gemm g{U, (const bf16*)(ws + WS_WFF2) + (size_t)l * DM * FF, MALL, DM, FF / 2, FF, FF, 2}; pg8::ResOrder S; S.init(gG, gbx, FF);
            pg8::EpiRes2 E{X, MODS + (size_t)l * 3 * NMOD + 5 * DM, (bf16*)(ws + WS_S + S_PART), l + 1 == DEPTH ? out + O_X : nullptr};
            pg8::gemm_phase<pg8::EpiRes2, pg8::ResOrder>(lds, g, S, E);
            SEAM(pb + 9);
        }
    }
    if (IN(NPHASE - 1)) final_fix_phase(a, (const float*)(a.ws + WS_MODS) + (size_t)(DEPTH - 1) * 3 * NMOD + 5 * DM, lane, gw, NGW);
#if defined(DBG_PROF)
    xcd_barrier(bar);
    { unsigned long long* prof = (unsigned long long*)((unsigned char*)bar.bar - CW_BAR * 4 + WS_PROF); float* po_ = a.out;
    if (bx == 0) {
        if (tid == 0) { prof[100 + NPHASE] = wall_clock64(); prof[300 + NPHASE] = clock64(); }
        __syncthreads();
        if (tid == 0) { constexpr int p = DBG_PROF; const unsigned long long dw = prof[100 + p + 1] - prof[100 + p], dc = prof[300 + p + 1] - prof[300 + p];
            float mant = (float)dw * 1e-4f; mant = mant < 1.f ? 1.f : mant > 9.9f ? 9.9f : mant; const int expo = dw ? (int)(dc / dw) : 0;
            po_[O_X + 7] = mant * __builtin_powif(10.f, expo); }
    } }
#endif
#undef IN
#undef SEAM
#undef tid
#undef lane
#undef wave
#undef gw
}

extern "C" void kernel_launch(void* const* d_in, const int* in_sizes, int n_in, void* d_out, int out_size, void* d_ws, size_t ws_size, hipStream_t stream) {
    static int grid = 0;
    if (grid == 0) {
        if (n_in != N_IN || (size_t)out_size != O_END || ws_size < WS_END) { fprintf(stderr, "kernel_launch: shape mismatch n_in %d out %d ws %zu (need %zu); nothing launched\n", n_in, out_size, ws_size, (size_t)WS_END); grid = -1; return; }
        int dev = 0, cus = 0, per_cu = 0;
        if (hipGetDevice(&dev) != hipSuccess || hipDeviceGetAttribute(&cus, hipDeviceAttributeMultiprocessorCount, dev) != hipSuccess) { fprintf(stderr, "kernel_launch: device query failed\n"); grid = -1; return; }
        if (hipFuncSetAttribute((const void*)fwd, hipFuncAttributeMaxDynamicSharedMemorySize, LDS_BYTES) != hipSuccess) { fprintf(stderr, "kernel_launch: hipFuncSetAttribute failed\n"); grid = -1; return; }
        if (hipOccupancyMaxActiveBlocksPerMultiprocessor(&per_cu, (const void*)fwd, NTHR, LDS_BYTES) != hipSuccess || per_cu < 1) { fprintf(stderr, "kernel_launch: occupancy query says %d blocks/CU\n", per_cu); }
        (void)hipGetLastError();
        grid = cus;
    }
    if (grid < 0) return;
    if (hipMemsetAsync((char*)d_ws + WS_CTL, 0, CTL_ZERO_BYTES, stream) != hipSuccess) { fprintf(stderr, "kernel_launch: memset failed\n"); return; }
    Args a{};
    for (int i = 0; i < N_IN; ++i) a.in[i] = (const float*)d_in[i];
    a.out = (float*)d_out; a.ws = (unsigned char*)d_ws;
    int nt = 0, items = 0;
    auto add = [&](const float* src, size_t dst_off, int K, int N, int row_off) { TJob& t = a.tj[nt++]; t.src = src; t.dst = (bf16*)((unsigned char*)d_ws + dst_off); t.K = K; t.N = N; t.row_off = row_off; t.start = items; items += (K / 64) * (N / 32); };
    auto add_mixer = [&](int l) {
        if (l % 3 == 0) { const int j = l / 3; const size_t wb = WS_WMLA + (size_t)j * WMLA_STRIDE;
            add(a.in[I_WQA] + (size_t)j * DM * 768, wb, DM, 768, 0); add(a.in[I_WKVA] + (size_t)j * DM * 576, wb, DM, 576, 768);
            add(a.in[I_WQB] + (size_t)j * 768 * 3072, wb + WMLA_QB, 768, 3072, 0); add(a.in[I_WKVB] + (size_t)j * 512 * 4096, wb + WMLA_KVB, 512, 4096, 0);
            add(a.in[I_WMO] + (size_t)j * DM * DM, wb + WMLA_WO, DM, DM, 0); }
        if (l % 3 == 1) { add(a.in[I_WHQ], WS_WHG, DM, DM, 0); add(a.in[I_WHF], WS_WHG, DM, DM, 2048); add(a.in[I_WHF] + (size_t)DM * DM, WS_WHG, DM, DM, 4096);
            add(a.in[I_WHI], WS_WHG, DM, DM, 6144); add(a.in[I_WHG], WS_WHG, DM, DM, 8192); add(a.in[I_WHO], WS_WHG + WHG_WO, DM, DM, 0); }
        if (l % 3 == 2) { add(a.in[I_WNQKV], WS_WNAT, DM, 3 * DM, 0); add(a.in[I_WNO], WS_WNAT + WNAT_WO, DM, DM, 0); } };
    a.wstart[0] = 0; add_mixer(0);
    for (int l = 0; l < DEPTH; ++l) {
        a.wstart[l + 1] = items;
        add(a.in[I_WFF1] + (size_t)l * DM * FF, WS_WFF1 + (size_t)l * DM * FF * 2, DM, FF, 0); add(a.in[I_WFF2] + (size_t)l * DM * FF, WS_WFF2 + (size_t)l * DM * FF * 2, FF, DM, 0);
        if (l + 1 < DEPTH) add_mixer(l + 1);
    }
    for (int w = DEPTH + 1; w < 8; ++w) a.wstart[w] = items;
    for (int w = 0; w < 8; ++w) a.wmid[w] = a.wstart[w];
    for (int l = 0; l < DEPTH; ++l) if (l % 3 == 0) {
        const int from = 288 % grid, part = (from ? grid - from : grid) * NWAVES; long n = (long)WQA * part; const long tot = a.wstart[l + 2] - a.wstart[l + 1]; if (n > tot) n = tot;
        a.wmid[l + 1] = a.wstart[l + 1] + (int)n; }
    a.ntj = nt; a.nitems = items;
#if MK_SINGLE
    a.ph_lo = 0; a.ph_hi = NPHASE < MK_LAST_PHASE ? NPHASE : MK_LAST_PHASE;
    hipLaunchKernelGGL(fwd, dim3(grid), dim3(NTHR), LDS_BYTES, stream, a);
#else
    for (int ph = 0; ph < NPHASE && ph < MK_LAST_PHASE; ++ph) {
        if (!phase_exists(ph)) continue;
        a.ph_lo = ph; a.ph_hi = ph + 1;
        hipLaunchKernelGGL(fwd, dim3(grid), dim3(NTHR), LDS_BYTES, stream, a);
    }
#endif
    const hipError_t le = hipPeekAtLastError();
    if (le != hipSuccess) fprintf(stderr, "kernel_launch: launch failed: %s\n", hipGetErrorName(le));
}
```

```cpp
#define MK_SINGLE 1
#define MK_LAST_PHASE 1000
#include <hip/hip_runtime.h>
#include <cstdio>
#include <cstdint>

#ifndef MK_SINGLE
#define MK_SINGLE 1
#endif
#ifndef WQA
#define WQA 12
#endif
#ifndef MK_LAST_PHASE
#define MK_LAST_PHASE 1000
#endif
namespace pg8 {
#define PG8_LAS __attribute__((address_space(3)))
#define PG8_GAS __attribute__((address_space(1)))
typedef unsigned short bf16_t;
typedef short bf16x8 __attribute__((ext_vector_type(8)));
typedef float f32x4 __attribute__((ext_vector_type(4)));
typedef unsigned u32x4 __attribute__((ext_vector_type(4)));
constexpr int BM = 256, BK = 64, HALF = 128, HTB = HALF * BK * 2  , STAGE_BYTES = 8 * HTB, NXCD = 8, WGM = 8;

__host__ __device__ __forceinline__ int lds_byte(int r, int c) { const int st = (r >> 4) * 2 + (c >> 5), rr = r & 15, cc = c & 31, ob = rr * 64 + cc * 2; return st * 1024 + (ob ^ (((ob >> 9) & 1) << 5)); }
__host__ __device__ __forceinline__ void stage_rc(int b, int& R, int& C) { const int st = b / 1024, sb = b % 1024, swz = sb ^ (((sb >> 9) & 1) << 5); R = (st >> 1) * 16 + swz / 64; C = (st & 1) * 32 + (swz % 64) / 2; }
__host__ __device__ __forceinline__ int perm32(int rho) { const int n = rho >> 4, i = rho & 15; return 8 * (i >> 2) + 4 * n + (i & 3); }

struct Unit { int pm, pn, ks, nkt, part, nh; };
struct Gemm { const bf16_t* A; const bf16_t* Bt; int M, N, K, lda, ldb, nsplit; };

struct StaticOrder {
    static constexpr bool HAS_NH = false;
    int nM, nN, nNv, nwg, G, c, nkt, split;
    __host__ __device__ void init(int M, int N, int nsplit, int G_, int c_, int K = 0) { nM = M / BM; nN = N / BM; nNv = nN * nsplit; nwg = nM * nNv; G = G_; c = c_; nkt = K / BK; split = nsplit; }
    __host__ __device__ bool next(int i, Unit& u) const {
        const long L = (long)i * G + c; if (L >= nwg) return false;
        int wgid = (int)L; { const int q = nwg / NXCD, r = nwg % NXCD, xcd = wgid % NXCD, off = wgid / NXCD; wgid = (xcd < r ? xcd * (q + 1) : r * (q + 1) + (xcd - r) * q) + off; }
        const int nig = WGM * nNv, gid = wgid / nig, fm = gid * WGM, gsz = (nM - fm) < WGM ? (nM - fm) : WGM;
        u.pm = fm + ((wgid % nig) % gsz); const int pv = (wgid % nig) / gsz; u.pn = pv % nN; u.ks = pv / nN; u.nkt = nkt; u.part = split > 1 ? u.ks : -1; u.nh = 0; return true;
    }
    __device__ __forceinline__ void a_ready(const Unit&) const {}
    __device__ __forceinline__ void done(const Unit&) const {}
};

struct QaOrder {
    static constexpr bool HAS_NH = true;
    StaticOrder M5; int G, c, nkt;
    __host__ __device__ void init(int G_, int c_, int K) { M5.init(12288, 1280, 1, G_, c_, K); G = G_; c = c_; nkt = K / BK; }
    __host__ __device__ bool next(int i, Unit& u) const {
        const int L = i * G + c;
        if (L < 240) return M5.next(i, u);
        if (L >= 288) return false;
        u.pm = L - 240; u.pn = 5; u.ks = 0; u.nkt = nkt; u.part = -1; u.nh = 1; return true;
    }
    __device__ __forceinline__ void a_ready(const Unit&) const {}
    __device__ __forceinline__ void done(const Unit&) const {}
};
struct ResOrder {
    static constexpr bool HAS_NH = false;
    int G, c, nkF, nkH;
    __host__ __device__ void init(int G_, int c_, int K) { G = G_; c = c_; nkF = K / BK; nkH = K / (2 * BK); }
    __host__ __device__ bool next(int i, Unit& u) const {
        const int L = i * G + c; if (L >= 512) return false;
        const bool half = L >= 256; int w = half ? L - 256 : L;
        w = (w & 7) * 32 + (w >> 3);
        const int sh = half ? 7 : 6, e = w & ((1 << sh) - 1), pv = e >> 3;
        u.pm = (half ? 32 : 0) + ((w >> sh) << 3) + (e & 7); u.pn = pv & 7; u.ks = pv >> 3; u.nkt = half ? nkH : nkF; u.part = half ? u.ks : -1; u.nh = 0; return true;
    }
    __device__ __forceinline__ void a_ready(const Unit&) const {}
    __device__ __forceinline__ void done(const Unit&) const {}
};

__device__ __forceinline__ unsigned cvt_pk_bf16(float lo, float hi) { unsigned r; asm("v_cvt_pk_bf16_f32 %0, %1, %2" : "=v"(r) : "v"(lo), "v"(hi)); return r; }


template <class Epi, class Sched, bool ALIGN_EPI = true, bool SP2 = true>
__device__ __forceinline__ void gemm_phase(PG8_LAS unsigned char* lds, const Gemm g, const Sched& S, const Epi& E) {
    int tid_ = threadIdx.x; asm volatile("" : "+v"(tid_));
    const int tid = tid_, wid = __builtin_amdgcn_readfirstlane(tid >> 6), lane = tid & 63, wr = wid >> 2, wc = wid & 3, fr = lane & 15, fq = lane >> 4;
    const int K = g.K;
    unsigned voffA[2], voffB[2];
#pragma unroll
    for (int i = 0; i < 2; ++i) { int R, C; stage_rc(tid * 16 + i * 8192, R, C); const int Rb = Epi::PERM ? ((R & ~31) + perm32(R & 31)) : R;
        voffA[i] = (unsigned)(R * g.lda + C) * 2u; voffB[i] = (unsigned)(Rb * g.ldb + C) * 2u; }
    const size_t kstep = (size_t)(BK * 2);
    const size_t hstepA = (size_t)HALF * g.lda * 2, hstepB = (size_t)HALF * g.ldb * 2;
    const size_t tstepA = 2 * hstepA, tstepB = 2 * hstepB;
    const size_t sstep = (size_t)K * 2;
    const unsigned ldsw = (unsigned)wid * 1024u;
    const int aoff = lds_byte(wr * 64 + fr, fq * 8), boff = lds_byte(wc * 32 + fr, fq * 8);
#define PG8_SA(b, h) (((b) * 2 + (h)) * HTB)
#define PG8_SB(b, h) ((4 + (b) * 2 + (h)) * HTB)
#define PG8_STAGE(bufoff, gbase, voff) do { _Pragma("unroll") for (int _i = 0; _i < 2; ++_i) \
        __builtin_amdgcn_global_load_lds((const unsigned*)((const char*)(gbase) + (voff)[_i]), (PG8_LAS unsigned*)(lds + (bufoff) + ldsw + _i * 8192), 16, 0, 0); } while (0)
#define PG8_LDA(dst, b, h) do { _Pragma("unroll") for (int m = 0; m < 4; ++m) _Pragma("unroll") for (int k = 0; k < 2; ++k) dst[m][k] = *(const PG8_LAS bf16x8*)(lds + PG8_SA(b, h) + aoff + m * 2048 + k * 1024); } while (0)
#define PG8_LDB(dst, b, h) do { _Pragma("unroll") for (int n = 0; n < 2; ++n) _Pragma("unroll") for (int k = 0; k < 2; ++k) dst[n][k] = *(const PG8_LAS bf16x8*)(lds + PG8_SB(b, h) + boff + n * 2048 + k * 1024); } while (0)
#define PG8_MMA(ai, bj, At, Bt) do { __builtin_amdgcn_s_setprio(1); _Pragma("unroll") for (int m = 0; m < 4; ++m) _Pragma("unroll") for (int n = 0; n < 2; ++n) _Pragma("unroll") for (int k = 0; k < 2; ++k) \
        acc[ai][bj][m][n] = __builtin_amdgcn_mfma_f32_16x16x32_bf16(Bt[n][k], At[m][k], acc[ai][bj][m][n], 0, 0, 0); __builtin_amdgcn_s_setprio(0); } while (0)
#define PG8_WAIT_V(n) asm volatile("s_waitcnt vmcnt(" #n ")" ::: "memory")
#define PG8_WAIT_L(n) asm volatile("s_waitcnt lgkmcnt(" #n ")" ::: "memory")
#define PG8_BAR __builtin_amdgcn_s_barrier()
#define PG8_SCHED __builtin_amdgcn_sched_barrier(0)
    Unit cur, nxt; int ui = 0;
    if (!S.next(0, cur)) return;
    f32x4 acc[2][2][4][2];
#pragma unroll
    for (int a = 0; a < 2; ++a)
#pragma unroll
        for (int b = 0; b < 2; ++b)
#pragma unroll
            for (int m = 0; m < 4; ++m)
#pragma unroll
                for (int n = 0; n < 2; ++n) acc[a][b][m][n] = (f32x4){0.f, 0.f, 0.f, 0.f};
    bf16x8 At[4][2], B0[2][2], B1[2][2];
    const char* cA = (const char*)g.A + (size_t)cur.pm * tstepA + (size_t)cur.ks * sstep; const char* cB = (const char*)g.Bt + (size_t)cur.pn * tstepB + (size_t)cur.ks * sstep;
    S.a_ready(cur);
    if constexpr (SP2) {
        PG8_STAGE(PG8_SB(0, 0), cB, voffB); PG8_STAGE(PG8_SB(0, 1), cB + hstepB, voffB); PG8_STAGE(PG8_SA(0, 0), cA, voffA); PG8_STAGE(PG8_SA(0, 1), cA + hstepA, voffA);
        if (wr == 1) PG8_BAR;
        PG8_WAIT_V(2); PG8_BAR;
        PG8_STAGE(PG8_SB(1, 0), cB + kstep, voffB); PG8_STAGE(PG8_SA(1, 0), cA + kstep, voffA); PG8_STAGE(PG8_SB(1, 1), cB + hstepB + kstep, voffB);
        PG8_WAIT_V(6); PG8_BAR;
    } else {
        PG8_STAGE(PG8_SB(0, 0), cB, voffB); PG8_STAGE(PG8_SA(0, 0), cA, voffA); PG8_STAGE(PG8_SB(0, 1), cB + hstepB, voffB); PG8_STAGE(PG8_SA(0, 1), cA + hstepA, voffA);
        if (wr == 1) PG8_BAR;
        PG8_WAIT_V(4); PG8_BAR;
        PG8_STAGE(PG8_SB(1, 0), cB + kstep, voffB); PG8_STAGE(PG8_SA(1, 0), cA + kstep, voffA); PG8_STAGE(PG8_SB(1, 1), cB + hstepB + kstep, voffB);
        PG8_WAIT_V(6); PG8_BAR;
    }
    for (;;) {
        const bool has_next = S.next(ui + 1, nxt);
        const char* nA = has_next ? (const char*)g.A + (size_t)nxt.pm * tstepA + (size_t)nxt.ks * sstep : cA; const char* nB = has_next ? (const char*)g.Bt + (size_t)nxt.pn * tstepB + (size_t)nxt.ks * sstep : cB;
        const int nt = cur.nkt; const bool nh = cur.nh != 0;
        for (int t = 0; t < nt; t += 2) {
            const bool last = (t == nt - 2);
            const char* a1 = cA + (size_t)(t + 1) * kstep;
            const char* a2 = last ? nA : cA + (size_t)(t + 2) * kstep; const char* b2 = last ? nB : cB + (size_t)(t + 2) * kstep;
            const char* a3 = a2 + kstep; const char* b3 = b2 + kstep;
            if (last && has_next) S.a_ready(nxt);
            if constexpr (SP2) {
            PG8_LDB(B0, 0, 0); PG8_LDB(B1, 0, 1); PG8_SCHED; PG8_LDA(At, 0, 0); PG8_STAGE(PG8_SA(1, 1), a1 + hstepA, voffA);
            PG8_WAIT_V(8); PG8_WAIT_L(0); PG8_BAR; PG8_MMA(0, 0, At, B0); if (!Sched::HAS_NH || !nh) PG8_MMA(0, 1, At, B1); PG8_BAR; PG8_SCHED;
            PG8_LDA(At, 0, 1); PG8_STAGE(PG8_SB(0, 0), b2, voffB); PG8_STAGE(PG8_SB(0, 1), b2 + hstepB, voffB); PG8_STAGE(PG8_SA(0, 0), a2, voffA);
            PG8_WAIT_V(8); PG8_WAIT_L(0); PG8_BAR; PG8_MMA(1, 0, At, B0); if (!Sched::HAS_NH || !nh) PG8_MMA(1, 1, At, B1); PG8_BAR; PG8_SCHED;
            PG8_LDB(B0, 1, 0); PG8_LDB(B1, 1, 1); PG8_SCHED; PG8_LDA(At, 1, 0); PG8_STAGE(PG8_SA(0, 1), a2 + hstepA, voffA);
            PG8_WAIT_V(8); PG8_WAIT_L(0); PG8_BAR; PG8_MMA(0, 0, At, B0); if (!Sched::HAS_NH || !nh) PG8_MMA(0, 1, At, B1); PG8_BAR; PG8_SCHED;
            PG8_LDA(At, 1, 1); PG8_STAGE(PG8_SB(1, 0), b3, voffB); PG8_STAGE(PG8_SB(1, 1), b3 + hstepB, voffB); PG8_STAGE(PG8_SA(1, 0), a3, voffA);
            PG8_WAIT_V(8); PG8_WAIT_L(0); PG8_BAR; PG8_MMA(1, 0, At, B0); if (!Sched::HAS_NH || !nh) PG8_MMA(1, 1, At, B1); PG8_BAR; PG8_SCHED;
            } else {
            PG8_LDB(B0, 0, 0); PG8_SCHED; PG8_LDA(At, 0, 0); PG8_STAGE(PG8_SA(1, 1), a1 + hstepA, voffA);
            PG8_WAIT_L(8); PG8_BAR; PG8_WAIT_L(0); PG8_MMA(0, 0, At, B0); PG8_BAR; PG8_SCHED;
            PG8_LDB(B1, 0, 1); PG8_STAGE(PG8_SB(0, 0), b2, voffB);
            PG8_BAR; PG8_WAIT_L(0); PG8_MMA(0, 1, At, B1); PG8_BAR;
            PG8_LDA(At, 0, 1); PG8_STAGE(PG8_SA(0, 0), a2, voffA);
            PG8_BAR; PG8_WAIT_L(0); PG8_MMA(1, 0, At, B0); PG8_BAR; PG8_SCHED;
            PG8_STAGE(PG8_SB(0, 1), b2 + hstepB, voffB);
            PG8_WAIT_V(6); PG8_BAR; PG8_MMA(1, 1, At, B1); PG8_BAR;
            PG8_LDB(B0, 1, 0); PG8_SCHED; PG8_LDA(At, 1, 0); PG8_STAGE(PG8_SA(0, 1), a2 + hstepA, voffA);
            PG8_WAIT_L(8); PG8_BAR; PG8_WAIT_L(0); PG8_MMA(0, 0, At, B0); PG8_BAR; PG8_SCHED;
            PG8_LDB(B1, 1, 1); PG8_STAGE(PG8_SB(1, 0), b3, voffB);
            PG8_BAR; PG8_WAIT_L(0); PG8_MMA(0, 1, At, B1); PG8_BAR;
            PG8_LDA(At, 1, 1); PG8_STAGE(PG8_SA(1, 0), a3, voffA);
            PG8_BAR; PG8_WAIT_L(0); PG8_MMA(1, 0, At, B0); PG8_BAR; PG8_SCHED;
            PG8_STAGE(PG8_SB(1, 1), b3 + hstepB, voffB);
            PG8_WAIT_V(6); PG8_BAR; PG8_MMA(1, 1, At, B1); PG8_BAR;
            }
        }
        if constexpr (ALIGN_EPI) { if (wr == 0) PG8_BAR; }
        E(acc, cur, wr, wc, fr, fq); S.done(cur);
        if (!has_next) break;
#pragma unroll
        for (int a = 0; a < 2; ++a)
#pragma unroll
            for (int b = 0; b < 2; ++b)
#pragma unroll
                for (int m = 0; m < 4; ++m)
#pragma unroll
                    for (int n = 0; n < 2; ++n) acc[a][b][m][n] = (f32x4){0.f, 0.f, 0.f, 0.f};
        cur = nxt; cA = nA; cB = nB; ++ui;
        if constexpr (ALIGN_EPI) { if (wr == 1) PG8_BAR; }
    }
    PG8_WAIT_V(0);
    if constexpr (!ALIGN_EPI) { if (wr == 0) PG8_BAR; }
    PG8_BAR;
#undef PG8_SA
#undef PG8_SB
#undef PG8_STAGE
#undef PG8_LDA
#undef PG8_LDB
#undef PG8_MMA
#undef PG8_WAIT_V
#undef PG8_WAIT_L
#undef PG8_BAR
#undef PG8_SCHED
}
}
constexpr int DM = 2048, MP = 8192, MS = 4096, MALL = 12288, MKV = 12800, FF = 8192, NMOD = 12288;
constexpr int NWAVES = 8, NTHR = 512, DEPTH = 4;
constexpr float EPS = 1e-6f;
constexpr size_t O_X = 0, O_CKV = 25165824, O_KPE = 33554432, O_HG = 34603008, O_NK = 51380224, O_NV = 68157440, O_END = 84934656;
enum { I_XP = 0, I_XS, I_CCKV, I_CKPE, I_SHG, I_CNK, I_CNV, I_C, I_CCTX, I_WMOD, I_BMOD, I_GMIX, I_GFFN, I_WQA, I_GQA, I_WQB, I_GQN, I_WKVA, I_GKVA, I_WKVB, I_GKN, I_WMO,
       I_WHQ, I_WHF, I_HLB, I_WHI, I_WHG, I_GHO, I_WHO, I_WNQKV, I_GNQ, I_GNK, I_RPB, I_WNO, I_WFF1, I_WFF2, N_IN };

constexpr size_t MiB = 1u << 20;
constexpr size_t WS_CTL = 0, CTL_ZERO_BYTES = 65536;
constexpr size_t WS_MODS = 2 * MiB;
constexpr size_t WS_LB = 3 * MiB;
constexpr size_t WS_SSK = 3 * MiB + 65536;
constexpr size_t WS_PROF = 3 * MiB + 786432;
constexpr size_t WS_ROPE = 3 * MiB + 131072;
constexpr size_t WS_WFF1 = 4 * MiB, WS_WFF2 = 132 * MiB;
constexpr size_t WS_WMLA = 260 * MiB, WMLA_STRIDE = 24 * MiB;
constexpr size_t WMLA_QB = 6 * MiB, WMLA_KVB = 11 * MiB, WMLA_WO = 15 * MiB;
constexpr size_t WS_WHG = 308 * MiB, WHG_WO = 40 * MiB;
constexpr size_t WS_WNAT = 356 * MiB, WNAT_WO = 24 * MiB;
constexpr size_t WS_H = 388 * MiB;
constexpr size_t WS_U = 436 * MiB;
constexpr size_t WS_S = 628 * MiB;
constexpr size_t S_AO = 0;
constexpr size_t S_QAKV = 48 * MiB, S_QAN = 120 * MiB, S_CKVN = 138 * MiB, S_KPE = 151 * MiB, S_QRAW = 155 * MiB, S_KVRAW = 227 * MiB, S_QN = 327 * MiB, S_KF = 399 * MiB;
constexpr size_t S_HQ = 48 * MiB, S_HK = 96 * MiB, S_HV = 192 * MiB, S_HGS = 240 * MiB, S_OF = 288 * MiB;
constexpr size_t S_NQKV = 48 * MiB, S_NQN = 198 * MiB, S_NKN = 246 * MiB;
constexpr size_t S_PART = 480 * MiB;
constexpr size_t S_X = 512 * MiB;
constexpr size_t WS_END = WS_S + 560 * MiB;
constexpr int CW_TMO = 0, CW_CODE = 1, CW_BAR = 4096;

constexpr int RING_BYTES = 131072;
constexpr int LDSCTL_OFF = 163840 - 512, MISC_OFF = LDSCTL_OFF + 320;
constexpr int EPI_TAB_OFF = LDSCTL_OFF - 8192;
constexpr int LDS_BYTES = 163840;

#define GAS __attribute__((address_space(1)))
#define LAS __attribute__((address_space(3)))
typedef unsigned short bf16;
typedef unsigned v4u __attribute__((ext_vector_type(4)));
typedef unsigned v2u __attribute__((ext_vector_type(2)));
typedef float f32x4 __attribute__((ext_vector_type(4)));
typedef float f32x2 __attribute__((ext_vector_type(2)));
typedef short bf16x8 __attribute__((ext_vector_type(8)));
typedef GAS unsigned gu32;
#define RLX_AGENT __ATOMIC_RELAXED, __HIP_MEMORY_SCOPE_AGENT
#define LDS_WAIT() asm volatile("s_waitcnt lgkmcnt(0)" ::: "memory")
#define VM_WAIT() asm volatile("s_waitcnt vmcnt(0)" ::: "memory")
#ifndef DBG_SCALE
#define DBG_SCALE 1.0f
#endif
#define OPAQUE_S(x) asm volatile("" : "+s"(x))
#define PH_PTRS unsigned char* ws = a.ws; float* out = a.out; OPAQUE_S(ws); OPAQUE_S(out)
#define OPAQUE_V(x) asm volatile("" : "+v"(x))
__device__ __forceinline__ unsigned pk2(float lo, float hi) { unsigned r; asm("v_cvt_pk_bf16_f32 %0, %1, %2" : "=v"(r) : "v"(lo), "v"(hi)); return r; }
__device__ __forceinline__ float bf_lo(unsigned w) { return __uint_as_float(w << 16); }
__device__ __forceinline__ float bf_hi(unsigned w) { return __uint_as_float(w & 0xffff0000u); }
__device__ __forceinline__ float wave_sum(float v) {
#pragma unroll
    for (int o = 1; o < 64; o <<= 1) v += __shfl_xor(v, o);
    return v;
}
__device__ __forceinline__ float sum16(float v) {
#pragma unroll
    for (int o = 1; o < 16; o <<= 1) v += __shfl_xor(v, o);
    return v;
}

#define XB_TMO      128
#define XB_XCNT(j)  (256  + 64 * (j))
#define XB_XSUB(j)  (1280 + 64 * (j))
#define XB_XGEN(j)  (2304 + 64 * (j))
#define XB_TOP      3328
#define XB_TOPGEN   3392
#define XCD_BAR_WORDS 3456
#define XB_SPIN_CAP (1u << 18)
__device__ __forceinline__ unsigned xb_ld(unsigned* p)              { return __hip_atomic_load(p, __ATOMIC_RELAXED, __HIP_MEMORY_SCOPE_AGENT); }
__device__ __forceinline__ unsigned xb_add(unsigned* p, unsigned v) { return __hip_atomic_fetch_add(p, v, __ATOMIC_RELAXED, __HIP_MEMORY_SCOPE_AGENT); }
__device__ __forceinline__ unsigned xb_xcc_id() { return (unsigned)__builtin_amdgcn_s_getreg((3 << 11) | 20) & 0xFu; }
#define XB_SPIN(cond, bar) do { unsigned _sp = 0; while (cond) { __builtin_amdgcn_s_sleep(1); \
    if ((++_sp & 255u) == 0u) { if (xb_ld(&(bar)[XB_TMO])) break; if (_sp > XB_SPIN_CAP) { atomicAdd(&(bar)[XB_TMO], 1u); break; } } } } while (0)
struct XcdBarrier { unsigned* bar; unsigned x; volatile LAS unsigned* st; };
__device__ __forceinline__ XcdBarrier xcd_barrier_post(unsigned* bar, volatile LAS unsigned* st) {
    XcdBarrier b; b.bar = bar; b.x = xb_xcc_id(); b.st = st;
    if (threadIdx.x == 0) (void)xb_add(&bar[XB_XCNT(b.x)], 1u);
    return b;
}
__device__ __forceinline__ void xcd_barrier_complete(unsigned* bar, unsigned x, unsigned& nloc, unsigned& nx) {
    const unsigned G = gridDim.x * gridDim.y * gridDim.z;
    unsigned sum, cnt, mine, sp = 0u;
    for (;;) {
        sum = 0u; cnt = 0u; mine = 0u;
#pragma unroll
        for (unsigned j = 0; j < 16; ++j) { const unsigned c = xb_ld(&bar[XB_XCNT(j)]); sum += c; cnt += (c > 0u) ? 1u : 0u; mine = (j == x) ? c : mine; }
        if (sum == G) break;
        __builtin_amdgcn_s_sleep(1);
        if ((++sp & 255u) == 0u) { if (xb_ld(&bar[XB_TMO])) break; if (sp > XB_SPIN_CAP) { atomicAdd(&bar[XB_TMO], 1u); break; } }
    }
    nloc = mine > 0u ? mine : 1u; nx = cnt > 0u ? cnt : 1u;
}
__device__ __forceinline__ void xcd_barrier(const XcdBarrier& b) {
    asm volatile("s_waitcnt vmcnt(0)" ::: "memory");
    __syncthreads();
    if (threadIdx.x == 0) {
        unsigned* bar = b.bar;
        __builtin_amdgcn_s_waitcnt(0);
        unsigned nloc = b.st[0], nx = b.st[1];
        if (nloc == 0u) { xcd_barrier_complete(bar, b.x, nloc, nx); b.st[0] = nloc; b.st[1] = nx; }
        const unsigned old = xb_add(&bar[XB_XSUB(b.x)], 1u);
        const unsigned gen = old / nloc;
        if (old + 1u == (gen + 1u) * nloc) {
            __builtin_amdgcn_fence(__ATOMIC_RELEASE, "agent");
            asm volatile("s_waitcnt vmcnt(0)" ::: "memory");
            const unsigned og = xb_add(&bar[XB_TOP], 1u);
            const unsigned tg = og / nx;
            if (og + 1u == (tg + 1u) * nx) xb_add(&bar[XB_TOPGEN], 1u);
            else XB_SPIN(xb_ld(&bar[XB_TOPGEN]) == tg, bar);
            __builtin_amdgcn_fence(__ATOMIC_ACQUIRE, "agent");
            xb_add(&bar[XB_XGEN(b.x)], 1u);
            asm volatile("s_waitcnt vmcnt(0)" ::: "memory");
        } else {
            XB_SPIN(xb_ld(&bar[XB_XGEN(b.x)]) == gen, bar);
            __builtin_amdgcn_fence(__ATOMIC_ACQUIRE, "agent");
            asm volatile("s_waitcnt vmcnt(0)" ::: "memory");
        }
    }
    __syncthreads();
}

struct TJob { const float* src; bf16* dst; int K, N, row_off, start; };
constexpr int MAX_TJ = 32;
struct Args { const float* in[N_IN]; float* out; unsigned char* ws; TJob tj[MAX_TJ]; int ntj, nitems, ph_lo, ph_hi;
              int wstart[8], wmid[8]; };

__device__ __forceinline__ void p0_transpose_item(const float* W, int K, int N, bf16* WT, int row_off, LAS float* scr, int item, int lane) {
    const int nblk = N / 32, kb = item / nblk, nb = item % nblk, k0 = 64 * kb, n0 = 32 * nb;
    { const int kr = lane >> 3, ns = (lane & 7) * 4;
      f32x4 t[8];
#pragma unroll
      for (int i = 0; i < 8; ++i) t[i] = __builtin_nontemporal_load((const GAS f32x4*)(W + (size_t)(k0 + kr + 8 * i) * N + n0 + ns));
#pragma unroll
      for (int i = 0; i < 8; ++i) { LAS float* d = scr + (kr + 8 * i) * 33 + ns; d[0] = t[i].x; d[1] = t[i].y; d[2] = t[i].z; d[3] = t[i].w; } }
    LDS_WAIT(); asm volatile("" ::: "memory");
    const int c = lane & 7;
#pragma unroll
    for (int j = 0; j < 4; ++j) { const int n = (lane >> 3) + 8 * j; const LAS float* s = scr + (8 * c) * 33 + n;
        v4u o; o.x = pk2(s[0 * 33], s[1 * 33]); o.y = pk2(s[2 * 33], s[3 * 33]); o.z = pk2(s[4 * 33], s[5 * 33]); o.w = pk2(s[6 * 33], s[7 * 33]);
        __builtin_nontemporal_store(o, (GAS v4u*)(WT + (size_t)(row_off + n0 + n) * K + k0 + 8 * c)); }
    LDS_WAIT(); asm volatile("" ::: "memory");
}

__device__ __forceinline__ void p0_convert_range(const Args& a, LAS unsigned char* lds, int lo, int hi, int idx, int stride, int lane, int wave) {
    OPAQUE_V(lane);
    LAS float* scr = (LAS float*)(lds + wave * 16384);
    for (int it = lo + idx; it < hi; it += stride) {
        int j = 0;
        while (j + 1 < a.ntj && it >= a.tj[j + 1].start) ++j;
        p0_transpose_item(a.tj[j].src, a.tj[j].K, a.tj[j].N, a.tj[j].dst, a.tj[j].row_off, scr, it - a.tj[j].start, lane);
    }
}

__device__ __forceinline__ float silu_f(float x) { return x / (1.f + __expf(-x)); }

__device__ __forceinline__ void p0_prologue(const Args& a, LAS unsigned char* lds, int tid, int lane, int wave, int vcu, int G) {
    OPAQUE_V(tid); OPAQUE_V(lane);
    float* mods = (float*)(a.ws + WS_MODS);
#ifndef DBG_REP_MASK
#define DBG_REP_MASK 0
#endif
    for (int rep_ = 0; rep_ < (((DBG_REP_MASK >> 14) & 1) ? 3 : 1); ++rep_)
    if (vcu < 768) {
        LAS f32x4* S3 = (LAS f32x4*)lds;
        LAS float* RED = (LAS float*)(lds + 32768);
        const float* cc = a.in[I_C]; const float* cx = a.in[I_CCTX];
        for (int k = tid; k < DM; k += NTHR) S3[k] = (f32x4){silu_f(cx[k]), silu_f(cc[k]), silu_f(cc[DM + k]), 0.f};
        __syncthreads();
        for (int tl = vcu; tl < 768; tl += G) {
            const int l = tl / 192, n = (tl % 192) * 64 + lane;
            const float* Wp = a.in[I_WMOD] + ((size_t)l * DM + wave * 256) * NMOD + n;
            float a0 = 0.f, a1 = 0.f, a2 = 0.f;
#pragma unroll 16
            for (int k = 0; k < 256; ++k) { const float wv = __builtin_nontemporal_load((const GAS float*)(Wp + (size_t)k * NMOD)); const f32x4 s = S3[wave * 256 + k]; a0 += s.x * wv; a1 += s.y * wv; a2 += s.z * wv; }
            RED[(wave * 3 + 0) * 64 + lane] = a0; RED[(wave * 3 + 1) * 64 + lane] = a1; RED[(wave * 3 + 2) * 64 + lane] = a2;
            __syncthreads();
            if (wave < 3) { float s = 0.f;
#pragma unroll
                for (int w = 0; w < 8; ++w) s += RED[(w * 3 + wave) * 64 + lane];
                mods[((size_t)l * 3 + wave) * NMOD + n] = s + a.in[I_BMOD][(size_t)l * NMOD + n]; }
            __syncthreads();
        }
    }
    { const int gt = vcu * NTHR + tid;
      if (gt < 2 * DM) { const int d = gt >> 11, c = gt & 2047; const float* hl = a.in[I_HLB] + (size_t)d * 4 * DM + c;
          const float x0 = hl[0], x1 = hl[DM], x2 = hl[2 * DM], x3 = hl[3 * DM]; const float m = fmaxf(fmaxf(x0, x1), fmaxf(x2, x3));
          const float e0 = __expf(x0 - m), e1 = __expf(x1 - m), e2 = __expf(x2 - m), e3 = __expf(x3 - m);
          ((float*)(a.ws + WS_LB))[gt] = e1 / (e0 + e1 + e2 + e3); } }
    __syncthreads();
    LAS float* scr = (LAS float*)(lds + wave * 16384);
    const int gw = vcu * NWAVES + wave, NGW = G * NWAVES;
    for (int rep_ = 0; rep_ < (((DBG_REP_MASK >> 15) & 1) ? 3 : 1); ++rep_)
    for (int it = gw; it < a.wstart[1]; it += NGW) {
        int j = 0;
        while (j + 1 < a.ntj && it >= a.tj[j + 1].start) ++j;
        p0_transpose_item(a.tj[j].src, a.tj[j].K, a.tj[j].N, a.tj[j].dst, a.tj[j].row_off, scr, it - a.tj[j].start, lane);
    }
#if defined(DBG_ZERO_OUT)
    { const size_t gt = (size_t)vcu * NTHR + tid, NT = (size_t)G * NTHR;
      for (size_t i = gt; i < (O_END - O_CKV) / 4; i += NT) *(GAS f32x4*)(a.out + O_CKV + 4 * i) = (f32x4){0.f, 0.f, 0.f, 0.f}; }
#endif
    { const int gt = vcu * NTHR + tid, NT = G * NTHR;
      for (int i = gt; i < 2 * 192 * DM / 8; i += NT) { const int j = i / (192 * DM / 8), r = i % (192 * DM / 8);
          *(GAS v4u*)(a.ws + WS_WMLA + j * WMLA_STRIDE + (size_t)1344 * DM * 2 + (size_t)r * 16) = (v4u){0u, 0u, 0u, 0u}; } }
}

__device__ __forceinline__ int cond_of_row(int row) { return row < MP ? 0 : 1 + ((row - MP) >> 11); }

__device__ __forceinline__ void norm_phase(const Args& a, int l, bool ffn, const float* fixgate, int lane, int gw, int NGW) {
    OPAQUE_V(lane); PH_PTRS; OPAQUE_S(gw); OPAQUE_S(NGW);
    const float* g = a.in[ffn ? I_GFFN : I_GMIX] + (size_t)l * DM;
    const float* mods = (const float*)(ws + WS_MODS) + (size_t)l * 3 * NMOD + (ffn ? 3 * DM : 0);
    bf16* H = (bf16*)(ws + WS_H); bf16* X = (bf16*)(ws + WS_S + S_X);
    const bool first = (l == 0 && !ffn);
    for (int row = gw; row < MALL; row += NGW) {
        const float* md = mods + (size_t)cond_of_row(row) * NMOD;
        f32x4 v[8]; float ss = 0.f;
        const bool fix = fixgate != nullptr && row >= MP;
        const bf16* P0 = (const bf16*)(ws + WS_S + S_PART) + (size_t)(row - MP) * DM; const float* fg = fixgate + (size_t)cond_of_row(row) * NMOD;
        if (first) { const float* xr = row < MP ? a.in[I_XP] + (size_t)row * DM : a.in[I_XS] + (size_t)(row - MP) * DM;
#pragma unroll
            for (int j = 0; j < 8; ++j) v[j] = __builtin_nontemporal_load((const GAS f32x4*)(xr + 4 * (lane + 64 * j)));
        } else { const bf16* xr = X + (size_t)row * DM;
#pragma unroll
            for (int j = 0; j < 8; ++j) { const v2u w = *(const GAS v2u*)(xr + 4 * (lane + 64 * j)); v[j] = (f32x4){bf_lo(w.x), bf_hi(w.x), bf_lo(w.y), bf_hi(w.y)}; } }
#pragma unroll
        for (int j = 0; j < 8; ++j) {
            if (fix) { const int c = 4 * (lane + 64 * j); const v2u pw = __builtin_nontemporal_load((const GAS v2u*)(P0 + c)); v[j] = v[j] + *(const GAS f32x4*)(fg + c) * (f32x4){bf_lo(pw.x), bf_hi(pw.x), bf_lo(pw.y), bf_hi(pw.y)}; }
            ss += (v[j].x * v[j].x + v[j].y * v[j].y) + (v[j].z * v[j].z + v[j].w * v[j].w); }
        const float rs = rsqrtf(wave_sum(ss) * (1.f / DM) + EPS);
#pragma unroll
        for (int j = 0; j < 8; ++j) { const int c = 4 * (lane + 64 * j);
            const f32x4 gg = *(const GAS f32x4*)(g + c), sh = *(const GAS f32x4*)(md + c), sc = *(const GAS f32x4*)(md + DM + c);
            const f32x4 y = v[j] * rs * gg * (sc + 1.f) + sh;
            *(GAS v2u*)(H + (size_t)row * DM + c) = (v2u){pk2(y.x, y.y), pk2(y.z, y.w)};
            if (first || fix) *(GAS v2u*)(X + (size_t)row * DM + c) = (v2u){pk2(v[j].x, v[j].y), pk2(v[j].z, v[j].w)}; }
    }
}
__device__ __forceinline__ void final_fix_phase(const Args& a, const float* fixgate, int lane, int gw, int NGW) {
    OPAQUE_V(lane); PH_PTRS; OPAQUE_S(gw); OPAQUE_S(NGW);
    for (int row = MP + gw; row < MALL; row += NGW) {
        const bf16* P0 = (const bf16*)(ws + WS_S + S_PART) + (size_t)(row - MP) * DM; const float* fg = fixgate + (size_t)cond_of_row(row) * NMOD; float* xr = out + O_X + (size_t)row * DM;
#pragma unroll
        for (int j = 0; j < 8; ++j) { const int c = 4 * (lane + 64 * j); const v2u pw = *(const GAS v2u*)(P0 + c);
            *(GAS f32x4*)(xr + c) = *(const GAS f32x4*)(xr + c) + *(const GAS f32x4*)(fg + c) * (f32x4){bf_lo(pw.x), bf_hi(pw.x), bf_lo(pw.y), bf_hi(pw.y)}; }
    }
}
__device__ __forceinline__ void mla_thin_a(const Args& a, int j, int lane, int gw, int NGW) {
    OPAQUE_V(lane); PH_PTRS; OPAQUE_S(gw); OPAQUE_S(NGW);
    const bf16* QAKV = (const bf16*)(ws + WS_S + S_QAKV);
    bf16* QAN = (bf16*)(ws + WS_S + S_QAN); bf16* CKVN = (bf16*)(ws + WS_S + S_CKVN); float* KPE = (float*)(ws + WS_S + S_KPE); float* SSK = (float*)(ws + WS_SSK);
    const float* gqa = a.in[I_GQA] + (size_t)j * 768; const float* gkva = a.in[I_GKVA] + (size_t)j * 512;
    for (int row = gw; row < MKV; row += NGW) {
        if (row < MALL) {
            const bf16* r = QAKV + (size_t)row * 1536;
#define LD4(p_) ({ const v2u w_ = *(const GAS v2u*)(p_); (f32x4){bf_lo(w_.x), bf_hi(w_.x), bf_lo(w_.y), bf_hi(w_.y)}; })
            { f32x4 v[3]; float ss = 0.f;
#pragma unroll
              for (int i = 0; i < 3; ++i) { v[i] = LD4(r + 4 * (lane + 64 * i)); ss += (v[i].x * v[i].x + v[i].y * v[i].y) + (v[i].z * v[i].z + v[i].w * v[i].w); }
              const float rs = rsqrtf(wave_sum(ss) * (1.f / 768.f) + EPS);
#pragma unroll
              for (int i = 0; i < 3; ++i) { const int c = 4 * (lane + 64 * i); const f32x4 y = v[i] * rs * *(const GAS f32x4*)(gqa + c);
                  *(GAS v2u*)(QAN + (size_t)row * 768 + c) = (v2u){pk2(y.x, y.y), pk2(y.z, y.w)}; } }
            { f32x4 v[2]; float ss = 0.f;
#pragma unroll
              for (int i = 0; i < 2; ++i) { v[i] = LD4(r + 768 + 4 * (lane + 64 * i)); ss += (v[i].x * v[i].x + v[i].y * v[i].y) + (v[i].z * v[i].z + v[i].w * v[i].w); }
              const float rs = rsqrtf(wave_sum(ss) * (1.f / 512.f) + EPS);
#pragma unroll
              for (int i = 0; i < 2; ++i) { const int c = 4 * (lane + 64 * i); const f32x4 y = v[i] * rs * *(const GAS f32x4*)(gkva + c);
                  *(GAS v2u*)(CKVN + (size_t)row * 512 + c) = (v2u){pk2(y.x, y.y), pk2(y.z, y.w)};
                  if (row < MP) __builtin_nontemporal_store(y * DBG_SCALE, (GAS f32x4*)(out + O_CKV + ((size_t)((row >> 8) * 2 + j) * 256 + (row & 255)) * 512 + c)); } }
            { const float kp = __uint_as_float((unsigned)r[1280 + lane] << 16); KPE[(size_t)row * 64 + lane] = kp;
              if (row < MP) out[O_KPE + ((size_t)((row >> 8) * 2 + j) * 256 + (row & 255)) * 64 + lane] = kp * DBG_SCALE;
              const float s = wave_sum(kp * kp); if (lane == 0) SSK[row] = s; }
#undef LD4
        } else {
            const int cr = row - MALL, b = cr >> 8, t = cr & 255; const size_t src = (size_t)((b * 2 + j) * 256 + t);
            const float* ck = a.in[I_CCKV] + src * 512;
#pragma unroll
            for (int i = 0; i < 2; ++i) { const int c = 4 * (lane + 64 * i); const f32x4 y = *(const GAS f32x4*)(ck + c);
                *(GAS v2u*)(CKVN + (size_t)row * 512 + c) = (v2u){pk2(y.x, y.y), pk2(y.z, y.w)}; }
            const float kp = a.in[I_CKPE][src * 64 + lane]; KPE[(size_t)row * 64 + lane] = kp;
            const float s = wave_sum(kp * kp); if (lane == 0) SSK[row] = s;
        }
    }
}
namespace pg8 {
struct EpiF32 {
    static constexpr bool PERM = false;
    float* C; int ldc;
    __device__ __forceinline__ void operator()(const f32x4 (&acc)[2][2][4][2], const Unit& u, int wr, int wc, int fr, int fq) const {
        const int row0 = u.pm * BM + wr * 64 + fr, col0 = u.pn * BM + wc * 32 + 4 * fq;
#pragma unroll
        for (int ai = 0; ai < 2; ++ai)
#pragma unroll
            for (int m = 0; m < 4; ++m) { float* rowp = C + (size_t)(row0 + ai * HALF + m * 16) * ldc + col0;
#pragma unroll
                for (int bj = 0; bj < 2; ++bj)
#pragma unroll
                    for (int n = 0; n < 2; ++n) *(PG8_GAS f32x4*)(rowp + bj * HALF + n * 16) = acc[ai][bj][m][n]; }
    }
};
template <int ACT  > struct EpiBf16 {
    static constexpr bool PERM = true;
    bf16_t* O; int ldc;
    __device__ __forceinline__ void operator()(const f32x4 (&acc)[2][2][4][2], const Unit& u, int wr, int wc, int fr, int fq) const {
        const int row0 = u.pm * BM + wr * 64 + fr, col0 = u.pn * BM + wc * 32 + 8 * fq;
#pragma unroll
        for (int ai = 0; ai < 2; ++ai)
#pragma unroll
            for (int m = 0; m < 4; ++m) { bf16_t* rowp = O + (size_t)(row0 + ai * HALF + m * 16) * ldc + col0;
#pragma unroll
                for (int bj = 0; bj < 2; ++bj) { f32x4 v0 = acc[ai][bj][m][0], v1 = acc[ai][bj][m][1];
                    if (ACT == 1) {
#pragma unroll
                        for (int e = 0; e < 4; ++e) { const float x0 = fmaxf(v0[e], 0.f), x1 = fmaxf(v1[e], 0.f); v0[e] = x0 * x0; v1[e] = x1 * x1; } }
                    u32x4 w; w.x = cvt_pk_bf16(v0[0], v0[1]); w.y = cvt_pk_bf16(v0[2], v0[3]); w.z = cvt_pk_bf16(v1[0], v1[1]); w.w = cvt_pk_bf16(v1[2], v1[3]);
                    *(PG8_GAS u32x4*)(rowp + bj * HALF) = w; } }
    }
};
template <bool ATOMIC> struct EpiRes {
    static constexpr bool PERM = false;
    float* X; const float* gate;
    __device__ __forceinline__ void operator()(const f32x4 (&acc)[2][2][4][2], const Unit& u, int wr, int wc, int fr, int fq) const {
        const int rb = u.pm * BM, row0 = rb + wr * 64 + fr, col0 = u.pn * BM + wc * 32 + 4 * fq;
        const int cond = rb < 8192 ? 0 : 1 + ((rb - 8192) >> 11);
        const float* gp = gate + (size_t)cond * 12288 + col0;
        f32x4 gv[2][2];
#pragma unroll
        for (int bj = 0; bj < 2; ++bj)
#pragma unroll
            for (int n = 0; n < 2; ++n) gv[bj][n] = *(const PG8_GAS f32x4*)(gp + bj * HALF + n * 16);
#pragma unroll
        for (int ai = 0; ai < 2; ++ai)
#pragma unroll
            for (int m = 0; m < 4; ++m) { float* rowp = X + (size_t)(row0 + ai * HALF + m * 16) * 2048 + col0;
#pragma unroll
                for (int bj = 0; bj < 2; ++bj)
#pragma unroll
                    for (int n = 0; n < 2; ++n) { float* p = rowp + bj * HALF + n * 16; const f32x4 d = gv[bj][n] * acc[ai][bj][m][n];
                        if (ATOMIC) {
#pragma unroll
                            for (int e = 0; e < 4; ++e) __hip_atomic_fetch_add((PG8_GAS float*)(p + e), d[e], __ATOMIC_RELAXED, __HIP_MEMORY_SCOPE_AGENT);
                        } else { *(PG8_GAS f32x4*)p = *(const PG8_GAS f32x4*)p + d; } }
                asm volatile("" ::: "memory"); }
    }
};
struct EpiRes2 {
    static constexpr bool PERM = false;
    bf16_t* X; const float* gate; bf16_t* P; float* Yout;
    __device__ __forceinline__ void operator()(const f32x4 (&acc)[2][2][4][2], const Unit& u, int wr, int wc, int fr, int fq) const {
        typedef unsigned u32x2_ __attribute__((ext_vector_type(2)));
        const int rb = u.pm * BM, row0 = rb + wr * 64 + fr, col0 = u.pn * BM + wc * 32 + 4 * fq;
        if (u.part <= 0) {
            const int cond = rb < 8192 ? 0 : 1 + ((rb - 8192) >> 11);
            const float* gp = gate + (size_t)cond * 12288 + col0;
            f32x4 gv[2][2];
#pragma unroll
            for (int bj = 0; bj < 2; ++bj)
#pragma unroll
                for (int n = 0; n < 2; ++n) gv[bj][n] = *(const PG8_GAS f32x4*)(gp + bj * HALF + n * 16);
#pragma unroll
            for (int ai = 0; ai < 2; ++ai)
#pragma unroll
                for (int m = 0; m < 4; ++m) { const size_t ro = (size_t)(row0 + ai * HALF + m * 16) * 2048 + col0;
#pragma unroll
                    for (int bj = 0; bj < 2; ++bj)
#pragma unroll
                        for (int n = 0; n < 2; ++n) { const size_t o = ro + bj * HALF + n * 16; const u32x2_ w = *(const PG8_GAS u32x2_*)(X + o);
                            const f32x4 xn = (f32x4){__uint_as_float(w.x << 16), __uint_as_float(w.x & 0xffff0000u), __uint_as_float(w.y << 16), __uint_as_float(w.y & 0xffff0000u)} + gv[bj][n] * acc[ai][bj][m][n];
                            if (Yout != nullptr) *(PG8_GAS f32x4*)(Yout + o) = xn; else *(PG8_GAS u32x2_*)(X + o) = (u32x2_){cvt_pk_bf16(xn[0], xn[1]), cvt_pk_bf16(xn[2], xn[3])}; }
                    asm volatile("" ::: "memory"); }
        } else {
            bf16_t* Pp = P + (size_t)(row0 - 8192) * 2048 + col0;
#pragma unroll
            for (int ai = 0; ai < 2; ++ai)
#pragma unroll
                for (int m = 0; m < 4; ++m) { bf16_t* rowp = Pp + (size_t)(ai * HALF + m * 16) * 2048;
#pragma unroll
                    for (int bj = 0; bj < 2; ++bj)
#pragma unroll
                        for (int n = 0; n < 2; ++n) { const f32x4 v = acc[ai][bj][m][n]; *(PG8_GAS u32x2_*)(rowp + bj * HALF + n * 16) = (u32x2_){cvt_pk_bf16(v[0], v[1]), cvt_pk_bf16(v[2], v[3])}; } }
        }
    }
};
}
#ifndef DBG_REP_MASK
#define DBG_REP_MASK 0
#endif
namespace att {
using bf16x8 = __attribute__((ext_vector_type(8))) short;
using s16x4  = __attribute__((ext_vector_type(4))) short;
using f32x16 = __attribute__((ext_vector_type(16))) float;
using u32x4  = __attribute__((ext_vector_type(4))) unsigned;
constexpr int NW = 8, QBLK = 32, KVBLK = 64, DV = 128;
constexpr float THR = 8.f;
constexpr int SHM_V = KVBLK * DV * 2;
constexpr int RPB_OFF = 2 * SHM_V + 2 * KVBLK * 512 + 2048;
#define ATT_SBAR() __builtin_amdgcn_sched_barrier(0)
__device__ __forceinline__ int crow(int r, int hi) { return (r & 3) + 8 * (r >> 2) + 4 * hi; }
__device__ __forceinline__ unsigned cvtpk(float lo, float hi) { unsigned r; asm volatile("v_cvt_pk_bf16_f32 %0, %1, %2" : "=v"(r) : "v"(lo), "v"(hi)); return r; }
__device__ __forceinline__ int v_st(int k, int c) { const int kk = (k & ~0xC) | ((k & 4) << 1) | ((k & 8) >> 1); return ((kk >> 3) * 4 + (c >> 5)) * 512 + ((kk & 7) * 32 + (c & 31)) * 2; }
__device__ __forceinline__ int v_rd_base(int lane) { return ((lane & 3) << 3) | (((lane >> 2) & 3) << 6) | (((lane >> 4) & 1) << 5) | (((lane >> 5) & 1) << 8); }
constexpr int v_rd_off(int d0, int ks, int half) { return d0 * 512 + ks * 4096 + half * 2048; }
template <int OFF> __device__ __forceinline__ s16x4 tr_read(int vb) { s16x4 r; asm volatile("ds_read_b64_tr_b16 %0, %1 offset:%2" : "=&v"(r) : "v"(vb), "i"(OFF) : "memory"); return r; }
template <int D0> __device__ __forceinline__ void pv_one(f32x16& od, int vb, bf16x8 pa0, bf16x8 pa1, bf16x8 pa2, bf16x8 pa3) {
  const s16x4 l0 = tr_read<v_rd_off(D0, 0, 0)>(vb), h0 = tr_read<v_rd_off(D0, 0, 1)>(vb), l1 = tr_read<v_rd_off(D0, 1, 0)>(vb), h1 = tr_read<v_rd_off(D0, 1, 1)>(vb);
  const s16x4 l2 = tr_read<v_rd_off(D0, 2, 0)>(vb), h2 = tr_read<v_rd_off(D0, 2, 1)>(vb), l3 = tr_read<v_rd_off(D0, 3, 0)>(vb), h3 = tr_read<v_rd_off(D0, 3, 1)>(vb);
  asm volatile("s_waitcnt lgkmcnt(0)" ::: "memory"); ATT_SBAR();
#define ATT_PK(L, H) (bf16x8){L[0], L[1], L[2], L[3], H[0], H[1], H[2], H[3]}
  od = __builtin_amdgcn_mfma_f32_32x32x16_bf16(pa0, ATT_PK(l0, h0), od, 0, 0, 0);
  od = __builtin_amdgcn_mfma_f32_32x32x16_bf16(pa1, ATT_PK(l1, h1), od, 0, 0, 0);
  od = __builtin_amdgcn_mfma_f32_32x32x16_bf16(pa2, ATT_PK(l2, h2), od, 0, 0, 0);
  od = __builtin_amdgcn_mfma_f32_32x32x16_bf16(pa3, ATT_PK(l3, h3), od, 0, 0, 0);
#undef ATT_PK
}
__device__ __forceinline__ void pv_d0(f32x16* o, int vb, bf16x8 pa0, bf16x8 pa1, bf16x8 pa2, bf16x8 pa3) {
  pv_one<0>(o[0], vb, pa0, pa1, pa2, pa3); pv_one<1>(o[1], vb, pa0, pa1, pa2, pa3); pv_one<2>(o[2], vb, pa0, pa1, pa2, pa3); pv_one<3>(o[3], vb, pa0, pa1, pa2, pa3);
}
struct KvSrc { int row0, n0, row1, n1; __device__ __forceinline__ int row(int t) const { const int u = t - n0; return t < n0 ? row0 + 64 * t : row1 + 64 * (u < n1 ? u : n1 - 1); } };
struct NatMask { int rlo, qrow, qcol; const LAS float* rpb; };

template <int DQK, int MODE, int ldq, int ldk, int ldv, int ldo, int QP = 0>
__device__ __forceinline__ void attn_unit(const bf16* __restrict__ Qb, const bf16* __restrict__ Kh, const bf16* __restrict__ Vh,
                                          bf16* __restrict__ Ob, const KvSrc src, int NT, const NatMask nm, LAS char* lds, int tid,
                                          const float* __restrict__ qgain = nullptr, const float* __restrict__ qrope = nullptr) {
  constexpr float SCALE = DQK == 128 ? 0.088388347648318440f : 0.072168783648703220f;
  constexpr float C = SCALE * 1.4426950408889634f;
  constexpr int KROW = DQK == 128 ? 256 : 512  , SHM_K = KVBLK * KROW, NKC = DQK / 8, KCH = KVBLK * NKC / 512, ND0 = DQK / 16;
  const int wid = tid >> 6, lane = tid & 63, r32 = lane & 31, hi = lane >> 5;
  LAS char* V_lds = lds; LAS char* K_lds = lds + 2 * SHM_V;
  LAS float* ws = (LAS float*)(lds + 2 * SHM_V + 2 * SHM_K) + wid * 64; LAS float* li_l = ws; LAS float* al_l = ws + 32;
  float m_reg = -1e30f, l_reg = 0; f32x16 o[4] = {}; bf16x8 qr[ND0];
  { const bf16* Qw = Qb + (size_t)(wid * QBLK + r32) * ldq + hi * 8;
#pragma unroll
    for (int d0 = 0; d0 < ND0; ++d0) qr[d0] = *(const GAS bf16x8*)(Qw + d0 * 16); }
  if constexpr (QP == 1) {
    float ss = 0.f;
#pragma unroll
    for (int d0 = 0; d0 < ND0; ++d0) { const u32x4 w = __builtin_bit_cast(u32x4, qr[d0]);
#pragma unroll
      for (int e = 0; e < 4; ++e) { const float a = __uint_as_float(w[e] << 16), b = __uint_as_float(w[e] & 0xffff0000u); ss += a * a + b * b; } }
    ss += __shfl_xor(ss, 32);
    const float rs = rsqrtf(ss * (1.f / DQK) + 1e-6f);
    float xv[ND0 < 12 ? 1 : 4][8];
#pragma unroll
    for (int d0 = 0; d0 < ND0; ++d0) { const u32x4 w = __builtin_bit_cast(u32x4, qr[d0]);
      const f32x4 g0 = *(const GAS f32x4*)(qgain + d0 * 16 + hi * 8), g1 = *(const GAS f32x4*)(qgain + d0 * 16 + hi * 8 + 4);
      float x[8];
#pragma unroll
      for (int e = 0; e < 4; ++e) { x[2 * e] = __uint_as_float(w[e] << 16) * rs; x[2 * e + 1] = __uint_as_float(w[e] & 0xffff0000u) * rs; }
      x[0] *= g0.x; x[1] *= g0.y; x[2] *= g0.z; x[3] *= g0.w; x[4] *= g1.x; x[5] *= g1.y; x[6] *= g1.z; x[7] *= g1.w;
      if (ND0 == 12 && d0 >= 8) {
#pragma unroll
        for (int e = 0; e < 8; ++e) xv[ND0 < 12 ? 0 : d0 - 8][e] = x[e];
      } else { const u32x4 o_ = {cvtpk(x[0], x[1]), cvtpk(x[2], x[3]), cvtpk(x[4], x[5]), cvtpk(x[6], x[7])}; qr[d0] = __builtin_bit_cast(bf16x8, o_); } }
    if constexpr (ND0 == 12) {
#pragma unroll
      for (int pp = 0; pp < 2; ++pp) {
        float y1[8], y2[8];
#pragma unroll
        for (int e = 0; e < 8; ++e) { y1[e] = xv[pp][e]; y2[e] = xv[2 + pp][e]; }
        if (qrope != nullptr) { const float* rt = qrope + ((size_t)(wid * QBLK + r32) * 32 + 16 * pp + 8 * hi) * 2;
#pragma unroll
          for (int e2 = 0; e2 < 4; ++e2) { const f32x4 cs = *(const GAS f32x4*)(rt + 4 * e2);
            const float a0 = y1[2 * e2] * cs.x - y2[2 * e2] * cs.y, b0 = y1[2 * e2] * cs.y + y2[2 * e2] * cs.x;
            const float a1 = y1[2 * e2 + 1] * cs.z - y2[2 * e2 + 1] * cs.w, b1 = y1[2 * e2 + 1] * cs.w + y2[2 * e2 + 1] * cs.z;
            y1[2 * e2] = a0; y2[2 * e2] = b0; y1[2 * e2 + 1] = a1; y2[2 * e2 + 1] = b1; } }
        const u32x4 o1 = {cvtpk(y1[0], y1[1]), cvtpk(y1[2], y1[3]), cvtpk(y1[4], y1[5]), cvtpk(y1[6], y1[7])}, o2 = {cvtpk(y2[0], y2[1]), cvtpk(y2[2], y2[3]), cvtpk(y2[4], y2[5]), cvtpk(y2[6], y2[7])};
        qr[8 + pp] = __builtin_bit_cast(bf16x8, o1); qr[10 + pp] = __builtin_bit_cast(bf16x8, o2); }
    }
  }
  const int sr = tid >> 4, sc = (tid & 15) * 8, vst0 = v_st(sr, sc), vst1 = v_st(32 + sr, sc);
  unsigned koff_[KCH], kst_[KCH]; const unsigned voff0 = (unsigned)(sr * ldv + sc);
#pragma unroll
  for (int i = 0; i < KCH; ++i) { const int c = tid + 512 * i, kr = c / NKC, kc = c % NKC; koff_[i] = (unsigned)(kr * ldk + kc * 8); kst_[i] = (unsigned)(kr * KROW + ((kc * 16) ^ ((kr & 15) << 4))); }
  const int vb0 = (int)(uintptr_t)V_lds + v_rd_base(lane);
  bf16x8 svs0, svs1, sks[KCH];
#define ATT_SLOAD(t) do { const int _r = __builtin_amdgcn_readfirstlane(src.row(t)); const bf16* _vt = Vh + (size_t)_r * ldv; const bf16* _kt = Kh + (size_t)_r * ldk; \
    svs0 = *(const GAS bf16x8*)(_vt + voff0); svs1 = *(const GAS bf16x8*)(_vt + 32 * ldv + voff0); \
    _Pragma("unroll") for (int _i = 0; _i < KCH; ++_i) sks[_i] = *(const GAS bf16x8*)(_kt + koff_[_i]); } while (0)
#define ATT_SWRITE(b) do { *(LAS bf16x8*)(V_lds + (b) * SHM_V + vst0) = svs0; *(LAS bf16x8*)(V_lds + (b) * SHM_V + vst1) = svs1; \
    _Pragma("unroll") for (int _i = 0; _i < KCH; ++_i) *(LAS bf16x8*)(K_lds + (b) * SHM_K + kst_[_i]) = sks[_i]; } while (0)
#define ATT_RESC(a) do { if (__any((a) < 1.f)) { if (hi == 0) al_l[r32] = (a); asm volatile("s_waitcnt lgkmcnt(0)" ::: "memory"); \
    _Pragma("unroll") for (int d = 0; d < 4; ++d) _Pragma("unroll") for (int r = 0; r < 16; ++r) o[d][r] *= al_l[crow(r, hi)]; } } while (0)
  auto qkt = [&](f32x16& p0, f32x16& p1, int b, int t) {
    const LAS char* Ks = K_lds + b * SHM_K;
    p0 = f32x16{}; p1 = f32x16{};
    const LAS char* k0p = Ks + r32 * KROW; const LAS char* k1p = Ks + (32 + r32) * KROW; const int sw = (r32 & 15) << 4;
    bf16x8 ka[2], kb[2];
    ka[0] = *reinterpret_cast<const LAS bf16x8*>(k0p + ((hi * 16) ^ sw)); kb[0] = *reinterpret_cast<const LAS bf16x8*>(k1p + ((hi * 16) ^ sw));
#pragma unroll
    for (int d0 = 0; d0 < ND0; ++d0) {
      if (d0 + 1 < ND0) { const int cb = ((d0 + 1) * 16 + hi * 8) * 2;
        ka[(d0 + 1) & 1] = *reinterpret_cast<const LAS bf16x8*>(k0p + (cb ^ sw)); kb[(d0 + 1) & 1] = *reinterpret_cast<const LAS bf16x8*>(k1p + (cb ^ sw)); }
      __builtin_amdgcn_sched_barrier(0);
      p0 = __builtin_amdgcn_mfma_f32_32x32x16_bf16(ka[d0 & 1], qr[d0], p0, 0, 0, 0);
      p1 = __builtin_amdgcn_mfma_f32_32x32x16_bf16(kb[d0 & 1], qr[d0], p1, 0, 0, 0);
      __builtin_amdgcn_sched_barrier(0); }
    if constexpr (MODE == 1) {
      const int i = t - src.n0;
      if (i >= 0) {
        const int kr = nm.rlo + i, r0q = min(max(nm.qrow - 4, 0), 24), c0q = min(max(nm.qcol - 8, 0), 48);
        const bool rowok = (i < src.n1) && (kr >= r0q) && (kr < r0q + 8);
        const int rowoff = (kr - nm.qrow + 7) * 31 + 15 - nm.qcol;
#pragma unroll
        for (int r = 0; r < 16; ++r) {
          const int kc0 = crow(r, hi), kc1 = kc0 + 32;
          const bool ok0 = rowok && ((unsigned)(kc0 - c0q) < 16u), ok1 = rowok && ((unsigned)(kc1 - c0q) < 16u);
          const float b0 = nm.rpb[ok0 ? rowoff + kc0 : 0], b1 = nm.rpb[ok1 ? rowoff + kc1 : 0];
          p0[r] = ok0 ? p0[r] + b0 : -1e30f; p1[r] = ok1 ? p1[r] + b1 : -1e30f; }
      }
    }
  };
  auto partialSM = [&](f32x16& p0, f32x16& p1, float& mn, float& alpha) {
    float pmax = p0[0];
#pragma unroll
    for (int r = 1; r < 16; ++r) pmax = fmaxf(pmax, p0[r]);
#pragma unroll
    for (int r = 0; r < 16; ++r) pmax = fmaxf(pmax, p1[r]);
    { auto rr = __builtin_amdgcn_permlane32_swap(__float_as_uint(pmax), __float_as_uint(pmax), false, false); pmax = fmaxf(__uint_as_float(rr[0]), __uint_as_float(rr[1])); }
    if (__builtin_expect(__all(pmax - m_reg <= THR / SCALE), 1)) { mn = m_reg; alpha = 1.f; }
    else { mn = fmaxf(m_reg, pmax); alpha = __builtin_amdgcn_exp2f((m_reg - mn) * C); m_reg = mn; }
    const float mnC = -mn * C;
#pragma unroll
    for (int r = 0; r < 16; ++r) p0[r] = fmaf(p0[r], C, mnC);
#pragma unroll
    for (int r = 0; r < 16; ++r) p1[r] = fmaf(p1[r], C, mnC);
#pragma unroll
    for (int r = 0; r < 16; ++r) p0[r] = __builtin_amdgcn_exp2f(p0[r]);
  };
  auto finishSM = [&](f32x16& p0, f32x16& p1, float alpha, bf16x8& pa0, bf16x8& pa1, bf16x8& pa2, bf16x8& pa3) {
#pragma unroll
    for (int r = 0; r < 16; ++r) p1[r] = __builtin_amdgcn_exp2f(p1[r]);
    float ps = 0;
#pragma unroll
    for (int r = 0; r < 16; ++r) ps += p0[r];
#pragma unroll
    for (int r = 0; r < 16; ++r) ps += p1[r];
    { auto rr = __builtin_amdgcn_permlane32_swap(__float_as_uint(ps), __float_as_uint(ps), false, false); ps = __uint_as_float(rr[0]) + __uint_as_float(rr[1]); }
    l_reg = l_reg * alpha + ps;
#define ATT_PK4(P, BASE, OUT) do { unsigned a0 = cvtpk(P[BASE + 0], P[BASE + 1]), a1 = cvtpk(P[BASE + 2], P[BASE + 3]); \
    unsigned b0 = cvtpk(P[BASE + 4], P[BASE + 5]), b1 = cvtpk(P[BASE + 6], P[BASE + 7]); \
    auto r0 = __builtin_amdgcn_permlane32_swap(a0, b0, false, false); auto r1 = __builtin_amdgcn_permlane32_swap(a1, b1, false, false); \
    u32x4 w = {r0[0], r1[0], r0[1], r1[1]}; OUT = *reinterpret_cast<bf16x8*>(&w); } while (0)
    ATT_PK4(p0, 0, pa0); ATT_PK4(p0, 8, pa1); ATT_PK4(p1, 0, pa2); ATT_PK4(p1, 8, pa3);
#undef ATT_PK4
  };
  f32x16 p0, p1; float mn, al; bf16x8 pa0, pa1, pa2, pa3;
  ATT_SLOAD(0); asm volatile("s_waitcnt vmcnt(0)" ::: "memory"); ATT_SWRITE(0); if (NT > 1) ATT_SLOAD(1); __syncthreads();
  for (int t = 0; t < NT; ++t) {
    const int b = t & 1;
    ATT_SBAR(); qkt(p0, p1, b, t); ATT_SBAR();
    if (t + 1 < NT) { asm volatile("s_waitcnt vmcnt(0)" ::: "memory"); ATT_SWRITE(b ^ 1); if (t + 2 < NT) ATT_SLOAD(t + 2); }
    ATT_SBAR();
    partialSM(p0, p1, mn, al); ATT_RESC(al);
    finishSM(p0, p1, al, pa0, pa1, pa2, pa3); ATT_SBAR();
    pv_d0(o, vb0 + b * SHM_V, pa0, pa1, pa2, pa3);
    __syncthreads();
  }
  if (hi == 0) li_l[r32] = l_reg; asm volatile("s_waitcnt lgkmcnt(0)" ::: "memory");
  int hi_o = hi; asm volatile("" : "+v"(hi_o));
  bf16* Ow = Ob + (size_t)(wid * QBLK + 4 * hi_o) * ldo;
#pragma unroll
  for (int r = 0; r < 16; ++r) { const int orow = crow(r, 0); const float rl = __builtin_amdgcn_rcpf(li_l[orow + 4 * hi_o]);
#pragma unroll
    for (int d0 = 0; d0 < 4; ++d0) { const float v = o[d0][r] * rl; ((GAS bf16*)Ow)[(size_t)orow * ldo + d0 * 32 + r32] = (bf16)(cvtpk(v, v) & 0xffffu); } }
#undef ATT_SLOAD
#undef ATT_SWRITE
#undef ATT_RESC
}
}
namespace pg8 {
struct EpiKV {
    static constexpr bool PERM = true;
    bf16_t* KV; bf16_t* KF; const float* gkn; const float* KPE; const float* SSK; const float* RT; PG8_LAS float* tab;
    __device__ __forceinline__ void operator()(const f32x4 (&acc)[2][2][4][2], const Unit& u, int wr, int wc, int fr, int fq) const {
        const int h = u.pn, row0 = u.pm * BM + wr * 64 + fr, c8 = wc * 32 + 8 * fq;
        float sk[2][4];
#pragma unroll
        for (int ai = 0; ai < 2; ++ai)
#pragma unroll
            for (int m = 0; m < 4; ++m) { const f32x4 a = acc[ai][0][m][0], b = acc[ai][0][m][1]; sk[ai][m] = ((const PG8_GAS float*)SSK)[row0 + ai * HALF + m * 16];
                float s = (a[0] * a[0] + a[1] * a[1]) + (a[2] * a[2] + a[3] * a[3]) + (b[0] * b[0] + b[1] * b[1]) + (b[2] * b[2] + b[3] * b[3]);
                s += __shfl_xor(s, 16); s += __shfl_xor(s, 32);
                if (fq == 0) tab[(ai * HALF + wr * 64 + m * 16 + fr) * 4 + wc] = s; }
#pragma unroll
        for (int ai = 0; ai < 2; ++ai)
#pragma unroll
            for (int m = 0; m < 4; ++m) { const f32x4 v0 = acc[ai][1][m][0], v1 = acc[ai][1][m][1];
                u32x4 w; w.x = cvt_pk_bf16(v0[0], v0[1]); w.y = cvt_pk_bf16(v0[2], v0[3]); w.z = cvt_pk_bf16(v1[0], v1[1]); w.w = cvt_pk_bf16(v1[2], v1[3]);
                *(PG8_GAS u32x4*)(KV + (size_t)(row0 + ai * HALF + m * 16) * 4096 + h * 256 + 128 + c8) = w; }
        asm volatile("s_waitcnt lgkmcnt(0)" ::: "memory"); __builtin_amdgcn_s_barrier(); asm volatile("" ::: "memory");
        const f32x4 g0 = *(const PG8_GAS f32x4*)(gkn + c8), g1 = *(const PG8_GAS f32x4*)(gkn + c8 + 4);
#pragma unroll
        for (int ai = 0; ai < 2; ++ai)
#pragma unroll
            for (int m = 0; m < 4; ++m) { const int row = row0 + ai * HALF + m * 16; const f32x4 p = *(const PG8_LAS f32x4*)(tab + (ai * HALF + wr * 64 + m * 16 + fr) * 4);
                const float rs = rsqrtf(((p[0] + p[1]) + (p[2] + p[3]) + sk[ai][m]) * (1.f / 192.f) + 1e-6f);
                const f32x4 k0 = acc[ai][0][m][0] * rs * g0, k1 = acc[ai][0][m][1] * rs * g1;
                u32x4 w; w.x = cvt_pk_bf16(k0[0], k0[1]); w.y = cvt_pk_bf16(k0[2], k0[3]); w.z = cvt_pk_bf16(k1[0], k1[1]); w.w = cvt_pk_bf16(k1[2], k1[3]);
                *(PG8_GAS u32x4*)(KF + (size_t)row * 3072 + h * 192 + c8) = w; }
        { const int t_ = (wr * 4 + wc) * 64 + fq * 16 + fr, r = t_ >> 1, hf = t_ & 1, row = u.pm * BM + r;
          const f32x4 p = *(const PG8_LAS f32x4*)(tab + r * 4);
          const float rs = rsqrtf(((p[0] + p[1]) + (p[2] + p[3]) + ((const PG8_GAS float*)SSK)[row]) * (1.f / 192.f) + 1e-6f);
          const bool rot = row >= 8192 && row < 12288; const float* rt = RT + ((size_t)((row - 8192) & 2047) * 32 + 16 * hf) * 2;
          const float* kp = KPE + (size_t)row * 64 + 16 * hf; bf16_t* o = KF + (size_t)row * 3072 + h * 192 + 128 + 16 * hf;
#pragma unroll
          for (int q = 0; q < 2; ++q) {
              f32x4 a0 = *(const PG8_GAS f32x4*)(kp + 8 * q), a1 = *(const PG8_GAS f32x4*)(kp + 8 * q + 4), b0 = *(const PG8_GAS f32x4*)(kp + 32 + 8 * q), b1 = *(const PG8_GAS f32x4*)(kp + 32 + 8 * q + 4);
              a0 = a0 * rs * *(const PG8_GAS f32x4*)(gkn + 128 + 16 * hf + 8 * q); a1 = a1 * rs * *(const PG8_GAS f32x4*)(gkn + 128 + 16 * hf + 8 * q + 4);
              b0 = b0 * rs * *(const PG8_GAS f32x4*)(gkn + 160 + 16 * hf + 8 * q); b1 = b1 * rs * *(const PG8_GAS f32x4*)(gkn + 160 + 16 * hf + 8 * q + 4);
              float x1[8] = {a0[0], a0[1], a0[2], a0[3], a1[0], a1[1], a1[2], a1[3]}, x2[8] = {b0[0], b0[1], b0[2], b0[3], b1[0], b1[1], b1[2], b1[3]};
              if (rot) {
#pragma unroll
                  for (int e2 = 0; e2 < 4; ++e2) { const f32x4 cs = *(const PG8_GAS f32x4*)(rt + (8 * q + 2 * e2) * 2);
                      const float y0 = x1[2 * e2] * cs[0] - x2[2 * e2] * cs[1], z0 = x1[2 * e2] * cs[1] + x2[2 * e2] * cs[0];
                      const float y1 = x1[2 * e2 + 1] * cs[2] - x2[2 * e2 + 1] * cs[3], z1 = x1[2 * e2 + 1] * cs[3] + x2[2 * e2 + 1] * cs[2];
                      x1[2 * e2] = y0; x2[2 * e2] = z0; x1[2 * e2 + 1] = y1; x2[2 * e2 + 1] = z1; } }
              u32x4 w1, w2; w1.x = cvt_pk_bf16(x1[0], x1[1]); w1.y = cvt_pk_bf16(x1[2], x1[3]); w1.z = cvt_pk_bf16(x1[4], x1[5]); w1.w = cvt_pk_bf16(x1[6], x1[7]);
              w2.x = cvt_pk_bf16(x2[0], x2[1]); w2.y = cvt_pk_bf16(x2[2], x2[3]); w2.z = cvt_pk_bf16(x2[4], x2[5]); w2.w = cvt_pk_bf16(x2[6], x2[7]);
              *(PG8_GAS u32x4*)(o + 8 * q) = w1; *(PG8_GAS u32x4*)(o + 32 + 8 * q) = w2; } }
    }
};
}
__device__ __forceinline__ void rope_table(const Args& a, int tid, int vcu, int G) {
    f32x2* RT = (f32x2*)(a.ws + WS_ROPE);
    for (int e = vcu * NTHR + tid; e < 2048 * 32; e += G * NTHR) { const int t = e >> 5, i = e & 31;
        const float inv = exp2f(-(float)(i & 15) * (13.287712379549449f / 16.f));
        const float ang = (float)(i < 16 ? (t >> 6) : (t & 63)) * inv; float s, c; sincosf(ang, &s, &c); RT[e] = (f32x2){c, s}; }
}
__device__ __forceinline__ void mla_thin_b(const Args& a, int j, int lane, int gw, int NGW) {
    OPAQUE_V(lane); PH_PTRS; OPAQUE_S(gw); OPAQUE_S(NGW);
    const bf16* QRAW = (const bf16*)(ws + WS_S + S_QRAW); bf16* QN = (bf16*)(ws + WS_S + S_QN);
    const bf16* KVRAW = (const bf16*)(ws + WS_S + S_KVRAW); bf16* KF = (bf16*)(ws + WS_S + S_KF);
    const float* KPE = (const float*)(ws + WS_S + S_KPE); const float* SSK = (const float*)(ws + WS_SSK);
    const f32x2* RT = (const f32x2*)(ws + WS_ROPE);
    const float* gqn = a.in[I_GQN] + (size_t)j * 192; const float* gkn = a.in[I_GKN] + (size_t)j * 192;
    const int grp = lane >> 4, s = lane & 15;
    float gq[12], gk[12];
#pragma unroll
    for (int e = 0; e < 8; ++e) { gq[e] = gqn[8 * s + e]; gk[e] = gkn[8 * s + e]; }
    gq[8] = gqn[128 + 2 * s]; gq[9] = gqn[129 + 2 * s]; gq[10] = gqn[160 + 2 * s]; gq[11] = gqn[161 + 2 * s];
    gk[8] = gkn[128 + 2 * s]; gk[9] = gkn[129 + 2 * s]; gk[10] = gkn[160 + 2 * s]; gk[11] = gkn[161 + 2 * s];
    const int NQI = 0, NKI = MKV * 4;
    for (int it = gw; it < NQI + NKI; it += NGW) {
        const bool isq = it < NQI; const int r4 = isq ? it : it - NQI; const int row = r4 >> 2, h = (r4 & 3) * 4 + grp;
        float x[12];
        if (isq) {
            const bf16* p = QRAW + (size_t)row * 3072 + h * 192;
            const v4u w = *(const GAS v4u*)(p + 8 * s); const unsigned w1 = *(const GAS unsigned*)(p + 128 + 2 * s), w2 = *(const GAS unsigned*)(p + 160 + 2 * s);
            x[0] = bf_lo(w.x); x[1] = bf_hi(w.x); x[2] = bf_lo(w.y); x[3] = bf_hi(w.y); x[4] = bf_lo(w.z); x[5] = bf_hi(w.z); x[6] = bf_lo(w.w); x[7] = bf_hi(w.w);
            x[8] = bf_lo(w1); x[9] = bf_hi(w1); x[10] = bf_lo(w2); x[11] = bf_hi(w2);
        } else {
            const bf16* p = KVRAW + (size_t)row * 4096 + h * 256;
            const v4u w = *(const GAS v4u*)(p + 8 * s);
            x[0] = bf_lo(w.x); x[1] = bf_hi(w.x); x[2] = bf_lo(w.y); x[3] = bf_hi(w.y); x[4] = bf_lo(w.z); x[5] = bf_hi(w.z); x[6] = bf_lo(w.w); x[7] = bf_hi(w.w);
            const f32x2 k1 = *(const GAS f32x2*)(KPE + (size_t)row * 64 + 2 * s), k2 = *(const GAS f32x2*)(KPE + (size_t)row * 64 + 32 + 2 * s);
            x[8] = k1.x; x[9] = k1.y; x[10] = k2.x; x[11] = k2.y;
        }
        float ss = 0.f;
#pragma unroll
        for (int e = 0; e < 8; ++e) ss += x[e] * x[e];
        if (isq) { ss += x[8] * x[8] + x[9] * x[9] + x[10] * x[10] + x[11] * x[11]; ss = sum16(ss); }
        else { ss = sum16(ss) + SSK[row]; }
        const float rs = rsqrtf(ss * (1.f / 192.f) + EPS);
#pragma unroll
        for (int e = 0; e < 12; ++e) x[e] = x[e] * rs * (isq ? gq[e] : gk[e]);
        if (row >= MP && row < MALL) {
            const int t = (row - MP) & 2047; const f32x2 cs0 = RT[t * 32 + 2 * s], cs1 = RT[t * 32 + 2 * s + 1];
            const float a0 = x[8] * cs0.x - x[10] * cs0.y, b0 = x[8] * cs0.y + x[10] * cs0.x, a1 = x[9] * cs1.x - x[11] * cs1.y, b1 = x[9] * cs1.y + x[11] * cs1.x;
            x[8] = a0; x[9] = a1; x[10] = b0; x[11] = b1;
        }
        bf16* o = (isq ? QN : KF) + (size_t)row * 3072 + h * 192;
        *(GAS v4u*)(o + 8 * s) = (v4u){pk2(x[0], x[1]), pk2(x[2], x[3]), pk2(x[4], x[5]), pk2(x[6], x[7])};
        *(GAS unsigned*)(o + 128 + 2 * s) = pk2(x[8], x[9]); *(GAS unsigned*)(o + 160 + 2 * s) = pk2(x[10], x[11]);
    }
}
__device__ __forceinline__ void mla_attn_phase(const Args& a, int j, LAS unsigned char* lds, int tid, int vcu, int G) {
    OPAQUE_V(tid); PH_PTRS; OPAQUE_S(vcu); OPAQUE_S(G);
    const bf16* QN = (const bf16*)(ws + WS_S + S_QRAW); const bf16* KF = (const bf16*)(ws + WS_S + S_KF); const bf16* KVRAW = (const bf16*)(ws + WS_S + S_KVRAW);
    bf16* AO = (bf16*)(ws + WS_S + S_AO); const float* gqn = a.in[I_GQN] + (size_t)j * 192; const float* RT = (const float*)(ws + WS_ROPE);
    for (int u = vcu; u < 768; u += G) {
        int q0, h, NT; att::KvSrc src; const float* qrope = nullptr;
        if (u < 256) { const int b = u >> 7, qb = u & 7; h = (u >> 3) & 15; q0 = MP + b * 2048 + qb * 256; src = att::KvSrc{MP + b * 2048, 32, MALL + b * 256, 4}; NT = 36; qrope = RT + (size_t)(qb * 256) * 64; }
        else { const int v = u - 256, b = v >> 4; h = v & 15; q0 = b * 256; src = att::KvSrc{b * 256, 4, 0, 1}; NT = 4; }
        att::attn_unit<192, 0, 3072, 3072, 4096, DM, 1>(QN + (size_t)q0 * 3072 + h * 192, KF + h * 192, KVRAW + h * 256 + 128, AO + (size_t)q0 * DM + h * 128, src, NT, att::NatMask{0, 0, 0, nullptr}, (LAS char*)lds, tid, gqn, qrope);
    }
}
namespace pg8 {
struct EpiHg {
    static constexpr bool PERM = true;
    unsigned char* ws;
    __device__ __forceinline__ void operator()(const f32x4 (&acc)[2][2][4][2], const Unit& u, int wr, int wc, int fr, int fq) const {
        const int region = u.pn >> 3, row0 = u.pm * BM + wr * 64 + fr, col0 = (u.pn & 7) * BM + wc * 32 + 8 * fq;
        if (region == 1 || region == 2) {
            const int d = region - 1;
            f32x4 lbv[2][2];
#pragma unroll
            for (int bj = 0; bj < 2; ++bj)
#pragma unroll
                for (int n = 0; n < 2; ++n) lbv[bj][n] = *(const PG8_GAS f32x4*)((const float*)(ws + WS_LB) + d * 2048 + col0 + bj * HALF + 4 * n);
            bf16_t* K = (bf16_t*)(ws + WS_S + S_HK) + (size_t)d * 12288 * 2048; float* Gd = (float*)(ws + WS_U) + (size_t)d * 12288 * 2048;
#pragma unroll
            for (int ai = 0; ai < 2; ++ai)
#pragma unroll
                for (int m = 0; m < 4; ++m) { const size_t ro = (size_t)(row0 + ai * HALF + m * 16) * 2048 + col0;
#pragma unroll
                    for (int bj = 0; bj < 2; ++bj) { f32x4 kk[2], gg[2];
#pragma unroll
                        for (int n = 0; n < 2; ++n)
#pragma unroll
                            for (int e = 0; e < 4; ++e) { const float z = acc[ai][bj][m][n][e]; const float sn = __builtin_amdgcn_rcpf(1.f + __expf(z));
                                const float k = (1.f - lbv[bj][n][e]) * sn; kk[n][e] = k; gg[n][e] = __log2f(1.f - k); }
                        u32x4 w; w.x = cvt_pk_bf16(kk[0][0], kk[0][1]); w.y = cvt_pk_bf16(kk[0][2], kk[0][3]); w.z = cvt_pk_bf16(kk[1][0], kk[1][1]); w.w = cvt_pk_bf16(kk[1][2], kk[1][3]);
                        *(PG8_GAS u32x4*)(K + ro + bj * HALF) = w; *(PG8_GAS f32x4*)(Gd + ro + bj * HALF) = gg[0]; *(PG8_GAS f32x4*)(Gd + ro + bj * HALF + 4) = gg[1]; } }
        } else {
            bf16_t* O = (bf16_t*)(ws + WS_S + (region == 0 ? S_HQ : region == 3 ? S_HV : S_HGS)); const bool act = region != 3;
#pragma unroll
            for (int ai = 0; ai < 2; ++ai)
#pragma unroll
                for (int m = 0; m < 4; ++m) { bf16_t* rowp = O + (size_t)(row0 + ai * HALF + m * 16) * 2048 + col0;
#pragma unroll
                    for (int bj = 0; bj < 2; ++bj) { f32x4 v0 = acc[ai][bj][m][0], v1 = acc[ai][bj][m][1];
                        if (act) {
#pragma unroll
                            for (int e = 0; e < 4; ++e) { v0[e] = v0[e] * __builtin_amdgcn_rcpf(1.f + __expf(-v0[e])); v1[e] = v1[e] * __builtin_amdgcn_rcpf(1.f + __expf(-v1[e])); } }
                        u32x4 w; w.x = cvt_pk_bf16(v0[0], v0[1]); w.y = cvt_pk_bf16(v0[2], v0[3]); w.z = cvt_pk_bf16(v1[0], v1[1]); w.w = cvt_pk_bf16(v1[2], v1[3]);
                        *(PG8_GAS u32x4*)(rowp + bj * HALF) = w; } }
        }
    }
};
}

namespace hg {
constexpr int PQ = 272, PK = 80;
constexpr int OFF_QM = 0, OFF_KM = 32 * PQ, OFF_V = 2 * 32 * PQ, OFF_ATT = 3 * 32 * PQ, OFF_C2 = OFF_ATT + 32 * PK, OFF_C3 = OFF_C2 + 512, BUF = OFF_C3 + 512;
constexpr int OFF_TOT = 2 * BUF, TOT_BYTES = 8 * 128 * 4;
constexpr int OFF_OST = OFF_TOT + 2 * TOT_BYTES;
constexpr int OFF_STG = OFF_OST + 32 * PQ, STG_SLOT = 40960;
static_assert(OFF_STG + 2 * STG_SLOT <= LDSCTL_OFF, "scan LDS (must stay below the control words)");
typedef short bf16x8 __attribute__((ext_vector_type(8)));
typedef short s16x4 __attribute__((ext_vector_type(4)));
struct Chain { int rb, N, d, h; const float* S0; float* Sout; };
template <int OFF> __device__ __forceinline__ s16x4 tr_read(int addr) { s16x4 r; asm volatile("ds_read_b64_tr_b16 %0, %1 offset:%2" : "=&v"(r) : "v"(addr), "i"(OFF) : "memory"); return r; }
__device__ __forceinline__ unsigned bfmul2(unsigned w, float e0, float e1) { return pk2(bf_lo(w) * e0, bf_hi(w) * e1); }

__device__ __forceinline__ void scan_chain(const Chain ch, const bf16* __restrict__ HQ, const bf16* __restrict__ HK, const float* __restrict__ HG, const bf16* __restrict__ HV,
                                           bf16* __restrict__ OD, LAS unsigned char* lds, int tid) {
    const int lane = tid & 63, w = tid >> 6, l15 = lane & 15, q4 = lane >> 4;
    const int k2 = lane;
    const int vt = tid >> 4, v8 = (tid & 15) * 8;
    const int nc = ch.N >> 5, hc = ch.h * 128;
    f32x4 S[8];
    if (ch.S0) {
#pragma unroll
        for (int kt = 0; kt < 8; ++kt)
#pragma unroll
            for (int r = 0; r < 4; ++r) S[kt][r] = ((const GAS float*)ch.S0)[(size_t)(16 * kt + 4 * q4 + r) * 128 + 16 * w + l15];
    } else {
#pragma unroll
        for (int kt = 0; kt < 8; ++kt) S[kt] = (f32x4){0.f, 0.f, 0.f, 0.f};
    }
#define HG_ROW(c, t) (ch.rb + (ch.d ? ch.N - 1 - (32 * (c) + (t)) : 32 * (c) + (t)))
    struct InSet { f32x2 g[4]; unsigned q[4], k[4]; v4u v; };
    f32x2 cl[4]; unsigned cq[4], ck[4]; v4u cv;
#define HG_DMA(c) do { LAS unsigned char* sl_ = lds + OFF_STG + ((c) & 1) * STG_SLOT; \
        _Pragma("unroll") for (int i_ = 0; i_ < 2; ++i_) __builtin_amdgcn_global_load_lds((const unsigned*)(HG + (size_t)HG_ROW(c, 4 * w + 2 * i_ + (lane >> 5)) * 2048 + hc + (lane & 31) * 4), (LAS unsigned*)(sl_ + (4 * w + 2 * i_) * 512), 16, 0, 0); \
        { const size_t ro_ = (size_t)HG_ROW(c, 4 * w + (lane >> 4)) * 2048 + hc + (lane & 15) * 8; \
          __builtin_amdgcn_global_load_lds((const unsigned*)(HQ + ro_), (LAS unsigned*)(sl_ + 16384 + 4 * w * 256), 16, 0, 0); \
          __builtin_amdgcn_global_load_lds((const unsigned*)(HK + ro_), (LAS unsigned*)(sl_ + 24576 + 4 * w * 256), 16, 0, 0); \
          __builtin_amdgcn_global_load_lds((const unsigned*)(HV + ro_), (LAS unsigned*)(sl_ + 32768 + 4 * w * 256), 16, 0, 0); } } while (0)
#define HG_P1(c) do { const LAS unsigned char* sl_ = lds + OFF_STG + ((c) & 1) * STG_SLOT; f32x2 run = (f32x2){0.f, 0.f}; \
        _Pragma("unroll") for (int i = 0; i < 4; ++i) { run = run + *(const LAS f32x2*)(sl_ + (4 * w + i) * 512 + k2 * 8); cl[i] = run; cq[i] = *(const LAS unsigned*)(sl_ + 16384 + (4 * w + i) * 256 + k2 * 4); ck[i] = *(const LAS unsigned*)(sl_ + 24576 + (4 * w + i) * 256 + k2 * 4); } \
        cv = *(const LAS v4u*)(sl_ + 32768 + vt * 256 + v8 * 2); \
        *(LAS f32x2*)(lds + OFF_TOT + ((c) & 1) * TOT_BYTES + (w * 128 + 2 * k2) * 4) = run; } while (0)
    HG_DMA(0); HG_DMA(1);
    asm volatile("s_waitcnt vmcnt(0)" ::: "memory"); HG_P1(0); LDS_WAIT(); asm volatile("" ::: "memory");
    HG_DMA(2);
    LDS_WAIT(); __builtin_amdgcn_s_barrier(); asm volatile("" ::: "memory");
    const int traddr = (int)(uintptr_t)lds + (8 * q4 + (l15 >> 2)) * PQ + (l15 & 3) * 8;
    auto mstage = [&](const int pc) {
        { LAS unsigned char* B = lds + (pc & 1) * BUF; const int tb = traddr + (pc & 1) * BUF;
            const s16x4 v0 = tr_read<0>(tb + OFF_V + 32 * w), v1 = tr_read<4 * PQ>(tb + OFF_V + 32 * w);
            bf16x8 aat[2]; v2u aq0[2][4], aq1[2][4];
#pragma unroll
            for (int tt = 0; tt < 2; ++tt) { aat[tt] = *(const LAS bf16x8*)(B + OFF_ATT + (16 * tt + l15) * PK + 16 * q4);
#pragma unroll
                for (int ks = 0; ks < 4; ++ks) { aq0[tt][ks] = *(const LAS v2u*)(B + OFF_QM + (16 * tt + l15) * PQ + (32 * ks + 4 * q4) * 2); aq1[tt][ks] = *(const LAS v2u*)(B + OFF_QM + (16 * tt + l15) * PQ + (32 * ks + 16 + 4 * q4) * 2); } }
            f32x4 c2v[8];
#pragma unroll
            for (int kt = 0; kt < 8; ++kt) c2v[kt] = *(const LAS f32x4*)(B + OFF_C2 + (16 * kt + 4 * q4) * 4);
            LDS_WAIT(); __builtin_amdgcn_sched_barrier(0);
            const bf16x8 bv = (bf16x8){v0[0], v0[1], v0[2], v0[3], v1[0], v1[1], v1[2], v1[3]};
            f32x4 o2[2];
#pragma unroll
            for (int kt = 0; kt < 8; ++kt) S[kt] = S[kt] * c2v[kt];
#pragma unroll
            for (int tt = 0; tt < 2; ++tt) o2[tt] = __builtin_amdgcn_mfma_f32_16x16x32_bf16(aat[tt], bv, (f32x4){0.f, 0.f, 0.f, 0.f}, 0, 0, 0);
#pragma unroll
            for (int ks = 0; ks < 4; ++ks) {
                const v4u sb = (v4u){pk2(S[2 * ks][0], S[2 * ks][1]), pk2(S[2 * ks][2], S[2 * ks][3]), pk2(S[2 * ks + 1][0], S[2 * ks + 1][1]), pk2(S[2 * ks + 1][2], S[2 * ks + 1][3])};
                const bf16x8 bs = __builtin_bit_cast(bf16x8, sb);
#pragma unroll
                for (int tt = 0; tt < 2; ++tt) { const bf16x8 aq = __builtin_bit_cast(bf16x8, ((v4u){aq0[tt][ks].x, aq0[tt][ks].y, aq1[tt][ks].x, aq1[tt][ks].y}));
                    o2[tt] = __builtin_amdgcn_mfma_f32_16x16x32_bf16(aq, bs, o2[tt], 0, 0, 0); }
            }
            s16x4 ke0[8], ke1[8]; f32x4 elv[8];
#define HG_KRD(kt) ke0[kt] = tr_read<32 * (kt)>(tb + OFF_KM); ke1[kt] = tr_read<32 * (kt) + 4 * PQ>(tb + OFF_KM)
            HG_KRD(0); HG_KRD(1); HG_KRD(2); HG_KRD(3); HG_KRD(4); HG_KRD(5); HG_KRD(6); HG_KRD(7);
#undef HG_KRD
#pragma unroll
            for (int kt = 0; kt < 8; ++kt) elv[kt] = *(const LAS f32x4*)(B + OFF_C3 + (16 * kt + 4 * q4) * 4);
            LDS_WAIT(); __builtin_amdgcn_sched_barrier(0);
#pragma unroll
            for (int kt = 0; kt < 8; ++kt) { const bf16x8 ak = (bf16x8){ke0[kt][0], ke0[kt][1], ke0[kt][2], ke0[kt][3], ke1[kt][0], ke1[kt][1], ke1[kt][2], ke1[kt][3]};
                S[kt] = __builtin_amdgcn_mfma_f32_16x16x32_bf16(ak, bv, S[kt], 0, 0, 0) * elv[kt]; }
#pragma unroll
            for (int tt = 0; tt < 2; ++tt)
#pragma unroll
                for (int r = 0; r < 4; ++r) *(LAS unsigned short*)(lds + OFF_OST + (16 * tt + 4 * q4 + r) * PQ + (16 * w + l15) * 2) = (unsigned short)(pk2(o2[tt][r], 0.f) & 0xffffu);
        }
    };
    for (int c = 0; c < nc; ++c) {
        if (c > 0) mstage(c - 1);
        LAS unsigned char* B = lds + (c & 1) * BUF;
        { const LAS f32x2* T = (const LAS f32x2*)(lds + OFF_TOT + (c & 1) * TOT_BYTES) + k2;
          f32x2 off = (f32x2){0.f, 0.f}, cm = (f32x2){0.f, 0.f}, last = (f32x2){0.f, 0.f};
#pragma unroll
          for (int sgm = 0; sgm < 8; ++sgm) { const f32x2 tv = T[sgm * 64]; if (sgm < w) off = off + tv; if (sgm < 4) cm = cm + tv; last = last + tv; }
#pragma unroll
          for (int i = 0; i < 4; ++i) { const f32x2 cu = off + cl[i]; const int t = 4 * w + i;
              *(LAS unsigned*)(B + OFF_QM + t * PQ + k2 * 4) = bfmul2(cq[i], __builtin_amdgcn_exp2f(cu.x - cm.x), __builtin_amdgcn_exp2f(cu.y - cm.y));
              *(LAS unsigned*)(B + OFF_KM + t * PQ + k2 * 4) = bfmul2(ck[i], __builtin_amdgcn_exp2f(cm.x - cu.x), __builtin_amdgcn_exp2f(cm.y - cu.y));
 }
          if (w == 0) { *(LAS f32x2*)(B + OFF_C2 + k2 * 8) = (f32x2){__builtin_amdgcn_exp2f(cm.x), __builtin_amdgcn_exp2f(cm.y)}; *(LAS f32x2*)(B + OFF_C3 + k2 * 8) = (f32x2){__builtin_amdgcn_exp2f(last.x - cm.x), __builtin_amdgcn_exp2f(last.y - cm.y)}; }
          *(LAS v4u*)(B + OFF_V + vt * PQ + v8 * 2) = cv; }
        { asm volatile("s_waitcnt vmcnt(5)" ::: "memory"); HG_P1(c + 1); LDS_WAIT(); asm volatile("" ::: "memory");
          const int cn = c + 3 < nc ? c + 3 : nc - 1; HG_DMA(cn); }
        LDS_WAIT(); __builtin_amdgcn_s_barrier(); asm volatile("" ::: "memory");
        if (c > 0) *(GAS v4u*)(OD + (size_t)HG_ROW(c - 1, vt) * 2048 + hc + v8) = *(const LAS v4u*)(lds + OFF_OST + vt * PQ + v8 * 2);
        if (w < 4) {
            const int tt = w >> 1, st = w & 1; f32x4 at = (f32x4){0.f, 0.f, 0.f, 0.f};
            if (!(tt == 0 && st == 1)) {
                bf16x8 af[4], bfr[4];
#pragma unroll
                for (int ks = 0; ks < 4; ++ks) { af[ks] = *(const LAS bf16x8*)(B + OFF_QM + (16 * tt + l15) * PQ + (32 * ks + 8 * q4) * 2); bfr[ks] = *(const LAS bf16x8*)(B + OFF_KM + (16 * st + l15) * PQ + (32 * ks + 8 * q4) * 2); }
                LDS_WAIT(); __builtin_amdgcn_sched_barrier(0);
#pragma unroll
                for (int ks = 0; ks < 4; ++ks) at = __builtin_amdgcn_mfma_f32_16x16x32_bf16(af[ks], bfr[ks], at, 0, 0, 0);
            }
            const int s_ = 16 * st + l15;
#pragma unroll
            for (int r = 0; r < 4; ++r) { const int t = 16 * tt + 4 * q4 + r; const float val = (s_ <= t) ? at[r] : 0.f;
                *(LAS unsigned short*)(B + OFF_ATT + t * PK + s_ * 2) = (unsigned short)(pk2(val, 0.f) & 0xffffu); }
        }
        LDS_WAIT(); __builtin_amdgcn_s_barrier(); asm volatile("" ::: "memory");
    }
    mstage(nc - 1);
    LDS_WAIT(); __builtin_amdgcn_s_barrier(); asm volatile("" ::: "memory");
    *(GAS v4u*)(OD + (size_t)HG_ROW(nc - 1, vt) * 2048 + hc + v8) = *(const LAS v4u*)(lds + OFF_OST + vt * PQ + v8 * 2);
    if (ch.Sout) {
#pragma unroll
        for (int kt = 0; kt < 8; ++kt)
#pragma unroll
            for (int r = 0; r < 4; ++r) __builtin_nontemporal_store(S[kt][r] * DBG_SCALE, (GAS float*)ch.Sout + (size_t)(16 * kt + 4 * q4 + r) * 128 + 16 * w + l15);
    }
    __builtin_amdgcn_s_barrier();
#undef HG_ROW
#undef HG_LOAD
#undef HG_P1
}
}

__device__ __forceinline__ void hg_scan_phase(const Args& a, LAS unsigned char* lds, int tid, int vcu, int G) {
    OPAQUE_V(tid); PH_PTRS; OPAQUE_S(vcu); OPAQUE_S(G);
    const bf16* HQ = (const bf16*)(ws + WS_S + S_HQ); const bf16* HK = (const bf16*)(ws + WS_S + S_HK); const float* HGp = (const float*)(ws + WS_U);
    const bf16* HV = (const bf16*)(ws + WS_S + S_HV); bf16* OF = (bf16*)(ws + WS_S + S_OF);
    const int NS = G > 128 ? 64 : 0;
    const int first = vcu < NS ? vcu : NS + (vcu - NS), step = vcu < NS ? 1088 : G - NS;
    const int reps = ((DBG_REP_MASK >> 16) & 1) && vcu < NS ? 3 : ((DBG_REP_MASK >> 17) & 1) && vcu >= NS ? 3 : 1;
    for (int rep_ = 0; rep_ < reps; ++rep_)
    for (int ci = first; ci < 1088; ci += step) {
        const bool lat = ci < 64; const int e = lat ? ci : ci - 64, b = e >> 5, d = (e >> 4) & 1, h = e & 15;
        const size_t so = ((size_t)((b * 2 + d) * 16 + h)) * 16384;
        hg::Chain ch{lat ? MP + b * 2048 : b * 256, lat ? 2048 : 256, d, h, lat ? a.in[I_SHG] + so : nullptr, lat ? nullptr : out + O_HG + so};
        hg::scan_chain(ch, HQ, HK + (size_t)d * MALL * DM, HGp + (size_t)d * MALL * DM, HV, OF + (size_t)d * MALL * DM, lds, tid);
    }
}

__device__ __forceinline__ void hg_thin_c(const Args& a, int lane, int gw, int NGW) {
    OPAQUE_V(lane); PH_PTRS; OPAQUE_S(gw); OPAQUE_S(NGW);
    const bf16* OF = (const bf16*)(ws + WS_S + S_OF); const bf16* HGS = (const bf16*)(ws + WS_S + S_HGS); bf16* AO = (bf16*)(ws + WS_S + S_AO);
    const int grp = lane >> 4, s = lane & 15;
    const f32x4 g0 = *(const GAS f32x4*)(a.in[I_GHO] + 8 * s), g1 = *(const GAS f32x4*)(a.in[I_GHO] + 8 * s + 4);
    for (int it = gw; it < MALL * 4; it += NGW) {
        const int row = it >> 2, h = (it & 3) * 4 + grp; const size_t o_ = (size_t)row * DM + h * 128 + 8 * s;
        const v4u of = *(const GAS v4u*)(OF + o_), ob = *(const GAS v4u*)(OF + (size_t)MALL * DM + o_);
        const f32x4 a0 = (f32x4){bf_lo(of.x) + bf_lo(ob.x), bf_hi(of.x) + bf_hi(ob.x), bf_lo(of.y) + bf_lo(ob.y), bf_hi(of.y) + bf_hi(ob.y)}, a1 = (f32x4){bf_lo(of.z) + bf_lo(ob.z), bf_hi(of.z) + bf_hi(ob.z), bf_lo(of.w) + bf_lo(ob.w), bf_hi(of.w) + bf_hi(ob.w)};
        float ss = (a0.x * a0.x + a0.y * a0.y) + (a0.z * a0.z + a0.w * a0.w) + (a1.x * a1.x + a1.y * a1.y) + (a1.z * a1.z + a1.w * a1.w);
        const float rs = rsqrtf(sum16(ss) * (1.f / 128.f) + EPS);
        const v4u gw_ = *(const GAS v4u*)(HGS + o_);
        const f32x4 y0 = a0 * rs * g0 * (f32x4){bf_lo(gw_.x), bf_hi(gw_.x), bf_lo(gw_.y), bf_hi(gw_.y)}, y1 = a1 * rs * g1 * (f32x4){bf_lo(gw_.z), bf_hi(gw_.z), bf_lo(gw_.w), bf_hi(gw_.w)};
        *(GAS v4u*)(AO + o_) = (v4u){pk2(y0.x, y0.y), pk2(y0.z, y0.w), pk2(y1.x, y1.y), pk2(y1.z, y1.w)};
    }
}
namespace pg8 {
struct EpiNat {
    static constexpr bool PERM = true;
    bf16_t* QKV; bf16_t* KN; float* outk; float* outv; const float* gk; PG8_LAS float* tab;
    __device__ __forceinline__ void operator()(const f32x4 (&acc)[2][2][4][2], const Unit& u, int wr, int wc, int fr, int fq) const {
        const int region = u.pn >> 3, row0 = u.pm * BM + wr * 64 + fr, ct = (u.pn & 7) * BM + wc * 32 + 8 * fq;
        if (region == 1) {
#pragma unroll
            for (int ai = 0; ai < 2; ++ai)
#pragma unroll
                for (int m = 0; m < 4; ++m)
#pragma unroll
                    for (int bj = 0; bj < 2; ++bj) { const f32x4 a = acc[ai][bj][m][0], b = acc[ai][bj][m][1];
                        float s = (a[0] * a[0] + a[1] * a[1]) + (a[2] * a[2] + a[3] * a[3]) + (b[0] * b[0] + b[1] * b[1]) + (b[2] * b[2] + b[3] * b[3]);
                        s += __shfl_xor(s, 16); s += __shfl_xor(s, 32);
                        if (fq == 0) tab[((ai * HALF + wr * 64 + m * 16 + fr) * 2 + bj) * 4 + wc] = s; }
            asm volatile("s_waitcnt lgkmcnt(0)" ::: "memory"); __builtin_amdgcn_s_barrier(); asm volatile("" ::: "memory");
            f32x4 g0[2], g1[2];
#pragma unroll
            for (int bj = 0; bj < 2; ++bj) { g0[bj] = *(const PG8_GAS f32x4*)(gk + wc * 32 + 8 * fq); g1[bj] = *(const PG8_GAS f32x4*)(gk + wc * 32 + 8 * fq + 4); }
#pragma unroll
            for (int ai = 0; ai < 2; ++ai)
#pragma unroll
                for (int m = 0; m < 4; ++m) { const int row = row0 + ai * HALF + m * 16;
#pragma unroll
                    for (int bj = 0; bj < 2; ++bj) { const f32x4 p = *(const PG8_LAS f32x4*)(tab + ((ai * HALF + wr * 64 + m * 16 + fr) * 2 + bj) * 4);
                        const float rs = rsqrtf(((p[0] + p[1]) + (p[2] + p[3])) * (1.f / 128.f) + 1e-6f);
                        const f32x4 k0 = acc[ai][bj][m][0] * rs * g0[bj], k1 = acc[ai][bj][m][1] * rs * g1[bj];
                        u32x4 w; w.x = cvt_pk_bf16(k0[0], k0[1]); w.y = cvt_pk_bf16(k0[2], k0[3]); w.z = cvt_pk_bf16(k1[0], k1[1]); w.w = cvt_pk_bf16(k1[2], k1[3]);
                        *(PG8_GAS u32x4*)(KN + (size_t)row * 2048 + ct + bj * HALF) = w;
                        if (row < 8192) { __builtin_nontemporal_store(k0 * DBG_SCALE, (PG8_GAS f32x4*)(outk + (size_t)row * 2048 + ct + bj * HALF)); __builtin_nontemporal_store(k1 * DBG_SCALE, (PG8_GAS f32x4*)(outk + (size_t)row * 2048 + ct + bj * HALF + 4)); } } }
        } else {
#pragma unroll
            for (int ai = 0; ai < 2; ++ai)
#pragma unroll
                for (int m = 0; m < 4; ++m) { const int row = row0 + ai * HALF + m * 16;
#pragma unroll
                    for (int bj = 0; bj < 2; ++bj) { const f32x4 v0 = acc[ai][bj][m][0], v1 = acc[ai][bj][m][1];
                        u32x4 w; w.x = cvt_pk_bf16(v0[0], v0[1]); w.y = cvt_pk_bf16(v0[2], v0[3]); w.z = cvt_pk_bf16(v1[0], v1[1]); w.w = cvt_pk_bf16(v1[2], v1[3]);
                        *(PG8_GAS u32x4*)(QKV + (size_t)row * 6144 + region * 2048 + ct + bj * HALF) = w;
                        if (region == 2 && row < 8192) { __builtin_nontemporal_store(v0 * DBG_SCALE, (PG8_GAS f32x4*)(outv + (size_t)row * 2048 + ct + bj * HALF)); __builtin_nontemporal_store(v1 * DBG_SCALE, (PG8_GAS f32x4*)(outv + (size_t)row * 2048 + ct + bj * HALF + 4)); } } }
        }
    }
};
}
__device__ __forceinline__ void nat_cache_rows(const Args& a, int lane, int gw, int NGW) {
    OPAQUE_V(lane); PH_PTRS; OPAQUE_S(gw); OPAQUE_S(NGW);
    bf16* QKV = (bf16*)(ws + WS_S + S_NQKV); bf16* KN = (bf16*)(ws + WS_S + S_NKN);
    for (int it = gw; it < 512 * 4; it += NGW) {
        const int row = MALL + (it >> 2), c = (it & 3) * 512 + 8 * lane; const size_t so = (size_t)(row - MALL) * DM + c;
        const f32x4 k0 = *(const GAS f32x4*)(a.in[I_CNK] + so), k1 = *(const GAS f32x4*)(a.in[I_CNK] + so + 4), v0 = *(const GAS f32x4*)(a.in[I_CNV] + so), v1 = *(const GAS f32x4*)(a.in[I_CNV] + so + 4);
        *(GAS v4u*)(KN + (size_t)row * DM + c) = (v4u){pk2(k0.x, k0.y), pk2(k0.z, k0.w), pk2(k1.x, k1.y), pk2(k1.z, k1.w)};
        *(GAS v4u*)(QKV + (size_t)row * 6144 + 4096 + c) = (v4u){pk2(v0.x, v0.y), pk2(v0.z, v0.w), pk2(v1.x, v1.y), pk2(v1.z, v1.w)};
    }
}
__device__ __forceinline__ void nat_attn_phase(const Args& a, LAS unsigned char* lds, int tid, int vcu, int G) {
    OPAQUE_V(tid); PH_PTRS; OPAQUE_S(vcu); OPAQUE_S(G);
    const bf16* QKV = (const bf16*)(ws + WS_S + S_NQKV); const bf16* KN = (const bf16*)(ws + WS_S + S_NKN); bf16* AO = (bf16*)(ws + WS_S + S_AO); const float* gq = a.in[I_GNQ];
    LAS float* rpb = (LAS float*)(lds + att::RPB_OFF);
    for (int u = vcu; u < 768; u += G) {
        if (u < 256) {
            const int b = u >> 7, h = (u >> 3) & 15, i = u & 7, q0 = MP + b * 2048 + i * 256;
            const int rlo = min(max(4 * i - 4, 0), 24), rhi = min(max(4 * i - 1, 0), 24) + 8, nrows = rhi - rlo;
            __syncthreads();
            for (int e = tid; e < 465; e += NTHR) rpb[e] = a.in[I_RPB][h * 465 + e] * 11.313708498984761f;
            __syncthreads();
            const att::KvSrc src{MALL + b * 256, 4, MP + b * 2048 + 64 * rlo, nrows};
            const att::NatMask nm{rlo, 4 * i + ((tid >> 6) >> 1), 32 * ((tid >> 6) & 1) + (tid & 31), rpb};
            att::attn_unit<128, 1, 6144, DM, 6144, DM, 1>(QKV + (size_t)q0 * 6144 + h * 128, KN + h * 128, QKV + 4096 + h * 128, AO + (size_t)q0 * DM + h * 128, src, 4 + nrows, nm, (LAS char*)lds, tid, gq, nullptr);
        } else {
            const int v = u - 256, b = v >> 4, h = v & 15, q0 = b * 256;
            const att::KvSrc src{b * 256, 4, 0, 1};
            att::attn_unit<128, 0, 6144, DM, 6144, DM, 1>(QKV + (size_t)q0 * 6144 + h * 128, KN + h * 128, QKV + 4096 + h * 128, AO + (size_t)q0 * DM + h * 128, src, 4, att::NatMask{0, 0, 0, nullptr}, (LAS char*)lds, tid, gq, nullptr);
        }
    }
}
constexpr int NPHASE = 2 + 10 * DEPTH;
__host__ __device__ constexpr bool phase_exists(int ph) {
    if (ph == 0 || ph == NPHASE - 1) return true;
    const int l = (ph - 1) / 10, k = (ph - 1) % 10, kind = l % 3;
    if (k == 2) return kind != 2;
    if (k == 3) return kind == 0;
    if (k == 4) return kind == 1;
    if (k == 5) return kind != 1;
    return true;
}

__global__ void __launch_bounds__(NTHR, 2) fwd(Args a) {
    extern __shared__ __attribute__((aligned(16))) unsigned char lds_[];
    LAS unsigned char* lds = (LAS unsigned char*)lds_;
#define tid ({ int t_ = threadIdx.x; asm volatile("" : "+v"(t_)); t_; })
#define lane (tid & 63)
#define wave (__builtin_amdgcn_readfirstlane(tid >> 6))
    const int G = gridDim.x, bx = blockIdx.x, vcu = (G % 8 == 0) ? (bx % 8) * (G / 8) + bx / 8 : bx;
    const int NGW = G * NWAVES;
#define gw (vcu * NWAVES + wave)
    volatile LAS unsigned* MISC = (volatile LAS unsigned*)(lds + MISC_OFF);
    unsigned* ctl = (unsigned*)(a.ws + WS_CTL);
    for (int u = tid; u < (LDS_BYTES - LDSCTL_OFF) / 4; u += NTHR) ((LAS unsigned*)(lds + LDSCTL_OFF))[u] = 0u;
    __syncthreads();
    XcdBarrier bar; bar.bar = ctl + CW_BAR; bar.x = 0; bar.st = nullptr;
    if (MK_SINGLE) bar = xcd_barrier_post(ctl + CW_BAR, MISC + 8);
    const int lo = a.ph_lo, hi = a.ph_hi;
#define IN(k) (lo <= (k) && (k) < hi)
#ifndef DBG_REP_MASK
#define DBG_REP_MASK 0
#endif
#define REPEAT(id) for (int rep_ = 0; rep_ < (((DBG_REP_MASK >> (id)) & 1) ? 3 : 1); ++rep_)
#if defined(DBG_PROF)
    { unsigned long long* prof = (unsigned long long*)((unsigned char*)ctl + WS_PROF); float* po_ = a.out;
      if (bx == 0 && tid == 0) { prof[200] = (unsigned long long)*(volatile unsigned*)(po_ + O_END - 1); prof[100] = wall_clock64(); prof[300] = clock64(); } }
#define SEAM(k) do { if (MK_SINGLE && (k) + 1 < hi) xcd_barrier(bar); if (bx == 0 && tid == 0) { unsigned long long* prof = (unsigned long long*)((unsigned char*)bar.bar - CW_BAR * 4 + WS_PROF); prof[100 + (k) + 1] = wall_clock64(); prof[300 + (k) + 1] = clock64(); } } while (0)
#else
#define SEAM(k) do { if (MK_SINGLE && (k) + 1 < hi) xcd_barrier(bar); } while (0)
#endif
#define GEMM_PTRS PH_PTRS; int gG = G, gbx = bx; OPAQUE_S(gG); OPAQUE_S(gbx); bf16* const H = (bf16*)(ws + WS_H); bf16* const U = (bf16*)(ws + WS_U); bf16* const AO = (bf16*)(ws + WS_S + S_AO); bf16* const X = (bf16*)(ws + WS_S + S_X); \
    const float* const MODS = (const float*)(ws + WS_MODS); (void)H; (void)U; (void)AO; (void)X; (void)MODS

#define CONVERT_WINDOW(lo_, hi_, nunits) do { const int from_ = (nunits) % gG; if (!from_ || gbx >= from_) p0_convert_range(a, lds, lo_, hi_, (gbx - from_) * NWAVES + wave, (gG - from_) * NWAVES, lane, wave); } while (0)

    if (IN(0)) { REPEAT(0) { p0_prologue(a, lds, tid, lane, wave, vcu, G); rope_table(a, tid, vcu, G); if (DBG_REP_MASK & 1) __syncthreads(); } SEAM(0); }

    for (int l = 0; l < DEPTH; ++l) {
        const int kind = l % 3, j = l / 3, pb = 1 + 10 * l;
        if (IN(pb + 0)) { REPEAT(1) norm_phase(a, l, false, l > 0 ? (const float*)(a.ws + WS_MODS) + (size_t)(l - 1) * 3 * NMOD + 5 * DM : nullptr, lane, gw, NGW); if (kind == 2) nat_cache_rows(a, lane, gw, NGW); SEAM(pb + 0); }
        if (kind == 0) {
            if (IN(pb + 1)) {
                GEMM_PTRS; unsigned char* wm = ws + WS_WMLA + (size_t)j * WMLA_STRIDE;
                pg8::Gemm g{H, (const bf16*)wm, MALL, 1536, DM, DM, DM, 1}; pg8::QaOrder S; S.init(gG, gbx, g.K);
                pg8::EpiBf16<0> E{(bf16*)(ws + WS_S + S_QAKV), 1536};
                REPEAT(2) pg8::gemm_phase<pg8::EpiBf16<0>, pg8::QaOrder>(lds, g, S, E);
                CONVERT_WINDOW(a.wstart[l + 1], a.wmid[l + 1], 288);
                SEAM(pb + 1);
            }
            if (IN(pb + 2)) { REPEAT(3) mla_thin_a(a, j, lane, gw, NGW); SEAM(pb + 2); }
            if (IN(pb + 3)) {
                GEMM_PTRS; unsigned char* wm = ws + WS_WMLA + (size_t)j * WMLA_STRIDE;
                REPEAT(4) {
                { pg8::Gemm g{(const bf16*)(ws + WS_S + S_QAN), (const bf16*)(wm + WMLA_QB), MALL, 3072, 768, 768, 768, 1}; pg8::StaticOrder S; S.init(MALL, 3072, 1, gG, gbx, g.K);
                  pg8::EpiBf16<0> E{(bf16*)(ws + WS_S + S_QRAW), 3072};
                  pg8::gemm_phase<pg8::EpiBf16<0>, pg8::StaticOrder>(lds, g, S, E); }
                { pg8::Gemm g{(const bf16*)(ws + WS_S + S_CKVN), (const bf16*)(wm + WMLA_KVB), MKV, 4096, 512, 512, 512, 1}; pg8::StaticOrder S; S.init(MKV, 4096, 1, gG, (gbx + gG / 2) % gG, g.K);
                  pg8::EpiKV E{(bf16*)(ws + WS_S + S_KVRAW), (bf16*)(ws + WS_S + S_KF), a.in[I_GKN] + (size_t)j * 192, (const float*)(ws + WS_S + S_KPE), (const float*)(ws + WS_SSK), (const float*)(ws + WS_ROPE), (LAS float*)(lds + EPI_TAB_OFF)};
                  pg8::gemm_phase<pg8::EpiKV, pg8::StaticOrder>(lds, g, S, E); }
                }
                {
                    int p_ = gbx, np_ = gG;
                    if (gG == 256) { p_ = gbx < 64 ? -1 : gbx < 128 ? gbx - 64 : gbx < 160 ? -1 : gbx - 96; np_ = 160; }
                    if (p_ >= 0) p0_convert_range(a, lds, a.wmid[l + 1], a.wstart[l + 2], p_ * NWAVES + wave, np_ * NWAVES, lane, wave);
                }
                SEAM(pb + 3);
            }
            if (IN(pb + 5)) { REPEAT(6) mla_attn_phase(a, j, lds, tid, vcu, G); SEAM(pb + 5); }
        }
        if (kind == 1) {
            if (IN(pb + 1)) {
                GEMM_PTRS;
                pg8::Gemm g{H, (const bf16*)(ws + WS_WHG), MALL, 10240, DM, DM, DM, 1}; pg8::StaticOrder S; S.init(MALL, 10240, 1, gG, gbx, g.K);
                pg8::EpiHg E{ws};
                REPEAT(8) pg8::gemm_phase<pg8::EpiHg, pg8::StaticOrder, false>(lds, g, S, E);
                CONVERT_WINDOW(a.wstart[l + 1], a.wstart[l + 2], 1920);
                SEAM(pb + 1);
            }
            if (IN(pb + 2)) { REPEAT(9) hg_scan_phase(a, lds, tid, vcu, G); SEAM(pb + 2); }
            if (IN(pb + 4)) { REPEAT(10) hg_thin_c(a, lane, gw, NGW); SEAM(pb + 4); }
        }
        if (kind == 2) {
            if (IN(pb + 1)) {
                GEMM_PTRS;
                pg8::Gemm g{H, (const bf16*)(ws + WS_WNAT), MALL, 6144, DM, DM, DM, 1}; pg8::StaticOrder S; S.init(MALL, 6144, 1, gG, gbx, g.K);
                pg8::EpiNat E{(bf16*)(ws + WS_S + S_NQKV), (bf16*)(ws + WS_S + S_NKN), out + O_NK, out + O_NV, a.in[I_GNK], (LAS float*)(lds + EPI_TAB_OFF)};
                REPEAT(11) pg8::gemm_phase<pg8::EpiNat, pg8::StaticOrder>(lds, g, S, E);
                CONVERT_WINDOW(a.wstart[l + 1], a.wstart[l + 2], 1152);
                SEAM(pb + 1);
            }
            if (IN(pb + 5)) { REPEAT(13) nat_attn_phase(a, lds, tid, vcu, G); SEAM(pb + 5); }
        }
        if (IN(pb + 6)) {
            GEMM_PTRS;
            const bf16* wo = (const bf16*)(kind == 0 ? ws + WS_WMLA + (size_t)j * WMLA_STRIDE + WMLA_WO : kind == 1 ? ws + WS_WHG + WHG_WO : ws + WS_WNAT + WNAT_WO);
            pg8::Gemm g{AO, wo, MALL, DM, DM / 2, DM, DM, 2}; pg8::ResOrder S; S.init(gG, gbx, DM);
            pg8::EpiRes2 E{X, MODS + (size_t)l * 3 * NMOD + 2 * DM, (bf16*)(ws + WS_S + S_PART), nullptr};
            pg8::gemm_phase<pg8::EpiRes2, pg8::ResOrder>(lds, g, S, E);
            SEAM(pb + 6);
        }
        if (IN(pb + 7)) { REPEAT(1) norm_phase(a, l, true, (const float*)(a.ws + WS_MODS) + (size_t)l * 3 * NMOD + 2 * DM, lane, gw, NGW); SEAM(pb + 7); }
        if (IN(pb + 8)) {
            GEMM_PTRS;
            pg8::Gemm g{H, (const bf16*)(ws + WS_WFF1) + (size_t)l * DM * FF, MALL, FF, DM, DM, DM, 1}; pg8::StaticOrder S; S.init(MALL, FF, 1, gG, gbx, g.K);
            pg8::EpiBf16<1> E{U, FF};
            REPEAT(7) pg8::gemm_phase<pg8::EpiBf16<1>, pg8::StaticOrder>(lds, g, S, E);
            SEAM(pb + 8);
        }
        if (IN(pb + 9)) {
            GEMM_PTRS;
            pg8::Gemm g{U, (const bf16*)(ws + WS_WFF2) + (size_t)l * DM * FF, MALL, DM, FF / 2, FF, FF, 2}; pg8::ResOrder S; S.init(gG, gbx, FF);
            pg8::EpiRes2 E{X, MODS + (size_t)l * 3 * NMOD + 5 * DM, (bf16*)(ws + WS_S + S_PART), l + 1 == DEPTH ? out + O_X : nullptr};
            pg8::gemm_phase<pg8::EpiRes2, pg8::ResOrder>(lds, g, S, E);
            SEAM(pb + 9);
        }
    }
    if (IN(NPHASE - 1)) final_fix_phase(a, (const float*)(a.ws + WS_MODS) + (size_t)(DEPTH - 1) * 3 * NMOD + 5 * DM, lane, gw, NGW);
#if defined(DBG_PROF)
    xcd_barrier(bar);
    { unsigned long long* prof = (unsigned long long*)((unsigned char*)bar.bar - CW_BAR * 4 + WS_PROF); float* po_ = a.out;
    if (bx == 0) {
        if (tid == 0) { prof[100 + NPHASE] = wall_clock64(); prof[300 + NPHASE] = clock64(); }
        __syncthreads();
        if (tid == 0) { constexpr int p = DBG_PROF; const unsigned long long dw = prof[100 + p + 1] - prof[100 + p], dc = prof[300 + p + 1] - prof[300 + p];
            float mant = (float)dw * 1e-4f; mant = mant < 1.f ? 1.f : mant > 9.9f ? 9.9f : mant; const int expo = dw ? (int)(dc / dw) : 0;
            po_[O_X + 7] = mant * __builtin_powif(10.f, expo); }
    } }
#endif
#undef IN
#undef SEAM
#undef tid
#undef lane
#undef wave
#undef gw
}

extern "C" void kernel_launch(void* const* d_in, const int* in_sizes, int n_in, void* d_out, int out_size, void* d_ws, size_t ws_size, hipStream_t stream) {
    static int grid = 0;
    if (grid == 0) {
        if (n_in != N_IN || (size_t)out_size != O_END || ws_size < WS_END) { fprintf(stderr, "kernel_launch: shape mismatch n_in %d out %d ws %zu (need %zu); nothing launched\n", n_in, out_size, ws_size, (size_t)WS_END); grid = -1; return; }
        int dev = 0, cus = 0, per_cu = 0;
        if (hipGetDevice(&dev) != hipSuccess || hipDeviceGetAttribute(&cus, hipDeviceAttributeMultiprocessorCount, dev) != hipSuccess) { fprintf(stderr, "kernel_launch: device query failed\n"); grid = -1; return; }
        if (hipFuncSetAttribute((const void*)fwd, hipFuncAttributeMaxDynamicSharedMemorySize, LDS_BYTES) != hipSuccess) { fprintf(stderr, "kernel_launch: hipFuncSetAttribute failed\n"); grid = -1; return; }
        if (hipOccupancyMaxActiveBlocksPerMultiprocessor(&per_cu, (const void*)fwd, NTHR, LDS_BYTES) != hipSuccess || per_cu < 1) { fprintf(stderr, "kernel_launch: occupancy query says %d blocks/CU\n", per_cu); }
        (void)hipGetLastError();
        grid = cus;
    }
    if (grid < 0) return;
    if (hipMemsetAsync((char*)d_ws + WS_CTL, 0, CTL_ZERO_BYTES, stream) != hipSuccess) { fprintf(stderr, "kernel_launch: memset failed\n"); return; }
    Args a{};
    for (int i = 0; i < N_IN; ++i) a.in[i] = (const float*)d_in[i];
    a.out = (float*)d_out; a.ws = (unsigned char*)d_ws;
    int nt = 0, items = 0;
    auto add = [&](const float* src, size_t dst_off, int K, int N, int row_off) { TJob& t = a.tj[nt++]; t.src = src; t.dst = (bf16*)((unsigned char*)d_ws + dst_off); t.K = K; t.N = N; t.row_off = row_off; t.start = items; items += (K / 64) * (N / 32); };
    auto add_mla_a = [&](int j) { const size_t wb = WS_WMLA + (size_t)j * WMLA_STRIDE;
        add(a.in[I_WQA] + (size_t)j * DM * 768, wb, DM, 768, 0); add(a.in[I_WKVA] + (size_t)j * DM * 576, wb, DM, 576, 768); };
    auto add_mla_b = [&](int j) { const size_t wb = WS_WMLA + (size_t)j * WMLA_STRIDE;
        add(a.in[I_WQB] + (size_t)j * 768 * 3072, wb + WMLA_QB, 768, 3072, 0); add(a.in[I_WKVB] + (size_t)j * 512 * 4096, wb + WMLA_KVB, 512, 4096, 0);
        add(a.in[I_WMO] + (size_t)j * DM * DM, wb + WMLA_WO, DM, DM, 0); };
    auto add_mixer = [&](int l) {
        if (l % 3 == 0) { add_mla_a(l / 3); add_mla_b(l / 3); }
        if (l % 3 == 1) { add(a.in[I_WHQ], WS_WHG, DM, DM, 0); add(a.in[I_WHF], WS_WHG, DM, DM, 2048); add(a.in[I_WHF] + (size_t)DM * DM, WS_WHG, DM, DM, 4096);
            add(a.in[I_WHI], WS_WHG, DM, DM, 6144); add(a.in[I_WHG], WS_WHG, DM, DM, 8192); add(a.in[I_WHO], WS_WHG + WHG_WO, DM, DM, 0); }
        if (l % 3 == 2) { add(a.in[I_WNQKV], WS_WNAT, DM, 3 * DM, 0); add(a.in[I_WNO], WS_WNAT + WNAT_WO, DM, DM, 0); } };
    a.wstart[0] = 0; add_mla_a(0);
    for (int l = 0; l < DEPTH; ++l) {
        a.wstart[l + 1] = items;
        if (l == 0) add_mla_b(0);
        add(a.in[I_WFF1] + (size_t)l * DM * FF, WS_WFF1 + (size_t)l * DM * FF * 2, DM, FF, 0); add(a.in[I_WFF2] + (size_t)l * DM * FF, WS_WFF2 + (size_t)l * DM * FF * 2, FF, DM, 0);
        if (l + 1 < DEPTH) add_mixer(l + 1);
    }
    for (int w = DEPTH + 1; w < 8; ++w) a.wstart[w] = items;
    for (int w = 0; w < 8; ++w) a.wmid[w] = a.wstart[w];
    for (int l = 0; l < DEPTH; ++l) if (l % 3 == 0) {
        const int from = 288 % grid, part = (from ? grid - from : grid) * NWAVES; long n = (long)WQA * part; const long tot = a.wstart[l + 2] - a.wstart[l + 1]; if (n > tot) n = tot;
        a.wmid[l + 1] = a.wstart[l + 1] + (int)n; }
    a.ntj = nt; a.nitems = items;
#if MK_SINGLE
    a.ph_lo = 0; a.ph_hi = NPHASE < MK_LAST_PHASE ? NPHASE : MK_LAST_PHASE;
    hipLaunchKernelGGL(fwd, dim3(grid), dim3(NTHR), LDS_BYTES, stream, a);
#else
    for (int ph = 0; ph < NPHASE && ph < MK_LAST_PHASE; ++ph) {
        if (!phase_exists(ph)) continue;
        a.ph_lo = ph; a.ph_hi = ph + 1;
        hipLaunchKernelGGL(fwd, dim3(grid), dim3(NTHR), LDS_BYTES, stream, a);
    }
#endif
    const hipError_t le = hipPeekAtLastError();
    if (le != hipSuccess) fprintf(stderr, "kernel_launch: launch failed: %s\n", hipGetErrorName(le));
}
```

```cpp
#define MK_SINGLE 1
#define MK_LAST_PHASE 1000
#include <hip/hip_runtime.h>
#include <cstdio>
#include <cstdint>

#ifndef MK_SINGLE
#define MK_SINGLE 1
#endif
#ifndef WQA
#define WQA 12
#endif
#ifndef MK_LAST_PHASE
#define MK_LAST_PHASE 1000
#endif
namespace pg8 {
#define PG8_LAS __attribute__((address_space(3)))
#define PG8_GAS __attribute__((address_space(1)))
typedef unsigned short bf16_t;
typedef short bf16x8 __attribute__((ext_vector_type(8)));
typedef float f32x4 __attribute__((ext_vector_type(4)));
typedef unsigned u32x4 __attribute__((ext_vector_type(4)));
constexpr int BM = 256, BK = 64, HALF = 128, HTB = HALF * BK * 2  , STAGE_BYTES = 8 * HTB, NXCD = 8, WGM = 8;

__host__ __device__ __forceinline__ int lds_byte(int r, int c) { const int st = (r >> 4) * 2 + (c >> 5), rr = r & 15, cc = c & 31, ob = rr * 64 + cc * 2; return st * 1024 + (ob ^ (((ob >> 9) & 1) << 5)); }
__host__ __device__ __forceinline__ void stage_rc(int b, int& R, int& C) { const int st = b / 1024, sb = b % 1024, swz = sb ^ (((sb >> 9) & 1) << 5); R = (st >> 1) * 16 + swz / 64; C = (st & 1) * 32 + (swz % 64) / 2; }
__host__ __device__ __forceinline__ int perm32(int rho) { const int n = rho >> 4, i = rho & 15; return 8 * (i >> 2) + 4 * n + (i & 3); }

struct Unit { int pm, pn, ks, nkt, part, nh; };
struct Gemm { const bf16_t* A; const bf16_t* Bt; int M, N, K, lda, ldb, nsplit; };

struct StaticOrder {
    static constexpr bool HAS_NH = false;
    int nM, nN, nNv, nwg, G, c, nkt, split;
    __host__ __device__ void init(int M, int N, int nsplit, int G_, int c_, int K = 0) { nM = M / BM; nN = N / BM; nNv = nN * nsplit; nwg = nM * nNv; G = G_; c = c_; nkt = K / BK; split = nsplit; }
    __host__ __device__ bool next(int i, Unit& u) const {
        const long L = (long)i * G + c; if (L >= nwg) return false;
        int wgid = (int)L; { const int q = nwg / NXCD, r = nwg % NXCD, xcd = wgid % NXCD, off = wgid / NXCD; wgid = (xcd < r ? xcd * (q + 1) : r * (q + 1) + (xcd - r) * q) + off; }
        const int nig = WGM * nNv, gid = wgid / nig, fm = gid * WGM, gsz = (nM - fm) < WGM ? (nM - fm) : WGM;
        u.pm = fm + ((wgid % nig) % gsz); const int pv = (wgid % nig) / gsz; u.pn = pv % nN; u.ks = pv / nN; u.nkt = nkt; u.part = split > 1 ? u.ks : -1; u.nh = 0; return true;
    }
    __device__ __forceinline__ void a_ready(const Unit&) const {}
    __device__ __forceinline__ void done(const Unit&) const {}
};

struct QaOrder {
    static constexpr bool HAS_NH = true;
    StaticOrder M5; int G, c, nkt;
    __host__ __device__ void init(int G_, int c_, int K) { M5.init(12288, 1280, 1, G_, c_, K); G = G_; c = c_; nkt = K / BK; }
    __host__ __device__ bool next(int i, Unit& u) const {
        const int L = i * G + c;
        if (L < 240) return M5.next(i, u);
        if (L >= 288) return false;
        u.pm = L - 240; u.pn = 5; u.ks = 0; u.nkt = nkt; u.part = -1; u.nh = 1; return true;
    }
    __device__ __forceinline__ void a_ready(const Unit&) const {}
    __device__ __forceinline__ void done(const Unit&) const {}
};
struct ResOrder {
    static constexpr bool HAS_NH = false;
    int G, c, nkF, nkH;
    __host__ __device__ void init(int G_, int c_, int K) { G = G_; c = c_; nkF = K / BK; nkH = K / (2 * BK); }
    __host__ __device__ bool next(int i, Unit& u) const {
        const int L = i * G + c; if (L >= 512) return false;
        const bool half = L >= 256; int w = half ? L - 256 : L;
        w = (w & 7) * 32 + (w >> 3);
        const int sh = half ? 7 : 6, e = w & ((1 << sh) - 1), pv = e >> 3;
        u.pm = (half ? 32 : 0) + ((w >> sh) << 3) + (e & 7); u.pn = pv & 7; u.ks = pv >> 3; u.nkt = half ? nkH : nkF; u.part = half ? u.ks : -1; u.nh = 0; return true;
    }
    __device__ __forceinline__ void a_ready(const Unit&) const {}
    __device__ __forceinline__ void done(const Unit&) const {}
};

__device__ __forceinline__ unsigned cvt_pk_bf16(float lo, float hi) { unsigned r; asm("v_cvt_pk_bf16_f32 %0, %1, %2" : "=v"(r) : "v"(lo), "v"(hi)); return r; }


template <class Epi, class Sched, bool ALIGN_EPI = true, bool SP2 = true>
__device__ __forceinline__ void gemm_phase(PG8_LAS unsigned char* lds, const Gemm g, const Sched& S, const Epi& E) {
    int tid_ = threadIdx.x; asm volatile("" : "+v"(tid_));
    const int tid = tid_, wid = __builtin_amdgcn_readfirstlane(tid >> 6), lane = tid & 63, wr = wid >> 2, wc = wid & 3, fr = lane & 15, fq = lane >> 4;
    const int K = g.K;
    unsigned voffA[2], voffB[2];
#pragma unroll
    for (int i = 0; i < 2; ++i) { int R, C; stage_rc(tid * 16 + i * 8192, R, C); const int Rb = Epi::PERM ? ((R & ~31) + perm32(R & 31)) : R;
        voffA[i] = (unsigned)(R * g.lda + C) * 2u; voffB[i] = (unsigned)(Rb * g.ldb + C) * 2u; }
    const size_t kstep = (size_t)(BK * 2);
    const size_t hstepA = (size_t)HALF * g.lda * 2, hstepB = (size_t)HALF * g.ldb * 2;
    const size_t tstepA = 2 * hstepA, tstepB = 2 * hstepB;
    const size_t sstep = (size_t)K * 2;
    const unsigned ldsw = (unsigned)wid * 1024u;
    const int aoff = lds_byte(wr * 64 + fr, fq * 8), boff = lds_byte(wc * 32 + fr, fq * 8);
#define PG8_SA(b, h) (((b) * 2 + (h)) * HTB)
#define PG8_SB(b, h) ((4 + (b) * 2 + (h)) * HTB)
#define PG8_STAGE(bufoff, gbase, voff) do { _Pragma("unroll") for (int _i = 0; _i < 2; ++_i) \
        __builtin_amdgcn_global_load_lds((const unsigned*)((const char*)(gbase) + (voff)[_i]), (PG8_LAS unsigned*)(lds + (bufoff) + ldsw + _i * 8192), 16, 0, 0); } while (0)
#define PG8_LDA(dst, b, h) do { _Pragma("unroll") for (int m = 0; m < 4; ++m) _Pragma("unroll") for (int k = 0; k < 2; ++k) dst[m][k] = *(const PG8_LAS bf16x8*)(lds + PG8_SA(b, h) + aoff + m * 2048 + k * 1024); } while (0)
#define PG8_LDB(dst, b, h) do { _Pragma("unroll") for (int n = 0; n < 2; ++n) _Pragma("unroll") for (int k = 0; k < 2; ++k) dst[n][k] = *(const PG8_LAS bf16x8*)(lds + PG8_SB(b, h) + boff + n * 2048 + k * 1024); } while (0)
#define PG8_MMA(ai, bj, At, Bt) do { __builtin_amdgcn_s_setprio(1); _Pragma("unroll") for (int m = 0; m < 4; ++m) _Pragma("unroll") for (int n = 0; n < 2; ++n) _Pragma("unroll") for (int k = 0; k < 2; ++k) \
        acc[ai][bj][m][n] = __builtin_amdgcn_mfma_f32_16x16x32_bf16(Bt[n][k], At[m][k], acc[ai][bj][m][n], 0, 0, 0); __builtin_amdgcn_s_setprio(0); } while (0)
#define PG8_WAIT_V(n) asm volatile("s_waitcnt vmcnt(" #n ")" ::: "memory")
#define PG8_WAIT_L(n) asm volatile("s_waitcnt lgkmcnt(" #n ")" ::: "memory")
#define PG8_BAR __builtin_amdgcn_s_barrier()
#define PG8_SCHED __builtin_amdgcn_sched_barrier(0)
    Unit cur, nxt; int ui = 0;
    if (!S.next(0, cur)) return;
    f32x4 acc[2][2][4][2];
#pragma unroll
    for (int a = 0; a < 2; ++a)
#pragma unroll
        for (int b = 0; b < 2; ++b)
#pragma unroll
            for (int m = 0; m < 4; ++m)
#pragma unroll
                for (int n = 0; n < 2; ++n) acc[a][b][m][n] = (f32x4){0.f, 0.f, 0.f, 0.f};
    bf16x8 At[4][2], B0[2][2], B1[2][2];
    const char* cA = (const char*)g.A + (size_t)cur.pm * tstepA + (size_t)cur.ks * sstep; const char* cB = (const char*)g.Bt + (size_t)cur.pn * tstepB + (size_t)cur.ks * sstep;
    S.a_ready(cur);
    if constexpr (SP2) {
        PG8_STAGE(PG8_SB(0, 0), cB, voffB); PG8_STAGE(PG8_SB(0, 1), cB + hstepB, voffB); PG8_STAGE(PG8_SA(0, 0), cA, voffA); PG8_STAGE(PG8_SA(0, 1), cA + hstepA, voffA);
        if (wr == 1) PG8_BAR;
        PG8_WAIT_V(2); PG8_BAR;
        PG8_STAGE(PG8_SB(1, 0), cB + kstep, voffB); PG8_STAGE(PG8_SA(1, 0), cA + kstep, voffA); PG8_STAGE(PG8_SB(1, 1), cB + hstepB + kstep, voffB);
        PG8_WAIT_V(6); PG8_BAR;
    } else {
        PG8_STAGE(PG8_SB(0, 0), cB, voffB); PG8_STAGE(PG8_SA(0, 0), cA, voffA); PG8_STAGE(PG8_SB(0, 1), cB + hstepB, voffB); PG8_STAGE(PG8_SA(0, 1), cA + hstepA, voffA);
        if (wr == 1) PG8_BAR;
        PG8_WAIT_V(4); PG8_BAR;
        PG8_STAGE(PG8_SB(1, 0), cB + kstep, voffB); PG8_STAGE(PG8_SA(1, 0), cA + kstep, voffA); PG8_STAGE(PG8_SB(1, 1), cB + hstepB + kstep, voffB);
        PG8_WAIT_V(6); PG8_BAR;
    }
    for (;;) {
        const bool has_next = S.next(ui + 1, nxt);
        const char* nA = has_next ? (const char*)g.A + (size_t)nxt.pm * tstepA + (size_t)nxt.ks * sstep : cA; const char* nB = has_next ? (const char*)g.Bt + (size_t)nxt.pn * tstepB + (size_t)nxt.ks * sstep : cB;
        const int nt = cur.nkt; const bool nh = cur.nh != 0;
        for (int t = 0; t < nt; t += 2) {
            const bool last = (t == nt - 2);
            const char* a1 = cA + (size_t)(t + 1) * kstep;
            const char* a2 = last ? nA : cA + (size_t)(t + 2) * kstep; const char* b2 = last ? nB : cB + (size_t)(t + 2) * kstep;
            const char* a3 = a2 + kstep; const char* b3 = b2 + kstep;
            if (last && has_next) S.a_ready(nxt);
            if constexpr (SP2) {
            PG8_LDB(B0, 0, 0); PG8_LDB(B1, 0, 1); PG8_SCHED; PG8_LDA(At, 0, 0); PG8_STAGE(PG8_SA(1, 1), a1 + hstepA, voffA);
            PG8_WAIT_V(8); PG8_WAIT_L(0); PG8_BAR; PG8_MMA(0, 0, At, B0); if (!Sched::HAS_NH || !nh) PG8_MMA(0, 1, At, B1); PG8_BAR; PG8_SCHED;
            PG8_LDA(At, 0, 1); PG8_STAGE(PG8_SB(0, 0), b2, voffB); PG8_STAGE(PG8_SB(0, 1), b2 + hstepB, voffB); PG8_STAGE(PG8_SA(0, 0), a2, voffA);
            PG8_WAIT_V(8); PG8_WAIT_L(0); PG8_BAR; PG8_MMA(1, 0, At, B0); if (!Sched::HAS_NH || !nh) PG8_MMA(1, 1, At, B1); PG8_BAR; PG8_SCHED;
            PG8_LDB(B0, 1, 0); PG8_LDB(B1, 1, 1); PG8_SCHED; PG8_LDA(At, 1, 0); PG8_STAGE(PG8_SA(0, 1), a2 + hstepA, voffA);
            PG8_WAIT_V(8); PG8_WAIT_L(0); PG8_BAR; PG8_MMA(0, 0, At, B0); if (!Sched::HAS_NH || !nh) PG8_MMA(0, 1, At, B1); PG8_BAR; PG8_SCHED;
            PG8_LDA(At, 1, 1); PG8_STAGE(PG8_SB(1, 0), b3, voffB); PG8_STAGE(PG8_SB(1, 1), b3 + hstepB, voffB); PG8_STAGE(PG8_SA(1, 0), a3, voffA);
            PG8_WAIT_V(8); PG8_WAIT_L(0); PG8_BAR; PG8_MMA(1, 0, At, B0); if (!Sched::HAS_NH || !nh) PG8_MMA(1, 1, At, B1); PG8_BAR; PG8_SCHED;
            } else {
            PG8_LDB(B0, 0, 0); PG8_SCHED; PG8_LDA(At, 0, 0); PG8_STAGE(PG8_SA(1, 1), a1 + hstepA, voffA);
            PG8_WAIT_L(8); PG8_BAR; PG8_WAIT_L(0); PG8_MMA(0, 0, At, B0); PG8_BAR; PG8_SCHED;
            PG8_LDB(B1, 0, 1); PG8_STAGE(PG8_SB(0, 0), b2, voffB);
            PG8_BAR; PG8_WAIT_L(0); PG8_MMA(0, 1, At, B1); PG8_BAR;
            PG8_LDA(At, 0, 1); PG8_STAGE(PG8_SA(0, 0), a2, voffA);
            PG8_BAR; PG8_WAIT_L(0); PG8_MMA(1, 0, At, B0); PG8_BAR; PG8_SCHED;
            PG8_STAGE(PG8_SB(0, 1), b2 + hstepB, voffB);
            PG8_WAIT_V(6); PG8_BAR; PG8_MMA(1, 1, At, B1); PG8_BAR;
            PG8_LDB(B0, 1, 0); PG8_SCHED; PG8_LDA(At, 1, 0); PG8_STAGE(PG8_SA(0, 1), a2 + hstepA, voffA);
            PG8_WAIT_L(8); PG8_BAR; PG8_WAIT_L(0); PG8_MMA(0, 0, At, B0); PG8_BAR; PG8_SCHED;
            PG8_LDB(B1, 1, 1); PG8_STAGE(PG8_SB(1, 0), b3, voffB);
            PG8_BAR; PG8_WAIT_L(0); PG8_MMA(0, 1, At, B1); PG8_BAR;
            PG8_LDA(At, 1, 1); PG8_STAGE(PG8_SA(1, 0), a3, voffA);
            PG8_BAR; PG8_WAIT_L(0); PG8_MMA(1, 0, At, B0); PG8_BAR; PG8_SCHED;
            PG8_STAGE(PG8_SB(1, 1), b3 + hstepB, voffB);
            PG8_WAIT_V(6); PG8_BAR; PG8_MMA(1, 1, At, B1); PG8_BAR;
            }
        }
        if constexpr (ALIGN_EPI) { if (wr == 0) PG8_BAR; }
        E(acc, cur, wr, wc, fr, fq); S.done(cur);
        if (!has_next) break;
#pragma unroll
        for (int a = 0; a < 2; ++a)
#pragma unroll
            for (int b = 0; b < 2; ++b)
#pragma unroll
                for (int m = 0; m < 4; ++m)
#pragma unroll
                    for (int n = 0; n < 2; ++n) acc[a][b][m][n] = (f32x4){0.f, 0.f, 0.f, 0.f};
        cur = nxt; cA = nA; cB = nB; ++ui;
        if constexpr (ALIGN_EPI) { if (wr == 1) PG8_BAR; }
    }
    PG8_WAIT_V(0);
    if constexpr (!ALIGN_EPI) { if (wr == 0) PG8_BAR; }
    PG8_BAR;
#undef PG8_SA
#undef PG8_SB
#undef PG8_STAGE
#undef PG8_LDA
#undef PG8_LDB
#undef PG8_MMA
#undef PG8_WAIT_V
#undef PG8_WAIT_L
#undef PG8_BAR
#undef PG8_SCHED
}
}
constexpr int DM = 2048, MP = 8192, MS = 4096, MALL = 12288, MKV = 12800, FF = 8192, NMOD = 12288;
constexpr int NWAVES = 8, NTHR = 512, DEPTH = 4;
constexpr float EPS = 1e-6f;
constexpr size_t O_X = 0, O_CKV = 25165824, O_KPE = 33554432, O_HG = 34603008, O_NK = 51380224, O_NV = 68157440, O_END = 84934656;
enum { I_XP = 0, I_XS, I_CCKV, I_CKPE, I_SHG, I_CNK, I_CNV, I_C, I_CCTX, I_WMOD, I_BMOD, I_GMIX, I_GFFN, I_WQA, I_GQA, I_WQB, I_GQN, I_WKVA, I_GKVA, I_WKVB, I_GKN, I_WMO,
       I_WHQ, I_WHF, I_HLB, I_WHI, I_WHG, I_GHO, I_WHO, I_WNQKV, I_GNQ, I_GNK, I_RPB, I_WNO, I_WFF1, I_WFF2, N_IN };

constexpr size_t MiB = 1u << 20;
constexpr size_t WS_CTL = 0, CTL_ZERO_BYTES = 65536;
constexpr size_t WS_MODS = 2 * MiB;
constexpr size_t WS_LB = 3 * MiB;
constexpr size_t WS_SSK = 3 * MiB + 65536;
constexpr size_t WS_PROF = 3 * MiB + 786432;
constexpr size_t WS_ROPE = 3 * MiB + 131072;
constexpr size_t WS_WFF1 = 4 * MiB, WS_WFF2 = 132 * MiB;
constexpr size_t WS_WMLA = 260 * MiB, WMLA_STRIDE = 24 * MiB;
constexpr size_t WMLA_QB = 6 * MiB, WMLA_KVB = 11 * MiB, WMLA_WO = 15 * MiB;
constexpr size_t WS_WHG = 308 * MiB, WHG_WO = 40 * MiB;
constexpr size_t WS_WNAT = 356 * MiB, WNAT_WO = 24 * MiB;
constexpr size_t WS_H = 388 * MiB;
constexpr size_t WS_U = 436 * MiB;
constexpr size_t WS_S = 628 * MiB;
constexpr size_t S_AO = 0;
constexpr size_t S_QAKV = 48 * MiB, S_QAN = 120 * MiB, S_CKVN = 138 * MiB, S_KPE = 151 * MiB, S_QRAW = 155 * MiB, S_KVRAW = 227 * MiB, S_QN = 327 * MiB, S_KF = 399 * MiB;
constexpr size_t S_HQ = 48 * MiB, S_HK = 96 * MiB, S_HV = 192 * MiB, S_HGS = 240 * MiB, S_OF = 288 * MiB;
constexpr size_t S_NQKV = 48 * MiB, S_NQN = 198 * MiB, S_NKN = 246 * MiB;
constexpr size_t S_PART = 480 * MiB;
constexpr size_t S_X = 512 * MiB;
constexpr size_t WS_END = WS_S + 560 * MiB;
constexpr int CW_TMO = 0, CW_CODE = 1, CW_BAR = 4096;

constexpr int RING_BYTES = 131072;
constexpr int LDSCTL_OFF = 163840 - 512, MISC_OFF = LDSCTL_OFF + 320;
constexpr int EPI_TAB_OFF = LDSCTL_OFF - 8192;
constexpr int LDS_BYTES = 163840;

#define GAS __attribute__((address_space(1)))
#define LAS __attribute__((address_space(3)))
typedef unsigned short bf16;
typedef unsigned v4u __attribute__((ext_vector_type(4)));
typedef unsigned v2u __attribute__((ext_vector_type(2)));
typedef float f32x4 __attribute__((ext_vector_type(4)));
typedef float f32x2 __attribute__((ext_vector_type(2)));
typedef short bf16x8 __attribute__((ext_vector_type(8)));
typedef GAS unsigned gu32;
#define RLX_AGENT __ATOMIC_RELAXED, __HIP_MEMORY_SCOPE_AGENT
#define LDS_WAIT() asm volatile("s_waitcnt lgkmcnt(0)" ::: "memory")
#define VM_WAIT() asm volatile("s_waitcnt vmcnt(0)" ::: "memory")
#ifndef DBG_SCALE
#define DBG_SCALE 1.0f
#endif
#define OPAQUE_S(x) asm volatile("" : "+s"(x))
#define PH_PTRS unsigned char* ws = a.ws; float* out = a.out; OPAQUE_S(ws); OPAQUE_S(out)
#define OPAQUE_V(x) asm volatile("" : "+v"(x))
__device__ __forceinline__ unsigned pk2(float lo, float hi) { unsigned r; asm("v_cvt_pk_bf16_f32 %0, %1, %2" : "=v"(r) : "v"(lo), "v"(hi)); return r; }
__device__ __forceinline__ float bf_lo(unsigned w) { return __uint_as_float(w << 16); }
__device__ __forceinline__ float bf_hi(unsigned w) { return __uint_as_float(w & 0xffff0000u); }
__device__ __forceinline__ float wave_sum(float v) {
#pragma unroll
    for (int o = 1; o < 64; o <<= 1) v += __shfl_xor(v, o);
    return v;
}
__device__ __forceinline__ float sum16(float v) {
#pragma unroll
    for (int o = 1; o < 16; o <<= 1) v += __shfl_xor(v, o);
    return v;
}

#define XB_TMO      128
#define XB_XCNT(j)  (256  + 64 * (j))
#define XB_XSUB(j)  (1280 + 64 * (j))
#define XB_XGEN(j)  (2304 + 64 * (j))
#define XB_TOP      3328
#define XB_TOPGEN   3392
#define XCD_BAR_WORDS 3456
#define XB_SPIN_CAP (1u << 18)
__device__ __forceinline__ unsigned xb_ld(unsigned* p)              { return __hip_atomic_load(p, __ATOMIC_RELAXED, __HIP_MEMORY_SCOPE_AGENT); }
__device__ __forceinline__ unsigned xb_add(unsigned* p, unsigned v) { return __hip_atomic_fetch_add(p, v, __ATOMIC_RELAXED, __HIP_MEMORY_SCOPE_AGENT); }
__device__ __forceinline__ unsigned xb_xcc_id() { return (unsigned)__builtin_amdgcn_s_getreg((3 << 11) | 20) & 0xFu; }
#define XB_SPIN(cond, bar) do { unsigned _sp = 0; while (cond) { __builtin_amdgcn_s_sleep(1); \
    if ((++_sp & 255u) == 0u) { if (xb_ld(&(bar)[XB_TMO])) break; if (_sp > XB_SPIN_CAP) { atomicAdd(&(bar)[XB_TMO], 1u); break; } } } } while (0)
struct XcdBarrier { unsigned* bar; unsigned x; volatile LAS unsigned* st; };
__device__ __forceinline__ XcdBarrier xcd_barrier_post(unsigned* bar, volatile LAS unsigned* st) {
    XcdBarrier b; b.bar = bar; b.x = xb_xcc_id(); b.st = st;
    if (threadIdx.x == 0) (void)xb_add(&bar[XB_XCNT(b.x)], 1u);
    return b;
}
__device__ __forceinline__ void xcd_barrier_complete(unsigned* bar, unsigned x, unsigned& nloc, unsigned& nx) {
    const unsigned G = gridDim.x * gridDim.y * gridDim.z;
    unsigned sum, cnt, mine, sp = 0u;
    for (;;) {
        sum = 0u; cnt = 0u; mine = 0u;
#pragma unroll
        for (unsigned j = 0; j < 16; ++j) { const unsigned c = xb_ld(&bar[XB_XCNT(j)]); sum += c; cnt += (c > 0u) ? 1u : 0u; mine = (j == x) ? c : mine; }
        if (sum == G) break;
        __builtin_amdgcn_s_sleep(1);
        if ((++sp & 255u) == 0u) { if (xb_ld(&bar[XB_TMO])) break; if (sp > XB_SPIN_CAP) { atomicAdd(&bar[XB_TMO], 1u); break; } }
    }
    nloc = mine > 0u ? mine : 1u; nx = cnt > 0u ? cnt : 1u;
}
__device__ __forceinline__ void xcd_barrier(const XcdBarrier& b) {
    asm volatile("s_waitcnt vmcnt(0)" ::: "memory");
    __syncthreads();
    if (threadIdx.x == 0) {
        unsigned* bar = b.bar;
        __builtin_amdgcn_s_waitcnt(0);
        unsigned nloc = b.st[0], nx = b.st[1];
        if (nloc == 0u) { xcd_barrier_complete(bar, b.x, nloc, nx); b.st[0] = nloc; b.st[1] = nx; }
        const unsigned old = xb_add(&bar[XB_XSUB(b.x)], 1u);
        const unsigned gen = old / nloc;
        if (old + 1u == (gen + 1u) * nloc) {
            __builtin_amdgcn_fence(__ATOMIC_RELEASE, "agent");
            asm volatile("s_waitcnt vmcnt(0)" ::: "memory");
            const unsigned og = xb_add(&bar[XB_TOP], 1u);
            const unsigned tg = og / nx;
            if (og + 1u == (tg + 1u) * nx) xb_add(&bar[XB_TOPGEN], 1u);
            else XB_SPIN(xb_ld(&bar[XB_TOPGEN]) == tg, bar);
            __builtin_amdgcn_fence(__ATOMIC_ACQUIRE, "agent");
            xb_add(&bar[XB_XGEN(b.x)], 1u);
            asm volatile("s_waitcnt vmcnt(0)" ::: "memory");
        } else {
            XB_SPIN(xb_ld(&bar[XB_XGEN(b.x)]) == gen, bar);
            __builtin_amdgcn_fence(__ATOMIC_ACQUIRE, "agent");
            asm volatile("s_waitcnt vmcnt(0)" ::: "memory");
        }
    }
    __syncthreads();
}

struct TJob { const float* src; bf16* dst; int K, N, row_off, start; };
constexpr int MAX_TJ = 32;
struct Args { const float* in[N_IN]; float* out; unsigned char* ws; TJob tj[MAX_TJ]; int ntj, nitems, ph_lo, ph_hi;
              int wstart[8], wmid[8]; };

__device__ __forceinline__ void p0_transpose_item(const float* W, int K, int N, bf16* WT, int row_off, LAS float* scr, int item, int lane) {
    const int nblk = N / 32, kb = item / nblk, nb = item % nblk, k0 = 64 * kb, n0 = 32 * nb;
    { const int kr = lane >> 3, ns = (lane & 7) * 4;
      f32x4 t[8];
#pragma unroll
      for (int i = 0; i < 8; ++i) t[i] = __builtin_nontemporal_load((const GAS f32x4*)(W + (size_t)(k0 + kr + 8 * i) * N + n0 + ns));
#pragma unroll
      for (int i = 0; i < 8; ++i) { LAS float* d = scr + (kr + 8 * i) * 33 + ns; d[0] = t[i].x; d[1] = t[i].y; d[2] = t[i].z; d[3] = t[i].w; } }
    LDS_WAIT(); asm volatile("" ::: "memory");
    const int c = lane & 7;
#pragma unroll
    for (int j = 0; j < 4; ++j) { const int n = (lane >> 3) + 8 * j; const LAS float* s = scr + (8 * c) * 33 + n;
        v4u o; o.x = pk2(s[0 * 33], s[1 * 33]); o.y = pk2(s[2 * 33], s[3 * 33]); o.z = pk2(s[4 * 33], s[5 * 33]); o.w = pk2(s[6 * 33], s[7 * 33]);
        __builtin_nontemporal_store(o, (GAS v4u*)(WT + (size_t)(row_off + n0 + n) * K + k0 + 8 * c)); }
    LDS_WAIT(); asm volatile("" ::: "memory");
}

__device__ __forceinline__ void p0_convert_range(const Args& a, LAS unsigned char* lds, int lo, int hi, int idx, int stride, int lane, int wave) {
    OPAQUE_V(lane);
    LAS float* scr = (LAS float*)(lds + wave * 16384);
    for (int it = lo + idx; it < hi; it += stride) {
        int j = 0;
        while (j + 1 < a.ntj && it >= a.tj[j + 1].start) ++j;
        p0_transpose_item(a.tj[j].src, a.tj[j].K, a.tj[j].N, a.tj[j].dst, a.tj[j].row_off, scr, it - a.tj[j].start, lane);
    }
}

__device__ __forceinline__ float silu_f(float x) { return x / (1.f + __expf(-x)); }

__device__ __forceinline__ void p0_prologue(const Args& a, LAS unsigned char* lds, int tid, int lane, int wave, int vcu, int G) {
    OPAQUE_V(tid); OPAQUE_V(lane);
    float* mods = (float*)(a.ws + WS_MODS);
#ifndef DBG_REP_MASK
#define DBG_REP_MASK 0
#endif
    for (int rep_ = 0; rep_ < (((DBG_REP_MASK >> 14) & 1) ? 3 : 1); ++rep_)
    if (vcu < 768) {
        LAS f32x4* S3 = (LAS f32x4*)lds;
        LAS float* RED = (LAS float*)(lds + 32768);
        const float* cc = a.in[I_C]; const float* cx = a.in[I_CCTX];
        for (int k = tid; k < DM; k += NTHR) S3[k] = (f32x4){silu_f(cx[k]), silu_f(cc[k]), silu_f(cc[DM + k]), 0.f};
        __syncthreads();
        for (int tl = vcu; tl < 768; tl += G) {
            const int l = tl / 192, n = (tl % 192) * 64 + lane;
            const float* Wp = a.in[I_WMOD] + ((size_t)l * DM + wave * 256) * NMOD + n;
            float a0 = 0.f, a1 = 0.f, a2 = 0.f;
#pragma unroll 16
            for (int k = 0; k < 256; ++k) { const float wv = __builtin_nontemporal_load((const GAS float*)(Wp + (size_t)k * NMOD)); const f32x4 s = S3[wave * 256 + k]; a0 += s.x * wv; a1 += s.y * wv; a2 += s.z * wv; }
            RED[(wave * 3 + 0) * 64 + lane] = a0; RED[(wave * 3 + 1) * 64 + lane] = a1; RED[(wave * 3 + 2) * 64 + lane] = a2;
            __syncthreads();
            if (wave < 3) { float s = 0.f;
#pragma unroll
                for (int w = 0; w < 8; ++w) s += RED[(w * 3 + wave) * 64 + lane];
                mods[((size_t)l * 3 + wave) * NMOD + n] = s + a.in[I_BMOD][(size_t)l * NMOD + n]; }
            __syncthreads();
        }
    }
    { const int gt = vcu * NTHR + tid;
      if (gt < 2 * DM) { const int d = gt >> 11, c = gt & 2047; const float* hl = a.in[I_HLB] + (size_t)d * 4 * DM + c;
          const float x0 = hl[0], x1 = hl[DM], x2 = hl[2 * DM], x3 = hl[3 * DM]; const float m = fmaxf(fmaxf(x0, x1), fmaxf(x2, x3));
          const float e0 = __expf(x0 - m), e1 = __expf(x1 - m), e2 = __expf(x2 - m), e3 = __expf(x3 - m);
          ((float*)(a.ws + WS_LB))[gt] = e1 / (e0 + e1 + e2 + e3); } }
    __syncthreads();
    LAS float* scr = (LAS float*)(lds + wave * 16384);
    const int gw = vcu * NWAVES + wave, NGW = G * NWAVES;
    for (int rep_ = 0; rep_ < (((DBG_REP_MASK >> 15) & 1) ? 3 : 1); ++rep_)
    for (int it = gw; it < a.wstart[1]; it += NGW) {
        int j = 0;
        while (j + 1 < a.ntj && it >= a.tj[j + 1].start) ++j;
        p0_transpose_item(a.tj[j].src, a.tj[j].K, a.tj[j].N, a.tj[j].dst, a.tj[j].row_off, scr, it - a.tj[j].start, lane);
    }
#if defined(DBG_ZERO_OUT)
    { const size_t gt = (size_t)vcu * NTHR + tid, NT = (size_t)G * NTHR;
      for (size_t i = gt; i < (O_END - O_CKV) / 4; i += NT) *(GAS f32x4*)(a.out + O_CKV + 4 * i) = (f32x4){0.f, 0.f, 0.f, 0.f}; }
#endif
    { const int gt = vcu * NTHR + tid, NT = G * NTHR;
      for (int i = gt; i < 2 * 192 * DM / 8; i += NT) { const int j = i / (192 * DM / 8), r = i % (192 * DM / 8);
          *(GAS v4u*)(a.ws + WS_WMLA + j * WMLA_STRIDE + (size_t)1344 * DM * 2 + (size_t)r * 16) = (v4u){0u, 0u, 0u, 0u}; } }
}

__device__ __forceinline__ int cond_of_row(int row) { return row < MP ? 0 : 1 + ((row - MP) >> 11); }

__device__ __forceinline__ void norm_phase(const Args& a, int l, bool ffn, const float* fixgate, int lane, int gw, int NGW) {
    OPAQUE_V(lane); PH_PTRS; OPAQUE_S(gw); OPAQUE_S(NGW);
    const float* g = a.in[ffn ? I_GFFN : I_GMIX] + (size_t)l * DM;
    const float* mods = (const float*)(ws + WS_MODS) + (size_t)l * 3 * NMOD + (ffn ? 3 * DM : 0);
    bf16* H = (bf16*)(ws + WS_H); bf16* X = (bf16*)(ws + WS_S + S_X);
    const bool first = (l == 0 && !ffn);
    for (int row = gw; row < MALL; row += NGW) {
        const float* md = mods + (size_t)cond_of_row(row) * NMOD;
        f32x4 v[8]; float ss = 0.f;
        const bool fix = fixgate != nullptr && row >= MP;
        const bf16* P0 = (const bf16*)(ws + WS_S + S_PART) + (size_t)(row - MP) * DM; const float* fg = fixgate + (size_t)cond_of_row(row) * NMOD;
        if (first) { const float* xr = row < MP ? a.in[I_XP] + (size_t)row * DM : a.in[I_XS] + (size_t)(row - MP) * DM;
#pragma unroll
            for (int j = 0; j < 8; ++j) v[j] = __builtin_nontemporal_load((const GAS f32x4*)(xr + 4 * (lane + 64 * j)));
        } else { const bf16* xr = X + (size_t)row * DM;
#pragma unroll
            for (int j = 0; j < 8; ++j) { const v2u w = *(const GAS v2u*)(xr + 4 * (lane + 64 * j)); v[j] = (f32x4){bf_lo(w.x), bf_hi(w.x), bf_lo(w.y), bf_hi(w.y)}; } }
#pragma unroll
        for (int j = 0; j < 8; ++j) {
            if (fix) { const int c = 4 * (lane + 64 * j); const v2u pw = __builtin_nontemporal_load((const GAS v2u*)(P0 + c)); v[j] = v[j] + *(const GAS f32x4*)(fg + c) * (f32x4){bf_lo(pw.x), bf_hi(pw.x), bf_lo(pw.y), bf_hi(pw.y)}; }
            ss += (v[j].x * v[j].x + v[j].y * v[j].y) + (v[j].z * v[j].z + v[j].w * v[j].w); }
        const float rs = rsqrtf(wave_sum(ss) * (1.f / DM) + EPS);
#pragma unroll
        for (int j = 0; j < 8; ++j) { const int c = 4 * (lane + 64 * j);
            const f32x4 gg = *(const GAS f32x4*)(g + c), sh = *(const GAS f32x4*)(md + c), sc = *(const GAS f32x4*)(md + DM + c);
            const f32x4 y = v[j] * rs * gg * (sc + 1.f) + sh;
            *(GAS v2u*)(H + (size_t)row * DM + c) = (v2u){pk2(y.x, y.y), pk2(y.z, y.w)};
            if (first || fix) *(GAS v2u*)(X + (size_t)row * DM + c) = (v2u){pk2(v[j].x, v[j].y), pk2(v[j].z, v[j].w)}; }
    }
}
__device__ __forceinline__ void final_fix_phase(const Args& a, const float* fixgate, int lane, int gw, int NGW) {
    OPAQUE_V(lane); PH_PTRS; OPAQUE_S(gw); OPAQUE_S(NGW);
    for (int row = MP + gw; row < MALL; row += NGW) {
        const bf16* P0 = (const bf16*)(ws + WS_S + S_PART) + (size_t)(row - MP) * DM; const float* fg = fixgate + (size_t)cond_of_row(row) * NMOD; float* xr = out + O_X + (size_t)row * DM;
#pragma unroll
        for (int j = 0; j < 8; ++j) { const int c = 4 * (lane + 64 * j); const v2u pw = *(const GAS v2u*)(P0 + c);
            *(GAS f32x4*)(xr + c) = *(const GAS f32x4*)(xr + c) + *(const GAS f32x4*)(fg + c) * (f32x4){bf_lo(pw.x), bf_hi(pw.x), bf_lo(pw.y), bf_hi(pw.y)}; }
    }
}
__device__ __forceinline__ void mla_thin_a(const Args& a, int j, int lane, int gw, int NGW) {
    OPAQUE_V(lane); PH_PTRS; OPAQUE_S(gw); OPAQUE_S(NGW);
    const bf16* QAKV = (const bf16*)(ws + WS_S + S_QAKV);
    bf16* QAN = (bf16*)(ws + WS_S + S_QAN); bf16* CKVN = (bf16*)(ws + WS_S + S_CKVN); float* KPE = (float*)(ws + WS_S + S_KPE); float* SSK = (float*)(ws + WS_SSK);
    const float* gqa = a.in[I_GQA] + (size_t)j * 768; const float* gkva = a.in[I_GKVA] + (size_t)j * 512;
    for (int row = gw; row < MKV; row += NGW) {
        if (row < MALL) {
            const bf16* r = QAKV + (size_t)row * 1536;
#define LD4(p_) ({ const v2u w_ = __builtin_nontemporal_load((const GAS v2u*)(p_)); (f32x4){bf_lo(w_.x), bf_hi(w_.x), bf_lo(w_.y), bf_hi(w_.y)}; })
            { f32x4 v[3]; float ss = 0.f;
#pragma unroll
              for (int i = 0; i < 3; ++i) { v[i] = LD4(r + 4 * (lane + 64 * i)); ss += (v[i].x * v[i].x + v[i].y * v[i].y) + (v[i].z * v[i].z + v[i].w * v[i].w); }
              const float rs = rsqrtf(wave_sum(ss) * (1.f / 768.f) + EPS);
#pragma unroll
              for (int i = 0; i < 3; ++i) { const int c = 4 * (lane + 64 * i); const f32x4 y = v[i] * rs * *(const GAS f32x4*)(gqa + c);
                  *(GAS v2u*)(QAN + (size_t)row * 768 + c) = (v2u){pk2(y.x, y.y), pk2(y.z, y.w)}; } }
            { f32x4 v[2]; float ss = 0.f;
#pragma unroll
              for (int i = 0; i < 2; ++i) { v[i] = LD4(r + 768 + 4 * (lane + 64 * i)); ss += (v[i].x * v[i].x + v[i].y * v[i].y) + (v[i].z * v[i].z + v[i].w * v[i].w); }
              const float rs = rsqrtf(wave_sum(ss) * (1.f / 512.f) + EPS);
#pragma unroll
              for (int i = 0; i < 2; ++i) { const int c = 4 * (lane + 64 * i); const f32x4 y = v[i] * rs * *(const GAS f32x4*)(gkva + c);
                  *(GAS v2u*)(CKVN + (size_t)row * 512 + c) = (v2u){pk2(y.x, y.y), pk2(y.z, y.w)};
                  if (row < MP) __builtin_nontemporal_store(y * DBG_SCALE, (GAS f32x4*)(out + O_CKV + ((size_t)((row >> 8) * 2 + j) * 256 + (row & 255)) * 512 + c)); } }
            { const float kp = __uint_as_float((unsigned)r[1280 + lane] << 16); KPE[(size_t)row * 64 + lane] = kp;
              if (row < MP) out[O_KPE + ((size_t)((row >> 8) * 2 + j) * 256 + (row & 255)) * 64 + lane] = kp * DBG_SCALE;
              const float s = wave_sum(kp * kp); if (lane == 0) SSK[row] = s; }
#undef LD4
        } else {
            const int cr = row - MALL, b = cr >> 8, t = cr & 255; const size_t src = (size_t)((b * 2 + j) * 256 + t);
            const float* ck = a.in[I_CCKV] + src * 512;
#pragma unroll
            for (int i = 0; i < 2; ++i) { const int c = 4 * (lane + 64 * i); const f32x4 y = *(const GAS f32x4*)(ck + c);
                *(GAS v2u*)(CKVN + (size_t)row * 512 + c) = (v2u){pk2(y.x, y.y), pk2(y.z, y.w)}; }
            const float kp = a.in[I_CKPE][src * 64 + lane]; KPE[(size_t)row * 64 + lane] = kp;
            const float s = wave_sum(kp * kp); if (lane == 0) SSK[row] = s;
        }
    }
}
namespace pg8 {
struct EpiF32 {
    static constexpr bool PERM = false;
    float* C; int ldc;
    __device__ __forceinline__ void operator()(const f32x4 (&acc)[2][2][4][2], const Unit& u, int wr, int wc, int fr, int fq) const {
        const int row0 = u.pm * BM + wr * 64 + fr, col0 = u.pn * BM + wc * 32 + 4 * fq;
#pragma unroll
        for (int ai = 0; ai < 2; ++ai)
#pragma unroll
            for (int m = 0; m < 4; ++m) { float* rowp = C + (size_t)(row0 + ai * HALF + m * 16) * ldc + col0;
#pragma unroll
                for (int bj = 0; bj < 2; ++bj)
#pragma unroll
                    for (int n = 0; n < 2; ++n) *(PG8_GAS f32x4*)(rowp + bj * HALF + n * 16) = acc[ai][bj][m][n]; }
    }
};
template <int ACT  > struct EpiBf16 {
    static constexpr bool PERM = true;
    bf16_t* O; int ldc;
    __device__ __forceinline__ void operator()(const f32x4 (&acc)[2][2][4][2], const Unit& u, int wr, int wc, int fr, int fq) const {
        const int row0 = u.pm * BM + wr * 64 + fr, col0 = u.pn * BM + wc * 32 + 8 * fq;
#pragma unroll
        for (int ai = 0; ai < 2; ++ai)
#pragma unroll
            for (int m = 0; m < 4; ++m) { bf16_t* rowp = O + (size_t)(row0 + ai * HALF + m * 16) * ldc + col0;
#pragma unroll
                for (int bj = 0; bj < 2; ++bj) { f32x4 v0 = acc[ai][bj][m][0], v1 = acc[ai][bj][m][1];
                    if (ACT == 1) {
#pragma unroll
                        for (int e = 0; e < 4; ++e) { const float x0 = fmaxf(v0[e], 0.f), x1 = fmaxf(v1[e], 0.f); v0[e] = x0 * x0; v1[e] = x1 * x1; } }
                    u32x4 w; w.x = cvt_pk_bf16(v0[0], v0[1]); w.y = cvt_pk_bf16(v0[2], v0[3]); w.z = cvt_pk_bf16(v1[0], v1[1]); w.w = cvt_pk_bf16(v1[2], v1[3]);
                    *(PG8_GAS u32x4*)(rowp + bj * HALF) = w; } }
    }
};
template <bool ATOMIC> struct EpiRes {
    static constexpr bool PERM = false;
    float* X; const float* gate;
    __device__ __forceinline__ void operator()(const f32x4 (&acc)[2][2][4][2], const Unit& u, int wr, int wc, int fr, int fq) const {
        const int rb = u.pm * BM, row0 = rb + wr * 64 + fr, col0 = u.pn * BM + wc * 32 + 4 * fq;
        const int cond = rb < 8192 ? 0 : 1 + ((rb - 8192) >> 11);
        const float* gp = gate + (size_t)cond * 12288 + col0;
        f32x4 gv[2][2];
#pragma unroll
        for (int bj = 0; bj < 2; ++bj)
#pragma unroll
            for (int n = 0; n < 2; ++n) gv[bj][n] = *(const PG8_GAS f32x4*)(gp + bj * HALF + n * 16);
#pragma unroll
        for (int ai = 0; ai < 2; ++ai)
#pragma unroll
            for (int m = 0; m < 4; ++m) { float* rowp = X + (size_t)(row0 + ai * HALF + m * 16) * 2048 + col0;
#pragma unroll
                for (int bj = 0; bj < 2; ++bj)
#pragma unroll
                    for (int n = 0; n < 2; ++n) { float* p = rowp + bj * HALF + n * 16; const f32x4 d = gv[bj][n] * acc[ai][bj][m][n];
                        if (ATOMIC) {
#pragma unroll
                            for (int e = 0; e < 4; ++e) __hip_atomic_fetch_add((PG8_GAS float*)(p + e), d[e], __ATOMIC_RELAXED, __HIP_MEMORY_SCOPE_AGENT);
                        } else { *(PG8_GAS f32x4*)p = *(const PG8_GAS f32x4*)p + d; } }
                asm volatile("" ::: "memory"); }
    }
};
struct EpiRes2 {
    static constexpr bool PERM = false;
    bf16_t* X; const float* gate; bf16_t* P; float* Yout;
    __device__ __forceinline__ void operator()(const f32x4 (&acc)[2][2][4][2], const Unit& u, int wr, int wc, int fr, int fq) const {
        typedef unsigned u32x2_ __attribute__((ext_vector_type(2)));
        const int rb = u.pm * BM, row0 = rb + wr * 64 + fr, col0 = u.pn * BM + wc * 32 + 4 * fq;
        if (u.part <= 0) {
            const int cond = rb < 8192 ? 0 : 1 + ((rb - 8192) >> 11);
            const float* gp = gate + (size_t)cond * 12288 + col0;
            f32x4 gv[2][2];
#pragma unroll
            for (int bj = 0; bj < 2; ++bj)
#pragma unroll
                for (int n = 0; n < 2; ++n) gv[bj][n] = *(const PG8_GAS f32x4*)(gp + bj * HALF + n * 16);
#pragma unroll
            for (int ai = 0; ai < 2; ++ai)
#pragma unroll
                for (int m = 0; m < 4; ++m) { const size_t ro = (size_t)(row0 + ai * HALF + m * 16) * 2048 + col0;
#pragma unroll
                    for (int bj = 0; bj < 2; ++bj)
#pragma unroll
                        for (int n = 0; n < 2; ++n) { const size_t o = ro + bj * HALF + n * 16; const u32x2_ w = *(const PG8_GAS u32x2_*)(X + o);
                            const f32x4 xn = (f32x4){__uint_as_float(w.x << 16), __uint_as_float(w.x & 0xffff0000u), __uint_as_float(w.y << 16), __uint_as_float(w.y & 0xffff0000u)} + gv[bj][n] * acc[ai][bj][m][n];
                            if (Yout != nullptr) *(PG8_GAS f32x4*)(Yout + o) = xn; else *(PG8_GAS u32x2_*)(X + o) = (u32x2_){cvt_pk_bf16(xn[0], xn[1]), cvt_pk_bf16(xn[2], xn[3])}; }
                    asm volatile("" ::: "memory"); }
        } else {
            bf16_t* Pp = P + (size_t)(row0 - 8192) * 2048 + col0;
#pragma unroll
            for (int ai = 0; ai < 2; ++ai)
#pragma unroll
                for (int m = 0; m < 4; ++m) { bf16_t* rowp = Pp + (size_t)(ai * HALF + m * 16) * 2048;
#pragma unroll
                    for (int bj = 0; bj < 2; ++bj)
#pragma unroll
                        for (int n = 0; n < 2; ++n) { const f32x4 v = acc[ai][bj][m][n]; *(PG8_GAS u32x2_*)(rowp + bj * HALF + n * 16) = (u32x2_){cvt_pk_bf16(v[0], v[1]), cvt_pk_bf16(v[2], v[3])}; } }
        }
    }
};
}
#ifndef DBG_REP_MASK
#define DBG_REP_MASK 0
#endif
namespace att {
using bf16x8 = __attribute__((ext_vector_type(8))) short;
using s16x4  = __attribute__((ext_vector_type(4))) short;
using f32x16 = __attribute__((ext_vector_type(16))) float;
using u32x4  = __attribute__((ext_vector_type(4))) unsigned;
constexpr int NW = 8, QBLK = 32, KVBLK = 64, DV = 128;
constexpr float THR = 8.f;
constexpr int SHM_V = KVBLK * DV * 2;
constexpr int RPB_OFF = 2 * SHM_V + 2 * KVBLK * 512 + 2048;
#define ATT_SBAR() __builtin_amdgcn_sched_barrier(0)
__device__ __forceinline__ int crow(int r, int hi) { return (r & 3) + 8 * (r >> 2) + 4 * hi; }
__device__ __forceinline__ unsigned cvtpk(float lo, float hi) { unsigned r; asm volatile("v_cvt_pk_bf16_f32 %0, %1, %2" : "=v"(r) : "v"(lo), "v"(hi)); return r; }
__device__ __forceinline__ int v_st(int k, int c) { const int kk = (k & ~0xC) | ((k & 4) << 1) | ((k & 8) >> 1); return ((kk >> 3) * 4 + (c >> 5)) * 512 + ((kk & 7) * 32 + (c & 31)) * 2; }
__device__ __forceinline__ int v_rd_base(int lane) { return ((lane & 3) << 3) | (((lane >> 2) & 3) << 6) | (((lane >> 4) & 1) << 5) | (((lane >> 5) & 1) << 8); }
constexpr int v_rd_off(int d0, int ks, int half) { return d0 * 512 + ks * 4096 + half * 2048; }
template <int OFF> __device__ __forceinline__ s16x4 tr_read(int vb) { s16x4 r; asm volatile("ds_read_b64_tr_b16 %0, %1 offset:%2" : "=&v"(r) : "v"(vb), "i"(OFF) : "memory"); return r; }
template <int D0> __device__ __forceinline__ void pv_one(f32x16& od, int vb, bf16x8 pa0, bf16x8 pa1, bf16x8 pa2, bf16x8 pa3) {
  const s16x4 l0 = tr_read<v_rd_off(D0, 0, 0)>(vb), h0 = tr_read<v_rd_off(D0, 0, 1)>(vb), l1 = tr_read<v_rd_off(D0, 1, 0)>(vb), h1 = tr_read<v_rd_off(D0, 1, 1)>(vb);
  const s16x4 l2 = tr_read<v_rd_off(D0, 2, 0)>(vb), h2 = tr_read<v_rd_off(D0, 2, 1)>(vb), l3 = tr_read<v_rd_off(D0, 3, 0)>(vb), h3 = tr_read<v_rd_off(D0, 3, 1)>(vb);
  asm volatile("s_waitcnt lgkmcnt(0)" ::: "memory"); ATT_SBAR();
#define ATT_PK(L, H) (bf16x8){L[0], L[1], L[2], L[3], H[0], H[1], H[2], H[3]}
  od = __builtin_amdgcn_mfma_f32_32x32x16_bf16(pa0, ATT_PK(l0, h0), od, 0, 0, 0);
  od = __builtin_amdgcn_mfma_f32_32x32x16_bf16(pa1, ATT_PK(l1, h1), od, 0, 0, 0);
  od = __builtin_amdgcn_mfma_f32_32x32x16_bf16(pa2, ATT_PK(l2, h2), od, 0, 0, 0);
  od = __builtin_amdgcn_mfma_f32_32x32x16_bf16(pa3, ATT_PK(l3, h3), od, 0, 0, 0);
#undef ATT_PK
}
__device__ __forceinline__ void pv_d0(f32x16* o, int vb, bf16x8 pa0, bf16x8 pa1, bf16x8 pa2, bf16x8 pa3) {
  pv_one<0>(o[0], vb, pa0, pa1, pa2, pa3); pv_one<1>(o[1], vb, pa0, pa1, pa2, pa3); pv_one<2>(o[2], vb, pa0, pa1, pa2, pa3); pv_one<3>(o[3], vb, pa0, pa1, pa2, pa3);
}
struct KvSrc { int row0, n0, row1, n1; __device__ __forceinline__ int row(int t) const { const int u = t - n0; return t < n0 ? row0 + 64 * t : row1 + 64 * (u < n1 ? u : n1 - 1); } };
struct NatMask { int rlo, qrow, qcol; const LAS float* rpb; };

template <int DQK, int MODE, int ldq, int ldk, int ldv, int ldo, int QP = 0>
__device__ __forceinline__ void attn_unit(const bf16* __restrict__ Qb, const bf16* __restrict__ Kh, const bf16* __restrict__ Vh,
                                          bf16* __restrict__ Ob, const KvSrc src, int NT, const NatMask nm, LAS char* lds, int tid,
                                          const float* __restrict__ qgain = nullptr, const float* __restrict__ qrope = nullptr) {
  constexpr float SCALE = DQK == 128 ? 0.088388347648318440f : 0.072168783648703220f;
  constexpr float C = SCALE * 1.4426950408889634f;
  constexpr int KROW = DQK == 128 ? 256 : 512  , SHM_K = KVBLK * KROW, NKC = DQK / 8, KCH = KVBLK * NKC / 512, ND0 = DQK / 16;
  const int wid = tid >> 6, lane = tid & 63, r32 = lane & 31, hi = lane >> 5;
  LAS char* V_lds = lds; LAS char* K_lds = lds + 2 * SHM_V;
  LAS float* ws = (LAS float*)(lds + 2 * SHM_V + 2 * SHM_K) + wid * 64; LAS float* li_l = ws; LAS float* al_l = ws + 32;
  float m_reg = -1e30f, l_reg = 0; f32x16 o[4] = {}; bf16x8 qr[ND0];
  { const bf16* Qw = Qb + (size_t)(wid * QBLK + r32) * ldq + hi * 8;
#pragma unroll
    for (int d0 = 0; d0 < ND0; ++d0) qr[d0] = *(const GAS bf16x8*)(Qw + d0 * 16); }
  if constexpr (QP == 1) {
    float ss = 0.f;
#pragma unroll
    for (int d0 = 0; d0 < ND0; ++d0) { const u32x4 w = __builtin_bit_cast(u32x4, qr[d0]);
#pragma unroll
      for (int e = 0; e < 4; ++e) { const float a = __uint_as_float(w[e] << 16), b = __uint_as_float(w[e] & 0xffff0000u); ss += a * a + b * b; } }
    ss += __shfl_xor(ss, 32);
    const float rs = rsqrtf(ss * (1.f / DQK) + 1e-6f);
    float xv[ND0 < 12 ? 1 : 4][8];
#pragma unroll
    for (int d0 = 0; d0 < ND0; ++d0) { const u32x4 w = __builtin_bit_cast(u32x4, qr[d0]);
      const f32x4 g0 = *(const GAS f32x4*)(qgain + d0 * 16 + hi * 8), g1 = *(const GAS f32x4*)(qgain + d0 * 16 + hi * 8 + 4);
      float x[8];
#pragma unroll
      for (int e = 0; e < 4; ++e) { x[2 * e] = __uint_as_float(w[e] << 16) * rs; x[2 * e + 1] = __uint_as_float(w[e] & 0xffff0000u) * rs; }
      x[0] *= g0.x; x[1] *= g0.y; x[2] *= g0.z; x[3] *= g0.w; x[4] *= g1.x; x[5] *= g1.y; x[6] *= g1.z; x[7] *= g1.w;
      if (ND0 == 12 && d0 >= 8) {
#pragma unroll
        for (int e = 0; e < 8; ++e) xv[ND0 < 12 ? 0 : d0 - 8][e] = x[e];
      } else { const u32x4 o_ = {cvtpk(x[0], x[1]), cvtpk(x[2], x[3]), cvtpk(x[4], x[5]), cvtpk(x[6], x[7])}; qr[d0] = __builtin_bit_cast(bf16x8, o_); } }
    if constexpr (ND0 == 12) {
#pragma unroll
      for (int pp = 0; pp < 2; ++pp) {
        float y1[8], y2[8];
#pragma unroll
        for (int e = 0; e < 8; ++e) { y1[e] = xv[pp][e]; y2[e] = xv[2 + pp][e]; }
        if (qrope != nullptr) { const float* rt = qrope + ((size_t)(wid * QBLK + r32) * 32 + 16 * pp + 8 * hi) * 2;
#pragma unroll
          for (int e2 = 0; e2 < 4; ++e2) { const f32x4 cs = *(const GAS f32x4*)(rt + 4 * e2);
            const float a0 = y1[2 * e2] * cs.x - y2[2 * e2] * cs.y, b0 = y1[2 * e2] * cs.y + y2[2 * e2] * cs.x;
            const float a1 = y1[2 * e2 + 1] * cs.z - y2[2 * e2 + 1] * cs.w, b1 = y1[2 * e2 + 1] * cs.w + y2[2 * e2 + 1] * cs.z;
            y1[2 * e2] = a0; y2[2 * e2] = b0; y1[2 * e2 + 1] = a1; y2[2 * e2 + 1] = b1; } }
        const u32x4 o1 = {cvtpk(y1[0], y1[1]), cvtpk(y1[2], y1[3]), cvtpk(y1[4], y1[5]), cvtpk(y1[6], y1[7])}, o2 = {cvtpk(y2[0], y2[1]), cvtpk(y2[2], y2[3]), cvtpk(y2[4], y2[5]), cvtpk(y2[6], y2[7])};
        qr[8 + pp] = __builtin_bit_cast(bf16x8, o1); qr[10 + pp] = __builtin_bit_cast(bf16x8, o2); }
    }
  }
  const int sr = tid >> 4, sc = (tid & 15) * 8, vst0 = v_st(sr, sc), vst1 = v_st(32 + sr, sc);
  unsigned koff_[KCH], kst_[KCH]; const unsigned voff0 = (unsigned)(sr * ldv + sc);
#pragma unroll
  for (int i = 0; i < KCH; ++i) { const int c = tid + 512 * i, kr = c / NKC, kc = c % NKC; koff_[i] = (unsigned)(kr * ldk + kc * 8); kst_[i] = (unsigned)(kr * KROW + ((kc * 16) ^ ((kr & 15) << 4))); }
  const int vb0 = (int)(uintptr_t)V_lds + v_rd_base(lane);
  bf16x8 svs0, svs1, sks[KCH];
#define ATT_SLOAD(t) do { const int _r = __builtin_amdgcn_readfirstlane(src.row(t)); const bf16* _vt = Vh + (size_t)_r * ldv; const bf16* _kt = Kh + (size_t)_r * ldk; \
    svs0 = *(const GAS bf16x8*)(_vt + voff0); svs1 = *(const GAS bf16x8*)(_vt + 32 * ldv + voff0); \
    _Pragma("unroll") for (int _i = 0; _i < KCH; ++_i) sks[_i] = *(const GAS bf16x8*)(_kt + koff_[_i]); } while (0)
#define ATT_SWRITE(b) do { *(LAS bf16x8*)(V_lds + (b) * SHM_V + vst0) = svs0; *(LAS bf16x8*)(V_lds + (b) * SHM_V + vst1) = svs1; \
    _Pragma("unroll") for (int _i = 0; _i < KCH; ++_i) *(LAS bf16x8*)(K_lds + (b) * SHM_K + kst_[_i]) = sks[_i]; } while (0)
#define ATT_RESC(a) do { if (__any((a) < 1.f)) { if (hi == 0) al_l[r32] = (a); asm volatile("s_waitcnt lgkmcnt(0)" ::: "memory"); \
    _Pragma("unroll") for (int d = 0; d < 4; ++d) _Pragma("unroll") for (int r = 0; r < 16; ++r) o[d][r] *= al_l[crow(r, hi)]; } } while (0)
  auto qkt = [&](f32x16& p0, f32x16& p1, int b, int t) {
    const LAS char* Ks = K_lds + b * SHM_K;
    p0 = f32x16{}; p1 = f32x16{};
    const LAS char* k0p = Ks + r32 * KROW; const LAS char* k1p = Ks + (32 + r32) * KROW; const int sw = (r32 & 15) << 4;
    bf16x8 ka[2], kb[2];
    ka[0] = *reinterpret_cast<const LAS bf16x8*>(k0p + ((hi * 16) ^ sw)); kb[0] = *reinterpret_cast<const LAS bf16x8*>(k1p + ((hi * 16) ^ sw));
#pragma unroll
    for (int d0 = 0; d0 < ND0; ++d0) {
      if (d0 + 1 < ND0) { const int cb = ((d0 + 1) * 16 + hi * 8) * 2;
        ka[(d0 + 1) & 1] = *reinterpret_cast<const LAS bf16x8*>(k0p + (cb ^ sw)); kb[(d0 + 1) & 1] = *reinterpret_cast<const LAS bf16x8*>(k1p + (cb ^ sw)); }
      __builtin_amdgcn_sched_barrier(0);
      p0 = __builtin_amdgcn_mfma_f32_32x32x16_bf16(ka[d0 & 1], qr[d0], p0, 0, 0, 0);
      p1 = __builtin_amdgcn_mfma_f32_32x32x16_bf16(kb[d0 & 1], qr[d0], p1, 0, 0, 0);
      __builtin_amdgcn_sched_barrier(0); }
    if constexpr (MODE == 1) {
      const int i = t - src.n0;
      if (i >= 0) {
        const int kr = nm.rlo + i, r0q = min(max(nm.qrow - 4, 0), 24), c0q = min(max(nm.qcol - 8, 0), 48);
        const bool rowok = (i < src.n1) && (kr >= r0q) && (kr < r0q + 8);
        const int rowoff = (kr - nm.qrow + 7) * 31 + 15 - nm.qcol;
#pragma unroll
        for (int r = 0; r < 16; ++r) {
          const int kc0 = crow(r, hi), kc1 = kc0 + 32;
          const bool ok0 = rowok && ((unsigned)(kc0 - c0q) < 16u), ok1 = rowok && ((unsigned)(kc1 - c0q) < 16u);
          const float b0 = nm.rpb[ok0 ? rowoff + kc0 : 0], b1 = nm.rpb[ok1 ? rowoff + kc1 : 0];
          p0[r] = ok0 ? p0[r] + b0 : -1e30f; p1[r] = ok1 ? p1[r] + b1 : -1e30f; }
      }
    }
  };
  auto partialSM = [&](f32x16& p0, f32x16& p1, float& mn, float& alpha) {
    float pmax = p0[0];
#pragma unroll
    for (int r = 1; r < 16; ++r) pmax = fmaxf(pmax, p0[r]);
#pragma unroll
    for (int r = 0; r < 16; ++r) pmax = fmaxf(pmax, p1[r]);
    { auto rr = __builtin_amdgcn_permlane32_swap(__float_as_uint(pmax), __float_as_uint(pmax), false, false); pmax = fmaxf(__uint_as_float(rr[0]), __uint_as_float(rr[1])); }
    if (__builtin_expect(__all(pmax - m_reg <= THR / SCALE), 1)) { mn = m_reg; alpha = 1.f; }
    else { mn = fmaxf(m_reg, pmax); alpha = __builtin_amdgcn_exp2f((m_reg - mn) * C); m_reg = mn; }
    const float mnC = -mn * C;
#pragma unroll
    for (int r = 0; r < 16; ++r) p0[r] = fmaf(p0[r], C, mnC);
#pragma unroll
    for (int r = 0; r < 16; ++r) p1[r] = fmaf(p1[r], C, mnC);
#pragma unroll
    for (int r = 0; r < 16; ++r) p0[r] = __builtin_amdgcn_exp2f(p0[r]);
  };
  auto finishSM = [&](f32x16& p0, f32x16& p1, float alpha, bf16x8& pa0, bf16x8& pa1, bf16x8& pa2, bf16x8& pa3) {
#pragma unroll
    for (int r = 0; r < 16; ++r) p1[r] = __builtin_amdgcn_exp2f(p1[r]);
    float ps = 0;
#pragma unroll
    for (int r = 0; r < 16; ++r) ps += p0[r];
#pragma unroll
    for (int r = 0; r < 16; ++r) ps += p1[r];
    { auto rr = __builtin_amdgcn_permlane32_swap(__float_as_uint(ps), __float_as_uint(ps), false, false); ps = __uint_as_float(rr[0]) + __uint_as_float(rr[1]); }
    l_reg = l_reg * alpha + ps;
#define ATT_PK4(P, BASE, OUT) do { unsigned a0 = cvtpk(P[BASE + 0], P[BASE + 1]), a1 = cvtpk(P[BASE + 2], P[BASE + 3]); \
    unsigned b0 = cvtpk(P[BASE + 4], P[BASE + 5]), b1 = cvtpk(P[BASE + 6], P[BASE + 7]); \
    auto r0 = __builtin_amdgcn_permlane32_swap(a0, b0, false, false); auto r1 = __builtin_amdgcn_permlane32_swap(a1, b1, false, false); \
    u32x4 w = {r0[0], r1[0], r0[1], r1[1]}; OUT = *reinterpret_cast<bf16x8*>(&w); } while (0)
    ATT_PK4(p0, 0, pa0); ATT_PK4(p0, 8, pa1); ATT_PK4(p1, 0, pa2); ATT_PK4(p1, 8, pa3);
#undef ATT_PK4
  };
  f32x16 p0, p1; float mn, al; bf16x8 pa0, pa1, pa2, pa3;
  ATT_SLOAD(0); asm volatile("s_waitcnt vmcnt(0)" ::: "memory"); ATT_SWRITE(0); if (NT > 1) ATT_SLOAD(1); __syncthreads();
  for (int t = 0; t < NT; ++t) {
    const int b = t & 1;
    ATT_SBAR(); qkt(p0, p1, b, t); ATT_SBAR();
    if (t + 1 < NT) { asm volatile("s_waitcnt vmcnt(0)" ::: "memory"); ATT_SWRITE(b ^ 1); if (t + 2 < NT) ATT_SLOAD(t + 2); }
    ATT_SBAR();
    partialSM(p0, p1, mn, al); ATT_RESC(al);
    finishSM(p0, p1, al, pa0, pa1, pa2, pa3); ATT_SBAR();
    pv_d0(o, vb0 + b * SHM_V, pa0, pa1, pa2, pa3);
    __syncthreads();
  }
  if (hi == 0) li_l[r32] = l_reg; asm volatile("s_waitcnt lgkmcnt(0)" ::: "memory");
  int hi_o = hi; asm volatile("" : "+v"(hi_o));
  bf16* Ow = Ob + (size_t)(wid * QBLK + 4 * hi_o) * ldo;
#pragma unroll
  for (int r = 0; r < 16; ++r) { const int orow = crow(r, 0); const float rl = __builtin_amdgcn_rcpf(li_l[orow + 4 * hi_o]);
#pragma unroll
    for (int d0 = 0; d0 < 4; ++d0) { const float v = o[d0][r] * rl; ((GAS bf16*)Ow)[(size_t)orow * ldo + d0 * 32 + r32] = (bf16)(cvtpk(v, v) & 0xffffu); } }
#undef ATT_SLOAD
#undef ATT_SWRITE
#undef ATT_RESC
}
}
namespace pg8 {
struct EpiKV {
    static constexpr bool PERM = true;
    bf16_t* KV; bf16_t* KF; const float* gkn; const float* KPE; const float* SSK; const float* RT; PG8_LAS float* tab;
    __device__ __forceinline__ void operator()(const f32x4 (&acc)[2][2][4][2], const Unit& u, int wr, int wc, int fr, int fq) const {
        const int h = u.pn, row0 = u.pm * BM + wr * 64 + fr, c8 = wc * 32 + 8 * fq;
        float sk[2][4];
#pragma unroll
        for (int ai = 0; ai < 2; ++ai)
#pragma unroll
            for (int m = 0; m < 4; ++m) { const f32x4 a = acc[ai][0][m][0], b = acc[ai][0][m][1]; sk[ai][m] = ((const PG8_GAS float*)SSK)[row0 + ai * HALF + m * 16];
                float s = (a[0] * a[0] + a[1] * a[1]) + (a[2] * a[2] + a[3] * a[3]) + (b[0] * b[0] + b[1] * b[1]) + (b[2] * b[2] + b[3] * b[3]);
                s += __shfl_xor(s, 16); s += __shfl_xor(s, 32);
                if (fq == 0) tab[(ai * HALF + wr * 64 + m * 16 + fr) * 4 + wc] = s; }
#pragma unroll
        for (int ai = 0; ai < 2; ++ai)
#pragma unroll
            for (int m = 0; m < 4; ++m) { const f32x4 v0 = acc[ai][1][m][0], v1 = acc[ai][1][m][1];
                u32x4 w; w.x = cvt_pk_bf16(v0[0], v0[1]); w.y = cvt_pk_bf16(v0[2], v0[3]); w.z = cvt_pk_bf16(v1[0], v1[1]); w.w = cvt_pk_bf16(v1[2], v1[3]);
                *(PG8_GAS u32x4*)(KV + (size_t)(row0 + ai * HALF + m * 16) * 4096 + h * 256 + 128 + c8) = w; }
        asm volatile("s_waitcnt lgkmcnt(0)" ::: "memory"); __builtin_amdgcn_s_barrier(); asm volatile("" ::: "memory");
        const f32x4 g0 = *(const PG8_GAS f32x4*)(gkn + c8), g1 = *(const PG8_GAS f32x4*)(gkn + c8 + 4);
#pragma unroll
        for (int ai = 0; ai < 2; ++ai)
#pragma unroll
            for (int m = 0; m < 4; ++m) { const int row = row0 + ai * HALF + m * 16; const f32x4 p = *(const PG8_LAS f32x4*)(tab + (ai * HALF + wr * 64 + m * 16 + fr) * 4);
                const float rs = rsqrtf(((p[0] + p[1]) + (p[2] + p[3]) + sk[ai][m]) * (1.f / 192.f) + 1e-6f);
                const f32x4 k0 = acc[ai][0][m][0] * rs * g0, k1 = acc[ai][0][m][1] * rs * g1;
                u32x4 w; w.x = cvt_pk_bf16(k0[0], k0[1]); w.y = cvt_pk_bf16(k0[2], k0[3]); w.z = cvt_pk_bf16(k1[0], k1[1]); w.w = cvt_pk_bf16(k1[2], k1[3]);
                *(PG8_GAS u32x4*)(KF + (size_t)row * 3072 + h * 192 + c8) = w; }
        { const int t_ = (wr * 4 + wc) * 64 + fq * 16 + fr, r = t_ >> 1, hf = t_ & 1, row = u.pm * BM + r;
          const f32x4 p = *(const PG8_LAS f32x4*)(tab + r * 4);
          const float rs = rsqrtf(((p[0] + p[1]) + (p[2] + p[3]) + ((const PG8_GAS float*)SSK)[row]) * (1.f / 192.f) + 1e-6f);
          const bool rot = row >= 8192 && row < 12288; const float* rt = RT + ((size_t)((row - 8192) & 2047) * 32 + 16 * hf) * 2;
          const float* kp = KPE + (size_t)row * 64 + 16 * hf; bf16_t* o = KF + (size_t)row * 3072 + h * 192 + 128 + 16 * hf;
#pragma unroll
          for (int q = 0; q < 2; ++q) {
              f32x4 a0 = *(const PG8_GAS f32x4*)(kp + 8 * q), a1 = *(const PG8_GAS f32x4*)(kp + 8 * q + 4), b0 = *(const PG8_GAS f32x4*)(kp + 32 + 8 * q), b1 = *(const PG8_GAS f32x4*)(kp + 32 + 8 * q + 4);
              a0 = a0 * rs * *(const PG8_GAS f32x4*)(gkn + 128 + 16 * hf + 8 * q); a1 = a1 * rs * *(const PG8_GAS f32x4*)(gkn + 128 + 16 * hf + 8 * q + 4);
              b0 = b0 * rs * *(const PG8_GAS f32x4*)(gkn + 160 + 16 * hf + 8 * q); b1 = b1 * rs * *(const PG8_GAS f32x4*)(gkn + 160 + 16 * hf + 8 * q + 4);
              float x1[8] = {a0[0], a0[1], a0[2], a0[3], a1[0], a1[1], a1[2], a1[3]}, x2[8] = {b0[0], b0[1], b0[2], b0[3], b1[0], b1[1], b1[2], b1[3]};
              if (rot) {
#pragma unroll
                  for (int e2 = 0; e2 < 4; ++e2) { const f32x4 cs = *(const PG8_GAS f32x4*)(rt + (8 * q + 2 * e2) * 2);
                      const float y0 = x1[2 * e2] * cs[0] - x2[2 * e2] * cs[1], z0 = x1[2 * e2] * cs[1] + x2[2 * e2] * cs[0];
                      const float y1 = x1[2 * e2 + 1] * cs[2] - x2[2 * e2 + 1] * cs[3], z1 = x1[2 * e2 + 1] * cs[3] + x2[2 * e2 + 1] * cs[2];
                      x1[2 * e2] = y0; x2[2 * e2] = z0; x1[2 * e2 + 1] = y1; x2[2 * e2 + 1] = z1; } }
              u32x4 w1, w2; w1.x = cvt_pk_bf16(x1[0], x1[1]); w1.y = cvt_pk_bf16(x1[2], x1[3]); w1.z = cvt_pk_bf16(x1[4], x1[5]); w1.w = cvt_pk_bf16(x1[6], x1[7]);
              w2.x = cvt_pk_bf16(x2[0], x2[1]); w2.y = cvt_pk_bf16(x2[2], x2[3]); w2.z = cvt_pk_bf16(x2[4], x2[5]); w2.w = cvt_pk_bf16(x2[6], x2[7]);
              *(PG8_GAS u32x4*)(o + 8 * q) = w1; *(PG8_GAS u32x4*)(o + 32 + 8 * q) = w2; } }
    }
};
}
__device__ __forceinline__ void rope_table(const Args& a, int tid, int vcu, int G) {
    f32x2* RT = (f32x2*)(a.ws + WS_ROPE);
    for (int e = vcu * NTHR + tid; e < 2048 * 32; e += G * NTHR) { const int t = e >> 5, i = e & 31;
        const float inv = exp2f(-(float)(i & 15) * (13.287712379549449f / 16.f));
        const float ang = (float)(i < 16 ? (t >> 6) : (t & 63)) * inv; float s, c; sincosf(ang, &s, &c); RT[e] = (f32x2){c, s}; }
}
__device__ __forceinline__ void mla_thin_b(const Args& a, int j, int lane, int gw, int NGW) {
    OPAQUE_V(lane); PH_PTRS; OPAQUE_S(gw); OPAQUE_S(NGW);
    const bf16* QRAW = (const bf16*)(ws + WS_S + S_QRAW); bf16* QN = (bf16*)(ws + WS_S + S_QN);
    const bf16* KVRAW = (const bf16*)(ws + WS_S + S_KVRAW); bf16* KF = (bf16*)(ws + WS_S + S_KF);
    const float* KPE = (const float*)(ws + WS_S + S_KPE); const float* SSK = (const float*)(ws + WS_SSK);
    const f32x2* RT = (const f32x2*)(ws + WS_ROPE);
    const float* gqn = a.in[I_GQN] + (size_t)j * 192; const float* gkn = a.in[I_GKN] + (size_t)j * 192;
    const int grp = lane >> 4, s = lane & 15;
    float gq[12], gk[12];
#pragma unroll
    for (int e = 0; e < 8; ++e) { gq[e] = gqn[8 * s + e]; gk[e] = gkn[8 * s + e]; }
    gq[8] = gqn[128 + 2 * s]; gq[9] = gqn[129 + 2 * s]; gq[10] = gqn[160 + 2 * s]; gq[11] = gqn[161 + 2 * s];
    gk[8] = gkn[128 + 2 * s]; gk[9] = gkn[129 + 2 * s]; gk[10] = gkn[160 + 2 * s]; gk[11] = gkn[161 + 2 * s];
    const int NQI = 0, NKI = MKV * 4;
    for (int it = gw; it < NQI + NKI; it += NGW) {
        const bool isq = it < NQI; const int r4 = isq ? it : it - NQI; const int row = r4 >> 2, h = (r4 & 3) * 4 + grp;
        float x[12];
        if (isq) {
            const bf16* p = QRAW + (size_t)row * 3072 + h * 192;
            const v4u w = *(const GAS v4u*)(p + 8 * s); const unsigned w1 = *(const GAS unsigned*)(p + 128 + 2 * s), w2 = *(const GAS unsigned*)(p + 160 + 2 * s);
            x[0] = bf_lo(w.x); x[1] = bf_hi(w.x); x[2] = bf_lo(w.y); x[3] = bf_hi(w.y); x[4] = bf_lo(w.z); x[5] = bf_hi(w.z); x[6] = bf_lo(w.w); x[7] = bf_hi(w.w);
            x[8] = bf_lo(w1); x[9] = bf_hi(w1); x[10] = bf_lo(w2); x[11] = bf_hi(w2);
        } else {
            const bf16* p = KVRAW + (size_t)row * 4096 + h * 256;
            const v4u w = *(const GAS v4u*)(p + 8 * s);
            x[0] = bf_lo(w.x); x[1] = bf_hi(w.x); x[2] = bf_lo(w.y); x[3] = bf_hi(w.y); x[4] = bf_lo(w.z); x[5] = bf_hi(w.z); x[6] = bf_lo(w.w); x[7] = bf_hi(w.w);
            const f32x2 k1 = *(const GAS f32x2*)(KPE + (size_t)row * 64 + 2 * s), k2 = *(const GAS f32x2*)(KPE + (size_t)row * 64 + 32 + 2 * s);
            x[8] = k1.x; x[9] = k1.y; x[10] = k2.x; x[11] = k2.y;
        }
        float ss = 0.f;
#pragma unroll
        for (int e = 0; e < 8; ++e) ss += x[e] * x[e];
        if (isq) { ss += x[8] * x[8] + x[9] * x[9] + x[10] * x[10] + x[11] * x[11]; ss = sum16(ss); }
        else { ss = sum16(ss) + SSK[row]; }
        const float rs = rsqrtf(ss * (1.f / 192.f) + EPS);
#pragma unroll
        for (int e = 0; e < 12; ++e) x[e] = x[e] * rs * (isq ? gq[e] : gk[e]);
        if (row >= MP && row < MALL) {
            const int t = (row - MP) & 2047; const f32x2 cs0 = RT[t * 32 + 2 * s], cs1 = RT[t * 32 + 2 * s + 1];
            const float a0 = x[8] * cs0.x - x[10] * cs0.y, b0 = x[8] * cs0.y + x[10] * cs0.x, a1 = x[9] * cs1.x - x[11] * cs1.y, b1 = x[9] * cs1.y + x[11] * cs1.x;
            x[8] = a0; x[9] = a1; x[10] = b0; x[11] = b1;
        }
        bf16* o = (isq ? QN : KF) + (size_t)row * 3072 + h * 192;
        *(GAS v4u*)(o + 8 * s) = (v4u){pk2(x[0], x[1]), pk2(x[2], x[3]), pk2(x[4], x[5]), pk2(x[6], x[7])};
        *(GAS unsigned*)(o + 128 + 2 * s) = pk2(x[8], x[9]); *(GAS unsigned*)(o + 160 + 2 * s) = pk2(x[10], x[11]);
    }
}
__device__ __forceinline__ void mla_attn_phase(const Args& a, int j, LAS unsigned char* lds, int tid, int vcu, int G) {
    OPAQUE_V(tid); PH_PTRS; OPAQUE_S(vcu); OPAQUE_S(G);
    const bf16* QN = (const bf16*)(ws + WS_S + S_QRAW); const bf16* KF = (const bf16*)(ws + WS_S + S_KF); const bf16* KVRAW = (const bf16*)(ws + WS_S + S_KVRAW);
    bf16* AO = (bf16*)(ws + WS_S + S_AO); const float* gqn = a.in[I_GQN] + (size_t)j * 192; const float* RT = (const float*)(ws + WS_ROPE);
    for (int u = vcu; u < 768; u += G) {
        int q0, h, NT; att::KvSrc src; const float* qrope = nullptr;
        if (u < 256) { const int b = u >> 7, qb = u & 7; h = (u >> 3) & 15; q0 = MP + b * 2048 + qb * 256; src = att::KvSrc{MP + b * 2048, 32, MALL + b * 256, 4}; NT = 36; qrope = RT + (size_t)(qb * 256) * 64; }
        else { const int v = u - 256, b = v >> 4; h = v & 15; q0 = b * 256; src = att::KvSrc{b * 256, 4, 0, 1}; NT = 4; }
        att::attn_unit<192, 0, 3072, 3072, 4096, DM, 1>(QN + (size_t)q0 * 3072 + h * 192, KF + h * 192, KVRAW + h * 256 + 128, AO + (size_t)q0 * DM + h * 128, src, NT, att::NatMask{0, 0, 0, nullptr}, (LAS char*)lds, tid, gqn, qrope);
    }
}
namespace pg8 {
struct EpiHg {
    static constexpr bool PERM = true;
    unsigned char* ws;
    __device__ __forceinline__ void operator()(const f32x4 (&acc)[2][2][4][2], const Unit& u, int wr, int wc, int fr, int fq) const {
        const int region = u.pn >> 3, row0 = u.pm * BM + wr * 64 + fr, col0 = (u.pn & 7) * BM + wc * 32 + 8 * fq;
        if (region == 1 || region == 2) {
            const int d = region - 1;
            f32x4 lbv[2][2];
#pragma unroll
            for (int bj = 0; bj < 2; ++bj)
#pragma unroll
                for (int n = 0; n < 2; ++n) lbv[bj][n] = *(const PG8_GAS f32x4*)((const float*)(ws + WS_LB) + d * 2048 + col0 + bj * HALF + 4 * n);
            bf16_t* K = (bf16_t*)(ws + WS_S + S_HK) + (size_t)d * 12288 * 2048; float* Gd = (float*)(ws + WS_U) + (size_t)d * 12288 * 2048;
#pragma unroll
            for (int ai = 0; ai < 2; ++ai)
#pragma unroll
                for (int m = 0; m < 4; ++m) { const size_t ro = (size_t)(row0 + ai * HALF + m * 16) * 2048 + col0;
#pragma unroll
                    for (int bj = 0; bj < 2; ++bj) { f32x4 kk[2], gg[2];
#pragma unroll
                        for (int n = 0; n < 2; ++n)
#pragma unroll
                            for (int e = 0; e < 4; ++e) { const float z = acc[ai][bj][m][n][e]; const float sn = __builtin_amdgcn_rcpf(1.f + __expf(z));
                                const float k = (1.f - lbv[bj][n][e]) * sn; kk[n][e] = k; gg[n][e] = __log2f(1.f - k); }
                        u32x4 w; w.x = cvt_pk_bf16(kk[0][0], kk[0][1]); w.y = cvt_pk_bf16(kk[0][2], kk[0][3]); w.z = cvt_pk_bf16(kk[1][0], kk[1][1]); w.w = cvt_pk_bf16(kk[1][2], kk[1][3]);
                        *(PG8_GAS u32x4*)(K + ro + bj * HALF) = w; *(PG8_GAS f32x4*)(Gd + ro + bj * HALF) = gg[0]; *(PG8_GAS f32x4*)(Gd + ro + bj * HALF + 4) = gg[1]; } }
        } else {
            bf16_t* O = (bf16_t*)(ws + WS_S + (region == 0 ? S_HQ : region == 3 ? S_HV : S_HGS)); const bool act = region != 3;
#pragma unroll
            for (int ai = 0; ai < 2; ++ai)
#pragma unroll
                for (int m = 0; m < 4; ++m) { bf16_t* rowp = O + (size_t)(row0 + ai * HALF + m * 16) * 2048 + col0;
#pragma unroll
                    for (int bj = 0; bj < 2; ++bj) { f32x4 v0 = acc[ai][bj][m][0], v1 = acc[ai][bj][m][1];
                        if (act) {
#pragma unroll
                            for (int e = 0; e < 4; ++e) { v0[e] = v0[e] * __builtin_amdgcn_rcpf(1.f + __expf(-v0[e])); v1[e] = v1[e] * __builtin_amdgcn_rcpf(1.f + __expf(-v1[e])); } }
                        u32x4 w; w.x = cvt_pk_bf16(v0[0], v0[1]); w.y = cvt_pk_bf16(v0[2], v0[3]); w.z = cvt_pk_bf16(v1[0], v1[1]); w.w = cvt_pk_bf16(v1[2], v1[3]);
                        *(PG8_GAS u32x4*)(rowp + bj * HALF) = w; } }
        }
    }
};
}

namespace hg {
constexpr int PQ = 272, PK = 80;
constexpr int OFF_QM = 0, OFF_KM = 32 * PQ, OFF_V = 2 * 32 * PQ, OFF_ATT = 3 * 32 * PQ, OFF_C2 = OFF_ATT + 32 * PK, OFF_C3 = OFF_C2 + 512, BUF = OFF_C3 + 512;
constexpr int OFF_TOT = 2 * BUF, TOT_BYTES = 8 * 128 * 4;
constexpr int OFF_OST = OFF_TOT + 2 * TOT_BYTES;
constexpr int OFF_STG = OFF_OST + 32 * PQ, STG_SLOT = 40960;
static_assert(OFF_STG + 2 * STG_SLOT <= LDSCTL_OFF, "scan LDS (must stay below the control words)");
typedef short bf16x8 __attribute__((ext_vector_type(8)));
typedef short s16x4 __attribute__((ext_vector_type(4)));
struct Chain { int rb, N, d, h; const float* S0; float* Sout; };
template <int OFF> __device__ __forceinline__ s16x4 tr_read(int addr) { s16x4 r; asm volatile("ds_read_b64_tr_b16 %0, %1 offset:%2" : "=&v"(r) : "v"(addr), "i"(OFF) : "memory"); return r; }
__device__ __forceinline__ unsigned bfmul2(unsigned w, float e0, float e1) { return pk2(bf_lo(w) * e0, bf_hi(w) * e1); }

__device__ __forceinline__ void scan_chain(const Chain ch, const bf16* __restrict__ HQ, const bf16* __restrict__ HK, const float* __restrict__ HG, const bf16* __restrict__ HV,
                                           bf16* __restrict__ OD, LAS unsigned char* lds, int tid) {
    const int lane = tid & 63, w = tid >> 6, l15 = lane & 15, q4 = lane >> 4;
    const int k2 = lane;
    const int vt = tid >> 4, v8 = (tid & 15) * 8;
    const int nc = ch.N >> 5, hc = ch.h * 128;
    f32x4 S[8];
    if (ch.S0) {
#pragma unroll
        for (int kt = 0; kt < 8; ++kt)
#pragma unroll
            for (int r = 0; r < 4; ++r) S[kt][r] = ((const GAS float*)ch.S0)[(size_t)(16 * kt + 4 * q4 + r) * 128 + 16 * w + l15];
    } else {
#pragma unroll
        for (int kt = 0; kt < 8; ++kt) S[kt] = (f32x4){0.f, 0.f, 0.f, 0.f};
    }
#define HG_ROW(c, t) (ch.rb + (ch.d ? ch.N - 1 - (32 * (c) + (t)) : 32 * (c) + (t)))
    struct InSet { f32x2 g[4]; unsigned q[4], k[4]; v4u v; };
    f32x2 cl[4]; unsigned cq[4], ck[4]; v4u cv;
#define HG_DMA(c) do { LAS unsigned char* sl_ = lds + OFF_STG + ((c) & 1) * STG_SLOT; \
        _Pragma("unroll") for (int i_ = 0; i_ < 2; ++i_) __builtin_amdgcn_global_load_lds((const unsigned*)(HG + (size_t)HG_ROW(c, 4 * w + 2 * i_ + (lane >> 5)) * 2048 + hc + (lane & 31) * 4), (LAS unsigned*)(sl_ + (4 * w + 2 * i_) * 512), 16, 0, 0); \
        { const size_t ro_ = (size_t)HG_ROW(c, 4 * w + (lane >> 4)) * 2048 + hc + (lane & 15) * 8; \
          __builtin_amdgcn_global_load_lds((const unsigned*)(HQ + ro_), (LAS unsigned*)(sl_ + 16384 + 4 * w * 256), 16, 0, 0); \
          __builtin_amdgcn_global_load_lds((const unsigned*)(HK + ro_), (LAS unsigned*)(sl_ + 24576 + 4 * w * 256), 16, 0, 0); \
          __builtin_amdgcn_global_load_lds((const unsigned*)(HV + ro_), (LAS unsigned*)(sl_ + 32768 + 4 * w * 256), 16, 0, 0); } } while (0)
#define HG_P1(c) do { const LAS unsigned char* sl_ = lds + OFF_STG + ((c) & 1) * STG_SLOT; f32x2 run = (f32x2){0.f, 0.f}; \
        _Pragma("unroll") for (int i = 0; i < 4; ++i) { run = run + *(const LAS f32x2*)(sl_ + (4 * w + i) * 512 + k2 * 8); cl[i] = run; cq[i] = *(const LAS unsigned*)(sl_ + 16384 + (4 * w + i) * 256 + k2 * 4); ck[i] = *(const LAS unsigned*)(sl_ + 24576 + (4 * w + i) * 256 + k2 * 4); } \
        cv = *(const LAS v4u*)(sl_ + 32768 + vt * 256 + v8 * 2); \
        *(LAS f32x2*)(lds + OFF_TOT + ((c) & 1) * TOT_BYTES + (w * 128 + 2 * k2) * 4) = run; } while (0)
    HG_DMA(0); HG_DMA(1);
    asm volatile("s_waitcnt vmcnt(0)" ::: "memory"); HG_P1(0); LDS_WAIT(); asm volatile("" ::: "memory");
    HG_DMA(2);
    LDS_WAIT(); __builtin_amdgcn_s_barrier(); asm volatile("" ::: "memory");
    const int traddr = (int)(uintptr_t)lds + (8 * q4 + (l15 >> 2)) * PQ + (l15 & 3) * 8;
    auto mstage = [&](const int pc) {
        { LAS unsigned char* B = lds + (pc & 1) * BUF; const int tb = traddr + (pc & 1) * BUF;
            const s16x4 v0 = tr_read<0>(tb + OFF_V + 32 * w), v1 = tr_read<4 * PQ>(tb + OFF_V + 32 * w);
            bf16x8 aat[2]; v2u aq0[2][4], aq1[2][4];
#pragma unroll
            for (int tt = 0; tt < 2; ++tt) { aat[tt] = *(const LAS bf16x8*)(B + OFF_ATT + (16 * tt + l15) * PK + 16 * q4);
#pragma unroll
                for (int ks = 0; ks < 4; ++ks) { aq0[tt][ks] = *(const LAS v2u*)(B + OFF_QM + (16 * tt + l15) * PQ + (32 * ks + 4 * q4) * 2); aq1[tt][ks] = *(const LAS v2u*)(B + OFF_QM + (16 * tt + l15) * PQ + (32 * ks + 16 + 4 * q4) * 2); } }
            f32x4 c2v[8];
#pragma unroll
            for (int kt = 0; kt < 8; ++kt) c2v[kt] = *(const LAS f32x4*)(B + OFF_C2 + (16 * kt + 4 * q4) * 4);
            LDS_WAIT(); __builtin_amdgcn_sched_barrier(0);
            const bf16x8 bv = (bf16x8){v0[0], v0[1], v0[2], v0[3], v1[0], v1[1], v1[2], v1[3]};
            f32x4 o2[2];
#pragma unroll
            for (int kt = 0; kt < 8; ++kt) S[kt] = S[kt] * c2v[kt];
#pragma unroll
            for (int tt = 0; tt < 2; ++tt) o2[tt] = __builtin_amdgcn_mfma_f32_16x16x32_bf16(aat[tt], bv, (f32x4){0.f, 0.f, 0.f, 0.f}, 0, 0, 0);
#pragma unroll
            for (int ks = 0; ks < 4; ++ks) {
                const v4u sb = (v4u){pk2(S[2 * ks][0], S[2 * ks][1]), pk2(S[2 * ks][2], S[2 * ks][3]), pk2(S[2 * ks + 1][0], S[2 * ks + 1][1]), pk2(S[2 * ks + 1][2], S[2 * ks + 1][3])};
                const bf16x8 bs = __builtin_bit_cast(bf16x8, sb);
#pragma unroll
                for (int tt = 0; tt < 2; ++tt) { const bf16x8 aq = __builtin_bit_cast(bf16x8, ((v4u){aq0[tt][ks].x, aq0[tt][ks].y, aq1[tt][ks].x, aq1[tt][ks].y}));
                    o2[tt] = __builtin_amdgcn_mfma_f32_16x16x32_bf16(aq, bs, o2[tt], 0, 0, 0); }
            }
            s16x4 ke0[8], ke1[8]; f32x4 elv[8];
#define HG_KRD(kt) ke0[kt] = tr_read<32 * (kt)>(tb + OFF_KM); ke1[kt] = tr_read<32 * (kt) + 4 * PQ>(tb + OFF_KM)
            HG_KRD(0); HG_KRD(1); HG_KRD(2); HG_KRD(3); HG_KRD(4); HG_KRD(5); HG_KRD(6); HG_KRD(7);
#undef HG_KRD
#pragma unroll
            for (int kt = 0; kt < 8; ++kt) elv[kt] = *(const LAS f32x4*)(B + OFF_C3 + (16 * kt + 4 * q4) * 4);
            LDS_WAIT(); __builtin_amdgcn_sched_barrier(0);
#pragma unroll
            for (int kt = 0; kt < 8; ++kt) { const bf16x8 ak = (bf16x8){ke0[kt][0], ke0[kt][1], ke0[kt][2], ke0[kt][3], ke1[kt][0], ke1[kt][1], ke1[kt][2], ke1[kt][3]};
                S[kt] = __builtin_amdgcn_mfma_f32_16x16x32_bf16(ak, bv, S[kt], 0, 0, 0) * elv[kt]; }
#pragma unroll
            for (int tt = 0; tt < 2; ++tt)
#pragma unroll
                for (int r = 0; r < 4; ++r) *(LAS unsigned short*)(lds + OFF_OST + (16 * tt + 4 * q4 + r) * PQ + (16 * w + l15) * 2) = (unsigned short)(pk2(o2[tt][r], 0.f) & 0xffffu);
        }
    };
    for (int c = 0; c < nc; ++c) {
        if (c > 0) mstage(c - 1);
        LAS unsigned char* B = lds + (c & 1) * BUF;
        { const LAS f32x2* T = (const LAS f32x2*)(lds + OFF_TOT + (c & 1) * TOT_BYTES) + k2;
          f32x2 off = (f32x2){0.f, 0.f}, cm = (f32x2){0.f, 0.f}, last = (f32x2){0.f, 0.f};
#pragma unroll
          for (int sgm = 0; sgm < 8; ++sgm) { const f32x2 tv = T[sgm * 64]; if (sgm < w) off = off + tv; if (sgm < 4) cm = cm + tv; last = last + tv; }
#pragma unroll
          for (int i = 0; i < 4; ++i) { const f32x2 cu = off + cl[i]; const int t = 4 * w + i;
              *(LAS unsigned*)(B + OFF_QM + t * PQ + k2 * 4) = bfmul2(cq[i], __builtin_amdgcn_exp2f(cu.x - cm.x), __builtin_amdgcn_exp2f(cu.y - cm.y));
              *(LAS unsigned*)(B + OFF_KM + t * PQ + k2 * 4) = bfmul2(ck[i], __builtin_amdgcn_exp2f(cm.x - cu.x), __builtin_amdgcn_exp2f(cm.y - cu.y));
 }
          if (w == 0) { *(LAS f32x2*)(B + OFF_C2 + k2 * 8) = (f32x2){__builtin_amdgcn_exp2f(cm.x), __builtin_amdgcn_exp2f(cm.y)}; *(LAS f32x2*)(B + OFF_C3 + k2 * 8) = (f32x2){__builtin_amdgcn_exp2f(last.x - cm.x), __builtin_amdgcn_exp2f(last.y - cm.y)}; }
          *(LAS v4u*)(B + OFF_V + vt * PQ + v8 * 2) = cv; }
        { asm volatile("s_waitcnt vmcnt(5)" ::: "memory"); HG_P1(c + 1); LDS_WAIT(); asm volatile("" ::: "memory");
          const int cn = c + 3 < nc ? c + 3 : nc - 1; HG_DMA(cn); }
        LDS_WAIT(); __builtin_amdgcn_s_barrier(); asm volatile("" ::: "memory");
        if (c > 0) *(GAS v4u*)(OD + (size_t)HG_ROW(c - 1, vt) * 2048 + hc + v8) = *(const LAS v4u*)(lds + OFF_OST + vt * PQ + v8 * 2);
        if (w < 4) {
            const int tt = w >> 1, st = w & 1; f32x4 at = (f32x4){0.f, 0.f, 0.f, 0.f};
            if (!(tt == 0 && st == 1)) {
                bf16x8 af[4], bfr[4];
#pragma unroll
                for (int ks = 0; ks < 4; ++ks) { af[ks] = *(const LAS bf16x8*)(B + OFF_QM + (16 * tt + l15) * PQ + (32 * ks + 8 * q4) * 2); bfr[ks] = *(const LAS bf16x8*)(B + OFF_KM + (16 * st + l15) * PQ + (32 * ks + 8 * q4) * 2); }
                LDS_WAIT(); __builtin_amdgcn_sched_barrier(0);
#pragma unroll
                for (int ks = 0; ks < 4; ++ks) at = __builtin_amdgcn_mfma_f32_16x16x32_bf16(af[ks], bfr[ks], at, 0, 0, 0);
            }
            const int s_ = 16 * st + l15;
#pragma unroll
            for (int r = 0; r < 4; ++r) { const int t = 16 * tt + 4 * q4 + r; const float val = (s_ <= t) ? at[r] : 0.f;
                *(LAS unsigned short*)(B + OFF_ATT + t * PK + s_ * 2) = (unsigned short)(pk2(val, 0.f) & 0xffffu); }
        }
        LDS_WAIT(); __builtin_amdgcn_s_barrier(); asm volatile("" ::: "memory");
    }
    mstage(nc - 1);
    LDS_WAIT(); __builtin_amdgcn_s_barrier(); asm volatile("" ::: "memory");
    *(GAS v4u*)(OD + (size_t)HG_ROW(nc - 1, vt) * 2048 + hc + v8) = *(const LAS v4u*)(lds + OFF_OST + vt * PQ + v8 * 2);
    if (ch.Sout) {
#pragma unroll
        for (int kt = 0; kt < 8; ++kt)
#pragma unroll
            for (int r = 0; r < 4; ++r) __builtin_nontemporal_store(S[kt][r] * DBG_SCALE, (GAS float*)ch.Sout + (size_t)(16 * kt + 4 * q4 + r) * 128 + 16 * w + l15);
    }
    __builtin_amdgcn_s_barrier();
#undef HG_ROW
#undef HG_LOAD
#undef HG_P1
}
}

__device__ __forceinline__ void hg_scan_phase(const Args& a, LAS unsigned char* lds, int tid, int vcu, int G) {
    OPAQUE_V(tid); PH_PTRS; OPAQUE_S(vcu); OPAQUE_S(G);
    const bf16* HQ = (const bf16*)(ws + WS_S + S_HQ); const bf16* HK = (const bf16*)(ws + WS_S + S_HK); const float* HGp = (const float*)(ws + WS_U);
    const bf16* HV = (const bf16*)(ws + WS_S + S_HV); bf16* OF = (bf16*)(ws + WS_S + S_OF);
    const int NS = G > 128 ? 64 : 0;
    const int first = vcu < NS ? vcu : NS + (vcu - NS), step = vcu < NS ? 1088 : G - NS;
    const int reps = ((DBG_REP_MASK >> 16) & 1) && vcu < NS ? 3 : ((DBG_REP_MASK >> 17) & 1) && vcu >= NS ? 3 : 1;
    for (int rep_ = 0; rep_ < reps; ++rep_)
    for (int ci = first; ci < 1088; ci += step) {
        const bool lat = ci < 64; const int e = lat ? ci : ci - 64, b = e >> 5, d = (e >> 4) & 1, h = e & 15;
        const size_t so = ((size_t)((b * 2 + d) * 16 + h)) * 16384;
        hg::Chain ch{lat ? MP + b * 2048 : b * 256, lat ? 2048 : 256, d, h, lat ? a.in[I_SHG] + so : nullptr, lat ? nullptr : out + O_HG + so};
        hg::scan_chain(ch, HQ, HK + (size_t)d * MALL * DM, HGp + (size_t)d * MALL * DM, HV, OF + (size_t)d * MALL * DM, lds, tid);
    }
}

__device__ __forceinline__ void hg_thin_c(const Args& a, int lane, int gw, int NGW) {
    OPAQUE_V(lane); PH_PTRS; OPAQUE_S(gw); OPAQUE_S(NGW);
    const bf16* OF = (const bf16*)(ws + WS_S + S_OF); const bf16* HGS = (const bf16*)(ws + WS_S + S_HGS); bf16* AO = (bf16*)(ws + WS_S + S_AO);
    const int grp = lane >> 4, s = lane & 15;
    const f32x4 g0 = *(const GAS f32x4*)(a.in[I_GHO] + 8 * s), g1 = *(const GAS f32x4*)(a.in[I_GHO] + 8 * s + 4);
    for (int it = gw; it < MALL * 4; it += NGW) {
        const int row = it >> 2, h = (it & 3) * 4 + grp; const size_t o_ = (size_t)row * DM + h * 128 + 8 * s;
        const v4u of = __builtin_nontemporal_load((const GAS v4u*)(OF + o_)), ob = __builtin_nontemporal_load((const GAS v4u*)(OF + (size_t)MALL * DM + o_));
        const f32x4 a0 = (f32x4){bf_lo(of.x) + bf_lo(ob.x), bf_hi(of.x) + bf_hi(ob.x), bf_lo(of.y) + bf_lo(ob.y), bf_hi(of.y) + bf_hi(ob.y)}, a1 = (f32x4){bf_lo(of.z) + bf_lo(ob.z), bf_hi(of.z) + bf_hi(ob.z), bf_lo(of.w) + bf_lo(ob.w), bf_hi(of.w) + bf_hi(ob.w)};
        float ss = (a0.x * a0.x + a0.y * a0.y) + (a0.z * a0.z + a0.w * a0.w) + (a1.x * a1.x + a1.y * a1.y) + (a1.z * a1.z + a1.w * a1.w);
        const float rs = rsqrtf(sum16(ss) * (1.f / 128.f) + EPS);
        const v4u gw_ = __builtin_nontemporal_load((const GAS v4u*)(HGS + o_));
        const f32x4 y0 = a0 * rs * g0 * (f32x4){bf_lo(gw_.x), bf_hi(gw_.x), bf_lo(gw_.y), bf_hi(gw_.y)}, y1 = a1 * rs * g1 * (f32x4){bf_lo(gw_.z), bf_hi(gw_.z), bf_lo(gw_.w), bf_hi(gw_.w)};
        *(GAS v4u*)(AO + o_) = (v4u){pk2(y0.x, y0.y), pk2(y0.z, y0.w), pk2(y1.x, y1.y), pk2(y1.z, y1.w)};
    }
}
namespace pg8 {
struct EpiNat {
    static constexpr bool PERM = true;
    bf16_t* QKV; bf16_t* KN; float* outk; float* outv; const float* gk; PG8_LAS float* tab;
    __device__ __forceinline__ void operator()(const f32x4 (&acc)[2][2][4][2], const Unit& u, int wr, int wc, int fr, int fq) const {
        const int region = u.pn >> 3, row0 = u.pm * BM + wr * 64 + fr, ct = (u.pn & 7) * BM + wc * 32 + 8 * fq;
        if (region == 1) {
#pragma unroll
            for (int ai = 0; ai < 2; ++ai)
#pragma unroll
                for (int m = 0; m < 4; ++m)
#pragma unroll
                    for (int bj = 0; bj < 2; ++bj) { const f32x4 a = acc[ai][bj][m][0], b = acc[ai][bj][m][1];
                        float s = (a[0] * a[0] + a[1] * a[1]) + (a[2] * a[2] + a[3] * a[3]) + (b[0] * b[0] + b[1] * b[1]) + (b[2] * b[2] + b[3] * b[3]);
                        s += __shfl_xor(s, 16); s += __shfl_xor(s, 32);
                        if (fq == 0) tab[((ai * HALF + wr * 64 + m * 16 + fr) * 2 + bj) * 4 + wc] = s; }
            asm volatile("s_waitcnt lgkmcnt(0)" ::: "memory"); __builtin_amdgcn_s_barrier(); asm volatile("" ::: "memory");
            f32x4 g0[2], g1[2];
#pragma unroll
            for (int bj = 0; bj < 2; ++bj) { g0[bj] = *(const PG8_GAS f32x4*)(gk + wc * 32 + 8 * fq); g1[bj] = *(const PG8_GAS f32x4*)(gk + wc * 32 + 8 * fq + 4); }
#pragma unroll
            for (int ai = 0; ai < 2; ++ai)
#pragma unroll
                for (int m = 0; m < 4; ++m) { const int row = row0 + ai * HALF + m * 16;
#pragma unroll
                    for (int bj = 0; bj < 2; ++bj) { const f32x4 p = *(const PG8_LAS f32x4*)(tab + ((ai * HALF + wr * 64 + m * 16 + fr) * 2 + bj) * 4);
                        const float rs = rsqrtf(((p[0] + p[1]) + (p[2] + p[3])) * (1.f / 128.f) + 1e-6f);
                        const f32x4 k0 = acc[ai][bj][m][0] * rs * g0[bj], k1 = acc[ai][bj][m][1] * rs * g1[bj];
                        u32x4 w; w.x = cvt_pk_bf16(k0[0], k0[1]); w.y = cvt_pk_bf16(k0[2], k0[3]); w.z = cvt_pk_bf16(k1[0], k1[1]); w.w = cvt_pk_bf16(k1[2], k1[3]);
                        *(PG8_GAS u32x4*)(KN + (size_t)row * 2048 + ct + bj * HALF) = w;
                        if (row < 8192) { __builtin_nontemporal_store(k0 * DBG_SCALE, (PG8_GAS f32x4*)(outk + (size_t)row * 2048 + ct + bj * HALF)); __builtin_nontemporal_store(k1 * DBG_SCALE, (PG8_GAS f32x4*)(outk + (size_t)row * 2048 + ct + bj * HALF + 4)); } } }
        } else {
#pragma unroll
            for (int ai = 0; ai < 2; ++ai)
#pragma unroll
                for (int m = 0; m < 4; ++m) { const int row = row0 + ai * HALF + m * 16;
#pragma unroll
                    for (int bj = 0; bj < 2; ++bj) { const f32x4 v0 = acc[ai][bj][m][0], v1 = acc[ai][bj][m][1];
                        u32x4 w; w.x = cvt_pk_bf16(v0[0], v0[1]); w.y = cvt_pk_bf16(v0[2], v0[3]); w.z = cvt_pk_bf16(v1[0], v1[1]); w.w = cvt_pk_bf16(v1[2], v1[3]);
                        *(PG8_GAS u32x4*)(QKV + (size_t)row * 6144 + region * 2048 + ct + bj * HALF) = w;
                        if (region == 2 && row < 8192) { __builtin_nontemporal_store(v0 * DBG_SCALE, (PG8_GAS f32x4*)(outv + (size_t)row * 2048 + ct + bj * HALF)); __builtin_nontemporal_store(v1 * DBG_SCALE, (PG8_GAS f32x4*)(outv + (size_t)row * 2048 + ct + bj * HALF + 4)); } } }
        }
    }
};
}
__device__ __forceinline__ void nat_cache_rows(const Args& a, int lane, int gw, int NGW) {
    OPAQUE_V(lane); PH_PTRS; OPAQUE_S(gw); OPAQUE_S(NGW);
    bf16* QKV = (bf16*)(ws + WS_S + S_NQKV); bf16* KN = (bf16*)(ws + WS_S + S_NKN);
    for (int it = gw; it < 512 * 4; it += NGW) {
        const int row = MALL + (it >> 2), c = (it & 3) * 512 + 8 * lane; const size_t so = (size_t)(row - MALL) * DM + c;
        const f32x4 k0 = *(const GAS f32x4*)(a.in[I_CNK] + so), k1 = *(const GAS f32x4*)(a.in[I_CNK] + so + 4), v0 = *(const GAS f32x4*)(a.in[I_CNV] + so), v1 = *(const GAS f32x4*)(a.in[I_CNV] + so + 4);
        *(GAS v4u*)(KN + (size_t)row * DM + c) = (v4u){pk2(k0.x, k0.y), pk2(k0.z, k0.w), pk2(k1.x, k1.y), pk2(k1.z, k1.w)};
        *(GAS v4u*)(QKV + (size_t)row * 6144 + 4096 + c) = (v4u){pk2(v0.x, v0.y), pk2(v0.z, v0.w), pk2(v1.x, v1.y), pk2(v1.z, v1.w)};
    }
}
__device__ __forceinline__ void nat_attn_phase(const Args& a, LAS unsigned char* lds, int tid, int vcu, int G) {
    OPAQUE_V(tid); PH_PTRS; OPAQUE_S(vcu); OPAQUE_S(G);
    const bf16* QKV = (const bf16*)(ws + WS_S + S_NQKV); const bf16* KN = (const bf16*)(ws + WS_S + S_NKN); bf16* AO = (bf16*)(ws + WS_S + S_AO); const float* gq = a.in[I_GNQ];
    LAS float* rpb = (LAS float*)(lds + att::RPB_OFF);
    for (int u = vcu; u < 768; u += G) {
        if (u < 256) {
            const int b = u >> 7, h = (u >> 3) & 15, i = u & 7, q0 = MP + b * 2048 + i * 256;
            const int rlo = min(max(4 * i - 4, 0), 24), rhi = min(max(4 * i - 1, 0), 24) + 8, nrows = rhi - rlo;
            __syncthreads();
            for (int e = tid; e < 465; e += NTHR) rpb[e] = a.in[I_RPB][h * 465 + e] * 11.313708498984761f;
            __syncthreads();
            const att::KvSrc src{MALL + b * 256, 4, MP + b * 2048 + 64 * rlo, nrows};
            const att::NatMask nm{rlo, 4 * i + ((tid >> 6) >> 1), 32 * ((tid >> 6) & 1) + (tid & 31), rpb};
            att::attn_unit<128, 1, 6144, DM, 6144, DM, 1>(QKV + (size_t)q0 * 6144 + h * 128, KN + h * 128, QKV + 4096 + h * 128, AO + (size_t)q0 * DM + h * 128, src, 4 + nrows, nm, (LAS char*)lds, tid, gq, nullptr);
        } else {
            const int v = u - 256, b = v >> 4, h = v & 15, q0 = b * 256;
            const att::KvSrc src{b * 256, 4, 0, 1};
            att::attn_unit<128, 0, 6144, DM, 6144, DM, 1>(QKV + (size_t)q0 * 6144 + h * 128, KN + h * 128, QKV + 4096 + h * 128, AO + (size_t)q0 * DM + h * 128, src, 4, att::NatMask{0, 0, 0, nullptr}, (LAS char*)lds, tid, gq, nullptr);
        }
    }
}
constexpr int NPHASE = 2 + 10 * DEPTH;
__host__ __device__ constexpr bool phase_exists(int ph) {
    if (ph == 0 || ph == NPHASE - 1) return true;
    const int l = (ph - 1) / 10, k = (ph - 1) % 10, kind = l % 3;
    if (k == 2) return kind != 2;
    if (k == 3) return kind == 0;
    if (k == 4) return kind == 1;
    if (k == 5) return kind != 1;
    return true;
}

__global__ void __launch_bounds__(NTHR, 2) fwd(Args a) {
    extern __shared__ __attribute__((aligned(16))) unsigned char lds_[];
    LAS unsigned char* lds = (LAS unsigned char*)lds_;
#define tid ({ int t_ = threadIdx.x; asm volatile("" : "+v"(t_)); t_; })
#define lane (tid & 63)
#define wave (__builtin_amdgcn_readfirstlane(tid >> 6))
    const int G = gridDim.x, bx = blockIdx.x, vcu = (G % 8 == 0) ? (bx % 8) * (G / 8) + bx / 8 : bx;
    const int NGW = G * NWAVES;
#define gw (vcu * NWAVES + wave)
    volatile LAS unsigned* MISC = (volatile LAS unsigned*)(lds + MISC_OFF);
    unsigned* ctl = (unsigned*)(a.ws + WS_CTL);
    for (int u = tid; u < (LDS_BYTES - LDSCTL_OFF) / 4; u += NTHR) ((LAS unsigned*)(lds + LDSCTL_OFF))[u] = 0u;
    __syncthreads();
    XcdBarrier bar; bar.bar = ctl + CW_BAR; bar.x = 0; bar.st = nullptr;
    if (MK_SINGLE) bar = xcd_barrier_post(ctl + CW_BAR, MISC + 8);
    const int lo = a.ph_lo, hi = a.ph_hi;
#define IN(k) (lo <= (k) && (k) < hi)
#ifndef DBG_REP_MASK
#define DBG_REP_MASK 0
#endif
#define REPEAT(id) for (int rep_ = 0; rep_ < (((DBG_REP_MASK >> (id)) & 1) ? 3 : 1); ++rep_)
#if defined(DBG_PROF)
    { unsigned long long* prof = (unsigned long long*)((unsigned char*)ctl + WS_PROF); float* po_ = a.out;
      if (bx == 0 && tid == 0) { prof[200] = (unsigned long long)*(volatile unsigned*)(po_ + O_END - 1); prof[100] = wall_clock64(); prof[300] = clock64(); } }
#define SEAM(k) do { if (MK_SINGLE && (k) + 1 < hi) xcd_barrier(bar); if (bx == 0 && tid == 0) { unsigned long long* prof = (unsigned long long*)((unsigned char*)bar.bar - CW_BAR * 4 + WS_PROF); prof[100 + (k) + 1] = wall_clock64(); prof[300 + (k) + 1] = clock64(); } } while (0)
#else
#define SEAM(k) do { if (MK_SINGLE && (k) + 1 < hi) xcd_barrier(bar); } while (0)
#endif
#define GEMM_PTRS PH_PTRS; int gG = G, gbx = bx; OPAQUE_S(gG); OPAQUE_S(gbx); bf16* const H = (bf16*)(ws + WS_H); bf16* const U = (bf16*)(ws + WS_U); bf16* const AO = (bf16*)(ws + WS_S + S_AO); bf16* const X = (bf16*)(ws + WS_S + S_X); \
    const float* const MODS = (const float*)(ws + WS_MODS); (void)H; (void)U; (void)AO; (void)X; (void)MODS

#define CONVERT_WINDOW(lo_, hi_, nunits) do { const int from_ = (nunits) % gG; if (!from_ || gbx >= from_) p0_convert_range(a, lds, lo_, hi_, (gbx - from_) * NWAVES + wave, (gG - from_) * NWAVES, lane, wave); } while (0)

    if (IN(0)) { REPEAT(0) { p0_prologue(a, lds, tid, lane, wave, vcu, G); rope_table(a, tid, vcu, G); if (DBG_REP_MASK & 1) __syncthreads(); } SEAM(0); }

    for (int l = 0; l < DEPTH; ++l) {
        const int kind = l % 3, j = l / 3, pb = 1 + 10 * l;
        if (IN(pb + 0)) { REPEAT(1) norm_phase(a, l, false, l > 0 ? (const float*)(a.ws + WS_MODS) + (size_t)(l - 1) * 3 * NMOD + 5 * DM : nullptr, lane, gw, NGW); if (kind == 2) nat_cache_rows(a, lane, gw, NGW); SEAM(pb + 0); }
        if (kind == 0) {
            if (IN(pb + 1)) {
                GEMM_PTRS; unsigned char* wm = ws + WS_WMLA + (size_t)j * WMLA_STRIDE;
                pg8::Gemm g{H, (const bf16*)wm, MALL, 1536, DM, DM, DM, 1}; pg8::QaOrder S; S.init(gG, gbx, g.K);
                pg8::EpiBf16<0> E{(bf16*)(ws + WS_S + S_QAKV), 1536};
                REPEAT(2) pg8::gemm_phase<pg8::EpiBf16<0>, pg8::QaOrder>(lds, g, S, E);
                CONVERT_WINDOW(a.wstart[l + 1], a.wmid[l + 1], 288);
                SEAM(pb + 1);
            }
            if (IN(pb + 2)) { REPEAT(3) mla_thin_a(a, j, lane, gw, NGW); SEAM(pb + 2); }
            if (IN(pb + 3)) {
                GEMM_PTRS; unsigned char* wm = ws + WS_WMLA + (size_t)j * WMLA_STRIDE;
                REPEAT(4) {
                { pg8::Gemm g{(const bf16*)(ws + WS_S + S_QAN), (const bf16*)(wm + WMLA_QB), MALL, 3072, 768, 768, 768, 1}; pg8::StaticOrder S; S.init(MALL, 3072, 1, gG, gbx, g.K);
                  pg8::EpiBf16<0> E{(bf16*)(ws + WS_S + S_QRAW), 3072};
                  pg8::gemm_phase<pg8::EpiBf16<0>, pg8::StaticOrder>(lds, g, S, E); }
                { pg8::Gemm g{(const bf16*)(ws + WS_S + S_CKVN), (const bf16*)(wm + WMLA_KVB), MKV, 4096, 512, 512, 512, 1}; pg8::StaticOrder S; S.init(MKV, 4096, 1, gG, (gbx + gG / 2) % gG, g.K);
                  pg8::EpiKV E{(bf16*)(ws + WS_S + S_KVRAW), (bf16*)(ws + WS_S + S_KF), a.in[I_GKN] + (size_t)j * 192, (const float*)(ws + WS_S + S_KPE), (const float*)(ws + WS_SSK), (const float*)(ws + WS_ROPE), (LAS float*)(lds + EPI_TAB_OFF)};
                  pg8::gemm_phase<pg8::EpiKV, pg8::StaticOrder>(lds, g, S, E); }
                }
                {
                    int p_ = gbx, np_ = gG;
                    if (gG == 256) { p_ = gbx < 64 ? -1 : gbx < 128 ? gbx - 64 : gbx < 160 ? -1 : gbx - 96; np_ = 160; }
                    if (p_ >= 0) p0_convert_range(a, lds, a.wmid[l + 1], a.wstart[l + 2], p_ * NWAVES + wave, np_ * NWAVES, lane, wave);
                }
                SEAM(pb + 3);
            }
            if (IN(pb + 5)) { REPEAT(6) mla_attn_phase(a, j, lds, tid, vcu, G); SEAM(pb + 5); }
        }
        if (kind == 1) {
            if (IN(pb + 1)) {
                GEMM_PTRS;
                pg8::Gemm g{H, (const bf16*)(ws + WS_WHG), MALL, 10240, DM, DM, DM, 1}; pg8::StaticOrder S; S.init(MALL, 10240, 1, gG, gbx, g.K);
                pg8::EpiHg E{ws};
                REPEAT(8) pg8::gemm_phase<pg8::EpiHg, pg8::StaticOrder, false>(lds, g, S, E);
                CONVERT_WINDOW(a.wstart[l + 1], a.wstart[l + 2], 1920);
                SEAM(pb + 1);
            }
            if (IN(pb + 2)) { REPEAT(9) hg_scan_phase(a, lds, tid, vcu, G); SEAM(pb + 2); }
            if (IN(pb + 4)) { REPEAT(10) hg_thin_c(a, lane, gw, NGW); SEAM(pb + 4); }
        }
        if (kind == 2) {
            if (IN(pb + 1)) {
                GEMM_PTRS;
                pg8::Gemm g{H, (const bf16*)(ws + WS_WNAT), MALL, 6144, DM, DM, DM, 1}; pg8::StaticOrder S; S.init(MALL, 6144, 1, gG, gbx, g.K);
                pg8::EpiNat E{(bf16*)(ws + WS_S + S_NQKV), (bf16*)(ws + WS_S + S_NKN), out + O_NK, out + O_NV, a.in[I_GNK], (LAS float*)(lds + EPI_TAB_OFF)};
                REPEAT(11) pg8::gemm_phase<pg8::EpiNat, pg8::StaticOrder>(lds, g, S, E);
                CONVERT_WINDOW(a.wstart[l + 1], a.wstart[l + 2], 1152);
                SEAM(pb + 1);
            }
            if (IN(pb + 5)) { REPEAT(13) nat_attn_phase(a, lds, tid, vcu, G); SEAM(pb + 5); }
        }
        if (IN(pb + 6)) {
            GEMM_PTRS;
            const bf16* wo = (const bf16*)(kind == 0 ? ws + WS_WMLA + (size_t)j * WMLA_STRIDE + WMLA_WO : kind == 1 ? ws + WS_WHG + WHG_WO : ws + WS_WNAT + WNAT_WO);
            pg8::Gemm g{AO, wo, MALL, DM, DM / 2, DM, DM, 2}; pg8::ResOrder S; S.init(gG, gbx, DM);
            pg8::EpiRes2 E{X, MODS + (size_t)l * 3 * NMOD + 2 * DM, (bf16*)(ws + WS_S + S_PART), nullptr};
            pg8::gemm_phase<pg8::EpiRes2, pg8::ResOrder>(lds, g, S, E);
            SEAM(pb + 6);
        }
        if (IN(pb + 7)) { REPEAT(1) norm_phase(a, l, true, (const float*)(a.ws + WS_MODS) + (size_t)l * 3 * NMOD + 2 * DM, lane, gw, NGW); SEAM(pb + 7); }
        if (IN(pb + 8)) {
            GEMM_PTRS;
            pg8::Gemm g{H, (const bf16*)(ws + WS_WFF1) + (size_t)l * DM * FF, MALL, FF, DM, DM, DM, 1}; pg8::StaticOrder S; S.init(MALL, FF, 1, gG, gbx, g.K);
            pg8::EpiBf16<1> E{U, FF};
            REPEAT(7) pg8::gemm_phase<pg8::EpiBf16<1>, pg8::StaticOrder>(lds, g, S, E);
            SEAM(pb + 8);
        }
        if (IN(pb + 9)) {
            GEMM_PTRS;
            pg8::Gemm g{U, (const bf16*)(ws + WS_WFF2) + (size_t)l * DM * FF, MALL, DM, FF / 2, FF, FF, 2}; pg8::ResOrder S; S.init(gG, gbx, FF);
            pg8::EpiRes2 E{X, MODS + (size_t)l * 3 * NMOD + 5 * DM, (bf16*)(ws + WS_S + S_PART), l + 1 == DEPTH ? out + O_X : nullptr};
            pg8::gemm_phase<pg8::EpiRes2, pg8::ResOrder>(lds, g, S, E);
            SEAM(pb + 9);
        }
    }
    if (IN(NPHASE - 1)) final_fix_phase(a, (const float*)(a.ws + WS_MODS) + (size_t)(DEPTH - 1) * 3 * NMOD + 5 * DM, lane, gw, NGW);
#if defined(DBG_PROF)
    xcd_barrier(bar);
    { unsigned long long* prof = (unsigned long long*)((unsigned char*)bar.bar - CW_BAR * 4 + WS_PROF); float* po_ = a.out;
    if (bx == 0) {
        if (tid == 0) { prof[100 + NPHASE] = wall_clock64(); prof[300 + NPHASE] = clock64(); }
        __syncthreads();
        if (tid == 0) { constexpr int p = DBG_PROF; const unsigned long long dw = prof[100 + p + 1] - prof[100 + p], dc = prof[300 + p + 1] - prof[300 + p];
            float mant = (float)dw * 1e-4f; mant = mant < 1.f ? 1.f : mant > 9.9f ? 9.9f : mant; const int expo = dw ? (int)(dc / dw) : 0;
            po_[O_X + 7] = mant * __builtin_powif(10.f, expo); }
    } }
#endif
#undef IN
#undef SEAM
#undef tid
#undef lane
#undef wave
#undef gw
}

extern "C" void kernel_launch(void* const* d_in, const int* in_sizes, int n_in, void* d_out, int out_size, void* d_ws, size_t ws_size, hipStream_t stream) {
    static int grid = 0;
    if (grid == 0) {
        if (n_in != N_IN || (size_t)out_size != O_END || ws_size < WS_END) { fprintf(stderr, "kernel_launch: shape mismatch n_in %d out %d ws %zu (need %zu); nothing launched\n", n_in, out_size, ws_size, (size_t)WS_END); grid = -1; return; }
        int dev = 0, cus = 0, per_cu = 0;
        if (hipGetDevice(&dev) != hipSuccess || hipDeviceGetAttribute(&cus, hipDeviceAttributeMultiprocessorCount, dev) != hipSuccess) { fprintf(stderr, "kernel_launch: device query failed\n"); grid = -1; return; }
        if (hipFuncSetAttribute((const void*)fwd, hipFuncAttributeMaxDynamicSharedMemorySize, LDS_BYTES) != hipSuccess) { fprintf(stderr, "kernel_launch: hipFuncSetAttribute failed\n"); grid = -1; return; }
        if (hipOccupancyMaxActiveBlocksPerMultiprocessor(&per_cu, (const void*)fwd, NTHR, LDS_BYTES) != hipSuccess || per_cu < 1) { fprintf(stderr, "kernel_launch: occupancy query says %d blocks/CU\n", per_cu); }
        (void)hipGetLastError();
        grid = cus;
    }
    if (grid < 0) return;
    if (hipMemsetAsync((char*)d_ws + WS_CTL, 0, CTL_ZERO_BYTES, stream) != hipSuccess) { fprintf(stderr, "kernel_launch: memset failed\n"); return; }
    Args a{};
    for (int i = 0; i < N_IN; ++i) a.in[i] = (const float*)d_in[i];
    a.out = (float*)d_out; a.ws = (unsigned char*)d_ws;
    int nt = 0, items = 0;
    auto add = [&](const float* src, size_t dst_off, int K, int N, int row_off) { TJob& t = a.tj[nt++]; t.src = src; t.dst = (bf16*)((unsigned char*)d_ws + dst_off); t.K = K; t.N = N; t.row_off = row_off; t.start = items; items += (K / 64) * (N / 32); };
    auto add_mla_a = [&](int j) { const size_t wb = WS_WMLA + (size_t)j * WMLA_STRIDE;
        add(a.in[I_WQA] + (size_t)j * DM * 768, wb, DM, 768, 0); add(a.in[I_WKVA] + (size_t)j * DM * 576, wb, DM, 576, 768); };
    auto add_mla_b = [&](int j) { const size_t wb = WS_WMLA + (size_t)j * WMLA_STRIDE;
        add(a.in[I_WQB] + (size_t)j * 768 * 3072, wb + WMLA_QB, 768, 3072, 0); add(a.in[I_WKVB] + (size_t)j * 512 * 4096, wb + WMLA_KVB, 512, 4096, 0);
        add(a.in[I_WMO] + (size_t)j * DM * DM, wb + WMLA_WO, DM, DM, 0); };
    auto add_mixer = [&](int l) {
        if (l % 3 == 0) { add_mla_a(l / 3); add_mla_b(l / 3); }
        if (l % 3 == 1) { add(a.in[I_WHQ], WS_WHG, DM, DM, 0); add(a.in[I_WHF], WS_WHG, DM, DM, 2048); add(a.in[I_WHF] + (size_t)DM * DM, WS_WHG, DM, DM, 4096);
            add(a.in[I_WHI], WS_WHG, DM, DM, 6144); add(a.in[I_WHG], WS_WHG, DM, DM, 8192); add(a.in[I_WHO], WS_WHG + WHG_WO, DM, DM, 0); }
        if (l % 3 == 2) { add(a.in[I_WNQKV], WS_WNAT, DM, 3 * DM, 0); add(a.in[I_WNO], WS_WNAT + WNAT_WO, DM, DM, 0); } };
    a.wstart[0] = 0; add_mla_a(0);
    for (int l = 0; l < DEPTH; ++l) {
        a.wstart[l + 1] = items;
        if (l % 3 == 0) add_mla_b(l / 3);
        add(a.in[I_WFF1] + (size_t)l * DM * FF, WS_WFF1 + (size_t)l * DM * FF * 2, DM, FF, 0); add(a.in[I_WFF2] + (size_t)l * DM * FF, WS_WFF2 + (size_t)l * DM * FF * 2, FF, DM, 0);
        if (l + 1 < DEPTH) { if ((l + 1) % 3 == 0) add_mla_a((l + 1) / 3); else add_mixer(l + 1); }
    }
    for (int w = DEPTH + 1; w < 8; ++w) a.wstart[w] = items;
    for (int w = 0; w < 8; ++w) a.wmid[w] = a.wstart[w];
    for (int l = 0; l < DEPTH; ++l) if (l % 3 == 0) {
        const int from = 288 % grid, part = (from ? grid - from : grid) * NWAVES; long n = (long)WQA * part; const long tot = a.wstart[l + 2] - a.wstart[l + 1]; if (n > tot) n = tot;
        a.wmid[l + 1] = a.wstart[l + 1] + (int)n; }
    a.ntj = nt; a.nitems = items;
#if MK_SINGLE
    a.ph_lo = 0; a.ph_hi = NPHASE < MK_LAST_PHASE ? NPHASE : MK_LAST_PHASE;
    hipLaunchKernelGGL(fwd, dim3(grid), dim3(NTHR), LDS_BYTES, stream, a);
#else
    for (int ph = 0; ph < NPHASE && ph < MK_LAST_PHASE; ++ph) {
        if (!phase_exists(ph)) continue;
        a.ph_lo = ph; a.ph_hi = ph + 1;
        hipLaunchKernelGGL(fwd, dim3(grid), dim3(NTHR), LDS_BYTES, stream, a);
    }
#endif
    const hipError_t le = hipPeekAtLastError();
    if (le != hipSuccess) fprintf(stderr, "kernel_launch: launch failed: %s\n", hipGetErrorName(le));
}
```

```cpp
#define MK_SINGLE 1
#define MK_LAST_PHASE 1000
#include <hip/hip_runtime.h>
#include <cstdio>
#include <cstdint>

#ifndef MK_SINGLE
#define MK_SINGLE 1
#endif
#ifndef WQA
#define WQA 16
#endif
#ifndef MK_LAST_PHASE
#define MK_LAST_PHASE 1000
#endif
namespace pg8 {
#define PG8_LAS __attribute__((address_space(3)))
#define PG8_GAS __attribute__((address_space(1)))
typedef unsigned short bf16_t;
typedef short bf16x8 __attribute__((ext_vector_type(8)));
typedef float f32x4 __attribute__((ext_vector_type(4)));
typedef unsigned u32x4 __attribute__((ext_vector_type(4)));
constexpr int BM = 256, BK = 64, HALF = 128, HTB = HALF * BK * 2  , STAGE_BYTES = 8 * HTB, NXCD = 8, WGM = 8;

__host__ __device__ __forceinline__ int lds_byte(int r, int c) { const int st = (r >> 4) * 2 + (c >> 5), rr = r & 15, cc = c & 31, ob = rr * 64 + cc * 2; return st * 1024 + (ob ^ (((ob >> 9) & 1) << 5)); }
__host__ __device__ __forceinline__ void stage_rc(int b, int& R, int& C) { const int st = b / 1024, sb = b % 1024, swz = sb ^ (((sb >> 9) & 1) << 5); R = (st >> 1) * 16 + swz / 64; C = (st & 1) * 32 + (swz % 64) / 2; }
__host__ __device__ __forceinline__ int perm32(int rho) { const int n = rho >> 4, i = rho & 15; return 8 * (i >> 2) + 4 * n + (i & 3); }

struct Unit { int pm, pn, ks, nkt, part, nh; };
struct Gemm { const bf16_t* A; const bf16_t* Bt; int M, N, K, lda, ldb, nsplit; };

struct StaticOrder {
    static constexpr bool HAS_NH = false;
    int nM, nN, nNv, nwg, G, c, nkt, split;
    __host__ __device__ void init(int M, int N, int nsplit, int G_, int c_, int K = 0) { nM = M / BM; nN = N / BM; nNv = nN * nsplit; nwg = nM * nNv; G = G_; c = c_; nkt = K / BK; split = nsplit; }
    __host__ __device__ bool next(int i, Unit& u) const {
        const long L = (long)i * G + c; if (L >= nwg) return false;
        int wgid = (int)L; { const int q = nwg / NXCD, r = nwg % NXCD, xcd = wgid % NXCD, off = wgid / NXCD; wgid = (xcd < r ? xcd * (q + 1) : r * (q + 1) + (xcd - r) * q) + off; }
        const int nig = WGM * nNv, gid = wgid / nig, fm = gid * WGM, gsz = (nM - fm) < WGM ? (nM - fm) : WGM;
        u.pm = fm + ((wgid % nig) % gsz); const int pv = (wgid % nig) / gsz; u.pn = pv % nN; u.ks = pv / nN; u.nkt = nkt; u.part = split > 1 ? u.ks : -1; u.nh = 0; return true;
    }
    __device__ __forceinline__ void a_ready(const Unit&) const {}
    __device__ __forceinline__ void done(const Unit&) const {}
};

struct QaOrder {
    static constexpr bool HAS_NH = true;
    StaticOrder M5; int G, c, nkt;
    __host__ __device__ void init(int G_, int c_, int K) { M5.init(12288, 1280, 1, G_, c_, K); G = G_; c = c_; nkt = K / BK; }
    __host__ __device__ bool next(int i, Unit& u) const {
        const int L = i * G + c;
        if (L < 240) return M5.next(i, u);
        if (L >= 288) return false;
        u.pm = L - 240; u.pn = 5; u.ks = 0; u.nkt = nkt; u.part = -1; u.nh = 1; return true;
    }
    __device__ __forceinline__ void a_ready(const Unit&) const {}
    __device__ __forceinline__ void done(const Unit&) const {}
};
struct ResOrder {
    static constexpr bool HAS_NH = false;
    int G, c, nkF, nkH;
    __host__ __device__ void init(int G_, int c_, int K) { G = G_; c = c_; nkF = K / BK; nkH = K / (2 * BK); }
    __host__ __device__ bool next(int i, Unit& u) const {
        const int L = i * G + c; if (L >= 512) return false;
        const bool half = L >= 256; int w = half ? L - 256 : L;
        w = (w & 7) * 32 + (w >> 3);
        const int sh = half ? 7 : 6, e = w & ((1 << sh) - 1), pv = e >> 3;
        u.pm = (half ? 32 : 0) + ((w >> sh) << 3) + (e & 7); u.pn = pv & 7; u.ks = pv >> 3; u.nkt = half ? nkH : nkF; u.part = half ? u.ks : -1; u.nh = 0; return true;
    }
    __device__ __forceinline__ void a_ready(const Unit&) const {}
    __device__ __forceinline__ void done(const Unit&) const {}
};

__device__ __forceinline__ unsigned cvt_pk_bf16(float lo, float hi) { unsigned r; asm("v_cvt_pk_bf16_f32 %0, %1, %2" : "=v"(r) : "v"(lo), "v"(hi)); return r; }


template <class Epi, class Sched, bool ALIGN_EPI = true, bool SP2 = true>
__device__ __forceinline__ void gemm_phase(PG8_LAS unsigned char* lds, const Gemm g, const Sched& S, const Epi& E) {
    int tid_ = threadIdx.x; asm volatile("" : "+v"(tid_));
    const int tid = tid_, wid = __builtin_amdgcn_readfirstlane(tid >> 6), lane = tid & 63, wr = wid >> 2, wc = wid & 3, fr = lane & 15, fq = lane >> 4;
    const int K = g.K;
    unsigned voffA[2], voffB[2];
#pragma unroll
    for (int i = 0; i < 2; ++i) { int R, C; stage_rc(tid * 16 + i * 8192, R, C); const int Rb = Epi::PERM ? ((R & ~31) + perm32(R & 31)) : R;
        voffA[i] = (unsigned)(R * g.lda + C) * 2u; voffB[i] = (unsigned)(Rb * g.ldb + C) * 2u; }
    const size_t kstep = (size_t)(BK * 2);
    const size_t hstepA = (size_t)HALF * g.lda * 2, hstepB = (size_t)HALF * g.ldb * 2;
    const size_t tstepA = 2 * hstepA, tstepB = 2 * hstepB;
    const size_t sstep = (size_t)K * 2;
    const unsigned ldsw = (unsigned)wid * 1024u;
    const int aoff = lds_byte(wr * 64 + fr, fq * 8), boff = lds_byte(wc * 32 + fr, fq * 8);
#define PG8_SA(b, h) (((b) * 2 + (h)) * HTB)
#define PG8_SB(b, h) ((4 + (b) * 2 + (h)) * HTB)
#define PG8_STAGE(bufoff, gbase, voff) do { _Pragma("unroll") for (int _i = 0; _i < 2; ++_i) \
        __builtin_amdgcn_global_load_lds((const unsigned*)((const char*)(gbase) + (voff)[_i]), (PG8_LAS unsigned*)(lds + (bufoff) + ldsw + _i * 8192), 16, 0, 0); } while (0)
#define PG8_LDA(dst, b, h) do { _Pragma("unroll") for (int m = 0; m < 4; ++m) _Pragma("unroll") for (int k = 0; k < 2; ++k) dst[m][k] = *(const PG8_LAS bf16x8*)(lds + PG8_SA(b, h) + aoff + m * 2048 + k * 1024); } while (0)
#define PG8_LDB(dst, b, h) do { _Pragma("unroll") for (int n = 0; n < 2; ++n) _Pragma("unroll") for (int k = 0; k < 2; ++k) dst[n][k] = *(const PG8_LAS bf16x8*)(lds + PG8_SB(b, h) + boff + n * 2048 + k * 1024); } while (0)
#define PG8_MMA(ai, bj, At, Bt) do { __builtin_amdgcn_s_setprio(1); _Pragma("unroll") for (int m = 0; m < 4; ++m) _Pragma("unroll") for (int n = 0; n < 2; ++n) _Pragma("unroll") for (int k = 0; k < 2; ++k) \
        acc[ai][bj][m][n] = __builtin_amdgcn_mfma_f32_16x16x32_bf16(Bt[n][k], At[m][k], acc[ai][bj][m][n], 0, 0, 0); __builtin_amdgcn_s_setprio(0); } while (0)
#define PG8_WAIT_V(n) asm volatile("s_waitcnt vmcnt(" #n ")" ::: "memory")
#define PG8_WAIT_L(n) asm volatile("s_waitcnt lgkmcnt(" #n ")" ::: "memory")
#define PG8_BAR __builtin_amdgcn_s_barrier()
#define PG8_SCHED __builtin_amdgcn_sched_barrier(0)
    Unit cur, nxt; int ui = 0;
    if (!S.next(0, cur)) return;
    f32x4 acc[2][2][4][2];
#pragma unroll
    for (int a = 0; a < 2; ++a)
#pragma unroll
        for (int b = 0; b < 2; ++b)
#pragma unroll
            for (int m = 0; m < 4; ++m)
#pragma unroll
                for (int n = 0; n < 2; ++n) acc[a][b][m][n] = (f32x4){0.f, 0.f, 0.f, 0.f};
    bf16x8 At[4][2], B0[2][2], B1[2][2];
    const char* cA = (const char*)g.A + (size_t)cur.pm * tstepA + (size_t)cur.ks * sstep; const char* cB = (const char*)g.Bt + (size_t)cur.pn * tstepB + (size_t)cur.ks * sstep;
    S.a_ready(cur);
    if constexpr (SP2) {
        PG8_STAGE(PG8_SB(0, 0), cB, voffB); PG8_STAGE(PG8_SB(0, 1), cB + hstepB, voffB); PG8_STAGE(PG8_SA(0, 0), cA, voffA); PG8_STAGE(PG8_SA(0, 1), cA + hstepA, voffA);
        if (wr == 1) PG8_BAR;
        PG8_WAIT_V(2); PG8_BAR;
        PG8_STAGE(PG8_SB(1, 0), cB + kstep, voffB); PG8_STAGE(PG8_SA(1, 0), cA + kstep, voffA); PG8_STAGE(PG8_SB(1, 1), cB + hstepB + kstep, voffB);
        PG8_WAIT_V(6); PG8_BAR;
    } else {
        PG8_STAGE(PG8_SB(0, 0), cB, voffB); PG8_STAGE(PG8_SA(0, 0), cA, voffA); PG8_STAGE(PG8_SB(0, 1), cB + hstepB, voffB); PG8_STAGE(PG8_SA(0, 1), cA + hstepA, voffA);
        if (wr == 1) PG8_BAR;
        PG8_WAIT_V(4); PG8_BAR;
        PG8_STAGE(PG8_SB(1, 0), cB + kstep, voffB); PG8_STAGE(PG8_SA(1, 0), cA + kstep, voffA); PG8_STAGE(PG8_SB(1, 1), cB + hstepB + kstep, voffB);
        PG8_WAIT_V(6); PG8_BAR;
    }
    for (;;) {
        const bool has_next = S.next(ui + 1, nxt);
        const char* nA = has_next ? (const char*)g.A + (size_t)nxt.pm * tstepA + (size_t)nxt.ks * sstep : cA; const char* nB = has_next ? (const char*)g.Bt + (size_t)nxt.pn * tstepB + (size_t)nxt.ks * sstep : cB;
        const int nt = cur.nkt; const bool nh = cur.nh != 0;
        for (int t = 0; t < nt; t += 2) {
            const bool last = (t == nt - 2);
            const char* a1 = cA + (size_t)(t + 1) * kstep;
            const char* a2 = last ? nA : cA + (size_t)(t + 2) * kstep; const char* b2 = last ? nB : cB + (size_t)(t + 2) * kstep;
            const char* a3 = a2 + kstep; const char* b3 = b2 + kstep;
            if (last && has_next) S.a_ready(nxt);
            if constexpr (SP2) {
            PG8_LDB(B0, 0, 0); PG8_LDB(B1, 0, 1); PG8_SCHED; PG8_LDA(At, 0, 0); PG8_STAGE(PG8_SA(1, 1), a1 + hstepA, voffA);
            PG8_WAIT_V(8); PG8_WAIT_L(0); PG8_BAR; PG8_MMA(0, 0, At, B0); if (!Sched::HAS_NH || !nh) PG8_MMA(0, 1, At, B1); PG8_BAR; PG8_SCHED;
            PG8_LDA(At, 0, 1); PG8_STAGE(PG8_SB(0, 0), b2, voffB); PG8_STAGE(PG8_SB(0, 1), b2 + hstepB, voffB); PG8_STAGE(PG8_SA(0, 0), a2, voffA);
            PG8_WAIT_V(8); PG8_WAIT_L(0); PG8_BAR; PG8_MMA(1, 0, At, B0); if (!Sched::HAS_NH || !nh) PG8_MMA(1, 1, At, B1); PG8_BAR; PG8_SCHED;
            PG8_LDB(B0, 1, 0); PG8_LDB(B1, 1, 1); PG8_SCHED; PG8_LDA(At, 1, 0); PG8_STAGE(PG8_SA(0, 1), a2 + hstepA, voffA);
            PG8_WAIT_V(8); PG8_WAIT_L(0); PG8_BAR; PG8_MMA(0, 0, At, B0); if (!Sched::HAS_NH || !nh) PG8_MMA(0, 1, At, B1); PG8_BAR; PG8_SCHED;
            PG8_LDA(At, 1, 1); PG8_STAGE(PG8_SB(1, 0), b3, voffB); PG8_STAGE(PG8_SB(1, 1), b3 + hstepB, voffB); PG8_STAGE(PG8_SA(1, 0), a3, voffA);
            PG8_WAIT_V(8); PG8_WAIT_L(0); PG8_BAR; PG8_MMA(1, 0, At, B0); if (!Sched::HAS_NH || !nh) PG8_MMA(1, 1, At, B1); PG8_BAR; PG8_SCHED;
            } else {
            PG8_LDB(B0, 0, 0); PG8_SCHED; PG8_LDA(At, 0, 0); PG8_STAGE(PG8_SA(1, 1), a1 + hstepA, voffA);
            PG8_WAIT_L(8); PG8_BAR; PG8_WAIT_L(0); PG8_MMA(0, 0, At, B0); PG8_BAR; PG8_SCHED;
            PG8_LDB(B1, 0, 1); PG8_STAGE(PG8_SB(0, 0), b2, voffB);
            PG8_BAR; PG8_WAIT_L(0); PG8_MMA(0, 1, At, B1); PG8_BAR;
            PG8_LDA(At, 0, 1); PG8_STAGE(PG8_SA(0, 0), a2, voffA);
            PG8_BAR; PG8_WAIT_L(0); PG8_MMA(1, 0, At, B0); PG8_BAR; PG8_SCHED;
            PG8_STAGE(PG8_SB(0, 1), b2 + hstepB, voffB);
            PG8_WAIT_V(6); PG8_BAR; PG8_MMA(1, 1, At, B1); PG8_BAR;
            PG8_LDB(B0, 1, 0); PG8_SCHED; PG8_LDA(At, 1, 0); PG8_STAGE(PG8_SA(0, 1), a2 + hstepA, voffA);
            PG8_WAIT_L(8); PG8_BAR; PG8_WAIT_L(0); PG8_MMA(0, 0, At, B0); PG8_BAR; PG8_SCHED;
            PG8_LDB(B1, 1, 1); PG8_STAGE(PG8_SB(1, 0), b3, voffB);
            PG8_BAR; PG8_WAIT_L(0); PG8_MMA(0, 1, At, B1); PG8_BAR;
            PG8_LDA(At, 1, 1); PG8_STAGE(PG8_SA(1, 0), a3, voffA);
            PG8_BAR; PG8_WAIT_L(0); PG8_MMA(1, 0, At, B0); PG8_BAR; PG8_SCHED;
            PG8_STAGE(PG8_SB(1, 1), b3 + hstepB, voffB);
            PG8_WAIT_V(6); PG8_BAR; PG8_MMA(1, 1, At, B1); PG8_BAR;
            }
        }
        if constexpr (ALIGN_EPI) { if (wr == 0) PG8_BAR; }
        E(acc, cur, wr, wc, fr, fq); S.done(cur);
        if (!has_next) break;
#pragma unroll
        for (int a = 0; a < 2; ++a)
#pragma unroll
            for (int b = 0; b < 2; ++b)
#pragma unroll
                for (int m = 0; m < 4; ++m)
#pragma unroll
                    for (int n = 0; n < 2; ++n) acc[a][b][m][n] = (f32x4){0.f, 0.f, 0.f, 0.f};
        cur = nxt; cA = nA; cB = nB; ++ui;
        if constexpr (ALIGN_EPI) { if (wr == 1) PG8_BAR; }
    }
    PG8_WAIT_V(0);
    if constexpr (!ALIGN_EPI) { if (wr == 0) PG8_BAR; }
    PG8_BAR;
#undef PG8_SA
#undef PG8_SB
#undef PG8_STAGE
#undef PG8_LDA
#undef PG8_LDB
#undef PG8_MMA
#undef PG8_WAIT_V
#undef PG8_WAIT_L
#undef PG8_BAR
#undef PG8_SCHED
}
}
constexpr int DM = 2048, MP = 8192, MS = 4096, MALL = 12288, MKV = 12800, FF = 8192, NMOD = 12288;
constexpr int NWAVES = 8, NTHR = 512, DEPTH = 4;
constexpr float EPS = 1e-6f;
constexpr size_t O_X = 0, O_CKV = 25165824, O_KPE = 33554432, O_HG = 34603008, O_NK = 51380224, O_NV = 68157440, O_END = 84934656;
enum { I_XP = 0, I_XS, I_CCKV, I_CKPE, I_SHG, I_CNK, I_CNV, I_C, I_CCTX, I_WMOD, I_BMOD, I_GMIX, I_GFFN, I_WQA, I_GQA, I_WQB, I_GQN, I_WKVA, I_GKVA, I_WKVB, I_GKN, I_WMO,
       I_WHQ, I_WHF, I_HLB, I_WHI, I_WHG, I_GHO, I_WHO, I_WNQKV, I_GNQ, I_GNK, I_RPB, I_WNO, I_WFF1, I_WFF2, N_IN };

constexpr size_t MiB = 1u << 20;
constexpr size_t WS_CTL = 0, CTL_ZERO_BYTES = 65536;
constexpr size_t WS_MODS = 2 * MiB;
constexpr size_t WS_LB = 3 * MiB;
constexpr size_t WS_SSK = 3 * MiB + 65536;
constexpr size_t WS_PROF = 3 * MiB + 786432;
constexpr size_t WS_ROPE = 3 * MiB + 131072;
constexpr size_t WS_WFF1 = 4 * MiB, WS_WFF2 = 132 * MiB;
constexpr size_t WS_WMLA = 260 * MiB, WMLA_STRIDE = 24 * MiB;
constexpr size_t WMLA_QB = 6 * MiB, WMLA_KVB = 11 * MiB, WMLA_WO = 15 * MiB;
constexpr size_t WS_WHG = 308 * MiB, WHG_WO = 40 * MiB;
constexpr size_t WS_WNAT = 356 * MiB, WNAT_WO = 24 * MiB;
constexpr size_t WS_H = 388 * MiB;
constexpr size_t WS_U = 436 * MiB;
constexpr size_t WS_S = 628 * MiB;
constexpr size_t S_AO = 0;
constexpr size_t S_QAKV = 48 * MiB, S_QAN = 120 * MiB, S_CKVN = 138 * MiB, S_KPE = 151 * MiB, S_QRAW = 155 * MiB, S_KVRAW = 227 * MiB, S_QN = 327 * MiB, S_KF = 399 * MiB;
constexpr size_t S_HQ = 48 * MiB, S_HK = 96 * MiB, S_HV = 192 * MiB, S_HGS = 240 * MiB, S_OF = 288 * MiB;
constexpr size_t S_NQKV = 48 * MiB, S_NQN = 198 * MiB, S_NKN = 246 * MiB;
constexpr size_t S_PART = 480 * MiB;
constexpr size_t S_X = 512 * MiB;
constexpr size_t WS_END = WS_S + 560 * MiB;
constexpr int CW_TMO = 0, CW_CODE = 1, CW_BAR = 4096;

constexpr int RING_BYTES = 131072;
constexpr int LDSCTL_OFF = 163840 - 512, MISC_OFF = LDSCTL_OFF + 320;
constexpr int EPI_TAB_OFF = LDSCTL_OFF - 8192;
constexpr int LDS_BYTES = 163840;

#define GAS __attribute__((address_space(1)))
#define LAS __attribute__((address_space(3)))
typedef unsigned short bf16;
typedef unsigned v4u __attribute__((ext_vector_type(4)));
typedef unsigned v2u __attribute__((ext_vector_type(2)));
typedef float f32x4 __attribute__((ext_vector_type(4)));
typedef float f32x2 __attribute__((ext_vector_type(2)));
typedef short bf16x8 __attribute__((ext_vector_type(8)));
typedef GAS unsigned gu32;
#define RLX_AGENT __ATOMIC_RELAXED, __HIP_MEMORY_SCOPE_AGENT
#define LDS_WAIT() asm volatile("s_waitcnt lgkmcnt(0)" ::: "memory")
#define VM_WAIT() asm volatile("s_waitcnt vmcnt(0)" ::: "memory")
#ifndef DBG_SCALE
#define DBG_SCALE 1.0f
#endif
#define OPAQUE_S(x) asm volatile("" : "+s"(x))
#define PH_PTRS unsigned char* ws = a.ws; float* out = a.out; OPAQUE_S(ws); OPAQUE_S(out)
#define OPAQUE_V(x) asm volatile("" : "+v"(x))
__device__ __forceinline__ unsigned pk2(float lo, float hi) { unsigned r; asm("v_cvt_pk_bf16_f32 %0, %1, %2" : "=v"(r) : "v"(lo), "v"(hi)); return r; }
__device__ __forceinline__ float bf_lo(unsigned w) { return __uint_as_float(w << 16); }
__device__ __forceinline__ float bf_hi(unsigned w) { return __uint_as_float(w & 0xffff0000u); }
__device__ __forceinline__ float wave_sum(float v) {
#pragma unroll
    for (int o = 1; o < 64; o <<= 1) v += __shfl_xor(v, o);
    return v;
}
__device__ __forceinline__ float sum16(float v) {
#pragma unroll
    for (int o = 1; o < 16; o <<= 1) v += __shfl_xor(v, o);
    return v;
}

#define XB_TMO      128
#define XB_XCNT(j)  (256  + 64 * (j))
#define XB_XSUB(j)  (1280 + 64 * (j))
#define XB_XGEN(j)  (2304 + 64 * (j))
#define XB_TOP      3328
#define XB_TOPGEN   3392
#define XCD_BAR_WORDS 3456
#define XB_SPIN_CAP (1u << 18)
__device__ __forceinline__ unsigned xb_ld(unsigned* p)              { return __hip_atomic_load(p, __ATOMIC_RELAXED, __HIP_MEMORY_SCOPE_AGENT); }
__device__ __forceinline__ unsigned xb_add(unsigned* p, unsigned v) { return __hip_atomic_fetch_add(p, v, __ATOMIC_RELAXED, __HIP_MEMORY_SCOPE_AGENT); }
__device__ __forceinline__ unsigned xb_xcc_id() { return (unsigned)__builtin_amdgcn_s_getreg((3 << 11) | 20) & 0xFu; }
#define XB_SPIN(cond, bar) do { unsigned _sp = 0; while (cond) { __builtin_amdgcn_s_sleep(1); \
    if ((++_sp & 255u) == 0u) { if (xb_ld(&(bar)[XB_TMO])) break; if (_sp > XB_SPIN_CAP) { atomicAdd(&(bar)[XB_TMO], 1u); break; } } } } while (0)
struct XcdBarrier { unsigned* bar; unsigned x; volatile LAS unsigned* st; };
__device__ __forceinline__ XcdBarrier xcd_barrier_post(unsigned* bar, volatile LAS unsigned* st) {
    XcdBarrier b; b.bar = bar; b.x = xb_xcc_id(); b.st = st;
    if (threadIdx.x == 0) (void)xb_add(&bar[XB_XCNT(b.x)], 1u);
    return b;
}
__device__ __forceinline__ void xcd_barrier_complete(unsigned* bar, unsigned x, unsigned& nloc, unsigned& nx) {
    const unsigned G = gridDim.x * gridDim.y * gridDim.z;
    unsigned sum, cnt, mine, sp = 0u;
    for (;;) {
        sum = 0u; cnt = 0u; mine = 0u;
#pragma unroll
        for (unsigned j = 0; j < 16; ++j) { const unsigned c = xb_ld(&bar[XB_XCNT(j)]); sum += c; cnt += (c > 0u) ? 1u : 0u; mine = (j == x) ? c : mine; }
        if (sum == G) break;
        __builtin_amdgcn_s_sleep(1);
        if ((++sp & 255u) == 0u) { if (xb_ld(&bar[XB_TMO])) break; if (sp > XB_SPIN_CAP) { atomicAdd(&bar[XB_TMO], 1u); break; } }
    }
    nloc = mine > 0u ? mine : 1u; nx = cnt > 0u ? cnt : 1u;
}
__device__ __forceinline__ void xcd_barrier(const XcdBarrier& b) {
    asm volatile("s_waitcnt vmcnt(0)" ::: "memory");
    __syncthreads();
    if (threadIdx.x == 0) {
        unsigned* bar = b.bar;
        __builtin_amdgcn_s_waitcnt(0);
        unsigned nloc = b.st[0], nx = b.st[1];
        if (nloc == 0u) { xcd_barrier_complete(bar, b.x, nloc, nx); b.st[0] = nloc; b.st[1] = nx; }
        const unsigned old = xb_add(&bar[XB_XSUB(b.x)], 1u);
        const unsigned gen = old / nloc;
        if (old + 1u == (gen + 1u) * nloc) {
            __builtin_amdgcn_fence(__ATOMIC_RELEASE, "agent");
            asm volatile("s_waitcnt vmcnt(0)" ::: "memory");
            const unsigned og = xb_add(&bar[XB_TOP], 1u);
            const unsigned tg = og / nx;
            if (og + 1u == (tg + 1u) * nx) xb_add(&bar[XB_TOPGEN], 1u);
            else XB_SPIN(xb_ld(&bar[XB_TOPGEN]) == tg, bar);
            __builtin_amdgcn_fence(__ATOMIC_ACQUIRE, "agent");
            xb_add(&bar[XB_XGEN(b.x)], 1u);
            asm volatile("s_waitcnt vmcnt(0)" ::: "memory");
        } else {
            XB_SPIN(xb_ld(&bar[XB_XGEN(b.x)]) == gen, bar);
            __builtin_amdgcn_fence(__ATOMIC_ACQUIRE, "agent");
            asm volatile("s_waitcnt vmcnt(0)" ::: "memory");
        }
    }
    __syncthreads();
}

struct TJob { const float* src; bf16* dst; int K, N, row_off, start; };
constexpr int MAX_TJ = 32;
struct Args { const float* in[N_IN]; float* out; unsigned char* ws; TJob tj[MAX_TJ]; int ntj, nitems, ph_lo, ph_hi;
              int wstart[8], wmid[8]; };

__device__ __forceinline__ void p0_transpose_item(const float* W, int K, int N, bf16* WT, int row_off, LAS float* scr, int item, int lane) {
    const int nblk = N / 32, kb = item / nblk, nb = item % nblk, k0 = 64 * kb, n0 = 32 * nb;
    { const int kr = lane >> 3, ns = (lane & 7) * 4;
      f32x4 t[8];
#pragma unroll
      for (int i = 0; i < 8; ++i) t[i] = __builtin_nontemporal_load((const GAS f32x4*)(W + (size_t)(k0 + kr + 8 * i) * N + n0 + ns));
#pragma unroll
      for (int i = 0; i < 8; ++i) { LAS float* d = scr + (kr + 8 * i) * 33 + ns; d[0] = t[i].x; d[1] = t[i].y; d[2] = t[i].z; d[3] = t[i].w; } }
    LDS_WAIT(); asm volatile("" ::: "memory");
    const int c = lane & 7;
#pragma unroll
    for (int j = 0; j < 4; ++j) { const int n = (lane >> 3) + 8 * j; const LAS float* s = scr + (8 * c) * 33 + n;
        v4u o; o.x = pk2(s[0 * 33], s[1 * 33]); o.y = pk2(s[2 * 33], s[3 * 33]); o.z = pk2(s[4 * 33], s[5 * 33]); o.w = pk2(s[6 * 33], s[7 * 33]);
        __builtin_nontemporal_store(o, (GAS v4u*)(WT + (size_t)(row_off + n0 + n) * K + k0 + 8 * c)); }
    LDS_WAIT(); asm volatile("" ::: "memory");
}

__device__ __forceinline__ void p0_convert_range(const Args& a, LAS unsigned char* lds, int lo, int hi, int idx, int stride, int lane, int wave) {
    OPAQUE_V(lane);
    LAS float* scr = (LAS float*)(lds + wave * 16384);
    for (int it = lo + idx; it < hi; it += stride) {
        int j = 0;
        while (j + 1 < a.ntj && it >= a.tj[j + 1].start) ++j;
        p0_transpose_item(a.tj[j].src, a.tj[j].K, a.tj[j].N, a.tj[j].dst, a.tj[j].row_off, scr, it - a.tj[j].start, lane);
    }
}

__device__ __forceinline__ float silu_f(float x) { return x / (1.f + __expf(-x)); }

__device__ __forceinline__ void p0_prologue(const Args& a, LAS unsigned char* lds, int tid, int lane, int wave, int vcu, int G) {
    OPAQUE_V(tid); OPAQUE_V(lane);
    float* mods = (float*)(a.ws + WS_MODS);
#ifndef DBG_REP_MASK
#define DBG_REP_MASK 0
#endif
    for (int rep_ = 0; rep_ < (((DBG_REP_MASK >> 14) & 1) ? 3 : 1); ++rep_)
    if (vcu < 768) {
        LAS f32x4* S3 = (LAS f32x4*)lds;
        LAS float* RED = (LAS float*)(lds + 32768);
        const float* cc = a.in[I_C]; const float* cx = a.in[I_CCTX];
        for (int k = tid; k < DM; k += NTHR) S3[k] = (f32x4){silu_f(cx[k]), silu_f(cc[k]), silu_f(cc[DM + k]), 0.f};
        __syncthreads();
        for (int tl = vcu; tl < 768; tl += G) {
            const int l = tl / 192, n = (tl % 192) * 64 + lane;
            const float* Wp = a.in[I_WMOD] + ((size_t)l * DM + wave * 256) * NMOD + n;
            float a0 = 0.f, a1 = 0.f, a2 = 0.f;
#pragma unroll 16
            for (int k = 0; k < 256; ++k) { const float wv = __builtin_nontemporal_load((const GAS float*)(Wp + (size_t)k * NMOD)); const f32x4 s = S3[wave * 256 + k]; a0 += s.x * wv; a1 += s.y * wv; a2 += s.z * wv; }
            RED[(wave * 3 + 0) * 64 + lane] = a0; RED[(wave * 3 + 1) * 64 + lane] = a1; RED[(wave * 3 + 2) * 64 + lane] = a2;
            __syncthreads();
            if (wave < 3) { float s = 0.f;
#pragma unroll
                for (int w = 0; w < 8; ++w) s += RED[(w * 3 + wave) * 64 + lane];
                mods[((size_t)l * 3 + wave) * NMOD + n] = s + a.in[I_BMOD][(size_t)l * NMOD + n]; }
            __syncthreads();
        }
    }
    { const int gt = vcu * NTHR + tid;
      if (gt < 2 * DM) { const int d = gt >> 11, c = gt & 2047; const float* hl = a.in[I_HLB] + (size_t)d * 4 * DM + c;
          const float x0 = hl[0], x1 = hl[DM], x2 = hl[2 * DM], x3 = hl[3 * DM]; const float m = fmaxf(fmaxf(x0, x1), fmaxf(x2, x3));
          const float e0 = __expf(x0 - m), e1 = __expf(x1 - m), e2 = __expf(x2 - m), e3 = __expf(x3 - m);
          ((float*)(a.ws + WS_LB))[gt] = e1 / (e0 + e1 + e2 + e3); } }
    __syncthreads();
    LAS float* scr = (LAS float*)(lds + wave * 16384);
    const int gw = vcu * NWAVES + wave, NGW = G * NWAVES;
    for (int rep_ = 0; rep_ < (((DBG_REP_MASK >> 15) & 1) ? 3 : 1); ++rep_)
    for (int it = gw; it < a.wstart[1]; it += NGW) {
        int j = 0;
        while (j + 1 < a.ntj && it >= a.tj[j + 1].start) ++j;
        p0_transpose_item(a.tj[j].src, a.tj[j].K, a.tj[j].N, a.tj[j].dst, a.tj[j].row_off, scr, it - a.tj[j].start, lane);
    }
#if defined(DBG_ZERO_OUT)
    { const size_t gt = (size_t)vcu * NTHR + tid, NT = (size_t)G * NTHR;
      for (size_t i = gt; i < (O_END - O_CKV) / 4; i += NT) *(GAS f32x4*)(a.out + O_CKV + 4 * i) = (f32x4){0.f, 0.f, 0.f, 0.f}; }
#endif
    { const int gt = vcu * NTHR + tid, NT = G * NTHR;
      for (int i = gt; i < 2 * 192 * DM / 8; i += NT) { const int j = i / (192 * DM / 8), r = i % (192 * DM / 8);
          *(GAS v4u*)(a.ws + WS_WMLA + j * WMLA_STRIDE + (size_t)1344 * DM * 2 + (size_t)r * 16) = (v4u){0u, 0u, 0u, 0u}; } }
}

__device__ __forceinline__ int cond_of_row(int row) { return row < MP ? 0 : 1 + ((row - MP) >> 11); }

__device__ __forceinline__ void norm_phase(const Args& a, int l, bool ffn, const float* fixgate, int lane, int gw, int NGW) {
    OPAQUE_V(lane); PH_PTRS; OPAQUE_S(gw); OPAQUE_S(NGW);
    const float* g = a.in[ffn ? I_GFFN : I_GMIX] + (size_t)l * DM;
    const float* mods = (const float*)(ws + WS_MODS) + (size_t)l * 3 * NMOD + (ffn ? 3 * DM : 0);
    bf16* H = (bf16*)(ws + WS_H); bf16* X = (bf16*)(ws + WS_S + S_X);
    const bool first = (l == 0 && !ffn);
    for (int row = gw; row < MALL; row += NGW) {
        const float* md = mods + (size_t)cond_of_row(row) * NMOD;
        f32x4 v[8]; float ss = 0.f;
        const bool fix = fixgate != nullptr && row >= MP;
        const bf16* P0 = (const bf16*)(ws + WS_S + S_PART) + (size_t)(row - MP) * DM; const float* fg = fixgate + (size_t)cond_of_row(row) * NMOD;
        if (first) { const float* xr = row < MP ? a.in[I_XP] + (size_t)row * DM : a.in[I_XS] + (size_t)(row - MP) * DM;
#pragma unroll
            for (int j = 0; j < 8; ++j) v[j] = __builtin_nontemporal_load((const GAS f32x4*)(xr + 4 * (lane + 64 * j)));
        } else { const bf16* xr = X + (size_t)row * DM;
#pragma unroll
            for (int j = 0; j < 8; ++j) { const v2u w = *(const GAS v2u*)(xr + 4 * (lane + 64 * j)); v[j] = (f32x4){bf_lo(w.x), bf_hi(w.x), bf_lo(w.y), bf_hi(w.y)}; } }
#pragma unroll
        for (int j = 0; j < 8; ++j) {
            if (fix) { const int c = 4 * (lane + 64 * j); const v2u pw = __builtin_nontemporal_load((const GAS v2u*)(P0 + c)); v[j] = v[j] + *(const GAS f32x4*)(fg + c) * (f32x4){bf_lo(pw.x), bf_hi(pw.x), bf_lo(pw.y), bf_hi(pw.y)}; }
            ss += (v[j].x * v[j].x + v[j].y * v[j].y) + (v[j].z * v[j].z + v[j].w * v[j].w); }
        const float rs = rsqrtf(wave_sum(ss) * (1.f / DM) + EPS);
#pragma unroll
        for (int j = 0; j < 8; ++j) { const int c = 4 * (lane + 64 * j);
            const f32x4 gg = *(const GAS f32x4*)(g + c), sh = *(const GAS f32x4*)(md + c), sc = *(const GAS f32x4*)(md + DM + c);
            const f32x4 y = v[j] * rs * gg * (sc + 1.f) + sh;
            *(GAS v2u*)(H + (size_t)row * DM + c) = (v2u){pk2(y.x, y.y), pk2(y.z, y.w)};
            if (first || fix) *(GAS v2u*)(X + (size_t)row * DM + c) = (v2u){pk2(v[j].x, v[j].y), pk2(v[j].z, v[j].w)}; }
    }
}
__device__ __forceinline__ void final_fix_phase(const Args& a, const float* fixgate, int lane, int gw, int NGW) {
    OPAQUE_V(lane); PH_PTRS; OPAQUE_S(gw); OPAQUE_S(NGW);
    for (int row = MP + gw; row < MALL; row += NGW) {
        const bf16* P0 = (const bf16*)(ws + WS_S + S_PART) + (size_t)(row - MP) * DM; const float* fg = fixgate + (size_t)cond_of_row(row) * NMOD; float* xr = out + O_X + (size_t)row * DM;
#pragma unroll
        for (int j = 0; j < 8; ++j) { const int c = 4 * (lane + 64 * j); const v2u pw = *(const GAS v2u*)(P0 + c);
            *(GAS f32x4*)(xr + c) = *(const GAS f32x4*)(xr + c) + *(const GAS f32x4*)(fg + c) * (f32x4){bf_lo(pw.x), bf_hi(pw.x), bf_lo(pw.y), bf_hi(pw.y)}; }
    }
}
__device__ __forceinline__ void mla_thin_a(const Args& a, int j, int lane, int gw, int NGW) {
    OPAQUE_V(lane); PH_PTRS; OPAQUE_S(gw); OPAQUE_S(NGW);
    const bf16* QAKV = (const bf16*)(ws + WS_S + S_QAKV);
    bf16* QAN = (bf16*)(ws + WS_S + S_QAN); bf16* CKVN = (bf16*)(ws + WS_S + S_CKVN); float* KPE = (float*)(ws + WS_S + S_KPE); float* SSK = (float*)(ws + WS_SSK);
    const float* gqa = a.in[I_GQA] + (size_t)j * 768; const float* gkva = a.in[I_GKVA] + (size_t)j * 512;
    for (int row = gw; row < MKV; row += NGW) {
        if (row < MALL) {
            const bf16* r = QAKV + (size_t)row * 1536;
#define LD4(p_) ({ const v2u w_ = __builtin_nontemporal_load((const GAS v2u*)(p_)); (f32x4){bf_lo(w_.x), bf_hi(w_.x), bf_lo(w_.y), bf_hi(w_.y)}; })
            { f32x4 v[3]; float ss = 0.f;
#pragma unroll
              for (int i = 0; i < 3; ++i) { v[i] = LD4(r + 4 * (lane + 64 * i)); ss += (v[i].x * v[i].x + v[i].y * v[i].y) + (v[i].z * v[i].z + v[i].w * v[i].w); }
              const float rs = rsqrtf(wave_sum(ss) * (1.f / 768.f) + EPS);
#pragma unroll
              for (int i = 0; i < 3; ++i) { const int c = 4 * (lane + 64 * i); const f32x4 y = v[i] * rs * *(const GAS f32x4*)(gqa + c);
                  *(GAS v2u*)(QAN + (size_t)row * 768 + c) = (v2u){pk2(y.x, y.y), pk2(y.z, y.w)}; } }
            { f32x4 v[2]; float ss = 0.f;
#pragma unroll
              for (int i = 0; i < 2; ++i) { v[i] = LD4(r + 768 + 4 * (lane + 64 * i)); ss += (v[i].x * v[i].x + v[i].y * v[i].y) + (v[i].z * v[i].z + v[i].w * v[i].w); }
              const float rs = rsqrtf(wave_sum(ss) * (1.f / 512.f) + EPS);
#pragma unroll
              for (int i = 0; i < 2; ++i) { const int c = 4 * (lane + 64 * i); const f32x4 y = v[i] * rs * *(const GAS f32x4*)(gkva + c);
                  *(GAS v2u*)(CKVN + (size_t)row * 512 + c) = (v2u){pk2(y.x, y.y), pk2(y.z, y.w)};
                  if (row < MP) __builtin_nontemporal_store(y * DBG_SCALE, (GAS f32x4*)(out + O_CKV + ((size_t)((row >> 8) * 2 + j) * 256 + (row & 255)) * 512 + c)); } }
            { const float kp = __uint_as_float((unsigned)r[1280 + lane] << 16); KPE[(size_t)row * 64 + lane] = kp;
              if (row < MP) out[O_KPE + ((size_t)((row >> 8) * 2 + j) * 256 + (row & 255)) * 64 + lane] = kp * DBG_SCALE;
              const float s = wave_sum(kp * kp); if (lane == 0) SSK[row] = s; }
#undef LD4
        } else {
            const int cr = row - MALL, b = cr >> 8, t = cr & 255; const size_t src = (size_t)((b * 2 + j) * 256 + t);
            const float* ck = a.in[I_CCKV] + src * 512;
#pragma unroll
            for (int i = 0; i < 2; ++i) { const int c = 4 * (lane + 64 * i); const f32x4 y = *(const GAS f32x4*)(ck + c);
                *(GAS v2u*)(CKVN + (size_t)row * 512 + c) = (v2u){pk2(y.x, y.y), pk2(y.z, y.w)}; }
            const float kp = a.in[I_CKPE][src * 64 + lane]; KPE[(size_t)row * 64 + lane] = kp;
            const float s = wave_sum(kp * kp); if (lane == 0) SSK[row] = s;
        }
    }
}
namespace pg8 {
struct EpiF32 {
    static constexpr bool PERM = false;
    float* C; int ldc;
    __device__ __forceinline__ void operator()(const f32x4 (&acc)[2][2][4][2], const Unit& u, int wr, int wc, int fr, int fq) const {
        const int row0 = u.pm * BM + wr * 64 + fr, col0 = u.pn * BM + wc * 32 + 4 * fq;
#pragma unroll
        for (int ai = 0; ai < 2; ++ai)
#pragma unroll
            for (int m = 0; m < 4; ++m) { float* rowp = C + (size_t)(row0 + ai * HALF + m * 16) * ldc + col0;
#pragma unroll
                for (int bj = 0; bj < 2; ++bj)
#pragma unroll
                    for (int n = 0; n < 2; ++n) *(PG8_GAS f32x4*)(rowp + bj * HALF + n * 16) = acc[ai][bj][m][n]; }
    }
};
template <int ACT  > struct EpiBf16 {
    static constexpr bool PERM = true;
    bf16_t* O; int ldc;
    __device__ __forceinline__ void operator()(const f32x4 (&acc)[2][2][4][2], const Unit& u, int wr, int wc, int fr, int fq) const {
        const int row0 = u.pm * BM + wr * 64 + fr, col0 = u.pn * BM + wc * 32 + 8 * fq;
#pragma unroll
        for (int ai = 0; ai < 2; ++ai)
#pragma unroll
            for (int m = 0; m < 4; ++m) { bf16_t* rowp = O + (size_t)(row0 + ai * HALF + m * 16) * ldc + col0;
#pragma unroll
                for (int bj = 0; bj < 2; ++bj) { f32x4 v0 = acc[ai][bj][m][0], v1 = acc[ai][bj][m][1];
                    if (ACT == 1) {
#pragma unroll
                        for (int e = 0; e < 4; ++e) { const float x0 = fmaxf(v0[e], 0.f), x1 = fmaxf(v1[e], 0.f); v0[e] = x0 * x0; v1[e] = x1 * x1; } }
                    u32x4 w; w.x = cvt_pk_bf16(v0[0], v0[1]); w.y = cvt_pk_bf16(v0[2], v0[3]); w.z = cvt_pk_bf16(v1[0], v1[1]); w.w = cvt_pk_bf16(v1[2], v1[3]);
                    *(PG8_GAS u32x4*)(rowp + bj * HALF) = w; } }
    }
};
template <bool ATOMIC> struct EpiRes {
    static constexpr bool PERM = false;
    float* X; const float* gate;
    __device__ __forceinline__ void operator()(const f32x4 (&acc)[2][2][4][2], const Unit& u, int wr, int wc, int fr, int fq) const {
        const int rb = u.pm * BM, row0 = rb + wr * 64 + fr, col0 = u.pn * BM + wc * 32 + 4 * fq;
        const int cond = rb < 8192 ? 0 : 1 + ((rb - 8192) >> 11);
        const float* gp = gate + (size_t)cond * 12288 + col0;
        f32x4 gv[2][2];
#pragma unroll
        for (int bj = 0; bj < 2; ++bj)
#pragma unroll
            for (int n = 0; n < 2; ++n) gv[bj][n] = *(const PG8_GAS f32x4*)(gp + bj * HALF + n * 16);
#pragma unroll
        for (int ai = 0; ai < 2; ++ai)
#pragma unroll
            for (int m = 0; m < 4; ++m) { float* rowp = X + (size_t)(row0 + ai * HALF + m * 16) * 2048 + col0;
#pragma unroll
                for (int bj = 0; bj < 2; ++bj)
#pragma unroll
                    for (int n = 0; n < 2; ++n) { float* p = rowp + bj * HALF + n * 16; const f32x4 d = gv[bj][n] * acc[ai][bj][m][n];
                        if (ATOMIC) {
#pragma unroll
                            for (int e = 0; e < 4; ++e) __hip_atomic_fetch_add((PG8_GAS float*)(p + e), d[e], __ATOMIC_RELAXED, __HIP_MEMORY_SCOPE_AGENT);
                        } else { *(PG8_GAS f32x4*)p = *(const PG8_GAS f32x4*)p + d; } }
                asm volatile("" ::: "memory"); }
    }
};
struct EpiRes2 {
    static constexpr bool PERM = false;
    bf16_t* X; const float* gate; bf16_t* P; float* Yout;
    __device__ __forceinline__ void operator()(const f32x4 (&acc)[2][2][4][2], const Unit& u, int wr, int wc, int fr, int fq) const {
        typedef unsigned u32x2_ __attribute__((ext_vector_type(2)));
        const int rb = u.pm * BM, row0 = rb + wr * 64 + fr, col0 = u.pn * BM + wc * 32 + 4 * fq;
        if (u.part <= 0) {
            const int cond = rb < 8192 ? 0 : 1 + ((rb - 8192) >> 11);
            const float* gp = gate + (size_t)cond * 12288 + col0;
            f32x4 gv[2][2];
#pragma unroll
            for (int bj = 0; bj < 2; ++bj)
#pragma unroll
                for (int n = 0; n < 2; ++n) gv[bj][n] = *(const PG8_GAS f32x4*)(gp + bj * HALF + n * 16);
#pragma unroll
            for (int ai = 0; ai < 2; ++ai)
#pragma unroll
                for (int m = 0; m < 4; ++m) { const size_t ro = (size_t)(row0 + ai * HALF + m * 16) * 2048 + col0;
#pragma unroll
                    for (int bj = 0; bj < 2; ++bj)
#pragma unroll
                        for (int n = 0; n < 2; ++n) { const size_t o = ro + bj * HALF + n * 16; const u32x2_ w = *(const PG8_GAS u32x2_*)(X + o);
                            const f32x4 xn = (f32x4){__uint_as_float(w.x << 16), __uint_as_float(w.x & 0xffff0000u), __uint_as_float(w.y << 16), __uint_as_float(w.y & 0xffff0000u)} + gv[bj][n] * acc[ai][bj][m][n];
                            if (Yout != nullptr) *(PG8_GAS f32x4*)(Yout + o) = xn; else *(PG8_GAS u32x2_*)(X + o) = (u32x2_){cvt_pk_bf16(xn[0], xn[1]), cvt_pk_bf16(xn[2], xn[3])}; }
                    asm volatile("" ::: "memory"); }
        } else {
            bf16_t* Pp = P + (size_t)(row0 - 8192) * 2048 + col0;
#pragma unroll
            for (int ai = 0; ai < 2; ++ai)
#pragma unroll
                for (int m = 0; m < 4; ++m) { bf16_t* rowp = Pp + (size_t)(ai * HALF + m * 16) * 2048;
#pragma unroll
                    for (int bj = 0; bj < 2; ++bj)
#pragma unroll
                        for (int n = 0; n < 2; ++n) { const f32x4 v = acc[ai][bj][m][n]; *(PG8_GAS u32x2_*)(rowp + bj * HALF + n * 16) = (u32x2_){cvt_pk_bf16(v[0], v[1]), cvt_pk_bf16(v[2], v[3])}; } }
        }
    }
};
}
#ifndef DBG_REP_MASK
#define DBG_REP_MASK 0
#endif
namespace att {
using bf16x8 = __attribute__((ext_vector_type(8))) short;
using s16x4  = __attribute__((ext_vector_type(4))) short;
using f32x16 = __attribute__((ext_vector_type(16))) float;
using u32x4  = __attribute__((ext_vector_type(4))) unsigned;
constexpr int NW = 8, QBLK = 32, KVBLK = 64, DV = 128;
constexpr float THR = 8.f;
constexpr int SHM_V = KVBLK * DV * 2;
constexpr int RPB_OFF = 2 * SHM_V + 2 * KVBLK * 512 + 2048;
#define ATT_SBAR() __builtin_amdgcn_sched_barrier(0)
__device__ __forceinline__ int crow(int r, int hi) { return (r & 3) + 8 * (r >> 2) + 4 * hi; }
__device__ __forceinline__ unsigned cvtpk(float lo, float hi) { unsigned r; asm volatile("v_cvt_pk_bf16_f32 %0, %1, %2" : "=v"(r) : "v"(lo), "v"(hi)); return r; }
__device__ __forceinline__ int v_st(int k, int c) { const int kk = (k & ~0xC) | ((k & 4) << 1) | ((k & 8) >> 1); return ((kk >> 3) * 4 + (c >> 5)) * 512 + ((kk & 7) * 32 + (c & 31)) * 2; }
__device__ __forceinline__ int v_rd_base(int lane) { return ((lane & 3) << 3) | (((lane >> 2) & 3) << 6) | (((lane >> 4) & 1) << 5) | (((lane >> 5) & 1) << 8); }
constexpr int v_rd_off(int d0, int ks, int half) { return d0 * 512 + ks * 4096 + half * 2048; }
template <int OFF> __device__ __forceinline__ s16x4 tr_read(int vb) { s16x4 r; asm volatile("ds_read_b64_tr_b16 %0, %1 offset:%2" : "=&v"(r) : "v"(vb), "i"(OFF) : "memory"); return r; }
template <int D0> __device__ __forceinline__ void pv_one(f32x16& od, int vb, bf16x8 pa0, bf16x8 pa1, bf16x8 pa2, bf16x8 pa3) {
  const s16x4 l0 = tr_read<v_rd_off(D0, 0, 0)>(vb), h0 = tr_read<v_rd_off(D0, 0, 1)>(vb), l1 = tr_read<v_rd_off(D0, 1, 0)>(vb), h1 = tr_read<v_rd_off(D0, 1, 1)>(vb);
  const s16x4 l2 = tr_read<v_rd_off(D0, 2, 0)>(vb), h2 = tr_read<v_rd_off(D0, 2, 1)>(vb), l3 = tr_read<v_rd_off(D0, 3, 0)>(vb), h3 = tr_read<v_rd_off(D0, 3, 1)>(vb);
  asm volatile("s_waitcnt lgkmcnt(0)" ::: "memory"); ATT_SBAR();
#define ATT_PK(L, H) (bf16x8){L[0], L[1], L[2], L[3], H[0], H[1], H[2], H[3]}
  od = __builtin_amdgcn_mfma_f32_32x32x16_bf16(pa0, ATT_PK(l0, h0), od, 0, 0, 0);
  od = __builtin_amdgcn_mfma_f32_32x32x16_bf16(pa1, ATT_PK(l1, h1), od, 0, 0, 0);
  od = __builtin_amdgcn_mfma_f32_32x32x16_bf16(pa2, ATT_PK(l2, h2), od, 0, 0, 0);
  od = __builtin_amdgcn_mfma_f32_32x32x16_bf16(pa3, ATT_PK(l3, h3), od, 0, 0, 0);
#undef ATT_PK
}
__device__ __forceinline__ void pv_d0(f32x16* o, int vb, bf16x8 pa0, bf16x8 pa1, bf16x8 pa2, bf16x8 pa3) {
  pv_one<0>(o[0], vb, pa0, pa1, pa2, pa3); pv_one<1>(o[1], vb, pa0, pa1, pa2, pa3); pv_one<2>(o[2], vb, pa0, pa1, pa2, pa3); pv_one<3>(o[3], vb, pa0, pa1, pa2, pa3);
}
struct KvSrc { int row0, n0, row1, n1; __device__ __forceinline__ int row(int t) const { const int u = t - n0; return t < n0 ? row0 + 64 * t : row1 + 64 * (u < n1 ? u : n1 - 1); } };
struct NatMask { int rlo, qrow, qcol; const LAS float* rpb; };

template <int DQK, int MODE, int ldq, int ldk, int ldv, int ldo, int QP = 0>
__device__ __forceinline__ void attn_unit(const bf16* __restrict__ Qb, const bf16* __restrict__ Kh, const bf16* __restrict__ Vh,
                                          bf16* __restrict__ Ob, const KvSrc src, int NT, const NatMask nm, LAS char* lds, int tid,
                                          const float* __restrict__ qgain = nullptr, const float* __restrict__ qrope = nullptr) {
  constexpr float SCALE = DQK == 128 ? 0.088388347648318440f : 0.072168783648703220f;
  constexpr float C = SCALE * 1.4426950408889634f;
  constexpr int KROW = DQK == 128 ? 256 : 512  , SHM_K = KVBLK * KROW, NKC = DQK / 8, KCH = KVBLK * NKC / 512, ND0 = DQK / 16;
  const int wid = tid >> 6, lane = tid & 63, r32 = lane & 31, hi = lane >> 5;
  LAS char* V_lds = lds; LAS char* K_lds = lds + 2 * SHM_V;
  LAS float* ws = (LAS float*)(lds + 2 * SHM_V + 2 * SHM_K) + wid * 64; LAS float* li_l = ws; LAS float* al_l = ws + 32;
  float m_reg = -1e30f, l_reg = 0; f32x16 o[4] = {}; bf16x8 qr[ND0];
  { const bf16* Qw = Qb + (size_t)(wid * QBLK + r32) * ldq + hi * 8;
#pragma unroll
    for (int d0 = 0; d0 < ND0; ++d0) qr[d0] = *(const GAS bf16x8*)(Qw + d0 * 16); }
  if constexpr (QP == 1) {
    float ss = 0.f;
#pragma unroll
    for (int d0 = 0; d0 < ND0; ++d0) { const u32x4 w = __builtin_bit_cast(u32x4, qr[d0]);
#pragma unroll
      for (int e = 0; e < 4; ++e) { const float a = __uint_as_float(w[e] << 16), b = __uint_as_float(w[e] & 0xffff0000u); ss += a * a + b * b; } }
    ss += __shfl_xor(ss, 32);
    const float rs = rsqrtf(ss * (1.f / DQK) + 1e-6f);
    float xv[ND0 < 12 ? 1 : 4][8];
#pragma unroll
    for (int d0 = 0; d0 < ND0; ++d0) { const u32x4 w = __builtin_bit_cast(u32x4, qr[d0]);
      const f32x4 g0 = *(const GAS f32x4*)(qgain + d0 * 16 + hi * 8), g1 = *(const GAS f32x4*)(qgain + d0 * 16 + hi * 8 + 4);
      float x[8];
#pragma unroll
      for (int e = 0; e < 4; ++e) { x[2 * e] = __uint_as_float(w[e] << 16) * rs; x[2 * e + 1] = __uint_as_float(w[e] & 0xffff0000u) * rs; }
      x[0] *= g0.x; x[1] *= g0.y; x[2] *= g0.z; x[3] *= g0.w; x[4] *= g1.x; x[5] *= g1.y; x[6] *= g1.z; x[7] *= g1.w;
      if (ND0 == 12 && d0 >= 8) {
#pragma unroll
        for (int e = 0; e < 8; ++e) xv[ND0 < 12 ? 0 : d0 - 8][e] = x[e];
      } else { const u32x4 o_ = {cvtpk(x[0], x[1]), cvtpk(x[2], x[3]), cvtpk(x[4], x[5]), cvtpk(x[6], x[7])}; qr[d0] = __builtin_bit_cast(bf16x8, o_); } }
    if constexpr (ND0 == 12) {
#pragma unroll
      for (int pp = 0; pp < 2; ++pp) {
        float y1[8], y2[8];
#pragma unroll
        for (int e = 0; e < 8; ++e) { y1[e] = xv[pp][e]; y2[e] = xv[2 + pp][e]; }
        if (qrope != nullptr) { const float* rt = qrope + ((size_t)(wid * QBLK + r32) * 32 + 16 * pp + 8 * hi) * 2;
#pragma unroll
          for (int e2 = 0; e2 < 4; ++e2) { const f32x4 cs = *(const GAS f32x4*)(rt + 4 * e2);
            const float a0 = y1[2 * e2] * cs.x - y2[2 * e2] * cs.y, b0 = y1[2 * e2] * cs.y + y2[2 * e2] * cs.x;
            const float a1 = y1[2 * e2 + 1] * cs.z - y2[2 * e2 + 1] * cs.w, b1 = y1[2 * e2 + 1] * cs.w + y2[2 * e2 + 1] * cs.z;
            y1[2 * e2] = a0; y2[2 * e2] = b0; y1[2 * e2 + 1] = a1; y2[2 * e2 + 1] = b1; } }
        const u32x4 o1 = {cvtpk(y1[0], y1[1]), cvtpk(y1[2], y1[3]), cvtpk(y1[4], y1[5]), cvtpk(y1[6], y1[7])}, o2 = {cvtpk(y2[0], y2[1]), cvtpk(y2[2], y2[3]), cvtpk(y2[4], y2[5]), cvtpk(y2[6], y2[7])};
        qr[8 + pp] = __builtin_bit_cast(bf16x8, o1); qr[10 + pp] = __builtin_bit_cast(bf16x8, o2); }
    }
  }
  const int sr = tid >> 4, sc = (tid & 15) * 8, vst0 = v_st(sr, sc), vst1 = v_st(32 + sr, sc);
  unsigned koff_[KCH], kst_[KCH]; const unsigned voff0 = (unsigned)(sr * ldv + sc);
#pragma unroll
  for (int i = 0; i < KCH; ++i) { const int c = tid + 512 * i, kr = c / NKC, kc = c % NKC; koff_[i] = (unsigned)(kr * ldk + kc * 8); kst_[i] = (unsigned)(kr * KROW + ((kc * 16) ^ ((kr & 15) << 4))); }
  const int vb0 = (int)(uintptr_t)V_lds + v_rd_base(lane);
  bf16x8 svs0, svs1, sks[KCH];
#define ATT_SLOAD(t) do { const int _r = __builtin_amdgcn_readfirstlane(src.row(t)); const bf16* _vt = Vh + (size_t)_r * ldv; const bf16* _kt = Kh + (size_t)_r * ldk; \
    svs0 = *(const GAS bf16x8*)(_vt + voff0); svs1 = *(const GAS bf16x8*)(_vt + 32 * ldv + voff0); \
    _Pragma("unroll") for (int _i = 0; _i < KCH; ++_i) sks[_i] = *(const GAS bf16x8*)(_kt + koff_[_i]); } while (0)
#define ATT_SWRITE(b) do { *(LAS bf16x8*)(V_lds + (b) * SHM_V + vst0) = svs0; *(LAS bf16x8*)(V_lds + (b) * SHM_V + vst1) = svs1; \
    _Pragma("unroll") for (int _i = 0; _i < KCH; ++_i) *(LAS bf16x8*)(K_lds + (b) * SHM_K + kst_[_i]) = sks[_i]; } while (0)
#define ATT_RESC(a) do { if (__any((a) < 1.f)) { if (hi == 0) al_l[r32] = (a); asm volatile("s_waitcnt lgkmcnt(0)" ::: "memory"); \
    _Pragma("unroll") for (int d = 0; d < 4; ++d) _Pragma("unroll") for (int r = 0; r < 16; ++r) o[d][r] *= al_l[crow(r, hi)]; } } while (0)
  auto qkt = [&](f32x16& p0, f32x16& p1, int b, int t) {
    const LAS char* Ks = K_lds + b * SHM_K;
    p0 = f32x16{}; p1 = f32x16{};
    const LAS char* k0p = Ks + r32 * KROW; const LAS char* k1p = Ks + (32 + r32) * KROW; const int sw = (r32 & 15) << 4;
    bf16x8 ka[2], kb[2];
    ka[0] = *reinterpret_cast<const LAS bf16x8*>(k0p + ((hi * 16) ^ sw)); kb[0] = *reinterpret_cast<const LAS bf16x8*>(k1p + ((hi * 16) ^ sw));
#pragma unroll
    for (int d0 = 0; d0 < ND0; ++d0) {
      if (d0 + 1 < ND0) { const int cb = ((d0 + 1) * 16 + hi * 8) * 2;
        ka[(d0 + 1) & 1] = *reinterpret_cast<const LAS bf16x8*>(k0p + (cb ^ sw)); kb[(d0 + 1) & 1] = *reinterpret_cast<const LAS bf16x8*>(k1p + (cb ^ sw)); }
      __builtin_amdgcn_sched_barrier(0);
      p0 = __builtin_amdgcn_mfma_f32_32x32x16_bf16(ka[d0 & 1], qr[d0], p0, 0, 0, 0);
      p1 = __builtin_amdgcn_mfma_f32_32x32x16_bf16(kb[d0 & 1], qr[d0], p1, 0, 0, 0);
      __builtin_amdgcn_sched_barrier(0); }
    if constexpr (MODE == 1) {
      const int i = t - src.n0;
      if (i >= 0) {
        const int kr = nm.rlo + i, r0q = min(max(nm.qrow - 4, 0), 24), c0q = min(max(nm.qcol - 8, 0), 48);
        const bool rowok = (i < src.n1) && (kr >= r0q) && (kr < r0q + 8);
        const int rowoff = (kr - nm.qrow + 7) * 31 + 15 - nm.qcol;
#pragma unroll
        for (int r = 0; r < 16; ++r) {
          const int kc0 = crow(r, hi), kc1 = kc0 + 32;
          const bool ok0 = rowok && ((unsigned)(kc0 - c0q) < 16u), ok1 = rowok && ((unsigned)(kc1 - c0q) < 16u);
          const float b0 = nm.rpb[ok0 ? rowoff + kc0 : 0], b1 = nm.rpb[ok1 ? rowoff + kc1 : 0];
          p0[r] = ok0 ? p0[r] + b0 : -1e30f; p1[r] = ok1 ? p1[r] + b1 : -1e30f; }
      }
    }
  };
  auto partialSM = [&](f32x16& p0, f32x16& p1, float& mn, float& alpha) {
    float pmax = p0[0];
#pragma unroll
    for (int r = 1; r < 16; ++r) pmax = fmaxf(pmax, p0[r]);
#pragma unroll
    for (int r = 0; r < 16; ++r) pmax = fmaxf(pmax, p1[r]);
    { auto rr = __builtin_amdgcn_permlane32_swap(__float_as_uint(pmax), __float_as_uint(pmax), false, false); pmax = fmaxf(__uint_as_float(rr[0]), __uint_as_float(rr[1])); }
    if (__builtin_expect(__all(pmax - m_reg <= THR / SCALE), 1)) { mn = m_reg; alpha = 1.f; }
    else { mn = fmaxf(m_reg, pmax); alpha = __builtin_amdgcn_exp2f((m_reg - mn) * C); m_reg = mn; }
    const float mnC = -mn * C;
#pragma unroll
    for (int r = 0; r < 16; ++r) p0[r] = fmaf(p0[r], C, mnC);
#pragma unroll
    for (int r = 0; r < 16; ++r) p1[r] = fmaf(p1[r], C, mnC);
#pragma unroll
    for (int r = 0; r < 16; ++r) p0[r] = __builtin_amdgcn_exp2f(p0[r]);
  };
  auto finishSM = [&](f32x16& p0, f32x16& p1, float alpha, bf16x8& pa0, bf16x8& pa1, bf16x8& pa2, bf16x8& pa3) {
#pragma unroll
    for (int r = 0; r < 16; ++r) p1[r] = __builtin_amdgcn_exp2f(p1[r]);
    float ps = 0;
#pragma unroll
    for (int r = 0; r < 16; ++r) ps += p0[r];
#pragma unroll
    for (int r = 0; r < 16; ++r) ps += p1[r];
    { auto rr = __builtin_amdgcn_permlane32_swap(__float_as_uint(ps), __float_as_uint(ps), false, false); ps = __uint_as_float(rr[0]) + __uint_as_float(rr[1]); }
    l_reg = l_reg * alpha + ps;
#define ATT_PK4(P, BASE, OUT) do { unsigned a0 = cvtpk(P[BASE + 0], P[BASE + 1]), a1 = cvtpk(P[BASE + 2], P[BASE + 3]); \
    unsigned b0 = cvtpk(P[BASE + 4], P[BASE + 5]), b1 = cvtpk(P[BASE + 6], P[BASE + 7]); \
    auto r0 = __builtin_amdgcn_permlane32_swap(a0, b0, false, false); auto r1 = __builtin_amdgcn_permlane32_swap(a1, b1, false, false); \
    u32x4 w = {r0[0], r1[0], r0[1], r1[1]}; OUT = *reinterpret_cast<bf16x8*>(&w); } while (0)
    ATT_PK4(p0, 0, pa0); ATT_PK4(p0, 8, pa1); ATT_PK4(p1, 0, pa2); ATT_PK4(p1, 8, pa3);
#undef ATT_PK4
  };
  f32x16 p0, p1; float mn, al; bf16x8 pa0, pa1, pa2, pa3;
  ATT_SLOAD(0); asm volatile("s_waitcnt vmcnt(0)" ::: "memory"); ATT_SWRITE(0); if (NT > 1) ATT_SLOAD(1); __syncthreads();
  for (int t = 0; t < NT; ++t) {
    const int b = t & 1;
    ATT_SBAR(); qkt(p0, p1, b, t); ATT_SBAR();
    if (t + 1 < NT) { asm volatile("s_waitcnt vmcnt(0)" ::: "memory"); ATT_SWRITE(b ^ 1); if (t + 2 < NT) ATT_SLOAD(t + 2); }
    ATT_SBAR();
    partialSM(p0, p1, mn, al); ATT_RESC(al);
    finishSM(p0, p1, al, pa0, pa1, pa2, pa3); ATT_SBAR();
    pv_d0(o, vb0 + b * SHM_V, pa0, pa1, pa2, pa3);
    __syncthreads();
  }
  if (hi == 0) li_l[r32] = l_reg; asm volatile("s_waitcnt lgkmcnt(0)" ::: "memory");
  int hi_o = hi; asm volatile("" : "+v"(hi_o));
  bf16* Ow = Ob + (size_t)(wid * QBLK + 4 * hi_o) * ldo;
#pragma unroll
  for (int r = 0; r < 16; ++r) { const int orow = crow(r, 0); const float rl = __builtin_amdgcn_rcpf(li_l[orow + 4 * hi_o]);
#pragma unroll
    for (int d0 = 0; d0 < 4; ++d0) { const float v = o[d0][r] * rl; ((GAS bf16*)Ow)[(size_t)orow * ldo + d0 * 32 + r32] = (bf16)(cvtpk(v, v) & 0xffffu); } }
#undef ATT_SLOAD
#undef ATT_SWRITE
#undef ATT_RESC
}
}
namespace pg8 {
struct EpiKV {
    static constexpr bool PERM = true;
    bf16_t* KV; bf16_t* KF; const float* gkn; const float* KPE; const float* SSK; const float* RT; PG8_LAS float* tab;
    __device__ __forceinline__ void operator()(const f32x4 (&acc)[2][2][4][2], const Unit& u, int wr, int wc, int fr, int fq) const {
        const int h = u.pn, row0 = u.pm * BM + wr * 64 + fr, c8 = wc * 32 + 8 * fq;
        float sk[2][4];
#pragma unroll
        for (int ai = 0; ai < 2; ++ai)
#pragma unroll
            for (int m = 0; m < 4; ++m) { const f32x4 a = acc[ai][0][m][0], b = acc[ai][0][m][1]; sk[ai][m] = ((const PG8_GAS float*)SSK)[row0 + ai * HALF + m * 16];
                float s = (a[0] * a[0] + a[1] * a[1]) + (a[2] * a[2] + a[3] * a[3]) + (b[0] * b[0] + b[1] * b[1]) + (b[2] * b[2] + b[3] * b[3]);
                s += __shfl_xor(s, 16); s += __shfl_xor(s, 32);
                if (fq == 0) tab[(ai * HALF + wr * 64 + m * 16 + fr) * 4 + wc] = s; }
#pragma unroll
        for (int ai = 0; ai < 2; ++ai)
#pragma unroll
            for (int m = 0; m < 4; ++m) { const f32x4 v0 = acc[ai][1][m][0], v1 = acc[ai][1][m][1];
                u32x4 w; w.x = cvt_pk_bf16(v0[0], v0[1]); w.y = cvt_pk_bf16(v0[2], v0[3]); w.z = cvt_pk_bf16(v1[0], v1[1]); w.w = cvt_pk_bf16(v1[2], v1[3]);
                *(PG8_GAS u32x4*)(KV + (size_t)(row0 + ai * HALF + m * 16) * 4096 + h * 256 + 128 + c8) = w; }
        asm volatile("s_waitcnt lgkmcnt(0)" ::: "memory"); __builtin_amdgcn_s_barrier(); asm volatile("" ::: "memory");
        const f32x4 g0 = *(const PG8_GAS f32x4*)(gkn + c8), g1 = *(const PG8_GAS f32x4*)(gkn + c8 + 4);
#pragma unroll
        for (int ai = 0; ai < 2; ++ai)
#pragma unroll
            for (int m = 0; m < 4; ++m) { const int row = row0 + ai * HALF + m * 16; const f32x4 p = *(const PG8_LAS f32x4*)(tab + (ai * HALF + wr * 64 + m * 16 + fr) * 4);
                const float rs = rsqrtf(((p[0] + p[1]) + (p[2] + p[3]) + sk[ai][m]) * (1.f / 192.f) + 1e-6f);
                const f32x4 k0 = acc[ai][0][m][0] * rs * g0, k1 = acc[ai][0][m][1] * rs * g1;
                u32x4 w; w.x = cvt_pk_bf16(k0[0], k0[1]); w.y = cvt_pk_bf16(k0[2], k0[3]); w.z = cvt_pk_bf16(k1[0], k1[1]); w.w = cvt_pk_bf16(k1[2], k1[3]);
                *(PG8_GAS u32x4*)(KF + (size_t)row * 3072 + h * 192 + c8) = w; }
        { const int t_ = (wr * 4 + wc) * 64 + fq * 16 + fr, r = t_ >> 1, hf = t_ & 1, row = u.pm * BM + r;
          const f32x4 p = *(const PG8_LAS f32x4*)(tab + r * 4);
          const float rs = rsqrtf(((p[0] + p[1]) + (p[2] + p[3]) + ((const PG8_GAS float*)SSK)[row]) * (1.f / 192.f) + 1e-6f);
          const bool rot = row >= 8192 && row < 12288; const float* rt = RT + ((size_t)((row - 8192) & 2047) * 32 + 16 * hf) * 2;
          const float* kp = KPE + (size_t)row * 64 + 16 * hf; bf16_t* o = KF + (size_t)row * 3072 + h * 192 + 128 + 16 * hf;
#pragma unroll
          for (int q = 0; q < 2; ++q) {
              f32x4 a0 = *(const PG8_GAS f32x4*)(kp + 8 * q), a1 = *(const PG8_GAS f32x4*)(kp + 8 * q + 4), b0 = *(const PG8_GAS f32x4*)(kp + 32 + 8 * q), b1 = *(const PG8_GAS f32x4*)(kp + 32 + 8 * q + 4);
              a0 = a0 * rs * *(const PG8_GAS f32x4*)(gkn + 128 + 16 * hf + 8 * q); a1 = a1 * rs * *(const PG8_GAS f32x4*)(gkn + 128 + 16 * hf + 8 * q + 4);
              b0 = b0 * rs * *(const PG8_GAS f32x4*)(gkn + 160 + 16 * hf + 8 * q); b1 = b1 * rs * *(const PG8_GAS f32x4*)(gkn + 160 + 16 * hf + 8 * q + 4);
              float x1[8] = {a0[0], a0[1], a0[2], a0[3], a1[0], a1[1], a1[2], a1[3]}, x2[8] = {b0[0], b0[1], b0[2], b0[3], b1[0], b1[1], b1[2], b1[3]};
              if (rot) {
#pragma unroll
                  for (int e2 = 0; e2 < 4; ++e2) { const f32x4 cs = *(const PG8_GAS f32x4*)(rt + (8 * q + 2 * e2) * 2);
                      const float y0 = x1[2 * e2] * cs[0] - x2[2 * e2] * cs[1], z0 = x1[2 * e2] * cs[1] + x2[2 * e2] * cs[0];
                      const float y1 = x1[2 * e2 + 1] * cs[2] - x2[2 * e2 + 1] * cs[3], z1 = x1[2 * e2 + 1] * cs[3] + x2[2 * e2 + 1] * cs[2];
                      x1[2 * e2] = y0; x2[2 * e2] = z0; x1[2 * e2 + 1] = y1; x2[2 * e2 + 1] = z1; } }
              u32x4 w1, w2; w1.x = cvt_pk_bf16(x1[0], x1[1]); w1.y = cvt_pk_bf16(x1[2], x1[3]); w1.z = cvt_pk_bf16(x1[4], x1[5]); w1.w = cvt_pk_bf16(x1[6], x1[7]);
              w2.x = cvt_pk_bf16(x2[0], x2[1]); w2.y = cvt_pk_bf16(x2[2], x2[3]); w2.z = cvt_pk_bf16(x2[4], x2[5]); w2.w = cvt_pk_bf16(x2[6], x2[7]);
              *(PG8_GAS u32x4*)(o + 8 * q) = w1; *(PG8_GAS u32x4*)(o + 32 + 8 * q) = w2; } }
    }
};
}
__device__ __forceinline__ void rope_table(const Args& a, int tid, int vcu, int G) {
    f32x2* RT = (f32x2*)(a.ws + WS_ROPE);
    for (int e = vcu * NTHR + tid; e < 2048 * 32; e += G * NTHR) { const int t = e >> 5, i = e & 31;
        const float inv = exp2f(-(float)(i & 15) * (13.287712379549449f / 16.f));
        const float ang = (float)(i < 16 ? (t >> 6) : (t & 63)) * inv; float s, c; sincosf(ang, &s, &c); RT[e] = (f32x2){c, s}; }
}
__device__ __forceinline__ void mla_thin_b(const Args& a, int j, int lane, int gw, int NGW) {
    OPAQUE_V(lane); PH_PTRS; OPAQUE_S(gw); OPAQUE_S(NGW);
    const bf16* QRAW = (const bf16*)(ws + WS_S + S_QRAW); bf16* QN = (bf16*)(ws + WS_S + S_QN);
    const bf16* KVRAW = (const bf16*)(ws + WS_S + S_KVRAW); bf16* KF = (bf16*)(ws + WS_S + S_KF);
    const float* KPE = (const float*)(ws + WS_S + S_KPE); const float* SSK = (const float*)(ws + WS_SSK);
    const f32x2* RT = (const f32x2*)(ws + WS_ROPE);
    const float* gqn = a.in[I_GQN] + (size_t)j * 192; const float* gkn = a.in[I_GKN] + (size_t)j * 192;
    const int grp = lane >> 4, s = lane & 15;
    float gq[12], gk[12];
#pragma unroll
    for (int e = 0; e < 8; ++e) { gq[e] = gqn[8 * s + e]; gk[e] = gkn[8 * s + e]; }
    gq[8] = gqn[128 + 2 * s]; gq[9] = gqn[129 + 2 * s]; gq[10] = gqn[160 + 2 * s]; gq[11] = gqn[161 + 2 * s];
    gk[8] = gkn[128 + 2 * s]; gk[9] = gkn[129 + 2 * s]; gk[10] = gkn[160 + 2 * s]; gk[11] = gkn[161 + 2 * s];
    const int NQI = 0, NKI = MKV * 4;
    for (int it = gw; it < NQI + NKI; it += NGW) {
        const bool isq = it < NQI; const int r4 = isq ? it : it - NQI; const int row = r4 >> 2, h = (r4 & 3) * 4 + grp;
        float x[12];
        if (isq) {
            const bf16* p = QRAW + (size_t)row * 3072 + h * 192;
            const v4u w = *(const GAS v4u*)(p + 8 * s); const unsigned w1 = *(const GAS unsigned*)(p + 128 + 2 * s), w2 = *(const GAS unsigned*)(p + 160 + 2 * s);
            x[0] = bf_lo(w.x); x[1] = bf_hi(w.x); x[2] = bf_lo(w.y); x[3] = bf_hi(w.y); x[4] = bf_lo(w.z); x[5] = bf_hi(w.z); x[6] = bf_lo(w.w); x[7] = bf_hi(w.w);
            x[8] = bf_lo(w1); x[9] = bf_hi(w1); x[10] = bf_lo(w2); x[11] = bf_hi(w2);
        } else {
            const bf16* p = KVRAW + (size_t)row * 4096 + h * 256;
            const v4u w = *(const GAS v4u*)(p + 8 * s);
            x[0] = bf_lo(w.x); x[1] = bf_hi(w.x); x[2] = bf_lo(w.y); x[3] = bf_hi(w.y); x[4] = bf_lo(w.z); x[5] = bf_hi(w.z); x[6] = bf_lo(w.w); x[7] = bf_hi(w.w);
            const f32x2 k1 = *(const GAS f32x2*)(KPE + (size_t)row * 64 + 2 * s), k2 = *(const GAS f32x2*)(KPE + (size_t)row * 64 + 32 + 2 * s);
            x[8] = k1.x; x[9] = k1.y; x[10] = k2.x; x[11] = k2.y;
        }
        float ss = 0.f;
#pragma unroll
        for (int e = 0; e < 8; ++e) ss += x[e] * x[e];
        if (isq) { ss += x[8] * x[8] + x[9] * x[9] + x[10] * x[10] + x[11] * x[11]; ss = sum16(ss); }
        else { ss = sum16(ss) + SSK[row]; }
        const float rs = rsqrtf(ss * (1.f / 192.f) + EPS);
#pragma unroll
        for (int e = 0; e < 12; ++e) x[e] = x[e] * rs * (isq ? gq[e] : gk[e]);
        if (row >= MP && row < MALL) {
            const int t = (row - MP) & 2047; const f32x2 cs0 = RT[t * 32 + 2 * s], cs1 = RT[t * 32 + 2 * s + 1];
            const float a0 = x[8] * cs0.x - x[10] * cs0.y, b0 = x[8] * cs0.y + x[10] * cs0.x, a1 = x[9] * cs1.x - x[11] * cs1.y, b1 = x[9] * cs1.y + x[11] * cs1.x;
            x[8] = a0; x[9] = a1; x[10] = b0; x[11] = b1;
        }
        bf16* o = (isq ? QN : KF) + (size_t)row * 3072 + h * 192;
        *(GAS v4u*)(o + 8 * s) = (v4u){pk2(x[0], x[1]), pk2(x[2], x[3]), pk2(x[4], x[5]), pk2(x[6], x[7])};
        *(GAS unsigned*)(o + 128 + 2 * s) = pk2(x[8], x[9]); *(GAS unsigned*)(o + 160 + 2 * s) = pk2(x[10], x[11]);
    }
}
__device__ __forceinline__ void mla_attn_phase(const Args& a, int j, LAS unsigned char* lds, int tid, int vcu, int G) {
    OPAQUE_V(tid); PH_PTRS; OPAQUE_S(vcu); OPAQUE_S(G);
    const bf16* QN = (const bf16*)(ws + WS_S + S_QRAW); const bf16* KF = (const bf16*)(ws + WS_S + S_KF); const bf16* KVRAW = (const bf16*)(ws + WS_S + S_KVRAW);
    bf16* AO = (bf16*)(ws + WS_S + S_AO); const float* gqn = a.in[I_GQN] + (size_t)j * 192; const float* RT = (const float*)(ws + WS_ROPE);
    for (int u = vcu; u < 768; u += G) {
        int q0, h, NT; att::KvSrc src; const float* qrope = nullptr;
        if (u < 256) { const int b = u >> 7, qb = u & 7; h = (u >> 3) & 15; q0 = MP + b * 2048 + qb * 256; src = att::KvSrc{MP + b * 2048, 32, MALL + b * 256, 4}; NT = 36; qrope = RT + (size_t)(qb * 256) * 64; }
        else { const int v = u - 256, b = v >> 4; h = v & 15; q0 = b * 256; src = att::KvSrc{b * 256, 4, 0, 1}; NT = 4; }
        att::attn_unit<192, 0, 3072, 3072, 4096, DM, 1>(QN + (size_t)q0 * 3072 + h * 192, KF + h * 192, KVRAW + h * 256 + 128, AO + (size_t)q0 * DM + h * 128, src, NT, att::NatMask{0, 0, 0, nullptr}, (LAS char*)lds, tid, gqn, qrope);
    }
}
namespace pg8 {
struct EpiHg {
    static constexpr bool PERM = true;
    unsigned char* ws;
    __device__ __forceinline__ void operator()(const f32x4 (&acc)[2][2][4][2], const Unit& u, int wr, int wc, int fr, int fq) const {
        const int region = u.pn >> 3, row0 = u.pm * BM + wr * 64 + fr, col0 = (u.pn & 7) * BM + wc * 32 + 8 * fq;
        if (region == 1 || region == 2) {
            const int d = region - 1;
            f32x4 lbv[2][2];
#pragma unroll
            for (int bj = 0; bj < 2; ++bj)
#pragma unroll
                for (int n = 0; n < 2; ++n) lbv[bj][n] = *(const PG8_GAS f32x4*)((const float*)(ws + WS_LB) + d * 2048 + col0 + bj * HALF + 4 * n);
            bf16_t* K = (bf16_t*)(ws + WS_S + S_HK) + (size_t)d * 12288 * 2048; float* Gd = (float*)(ws + WS_U) + (size_t)d * 12288 * 2048;
#pragma unroll
            for (int ai = 0; ai < 2; ++ai)
#pragma unroll
                for (int m = 0; m < 4; ++m) { const size_t ro = (size_t)(row0 + ai * HALF + m * 16) * 2048 + col0;
#pragma unroll
                    for (int bj = 0; bj < 2; ++bj) { f32x4 kk[2], gg[2];
#pragma unroll
                        for (int n = 0; n < 2; ++n)
#pragma unroll
                            for (int e = 0; e < 4; ++e) { const float z = acc[ai][bj][m][n][e]; const float sn = __builtin_amdgcn_rcpf(1.f + __expf(z));
                                const float k = (1.f - lbv[bj][n][e]) * sn; kk[n][e] = k; gg[n][e] = __log2f(1.f - k); }
                        u32x4 w; w.x = cvt_pk_bf16(kk[0][0], kk[0][1]); w.y = cvt_pk_bf16(kk[0][2], kk[0][3]); w.z = cvt_pk_bf16(kk[1][0], kk[1][1]); w.w = cvt_pk_bf16(kk[1][2], kk[1][3]);
                        *(PG8_GAS u32x4*)(K + ro + bj * HALF) = w; *(PG8_GAS f32x4*)(Gd + ro + bj * HALF) = gg[0]; *(PG8_GAS f32x4*)(Gd + ro + bj * HALF + 4) = gg[1]; } }
        } else {
            bf16_t* O = (bf16_t*)(ws + WS_S + (region == 0 ? S_HQ : region == 3 ? S_HV : S_HGS)); const bool act = region != 3;
#pragma unroll
            for (int ai = 0; ai < 2; ++ai)
#pragma unroll
                for (int m = 0; m < 4; ++m) { bf16_t* rowp = O + (size_t)(row0 + ai * HALF + m * 16) * 2048 + col0;
#pragma unroll
                    for (int bj = 0; bj < 2; ++bj) { f32x4 v0 = acc[ai][bj][m][0], v1 = acc[ai][bj][m][1];
                        if (act) {
#pragma unroll
                            for (int e = 0; e < 4; ++e) { v0[e] = v0[e] * __builtin_amdgcn_rcpf(1.f + __expf(-v0[e])); v1[e] = v1[e] * __builtin_amdgcn_rcpf(1.f + __expf(-v1[e])); } }
                        u32x4 w; w.x = cvt_pk_bf16(v0[0], v0[1]); w.y = cvt_pk_bf16(v0[2], v0[3]); w.z = cvt_pk_bf16(v1[0], v1[1]); w.w = cvt_pk_bf16(v1[2], v1[3]);
                        *(PG8_GAS u32x4*)(rowp + bj * HALF) = w; } }
        }
    }
};
}

namespace hg {
constexpr int PQ = 272, PK = 80;
constexpr int OFF_QM = 0, OFF_KM = 32 * PQ, OFF_V = 2 * 32 * PQ, OFF_ATT = 3 * 32 * PQ, OFF_C2 = OFF_ATT + 32 * PK, OFF_C3 = OFF_C2 + 512, BUF = OFF_C3 + 512;
constexpr int OFF_TOT = 2 * BUF, TOT_BYTES = 8 * 128 * 4;
constexpr int OFF_OST = OFF_TOT + 2 * TOT_BYTES;
constexpr int OFF_STG = OFF_OST + 32 * PQ, STG_SLOT = 40960;
static_assert(OFF_STG + 2 * STG_SLOT <= LDSCTL_OFF, "scan LDS (must stay below the control words)");
typedef short bf16x8 __attribute__((ext_vector_type(8)));
typedef short s16x4 __attribute__((ext_vector_type(4)));
struct Chain { int rb, N, d, h; const float* S0; float* Sout; };
template <int OFF> __device__ __forceinline__ s16x4 tr_read(int addr) { s16x4 r; asm volatile("ds_read_b64_tr_b16 %0, %1 offset:%2" : "=&v"(r) : "v"(addr), "i"(OFF) : "memory"); return r; }
__device__ __forceinline__ unsigned bfmul2(unsigned w, float e0, float e1) { return pk2(bf_lo(w) * e0, bf_hi(w) * e1); }

__device__ __forceinline__ void scan_chain(const Chain ch, const bf16* __restrict__ HQ, const bf16* __restrict__ HK, const float* __restrict__ HG, const bf16* __restrict__ HV,
                                           bf16* __restrict__ OD, LAS unsigned char* lds, int tid) {
    const int lane = tid & 63, w = tid >> 6, l15 = lane & 15, q4 = lane >> 4;
    const int k2 = lane;
    const int vt = tid >> 4, v8 = (tid & 15) * 8;
    const int nc = ch.N >> 5, hc = ch.h * 128;
    f32x4 S[8];
    if (ch.S0) {
#pragma unroll
        for (int kt = 0; kt < 8; ++kt)
#pragma unroll
            for (int r = 0; r < 4; ++r) S[kt][r] = ((const GAS float*)ch.S0)[(size_t)(16 * kt + 4 * q4 + r) * 128 + 16 * w + l15];
    } else {
#pragma unroll
        for (int kt = 0; kt < 8; ++kt) S[kt] = (f32x4){0.f, 0.f, 0.f, 0.f};
    }
#define HG_ROW(c, t) (ch.rb + (ch.d ? ch.N - 1 - (32 * (c) + (t)) : 32 * (c) + (t)))
    struct InSet { f32x2 g[4]; unsigned q[4], k[4]; v4u v; };
    f32x2 cl[4]; unsigned cq[4], ck[4]; v4u cv;
#define HG_DMA(c) do { LAS unsigned char* sl_ = lds + OFF_STG + ((c) & 1) * STG_SLOT; \
        _Pragma("unroll") for (int i_ = 0; i_ < 2; ++i_) __builtin_amdgcn_global_load_lds((const unsigned*)(HG + (size_t)HG_ROW(c, 4 * w + 2 * i_ + (lane >> 5)) * 2048 + hc + (lane & 31) * 4), (LAS unsigned*)(sl_ + (4 * w + 2 * i_) * 512), 16, 0, 0); \
        { const size_t ro_ = (size_t)HG_ROW(c, 4 * w + (lane >> 4)) * 2048 + hc + (lane & 15) * 8; \
          __builtin_amdgcn_global_load_lds((const unsigned*)(HQ + ro_), (LAS unsigned*)(sl_ + 16384 + 4 * w * 256), 16, 0, 0); \
          __builtin_amdgcn_global_load_lds((const unsigned*)(HK + ro_), (LAS unsigned*)(sl_ + 24576 + 4 * w * 256), 16, 0, 0); \
          __builtin_amdgcn_global_load_lds((const unsigned*)(HV + ro_), (LAS unsigned*)(sl_ + 32768 + 4 * w * 256), 16, 0, 0); } } while (0)
#define HG_P1(c) do { const LAS unsigned char* sl_ = lds + OFF_STG + ((c) & 1) * STG_SLOT; f32x2 run = (f32x2){0.f, 0.f}; \
        _Pragma("unroll") for (int i = 0; i < 4; ++i) { run = run + *(const LAS f32x2*)(sl_ + (4 * w + i) * 512 + k2 * 8); cl[i] = run; cq[i] = *(const LAS unsigned*)(sl_ + 16384 + (4 * w + i) * 256 + k2 * 4); ck[i] = *(const LAS unsigned*)(sl_ + 24576 + (4 * w + i) * 256 + k2 * 4); } \
        cv = *(const LAS v4u*)(sl_ + 32768 + vt * 256 + v8 * 2); \
        *(LAS f32x2*)(lds + OFF_TOT + ((c) & 1) * TOT_BYTES + (w * 128 + 2 * k2) * 4) = run; } while (0)
    HG_DMA(0); HG_DMA(1);
    asm volatile("s_waitcnt vmcnt(0)" ::: "memory"); HG_P1(0); LDS_WAIT(); asm volatile("" ::: "memory");
    HG_DMA(2);
    LDS_WAIT(); __builtin_amdgcn_s_barrier(); asm volatile("" ::: "memory");
    const int traddr = (int)(uintptr_t)lds + (8 * q4 + (l15 >> 2)) * PQ + (l15 & 3) * 8;
    auto mstage = [&](const int pc) {
        { LAS unsigned char* B = lds + (pc & 1) * BUF; const int tb = traddr + (pc & 1) * BUF;
            const s16x4 v0 = tr_read<0>(tb + OFF_V + 32 * w), v1 = tr_read<4 * PQ>(tb + OFF_V + 32 * w);
            bf16x8 aat[2]; v2u aq0[2][4], aq1[2][4];
#pragma unroll
            for (int tt = 0; tt < 2; ++tt) { aat[tt] = *(const LAS bf16x8*)(B + OFF_ATT + (16 * tt + l15) * PK + 16 * q4);
#pragma unroll
                for (int ks = 0; ks < 4; ++ks) { aq0[tt][ks] = *(const LAS v2u*)(B + OFF_QM + (16 * tt + l15) * PQ + (32 * ks + 4 * q4) * 2); aq1[tt][ks] = *(const LAS v2u*)(B + OFF_QM + (16 * tt + l15) * PQ + (32 * ks + 16 + 4 * q4) * 2); } }
            f32x4 c2v[8];
#pragma unroll
            for (int kt = 0; kt < 8; ++kt) c2v[kt] = *(const LAS f32x4*)(B + OFF_C2 + (16 * kt + 4 * q4) * 4);
            LDS_WAIT(); __builtin_amdgcn_sched_barrier(0);
            const bf16x8 bv = (bf16x8){v0[0], v0[1], v0[2], v0[3], v1[0], v1[1], v1[2], v1[3]};
            f32x4 o2[2];
#pragma unroll
            for (int kt = 0; kt < 8; ++kt) S[kt] = S[kt] * c2v[kt];
#pragma unroll
            for (int tt = 0; tt < 2; ++tt) o2[tt] = __builtin_amdgcn_mfma_f32_16x16x32_bf16(aat[tt], bv, (f32x4){0.f, 0.f, 0.f, 0.f}, 0, 0, 0);
#pragma unroll
            for (int ks = 0; ks < 4; ++ks) {
                const v4u sb = (v4u){pk2(S[2 * ks][0], S[2 * ks][1]), pk2(S[2 * ks][2], S[2 * ks][3]), pk2(S[2 * ks + 1][0], S[2 * ks + 1][1]), pk2(S[2 * ks + 1][2], S[2 * ks + 1][3])};
                const bf16x8 bs = __builtin_bit_cast(bf16x8, sb);
#pragma unroll
                for (int tt = 0; tt < 2; ++tt) { const bf16x8 aq = __builtin_bit_cast(bf16x8, ((v4u){aq0[tt][ks].x, aq0[tt][ks].y, aq1[tt][ks].x, aq1[tt][ks].y}));
                    o2[tt] = __builtin_amdgcn_mfma_f32_16x16x32_bf16(aq, bs, o2[tt], 0, 0, 0); }
            }
            s16x4 ke0[8], ke1[8]; f32x4 elv[8];
#define HG_KRD(kt) ke0[kt] = tr_read<32 * (kt)>(tb + OFF_KM); ke1[kt] = tr_read<32 * (kt) + 4 * PQ>(tb + OFF_KM)
            HG_KRD(0); HG_KRD(1); HG_KRD(2); HG_KRD(3); HG_KRD(4); HG_KRD(5); HG_KRD(6); HG_KRD(7);
#undef HG_KRD
#pragma unroll
            for (int kt = 0; kt < 8; ++kt) elv[kt] = *(const LAS f32x4*)(B + OFF_C3 + (16 * kt + 4 * q4) * 4);
            LDS_WAIT(); __builtin_amdgcn_sched_barrier(0);
#pragma unroll
            for (int kt = 0; kt < 8; ++kt) { const bf16x8 ak = (bf16x8){ke0[kt][0], ke0[kt][1], ke0[kt][2], ke0[kt][3], ke1[kt][0], ke1[kt][1], ke1[kt][2], ke1[kt][3]};
                S[kt] = __builtin_amdgcn_mfma_f32_16x16x32_bf16(ak, bv, S[kt], 0, 0, 0) * elv[kt]; }
#pragma unroll
            for (int tt = 0; tt < 2; ++tt)
#pragma unroll
                for (int r = 0; r < 4; ++r) *(LAS unsigned short*)(lds + OFF_OST + (16 * tt + 4 * q4 + r) * PQ + (16 * w + l15) * 2) = (unsigned short)(pk2(o2[tt][r], 0.f) & 0xffffu);
        }
    };
    for (int c = 0; c < nc; ++c) {
        if (c > 0) mstage(c - 1);
        LAS unsigned char* B = lds + (c & 1) * BUF;
        { const LAS f32x2* T = (const LAS f32x2*)(lds + OFF_TOT + (c & 1) * TOT_BYTES) + k2;
          f32x2 off = (f32x2){0.f, 0.f}, cm = (f32x2){0.f, 0.f}, last = (f32x2){0.f, 0.f};
#pragma unroll
          for (int sgm = 0; sgm < 8; ++sgm) { const f32x2 tv = T[sgm * 64]; if (sgm < w) off = off + tv; if (sgm < 4) cm = cm + tv; last = last + tv; }
#pragma unroll
          for (int i = 0; i < 4; ++i) { const f32x2 cu = off + cl[i]; const int t = 4 * w + i;
              *(LAS unsigned*)(B + OFF_QM + t * PQ + k2 * 4) = bfmul2(cq[i], __builtin_amdgcn_exp2f(cu.x - cm.x), __builtin_amdgcn_exp2f(cu.y - cm.y));
              *(LAS unsigned*)(B + OFF_KM + t * PQ + k2 * 4) = bfmul2(ck[i], __builtin_amdgcn_exp2f(cm.x - cu.x), __builtin_amdgcn_exp2f(cm.y - cu.y));
 }
          if (w == 0) { *(LAS f32x2*)(B + OFF_C2 + k2 * 8) = (f32x2){__builtin_amdgcn_exp2f(cm.x), __builtin_amdgcn_exp2f(cm.y)}; *(LAS f32x2*)(B + OFF_C3 + k2 * 8) = (f32x2){__builtin_amdgcn_exp2f(last.x - cm.x), __builtin_amdgcn_exp2f(last.y - cm.y)}; }
          *(LAS v4u*)(B + OFF_V + vt * PQ + v8 * 2) = cv; }
        { asm volatile("s_waitcnt vmcnt(5)" ::: "memory"); HG_P1(c + 1); LDS_WAIT(); asm volatile("" ::: "memory");
          const int cn = c + 3 < nc ? c + 3 : nc - 1; HG_DMA(cn); }
        LDS_WAIT(); __builtin_amdgcn_s_barrier(); asm volatile("" ::: "memory");
        if (c > 0) *(GAS v4u*)(OD + (size_t)HG_ROW(c - 1, vt) * 2048 + hc + v8) = *(const LAS v4u*)(lds + OFF_OST + vt * PQ + v8 * 2);
        if (w < 4) {
            const int tt = w >> 1, st = w & 1; f32x4 at = (f32x4){0.f, 0.f, 0.f, 0.f};
            if (!(tt == 0 && st == 1)) {
                bf16x8 af[4], bfr[4];
#pragma unroll
                for (int ks = 0; ks < 4; ++ks) { af[ks] = *(const LAS bf16x8*)(B + OFF_QM + (16 * tt + l15) * PQ + (32 * ks + 8 * q4) * 2); bfr[ks] = *(const LAS bf16x8*)(B + OFF_KM + (16 * st + l15) * PQ + (32 * ks + 8 * q4) * 2); }
                LDS_WAIT(); __builtin_amdgcn_sched_barrier(0);
#pragma unroll
                for (int ks = 0; ks < 4; ++ks) at = __builtin_amdgcn_mfma_f32_16x16x32_bf16(af[ks], bfr[ks], at, 0, 0, 0);
            }
            const int s_ = 16 * st + l15;
#pragma unroll
            for (int r = 0; r < 4; ++r) { const int t = 16 * tt + 4 * q4 + r; const float val = (s_ <= t) ? at[r] : 0.f;
                *(LAS unsigned short*)(B + OFF_ATT + t * PK + s_ * 2) = (unsigned short)(pk2(val, 0.f) & 0xffffu); }
        }
        LDS_WAIT(); __builtin_amdgcn_s_barrier(); asm volatile("" ::: "memory");
    }
    mstage(nc - 1);
    LDS_WAIT(); __builtin_amdgcn_s_barrier(); asm volatile("" ::: "memory");
    *(GAS v4u*)(OD + (size_t)HG_ROW(nc - 1, vt) * 2048 + hc + v8) = *(const LAS v4u*)(lds + OFF_OST + vt * PQ + v8 * 2);
    if (ch.Sout) {
#pragma unroll
        for (int kt = 0; kt < 8; ++kt)
#pragma unroll
            for (int r = 0; r < 4; ++r) __builtin_nontemporal_store(S[kt][r] * DBG_SCALE, (GAS float*)ch.Sout + (size_t)(16 * kt + 4 * q4 + r) * 128 + 16 * w + l15);
    }
    __builtin_amdgcn_s_barrier();
#undef HG_ROW
#undef HG_LOAD
#undef HG_P1
}
}

__device__ __forceinline__ void hg_scan_phase(const Args& a, LAS unsigned char* lds, int tid, int vcu, int G) {
    OPAQUE_V(tid); PH_PTRS; OPAQUE_S(vcu); OPAQUE_S(G);
    const bf16* HQ = (const bf16*)(ws + WS_S + S_HQ); const bf16* HK = (const bf16*)(ws + WS_S + S_HK); const float* HGp = (const float*)(ws + WS_U);
    const bf16* HV = (const bf16*)(ws + WS_S + S_HV); bf16* OF = (bf16*)(ws + WS_S + S_OF);
    const int NS = G > 128 ? 64 : 0;
    const int first = vcu < NS ? vcu : NS + (vcu - NS), step = vcu < NS ? 1088 : G - NS;
    const int reps = ((DBG_REP_MASK >> 16) & 1) && vcu < NS ? 3 : ((DBG_REP_MASK >> 17) & 1) && vcu >= NS ? 3 : 1;
    for (int rep_ = 0; rep_ < reps; ++rep_)
    for (int ci = first; ci < 1088; ci += step) {
        const bool lat = ci < 64; const int e = lat ? ci : ci - 64, b = e >> 5, d = (e >> 4) & 1, h = e & 15;
        const size_t so = ((size_t)((b * 2 + d) * 16 + h)) * 16384;
        hg::Chain ch{lat ? MP + b * 2048 : b * 256, lat ? 2048 : 256, d, h, lat ? a.in[I_SHG] + so : nullptr, lat ? nullptr : out + O_HG + so};
        hg::scan_chain(ch, HQ, HK + (size_t)d * MALL * DM, HGp + (size_t)d * MALL * DM, HV, OF + (size_t)d * MALL * DM, lds, tid);
    }
}

__device__ __forceinline__ void hg_thin_c(const Args& a, int lane, int gw, int NGW) {
    OPAQUE_V(lane); PH_PTRS; OPAQUE_S(gw); OPAQUE_S(NGW);
    const bf16* OF = (const bf16*)(ws + WS_S + S_OF); const bf16* HGS = (const bf16*)(ws + WS_S + S_HGS); bf16* AO = (bf16*)(ws + WS_S + S_AO);
    const int grp = lane >> 4, s = lane & 15;
    const f32x4 g0 = *(const GAS f32x4*)(a.in[I_GHO] + 8 * s), g1 = *(const GAS f32x4*)(a.in[I_GHO] + 8 * s + 4);
    for (int it = gw; it < MALL * 4; it += NGW) {
        const int row = it >> 2, h = (it & 3) * 4 + grp; const size_t o_ = (size_t)row * DM + h * 128 + 8 * s;
        const v4u of = __builtin_nontemporal_load((const GAS v4u*)(OF + o_)), ob = __builtin_nontemporal_load((const GAS v4u*)(OF + (size_t)MALL * DM + o_));
        const f32x4 a0 = (f32x4){bf_lo(of.x) + bf_lo(ob.x), bf_hi(of.x) + bf_hi(ob.x), bf_lo(of.y) + bf_lo(ob.y), bf_hi(of.y) + bf_hi(ob.y)}, a1 = (f32x4){bf_lo(of.z) + bf_lo(ob.z), bf_hi(of.z) + bf_hi(ob.z), bf_lo(of.w) + bf_lo(ob.w), bf_hi(of.w) + bf_hi(ob.w)};
        float ss = (a0.x * a0.x + a0.y * a0.y) + (a0.z * a0.z + a0.w * a0.w) + (a1.x * a1.x + a1.y * a1.y) + (a1.z * a1.z + a1.w * a1.w);
        const float rs = rsqrtf(sum16(ss) * (1.f / 128.f) + EPS);
        const v4u gw_ = __builtin_nontemporal_load((const GAS v4u*)(HGS + o_));
        const f32x4 y0 = a0 * rs * g0 * (f32x4){bf_lo(gw_.x), bf_hi(gw_.x), bf_lo(gw_.y), bf_hi(gw_.y)}, y1 = a1 * rs * g1 * (f32x4){bf_lo(gw_.z), bf_hi(gw_.z), bf_lo(gw_.w), bf_hi(gw_.w)};
        *(GAS v4u*)(AO + o_) = (v4u){pk2(y0.x, y0.y), pk2(y0.z, y0.w), pk2(y1.x, y1.y), pk2(y1.z, y1.w)};
    }
}
namespace pg8 {
struct EpiNat {
    static constexpr bool PERM = true;
    bf16_t* QKV; bf16_t* KN; float* outk; float* outv; const float* gk; PG8_LAS float* tab;
    __device__ __forceinline__ void operator()(const f32x4 (&acc)[2][2][4][2], const Unit& u, int wr, int wc, int fr, int fq) const {
        const int region = u.pn >> 3, row0 = u.pm * BM + wr * 64 + fr, ct = (u.pn & 7) * BM + wc * 32 + 8 * fq;
        if (region == 1) {
#pragma unroll
            for (int ai = 0; ai < 2; ++ai)
#pragma unroll
                for (int m = 0; m < 4; ++m)
#pragma unroll
                    for (int bj = 0; bj < 2; ++bj) { const f32x4 a = acc[ai][bj][m][0], b = acc[ai][bj][m][1];
                        float s = (a[0] * a[0] + a[1] * a[1]) + (a[2] * a[2] + a[3] * a[3]) + (b[0] * b[0] + b[1] * b[1]) + (b[2] * b[2] + b[3] * b[3]);
                        s += __shfl_xor(s, 16); s += __shfl_xor(s, 32);
                        if (fq == 0) tab[((ai * HALF + wr * 64 + m * 16 + fr) * 2 + bj) * 4 + wc] = s; }
            asm volatile("s_waitcnt lgkmcnt(0)" ::: "memory"); __builtin_amdgcn_s_barrier(); asm volatile("" ::: "memory");
            f32x4 g0[2], g1[2];
#pragma unroll
            for (int bj = 0; bj < 2; ++bj) { g0[bj] = *(const PG8_GAS f32x4*)(gk + wc * 32 + 8 * fq); g1[bj] = *(const PG8_GAS f32x4*)(gk + wc * 32 + 8 * fq + 4); }
#pragma unroll
            for (int ai = 0; ai < 2; ++ai)
#pragma unroll
                for (int m = 0; m < 4; ++m) { const int row = row0 + ai * HALF + m * 16;
#pragma unroll
                    for (int bj = 0; bj < 2; ++bj) { const f32x4 p = *(const PG8_LAS f32x4*)(tab + ((ai * HALF + wr * 64 + m * 16 + fr) * 2 + bj) * 4);
                        const float rs = rsqrtf(((p[0] + p[1]) + (p[2] + p[3])) * (1.f / 128.f) + 1e-6f);
                        const f32x4 k0 = acc[ai][bj][m][0] * rs * g0[bj], k1 = acc[ai][bj][m][1] * rs * g1[bj];
                        u32x4 w; w.x = cvt_pk_bf16(k0[0], k0[1]); w.y = cvt_pk_bf16(k0[2], k0[3]); w.z = cvt_pk_bf16(k1[0], k1[1]); w.w = cvt_pk_bf16(k1[2], k1[3]);
                        *(PG8_GAS u32x4*)(KN + (size_t)row * 2048 + ct + bj * HALF) = w;
                        if (row < 8192) { __builtin_nontemporal_store(k0 * DBG_SCALE, (PG8_GAS f32x4*)(outk + (size_t)row * 2048 + ct + bj * HALF)); __builtin_nontemporal_store(k1 * DBG_SCALE, (PG8_GAS f32x4*)(outk + (size_t)row * 2048 + ct + bj * HALF + 4)); } } }
        } else {
#pragma unroll
            for (int ai = 0; ai < 2; ++ai)
#pragma unroll
                for (int m = 0; m < 4; ++m) { const int row = row0 + ai * HALF + m * 16;
#pragma unroll
                    for (int bj = 0; bj < 2; ++bj) { const f32x4 v0 = acc[ai][bj][m][0], v1 = acc[ai][bj][m][1];
                        u32x4 w; w.x = cvt_pk_bf16(v0[0], v0[1]); w.y = cvt_pk_bf16(v0[2], v0[3]); w.z = cvt_pk_bf16(v1[0], v1[1]); w.w = cvt_pk_bf16(v1[2], v1[3]);
                        *(PG8_GAS u32x4*)(QKV + (size_t)row * 6144 + region * 2048 + ct + bj * HALF) = w;
                        if (region == 2 && row < 8192) { __builtin_nontemporal_store(v0 * DBG_SCALE, (PG8_GAS f32x4*)(outv + (size_t)row * 2048 + ct + bj * HALF)); __builtin_nontemporal_store(v1 * DBG_SCALE, (PG8_GAS f32x4*)(outv + (size_t)row * 2048 + ct + bj * HALF + 4)); } } }
        }
    }
};
}
__device__ __forceinline__ void nat_cache_rows(const Args& a, int lane, int gw, int NGW) {
    OPAQUE_V(lane); PH_PTRS; OPAQUE_S(gw); OPAQUE_S(NGW);
    bf16* QKV = (bf16*)(ws + WS_S + S_NQKV); bf16* KN = (bf16*)(ws + WS_S + S_NKN);
    for (int it = gw; it < 512 * 4; it += NGW) {
        const int row = MALL + (it >> 2), c = (it & 3) * 512 + 8 * lane; const size_t so = (size_t)(row - MALL) * DM + c;
        const f32x4 k0 = *(const GAS f32x4*)(a.in[I_CNK] + so), k1 = *(const GAS f32x4*)(a.in[I_CNK] + so + 4), v0 = *(const GAS f32x4*)(a.in[I_CNV] + so), v1 = *(const GAS f32x4*)(a.in[I_CNV] + so + 4);
        *(GAS v4u*)(KN + (size_t)row * DM + c) = (v4u){pk2(k0.x, k0.y), pk2(k0.z, k0.w), pk2(k1.x, k1.y), pk2(k1.z, k1.w)};
        *(GAS v4u*)(QKV + (size_t)row * 6144 + 4096 + c) = (v4u){pk2(v0.x, v0.y), pk2(v0.z, v0.w), pk2(v1.x, v1.y), pk2(v1.z, v1.w)};
    }
}
__device__ __forceinline__ void nat_attn_phase(const Args& a, LAS unsigned char* lds, int tid, int vcu, int G) {
    OPAQUE_V(tid); PH_PTRS; OPAQUE_S(vcu); OPAQUE_S(G);
    const bf16* QKV = (const bf16*)(ws + WS_S + S_NQKV); const bf16* KN = (const bf16*)(ws + WS_S + S_NKN); bf16* AO = (bf16*)(ws + WS_S + S_AO); const float* gq = a.in[I_GNQ];
    LAS float* rpb = (LAS float*)(lds + att::RPB_OFF);
    for (int u = vcu; u < 768; u += G) {
        if (u < 256) {
            const int b = u >> 7, h = (u >> 3) & 15, i = u & 7, q0 = MP + b * 2048 + i * 256;
            const int rlo = min(max(4 * i - 4, 0), 24), rhi = min(max(4 * i - 1, 0), 24) + 8, nrows = rhi - rlo;
            __syncthreads();
            for (int e = tid; e < 465; e += NTHR) rpb[e] = a.in[I_RPB][h * 465 + e] * 11.313708498984761f;
            __syncthreads();
            const att::KvSrc src{MALL + b * 256, 4, MP + b * 2048 + 64 * rlo, nrows};
            const att::NatMask nm{rlo, 4 * i + ((tid >> 6) >> 1), 32 * ((tid >> 6) & 1) + (tid & 31), rpb};
            att::attn_unit<128, 1, 6144, DM, 6144, DM, 1>(QKV + (size_t)q0 * 6144 + h * 128, KN + h * 128, QKV + 4096 + h * 128, AO + (size_t)q0 * DM + h * 128, src, 4 + nrows, nm, (LAS char*)lds, tid, gq, nullptr);
        } else {
            const int v = u - 256, b = v >> 4, h = v & 15, q0 = b * 256;
            const att::KvSrc src{b * 256, 4, 0, 1};
            att::attn_unit<128, 0, 6144, DM, 6144, DM, 1>(QKV + (size_t)q0 * 6144 + h * 128, KN + h * 128, QKV + 4096 + h * 128, AO + (size_t)q0 * DM + h * 128, src, 4, att::NatMask{0, 0, 0, nullptr}, (LAS char*)lds, tid, gq, nullptr);
        }
    }
}
constexpr int NPHASE = 2 + 10 * DEPTH;
__host__ __device__ constexpr bool phase_exists(int ph) {
    if (ph == 0 || ph == NPHASE - 1) return true;
    const int l = (ph - 1) / 10, k = (ph - 1) % 10, kind = l % 3;
    if (k == 2) return kind != 2;
    if (k == 3) return kind == 0;
    if (k == 4) return kind == 1;
    if (k == 5) return kind != 1;
    return true;
}

__global__ void __launch_bounds__(NTHR, 2) fwd(Args a) {
    extern __shared__ __attribute__((aligned(16))) unsigned char lds_[];
    LAS unsigned char* lds = (LAS unsigned char*)lds_;
#define tid ({ int t_ = threadIdx.x; asm volatile("" : "+v"(t_)); t_; })
#define lane (tid & 63)
#define wave (__builtin_amdgcn_readfirstlane(tid >> 6))
    const int G = gridDim.x, bx = blockIdx.x, vcu = (G % 8 == 0) ? (bx % 8) * (G / 8) + bx / 8 : bx;
    const int NGW = G * NWAVES;
#define gw (vcu * NWAVES + wave)
    volatile LAS unsigned* MISC = (volatile LAS unsigned*)(lds + MISC_OFF);
    unsigned* ctl = (unsigned*)(a.ws + WS_CTL);
    for (int u = tid; u < (LDS_BYTES - LDSCTL_OFF) / 4; u += NTHR) ((LAS unsigned*)(lds + LDSCTL_OFF))[u] = 0u;
    __syncthreads();
    XcdBarrier bar; bar.bar = ctl + CW_BAR; bar.x = 0; bar.st = nullptr;
    if (MK_SINGLE) bar = xcd_barrier_post(ctl + CW_BAR, MISC + 8);
    const int lo = a.ph_lo, hi = a.ph_hi;
#define IN(k) (lo <= (k) && (k) < hi)
#ifndef DBG_REP_MASK
#define DBG_REP_MASK 0
#endif
#define REPEAT(id) for (int rep_ = 0; rep_ < (((DBG_REP_MASK >> (id)) & 1) ? 3 : 1); ++rep_)
#if defined(DBG_PROF)
    { unsigned long long* prof = (unsigned long long*)((unsigned char*)ctl + WS_PROF); float* po_ = a.out;
      if (bx == 0 && tid == 0) { prof[200] = (unsigned long long)*(volatile unsigned*)(po_ + O_END - 1); prof[100] = wall_clock64(); prof[300] = clock64(); } }
#define SEAM(k) do { if (MK_SINGLE && (k) + 1 < hi) xcd_barrier(bar); if (bx == 0 && tid == 0) { unsigned long long* prof = (unsigned long long*)((unsigned char*)bar.bar - CW_BAR * 4 + WS_PROF); prof[100 + (k) + 1] = wall_clock64(); prof[300 + (k) + 1] = clock64(); } } while (0)
#else
#define SEAM(k) do { if (MK_SINGLE && (k) + 1 < hi) xcd_barrier(bar); } while (0)
#endif
#define GEMM_PTRS PH_PTRS; int gG = G, gbx = bx; OPAQUE_S(gG); OPAQUE_S(gbx); bf16* const H = (bf16*)(ws + WS_H); bf16* const U = (bf16*)(ws + WS_U); bf16* const AO = (bf16*)(ws + WS_S + S_AO); bf16* const X = (bf16*)(ws + WS_S + S_X); \
    const float* const MODS = (const float*)(ws + WS_MODS); (void)H; (void)U; (void)AO; (void)X; (void)MODS

#define CONVERT_WINDOW(lo_, hi_, nunits) do { const int from_ = (nunits) % gG; if (!from_ || gbx >= from_) p0_convert_range(a, lds, lo_, hi_, (gbx - from_) * NWAVES + wave, (gG - from_) * NWAVES, lane, wave); } while (0)

    if (IN(0)) { REPEAT(0) { p0_prologue(a, lds, tid, lane, wave, vcu, G); rope_table(a, tid, vcu, G); if (DBG_REP_MASK & 1) __syncthreads(); } SEAM(0); }

    for (int l = 0; l < DEPTH; ++l) {
        const int kind = l % 3, j = l / 3, pb = 1 + 10 * l;
        if (IN(pb + 0)) { REPEAT(1) norm_phase(a, l, false, l > 0 ? (const float*)(a.ws + WS_MODS) + (size_t)(l - 1) * 3 * NMOD + 5 * DM : nullptr, lane, gw, NGW); if (kind == 2) nat_cache_rows(a, lane, gw, NGW); SEAM(pb + 0); }
        if (kind == 0) {
            if (IN(pb + 1)) {
                GEMM_PTRS; unsigned char* wm = ws + WS_WMLA + (size_t)j * WMLA_STRIDE;
                pg8::Gemm g{H, (const bf16*)wm, MALL, 1536, DM, DM, DM, 1}; pg8::QaOrder S; S.init(gG, gbx, g.K);
                pg8::EpiBf16<0> E{(bf16*)(ws + WS_S + S_QAKV), 1536};
                REPEAT(2) pg8::gemm_phase<pg8::EpiBf16<0>, pg8::QaOrder>(lds, g, S, E);
                CONVERT_WINDOW(a.wstart[l + 1], a.wmid[l + 1], 288);
                SEAM(pb + 1);
            }
            if (IN(pb + 2)) { REPEAT(3) mla_thin_a(a, j, lane, gw, NGW); SEAM(pb + 2); }
            if (IN(pb + 3)) {
                GEMM_PTRS; unsigned char* wm = ws + WS_WMLA + (size_t)j * WMLA_STRIDE;
                REPEAT(4) {
                { pg8::Gemm g{(const bf16*)(ws + WS_S + S_QAN), (const bf16*)(wm + WMLA_QB), MALL, 3072, 768, 768, 768, 1}; pg8::StaticOrder S; S.init(MALL, 3072, 1, gG, gbx, g.K);
                  pg8::EpiBf16<0> E{(bf16*)(ws + WS_S + S_QRAW), 3072};
                  pg8::gemm_phase<pg8::EpiBf16<0>, pg8::StaticOrder>(lds, g, S, E); }
                { pg8::Gemm g{(const bf16*)(ws + WS_S + S_CKVN), (const bf16*)(wm + WMLA_KVB), MKV, 4096, 512, 512, 512, 1}; pg8::StaticOrder S; S.init(MKV, 4096, 1, gG, (gbx + gG / 2) % gG, g.K);
                  pg8::EpiKV E{(bf16*)(ws + WS_S + S_KVRAW), (bf16*)(ws + WS_S + S_KF), a.in[I_GKN] + (size_t)j * 192, (const float*)(ws + WS_S + S_KPE), (const float*)(ws + WS_SSK), (const float*)(ws + WS_ROPE), (LAS float*)(lds + EPI_TAB_OFF)};
                  pg8::gemm_phase<pg8::EpiKV, pg8::StaticOrder>(lds, g, S, E); }
                }
                {
                    int p_ = gbx, np_ = gG;
                    if (gG == 256) { p_ = gbx < 64 ? -1 : gbx < 128 ? gbx - 64 : gbx < 160 ? -1 : gbx - 96; np_ = 160; }
                    if (p_ >= 0) p0_convert_range(a, lds, a.wmid[l + 1], a.wstart[l + 2], p_ * NWAVES + wave, np_ * NWAVES, lane, wave);
                }
                SEAM(pb + 3);
            }
            if (IN(pb + 5)) { REPEAT(6) mla_attn_phase(a, j, lds, tid, vcu, G); SEAM(pb + 5); }
        }
        if (kind == 1) {
            if (IN(pb + 1)) {
                GEMM_PTRS;
                pg8::Gemm g{H, (const bf16*)(ws + WS_WHG), MALL, 10240, DM, DM, DM, 1}; pg8::StaticOrder S; S.init(MALL, 10240, 1, gG, gbx, g.K);
                pg8::EpiHg E{ws};
                REPEAT(8) pg8::gemm_phase<pg8::EpiHg, pg8::StaticOrder, false>(lds, g, S, E);
                CONVERT_WINDOW(a.wstart[l + 1], a.wstart[l + 2], 1920);
                SEAM(pb + 1);
            }
            if (IN(pb + 2)) { REPEAT(9) hg_scan_phase(a, lds, tid, vcu, G); SEAM(pb + 2); }
            if (IN(pb + 4)) { REPEAT(10) hg_thin_c(a, lane, gw, NGW); SEAM(pb + 4); }
        }
        if (kind == 2) {
            if (IN(pb + 1)) {
                GEMM_PTRS;
                pg8::Gemm g{H, (const bf16*)(ws + WS_WNAT), MALL, 6144, DM, DM, DM, 1}; pg8::StaticOrder S; S.init(MALL, 6144, 1, gG, gbx, g.K);
                pg8::EpiNat E{(bf16*)(ws + WS_S + S_NQKV), (bf16*)(ws + WS_S + S_NKN), out + O_NK, out + O_NV, a.in[I_GNK], (LAS float*)(lds + EPI_TAB_OFF)};
                REPEAT(11) pg8::gemm_phase<pg8::EpiNat, pg8::StaticOrder>(lds, g, S, E);
                CONVERT_WINDOW(a.wstart[l + 1], a.wstart[l + 2], 1152);
                SEAM(pb + 1);
            }
            if (IN(pb + 5)) { REPEAT(13) nat_attn_phase(a, lds, tid, vcu, G); SEAM(pb + 5); }
        }
        if (IN(pb + 6)) {
            GEMM_PTRS;
            const bf16* wo = (const bf16*)(kind == 0 ? ws + WS_WMLA + (size_t)j * WMLA_STRIDE + WMLA_WO : kind == 1 ? ws + WS_WHG + WHG_WO : ws + WS_WNAT + WNAT_WO);
            pg8::Gemm g{AO, wo, MALL, DM, DM / 2, DM, DM, 2}; pg8::ResOrder S; S.init(gG, gbx, DM);
            pg8::EpiRes2 E{X, MODS + (size_t)l * 3 * NMOD + 2 * DM, (bf16*)(ws + WS_S + S_PART), nullptr};
            pg8::gemm_phase<pg8::EpiRes2, pg8::ResOrder>(lds, g, S, E);
            SEAM(pb + 6);
        }
        if (IN(pb + 7)) { REPEAT(1) norm_phase(a, l, true, (const float*)(a.ws + WS_MODS) + (size_t)l * 3 * NMOD + 2 * DM, lane, gw, NGW); SEAM(pb + 7); }
        if (IN(pb + 8)) {
            GEMM_PTRS;
            pg8::Gemm g{H, (const bf16*)(ws + WS_WFF1) + (size_t)l * DM * FF, MALL, FF, DM, DM, DM, 1}; pg8::StaticOrder S; S.init(MALL, FF, 1, gG, gbx, g.K);
            pg8::EpiBf16<1> E{U, FF};
            REPEAT(7) pg8::gemm_phase<pg8::EpiBf16<1>, pg8::StaticOrder>(lds, g, S, E);
            SEAM(pb + 8);
        }
        if (IN(pb + 9)) {
            GEMM_PTRS;
            pg8::Gemm g{U, (const bf16*)(ws + WS_WFF2) + (size_t)l * DM * FF, MALL, DM, FF / 2, FF, FF, 2}; pg8::ResOrder S; S.init(gG, gbx, FF);
            pg8::EpiRes2 E{X, MODS + (size_t)l * 3 * NMOD + 5 * DM, (bf16*)(ws + WS_S + S_PART), l + 1 == DEPTH ? out + O_X : nullptr};
            pg8::gemm_phase<pg8::EpiRes2, pg8::ResOrder>(lds, g, S, E);
            SEAM(pb + 9);
        }
    }
    if (IN(NPHASE - 1)) final_fix_phase(a, (const float*)(a.ws + WS_MODS) + (size_t)(DEPTH - 1) * 3 * NMOD + 5 * DM, lane, gw, NGW);
#if defined(DBG_PROF)
    xcd_barrier(bar);
    { unsigned long long* prof = (unsigned long long*)((unsigned char*)bar.bar - CW_BAR * 4 + WS_PROF); float* po_ = a.out;
    if (bx == 0) {
        if (tid == 0) { prof[100 + NPHASE] = wall_clock64(); prof[300 + NPHASE] = clock64(); }
        __syncthreads();
        if (tid == 0) { constexpr int p = DBG_PROF; const unsigned long long dw = prof[100 + p + 1] - prof[100 + p], dc = prof[300 + p + 1] - prof[300 + p];
            float mant = (float)dw * 1e-4f; mant = mant < 1.f ? 1.f : mant > 9.9f ? 9.9f : mant; const int expo = dw ? (int)(dc / dw) : 0;
            po_[O_X + 7] = mant * __builtin_powif(10.f, expo); }
    } }
#endif
#undef IN
#undef SEAM
#undef tid
#undef lane
#undef wave
#undef gw
}

extern "C" void kernel_launch(void* const* d_in, const int* in_sizes, int n_in, void* d_out, int out_size, void* d_ws, size_t ws_size, hipStream_t stream) {
    static int grid = 0;
    if (grid == 0) {
        if (n_in != N_IN || (size_t)out_size != O_END || ws_size < WS_END) { fprintf(stderr, "kernel_launch: shape mismatch n_in %d out %d ws %zu (need %zu); nothing launched\n", n_in, out_size, ws_size, (size_t)WS_END); grid = -1; return; }
        int dev = 0, cus = 0, per_cu = 0;
        if (hipGetDevice(&dev) != hipSuccess || hipDeviceGetAttribute(&cus, hipDeviceAttributeMultiprocessorCount, dev) != hipSuccess) { fprintf(stderr, "kernel_launch: device query failed\n"); grid = -1; return; }
        if (hipFuncSetAttribute((const void*)fwd, hipFuncAttributeMaxDynamicSharedMemorySize, LDS_BYTES) != hipSuccess) { fprintf(stderr, "kernel_launch: hipFuncSetAttribute failed\n"); grid = -1; return; }
        if (hipOccupancyMaxActiveBlocksPerMultiprocessor(&per_cu, (const void*)fwd, NTHR, LDS_BYTES) != hipSuccess || per_cu < 1) { fprintf(stderr, "kernel_launch: occupancy query says %d blocks/CU\n", per_cu); }
        (void)hipGetLastError();
        grid = cus;
    }
    if (grid < 0) return;
    if (hipMemsetAsync((char*)d_ws + WS_CTL, 0, CTL_ZERO_BYTES, stream) != hipSuccess) { fprintf(stderr, "kernel_launch: memset failed\n"); return; }
    Args a{};
    for (int i = 0; i < N_IN; ++i) a.in[i] = (const float*)d_in[i];
    a.out = (float*)d_out; a.ws = (unsigned char*)d_ws;
    int nt = 0, items = 0;
    auto add = [&](const float* src, size_t dst_off, int K, int N, int row_off) { TJob& t = a.tj[nt++]; t.src = src; t.dst = (bf16*)((unsigned char*)d_ws + dst_off); t.K = K; t.N = N; t.row_off = row_off; t.start = items; items += (K / 64) * (N / 32); };
    auto add_mla_a = [&](int j) { const size_t wb = WS_WMLA + (size_t)j * WMLA_STRIDE;
        add(a.in[I_WQA] + (size_t)j * DM * 768, wb, DM, 768, 0); add(a.in[I_WKVA] + (size_t)j * DM * 576, wb, DM, 576, 768); };
    auto add_mla_b = [&](int j) { const size_t wb = WS_WMLA + (size_t)j * WMLA_STRIDE;
        add(a.in[I_WQB] + (size_t)j * 768 * 3072, wb + WMLA_QB, 768, 3072, 0); add(a.in[I_WKVB] + (size_t)j * 512 * 4096, wb + WMLA_KVB, 512, 4096, 0);
        add(a.in[I_WMO] + (size_t)j * DM * DM, wb + WMLA_WO, DM, DM, 0); };
    auto add_mixer = [&](int l) {
        if (l % 3 == 0) { add_mla_a(l / 3); add_mla_b(l / 3); }
        if (l % 3 == 1) { add(a.in[I_WHQ], WS_WHG, DM, DM, 0); add(a.in[I_WHF], WS_WHG, DM, DM, 2048); add(a.in[I_WHF] + (size_t)DM * DM, WS_WHG, DM, DM, 4096);
            add(a.in[I_WHI], WS_WHG, DM, DM, 6144); add(a.in[I_WHG], WS_WHG, DM, DM, 8192); add(a.in[I_WHO], WS_WHG + WHG_WO, DM, DM, 0); }
        if (l % 3 == 2) { add(a.in[I_WNQKV], WS_WNAT, DM, 3 * DM, 0); add(a.in[I_WNO], WS_WNAT + WNAT_WO, DM, DM, 0); } };
    a.wstart[0] = 0; add_mla_a(0);
    for (int l = 0; l < DEPTH; ++l) {
        a.wstart[l + 1] = items;
        if (l % 3 == 0) add_mla_b(l / 3);
        add(a.in[I_WFF1] + (size_t)l * DM * FF, WS_WFF1 + (size_t)l * DM * FF * 2, DM, FF, 0); add(a.in[I_WFF2] + (size_t)l * DM * FF, WS_WFF2 + (size_t)l * DM * FF * 2, FF, DM, 0);
        if (l + 1 < DEPTH) { if ((l + 1) % 3 == 0) add_mla_a((l + 1) / 3); else add_mixer(l + 1); }
    }
    for (int w = DEPTH + 1; w < 8; ++w) a.wstart[w] = items;
    for (int w = 0; w < 8; ++w) a.wmid[w] = a.wstart[w];
    for (int l = 0; l < DEPTH; ++l) if (l % 3 == 0) {
        const int from = 288 % grid, part = (from ? grid - from : grid) * NWAVES; long n = (long)WQA * part; const long tot = a.wstart[l + 2] - a.wstart[l + 1]; if (n > tot) n = tot;
        a.wmid[l + 1] = a.wstart[l + 1] + (int)n; }
    a.ntj = nt; a.nitems = items;
#if MK_SINGLE
    a.ph_lo = 0; a.ph_hi = NPHASE < MK_LAST_PHASE ? NPHASE : MK_LAST_PHASE;
    hipLaunchKernelGGL(fwd, dim3(grid), dim3(NTHR), LDS_BYTES, stream, a);
#else
    for (int ph = 0; ph < NPHASE && ph < MK_LAST_PHASE; ++ph) {
        if (!phase_exists(ph)) continue;
        a.ph_lo = ph; a.ph_hi = ph + 1;
        hipLaunchKernelGGL(fwd, dim3(grid), dim3(NTHR), LDS_BYTES, stream, a);
    }
#endif
    const hipError_t le = hipPeekAtLastError();
    if (le != hipSuccess) fprintf(stderr, "kernel_launch: launch failed: %s\n", hipGetErrorName(le));
}
```

```cpp
#define MK_SINGLE 1
#define MK_LAST_PHASE 1000
#include <hip/hip_runtime.h>
#include <cstdio>
#include <cstdint>

#ifndef MK_SINGLE
#define MK_SINGLE 1
#endif
#ifndef WQA
#define WQA 16
#endif
#ifndef MK_LAST_PHASE
#define MK_LAST_PHASE 1000
#endif
namespace pg8 {
#define PG8_LAS __attribute__((address_space(3)))
#define PG8_GAS __attribute__((address_space(1)))
typedef unsigned short bf16_t;
typedef short bf16x8 __attribute__((ext_vector_type(8)));
typedef float f32x4 __attribute__((ext_vector_type(4)));
typedef unsigned u32x4 __attribute__((ext_vector_type(4)));
constexpr int BM = 256, BK = 64, HALF = 128, HTB = HALF * BK * 2  , STAGE_BYTES = 8 * HTB, NXCD = 8, WGM = 8;

__host__ __device__ __forceinline__ int lds_byte(int r, int c) { const int st = (r >> 4) * 2 + (c >> 5), rr = r & 15, cc = c & 31, ob = rr * 64 + cc * 2; return st * 1024 + (ob ^ (((ob >> 9) & 1) << 5)); }
__host__ __device__ __forceinline__ void stage_rc(int b, int& R, int& C) { const int st = b / 1024, sb = b % 1024, swz = sb ^ (((sb >> 9) & 1) << 5); R = (st >> 1) * 16 + swz / 64; C = (st & 1) * 32 + (swz % 64) / 2; }
__host__ __device__ __forceinline__ int perm32(int rho) { const int n = rho >> 4, i = rho & 15; return 8 * (i >> 2) + 4 * n + (i & 3); }

struct Unit { int pm, pn, ks, nkt, part, nh; };
struct Gemm { const bf16_t* A; const bf16_t* Bt; int M, N, K, lda, ldb, nsplit; };

struct StaticOrder {
    static constexpr bool HAS_NH = false;
    int nM, nN, nNv, nwg, G, c, nkt, split;
    __host__ __device__ void init(int M, int N, int nsplit, int G_, int c_, int K = 0) { nM = M / BM; nN = N / BM; nNv = nN * nsplit; nwg = nM * nNv; G = G_; c = c_; nkt = K / BK; split = nsplit; }
    __host__ __device__ bool next(int i, Unit& u) const {
        const long L = (long)i * G + c; if (L >= nwg) return false;
        int wgid = (int)L; { const int q = nwg / NXCD, r = nwg % NXCD, xcd = wgid % NXCD, off = wgid / NXCD; wgid = (xcd < r ? xcd * (q + 1) : r * (q + 1) + (xcd - r) * q) + off; }
        const int nig = WGM * nNv, gid = wgid / nig, fm = gid * WGM, gsz = (nM - fm) < WGM ? (nM - fm) : WGM;
        u.pm = fm + ((wgid % nig) % gsz); const int pv = (wgid % nig) / gsz; u.pn = pv % nN; u.ks = pv / nN; u.nkt = nkt; u.part = split > 1 ? u.ks : -1; u.nh = 0; return true;
    }
    __device__ __forceinline__ void a_ready(const Unit&) const {}
    __device__ __forceinline__ void done(const Unit&) const {}
};

struct QaOrder {
    static constexpr bool HAS_NH = true;
    StaticOrder M5; int G, c, nkt;
    __host__ __device__ void init(int G_, int c_, int K) { M5.init(12288, 1280, 1, G_, c_, K); G = G_; c = c_; nkt = K / BK; }
    __host__ __device__ bool next(int i, Unit& u) const {
        const int L = i * G + c;
        if (L < 240) return M5.next(i, u);
        if (L >= 288) return false;
        u.pm = L - 240; u.pn = 5; u.ks = 0; u.nkt = nkt; u.part = -1; u.nh = 1; return true;
    }
    __device__ __forceinline__ void a_ready(const Unit&) const {}
    __device__ __forceinline__ void done(const Unit&) const {}
};
struct ResOrder {
    static constexpr bool HAS_NH = false;
    int G, c, nkF, nkH;
    __host__ __device__ void init(int G_, int c_, int K) { G = G_; c = c_; nkF = K / BK; nkH = K / (2 * BK); }
    __host__ __device__ bool next(int i, Unit& u) const {
        const int L = i * G + c; if (L >= 512) return false;
        const bool half = L >= 256; int w = half ? L - 256 : L;
        w = (w & 7) * 32 + (w >> 3);
        const int sh = half ? 7 : 6, e = w & ((1 << sh) - 1), pv = e >> 3;
        u.pm = (half ? 32 : 0) + ((w >> sh) << 3) + (e & 7); u.pn = pv & 7; u.ks = pv >> 3; u.nkt = half ? nkH : nkF; u.part = half ? u.ks : -1; u.nh = 0; return true;
    }
    __device__ __forceinline__ void a_ready(const Unit&) const {}
    __device__ __forceinline__ void done(const Unit&) const {}
};

__device__ __forceinline__ unsigned cvt_pk_bf16(float lo, float hi) { unsigned r; asm("v_cvt_pk_bf16_f32 %0, %1, %2" : "=v"(r) : "v"(lo), "v"(hi)); return r; }


template <class Epi, class Sched, bool ALIGN_EPI = true, bool SP2 = true>
__device__ __forceinline__ void gemm_phase(PG8_LAS unsigned char* lds, const Gemm g, const Sched& S, const Epi& E) {
    int tid_ = threadIdx.x; asm volatile("" : "+v"(tid_));
    const int tid = tid_, wid = __builtin_amdgcn_readfirstlane(tid >> 6), lane = tid & 63, wr = wid >> 2, wc = wid & 3, fr = lane & 15, fq = lane >> 4;
    const int K = g.K;
    unsigned voffA[2], voffB[2];
#pragma unroll
    for (int i = 0; i < 2; ++i) { int R, C; stage_rc(tid * 16 + i * 8192, R, C); const int Rb = Epi::PERM ? ((R & ~31) + perm32(R & 31)) : R;
        voffA[i] = (unsigned)(R * g.lda + C) * 2u; voffB[i] = (unsigned)(Rb * g.ldb + C) * 2u; }
    const size_t kstep = (size_t)(BK * 2);
    const size_t hstepA = (size_t)HALF * g.lda * 2, hstepB = (size_t)HALF * g.ldb * 2;
    const size_t tstepA = 2 * hstepA, tstepB = 2 * hstepB;
    const size_t sstep = (size_t)K * 2;
    const unsigned ldsw = (unsigned)wid * 1024u;
    const int aoff = lds_byte(wr * 64 + fr, fq * 8), boff = lds_byte(wc * 32 + fr, fq * 8);
#define PG8_SA(b, h) (((b) * 2 + (h)) * HTB)
#define PG8_SB(b, h) ((4 + (b) * 2 + (h)) * HTB)
#define PG8_STAGE(bufoff, gbase, voff) do { _Pragma("unroll") for (int _i = 0; _i < 2; ++_i) \
        __builtin_amdgcn_global_load_lds((const unsigned*)((const char*)(gbase) + (voff)[_i]), (PG8_LAS unsigned*)(lds + (bufoff) + ldsw + _i * 8192), 16, 0, 0); } while (0)
#define PG8_LDA(dst, b, h) do { _Pragma("unroll") for (int m = 0; m < 4; ++m) _Pragma("unroll") for (int k = 0; k < 2; ++k) dst[m][k] = *(const PG8_LAS bf16x8*)(lds + PG8_SA(b, h) + aoff + m * 2048 + k * 1024); } while (0)
#define PG8_LDB(dst, b, h) do { _Pragma("unroll") for (int n = 0; n < 2; ++n) _Pragma("unroll") for (int k = 0; k < 2; ++k) dst[n][k] = *(const PG8_LAS bf16x8*)(lds + PG8_SB(b, h) + boff + n * 2048 + k * 1024); } while (0)
#define PG8_MMA(ai, bj, At, Bt) do { __builtin_amdgcn_s_setprio(1); _Pragma("unroll") for (int m = 0; m < 4; ++m) _Pragma("unroll") for (int n = 0; n < 2; ++n) _Pragma("unroll") for (int k = 0; k < 2; ++k) \
        acc[ai][bj][m][n] = __builtin_amdgcn_mfma_f32_16x16x32_bf16(Bt[n][k], At[m][k], acc[ai][bj][m][n], 0, 0, 0); __builtin_amdgcn_s_setprio(0); } while (0)
#define PG8_WAIT_V(n) asm volatile("s_waitcnt vmcnt(" #n ")" ::: "memory")
#define PG8_WAIT_L(n) asm volatile("s_waitcnt lgkmcnt(" #n ")" ::: "memory")
#define PG8_BAR __builtin_amdgcn_s_barrier()
#define PG8_SCHED __builtin_amdgcn_sched_barrier(0)
    Unit cur, nxt; int ui = 0;
    if (!S.next(0, cur)) return;
    f32x4 acc[2][2][4][2];
#pragma unroll
    for (int a = 0; a < 2; ++a)
#pragma unroll
        for (int b = 0; b < 2; ++b)
#pragma unroll
            for (int m = 0; m < 4; ++m)
#pragma unroll
                for (int n = 0; n < 2; ++n) acc[a][b][m][n] = (f32x4){0.f, 0.f, 0.f, 0.f};
    bf16x8 At[4][2], B0[2][2], B1[2][2];
    const char* cA = (const char*)g.A + (size_t)cur.pm * tstepA + (size_t)cur.ks * sstep; const char* cB = (const char*)g.Bt + (size_t)cur.pn * tstepB + (size_t)cur.ks * sstep;
    S.a_ready(cur);
    if constexpr (SP2) {
        PG8_STAGE(PG8_SB(0, 0), cB, voffB); PG8_STAGE(PG8_SB(0, 1), cB + hstepB, voffB); PG8_STAGE(PG8_SA(0, 0), cA, voffA); PG8_STAGE(PG8_SA(0, 1), cA + hstepA, voffA);
        if (wr == 1) PG8_BAR;
        PG8_WAIT_V(2); PG8_BAR;
        PG8_STAGE(PG8_SB(1, 0), cB + kstep, voffB); PG8_STAGE(PG8_SA(1, 0), cA + kstep, voffA); PG8_STAGE(PG8_SB(1, 1), cB + hstepB + kstep, voffB);
        PG8_WAIT_V(6); PG8_BAR;
    } else {
        PG8_STAGE(PG8_SB(0, 0), cB, voffB); PG8_STAGE(PG8_SA(0, 0), cA, voffA); PG8_STAGE(PG8_SB(0, 1), cB + hstepB, voffB); PG8_STAGE(PG8_SA(0, 1), cA + hstepA, voffA);
        if (wr == 1) PG8_BAR;
        PG8_WAIT_V(4); PG8_BAR;
        PG8_STAGE(PG8_SB(1, 0), cB + kstep, voffB); PG8_STAGE(PG8_SA(1, 0), cA + kstep, voffA); PG8_STAGE(PG8_SB(1, 1), cB + hstepB + kstep, voffB);
        PG8_WAIT_V(6); PG8_BAR;
    }
    for (;;) {
        const bool has_next = S.next(ui + 1, nxt);
        const char* nA = has_next ? (const char*)g.A + (size_t)nxt.pm * tstepA + (size_t)nxt.ks * sstep : cA; const char* nB = has_next ? (const char*)g.Bt + (size_t)nxt.pn * tstepB + (size_t)nxt.ks * sstep : cB;
        const int nt = cur.nkt; const bool nh = cur.nh != 0;
        for (int t = 0; t < nt; t += 2) {
            const bool last = (t == nt - 2);
            const char* a1 = cA + (size_t)(t + 1) * kstep;
            const char* a2 = last ? nA : cA + (size_t)(t + 2) * kstep; const char* b2 = last ? nB : cB + (size_t)(t + 2) * kstep;
            const char* a3 = a2 + kstep; const char* b3 = b2 + kstep;
            if (last && has_next) S.a_ready(nxt);
            if constexpr (SP2) {
            PG8_LDB(B0, 0, 0); PG8_LDB(B1, 0, 1); PG8_SCHED; PG8_LDA(At, 0, 0); PG8_STAGE(PG8_SA(1, 1), a1 + hstepA, voffA);
            PG8_WAIT_V(8); PG8_WAIT_L(0); PG8_BAR; PG8_MMA(0, 0, At, B0); if (!Sched::HAS_NH || !nh) PG8_MMA(0, 1, At, B1); PG8_BAR; PG8_SCHED;
            PG8_LDA(At, 0, 1); PG8_STAGE(PG8_SB(0, 0), b2, voffB); PG8_STAGE(PG8_SB(0, 1), b2 + hstepB, voffB); PG8_STAGE(PG8_SA(0, 0), a2, voffA);
            PG8_WAIT_V(8); PG8_WAIT_L(0); PG8_BAR; PG8_MMA(1, 0, At, B0); if (!Sched::HAS_NH || !nh) PG8_MMA(1, 1, At, B1); PG8_BAR; PG8_SCHED;
            PG8_LDB(B0, 1, 0); PG8_LDB(B1, 1, 1); PG8_SCHED; PG8_LDA(At, 1, 0); PG8_STAGE(PG8_SA(0, 1), a2 + hstepA, voffA);
            PG8_WAIT_V(8); PG8_WAIT_L(0); PG8_BAR; PG8_MMA(0, 0, At, B0); if (!Sched::HAS_NH || !nh) PG8_MMA(0, 1, At, B1); PG8_BAR; PG8_SCHED;
            PG8_LDA(At, 1, 1); PG8_STAGE(PG8_SB(1, 0), b3, voffB); PG8_STAGE(PG8_SB(1, 1), b3 + hstepB, voffB); PG8_STAGE(PG8_SA(1, 0), a3, voffA);
            PG8_WAIT_V(8); PG8_WAIT_L(0); PG8_BAR; PG8_MMA(1, 0, At, B0); if (!Sched::HAS_NH || !nh) PG8_MMA(1, 1, At, B1); PG8_BAR; PG8_SCHED;
            } else {
            PG8_LDB(B0, 0, 0); PG8_SCHED; PG8_LDA(At, 0, 0); PG8_STAGE(PG8_SA(1, 1), a1 + hstepA, voffA);
            PG8_WAIT_L(8); PG8_BAR; PG8_WAIT_L(0); PG8_MMA(0, 0, At, B0); PG8_BAR; PG8_SCHED;
            PG8_LDB(B1, 0, 1); PG8_STAGE(PG8_SB(0, 0), b2, voffB);
            PG8_BAR; PG8_WAIT_L(0); PG8_MMA(0, 1, At, B1); PG8_BAR;
            PG8_LDA(At, 0, 1); PG8_STAGE(PG8_SA(0, 0), a2, voffA);
            PG8_BAR; PG8_WAIT_L(0); PG8_MMA(1, 0, At, B0); PG8_BAR; PG8_SCHED;
            PG8_STAGE(PG8_SB(0, 1), b2 + hstepB, voffB);
            PG8_WAIT_V(6); PG8_BAR; PG8_MMA(1, 1, At, B1); PG8_BAR;
            PG8_LDB(B0, 1, 0); PG8_SCHED; PG8_LDA(At, 1, 0); PG8_STAGE(PG8_SA(0, 1), a2 + hstepA, voffA);
            PG8_WAIT_L(8); PG8_BAR; PG8_WAIT_L(0); PG8_MMA(0, 0, At, B0); PG8_BAR; PG8_SCHED;
            PG8_LDB(B1, 1, 1); PG8_STAGE(PG8_SB(1, 0), b3, voffB);
            PG8_BAR; PG8_WAIT_L(0); PG8_MMA(0, 1, At, B1); PG8_BAR;
            PG8_LDA(At, 1, 1); PG8_STAGE(PG8_SA(1, 0), a3, voffA);
            PG8_BAR; PG8_WAIT_L(0); PG8_MMA(1, 0, At, B0); PG8_BAR; PG8_SCHED;
            PG8_STAGE(PG8_SB(1, 1), b3 + hstepB, voffB);
            PG8_WAIT_V(6); PG8_BAR; PG8_MMA(1, 1, At, B1); PG8_BAR;
            }
        }
        if constexpr (ALIGN_EPI) { if (wr == 0) PG8_BAR; }
        E(acc, cur, wr, wc, fr, fq); S.done(cur);
        if (!has_next) break;
#pragma unroll
        for (int a = 0; a < 2; ++a)
#pragma unroll
            for (int b = 0; b < 2; ++b)
#pragma unroll
                for (int m = 0; m < 4; ++m)
#pragma unroll
                    for (int n = 0; n < 2; ++n) acc[a][b][m][n] = (f32x4){0.f, 0.f, 0.f, 0.f};
        cur = nxt; cA = nA; cB = nB; ++ui;
        if constexpr (ALIGN_EPI) { if (wr == 1) PG8_BAR; }
    }
    PG8_WAIT_V(0);
    if constexpr (!ALIGN_EPI) { if (wr == 0) PG8_BAR; }
    PG8_BAR;
#undef PG8_SA
#undef PG8_SB
#undef PG8_STAGE
#undef PG8_LDA
#undef PG8_LDB
#undef PG8_MMA
#undef PG8_WAIT_V
#undef PG8_WAIT_L
#undef PG8_BAR
#undef PG8_SCHED
}
}
constexpr int DM = 2048, MP = 8192, MS = 4096, MALL = 12288, MKV = 12800, FF = 8192, NMOD = 12288;
constexpr int NWAVES = 8, NTHR = 512, DEPTH = 4;
constexpr float EPS = 1e-6f;
constexpr size_t O_X = 0, O_CKV = 25165824, O_KPE = 33554432, O_HG = 34603008, O_NK = 51380224, O_NV = 68157440, O_END = 84934656;
enum { I_XP = 0, I_XS, I_CCKV, I_CKPE, I_SHG, I_CNK, I_CNV, I_C, I_CCTX, I_WMOD, I_BMOD, I_GMIX, I_GFFN, I_WQA, I_GQA, I_WQB, I_GQN, I_WKVA, I_GKVA, I_WKVB, I_GKN, I_WMO,
       I_WHQ, I_WHF, I_HLB, I_WHI, I_WHG, I_GHO, I_WHO, I_WNQKV, I_GNQ, I_GNK, I_RPB, I_WNO, I_WFF1, I_WFF2, N_IN };

constexpr size_t MiB = 1u << 20;
constexpr size_t WS_CTL = 0, CTL_ZERO_BYTES = 65536;
constexpr size_t WS_MODS = 2 * MiB;
constexpr size_t WS_LB = 3 * MiB;
constexpr size_t WS_SSK = 3 * MiB + 65536;
constexpr size_t WS_PROF = 3 * MiB + 786432;
constexpr size_t WS_ROPE = 3 * MiB + 131072;
constexpr size_t WS_WFF1 = 4 * MiB, WS_WFF2 = 132 * MiB;
constexpr size_t WS_WMLA = 260 * MiB, WMLA_STRIDE = 24 * MiB;
constexpr size_t WMLA_QB = 6 * MiB, WMLA_KVB = 11 * MiB, WMLA_WO = 15 * MiB;
constexpr size_t WS_WHG = 308 * MiB, WHG_WO = 40 * MiB;
constexpr size_t WS_WNAT = 356 * MiB, WNAT_WO = 24 * MiB;
constexpr size_t WS_H = 388 * MiB;
constexpr size_t WS_U = 436 * MiB;
constexpr size_t WS_S = 628 * MiB;
constexpr size_t S_AO = 0;
constexpr size_t S_QAKV = 48 * MiB, S_QAN = 120 * MiB, S_CKVN = 138 * MiB, S_KPE = 151 * MiB, S_QRAW = 155 * MiB, S_KVRAW = 227 * MiB, S_QN = 327 * MiB, S_KF = 399 * MiB;
constexpr size_t S_HQ = 48 * MiB, S_HK = 96 * MiB, S_HV = 192 * MiB, S_HGS = 240 * MiB, S_OF = 288 * MiB;
constexpr size_t S_NQKV = 48 * MiB, S_NQN = 198 * MiB, S_NKN = 246 * MiB;
constexpr size_t S_PART = 480 * MiB;
constexpr size_t S_X = 512 * MiB;
constexpr size_t WS_END = WS_S + 560 * MiB;
constexpr int CW_TMO = 0, CW_CODE = 1, CW_BAR = 4096;

constexpr int RING_BYTES = 131072;
constexpr int LDSCTL_OFF = 163840 - 512, MISC_OFF = LDSCTL_OFF + 320;
constexpr int EPI_TAB_OFF = LDSCTL_OFF - 8192;
constexpr int LDS_BYTES = 163840;

#define GAS __attribute__((address_space(1)))
#define LAS __attribute__((address_space(3)))
typedef unsigned short bf16;
typedef unsigned v4u __attribute__((ext_vector_type(4)));
typedef unsigned v2u __attribute__((ext_vector_type(2)));
typedef float f32x4 __attribute__((ext_vector_type(4)));
typedef float f32x2 __attribute__((ext_vector_type(2)));
typedef short bf16x8 __attribute__((ext_vector_type(8)));
typedef GAS unsigned gu32;
#define RLX_AGENT __ATOMIC_RELAXED, __HIP_MEMORY_SCOPE_AGENT
#define LDS_WAIT() asm volatile("s_waitcnt lgkmcnt(0)" ::: "memory")
#define VM_WAIT() asm volatile("s_waitcnt vmcnt(0)" ::: "memory")
#ifndef DBG_SCALE
#define DBG_SCALE 1.0f
#endif
#define OPAQUE_S(x) asm volatile("" : "+s"(x))
#define PH_PTRS unsigned char* ws = a.ws; float* out = a.out; OPAQUE_S(ws); OPAQUE_S(out)
#define OPAQUE_V(x) asm volatile("" : "+v"(x))
__device__ __forceinline__ unsigned pk2(float lo, float hi) { unsigned r; asm("v_cvt_pk_bf16_f32 %0, %1, %2" : "=v"(r) : "v"(lo), "v"(hi)); return r; }
__device__ __forceinline__ float bf_lo(unsigned w) { return __uint_as_float(w << 16); }
__device__ __forceinline__ float bf_hi(unsigned w) { return __uint_as_float(w & 0xffff0000u); }
__device__ __forceinline__ float wave_sum(float v) {
#pragma unroll
    for (int o = 1; o < 64; o <<= 1) v += __shfl_xor(v, o);
    return v;
}
__device__ __forceinline__ float sum16(float v) {
#pragma unroll
    for (int o = 1; o < 16; o <<= 1) v += __shfl_xor(v, o);
    return v;
}

#define XB_TMO      128
#define XB_XCNT(j)  (256  + 64 * (j))
#define XB_XSUB(j)  (1280 + 64 * (j))
#define XB_XGEN(j)  (2304 + 64 * (j))
#define XB_TOP      3328
#define XB_TOPGEN   3392
#define XCD_BAR_WORDS 3456
#define XB_SPIN_CAP (1u << 18)
__device__ __forceinline__ unsigned xb_ld(unsigned* p)              { return __hip_atomic_load(p, __ATOMIC_RELAXED, __HIP_MEMORY_SCOPE_AGENT); }
__device__ __forceinline__ unsigned xb_add(unsigned* p, unsigned v) { return __hip_atomic_fetch_add(p, v, __ATOMIC_RELAXED, __HIP_MEMORY_SCOPE_AGENT); }
__device__ __forceinline__ unsigned xb_xcc_id() { return (unsigned)__builtin_amdgcn_s_getreg((3 << 11) | 20) & 0xFu; }
#define XB_SPIN(cond, bar) do { unsigned _sp = 0; while (cond) { __builtin_amdgcn_s_sleep(1); \
    if ((++_sp & 255u) == 0u) { if (xb_ld(&(bar)[XB_TMO])) break; if (_sp > XB_SPIN_CAP) { atomicAdd(&(bar)[XB_TMO], 1u); break; } } } } while (0)
struct XcdBarrier { unsigned* bar; unsigned x; volatile LAS unsigned* st; };
__device__ __forceinline__ XcdBarrier xcd_barrier_post(unsigned* bar, volatile LAS unsigned* st) {
    XcdBarrier b; b.bar = bar; b.x = xb_xcc_id(); b.st = st;
    if (threadIdx.x == 0) (void)xb_add(&bar[XB_XCNT(b.x)], 1u);
    return b;
}
__device__ __forceinline__ void xcd_barrier_complete(unsigned* bar, unsigned x, unsigned& nloc, unsigned& nx) {
    const unsigned G = gridDim.x * gridDim.y * gridDim.z;
    unsigned sum, cnt, mine, sp = 0u;
    for (;;) {
        sum = 0u; cnt = 0u; mine = 0u;
#pragma unroll
        for (unsigned j = 0; j < 16; ++j) { const unsigned c = xb_ld(&bar[XB_XCNT(j)]); sum += c; cnt += (c > 0u) ? 1u : 0u; mine = (j == x) ? c : mine; }
        if (sum == G) break;
        __builtin_amdgcn_s_sleep(1);
        if ((++sp & 255u) == 0u) { if (xb_ld(&bar[XB_TMO])) break; if (sp > XB_SPIN_CAP) { atomicAdd(&bar[XB_TMO], 1u); break; } }
    }
    nloc = mine > 0u ? mine : 1u; nx = cnt > 0u ? cnt : 1u;
}
#ifndef CODE_PF_BYTES
#define CODE_PF_BYTES 208896u
#endif
__device__ __forceinline__ void xb_code_prefetch(volatile LAS unsigned* st) {
    const unsigned lo = st[2], hi = st[3];
    const unsigned long long base = ((unsigned long long)hi << 32) | lo;
    unsigned t_ = threadIdx.x; asm volatile("" : "+v"(t_));
    unsigned o = ((blockIdx.x >> 3) & 31u) * (CODE_PF_BYTES / 32u) + (t_ - 64u) * 16u;
    o = o < CODE_PF_BYTES - 16u ? o : CODE_PF_BYTES - 16u;
    const f32x4 v = *(const GAS f32x4*)(base + o);
    asm volatile("" :: "v"(v));
}
__device__ __forceinline__ void xb_data_prefetch(volatile LAS unsigned* st, unsigned pitch) {
    unsigned t_ = threadIdx.x; asm volatile("" : "+v"(t_));
    const unsigned long long base = ((unsigned long long)st[5] << 32) | st[4];
    if (pitch == 1u) {
        unsigned o = ((blockIdx.x >> 3) & 31u) * 4608u + (t_ - 64u) * 16u; o = o < 147456u - 16u ? o : 147456u - 16u;
        const f32x4 v = *(const GAS f32x4*)(base + o);
        asm volatile("" :: "v"(v));
        const unsigned long long base2 = ((unsigned long long)st[8] << 32) | st[7];
        const unsigned o2 = ((blockIdx.x >> 3) & 31u) * 1024u + (t_ - 64u) * 16u;
        if (base2 != 0ull && o2 < 8192u) { const f32x4 v2 = *(const GAS f32x4*)(base2 + o2); asm volatile("" :: "v"(v2)); }
        const unsigned long long base3 = ((unsigned long long)st[10] << 32) | st[9];
        if (base3 != 0ull) { const f32x4 v3 = *(const GAS f32x4*)(base3 + o); asm volatile("" :: "v"(v3)); }
        return;
    }
    const unsigned row = ((blockIdx.x >> 3) & 7u) * 32u + ((t_ >> 6) - 1u) * 4u + ((t_ & 63u) >> 4);
    const f32x4 v = *(const GAS f32x4*)(base + (unsigned long long)row * pitch + (t_ & 15u) * 16u);
    asm volatile("" :: "v"(v));
}
__device__ __forceinline__ void xcd_barrier(const XcdBarrier& b) {
    asm volatile("s_waitcnt vmcnt(0)" ::: "memory");
    __syncthreads();
    if (threadIdx.x == 0) {
        unsigned* bar = b.bar;
        __builtin_amdgcn_s_waitcnt(0);
        unsigned nloc = b.st[0], nx = b.st[1];
        if (nloc == 0u) { xcd_barrier_complete(bar, b.x, nloc, nx); b.st[0] = nloc; b.st[1] = nx; }
        const unsigned old = xb_add(&bar[XB_XSUB(b.x)], 1u);
        const unsigned gen = old / nloc;
        if (old + 1u == (gen + 1u) * nloc) {
            __builtin_amdgcn_fence(__ATOMIC_RELEASE, "agent");
            asm volatile("s_waitcnt vmcnt(0)" ::: "memory");
            const unsigned og = xb_add(&bar[XB_TOP], 1u);
            const unsigned tg = og / nx;
            if (og + 1u == (tg + 1u) * nx) xb_add(&bar[XB_TOPGEN], 1u);
            else XB_SPIN(xb_ld(&bar[XB_TOPGEN]) == tg, bar);
            __builtin_amdgcn_fence(__ATOMIC_ACQUIRE, "agent");
            xb_add(&bar[XB_XGEN(b.x)], 1u);
            asm volatile("s_waitcnt vmcnt(0)" ::: "memory");
        } else {
            XB_SPIN(xb_ld(&bar[XB_XGEN(b.x)]) == gen, bar);
            __builtin_amdgcn_fence(__ATOMIC_ACQUIRE, "agent");
            asm volatile("s_waitcnt vmcnt(0)" ::: "memory");
        }
    }
#if CODE_PF_BYTES > 0
    else if (threadIdx.x >= 64) { xb_code_prefetch(b.st); const unsigned pitch_ = b.st[6]; if (pitch_ != 0u) xb_data_prefetch(b.st, pitch_); }
#endif
    __syncthreads();
    if (threadIdx.x == 0) { b.st[6] = 0u; b.st[7] = 0u; b.st[8] = 0u; b.st[9] = 0u; b.st[10] = 0u; }
}

struct TJob { const float* src; bf16* dst; int K, N, row_off, start; };
constexpr int MAX_TJ = 32;
struct Args { const float* in[N_IN]; float* out; unsigned char* ws; TJob tj[MAX_TJ]; int ntj, nitems, ph_lo, ph_hi;
              int wstart[8], wmid[8]; };

__device__ __forceinline__ void p0_transpose_item(const float* W, int K, int N, bf16* WT, int row_off, LAS float* scr, int item, int lane) {
    const int nblk = N / 32, kb = item / nblk, nb = item % nblk, k0 = 64 * kb, n0 = 32 * nb;
    { const int kr = lane >> 3, ns = (lane & 7) * 4;
      f32x4 t[8];
#pragma unroll
      for (int i = 0; i < 8; ++i) t[i] = __builtin_nontemporal_load((const GAS f32x4*)(W + (size_t)(k0 + kr + 8 * i) * N + n0 + ns));
#pragma unroll
      for (int i = 0; i < 8; ++i) { LAS float* d = scr + (kr + 8 * i) * 33 + ns; d[0] = t[i].x; d[1] = t[i].y; d[2] = t[i].z; d[3] = t[i].w; } }
    LDS_WAIT(); asm volatile("" ::: "memory");
    const int c = lane & 7;
#pragma unroll
    for (int j = 0; j < 4; ++j) { const int n = (lane >> 3) + 8 * j; const LAS float* s = scr + (8 * c) * 33 + n;
        v4u o; o.x = pk2(s[0 * 33], s[1 * 33]); o.y = pk2(s[2 * 33], s[3 * 33]); o.z = pk2(s[4 * 33], s[5 * 33]); o.w = pk2(s[6 * 33], s[7 * 33]);
        __builtin_nontemporal_store(o, (GAS v4u*)(WT + (size_t)(row_off + n0 + n) * K + k0 + 8 * c)); }
    LDS_WAIT(); asm volatile("" ::: "memory");
}

__device__ __forceinline__ void p0_convert_range(const Args& a, LAS unsigned char* lds, int lo, int hi, int idx, int stride, int lane, int wave) {
    OPAQUE_V(lane);
    LAS float* scr = (LAS float*)(lds + wave * 16384);
    for (int it = lo + idx; it < hi; it += stride) {
        int j = 0;
        while (j + 1 < a.ntj && it >= a.tj[j + 1].start) ++j;
        p0_transpose_item(a.tj[j].src, a.tj[j].K, a.tj[j].N, a.tj[j].dst, a.tj[j].row_off, scr, it - a.tj[j].start, lane);
    }
}

__device__ __forceinline__ float silu_f(float x) { return x / (1.f + __expf(-x)); }

__device__ __forceinline__ void p0_prologue(const Args& a, LAS unsigned char* lds, int tid, int lane, int wave, int vcu, int G) {
    OPAQUE_V(tid); OPAQUE_V(lane);
    float* mods = (float*)(a.ws + WS_MODS);
#ifndef DBG_REP_MASK
#define DBG_REP_MASK 0
#endif
    for (int rep_ = 0; rep_ < (((DBG_REP_MASK >> 14) & 1) ? 3 : 1); ++rep_)
    if (vcu < 768) {
        LAS f32x4* S3 = (LAS f32x4*)lds;
        LAS float* RED = (LAS float*)(lds + 32768);
        const float* cc = a.in[I_C]; const float* cx = a.in[I_CCTX];
        for (int k = tid; k < DM; k += NTHR) S3[k] = (f32x4){silu_f(cx[k]), silu_f(cc[k]), silu_f(cc[DM + k]), 0.f};
        __syncthreads();
        for (int tl = vcu; tl < 768; tl += G) {
            const int l = tl / 192, n = (tl % 192) * 64 + lane;
            const float* Wp = a.in[I_WMOD] + ((size_t)l * DM + wave * 256) * NMOD + n;
            float a0 = 0.f, a1 = 0.f, a2 = 0.f;
#pragma unroll 16
            for (int k = 0; k < 256; ++k) { const float wv = __builtin_nontemporal_load((const GAS float*)(Wp + (size_t)k * NMOD)); const f32x4 s = S3[wave * 256 + k]; a0 += s.x * wv; a1 += s.y * wv; a2 += s.z * wv; }
            RED[(wave * 3 + 0) * 64 + lane] = a0; RED[(wave * 3 + 1) * 64 + lane] = a1; RED[(wave * 3 + 2) * 64 + lane] = a2;
            __syncthreads();
            if (wave < 3) { float s = 0.f;
#pragma unroll
                for (int w = 0; w < 8; ++w) s += RED[(w * 3 + wave) * 64 + lane];
                mods[((size_t)l * 3 + wave) * NMOD + n] = s + a.in[I_BMOD][(size_t)l * NMOD + n]; }
            __syncthreads();
        }
    }
    { const int gt = vcu * NTHR + tid;
      if (gt < 2 * DM) { const int d = gt >> 11, c = gt & 2047; const float* hl = a.in[I_HLB] + (size_t)d * 4 * DM + c;
          const float x0 = hl[0], x1 = hl[DM], x2 = hl[2 * DM], x3 = hl[3 * DM]; const float m = fmaxf(fmaxf(x0, x1), fmaxf(x2, x3));
          const float e0 = __expf(x0 - m), e1 = __expf(x1 - m), e2 = __expf(x2 - m), e3 = __expf(x3 - m);
          ((float*)(a.ws + WS_LB))[gt] = e1 / (e0 + e1 + e2 + e3); } }
    __syncthreads();
    LAS float* scr = (LAS float*)(lds + wave * 16384);
    const int gw = vcu * NWAVES + wave, NGW = G * NWAVES;
    for (int rep_ = 0; rep_ < (((DBG_REP_MASK >> 15) & 1) ? 3 : 1); ++rep_)
    for (int it = gw; it < a.wstart[1]; it += NGW) {
        int j = 0;
        while (j + 1 < a.ntj && it >= a.tj[j + 1].start) ++j;
        p0_transpose_item(a.tj[j].src, a.tj[j].K, a.tj[j].N, a.tj[j].dst, a.tj[j].row_off, scr, it - a.tj[j].start, lane);
    }
#if defined(DBG_ZERO_OUT)
    { const size_t gt = (size_t)vcu * NTHR + tid, NT = (size_t)G * NTHR;
      for (size_t i = gt; i < (O_END - O_CKV) / 4; i += NT) *(GAS f32x4*)(a.out + O_CKV + 4 * i) = (f32x4){0.f, 0.f, 0.f, 0.f}; }
#endif
    { const int gt = vcu * NTHR + tid, NT = G * NTHR;
      for (int i = gt; i < 2 * 192 * DM / 8; i += NT) { const int j = i / (192 * DM / 8), r = i % (192 * DM / 8);
          *(GAS v4u*)(a.ws + WS_WMLA + j * WMLA_STRIDE + (size_t)1344 * DM * 2 + (size_t)r * 16) = (v4u){0u, 0u, 0u, 0u}; } }
}

__device__ __forceinline__ int cond_of_row(int row) { return row < MP ? 0 : 1 + ((row - MP) >> 11); }

__device__ __forceinline__ void norm_phase(const Args& a, int l, bool ffn, const float* fixgate, int lane, int gw, int NGW) {
    OPAQUE_V(lane); PH_PTRS; OPAQUE_S(gw); OPAQUE_S(NGW);
    const float* g = a.in[ffn ? I_GFFN : I_GMIX] + (size_t)l * DM;
    const float* mods = (const float*)(ws + WS_MODS) + (size_t)l * 3 * NMOD + (ffn ? 3 * DM : 0);
    bf16* H = (bf16*)(ws + WS_H); bf16* X = (bf16*)(ws + WS_S + S_X);
    const bool first = (l == 0 && !ffn);
    for (int row = gw; row < MALL; row += NGW) {
        const float* md = mods + (size_t)cond_of_row(row) * NMOD;
        f32x4 v[8]; float ss = 0.f;
        const bool fix = fixgate != nullptr && row >= MP;
        const bf16* P0 = (const bf16*)(ws + WS_S + S_PART) + (size_t)(row - MP) * DM; const float* fg = fixgate + (size_t)cond_of_row(row) * NMOD;
        if (first) { const float* xr = row < MP ? a.in[I_XP] + (size_t)row * DM : a.in[I_XS] + (size_t)(row - MP) * DM;
#pragma unroll
            for (int j = 0; j < 8; ++j) v[j] = __builtin_nontemporal_load((const GAS f32x4*)(xr + 4 * (lane + 64 * j)));
        } else { const bf16* xr = X + (size_t)row * DM;
#pragma unroll
            for (int j = 0; j < 8; ++j) { const v2u w = *(const GAS v2u*)(xr + 4 * (lane + 64 * j)); v[j] = (f32x4){bf_lo(w.x), bf_hi(w.x), bf_lo(w.y), bf_hi(w.y)}; } }
#pragma unroll
        for (int j = 0; j < 8; ++j) {
            if (fix) { const int c = 4 * (lane + 64 * j); const v2u pw = __builtin_nontemporal_load((const GAS v2u*)(P0 + c)); v[j] = v[j] + *(const GAS f32x4*)(fg + c) * (f32x4){bf_lo(pw.x), bf_hi(pw.x), bf_lo(pw.y), bf_hi(pw.y)}; }
            ss += (v[j].x * v[j].x + v[j].y * v[j].y) + (v[j].z * v[j].z + v[j].w * v[j].w); }
        const float rs = rsqrtf(wave_sum(ss) * (1.f / DM) + EPS);
#pragma unroll
        for (int j = 0; j < 8; ++j) { const int c = 4 * (lane + 64 * j);
            const f32x4 gg = *(const GAS f32x4*)(g + c), sh = *(const GAS f32x4*)(md + c), sc = *(const GAS f32x4*)(md + DM + c);
            const f32x4 y = v[j] * rs * gg * (sc + 1.f) + sh;
            *(GAS v2u*)(H + (size_t)row * DM + c) = (v2u){pk2(y.x, y.y), pk2(y.z, y.w)};
            if (first || fix) *(GAS v2u*)(X + (size_t)row * DM + c) = (v2u){pk2(v[j].x, v[j].y), pk2(v[j].z, v[j].w)}; }
    }
}
__device__ __forceinline__ void final_fix_phase(const Args& a, const float* fixgate, int lane, int gw, int NGW) {
    OPAQUE_V(lane); PH_PTRS; OPAQUE_S(gw); OPAQUE_S(NGW);
    for (int row = MP + gw; row < MALL; row += NGW) {
        const bf16* P0 = (const bf16*)(ws + WS_S + S_PART) + (size_t)(row - MP) * DM; const float* fg = fixgate + (size_t)cond_of_row(row) * NMOD; float* xr = out + O_X + (size_t)row * DM;
#pragma unroll
        for (int j = 0; j < 8; ++j) { const int c = 4 * (lane + 64 * j); const v2u pw = *(const GAS v2u*)(P0 + c);
            *(GAS f32x4*)(xr + c) = *(const GAS f32x4*)(xr + c) + *(const GAS f32x4*)(fg + c) * (f32x4){bf_lo(pw.x), bf_hi(pw.x), bf_lo(pw.y), bf_hi(pw.y)}; }
    }
}
__device__ __forceinline__ void mla_thin_a(const Args& a, int j, int lane, int gw, int NGW) {
    OPAQUE_V(lane); PH_PTRS; OPAQUE_S(gw); OPAQUE_S(NGW);
    const bf16* QAKV = (const bf16*)(ws + WS_S + S_QAKV);
    bf16* QAN = (bf16*)(ws + WS_S + S_QAN); bf16* CKVN = (bf16*)(ws + WS_S + S_CKVN); float* KPE = (float*)(ws + WS_S + S_KPE); float* SSK = (float*)(ws + WS_SSK);
    const float* gqa = a.in[I_GQA] + (size_t)j * 768; const float* gkva = a.in[I_GKVA] + (size_t)j * 512;
    for (int row = gw; row < MKV; row += NGW) {
        if (row < MALL) {
            const bf16* r = QAKV + (size_t)row * 1536;
#define LD4(p_) ({ const v2u w_ = __builtin_nontemporal_load((const GAS v2u*)(p_)); (f32x4){bf_lo(w_.x), bf_hi(w_.x), bf_lo(w_.y), bf_hi(w_.y)}; })
            { f32x4 v[3]; float ss = 0.f;
#pragma unroll
              for (int i = 0; i < 3; ++i) { v[i] = LD4(r + 4 * (lane + 64 * i)); ss += (v[i].x * v[i].x + v[i].y * v[i].y) + (v[i].z * v[i].z + v[i].w * v[i].w); }
              const float rs = rsqrtf(wave_sum(ss) * (1.f / 768.f) + EPS);
#pragma unroll
              for (int i = 0; i < 3; ++i) { const int c = 4 * (lane + 64 * i); const f32x4 y = v[i] * rs * *(const GAS f32x4*)(gqa + c);
                  *(GAS v2u*)(QAN + (size_t)row * 768 + c) = (v2u){pk2(y.x, y.y), pk2(y.z, y.w)}; } }
            { f32x4 v[2]; float ss = 0.f;
#pragma unroll
              for (int i = 0; i < 2; ++i) { v[i] = LD4(r + 768 + 4 * (lane + 64 * i)); ss += (v[i].x * v[i].x + v[i].y * v[i].y) + (v[i].z * v[i].z + v[i].w * v[i].w); }
              const float rs = rsqrtf(wave_sum(ss) * (1.f / 512.f) + EPS);
#pragma unroll
              for (int i = 0; i < 2; ++i) { const int c = 4 * (lane + 64 * i); const f32x4 y = v[i] * rs * *(const GAS f32x4*)(gkva + c);
                  *(GAS v2u*)(CKVN + (size_t)row * 512 + c) = (v2u){pk2(y.x, y.y), pk2(y.z, y.w)};
                  if (row < MP) __builtin_nontemporal_store(y * DBG_SCALE, (GAS f32x4*)(out + O_CKV + ((size_t)((row >> 8) * 2 + j) * 256 + (row & 255)) * 512 + c)); } }
            { const float kp = __uint_as_float((unsigned)r[1280 + lane] << 16); KPE[(size_t)row * 64 + lane] = kp;
              if (row < MP) out[O_KPE + ((size_t)((row >> 8) * 2 + j) * 256 + (row & 255)) * 64 + lane] = kp * DBG_SCALE;
              const float s = wave_sum(kp * kp); if (lane == 0) SSK[row] = s; }
#undef LD4
        } else {
            const int cr = row - MALL, b = cr >> 8, t = cr & 255; const size_t src = (size_t)((b * 2 + j) * 256 + t);
            const float* ck = a.in[I_CCKV] + src * 512;
#pragma unroll
            for (int i = 0; i < 2; ++i) { const int c = 4 * (lane + 64 * i); const f32x4 y = *(const GAS f32x4*)(ck + c);
                *(GAS v2u*)(CKVN + (size_t)row * 512 + c) = (v2u){pk2(y.x, y.y), pk2(y.z, y.w)}; }
            const float kp = a.in[I_CKPE][src * 64 + lane]; KPE[(size_t)row * 64 + lane] = kp;
            const float s = wave_sum(kp * kp); if (lane == 0) SSK[row] = s;
        }
    }
}
namespace pg8 {
struct EpiF32 {
    static constexpr bool PERM = false;
    float* C; int ldc;
    __device__ __forceinline__ void operator()(const f32x4 (&acc)[2][2][4][2], const Unit& u, int wr, int wc, int fr, int fq) const {
        const int row0 = u.pm * BM + wr * 64 + fr, col0 = u.pn * BM + wc * 32 + 4 * fq;
#pragma unroll
        for (int ai = 0; ai < 2; ++ai)
#pragma unroll
            for (int m = 0; m < 4; ++m) { float* rowp = C + (size_t)(row0 + ai * HALF + m * 16) * ldc + col0;
#pragma unroll
                for (int bj = 0; bj < 2; ++bj)
#pragma unroll
                    for (int n = 0; n < 2; ++n) *(PG8_GAS f32x4*)(rowp + bj * HALF + n * 16) = acc[ai][bj][m][n]; }
    }
};
template <int ACT  > struct EpiBf16 {
    static constexpr bool PERM = true;
    bf16_t* O; int ldc;
    __device__ __forceinline__ void operator()(const f32x4 (&acc)[2][2][4][2], const Unit& u, int wr, int wc, int fr, int fq) const {
        const int row0 = u.pm * BM + wr * 64 + fr, col0 = u.pn * BM + wc * 32 + 8 * fq;
#pragma unroll
        for (int ai = 0; ai < 2; ++ai)
#pragma unroll
            for (int m = 0; m < 4; ++m) { bf16_t* rowp = O + (size_t)(row0 + ai * HALF + m * 16) * ldc + col0;
#pragma unroll
                for (int bj = 0; bj < 2; ++bj) { f32x4 v0 = acc[ai][bj][m][0], v1 = acc[ai][bj][m][1];
                    if (ACT == 1) {
#pragma unroll
                        for (int e = 0; e < 4; ++e) { const float x0 = fmaxf(v0[e], 0.f), x1 = fmaxf(v1[e], 0.f); v0[e] = x0 * x0; v1[e] = x1 * x1; } }
                    u32x4 w; w.x = cvt_pk_bf16(v0[0], v0[1]); w.y = cvt_pk_bf16(v0[2], v0[3]); w.z = cvt_pk_bf16(v1[0], v1[1]); w.w = cvt_pk_bf16(v1[2], v1[3]);
                    *(PG8_GAS u32x4*)(rowp + bj * HALF) = w; } }
    }
};
template <bool ATOMIC> struct EpiRes {
    static constexpr bool PERM = false;
    float* X; const float* gate;
    __device__ __forceinline__ void operator()(const f32x4 (&acc)[2][2][4][2], const Unit& u, int wr, int wc, int fr, int fq) const {
        const int rb = u.pm * BM, row0 = rb + wr * 64 + fr, col0 = u.pn * BM + wc * 32 + 4 * fq;
        const int cond = rb < 8192 ? 0 : 1 + ((rb - 8192) >> 11);
        const float* gp = gate + (size_t)cond * 12288 + col0;
        f32x4 gv[2][2];
#pragma unroll
        for (int bj = 0; bj < 2; ++bj)
#pragma unroll
            for (int n = 0; n < 2; ++n) gv[bj][n] = *(const PG8_GAS f32x4*)(gp + bj * HALF + n * 16);
#pragma unroll
        for (int ai = 0; ai < 2; ++ai)
#pragma unroll
            for (int m = 0; m < 4; ++m) { float* rowp = X + (size_t)(row0 + ai * HALF + m * 16) * 2048 + col0;
#pragma unroll
                for (int bj = 0; bj < 2; ++bj)
#pragma unroll
                    for (int n = 0; n < 2; ++n) { float* p = rowp + bj * HALF + n * 16; const f32x4 d = gv[bj][n] * acc[ai][bj][m][n];
                        if (ATOMIC) {
#pragma unroll
                            for (int e = 0; e < 4; ++e) __hip_atomic_fetch_add((PG8_GAS float*)(p + e), d[e], __ATOMIC_RELAXED, __HIP_MEMORY_SCOPE_AGENT);
                        } else { *(PG8_GAS f32x4*)p = *(const PG8_GAS f32x4*)p + d; } }
                asm volatile("" ::: "memory"); }
    }
};
struct EpiRes2 {
    static constexpr bool PERM = false;
    bf16_t* X; const float* gate; bf16_t* P; float* Yout;
    __device__ __forceinline__ void operator()(const f32x4 (&acc)[2][2][4][2], const Unit& u, int wr, int wc, int fr, int fq) const {
        typedef unsigned u32x2_ __attribute__((ext_vector_type(2)));
        const int rb = u.pm * BM, row0 = rb + wr * 64 + fr, col0 = u.pn * BM + wc * 32 + 4 * fq;
        if (u.part <= 0) {
            const int cond = rb < 8192 ? 0 : 1 + ((rb - 8192) >> 11);
            const float* gp = gate + (size_t)cond * 12288 + col0;
            f32x4 gv[2][2];
#pragma unroll
            for (int bj = 0; bj < 2; ++bj)
#pragma unroll
                for (int n = 0; n < 2; ++n) gv[bj][n] = *(const PG8_GAS f32x4*)(gp + bj * HALF + n * 16);
#pragma unroll
            for (int ai = 0; ai < 2; ++ai)
#pragma unroll
                for (int m = 0; m < 4; ++m) { const size_t ro = (size_t)(row0 + ai * HALF + m * 16) * 2048 + col0;
#pragma unroll
                    for (int bj = 0; bj < 2; ++bj)
#pragma unroll
                        for (int n = 0; n < 2; ++n) { const size_t o = ro + bj * HALF + n * 16; const u32x2_ w = *(const PG8_GAS u32x2_*)(X + o);
                            const f32x4 xn = (f32x4){__uint_as_float(w.x << 16), __uint_as_float(w.x & 0xffff0000u), __uint_as_float(w.y << 16), __uint_as_float(w.y & 0xffff0000u)} + gv[bj][n] * acc[ai][bj][m][n];
                            if (Yout != nullptr) *(PG8_GAS f32x4*)(Yout + o) = xn; else *(PG8_GAS u32x2_*)(X + o) = (u32x2_){cvt_pk_bf16(xn[0], xn[1]), cvt_pk_bf16(xn[2], xn[3])}; }
                    asm volatile("" ::: "memory"); }
        } else {
            bf16_t* Pp = P + (size_t)(row0 - 8192) * 2048 + col0;
#pragma unroll
            for (int ai = 0; ai < 2; ++ai)
#pragma unroll
                for (int m = 0; m < 4; ++m) { bf16_t* rowp = Pp + (size_t)(ai * HALF + m * 16) * 2048;
#pragma unroll
                    for (int bj = 0; bj < 2; ++bj)
#pragma unroll
                        for (int n = 0; n < 2; ++n) { const f32x4 v = acc[ai][bj][m][n]; *(PG8_GAS u32x2_*)(rowp + bj * HALF + n * 16) = (u32x2_){cvt_pk_bf16(v[0], v[1]), cvt_pk_bf16(v[2], v[3])}; } }
        }
    }
};
}
#ifndef DBG_REP_MASK
#define DBG_REP_MASK 0
#endif
namespace att {
using bf16x8 = __attribute__((ext_vector_type(8))) short;
using s16x4  = __attribute__((ext_vector_type(4))) short;
using f32x16 = __attribute__((ext_vector_type(16))) float;
using u32x4  = __attribute__((ext_vector_type(4))) unsigned;
constexpr int NW = 8, QBLK = 32, KVBLK = 64, DV = 128;
constexpr float THR = 8.f;
constexpr int SHM_V = KVBLK * DV * 2;
constexpr int RPB_OFF = 2 * SHM_V + 2 * KVBLK * 512 + 2048;
#define ATT_SBAR() __builtin_amdgcn_sched_barrier(0)
__device__ __forceinline__ int crow(int r, int hi) { return (r & 3) + 8 * (r >> 2) + 4 * hi; }
__device__ __forceinline__ unsigned cvtpk(float lo, float hi) { unsigned r; asm volatile("v_cvt_pk_bf16_f32 %0, %1, %2" : "=v"(r) : "v"(lo), "v"(hi)); return r; }
__device__ __forceinline__ int v_st(int k, int c) { const int kk = (k & ~0xC) | ((k & 4) << 1) | ((k & 8) >> 1); return ((kk >> 3) * 4 + (c >> 5)) * 512 + ((kk & 7) * 32 + (c & 31)) * 2; }
__device__ __forceinline__ int v_rd_base(int lane) { return ((lane & 3) << 3) | (((lane >> 2) & 3) << 6) | (((lane >> 4) & 1) << 5) | (((lane >> 5) & 1) << 8); }
constexpr int v_rd_off(int d0, int ks, int half) { return d0 * 512 + ks * 4096 + half * 2048; }
template <int OFF> __device__ __forceinline__ s16x4 tr_read(int vb) { s16x4 r; asm volatile("ds_read_b64_tr_b16 %0, %1 offset:%2" : "=&v"(r) : "v"(vb), "i"(OFF) : "memory"); return r; }
template <int D0> __device__ __forceinline__ void pv_one(f32x16& od, int vb, bf16x8 pa0, bf16x8 pa1, bf16x8 pa2, bf16x8 pa3) {
  const s16x4 l0 = tr_read<v_rd_off(D0, 0, 0)>(vb), h0 = tr_read<v_rd_off(D0, 0, 1)>(vb), l1 = tr_read<v_rd_off(D0, 1, 0)>(vb), h1 = tr_read<v_rd_off(D0, 1, 1)>(vb);
  const s16x4 l2 = tr_read<v_rd_off(D0, 2, 0)>(vb), h2 = tr_read<v_rd_off(D0, 2, 1)>(vb), l3 = tr_read<v_rd_off(D0, 3, 0)>(vb), h3 = tr_read<v_rd_off(D0, 3, 1)>(vb);
  asm volatile("s_waitcnt lgkmcnt(0)" ::: "memory"); ATT_SBAR();
#define ATT_PK(L, H) (bf16x8){L[0], L[1], L[2], L[3], H[0], H[1], H[2], H[3]}
  od = __builtin_amdgcn_mfma_f32_32x32x16_bf16(pa0, ATT_PK(l0, h0), od, 0, 0, 0);
  od = __builtin_amdgcn_mfma_f32_32x32x16_bf16(pa1, ATT_PK(l1, h1), od, 0, 0, 0);
  od = __builtin_amdgcn_mfma_f32_32x32x16_bf16(pa2, ATT_PK(l2, h2), od, 0, 0, 0);
  od = __builtin_amdgcn_mfma_f32_32x32x16_bf16(pa3, ATT_PK(l3, h3), od, 0, 0, 0);
#undef ATT_PK
}
__device__ __forceinline__ void pv_d0(f32x16* o, int vb, bf16x8 pa0, bf16x8 pa1, bf16x8 pa2, bf16x8 pa3) {
  pv_one<0>(o[0], vb, pa0, pa1, pa2, pa3); pv_one<1>(o[1], vb, pa0, pa1, pa2, pa3); pv_one<2>(o[2], vb, pa0, pa1, pa2, pa3); pv_one<3>(o[3], vb, pa0, pa1, pa2, pa3);
}
struct KvSrc { int row0, n0, row1, n1; __device__ __forceinline__ int row(int t) const { const int u = t - n0; return t < n0 ? row0 + 64 * t : row1 + 64 * (u < n1 ? u : n1 - 1); } };
struct NatMask { int rlo, qrow, qcol; const LAS float* rpb; };

template <int DQK, int MODE, int ldq, int ldk, int ldv, int ldo, int QP = 0>
__device__ __forceinline__ void attn_unit(const bf16* __restrict__ Qb, const bf16* __restrict__ Kh, const bf16* __restrict__ Vh,
                                          bf16* __restrict__ Ob, const KvSrc src, int NT, const NatMask nm, LAS char* lds, int tid,
                                          const float* __restrict__ qgain = nullptr, const float* __restrict__ qrope = nullptr) {
  constexpr float SCALE = DQK == 128 ? 0.088388347648318440f : 0.072168783648703220f;
  constexpr float C = SCALE * 1.4426950408889634f;
  constexpr int KROW = DQK == 128 ? 256 : 512  , SHM_K = KVBLK * KROW, NKC = DQK / 8, KCH = KVBLK * NKC / 512, ND0 = DQK / 16;
  const int wid = tid >> 6, lane = tid & 63, r32 = lane & 31, hi = lane >> 5;
  LAS char* V_lds = lds; LAS char* K_lds = lds + 2 * SHM_V;
  LAS float* ws = (LAS float*)(lds + 2 * SHM_V + 2 * SHM_K) + wid * 64; LAS float* li_l = ws; LAS float* al_l = ws + 32;
  float m_reg = -1e30f, l_reg = 0; f32x16 o[4] = {}; bf16x8 qr[ND0];
  { const bf16* Qw = Qb + (size_t)(wid * QBLK + r32) * ldq + hi * 8;
#pragma unroll
    for (int d0 = 0; d0 < ND0; ++d0) qr[d0] = *(const GAS bf16x8*)(Qw + d0 * 16); }
  if constexpr (QP == 1) {
    float ss = 0.f;
#pragma unroll
    for (int d0 = 0; d0 < ND0; ++d0) { const u32x4 w = __builtin_bit_cast(u32x4, qr[d0]);
#pragma unroll
      for (int e = 0; e < 4; ++e) { const float a = __uint_as_float(w[e] << 16), b = __uint_as_float(w[e] & 0xffff0000u); ss += a * a + b * b; } }
    ss += __shfl_xor(ss, 32);
    const float rs = rsqrtf(ss * (1.f / DQK) + 1e-6f);
    float xv[ND0 < 12 ? 1 : 4][8];
#pragma unroll
    for (int d0 = 0; d0 < ND0; ++d0) { const u32x4 w = __builtin_bit_cast(u32x4, qr[d0]);
      const f32x4 g0 = *(const GAS f32x4*)(qgain + d0 * 16 + hi * 8), g1 = *(const GAS f32x4*)(qgain + d0 * 16 + hi * 8 + 4);
      float x[8];
#pragma unroll
      for (int e = 0; e < 4; ++e) { x[2 * e] = __uint_as_float(w[e] << 16) * rs; x[2 * e + 1] = __uint_as_float(w[e] & 0xffff0000u) * rs; }
      x[0] *= g0.x; x[1] *= g0.y; x[2] *= g0.z; x[3] *= g0.w; x[4] *= g1.x; x[5] *= g1.y; x[6] *= g1.z; x[7] *= g1.w;
      if (ND0 == 12 && d0 >= 8) {
#pragma unroll
        for (int e = 0; e < 8; ++e) xv[ND0 < 12 ? 0 : d0 - 8][e] = x[e];
      } else { const u32x4 o_ = {cvtpk(x[0], x[1]), cvtpk(x[2], x[3]), cvtpk(x[4], x[5]), cvtpk(x[6], x[7])}; qr[d0] = __builtin_bit_cast(bf16x8, o_); } }
    if constexpr (ND0 == 12) {
#pragma unroll
      for (int pp = 0; pp < 2; ++pp) {
        float y1[8], y2[8];
#pragma unroll
        for (int e = 0; e < 8; ++e) { y1[e] = xv[pp][e]; y2[e] = xv[2 + pp][e]; }
        if (qrope != nullptr) { const float* rt = qrope + ((size_t)(wid * QBLK + r32) * 32 + 16 * pp + 8 * hi) * 2;
#pragma unroll
          for (int e2 = 0; e2 < 4; ++e2) { const f32x4 cs = *(const GAS f32x4*)(rt + 4 * e2);
            const float a0 = y1[2 * e2] * cs.x - y2[2 * e2] * cs.y, b0 = y1[2 * e2] * cs.y + y2[2 * e2] * cs.x;
            const float a1 = y1[2 * e2 + 1] * cs.z - y2[2 * e2 + 1] * cs.w, b1 = y1[2 * e2 + 1] * cs.w + y2[2 * e2 + 1] * cs.z;
            y1[2 * e2] = a0; y2[2 * e2] = b0; y1[2 * e2 + 1] = a1; y2[2 * e2 + 1] = b1; } }
        const u32x4 o1 = {cvtpk(y1[0], y1[1]), cvtpk(y1[2], y1[3]), cvtpk(y1[4], y1[5]), cvtpk(y1[6], y1[7])}, o2 = {cvtpk(y2[0], y2[1]), cvtpk(y2[2], y2[3]), cvtpk(y2[4], y2[5]), cvtpk(y2[6], y2[7])};
        qr[8 + pp] = __builtin_bit_cast(bf16x8, o1); qr[10 + pp] = __builtin_bit_cast(bf16x8, o2); }
    }
  }
  const int sr = tid >> 4, sc = (tid & 15) * 8, vst0 = v_st(sr, sc), vst1 = v_st(32 + sr, sc);
  unsigned koff_[KCH], kst_[KCH]; const unsigned voff0 = (unsigned)(sr * ldv + sc);
#pragma unroll
  for (int i = 0; i < KCH; ++i) { const int c = tid + 512 * i, kr = c / NKC, kc = c % NKC; koff_[i] = (unsigned)(kr * ldk + kc * 8); kst_[i] = (unsigned)(kr * KROW + ((kc * 16) ^ ((kr & 15) << 4))); }
  const int vb0 = (int)(uintptr_t)V_lds + v_rd_base(lane);
  bf16x8 svs0, svs1, sks[KCH];
#define ATT_SLOAD(t) do { const int _r = __builtin_amdgcn_readfirstlane(src.row(t)); const bf16* _vt = Vh + (size_t)_r * ldv; const bf16* _kt = Kh + (size_t)_r * ldk; \
    svs0 = *(const GAS bf16x8*)(_vt + voff0); svs1 = *(const GAS bf16x8*)(_vt + 32 * ldv + voff0); \
    _Pragma("unroll") for (int _i = 0; _i < KCH; ++_i) sks[_i] = *(const GAS bf16x8*)(_kt + koff_[_i]); } while (0)
#define ATT_SWRITE(b) do { *(LAS bf16x8*)(V_lds + (b) * SHM_V + vst0) = svs0; *(LAS bf16x8*)(V_lds + (b) * SHM_V + vst1) = svs1; \
    _Pragma("unroll") for (int _i = 0; _i < KCH; ++_i) *(LAS bf16x8*)(K_lds + (b) * SHM_K + kst_[_i]) = sks[_i]; } while (0)
#define ATT_RESC(a) do { if (__any((a) < 1.f)) { if (hi == 0) al_l[r32] = (a); asm volatile("s_waitcnt lgkmcnt(0)" ::: "memory"); \
    _Pragma("unroll") for (int d = 0; d < 4; ++d) _Pragma("unroll") for (int r = 0; r < 16; ++r) o[d][r] *= al_l[crow(r, hi)]; } } while (0)
  auto qkt = [&](f32x16& p0, f32x16& p1, int b, int t) {
    const LAS char* Ks = K_lds + b * SHM_K;
    p0 = f32x16{}; p1 = f32x16{};
    const LAS char* k0p = Ks + r32 * KROW; const LAS char* k1p = Ks + (32 + r32) * KROW; const int sw = (r32 & 15) << 4;
    bf16x8 ka[2], kb[2];
    ka[0] = *reinterpret_cast<const LAS bf16x8*>(k0p + ((hi * 16) ^ sw)); kb[0] = *reinterpret_cast<const LAS bf16x8*>(k1p + ((hi * 16) ^ sw));
#pragma unroll
    for (int d0 = 0; d0 < ND0; ++d0) {
      if (d0 + 1 < ND0) { const int cb = ((d0 + 1) * 16 + hi * 8) * 2;
        ka[(d0 + 1) & 1] = *reinterpret_cast<const LAS bf16x8*>(k0p + (cb ^ sw)); kb[(d0 + 1) & 1] = *reinterpret_cast<const LAS bf16x8*>(k1p + (cb ^ sw)); }
      __builtin_amdgcn_sched_barrier(0);
      p0 = __builtin_amdgcn_mfma_f32_32x32x16_bf16(ka[d0 & 1], qr[d0], p0, 0, 0, 0);
      p1 = __builtin_amdgcn_mfma_f32_32x32x16_bf16(kb[d0 & 1], qr[d0], p1, 0, 0, 0);
      __builtin_amdgcn_sched_barrier(0); }
    if constexpr (MODE == 1) {
      const int i = t - src.n0;
      if (i >= 0) {
        const int kr = nm.rlo + i, r0q = min(max(nm.qrow - 4, 0), 24), c0q = min(max(nm.qcol - 8, 0), 48);
        const bool rowok = (i < src.n1) && (kr >= r0q) && (kr < r0q + 8);
        const int rowoff = (kr - nm.qrow + 7) * 31 + 15 - nm.qcol;
#pragma unroll
        for (int r = 0; r < 16; ++r) {
          const int kc0 = crow(r, hi), kc1 = kc0 + 32;
          const bool ok0 = rowok && ((unsigned)(kc0 - c0q) < 16u), ok1 = rowok && ((unsigned)(kc1 - c0q) < 16u);
          const float b0 = nm.rpb[ok0 ? rowoff + kc0 : 0], b1 = nm.rpb[ok1 ? rowoff + kc1 : 0];
          p0[r] = ok0 ? p0[r] + b0 : -1e30f; p1[r] = ok1 ? p1[r] + b1 : -1e30f; }
      }
    }
  };
  auto partialSM = [&](f32x16& p0, f32x16& p1, float& mn, float& alpha) {
    float pmax = p0[0];
#pragma unroll
    for (int r = 1; r < 16; ++r) pmax = fmaxf(pmax, p0[r]);
#pragma unroll
    for (int r = 0; r < 16; ++r) pmax = fmaxf(pmax, p1[r]);
    { auto rr = __builtin_amdgcn_permlane32_swap(__float_as_uint(pmax), __float_as_uint(pmax), false, false); pmax = fmaxf(__uint_as_float(rr[0]), __uint_as_float(rr[1])); }
    if (__builtin_expect(__all(pmax - m_reg <= THR / SCALE), 1)) { mn = m_reg; alpha = 1.f; }
    else { mn = fmaxf(m_reg, pmax); alpha = __builtin_amdgcn_exp2f((m_reg - mn) * C); m_reg = mn; }
    const float mnC = -mn * C;
#pragma unroll
    for (int r = 0; r < 16; ++r) p0[r] = fmaf(p0[r], C, mnC);
#pragma unroll
    for (int r = 0; r < 16; ++r) p1[r] = fmaf(p1[r], C, mnC);
#pragma unroll
    for (int r = 0; r < 16; ++r) p0[r] = __builtin_amdgcn_exp2f(p0[r]);
  };
  auto finishSM = [&](f32x16& p0, f32x16& p1, float alpha, bf16x8& pa0, bf16x8& pa1, bf16x8& pa2, bf16x8& pa3) {
#pragma unroll
    for (int r = 0; r < 16; ++r) p1[r] = __builtin_amdgcn_exp2f(p1[r]);
    float ps = 0;
#pragma unroll
    for (int r = 0; r < 16; ++r) ps += p0[r];
#pragma unroll
    for (int r = 0; r < 16; ++r) ps += p1[r];
    { auto rr = __builtin_amdgcn_permlane32_swap(__float_as_uint(ps), __float_as_uint(ps), false, false); ps = __uint_as_float(rr[0]) + __uint_as_float(rr[1]); }
    l_reg = l_reg * alpha + ps;
#define ATT_PK4(P, BASE, OUT) do { unsigned a0 = cvtpk(P[BASE + 0], P[BASE + 1]), a1 = cvtpk(P[BASE + 2], P[BASE + 3]); \
    unsigned b0 = cvtpk(P[BASE + 4], P[BASE + 5]), b1 = cvtpk(P[BASE + 6], P[BASE + 7]); \
    auto r0 = __builtin_amdgcn_permlane32_swap(a0, b0, false, false); auto r1 = __builtin_amdgcn_permlane32_swap(a1, b1, false, false); \
    u32x4 w = {r0[0], r1[0], r0[1], r1[1]}; OUT = *reinterpret_cast<bf16x8*>(&w); } while (0)
    ATT_PK4(p0, 0, pa0); ATT_PK4(p0, 8, pa1); ATT_PK4(p1, 0, pa2); ATT_PK4(p1, 8, pa3);
#undef ATT_PK4
  };
  f32x16 p0, p1; float mn, al; bf16x8 pa0, pa1, pa2, pa3;
  ATT_SLOAD(0); asm volatile("s_waitcnt vmcnt(0)" ::: "memory"); ATT_SWRITE(0); if (NT > 1) ATT_SLOAD(1); __syncthreads();
  for (int t = 0; t < NT; ++t) {
    const int b = t & 1;
    bool live = true;
    if constexpr (MODE == 1) { const int i = t - src.n0; if (i >= 0) { const int kr = nm.rlo + i, r0q = min(max(nm.qrow - 4, 0), 24); live = (i < src.n1) && (kr >= r0q) && (kr < r0q + 8); } }
    ATT_SBAR(); if (live) qkt(p0, p1, b, t); ATT_SBAR();
    if (t + 1 < NT) { asm volatile("s_waitcnt vmcnt(0)" ::: "memory"); ATT_SWRITE(b ^ 1); if (t + 2 < NT) ATT_SLOAD(t + 2); }
    ATT_SBAR();
    if (live) { partialSM(p0, p1, mn, al); ATT_RESC(al);
      finishSM(p0, p1, al, pa0, pa1, pa2, pa3); ATT_SBAR();
      pv_d0(o, vb0 + b * SHM_V, pa0, pa1, pa2, pa3); }
    __syncthreads();
  }
  if (hi == 0) li_l[r32] = l_reg; asm volatile("s_waitcnt lgkmcnt(0)" ::: "memory");
  int hi_o = hi; asm volatile("" : "+v"(hi_o));
  bf16* Ow = Ob + (size_t)(wid * QBLK + 4 * hi_o) * ldo;
#pragma unroll
  for (int r = 0; r < 16; ++r) { const int orow = crow(r, 0); const float rl = __builtin_amdgcn_rcpf(li_l[orow + 4 * hi_o]);
#pragma unroll
    for (int d0 = 0; d0 < 4; ++d0) { const float v = o[d0][r] * rl; ((GAS bf16*)Ow)[(size_t)orow * ldo + d0 * 32 + r32] = (bf16)(cvtpk(v, v) & 0xffffu); } }
#undef ATT_SLOAD
#undef ATT_SWRITE
#undef ATT_RESC
}
}
namespace pg8 {
struct EpiKV {
    static constexpr bool PERM = true;
    bf16_t* KV; bf16_t* KF; const float* gkn; const float* KPE; const float* SSK; const float* RT; PG8_LAS float* tab;
    __device__ __forceinline__ void operator()(const f32x4 (&acc)[2][2][4][2], const Unit& u, int wr, int wc, int fr, int fq) const {
        const int h = u.pn, row0 = u.pm * BM + wr * 64 + fr, c8 = wc * 32 + 8 * fq;
        float sk[2][4];
#pragma unroll
        for (int ai = 0; ai < 2; ++ai)
#pragma unroll
            for (int m = 0; m < 4; ++m) { const f32x4 a = acc[ai][0][m][0], b = acc[ai][0][m][1]; sk[ai][m] = ((const PG8_GAS float*)SSK)[row0 + ai * HALF + m * 16];
                float s = (a[0] * a[0] + a[1] * a[1]) + (a[2] * a[2] + a[3] * a[3]) + (b[0] * b[0] + b[1] * b[1]) + (b[2] * b[2] + b[3] * b[3]);
                s += __shfl_xor(s, 16); s += __shfl_xor(s, 32);
                if (fq == 0) tab[(ai * HALF + wr * 64 + m * 16 + fr) * 4 + wc] = s; }
#pragma unroll
        for (int ai = 0; ai < 2; ++ai)
#pragma unroll
            for (int m = 0; m < 4; ++m) { const f32x4 v0 = acc[ai][1][m][0], v1 = acc[ai][1][m][1];
                u32x4 w; w.x = cvt_pk_bf16(v0[0], v0[1]); w.y = cvt_pk_bf16(v0[2], v0[3]); w.z = cvt_pk_bf16(v1[0], v1[1]); w.w = cvt_pk_bf16(v1[2], v1[3]);
                *(PG8_GAS u32x4*)(KV + (size_t)(row0 + ai * HALF + m * 16) * 4096 + h * 256 + 128 + c8) = w; }
        asm volatile("s_waitcnt lgkmcnt(0)" ::: "memory"); __builtin_amdgcn_s_barrier(); asm volatile("" ::: "memory");
        const f32x4 g0 = *(const PG8_GAS f32x4*)(gkn + c8), g1 = *(const PG8_GAS f32x4*)(gkn + c8 + 4);
#pragma unroll
        for (int ai = 0; ai < 2; ++ai)
#pragma unroll
            for (int m = 0; m < 4; ++m) { const int row = row0 + ai * HALF + m * 16; const f32x4 p = *(const PG8_LAS f32x4*)(tab + (ai * HALF + wr * 64 + m * 16 + fr) * 4);
                const float rs = rsqrtf(((p[0] + p[1]) + (p[2] + p[3]) + sk[ai][m]) * (1.f / 192.f) + 1e-6f);
                const f32x4 k0 = acc[ai][0][m][0] * rs * g0, k1 = acc[ai][0][m][1] * rs * g1;
                u32x4 w; w.x = cvt_pk_bf16(k0[0], k0[1]); w.y = cvt_pk_bf16(k0[2], k0[3]); w.z = cvt_pk_bf16(k1[0], k1[1]); w.w = cvt_pk_bf16(k1[2], k1[3]);
                *(PG8_GAS u32x4*)(KF + (size_t)row * 3072 + h * 192 + c8) = w; }
        { const int t_ = (wr * 4 + wc) * 64 + fq * 16 + fr, r = t_ >> 1, hf = t_ & 1, row = u.pm * BM + r;
          const f32x4 p = *(const PG8_LAS f32x4*)(tab + r * 4);
          const float rs = rsqrtf(((p[0] + p[1]) + (p[2] + p[3]) + ((const PG8_GAS float*)SSK)[row]) * (1.f / 192.f) + 1e-6f);
          const bool rot = row >= 8192 && row < 12288; const float* rt = RT + ((size_t)((row - 8192) & 2047) * 32 + 16 * hf) * 2;
          const float* kp = KPE + (size_t)row * 64 + 16 * hf; bf16_t* o = KF + (size_t)row * 3072 + h * 192 + 128 + 16 * hf;
#pragma unroll
          for (int q = 0; q < 2; ++q) {
              f32x4 a0 = *(const PG8_GAS f32x4*)(kp + 8 * q), a1 = *(const PG8_GAS f32x4*)(kp + 8 * q + 4), b0 = *(const PG8_GAS f32x4*)(kp + 32 + 8 * q), b1 = *(const PG8_GAS f32x4*)(kp + 32 + 8 * q + 4);
              a0 = a0 * rs * *(const PG8_GAS f32x4*)(gkn + 128 + 16 * hf + 8 * q); a1 = a1 * rs * *(const PG8_GAS f32x4*)(gkn + 128 + 16 * hf + 8 * q + 4);
              b0 = b0 * rs * *(const PG8_GAS f32x4*)(gkn + 160 + 16 * hf + 8 * q); b1 = b1 * rs * *(const PG8_GAS f32x4*)(gkn + 160 + 16 * hf + 8 * q + 4);
              float x1[8] = {a0[0], a0[1], a0[2], a0[3], a1[0], a1[1], a1[2], a1[3]}, x2[8] = {b0[0], b0[1], b0[2], b0[3], b1[0], b1[1], b1[2], b1[3]};
              if (rot) {
#pragma unroll
                  for (int e2 = 0; e2 < 4; ++e2) { const f32x4 cs = *(const PG8_GAS f32x4*)(rt + (8 * q + 2 * e2) * 2);
                      const float y0 = x1[2 * e2] * cs[0] - x2[2 * e2] * cs[1], z0 = x1[2 * e2] * cs[1] + x2[2 * e2] * cs[0];
                      const float y1 = x1[2 * e2 + 1] * cs[2] - x2[2 * e2 + 1] * cs[3], z1 = x1[2 * e2 + 1] * cs[3] + x2[2 * e2 + 1] * cs[2];
                      x1[2 * e2] = y0; x2[2 * e2] = z0; x1[2 * e2 + 1] = y1; x2[2 * e2 + 1] = z1; } }
              u32x4 w1, w2; w1.x = cvt_pk_bf16(x1[0], x1[1]); w1.y = cvt_pk_bf16(x1[2], x1[3]); w1.z = cvt_pk_bf16(x1[4], x1[5]); w1.w = cvt_pk_bf16(x1[6], x1[7]);
              w2.x = cvt_pk_bf16(x2[0], x2[1]); w2.y = cvt_pk_bf16(x2[2], x2[3]); w2.z = cvt_pk_bf16(x2[4], x2[5]); w2.w = cvt_pk_bf16(x2[6], x2[7]);
              *(PG8_GAS u32x4*)(o + 8 * q) = w1; *(PG8_GAS u32x4*)(o + 32 + 8 * q) = w2; } }
    }
};
}
__device__ __forceinline__ void rope_table(const Args& a, int tid, int vcu, int G) {
    f32x2* RT = (f32x2*)(a.ws + WS_ROPE);
    for (int e = vcu * NTHR + tid; e < 2048 * 32; e += G * NTHR) { const int t = e >> 5, i = e & 31;
        const float inv = exp2f(-(float)(i & 15) * (13.287712379549449f / 16.f));
        const float ang = (float)(i < 16 ? (t >> 6) : (t & 63)) * inv; float s, c; sincosf(ang, &s, &c); RT[e] = (f32x2){c, s}; }
}
__device__ __forceinline__ void mla_thin_b(const Args& a, int j, int lane, int gw, int NGW) {
    OPAQUE_V(lane); PH_PTRS; OPAQUE_S(gw); OPAQUE_S(NGW);
    const bf16* QRAW = (const bf16*)(ws + WS_S + S_QRAW); bf16* QN = (bf16*)(ws + WS_S + S_QN);
    const bf16* KVRAW = (const bf16*)(ws + WS_S + S_KVRAW); bf16* KF = (bf16*)(ws + WS_S + S_KF);
    const float* KPE = (const float*)(ws + WS_S + S_KPE); const float* SSK = (const float*)(ws + WS_SSK);
    const f32x2* RT = (const f32x2*)(ws + WS_ROPE);
    const float* gqn = a.in[I_GQN] + (size_t)j * 192; const float* gkn = a.in[I_GKN] + (size_t)j * 192;
    const int grp = lane >> 4, s = lane & 15;
    float gq[12], gk[12];
#pragma unroll
    for (int e = 0; e < 8; ++e) { gq[e] = gqn[8 * s + e]; gk[e] = gkn[8 * s + e]; }
    gq[8] = gqn[128 + 2 * s]; gq[9] = gqn[129 + 2 * s]; gq[10] = gqn[160 + 2 * s]; gq[11] = gqn[161 + 2 * s];
    gk[8] = gkn[128 + 2 * s]; gk[9] = gkn[129 + 2 * s]; gk[10] = gkn[160 + 2 * s]; gk[11] = gkn[161 + 2 * s];
    const int NQI = 0, NKI = MKV * 4;
    for (int it = gw; it < NQI + NKI; it += NGW) {
        const bool isq = it < NQI; const int r4 = isq ? it : it - NQI; const int row = r4 >> 2, h = (r4 & 3) * 4 + grp;
        float x[12];
        if (isq) {
            const bf16* p = QRAW + (size_t)row * 3072 + h * 192;
            const v4u w = *(const GAS v4u*)(p + 8 * s); const unsigned w1 = *(const GAS unsigned*)(p + 128 + 2 * s), w2 = *(const GAS unsigned*)(p + 160 + 2 * s);
            x[0] = bf_lo(w.x); x[1] = bf_hi(w.x); x[2] = bf_lo(w.y); x[3] = bf_hi(w.y); x[4] = bf_lo(w.z); x[5] = bf_hi(w.z); x[6] = bf_lo(w.w); x[7] = bf_hi(w.w);
            x[8] = bf_lo(w1); x[9] = bf_hi(w1); x[10] = bf_lo(w2); x[11] = bf_hi(w2);
        } else {
            const bf16* p = KVRAW + (size_t)row * 4096 + h * 256;
            const v4u w = *(const GAS v4u*)(p + 8 * s);
            x[0] = bf_lo(w.x); x[1] = bf_hi(w.x); x[2] = bf_lo(w.y); x[3] = bf_hi(w.y); x[4] = bf_lo(w.z); x[5] = bf_hi(w.z); x[6] = bf_lo(w.w); x[7] = bf_hi(w.w);
            const f32x2 k1 = *(const GAS f32x2*)(KPE + (size_t)row * 64 + 2 * s), k2 = *(const GAS f32x2*)(KPE + (size_t)row * 64 + 32 + 2 * s);
            x[8] = k1.x; x[9] = k1.y; x[10] = k2.x; x[11] = k2.y;
        }
        float ss = 0.f;
#pragma unroll
        for (int e = 0; e < 8; ++e) ss += x[e] * x[e];
        if (isq) { ss += x[8] * x[8] + x[9] * x[9] + x[10] * x[10] + x[11] * x[11]; ss = sum16(ss); }
        else { ss = sum16(ss) + SSK[row]; }
        const float rs = rsqrtf(ss * (1.f / 192.f) + EPS);
#pragma unroll
        for (int e = 0; e < 12; ++e) x[e] = x[e] * rs * (isq ? gq[e] : gk[e]);
        if (row >= MP && row < MALL) {
            const int t = (row - MP) & 2047; const f32x2 cs0 = RT[t * 32 + 2 * s], cs1 = RT[t * 32 + 2 * s + 1];
            const float a0 = x[8] * cs0.x - x[10] * cs0.y, b0 = x[8] * cs0.y + x[10] * cs0.x, a1 = x[9] * cs1.x - x[11] * cs1.y, b1 = x[9] * cs1.y + x[11] * cs1.x;
            x[8] = a0; x[9] = a1; x[10] = b0; x[11] = b1;
        }
        bf16* o = (isq ? QN : KF) + (size_t)row * 3072 + h * 192;
        *(GAS v4u*)(o + 8 * s) = (v4u){pk2(x[0], x[1]), pk2(x[2], x[3]), pk2(x[4], x[5]), pk2(x[6], x[7])};
        *(GAS unsigned*)(o + 128 + 2 * s) = pk2(x[8], x[9]); *(GAS unsigned*)(o + 160 + 2 * s) = pk2(x[10], x[11]);
    }
}
__device__ __forceinline__ void mla_attn_phase(const Args& a, int j, LAS unsigned char* lds, int tid, int vcu, int G) {
    OPAQUE_V(tid); PH_PTRS; OPAQUE_S(vcu); OPAQUE_S(G);
    const bf16* QN = (const bf16*)(ws + WS_S + S_QRAW); const bf16* KF = (const bf16*)(ws + WS_S + S_KF); const bf16* KVRAW = (const bf16*)(ws + WS_S + S_KVRAW);
    bf16* AO = (bf16*)(ws + WS_S + S_AO); const float* gqn = a.in[I_GQN] + (size_t)j * 192; const float* RT = (const float*)(ws + WS_ROPE);
    for (int u = vcu; u < 768; u += G) {
        int q0, h, NT; att::KvSrc src; const float* qrope = nullptr;
        if (u < 256) { const int b = u >> 7, qb = u & 7; h = (u >> 3) & 15; q0 = MP + b * 2048 + qb * 256; src = att::KvSrc{MP + b * 2048, 32, MALL + b * 256, 4}; NT = 36; qrope = RT + (size_t)(qb * 256) * 64; }
        else { const int v = u - 256, b = v >> 4; h = v & 15; q0 = b * 256; src = att::KvSrc{b * 256, 4, 0, 1}; NT = 4; }
        att::attn_unit<192, 0, 3072, 3072, 4096, DM, 1>(QN + (size_t)q0 * 3072 + h * 192, KF + h * 192, KVRAW + h * 256 + 128, AO + (size_t)q0 * DM + h * 128, src, NT, att::NatMask{0, 0, 0, nullptr}, (LAS char*)lds, tid, gqn, qrope);
    }
}
namespace pg8 {
struct EpiHg {
    static constexpr bool PERM = true;
    unsigned char* ws;
    __device__ __forceinline__ void operator()(const f32x4 (&acc)[2][2][4][2], const Unit& u, int wr, int wc, int fr, int fq) const {
        const int region = u.pn >> 3, row0 = u.pm * BM + wr * 64 + fr, col0 = (u.pn & 7) * BM + wc * 32 + 8 * fq;
        if (region == 1 || region == 2) {
            const int d = region - 1;
            f32x4 lbv[2][2];
#pragma unroll
            for (int bj = 0; bj < 2; ++bj)
#pragma unroll
                for (int n = 0; n < 2; ++n) lbv[bj][n] = *(const PG8_GAS f32x4*)((const float*)(ws + WS_LB) + d * 2048 + col0 + bj * HALF + 4 * n);
            bf16_t* K = (bf16_t*)(ws + WS_S + S_HK) + (size_t)d * 12288 * 2048; float* Gd = (float*)(ws + WS_U) + (size_t)d * 12288 * 2048;
#pragma unroll
            for (int ai = 0; ai < 2; ++ai)
#pragma unroll
                for (int m = 0; m < 4; ++m) { const size_t ro = (size_t)(row0 + ai * HALF + m * 16) * 2048 + col0;
#pragma unroll
                    for (int bj = 0; bj < 2; ++bj) { f32x4 kk[2], gg[2];
#pragma unroll
                        for (int n = 0; n < 2; ++n)
#pragma unroll
                            for (int e = 0; e < 4; ++e) { const float z = acc[ai][bj][m][n][e]; const float sn = __builtin_amdgcn_rcpf(1.f + __expf(z));
                                const float k = (1.f - lbv[bj][n][e]) * sn; kk[n][e] = k; gg[n][e] = __log2f(1.f - k); }
                        u32x4 w; w.x = cvt_pk_bf16(kk[0][0], kk[0][1]); w.y = cvt_pk_bf16(kk[0][2], kk[0][3]); w.z = cvt_pk_bf16(kk[1][0], kk[1][1]); w.w = cvt_pk_bf16(kk[1][2], kk[1][3]);
                        *(PG8_GAS u32x4*)(K + ro + bj * HALF) = w; *(PG8_GAS f32x4*)(Gd + ro + bj * HALF) = gg[0]; *(PG8_GAS f32x4*)(Gd + ro + bj * HALF + 4) = gg[1]; } }
        } else {
            bf16_t* O = (bf16_t*)(ws + WS_S + (region == 0 ? S_HQ : region == 3 ? S_HV : S_HGS)); const bool act = region != 3;
#pragma unroll
            for (int ai = 0; ai < 2; ++ai)
#pragma unroll
                for (int m = 0; m < 4; ++m) { bf16_t* rowp = O + (size_t)(row0 + ai * HALF + m * 16) * 2048 + col0;
#pragma unroll
                    for (int bj = 0; bj < 2; ++bj) { f32x4 v0 = acc[ai][bj][m][0], v1 = acc[ai][bj][m][1];
                        if (act) {
#pragma unroll
                            for (int e = 0; e < 4; ++e) { v0[e] = v0[e] * __builtin_amdgcn_rcpf(1.f + __expf(-v0[e])); v1[e] = v1[e] * __builtin_amdgcn_rcpf(1.f + __expf(-v1[e])); } }
                        u32x4 w; w.x = cvt_pk_bf16(v0[0], v0[1]); w.y = cvt_pk_bf16(v0[2], v0[3]); w.z = cvt_pk_bf16(v1[0], v1[1]); w.w = cvt_pk_bf16(v1[2], v1[3]);
                        *(PG8_GAS u32x4*)(rowp + bj * HALF) = w; } }
        }
    }
};
}

namespace hg {
constexpr int PQ = 272, PK = 80;
constexpr int OFF_QM = 0, OFF_KM = 32 * PQ, OFF_V = 2 * 32 * PQ, OFF_ATT = 3 * 32 * PQ, OFF_C2 = OFF_ATT + 32 * PK, OFF_C3 = OFF_C2 + 512, BUF = OFF_C3 + 512;
constexpr int OFF_TOT = 2 * BUF, TOT_BYTES = 8 * 128 * 4;
constexpr int OFF_OST = OFF_TOT + 2 * TOT_BYTES;
constexpr int OFF_STG = OFF_OST + 32 * PQ, STG_SLOT = 40960;
static_assert(OFF_STG + 2 * STG_SLOT <= LDSCTL_OFF, "scan LDS (must stay below the control words)");
typedef short bf16x8 __attribute__((ext_vector_type(8)));
typedef short s16x4 __attribute__((ext_vector_type(4)));
struct Chain { int rb, N, d, h; const float* S0; float* Sout; };
template <int OFF> __device__ __forceinline__ s16x4 tr_read(int addr) { s16x4 r; asm volatile("ds_read_b64_tr_b16 %0, %1 offset:%2" : "=&v"(r) : "v"(addr), "i"(OFF) : "memory"); return r; }
__device__ __forceinline__ unsigned bfmul2(unsigned w, float e0, float e1) { return pk2(bf_lo(w) * e0, bf_hi(w) * e1); }

__device__ __forceinline__ void scan_chain(const Chain ch, const bf16* __restrict__ HQ, const bf16* __restrict__ HK, const float* __restrict__ HG, const bf16* __restrict__ HV,
                                           bf16* __restrict__ OD, LAS unsigned char* lds, int tid) {
    const int lane = tid & 63, w = tid >> 6, l15 = lane & 15, q4 = lane >> 4;
    const int k2 = lane;
    const int vt = tid >> 4, v8 = (tid & 15) * 8;
    const int nc = ch.N >> 5, hc = ch.h * 128;
    f32x4 S[8];
    if (ch.S0) {
#pragma unroll
        for (int kt = 0; kt < 8; ++kt)
#pragma unroll
            for (int r = 0; r < 4; ++r) S[kt][r] = ((const GAS float*)ch.S0)[(size_t)(16 * kt + 4 * q4 + r) * 128 + 16 * w + l15];
    } else {
#pragma unroll
        for (int kt = 0; kt < 8; ++kt) S[kt] = (f32x4){0.f, 0.f, 0.f, 0.f};
    }
#define HG_ROW(c, t) (ch.rb + (ch.d ? ch.N - 1 - (32 * (c) + (t)) : 32 * (c) + (t)))
    struct InSet { f32x2 g[4]; unsigned q[4], k[4]; v4u v; };
    f32x2 cl[4]; unsigned cq[4], ck[4]; v4u cv;
#define HG_DMA(c) do { LAS unsigned char* sl_ = lds + OFF_STG + ((c) & 1) * STG_SLOT; \
        _Pragma("unroll") for (int i_ = 0; i_ < 2; ++i_) __builtin_amdgcn_global_load_lds((const unsigned*)(HG + (size_t)HG_ROW(c, 4 * w + 2 * i_ + (lane >> 5)) * 2048 + hc + (lane & 31) * 4), (LAS unsigned*)(sl_ + (4 * w + 2 * i_) * 512), 16, 0, 0); \
        { const size_t ro_ = (size_t)HG_ROW(c, 4 * w + (lane >> 4)) * 2048 + hc + (lane & 15) * 8; \
          __builtin_amdgcn_global_load_lds((const unsigned*)(HQ + ro_), (LAS unsigned*)(sl_ + 16384 + 4 * w * 256), 16, 0, 0); \
          __builtin_amdgcn_global_load_lds((const unsigned*)(HK + ro_), (LAS unsigned*)(sl_ + 24576 + 4 * w * 256), 16, 0, 0); \
          __builtin_amdgcn_global_load_lds((const unsigned*)(HV + ro_), (LAS unsigned*)(sl_ + 32768 + 4 * w * 256), 16, 0, 0); } } while (0)
#define HG_P1(c) do { const LAS unsigned char* sl_ = lds + OFF_STG + ((c) & 1) * STG_SLOT; f32x2 run = (f32x2){0.f, 0.f}; \
        _Pragma("unroll") for (int i = 0; i < 4; ++i) { run = run + *(const LAS f32x2*)(sl_ + (4 * w + i) * 512 + k2 * 8); cl[i] = run; cq[i] = *(const LAS unsigned*)(sl_ + 16384 + (4 * w + i) * 256 + k2 * 4); ck[i] = *(const LAS unsigned*)(sl_ + 24576 + (4 * w + i) * 256 + k2 * 4); } \
        cv = *(const LAS v4u*)(sl_ + 32768 + vt * 256 + v8 * 2); \
        *(LAS f32x2*)(lds + OFF_TOT + ((c) & 1) * TOT_BYTES + (w * 128 + 2 * k2) * 4) = run; } while (0)
    HG_DMA(0); HG_DMA(1);
    asm volatile("s_waitcnt vmcnt(0)" ::: "memory"); HG_P1(0); LDS_WAIT(); asm volatile("" ::: "memory");
    HG_DMA(2);
    LDS_WAIT(); __builtin_amdgcn_s_barrier(); asm volatile("" ::: "memory");
    const int traddr = (int)(uintptr_t)lds + (8 * q4 + (l15 >> 2)) * PQ + (l15 & 3) * 8;
    auto mstage = [&](const int pc) {
        { LAS unsigned char* B = lds + (pc & 1) * BUF; const int tb = traddr + (pc & 1) * BUF;
            const s16x4 v0 = tr_read<0>(tb + OFF_V + 32 * w), v1 = tr_read<4 * PQ>(tb + OFF_V + 32 * w);
            bf16x8 aat[2]; v2u aq0[2][4], aq1[2][4];
#pragma unroll
            for (int tt = 0; tt < 2; ++tt) { aat[tt] = *(const LAS bf16x8*)(B + OFF_ATT + (16 * tt + l15) * PK + 16 * q4);
#pragma unroll
                for (int ks = 0; ks < 4; ++ks) { aq0[tt][ks] = *(const LAS v2u*)(B + OFF_QM + (16 * tt + l15) * PQ + (32 * ks + 4 * q4) * 2); aq1[tt][ks] = *(const LAS v2u*)(B + OFF_QM + (16 * tt + l15) * PQ + (32 * ks + 16 + 4 * q4) * 2); } }
            f32x4 c2v[8];
#pragma unroll
            for (int kt = 0; kt < 8; ++kt) c2v[kt] = *(const LAS f32x4*)(B + OFF_C2 + (16 * kt + 4 * q4) * 4);
            LDS_WAIT(); __builtin_amdgcn_sched_barrier(0);
            const bf16x8 bv = (bf16x8){v0[0], v0[1], v0[2], v0[3], v1[0], v1[1], v1[2], v1[3]};
            f32x4 o2[2];
#pragma unroll
            for (int kt = 0; kt < 8; ++kt) S[kt] = S[kt] * c2v[kt];
#pragma unroll
            for (int tt = 0; tt < 2; ++tt) o2[tt] = __builtin_amdgcn_mfma_f32_16x16x32_bf16(aat[tt], bv, (f32x4){0.f, 0.f, 0.f, 0.f}, 0, 0, 0);
#pragma unroll
            for (int ks = 0; ks < 4; ++ks) {
                const v4u sb = (v4u){pk2(S[2 * ks][0], S[2 * ks][1]), pk2(S[2 * ks][2], S[2 * ks][3]), pk2(S[2 * ks + 1][0], S[2 * ks + 1][1]), pk2(S[2 * ks + 1][2], S[2 * ks + 1][3])};
                const bf16x8 bs = __builtin_bit_cast(bf16x8, sb);
#pragma unroll
                for (int tt = 0; tt < 2; ++tt) { const bf16x8 aq = __builtin_bit_cast(bf16x8, ((v4u){aq0[tt][ks].x, aq0[tt][ks].y, aq1[tt][ks].x, aq1[tt][ks].y}));
                    o2[tt] = __builtin_amdgcn_mfma_f32_16x16x32_bf16(aq, bs, o2[tt], 0, 0, 0); }
            }
            s16x4 ke0[8], ke1[8]; f32x4 elv[8];
#define HG_KRD(kt) ke0[kt] = tr_read<32 * (kt)>(tb + OFF_KM); ke1[kt] = tr_read<32 * (kt) + 4 * PQ>(tb + OFF_KM)
            HG_KRD(0); HG_KRD(1); HG_KRD(2); HG_KRD(3); HG_KRD(4); HG_KRD(5); HG_KRD(6); HG_KRD(7);
#undef HG_KRD
#pragma unroll
            for (int kt = 0; kt < 8; ++kt) elv[kt] = *(const LAS f32x4*)(B + OFF_C3 + (16 * kt + 4 * q4) * 4);
            LDS_WAIT(); __builtin_amdgcn_sched_barrier(0);
#pragma unroll
            for (int kt = 0; kt < 8; ++kt) { const bf16x8 ak = (bf16x8){ke0[kt][0], ke0[kt][1], ke0[kt][2], ke0[kt][3], ke1[kt][0], ke1[kt][1], ke1[kt][2], ke1[kt][3]};
                S[kt] = __builtin_amdgcn_mfma_f32_16x16x32_bf16(ak, bv, S[kt], 0, 0, 0) * elv[kt]; }
#pragma unroll
            for (int tt = 0; tt < 2; ++tt)
#pragma unroll
                for (int r = 0; r < 4; ++r) *(LAS unsigned short*)(lds + OFF_OST + (16 * tt + 4 * q4 + r) * PQ + (16 * w + l15) * 2) = (unsigned short)(pk2(o2[tt][r], 0.f) & 0xffffu);
        }
    };
    for (int c = 0; c < nc; ++c) {
        if (c > 0) mstage(c - 1);
        LAS unsigned char* B = lds + (c & 1) * BUF;
        { const LAS f32x2* T = (const LAS f32x2*)(lds + OFF_TOT + (c & 1) * TOT_BYTES) + k2;
          f32x2 off = (f32x2){0.f, 0.f}, cm = (f32x2){0.f, 0.f}, last = (f32x2){0.f, 0.f};
#pragma unroll
          for (int sgm = 0; sgm < 8; ++sgm) { const f32x2 tv = T[sgm * 64]; if (sgm < w) off = off + tv; if (sgm < 4) cm = cm + tv; last = last + tv; }
#pragma unroll
          for (int i = 0; i < 4; ++i) { const f32x2 cu = off + cl[i]; const int t = 4 * w + i;
              *(LAS unsigned*)(B + OFF_QM + t * PQ + k2 * 4) = bfmul2(cq[i], __builtin_amdgcn_exp2f(cu.x - cm.x), __builtin_amdgcn_exp2f(cu.y - cm.y));
              *(LAS unsigned*)(B + OFF_KM + t * PQ + k2 * 4) = bfmul2(ck[i], __builtin_amdgcn_exp2f(cm.x - cu.x), __builtin_amdgcn_exp2f(cm.y - cu.y));
 }
          if (w == 0) { *(LAS f32x2*)(B + OFF_C2 + k2 * 8) = (f32x2){__builtin_amdgcn_exp2f(cm.x), __builtin_amdgcn_exp2f(cm.y)}; *(LAS f32x2*)(B + OFF_C3 + k2 * 8) = (f32x2){__builtin_amdgcn_exp2f(last.x - cm.x), __builtin_amdgcn_exp2f(last.y - cm.y)}; }
          *(LAS v4u*)(B + OFF_V + vt * PQ + v8 * 2) = cv; }
        { asm volatile("s_waitcnt vmcnt(5)" ::: "memory"); HG_P1(c + 1); LDS_WAIT(); asm volatile("" ::: "memory");
          const int cn = c + 3 < nc ? c + 3 : nc - 1; HG_DMA(cn); }
        LDS_WAIT(); __builtin_amdgcn_s_barrier(); asm volatile("" ::: "memory");
        if (c > 0) *(GAS v4u*)(OD + (size_t)HG_ROW(c - 1, vt) * 2048 + hc + v8) = *(const LAS v4u*)(lds + OFF_OST + vt * PQ + v8 * 2);
        if (w < 4) {
            const int tt = w >> 1, st = w & 1; f32x4 at = (f32x4){0.f, 0.f, 0.f, 0.f};
            if (!(tt == 0 && st == 1)) {
                bf16x8 af[4], bfr[4];
#pragma unroll
                for (int ks = 0; ks < 4; ++ks) { af[ks] = *(const LAS bf16x8*)(B + OFF_QM + (16 * tt + l15) * PQ + (32 * ks + 8 * q4) * 2); bfr[ks] = *(const LAS bf16x8*)(B + OFF_KM + (16 * st + l15) * PQ + (32 * ks + 8 * q4) * 2); }
                LDS_WAIT(); __builtin_amdgcn_sched_barrier(0);
#pragma unroll
                for (int ks = 0; ks < 4; ++ks) at = __builtin_amdgcn_mfma_f32_16x16x32_bf16(af[ks], bfr[ks], at, 0, 0, 0);
            }
            const int s_ = 16 * st + l15;
#pragma unroll
            for (int r = 0; r < 4; ++r) { const int t = 16 * tt + 4 * q4 + r; const float val = (s_ <= t) ? at[r] : 0.f;
                *(LAS unsigned short*)(B + OFF_ATT + t * PK + s_ * 2) = (unsigned short)(pk2(val, 0.f) & 0xffffu); }
        }
        LDS_WAIT(); __builtin_amdgcn_s_barrier(); asm volatile("" ::: "memory");
    }
    mstage(nc - 1);
    LDS_WAIT(); __builtin_amdgcn_s_barrier(); asm volatile("" ::: "memory");
    *(GAS v4u*)(OD + (size_t)HG_ROW(nc - 1, vt) * 2048 + hc + v8) = *(const LAS v4u*)(lds + OFF_OST + vt * PQ + v8 * 2);
    if (ch.Sout) {
#pragma unroll
        for (int kt = 0; kt < 8; ++kt)
#pragma unroll
            for (int r = 0; r < 4; ++r) __builtin_nontemporal_store(S[kt][r] * DBG_SCALE, (GAS float*)ch.Sout + (size_t)(16 * kt + 4 * q4 + r) * 128 + 16 * w + l15);
    }
    __builtin_amdgcn_s_barrier();
#undef HG_ROW
#undef HG_LOAD
#undef HG_P1
}
}

__device__ __forceinline__ void hg_scan_phase(const Args& a, LAS unsigned char* lds, int tid, int vcu, int G) {
    OPAQUE_V(tid); PH_PTRS; OPAQUE_S(vcu); OPAQUE_S(G);
    const bf16* HQ = (const bf16*)(ws + WS_S + S_HQ); const bf16* HK = (const bf16*)(ws + WS_S + S_HK); const float* HGp = (const float*)(ws + WS_U);
    const bf16* HV = (const bf16*)(ws + WS_S + S_HV); bf16* OF = (bf16*)(ws + WS_S + S_OF);
    const int NS = G > 128 ? 64 : 0;
    const int first = vcu < NS ? vcu : NS + (vcu - NS), step = vcu < NS ? 1088 : G - NS;
    const int reps = ((DBG_REP_MASK >> 16) & 1) && vcu < NS ? 3 : ((DBG_REP_MASK >> 17) & 1) && vcu >= NS ? 3 : 1;
    for (int rep_ = 0; rep_ < reps; ++rep_)
    for (int ci = first; ci < 1088; ci += step) {
        const bool lat = ci < 64; const int e = lat ? ci : ci - 64, b = e >> 5, d = (e >> 4) & 1, h = e & 15;
        const size_t so = ((size_t)((b * 2 + d) * 16 + h)) * 16384;
        hg::Chain ch{lat ? MP + b * 2048 : b * 256, lat ? 2048 : 256, d, h, lat ? a.in[I_SHG] + so : nullptr, lat ? nullptr : out + O_HG + so};
        hg::scan_chain(ch, HQ, HK + (size_t)d * MALL * DM, HGp + (size_t)d * MALL * DM, HV, OF + (size_t)d * MALL * DM, lds, tid);
    }
}

__device__ __forceinline__ void hg_thin_c(const Args& a, int lane, int gw, int NGW) {
    OPAQUE_V(lane); PH_PTRS; OPAQUE_S(gw); OPAQUE_S(NGW);
    const bf16* OF = (const bf16*)(ws + WS_S + S_OF); const bf16* HGS = (const bf16*)(ws + WS_S + S_HGS); bf16* AO = (bf16*)(ws + WS_S + S_AO);
    const int grp = lane >> 4, s = lane & 15;
    const f32x4 g0 = *(const GAS f32x4*)(a.in[I_GHO] + 8 * s), g1 = *(const GAS f32x4*)(a.in[I_GHO] + 8 * s + 4);
    for (int it = gw; it < MALL * 4; it += NGW) {
        const int row = it >> 2, h = (it & 3) * 4 + grp; const size_t o_ = (size_t)row * DM + h * 128 + 8 * s;
        const v4u of = __builtin_nontemporal_load((const GAS v4u*)(OF + o_)), ob = __builtin_nontemporal_load((const GAS v4u*)(OF + (size_t)MALL * DM + o_));
        const f32x4 a0 = (f32x4){bf_lo(of.x) + bf_lo(ob.x), bf_hi(of.x) + bf_hi(ob.x), bf_lo(of.y) + bf_lo(ob.y), bf_hi(of.y) + bf_hi(ob.y)}, a1 = (f32x4){bf_lo(of.z) + bf_lo(ob.z), bf_hi(of.z) + bf_hi(ob.z), bf_lo(of.w) + bf_lo(ob.w), bf_hi(of.w) + bf_hi(ob.w)};
        float ss = (a0.x * a0.x + a0.y * a0.y) + (a0.z * a0.z + a0.w * a0.w) + (a1.x * a1.x + a1.y * a1.y) + (a1.z * a1.z + a1.w * a1.w);
        const float rs = rsqrtf(sum16(ss) * (1.f / 128.f) + EPS);
        const v4u gw_ = __builtin_nontemporal_load((const GAS v4u*)(HGS + o_));
        const f32x4 y0 = a0 * rs * g0 * (f32x4){bf_lo(gw_.x), bf_hi(gw_.x), bf_lo(gw_.y), bf_hi(gw_.y)}, y1 = a1 * rs * g1 * (f32x4){bf_lo(gw_.z), bf_hi(gw_.z), bf_lo(gw_.w), bf_hi(gw_.w)};
        *(GAS v4u*)(AO + o_) = (v4u){pk2(y0.x, y0.y), pk2(y0.z, y0.w), pk2(y1.x, y1.y), pk2(y1.z, y1.w)};
    }
}
namespace pg8 {
struct EpiNat {
    static constexpr bool PERM = true;
    bf16_t* QKV; bf16_t* KN; float* outk; float* outv; const float* gk; PG8_LAS float* tab;
    __device__ __forceinline__ void operator()(const f32x4 (&acc)[2][2][4][2], const Unit& u, int wr, int wc, int fr, int fq) const {
        const int region = u.pn >> 3, row0 = u.pm * BM + wr * 64 + fr, ct = (u.pn & 7) * BM + wc * 32 + 8 * fq;
        if (region == 1) {
#pragma unroll
            for (int ai = 0; ai < 2; ++ai)
#pragma unroll
                for (int m = 0; m < 4; ++m)
#pragma unroll
                    for (int bj = 0; bj < 2; ++bj) { const f32x4 a = acc[ai][bj][m][0], b = acc[ai][bj][m][1];
                        float s = (a[0] * a[0] + a[1] * a[1]) + (a[2] * a[2] + a[3] * a[3]) + (b[0] * b[0] + b[1] * b[1]) + (b[2] * b[2] + b[3] * b[3]);
                        s += __shfl_xor(s, 16); s += __shfl_xor(s, 32);
                        if (fq == 0) tab[((ai * HALF + wr * 64 + m * 16 + fr) * 2 + bj) * 4 + wc] = s; }
            asm volatile("s_waitcnt lgkmcnt(0)" ::: "memory"); __builtin_amdgcn_s_barrier(); asm volatile("" ::: "memory");
            f32x4 g0[2], g1[2];
#pragma unroll
            for (int bj = 0; bj < 2; ++bj) { g0[bj] = *(const PG8_GAS f32x4*)(gk + wc * 32 + 8 * fq); g1[bj] = *(const PG8_GAS f32x4*)(gk + wc * 32 + 8 * fq + 4); }
#pragma unroll
            for (int ai = 0; ai < 2; ++ai)
#pragma unroll
                for (int m = 0; m < 4; ++m) { const int row = row0 + ai * HALF + m * 16;
#pragma unroll
                    for (int bj = 0; bj < 2; ++bj) { const f32x4 p = *(const PG8_LAS f32x4*)(tab + ((ai * HALF + wr * 64 + m * 16 + fr) * 2 + bj) * 4);
                        const float rs = rsqrtf(((p[0] + p[1]) + (p[2] + p[3])) * (1.f / 128.f) + 1e-6f);
                        const f32x4 k0 = acc[ai][bj][m][0] * rs * g0[bj], k1 = acc[ai][bj][m][1] * rs * g1[bj];
                        u32x4 w; w.x = cvt_pk_bf16(k0[0], k0[1]); w.y = cvt_pk_bf16(k0[2], k0[3]); w.z = cvt_pk_bf16(k1[0], k1[1]); w.w = cvt_pk_bf16(k1[2], k1[3]);
                        *(PG8_GAS u32x4*)(KN + (size_t)row * 2048 + ct + bj * HALF) = w;
                        if (row < 8192) { __builtin_nontemporal_store(k0 * DBG_SCALE, (PG8_GAS f32x4*)(outk + (size_t)row * 2048 + ct + bj * HALF)); __builtin_nontemporal_store(k1 * DBG_SCALE, (PG8_GAS f32x4*)(outk + (size_t)row * 2048 + ct + bj * HALF + 4)); } } }
        } else {
#pragma unroll
            for (int ai = 0; ai < 2; ++ai)
#pragma unroll
                for (int m = 0; m < 4; ++m) { const int row = row0 + ai * HALF + m * 16;
#pragma unroll
                    for (int bj = 0; bj < 2; ++bj) { const f32x4 v0 = acc[ai][bj][m][0], v1 = acc[ai][bj][m][1];
                        u32x4 w; w.x = cvt_pk_bf16(v0[0], v0[1]); w.y = cvt_pk_bf16(v0[2], v0[3]); w.z = cvt_pk_bf16(v1[0], v1[1]); w.w = cvt_pk_bf16(v1[2], v1[3]);
                        *(PG8_GAS u32x4*)(QKV + (size_t)row * 6144 + region * 2048 + ct + bj * HALF) = w;
                        if (region == 2 && row < 8192) { __builtin_nontemporal_store(v0 * DBG_SCALE, (PG8_GAS f32x4*)(outv + (size_t)row * 2048 + ct + bj * HALF)); __builtin_nontemporal_store(v1 * DBG_SCALE, (PG8_GAS f32x4*)(outv + (size_t)row * 2048 + ct + bj * HALF + 4)); } } }
        }
    }
};
}
__device__ __forceinline__ void nat_cache_rows(const Args& a, int lane, int gw, int NGW) {
    OPAQUE_V(lane); PH_PTRS; OPAQUE_S(gw); OPAQUE_S(NGW);
    bf16* QKV = (bf16*)(ws + WS_S + S_NQKV); bf16* KN = (bf16*)(ws + WS_S + S_NKN);
    for (int it = gw; it < 512 * 4; it += NGW) {
        const int row = MALL + (it >> 2), c = (it & 3) * 512 + 8 * lane; const size_t so = (size_t)(row - MALL) * DM + c;
        const f32x4 k0 = *(const GAS f32x4*)(a.in[I_CNK] + so), k1 = *(const GAS f32x4*)(a.in[I_CNK] + so + 4), v0 = *(const GAS f32x4*)(a.in[I_CNV] + so), v1 = *(const GAS f32x4*)(a.in[I_CNV] + so + 4);
        *(GAS v4u*)(KN + (size_t)row * DM + c) = (v4u){pk2(k0.x, k0.y), pk2(k0.z, k0.w), pk2(k1.x, k1.y), pk2(k1.z, k1.w)};
        *(GAS v4u*)(QKV + (size_t)row * 6144 + 4096 + c) = (v4u){pk2(v0.x, v0.y), pk2(v0.z, v0.w), pk2(v1.x, v1.y), pk2(v1.z, v1.w)};
    }
}
__device__ __forceinline__ void nat_attn_phase(const Args& a, LAS unsigned char* lds, int tid, int vcu, int G) {
    OPAQUE_V(tid); PH_PTRS; OPAQUE_S(vcu); OPAQUE_S(G);
    const bf16* QKV = (const bf16*)(ws + WS_S + S_NQKV); const bf16* KN = (const bf16*)(ws + WS_S + S_NKN); bf16* AO = (bf16*)(ws + WS_S + S_AO); const float* gq = a.in[I_GNQ];
    LAS float* rpb = (LAS float*)(lds + att::RPB_OFF);
    for (int u = vcu; u < 768; u += G) {
        if (u < 256) {
            const int b = u >> 7, h = (u >> 3) & 15, i = u & 7, q0 = MP + b * 2048 + i * 256;
            const int rlo = min(max(4 * i - 4, 0), 24), rhi = min(max(4 * i - 1, 0), 24) + 8, nrows = rhi - rlo;
            __syncthreads();
            for (int e = tid; e < 465; e += NTHR) rpb[e] = a.in[I_RPB][h * 465 + e] * 11.313708498984761f;
            __syncthreads();
            const att::KvSrc src{MALL + b * 256, 4, MP + b * 2048 + 64 * rlo, nrows};
            const att::NatMask nm{rlo, 4 * i + ((tid >> 6) >> 1), 32 * ((tid >> 6) & 1) + (tid & 31), rpb};
            att::attn_unit<128, 1, 6144, DM, 6144, DM, 1>(QKV + (size_t)q0 * 6144 + h * 128, KN + h * 128, QKV + 4096 + h * 128, AO + (size_t)q0 * DM + h * 128, src, 4 + nrows, nm, (LAS char*)lds, tid, gq, nullptr);
        } else {
            const int v = u - 256, b = v >> 4, h = v & 15, q0 = b * 256;
            const att::KvSrc src{b * 256, 4, 0, 1};
            att::attn_unit<128, 0, 6144, DM, 6144, DM, 1>(QKV + (size_t)q0 * 6144 + h * 128, KN + h * 128, QKV + 4096 + h * 128, AO + (size_t)q0 * DM + h * 128, src, 4, att::NatMask{0, 0, 0, nullptr}, (LAS char*)lds, tid, gq, nullptr);
        }
    }
}
constexpr int NPHASE = 2 + 10 * DEPTH;
__host__ __device__ constexpr bool phase_exists(int ph) {
    if (ph == 0 || ph == NPHASE - 1) return true;
    const int l = (ph - 1) / 10, k = (ph - 1) % 10, kind = l % 3;
    if (k == 2) return kind != 2;
    if (k == 3) return kind == 0;
    if (k == 4) return kind == 1;
    if (k == 5) return kind != 1;
    return true;
}

__global__ void __launch_bounds__(NTHR, 2) fwd(Args a) {
    extern __shared__ __attribute__((aligned(16))) unsigned char lds_[];
    LAS unsigned char* lds = (LAS unsigned char*)lds_;
#define tid ({ int t_ = threadIdx.x; asm volatile("" : "+v"(t_)); t_; })
#define lane (tid & 63)
#define wave (__builtin_amdgcn_readfirstlane(tid >> 6))
    const int G = gridDim.x, bx = blockIdx.x, vcu = (G % 8 == 0) ? (bx % 8) * (G / 8) + bx / 8 : bx;
    const int NGW = G * NWAVES;
#define gw (vcu * NWAVES + wave)
    volatile LAS unsigned* MISC = (volatile LAS unsigned*)(lds + MISC_OFF);
    unsigned* ctl = (unsigned*)(a.ws + WS_CTL);
    for (int u = tid; u < (LDS_BYTES - LDSCTL_OFF) / 4; u += NTHR) ((LAS unsigned*)(lds + LDSCTL_OFF))[u] = 0u;
    __syncthreads();
    XcdBarrier bar; bar.bar = ctl + CW_BAR; bar.x = 0; bar.st = nullptr;
    if (MK_SINGLE) bar = xcd_barrier_post(ctl + CW_BAR, MISC + 8);
    if (threadIdx.x == 0) { unsigned long long pc_; asm volatile("s_getpc_b64 %0" : "=s"(pc_)); pc_ &= ~63ull; MISC[10] = (unsigned)pc_; MISC[11] = (unsigned)(pc_ >> 32); }
    const int lo = a.ph_lo, hi = a.ph_hi;
#define IN(k) (lo <= (k) && (k) < hi)
#ifndef DBG_REP_MASK
#define DBG_REP_MASK 0
#endif
#define REPEAT(id) for (int rep_ = 0; rep_ < (((DBG_REP_MASK >> (id)) & 1) ? 3 : 1); ++rep_)
#if defined(DBG_PROF)
    { unsigned long long* prof = (unsigned long long*)((unsigned char*)ctl + WS_PROF); float* po_ = a.out;
      if (bx == 0 && tid == 0) { prof[200] = (unsigned long long)*(volatile unsigned*)(po_ + O_END - 1); prof[100] = wall_clock64(); prof[300] = clock64(); } }
#define SEAM(k) do { if (MK_SINGLE && (k) + 1 < hi) xcd_barrier(bar); if (bx == 0 && tid == 0) { unsigned long long* prof = (unsigned long long*)((unsigned char*)bar.bar - CW_BAR * 4 + WS_PROF); prof[100 + (k) + 1] = wall_clock64(); prof[300 + (k) + 1] = clock64(); } } while (0)
#else
#define SEAM(k) do { if (MK_SINGLE && (k) + 1 < hi) xcd_barrier(bar); } while (0)
#endif
#define GEMM_PTRS PH_PTRS; int gG = G, gbx = bx; OPAQUE_S(gG); OPAQUE_S(gbx); bf16* const H = (bf16*)(ws + WS_H); bf16* const U = (bf16*)(ws + WS_U); bf16* const AO = (bf16*)(ws + WS_S + S_AO); bf16* const X = (bf16*)(ws + WS_S + S_X); \
    const float* const MODS = (const float*)(ws + WS_MODS); (void)H; (void)U; (void)AO; (void)X; (void)MODS

#define CONVERT_WINDOW(lo_, hi_, nunits) do { const int from_ = (nunits) % gG; if (!from_ || gbx >= from_) p0_convert_range(a, lds, lo_, hi_, (gbx - from_) * NWAVES + wave, (gG - from_) * NWAVES, lane, wave); } while (0)

#define PF_TILE(off_, pn_, rowbytes_) do { unsigned char* q_ = a.ws; OPAQUE_S(q_); const unsigned long long p_ = (unsigned long long)(q_ + (off_) + (size_t)(pn_) * 256 * (rowbytes_)); \
        MISC[12] = (unsigned)p_; MISC[13] = (unsigned)(p_ >> 32); MISC[14] = (rowbytes_); } while (0)
#define PF_WO(wo_off_) do { if (threadIdx.x == 0) { int b_ = blockIdx.x; OPAQUE_S(b_); const int w_ = (b_ & 7) * 32 + ((b_ >> 3) & 31), pn_ = ((w_ & 63) >> 3) & 7; \
        unsigned char* q_ = a.ws; OPAQUE_S(q_); const unsigned long long p_ = (unsigned long long)(q_ + (wo_off_) + (size_t)pn_ * 256 * DM * 2); MISC[12] = (unsigned)p_; MISC[13] = (unsigned)(p_ >> 32); MISC[14] = DM * 2; } } while (0)

    if (IN(0)) { REPEAT(0) { p0_prologue(a, lds, tid, lane, wave, vcu, G); rope_table(a, tid, vcu, G); if (DBG_REP_MASK & 1) __syncthreads(); } SEAM(0); }

    for (int l = 0; l < DEPTH; ++l) {
        const int kind = l % 3, j = l / 3, pb = 1 + 10 * l;
        if (IN(pb + 0)) { REPEAT(1) norm_phase(a, l, false, l > 0 ? (const float*)(a.ws + WS_MODS) + (size_t)(l - 1) * 3 * NMOD + 5 * DM : nullptr, lane, gw, NGW); if (kind == 2) nat_cache_rows(a, lane, gw, NGW);
            if (threadIdx.x == 0) {
                int b_ = blockIdx.x; OPAQUE_S(b_);
                if (kind == 0) { const int wg_ = (b_ & 7) * 30 + (b_ >> 3), pn_ = b_ < 240 ? (wg_ % 40) >> 3 : 5; PF_TILE(WS_WMLA + (size_t)(l / 3) * WMLA_STRIDE, pn_, DM * 2); }
                else if (kind == 1) { const int wg_ = (b_ & 7) * 240 + (b_ >> 3), pn_ = (wg_ % 320) >> 3; PF_TILE(WS_WHG, pn_, DM * 2); }
                else { const int wg_ = (b_ & 7) * 144 + (b_ >> 3), pn_ = (wg_ % 192) >> 3; PF_TILE(WS_WNAT, pn_, DM * 2); } }
            SEAM(pb + 0); }
        if (kind == 0) {
            if (IN(pb + 1)) {
                GEMM_PTRS; unsigned char* wm = ws + WS_WMLA + (size_t)j * WMLA_STRIDE;
                pg8::Gemm g{H, (const bf16*)wm, MALL, 1536, DM, DM, DM, 1}; pg8::QaOrder S; S.init(gG, gbx, g.K);
                pg8::EpiBf16<0> E{(bf16*)(ws + WS_S + S_QAKV), 1536};
                REPEAT(2) pg8::gemm_phase<pg8::EpiBf16<0>, pg8::QaOrder>(lds, g, S, E);
                CONVERT_WINDOW(a.wstart[l + 1], a.wmid[l + 1], 288);
                SEAM(pb + 1);
            }
            if (IN(pb + 2)) { REPEAT(3) mla_thin_a(a, j, lane, gw, NGW);
                if (threadIdx.x == 0) { int b_ = blockIdx.x; OPAQUE_S(b_); const int wg_ = (b_ & 7) * 72 + (b_ >> 3), pn_ = (wg_ % 96) >> 3; PF_TILE(WS_WMLA + (size_t)j * WMLA_STRIDE + WMLA_QB, pn_, 768 * 2); }
                SEAM(pb + 2); }
            if (IN(pb + 3)) {
                GEMM_PTRS; unsigned char* wm = ws + WS_WMLA + (size_t)j * WMLA_STRIDE;
                REPEAT(4) {
                { pg8::Gemm g{(const bf16*)(ws + WS_S + S_QAN), (const bf16*)(wm + WMLA_QB), MALL, 3072, 768, 768, 768, 1}; pg8::StaticOrder S; S.init(MALL, 3072, 1, gG, gbx, g.K);
                  pg8::EpiBf16<0> E{(bf16*)(ws + WS_S + S_QRAW), 3072};
                  pg8::gemm_phase<pg8::EpiBf16<0>, pg8::StaticOrder>(lds, g, S, E); }
                { pg8::Gemm g{(const bf16*)(ws + WS_S + S_CKVN), (const bf16*)(wm + WMLA_KVB), MKV, 4096, 512, 512, 512, 1}; pg8::StaticOrder S; S.init(MKV, 4096, 1, gG, (gbx + gG / 2) % gG, g.K);
                  pg8::EpiKV E{(bf16*)(ws + WS_S + S_KVRAW), (bf16*)(ws + WS_S + S_KF), a.in[I_GKN] + (size_t)j * 192, (const float*)(ws + WS_S + S_KPE), (const float*)(ws + WS_SSK), (const float*)(ws + WS_ROPE), (LAS float*)(lds + EPI_TAB_OFF)};
                  pg8::gemm_phase<pg8::EpiKV, pg8::StaticOrder>(lds, g, S, E); }
                }
                {
                    int p_ = gbx, np_ = gG;
                    if (gG == 256) { p_ = gbx < 64 ? -1 : gbx < 128 ? gbx - 64 : gbx < 160 ? -1 : gbx - 96; np_ = 160; }
                    if (p_ >= 0) p0_convert_range(a, lds, a.wmid[l + 1], a.wstart[l + 2], p_ * NWAVES + wave, np_ * NWAVES, lane, wave);
                }
                SEAM(pb + 3);
            }
            if (IN(pb + 5)) { REPEAT(6) mla_attn_phase(a, j, lds, tid, vcu, G); PF_WO(WS_WMLA + (size_t)j * WMLA_STRIDE + WMLA_WO); SEAM(pb + 5); }
        }
        if (kind == 1) {
            if (IN(pb + 1)) {
                GEMM_PTRS;
                pg8::Gemm g{H, (const bf16*)(ws + WS_WHG), MALL, 10240, DM, DM, DM, 1}; pg8::StaticOrder S; S.init(MALL, 10240, 1, gG, gbx, g.K);
                pg8::EpiHg E{ws};
                REPEAT(8) pg8::gemm_phase<pg8::EpiHg, pg8::StaticOrder, false>(lds, g, S, E);
                CONVERT_WINDOW(a.wstart[l + 1], a.wstart[l + 2], 1920);
                SEAM(pb + 1);
            }
            if (IN(pb + 2)) { REPEAT(9) hg_scan_phase(a, lds, tid, vcu, G); SEAM(pb + 2); }
            if (IN(pb + 4)) { REPEAT(10) hg_thin_c(a, lane, gw, NGW); PF_WO(WS_WHG + WHG_WO); SEAM(pb + 4); }
        }
        if (kind == 2) {
            if (IN(pb + 1)) {
                GEMM_PTRS;
                pg8::Gemm g{H, (const bf16*)(ws + WS_WNAT), MALL, 6144, DM, DM, DM, 1}; pg8::StaticOrder S; S.init(MALL, 6144, 1, gG, gbx, g.K);
                pg8::EpiNat E{(bf16*)(ws + WS_S + S_NQKV), (bf16*)(ws + WS_S + S_NKN), out + O_NK, out + O_NV, a.in[I_GNK], (LAS float*)(lds + EPI_TAB_OFF)};
                REPEAT(11) pg8::gemm_phase<pg8::EpiNat, pg8::StaticOrder>(lds, g, S, E);
                CONVERT_WINDOW(a.wstart[l + 1], a.wstart[l + 2], 1152);
                SEAM(pb + 1);
            }
            if (IN(pb + 5)) { REPEAT(13) nat_attn_phase(a, lds, tid, vcu, G); PF_WO(WS_WNAT + WNAT_WO); SEAM(pb + 5); }
        }
        if (IN(pb + 6)) {
            GEMM_PTRS;
            const bf16* wo = (const bf16*)(kind == 0 ? ws + WS_WMLA + (size_t)j * WMLA_STRIDE + WMLA_WO : kind == 1 ? ws + WS_WHG + WHG_WO : ws + WS_WNAT + WNAT_WO);
            pg8::Gemm g{AO, wo, MALL, DM, DM / 2, DM, DM, 2}; pg8::ResOrder S; S.init(gG, gbx, DM);
            pg8::EpiRes2 E{X, MODS + (size_t)l * 3 * NMOD + 2 * DM, (bf16*)(ws + WS_S + S_PART), nullptr};
            pg8::gemm_phase<pg8::EpiRes2, pg8::ResOrder>(lds, g, S, E);
            if (threadIdx.x == 0) { unsigned char* q_ = a.ws; OPAQUE_S(q_); const unsigned long long p_ = (unsigned long long)(q_ + WS_MODS + (size_t)l * 3 * NMOD * 4);
                MISC[12] = (unsigned)p_; MISC[13] = (unsigned)(p_ >> 32); MISC[14] = 1u;
                const unsigned long long g_ = (unsigned long long)(a.in[I_GFFN] + (size_t)l * DM); MISC[15] = (unsigned)g_; MISC[16] = (unsigned)(g_ >> 32); }
            SEAM(pb + 6);
        }
        if (IN(pb + 7)) { REPEAT(1) norm_phase(a, l, true, (const float*)(a.ws + WS_MODS) + (size_t)l * 3 * NMOD + 2 * DM, lane, gw, NGW);
            if (threadIdx.x == 0) {
                int b_ = blockIdx.x; OPAQUE_S(b_); const int wg_ = (b_ & 7) * 192 + (b_ >> 3), pn_ = ((wg_ & 255) >> 3) & 31;
                const unsigned long long p_ = (unsigned long long)(a.ws + WS_WFF1 + (size_t)l * DM * FF * 2 + (size_t)pn_ * 256 * DM * 2);
                MISC[12] = (unsigned)p_; MISC[13] = (unsigned)(p_ >> 32); MISC[14] = DM * 2; }
            SEAM(pb + 7); }
        if (IN(pb + 8)) {
            GEMM_PTRS;
            pg8::Gemm g{H, (const bf16*)(ws + WS_WFF1) + (size_t)l * DM * FF, MALL, FF, DM, DM, DM, 1}; pg8::StaticOrder S; S.init(MALL, FF, 1, gG, gbx, g.K);
            pg8::EpiBf16<1> E{U, FF};
            REPEAT(7) pg8::gemm_phase<pg8::EpiBf16<1>, pg8::StaticOrder>(lds, g, S, E);
            if (threadIdx.x == 0) {
                int b_ = blockIdx.x; OPAQUE_S(b_); const int w_ = (b_ & 7) * 32 + ((b_ >> 3) & 31), pn_ = ((w_ & 63) >> 3) & 7;
                const unsigned long long p_ = (unsigned long long)(a.ws + WS_WFF2 + (size_t)l * DM * FF * 2 + (size_t)pn_ * 256 * FF * 2);
                MISC[12] = (unsigned)p_; MISC[13] = (unsigned)(p_ >> 32); MISC[14] = FF * 2; }
            SEAM(pb + 8);
        }
        if (IN(pb + 9)) {
            GEMM_PTRS;
            pg8::Gemm g{U, (const bf16*)(ws + WS_WFF2) + (size_t)l * DM * FF, MALL, DM, FF / 2, FF, FF, 2}; pg8::ResOrder S; S.init(gG, gbx, FF);
            pg8::EpiRes2 E{X, MODS + (size_t)l * 3 * NMOD + 5 * DM, (bf16*)(ws + WS_S + S_PART), l + 1 == DEPTH ? out + O_X : nullptr};
            pg8::gemm_phase<pg8::EpiRes2, pg8::ResOrder>(lds, g, S, E);
            if (threadIdx.x == 0) { unsigned char* q_ = a.ws; OPAQUE_S(q_);
                if (l + 1 < DEPTH) { const unsigned long long p_ = (unsigned long long)(q_ + WS_MODS + (size_t)(l + 1) * 3 * NMOD * 4);
                    MISC[12] = (unsigned)p_; MISC[13] = (unsigned)(p_ >> 32); MISC[14] = 1u;
                    const unsigned long long g_ = (unsigned long long)(a.in[I_GMIX] + (size_t)(l + 1) * DM); MISC[15] = (unsigned)g_; MISC[16] = (unsigned)(g_ >> 32);
                    const unsigned long long f_ = p_ - (unsigned long long)3 * NMOD * 4; MISC[17] = (unsigned)f_; MISC[18] = (unsigned)(f_ >> 32); }
                else { const unsigned long long p_ = (unsigned long long)(q_ + WS_MODS + (size_t)l * 3 * NMOD * 4);
                    MISC[12] = (unsigned)p_; MISC[13] = (unsigned)(p_ >> 32); MISC[14] = 1u; } }
            SEAM(pb + 9);
        }
    }
    if (IN(NPHASE - 1)) final_fix_phase(a, (const float*)(a.ws + WS_MODS) + (size_t)(DEPTH - 1) * 3 * NMOD + 5 * DM, lane, gw, NGW);
#if defined(DBG_PROF)
    xcd_barrier(bar);
    { unsigned long long* prof = (unsigned long long*)((unsigned char*)bar.bar - CW_BAR * 4 + WS_PROF); float* po_ = a.out;
    if (bx == 0) {
        if (tid == 0) { prof[100 + NPHASE] = wall_clock64(); prof[300 + NPHASE] = clock64(); }
        __syncthreads();
        if (tid == 0) { constexpr int p = DBG_PROF; const unsigned long long dw = prof[100 + p + 1] - prof[100 + p], dc = prof[300 + p + 1] - prof[300 + p];
            float mant = (float)dw * 1e-4f; mant = mant < 1.f ? 1.f : mant > 9.9f ? 9.9f : mant; const int expo = dw ? (int)(dc / dw) : 0;
            po_[O_X + 7] = mant * __builtin_powif(10.f, expo); }
    } }
#endif
#undef IN
#undef SEAM
#undef tid
#undef lane
#undef wave
#undef gw
}

extern "C" void kernel_launch(void* const* d_in, const int* in_sizes, int n_in, void* d_out, int out_size, void* d_ws, size_t ws_size, hipStream_t stream) {
    static int grid = 0;
    if (grid == 0) {
        if (n_in != N_IN || (size_t)out_size != O_END || ws_size < WS_END) { fprintf(stderr, "kernel_launch: shape mismatch n_in %d out %d ws %zu (need %zu); nothing launched\n", n_in, out_size, ws_size, (size_t)WS_END); grid = -1; return; }
        int dev = 0, cus = 0, per_cu = 0;
        if (hipGetDevice(&dev) != hipSuccess || hipDeviceGetAttribute(&cus, hipDeviceAttributeMultiprocessorCount, dev) != hipSuccess) { fprintf(stderr, "kernel_launch: device query failed\n"); grid = -1; return; }
        if (hipFuncSetAttribute((const void*)fwd, hipFuncAttributeMaxDynamicSharedMemorySize, LDS_BYTES) != hipSuccess) { fprintf(stderr, "kernel_launch: hipFuncSetAttribute failed\n"); grid = -1; return; }
        if (hipOccupancyMaxActiveBlocksPerMultiprocessor(&per_cu, (const void*)fwd, NTHR, LDS_BYTES) != hipSuccess || per_cu < 1) { fprintf(stderr, "kernel_launch: occupancy query says %d blocks/CU\n", per_cu); }
        (void)hipGetLastError();
        grid = cus;
    }
    if (grid < 0) return;
    if (hipMemsetAsync((char*)d_ws + WS_CTL, 0, CTL_ZERO_BYTES, stream) != hipSuccess) { fprintf(stderr, "kernel_launch: memset failed\n"); return; }
    Args a{};
    for (int i = 0; i < N_IN; ++i) a.in[i] = (const float*)d_in[i];
    a.out = (float*)d_out; a.ws = (unsigned char*)d_ws;
    int nt = 0, items = 0;
    auto add = [&](const float* src, size_t dst_off, int K, int N, int row_off) { TJob& t = a.tj[nt++]; t.src = src; t.dst = (bf16*)((unsigned char*)d_ws + dst_off); t.K = K; t.N = N; t.row_off = row_off; t.start = items; items += (K / 64) * (N / 32); };
    auto add_mla_a = [&](int j) { const size_t wb = WS_WMLA + (size_t)j * WMLA_STRIDE;
        add(a.in[I_WQA] + (size_t)j * DM * 768, wb, DM, 768, 0); add(a.in[I_WKVA] + (size_t)j * DM * 576, wb, DM, 576, 768); };
    auto add_mla_b = [&](int j) { const size_t wb = WS_WMLA + (size_t)j * WMLA_STRIDE;
        add(a.in[I_WQB] + (size_t)j * 768 * 3072, wb + WMLA_QB, 768, 3072, 0); add(a.in[I_WKVB] + (size_t)j * 512 * 4096, wb + WMLA_KVB, 512, 4096, 0);
        add(a.in[I_WMO] + (size_t)j * DM * DM, wb + WMLA_WO, DM, DM, 0); };
    auto add_mixer = [&](int l) {
        if (l % 3 == 0) { add_mla_a(l / 3); add_mla_b(l / 3); }
        if (l % 3 == 1) { add(a.in[I_WHQ], WS_WHG, DM, DM, 0); add(a.in[I_WHF], WS_WHG, DM, DM, 2048); add(a.in[I_WHF] + (size_t)DM * DM, WS_WHG, DM, DM, 4096);
            add(a.in[I_WHI], WS_WHG, DM, DM, 6144); add(a.in[I_WHG], WS_WHG, DM, DM, 8192); add(a.in[I_WHO], WS_WHG + WHG_WO, DM, DM, 0); }
        if (l % 3 == 2) { add(a.in[I_WNQKV], WS_WNAT, DM, 3 * DM, 0); add(a.in[I_WNO], WS_WNAT + WNAT_WO, DM, DM, 0); } };
    a.wstart[0] = 0; add_mla_a(0);
    for (int l = 0; l < DEPTH; ++l) {
        a.wstart[l + 1] = items;
        if (l % 3 == 0) add_mla_b(l / 3);
        add(a.in[I_WFF1] + (size_t)l * DM * FF, WS_WFF1 + (size_t)l * DM * FF * 2, DM, FF, 0); add(a.in[I_WFF2] + (size_t)l * DM * FF, WS_WFF2 + (size_t)l * DM * FF * 2, FF, DM, 0);
        if (l + 1 < DEPTH) { if ((l + 1) % 3 == 0) add_mla_a((l + 1) / 3); else add_mixer(l + 1); }
    }
    for (int w = DEPTH + 1; w < 8; ++w) a.wstart[w] = items;
    for (int w = 0; w < 8; ++w) a.wmid[w] = a.wstart[w];
    for (int l = 0; l < DEPTH; ++l) if (l % 3 == 0) {
        const int from = 288 % grid, part = (from ? grid - from : grid) * NWAVES; long n = (long)WQA * part; const long tot = a.wstart[l + 2] - a.wstart[l + 1]; if (n > tot) n = tot;
        a.wmid[l + 1] = a.wstart[l + 1] + (int)n; }
    a.ntj = nt; a.nitems = items;
#if MK_SINGLE
    a.ph_lo = 0; a.ph_hi = NPHASE < MK_LAST_PHASE ? NPHASE : MK_LAST_PHASE;
    hipLaunchKernelGGL(fwd, dim3(grid), dim3(NTHR), LDS_BYTES, stream, a);
#else
    for (int ph = 0; ph < NPHASE && ph < MK_LAST_PHASE; ++ph) {
        if (!phase_exists(ph)) continue;
        a.ph_lo = ph; a.ph_hi = ph + 1;
        hipLaunchKernelGGL(fwd, dim3(grid), dim3(NTHR), LDS_BYTES, stream, a);
    }
#endif
    const hipError_t le = hipPeekAtLastError();
    if (le != hipSuccess) fprintf(stderr, "kernel_launch: launch failed: %s\n", hipGetErrorName(le));
}
```
